# Optimizing an MI355X kernel written in HIP

```python
import math
import jax, jax.numpy as jnp
from jax import lax
import numpy as np

D_MODEL = 1024
BATCH = 8
SEQ = 4096
DEPTH = 1

PLE_DIM = 256
D_MIX = D_MODEL
CONV_WIDTH = D_MIX // 2
CONV_HEADS = 8
POOL_WIDTH = D_MIX - CONV_WIDTH
POOL_WINDOWS = (2, 4, 8, 16)
POOL_GROUP = POOL_WIDTH // len(POOL_WINDOWS)
IN_PROJ_WIDTH = 3 * CONV_WIDTH + POOL_WIDTH
CONV_K = 3
PEER_HEADS = 8
PEER_QDIM = 256
PEER_HALF = PEER_QDIM // 2
N_KEYS = 128
N_EXPERTS = N_KEYS * N_KEYS
PEER_TOPK = 16
TOKEN_BLOCK = 128
EPS = 1e-6

kernel_name = "hybrid_conv_pool_peer_block"


def rms_norm(x, g):
    xf = x.astype(jnp.float32)
    y = xf * lax.rsqrt(jnp.mean(xf * xf, axis=-1, keepdims=True) + EPS)
    return (y * g.astype(jnp.float32)).astype(x.dtype)


def short_conv_mixer(b_gate, c_gate, v, conv_w):
    z = c_gate * v
    zp = jnp.pad(z, ((0, 0), (1, 1), (0, 0)))
    y = conv_w[0] * zp[:, :-2] + conv_w[1] * zp[:, 1:-1] + conv_w[2] * zp[:, 2:]
    return b_gate * y


def pool_mixer(u, pool_w, pool_scale):
    bsz, seq, _ = u.shape
    ug = u.astype(jnp.float32).reshape(bsz, seq, len(POOL_WINDOWS), POOL_GROUP)
    t = jnp.arange(seq)
    outs = []
    for g, w in enumerate(POOL_WINDOWS):
        xg = ug[:, :, g]
        cs = jnp.concatenate([jnp.zeros((bsz, 1, POOL_GROUP), jnp.float32),
                              jnp.cumsum(xg, axis=1)], axis=1)
        lo = jnp.clip(t - w // 2, 0, seq)
        hi = jnp.clip(t + w // 2, 0, seq)
        win_sum = jnp.take(cs, hi, axis=1) - jnp.take(cs, lo, axis=1)
        cnt = (hi - lo).astype(jnp.float32)[None, :, None]
        outs.append(win_sum / cnt - xg)
    pooled = jnp.stack(outs, axis=2).astype(u.dtype)
    y = jnp.einsum('bsgc,gcd->bsgd', pooled, pool_w)
    return y.reshape(bsz, seq, POOL_WIDTH) * pool_scale


def peer_block(xb, w_q, sub_keys, expert_u, expert_v):
    T = xb.shape[0]
    q = (xb @ w_q).reshape(T, PEER_HEADS, 2, PEER_HALF)
    s = jnp.einsum('thpd,hpkd->thpk', q, sub_keys)
    sv, si = lax.top_k(s, PEER_TOPK)
    cand = (sv[:, :, 0, :, None] + sv[:, :, 1, None, :]).reshape(T, PEER_HEADS, PEER_TOPK * PEER_TOPK)
    cidx = (si[:, :, 0, :, None] * N_KEYS + si[:, :, 1, None, :]).reshape(T, PEER_HEADS, PEER_TOPK * PEER_TOPK)
    top_s, pos = lax.top_k(cand, PEER_TOPK)
    eidx = jnp.take_along_axis(cidx, pos, axis=-1)
    gate = jax.nn.softmax(top_s.astype(jnp.float32), axis=-1).astype(xb.dtype)
    u = jnp.take(expert_u, eidx, axis=0)
    act = jax.nn.gelu(jnp.einsum('thkd,td->thk', u, xb))
    v = jnp.take(expert_v, eidx, axis=0)
    return jnp.einsum('thk,thkd->td', gate * act, v)


def peer_ffn(xn, w_q, sub_keys, expert_u, expert_v):
    bsz, seq, d = xn.shape
    blocks = xn.reshape(-1, TOKEN_BLOCK, d)
    out = lax.map(lambda xb: peer_block(xb, w_q, sub_keys, expert_u, expert_v), blocks)
    return out.reshape(bsz, seq, d)


def setup_inputs(seed: int = 0) -> dict:
    key = jax.random.key(seed)
    ks = jax.random.split(key, 20)
    f32 = jnp.float32
    def nrm(k, shape, scale):
        return jax.random.normal(k, shape, f32) * scale
    def gain(k, shape):
        return 1.0 + 0.05 * jax.random.normal(k, shape, f32)
    return {
        "x": nrm(ks[0], (BATCH, SEQ, D_MODEL), 1.0),
        "p": nrm(ks[1], (DEPTH, BATCH, SEQ, PLE_DIM), 1.0),
        "g_mix": gain(ks[2], (DEPTH, D_MODEL)),
        "w_in": nrm(ks[3], (DEPTH, D_MODEL, IN_PROJ_WIDTH), D_MODEL ** -0.5),
        "conv_w": nrm(ks[4], (DEPTH, CONV_K, CONV_WIDTH), CONV_K ** -0.5),
        "pool_w": nrm(ks[5], (DEPTH, len(POOL_WINDOWS), POOL_GROUP, POOL_GROUP), POOL_GROUP ** -0.5),
        "pool_scale": gain(ks[6], (DEPTH, POOL_WIDTH)),
        "w_o": nrm(ks[7], (DEPTH, D_MIX, D_MODEL), D_MIX ** -0.5),
        "g_ffn": gain(ks[8], (DEPTH, D_MODEL)),
        "w_q": nrm(ks[9], (DEPTH, D_MODEL, PEER_HEADS * PEER_QDIM), D_MODEL ** -0.5),
        "sub_keys": nrm(ks[10], (DEPTH, PEER_HEADS, 2, N_KEYS, PEER_HALF), PEER_HALF ** -0.5),
        "expert_u": nrm(ks[11], (DEPTH, N_EXPERTS, D_MODEL), D_MODEL ** -0.5),
        "expert_v": nrm(ks[12], (DEPTH, N_EXPERTS, D_MODEL), PEER_HEADS ** -0.5),
        "g_ple": gain(ks[13], (DEPTH, D_MODEL)),
        "w_ple_gate": nrm(ks[14], (DEPTH, D_MODEL, D_MODEL), D_MODEL ** -0.5),
        "w_ple_proj": nrm(ks[15], (DEPTH, PLE_DIM, D_MODEL), PLE_DIM ** -0.5),
        "g_final": gain(ks[16], (D_MODEL,)),
    }


def reference(x, p, g_mix, w_in, conv_w, pool_w, pool_scale, w_o, g_ffn, w_q, sub_keys,
              expert_u, expert_v, g_ple, w_ple_gate, w_ple_proj, g_final):
    h = x
    for i in range(DEPTH):
        xn = rms_norm(h, g_mix[i])
        proj = xn @ w_in[i]
        b_gate = proj[..., :CONV_WIDTH]
        c_gate = proj[..., CONV_WIDTH:2 * CONV_WIDTH]
        v_conv = proj[..., 2 * CONV_WIDTH:3 * CONV_WIDTH]
        u_pool = proj[..., 3 * CONV_WIDTH:]
        y_conv = short_conv_mixer(b_gate, c_gate, v_conv, conv_w[i])
        y_pool = pool_mixer(u_pool, pool_w[i], pool_scale[i])
        h = h + jnp.concatenate([y_conv, y_pool], axis=-1) @ w_o[i]
        h = h + peer_ffn(rms_norm(h, g_ffn[i]), w_q[i], sub_keys[i], expert_u[i], expert_v[i])
        gate = jax.nn.sigmoid(rms_norm(h, g_ple[i]) @ w_ple_gate[i])
        h = h + gate * (p[i] @ w_ple_proj[i])
    return rms_norm(h, g_final)
```

```cpp
#include <hip/hip_runtime.h>
#include <cstdio>
#include <cstdint>
namespace pg8 {
#define PG8_LAS __attribute__((address_space(3)))
typedef unsigned short bf16_t;
typedef short bf16x8 __attribute__((ext_vector_type(8)));
typedef float f32x4 __attribute__((ext_vector_type(4)));
typedef unsigned u32x4 __attribute__((ext_vector_type(4)));
constexpr int BM = 256, BK = 64, HALF = 128, HTB = HALF * BK * 2  , STAGE_BYTES = 8 * HTB, NXCD = 8, WGM = 8;

__host__ __device__ __forceinline__ int lds_byte(int r, int c) { const int st = (r >> 4) * 2 + (c >> 5), rr = r & 15, cc = c & 31, ob = rr * 64 + cc * 2; return st * 1024 + (ob ^ (((ob >> 9) & 1) << 5)); }
__host__ __device__ __forceinline__ void stage_rc(int b, int& R, int& C) { const int st = b / 1024, sb = b % 1024, swz = sb ^ (((sb >> 9) & 1) << 5); R = (st >> 1) * 16 + swz / 64; C = (st & 1) * 32 + (swz % 64) / 2; }
__host__ __device__ __forceinline__ int perm32(int rho) { const int n = rho >> 4, i = rho & 15; return 8 * (i >> 2) + 4 * n + (i & 3); }

struct Unit { int pm, pn; };
struct Gemm { const bf16_t* A; const bf16_t* Bt; int M, N, K; };

struct StaticOrder {
    int nM, nN, nwg, G, c;
    __host__ __device__ void init(int M, int N, int G_, int c_) { nM = M / BM; nN = N / BM; nwg = nM * nN; G = G_; c = c_; }
    __host__ __device__ bool next(int i, Unit& u) const {
        const long L = (long)i * G + c; if (L >= nwg) return false;
        int wgid = (int)L; { const int q = nwg / NXCD, r = nwg % NXCD, xcd = wgid % NXCD, off = wgid / NXCD; wgid = (xcd < r ? xcd * (q + 1) : r * (q + 1) + (xcd - r) * q) + off; }
        const int nig = WGM * nN, gid = wgid / nig, fm = gid * WGM, gsz = (nM - fm) < WGM ? (nM - fm) : WGM;
        u.pm = fm + ((wgid % nig) % gsz); u.pn = (wgid % nig) / gsz; return true;
    }
    __device__ __forceinline__ void a_ready(const Unit&) const {}
    __device__ __forceinline__ void done(const Unit&) const {}
};

__device__ __forceinline__ unsigned cvt_pk_bf16(float lo, float hi) { unsigned r; asm volatile("v_cvt_pk_bf16_f32 %0, %1, %2" : "=v"(r) : "v"(lo), "v"(hi)); return r; }
template <class Epi, class Sched, bool ALIGN_EPI = false, bool SP2 = false>
__device__ __forceinline__ void gemm_phase(PG8_LAS unsigned char* lds, const Gemm g, const Sched& S, const Epi& E) {
    const int tid = threadIdx.x, wid = __builtin_amdgcn_readfirstlane(tid >> 6), lane = tid & 63, wr = wid >> 2, wc = wid & 3, fr = lane & 15, fq = lane >> 4;
    const int K = g.K, nt = K / BK;
    unsigned voffA[2], voffB[2];
#pragma unroll
    for (int i = 0; i < 2; ++i) { int R, C; stage_rc(tid * 16 + i * 8192, R, C); const int Rb = Epi::PERM ? ((R & ~31) + perm32(R & 31)) : R;
        voffA[i] = (unsigned)(R * K + C) * 2u; voffB[i] = (unsigned)(Rb * K + C) * 2u; }
    const size_t kstep = (size_t)(BK * 2);
    const size_t hstep = (size_t)HALF * K * 2;
    const size_t tstep = 2 * hstep;
    const unsigned ldsw = (unsigned)wid * 1024u;
    const int aoff = lds_byte(wr * 64 + fr, fq * 8), boff = lds_byte(wc * 32 + fr, fq * 8);
#define PG8_SA(b, h) (((b) * 2 + (h)) * HTB)
#define PG8_SB(b, h) ((4 + (b) * 2 + (h)) * HTB)
#define PG8_STAGE(bufoff, gbase, voff) do { _Pragma("unroll") for (int _i = 0; _i < 2; ++_i) \
        __builtin_amdgcn_global_load_lds((const unsigned*)((const char*)(gbase) + (voff)[_i]), (PG8_LAS unsigned*)(lds + (bufoff) + ldsw + _i * 8192), 16, 0, 0); } while (0)
#define PG8_LDA(dst, b, h) do { _Pragma("unroll") for (int m = 0; m < 4; ++m) _Pragma("unroll") for (int k = 0; k < 2; ++k) dst[m][k] = *(const PG8_LAS bf16x8*)(lds + PG8_SA(b, h) + aoff + m * 2048 + k * 1024); } while (0)
#define PG8_LDB(dst, b, h) do { _Pragma("unroll") for (int n = 0; n < 2; ++n) _Pragma("unroll") for (int k = 0; k < 2; ++k) dst[n][k] = *(const PG8_LAS bf16x8*)(lds + PG8_SB(b, h) + boff + n * 2048 + k * 1024); } while (0)
#define PG8_MMA(ai, bj, At, Bt) do { __builtin_amdgcn_s_setprio(1); _Pragma("unroll") for (int m = 0; m < 4; ++m) _Pragma("unroll") for (int n = 0; n < 2; ++n) _Pragma("unroll") for (int k = 0; k < 2; ++k) \
        acc[ai][bj][m][n] = __builtin_amdgcn_mfma_f32_16x16x32_bf16(Bt[n][k], At[m][k], acc[ai][bj][m][n], 0, 0, 0); __builtin_amdgcn_s_setprio(0); } while (0)
#define PG8_WAIT_V(n) asm volatile("s_waitcnt vmcnt(" #n ")" ::: "memory")
#define PG8_WAIT_L(n) asm volatile("s_waitcnt lgkmcnt(" #n ")" ::: "memory")
#define PG8_BAR __builtin_amdgcn_s_barrier()
#define PG8_SCHED __builtin_amdgcn_sched_barrier(0)
    Unit cur, nxt; int ui = 0;
    if (!S.next(0, cur)) return;
    f32x4 acc[2][2][4][2];
#pragma unroll
    for (int a = 0; a < 2; ++a)
#pragma unroll
        for (int b = 0; b < 2; ++b)
#pragma unroll
            for (int m = 0; m < 4; ++m)
#pragma unroll
                for (int n = 0; n < 2; ++n) acc[a][b][m][n] = (f32x4){0.f, 0.f, 0.f, 0.f};
    bf16x8 At[4][2], B0[2][2], B1[2][2];
    const char* cA = (const char*)g.A + (size_t)cur.pm * tstep; const char* cB = (const char*)g.Bt + (size_t)cur.pn * tstep;
    S.a_ready(cur);
    if constexpr (SP2) {
        PG8_STAGE(PG8_SB(0, 0), cB, voffB); PG8_STAGE(PG8_SB(0, 1), cB + hstep, voffB); PG8_STAGE(PG8_SA(0, 0), cA, voffA); PG8_STAGE(PG8_SA(0, 1), cA + hstep, voffA);
        if (wr == 1) PG8_BAR;
        PG8_WAIT_V(2); PG8_BAR;
        PG8_STAGE(PG8_SB(1, 0), cB + kstep, voffB); PG8_STAGE(PG8_SA(1, 0), cA + kstep, voffA); PG8_STAGE(PG8_SB(1, 1), cB + hstep + kstep, voffB);
        PG8_WAIT_V(6); PG8_BAR;
    } else {
        PG8_STAGE(PG8_SB(0, 0), cB, voffB); PG8_STAGE(PG8_SA(0, 0), cA, voffA); PG8_STAGE(PG8_SB(0, 1), cB + hstep, voffB); PG8_STAGE(PG8_SA(0, 1), cA + hstep, voffA);
        if (wr == 1) PG8_BAR;
        PG8_WAIT_V(4); PG8_BAR;
        PG8_STAGE(PG8_SB(1, 0), cB + kstep, voffB); PG8_STAGE(PG8_SA(1, 0), cA + kstep, voffA); PG8_STAGE(PG8_SB(1, 1), cB + hstep + kstep, voffB);
        PG8_WAIT_V(6); PG8_BAR;
    }
    for (;;) {
        const bool has_next = S.next(ui + 1, nxt);
        const char* nA = has_next ? (const char*)g.A + (size_t)nxt.pm * tstep : cA; const char* nB = has_next ? (const char*)g.Bt + (size_t)nxt.pn * tstep : cB;
        for (int t = 0; t < nt; t += 2) {
            const bool last = (t == nt - 2);
            const char* a1 = cA + (size_t)(t + 1) * kstep;
            const char* a2 = last ? nA : cA + (size_t)(t + 2) * kstep; const char* b2 = last ? nB : cB + (size_t)(t + 2) * kstep;
            const char* a3 = a2 + kstep; const char* b3 = b2 + kstep;
            if (last && has_next) S.a_ready(nxt);
            if constexpr (SP2) {
            PG8_LDB(B0, 0, 0); PG8_LDB(B1, 0, 1); PG8_SCHED; PG8_LDA(At, 0, 0); PG8_STAGE(PG8_SA(1, 1), a1 + hstep, voffA);
            PG8_WAIT_V(8); PG8_WAIT_L(0); PG8_BAR; PG8_MMA(0, 0, At, B0); PG8_MMA(0, 1, At, B1); PG8_BAR; PG8_SCHED;
            PG8_LDA(At, 0, 1); PG8_STAGE(PG8_SB(0, 0), b2, voffB); PG8_STAGE(PG8_SB(0, 1), b2 + hstep, voffB); PG8_STAGE(PG8_SA(0, 0), a2, voffA);
            PG8_WAIT_V(8); PG8_WAIT_L(0); PG8_BAR; PG8_MMA(1, 0, At, B0); PG8_MMA(1, 1, At, B1); PG8_BAR; PG8_SCHED;
            PG8_LDB(B0, 1, 0); PG8_LDB(B1, 1, 1); PG8_SCHED; PG8_LDA(At, 1, 0); PG8_STAGE(PG8_SA(0, 1), a2 + hstep, voffA);
            PG8_WAIT_V(8); PG8_WAIT_L(0); PG8_BAR; PG8_MMA(0, 0, At, B0); PG8_MMA(0, 1, At, B1); PG8_BAR; PG8_SCHED;
            PG8_LDA(At, 1, 1); PG8_STAGE(PG8_SB(1, 0), b3, voffB); PG8_STAGE(PG8_SB(1, 1), b3 + hstep, voffB); PG8_STAGE(PG8_SA(1, 0), a3, voffA);
            PG8_WAIT_V(8); PG8_WAIT_L(0); PG8_BAR; PG8_MMA(1, 0, At, B0); PG8_MMA(1, 1, At, B1); PG8_BAR; PG8_SCHED;
            } else {
            PG8_LDB(B0, 0, 0); PG8_SCHED; PG8_LDA(At, 0, 0); PG8_STAGE(PG8_SA(1, 1), a1 + hstep, voffA);
            PG8_WAIT_L(8); PG8_BAR; PG8_WAIT_L(0); PG8_MMA(0, 0, At, B0); PG8_BAR; PG8_SCHED;
            PG8_LDB(B1, 0, 1); PG8_STAGE(PG8_SB(0, 0), b2, voffB);
            PG8_BAR; PG8_WAIT_L(0); PG8_MMA(0, 1, At, B1); PG8_BAR;
            PG8_LDA(At, 0, 1); PG8_STAGE(PG8_SA(0, 0), a2, voffA);
            PG8_BAR; PG8_WAIT_L(0); PG8_MMA(1, 0, At, B0); PG8_BAR; PG8_SCHED;
            PG8_STAGE(PG8_SB(0, 1), b2 + hstep, voffB);
            PG8_WAIT_V(6); PG8_BAR; PG8_MMA(1, 1, At, B1); PG8_BAR;
            PG8_LDB(B0, 1, 0); PG8_SCHED; PG8_LDA(At, 1, 0); PG8_STAGE(PG8_SA(0, 1), a2 + hstep, voffA);
            PG8_WAIT_L(8); PG8_BAR; PG8_WAIT_L(0); PG8_MMA(0, 0, At, B0); PG8_BAR; PG8_SCHED;
            PG8_LDB(B1, 1, 1); PG8_STAGE(PG8_SB(1, 0), b3, voffB);
            PG8_BAR; PG8_WAIT_L(0); PG8_MMA(0, 1, At, B1); PG8_BAR;
            PG8_LDA(At, 1, 1); PG8_STAGE(PG8_SA(1, 0), a3, voffA);
            PG8_BAR; PG8_WAIT_L(0); PG8_MMA(1, 0, At, B0); PG8_BAR; PG8_SCHED;
            PG8_STAGE(PG8_SB(1, 1), b3 + hstep, voffB);
            PG8_WAIT_V(6); PG8_BAR; PG8_MMA(1, 1, At, B1); PG8_BAR;
            }
        }
        if constexpr (ALIGN_EPI) { if (wr == 0) PG8_BAR; }
        if constexpr (!Epi::AFTER_DRAIN) { E(acc, cur, wr, wc, fr, fq); S.done(cur); }
        if (!has_next) break;
#pragma unroll
        for (int a = 0; a < 2; ++a)
#pragma unroll
            for (int b = 0; b < 2; ++b)
#pragma unroll
                for (int m = 0; m < 4; ++m)
#pragma unroll
                    for (int n = 0; n < 2; ++n) acc[a][b][m][n] = (f32x4){0.f, 0.f, 0.f, 0.f};
        cur = nxt; cA = nA; cB = nB; ++ui;
        if constexpr (ALIGN_EPI) { if (wr == 1) PG8_BAR; }
    }
    PG8_WAIT_V(0);
    if constexpr (!ALIGN_EPI) { if (wr == 0) PG8_BAR; }
    PG8_BAR;
    if constexpr (Epi::AFTER_DRAIN) { E.fused(acc, cur, wr, wc, fr, fq, lds, wid, lane); S.done(cur); }
#undef PG8_SA
#undef PG8_SB
#undef PG8_STAGE
#undef PG8_LDA
#undef PG8_LDB
#undef PG8_MMA
#undef PG8_WAIT_V
#undef PG8_WAIT_L
#undef PG8_BAR
#undef PG8_SCHED
}
}

#define GAS __attribute__((address_space(1)))
#define LAS __attribute__((address_space(3)))
typedef unsigned short bf16;
typedef unsigned v4u __attribute__((ext_vector_type(4)));
typedef float f32x4 __attribute__((ext_vector_type(4)));
typedef short bf16x8 __attribute__((ext_vector_type(8)));
typedef GAS unsigned gu32;
typedef GAS unsigned long long gu64;
#define RLX_AGENT __ATOMIC_RELAXED, __HIP_MEMORY_SCOPE_AGENT
#define LDS_WAIT() asm volatile("s_waitcnt lgkmcnt(0)" ::: "memory")
#define VM_WAIT() asm volatile("s_waitcnt vmcnt(0)" ::: "memory")
__device__ __forceinline__ unsigned long long rt() { return __builtin_amdgcn_s_memrealtime(); }
__device__ __forceinline__ unsigned f2bf(float f) { unsigned u = __builtin_bit_cast(unsigned, f); return (u + 0x7fffu + ((u >> 16) & 1u)) >> 16; }
__device__ __forceinline__ unsigned pk2(float lo, float hi) { return f2bf(lo) | (f2bf(hi) << 16); }

#define XB_TMO      128
#define XB_XCNT(j)  (256  + 64 * (j))
#define XB_XSUB(j)  (1280 + 64 * (j))
#define XB_XGEN(j)  (2304 + 64 * (j))
#define XB_TOP      3328
#define XB_TOPGEN   3392
#define XCD_BAR_WORDS 3456
#define XB_SPIN_CAP (1u << 18)

__device__ __forceinline__ unsigned xb_ld(unsigned* p)              { return __hip_atomic_load(p, __ATOMIC_RELAXED, __HIP_MEMORY_SCOPE_AGENT); }
__device__ __forceinline__ unsigned xb_add(unsigned* p, unsigned v) { return __hip_atomic_fetch_add(p, v, __ATOMIC_RELAXED, __HIP_MEMORY_SCOPE_AGENT); }
__device__ __forceinline__ unsigned xb_xcc_id() { return (unsigned)__builtin_amdgcn_s_getreg((3 << 11) | 20) & 0xFu; }
#define XB_SPIN(cond, bar) do { unsigned _sp = 0; while (cond) { __builtin_amdgcn_s_sleep(1); \
    if ((++_sp & 255u) == 0u) { if (xb_ld(&(bar)[XB_TMO])) break; if (_sp > XB_SPIN_CAP) { atomicAdd(&(bar)[XB_TMO], 1u); break; } } } } while (0)

struct XcdBarrier {
    unsigned* bar; unsigned x;
    volatile LAS unsigned* st;
};

__device__ __forceinline__ XcdBarrier xcd_barrier_post(unsigned* bar, volatile LAS unsigned* st) {
    XcdBarrier b; b.bar = bar; b.x = xb_xcc_id(); b.st = st;
    if (threadIdx.x == 0) (void)xb_add(&bar[XB_XCNT(b.x)], 1u);
    return b;
}
__device__ __forceinline__ void xcd_barrier_complete(unsigned* bar, unsigned x, unsigned& nloc, unsigned& nx) {
    const unsigned G = gridDim.x * gridDim.y * gridDim.z;
    unsigned sum, cnt, mine, sp = 0u;
    for (;;) {
        sum = 0u; cnt = 0u; mine = 0u;
#pragma unroll
        for (unsigned j = 0; j < 16; ++j) { const unsigned c = xb_ld(&bar[XB_XCNT(j)]); sum += c; cnt += (c > 0u) ? 1u : 0u; mine = (j == x) ? c : mine; }
        if (sum == G) break;
        __builtin_amdgcn_s_sleep(1);
        if ((++sp & 255u) == 0u) { if (xb_ld(&bar[XB_TMO])) break; if (sp > XB_SPIN_CAP) { atomicAdd(&bar[XB_TMO], 1u); break; } }
    }
    nloc = mine > 0u ? mine : 1u; nx = cnt > 0u ? cnt : 1u;
}

__device__ __forceinline__ void xcd_barrier(const XcdBarrier& b) {
    asm volatile("s_waitcnt vmcnt(0)" ::: "memory");
    __syncthreads();
    if (threadIdx.x == 0) {
        unsigned* bar = b.bar;
        __builtin_amdgcn_s_waitcnt(0);
        unsigned nloc = b.st[0], nx = b.st[1];
        if (nloc == 0u) { xcd_barrier_complete(bar, b.x, nloc, nx); b.st[0] = nloc; b.st[1] = nx; }
        const unsigned old = xb_add(&bar[XB_XSUB(b.x)], 1u);
        const unsigned gen = old / nloc;
        if (old + 1u == (gen + 1u) * nloc) {
            __builtin_amdgcn_fence(__ATOMIC_RELEASE, "agent");
            asm volatile("s_waitcnt vmcnt(0)" ::: "memory");
            const unsigned og = xb_add(&bar[XB_TOP], 1u);
            const unsigned tg = og / nx;
            if (og + 1u == (tg + 1u) * nx) xb_add(&bar[XB_TOPGEN], 1u);
            else XB_SPIN(xb_ld(&bar[XB_TOPGEN]) == tg, bar);
            __builtin_amdgcn_fence(__ATOMIC_ACQUIRE, "agent");
            xb_add(&bar[XB_XGEN(b.x)], 1u);
            asm volatile("s_waitcnt vmcnt(0)" ::: "memory");
        } else {
            XB_SPIN(xb_ld(&bar[XB_XGEN(b.x)]) == gen, bar);
            __builtin_amdgcn_fence(__ATOMIC_ACQUIRE, "agent");
            asm volatile("s_waitcnt vmcnt(0)" ::: "memory");
        }
    }
    __syncthreads();
}

constexpr int NWAVES = 8;
constexpr int M = 32768, D = 1024, SEQ = 4096, NPROJ = 2048, NQ = 2048, PLED = 256, NEXP = 16384;
constexpr float EPS = 1e-6f;
#ifndef MK_PER_PHASE
#define MK_PER_PHASE 0
#endif
constexpr int NPHASES = 10;

constexpr size_t MiB = 1u << 20;
constexpr size_t WS_CTL = 0, CTL_ZERO_BYTES = 1 * MiB;
constexpr size_t WS_WIN = 2 * MiB, WS_WO = 6 * MiB, WS_WQ = 8 * MiB, WS_WG = 12 * MiB, WS_WP = 14 * MiB, WS_KEYS = 14 * MiB + 512 * 1024;
constexpr size_t WS_WF = 15 * MiB;
constexpr size_t WS_RSX = 17 * MiB, WS_RS2 = 17 * MiB + 512 * 1024, WS_RS1 = 18 * MiB, WS_RS3 = 20 * MiB;
constexpr size_t WS_U = 24 * MiB, WS_V = 56 * MiB;
constexpr size_t WS_XB = 88 * MiB;
constexpr size_t WS_PROJ = 152 * MiB;
constexpr size_t WS_MIX = 280 * MiB;
constexpr size_t WS_HB = 344 * MiB;
constexpr size_t WS_EIDX = 408 * MiB, WS_GATE = 424 * MiB;
constexpr size_t WS_PB = 440 * MiB;
constexpr size_t WS_END = 456 * MiB;
constexpr int CW_BAR = 4096;
static_assert((CW_BAR + XCD_BAR_WORDS) * 4 <= (int)CTL_ZERO_BYTES, "CTL words inside the memset region");

constexpr int RING_BYTES = 131072;
constexpr int LDSCTL_OFF = RING_BYTES, MISC_OFF = LDSCTL_OFF + 320;
constexpr int LDS_BYTES = 147456;

typedef float f32x16 __attribute__((ext_vector_type(16)));
typedef _Float16 h2_t __attribute__((ext_vector_type(2)));
typedef float f32x2 __attribute__((ext_vector_type(2)));
typedef int i32x4 __attribute__((ext_vector_type(4)));

__device__ __forceinline__ float wave_sum(float v) {
#pragma unroll
    for (int o = 1; o < 64; o <<= 1) v += __shfl_xor(v, o);
    return v;
}
__device__ __forceinline__ float bf_lo(unsigned w) { return __uint_as_float(w << 16); }
__device__ __forceinline__ float bf_hi(unsigned w) { return __uint_as_float(w & 0xffff0000u); }
__device__ __forceinline__ unsigned pkh(float lo, float hi) { f32x2 v = {lo, hi}; h2_t h = __builtin_convertvector(v, h2_t); return __builtin_bit_cast(unsigned, h); }

struct EpiBf16Row {
    static constexpr bool PERM = true, AFTER_DRAIN = false;
    pg8::bf16_t* O; int ldc; const float* rowss;
    __device__ __forceinline__ void operator()(const pg8::f32x4 (&acc)[2][2][4][2], const pg8::Unit& u, int wr, int wc, int fr, int fq) const {
        const int row0 = u.pm * 256 + wr * 64 + fr, col0 = u.pn * 256 + wc * 32 + 8 * fq;
#pragma unroll
        for (int ai = 0; ai < 2; ++ai)
#pragma unroll
            for (int m = 0; m < 4; ++m) {
                const int row = row0 + ai * 128 + m * 16;
                const float sc = rowss ? __builtin_amdgcn_rsqf(rowss[row] * (1.0f / 1024.0f) + EPS) : 1.0f;
                pg8::bf16_t* rowp = O + (size_t)row * ldc + col0;
#pragma unroll
                for (int bj = 0; bj < 2; ++bj) {
                    const pg8::f32x4 v0 = acc[ai][bj][m][0] * sc, v1 = acc[ai][bj][m][1] * sc;
                    pg8::u32x4 w; w.x = pg8::cvt_pk_bf16(v0[0], v0[1]); w.y = pg8::cvt_pk_bf16(v0[2], v0[3]); w.z = pg8::cvt_pk_bf16(v1[0], v1[1]); w.w = pg8::cvt_pk_bf16(v1[2], v1[3]);
                    *(pg8::u32x4*)(rowp + bj * 128) = w;
                }
            }
    }
};
struct EpiH1 {
    static constexpr bool PERM = true, AFTER_DRAIN = false;
    const float* X; float* H; pg8::bf16_t* HB; float* RS;
    __device__ __forceinline__ void operator()(const pg8::f32x4 (&acc)[2][2][4][2], const pg8::Unit& u, int wr, int wc, int fr, int fq) const {
        const int row0 = u.pm * 256 + wr * 64 + fr, col0 = u.pn * 256 + wc * 32 + 8 * fq;
#pragma unroll
        for (int ai = 0; ai < 2; ++ai)
#pragma unroll
            for (int m = 0; m < 4; ++m) {
                const int row = row0 + ai * 128 + m * 16; float s = 0.f;
#pragma unroll
                for (int bj = 0; bj < 2; ++bj) {
                    const size_t off = (size_t)row * 1024 + col0 + bj * 128;
                    const pg8::f32x4 x0 = *(const pg8::f32x4*)(X + off), x1 = *(const pg8::f32x4*)(X + off + 4);
                    const pg8::f32x4 v0 = acc[ai][bj][m][0] + x0, v1 = acc[ai][bj][m][1] + x1;
                    *(pg8::f32x4*)(H + off) = v0; *(pg8::f32x4*)(H + off + 4) = v1;
                    pg8::u32x4 w; w.x = pg8::cvt_pk_bf16(v0[0], v0[1]); w.y = pg8::cvt_pk_bf16(v0[2], v0[3]); w.z = pg8::cvt_pk_bf16(v1[0], v1[1]); w.w = pg8::cvt_pk_bf16(v1[2], v1[3]);
                    *(pg8::u32x4*)(HB + off) = w;
                    s += (v0[0] * v0[0] + v0[1] * v0[1]) + (v0[2] * v0[2] + v0[3] * v0[3]) + (v1[0] * v1[0] + v1[1] * v1[1]) + (v1[2] * v1[2] + v1[3] * v1[3]);
                }
                s += __shfl_xor(s, 16); s += __shfl_xor(s, 32);
                if (fq == 0) RS[(size_t)row * 16 + u.pn * 4 + wc] = s;
            }
    }
};
struct EpiGate {
    static constexpr bool PERM = true, AFTER_DRAIN = false;
    float* H; const pg8::bf16_t* PL; const float* RS2; float* RS3;
    __device__ __forceinline__ void operator()(const pg8::f32x4 (&acc)[2][2][4][2], const pg8::Unit& u, int wr, int wc, int fr, int fq) const {
        const int row0 = u.pm * 256 + wr * 64 + fr, col0 = u.pn * 256 + wc * 32 + 8 * fq;
#pragma unroll
        for (int ai = 0; ai < 2; ++ai)
#pragma unroll
            for (int m = 0; m < 4; ++m) {
                const int row = row0 + ai * 128 + m * 16; float s = 0.f;
                const float rstd = __builtin_amdgcn_rsqf(RS2[row] * (1.0f / 1024.0f) + EPS);
#pragma unroll
                for (int bj = 0; bj < 2; ++bj) {
                    const size_t off = (size_t)row * 1024 + col0 + bj * 128;
                    const pg8::u32x4 w = *(const pg8::u32x4*)(PL + off);
                    const pg8::f32x4 h0 = *(const pg8::f32x4*)(H + off), h1 = *(const pg8::f32x4*)(H + off + 4);
                    const pg8::f32x4 a0 = acc[ai][bj][m][0] * rstd, a1 = acc[ai][bj][m][1] * rstd;
                    pg8::f32x4 g0, g1;
#pragma unroll
                    for (int e = 0; e < 4; ++e) { g0[e] = 1.0f / (1.0f + __expf(-a0[e])); g1[e] = 1.0f / (1.0f + __expf(-a1[e])); }
                    const pg8::f32x4 p0 = {bf_lo(w.x), bf_hi(w.x), bf_lo(w.y), bf_hi(w.y)}, p1 = {bf_lo(w.z), bf_hi(w.z), bf_lo(w.w), bf_hi(w.w)};
#ifdef DBG_NO_PLE
                    const pg8::f32x4 v0 = h0, v1 = h1;
#else
                    const pg8::f32x4 v0 = h0 + g0 * p0, v1 = h1 + g1 * p1;
#endif
                    *(pg8::f32x4*)(H + off) = v0; *(pg8::f32x4*)(H + off + 4) = v1;
                    s += (v0[0] * v0[0] + v0[1] * v0[1]) + (v0[2] * v0[2] + v0[3] * v0[3]) + (v1[0] * v1[0] + v1[1] * v1[1]) + (v1[2] * v1[2] + v1[3] * v1[3]);
                }
                s += __shfl_xor(s, 16); s += __shfl_xor(s, 32);
                if (fq == 0) RS3[(size_t)row * 16 + u.pn * 4 + wc] = s;
            }
    }
};

__device__ __forceinline__ void p0_transpose_item(const float* W, int ldn, const float* gk, int K, bf16* WT, int row_off, int nblk, LAS float* scr, int item, int lane) {
    const int kb = item / nblk, nb = item % nblk, k0 = 64 * kb, n0 = 32 * nb;
#pragma unroll 8
    for (int i = 0; i < 32; ++i) { const int kk = 2 * i + (lane >> 5); float v = W[(size_t)(k0 + kk) * ldn + n0 + (lane & 31)]; if (gk) v *= gk[k0 + kk]; scr[kk * 33 + (lane & 31)] = v; }
    LDS_WAIT(); asm volatile("" ::: "memory");
    const int c = lane & 7;
#pragma unroll
    for (int j = 0; j < 4; ++j) { const int n = (lane >> 3) + 8 * j; const LAS float* s = scr + (8 * c) * 33 + n;
        v4u o; o.x = pk2(s[0 * 33], s[1 * 33]); o.y = pk2(s[2 * 33], s[3 * 33]); o.z = pk2(s[4 * 33], s[5 * 33]); o.w = pk2(s[6 * 33], s[7 * 33]);
        *(GAS v4u*)(WT + (size_t)(row_off + n0 + n) * K + k0 + 8 * c) = o; }
    LDS_WAIT(); asm volatile("" ::: "memory");
}

struct Ptrs {
    const float *x, *p, *g_mix, *w_in, *conv_w, *pool_w, *pool_scale, *w_o, *g_ffn, *w_q, *sub_keys, *eu, *ev, *g_ple, *w_gate, *w_proj, *g_final;
    float* out; unsigned char* ws;
};

__device__ __forceinline__ void p0a_phase(const Ptrs& P, LAS unsigned char* lds, int vcu, int G, int tid, int wave, int lane) {
    const int gw = vcu * NWAVES + wave, NGW = G * NWAVES;
    const int gt = vcu * (NWAVES * 64) + tid, NGT = G * NWAVES * 64;
    { float* Wf = (float*)(P.ws + WS_WF);
      for (int tk = gw; tk < 8192; tk += NGW) {
          const int k = tk >> 3, j = tk & 7, g = j >> 1, np = j * 64 + lane, d = np & 127;
          const float* wi = P.w_in + (size_t)k * 2048 + 1536 + g * 128; const float* pw = P.pool_w + (size_t)g * 128 * 128 + d;
          float a = 0.f;
#pragma unroll 8
          for (int c = 0; c < 128; ++c) a += wi[c] * pw[(size_t)c * 128];
          Wf[(size_t)k * 512 + np] = a * P.pool_scale[np];
      } }
    { LAS float* scr = (LAS float*)(lds + wave * 16384);
      constexpr int I_WO = 16 * 32, I_WQ = 16 * 64, I_WG = 16 * 32, I_WP = 4 * 32, I_WINA = 16 * 48;
      constexpr int NITEMS = I_WO + I_WQ + I_WG + I_WP + I_WINA;
      for (int it = gw; it < NITEMS; it += NGW) {
          int r = it;
          if (r < I_WO) { p0_transpose_item(P.w_o, 1024, nullptr, 1024, (bf16*)(P.ws + WS_WO), 0, 32, scr, r, lane); continue; } r -= I_WO;
          if (r < I_WQ) { p0_transpose_item(P.w_q, 2048, P.g_ffn, 1024, (bf16*)(P.ws + WS_WQ), 0, 64, scr, r, lane); continue; } r -= I_WQ;
          if (r < I_WG) { p0_transpose_item(P.w_gate, 1024, P.g_ple, 1024, (bf16*)(P.ws + WS_WG), 0, 32, scr, r, lane); continue; } r -= I_WG;
          if (r < I_WP) { p0_transpose_item(P.w_proj, 1024, nullptr, 256, (bf16*)(P.ws + WS_WP), 0, 32, scr, r, lane); continue; } r -= I_WP;
          p0_transpose_item(P.w_in, 2048, P.g_mix, 1024, (bf16*)(P.ws + WS_WIN), 0, 48, scr, r, lane);
      } }
    { const GAS f32x4* su = (const GAS f32x4*)P.eu; const GAS f32x4* sv = (const GAS f32x4*)P.ev; const GAS f32x4* gf = (const GAS f32x4*)P.g_ffn;
      GAS v4u* du = (GAS v4u*)(P.ws + WS_U); GAS v4u* dv = (GAS v4u*)(P.ws + WS_V);
      for (int i = gt; i < NEXP * 1024 / 8; i += NGT) {
          const int kq = (i & 127) * 2;
          const f32x4 a = su[2 * (size_t)i], b = su[2 * (size_t)i + 1], ga = gf[kq], gb = gf[kq + 1];
          v4u o; o.x = pkh(a.x * ga.x, a.y * ga.y); o.y = pkh(a.z * ga.z, a.w * ga.w); o.z = pkh(b.x * gb.x, b.y * gb.y); o.w = pkh(b.z * gb.z, b.w * gb.w);
          du[i] = o;
          const f32x4 c = sv[2 * (size_t)i], d = sv[2 * (size_t)i + 1];
          v4u q; q.x = pkh(c.x, c.y); q.y = pkh(c.z, c.w); q.z = pkh(d.x, d.y); q.w = pkh(d.z, d.w);
          dv[i] = q;
      } }
    { const GAS f32x4* sp = (const GAS f32x4*)P.p; GAS v4u* dp = (GAS v4u*)(P.ws + WS_PB);
      for (int i = gt; i < M * PLED / 8; i += NGT) { const f32x4 a = sp[2 * (size_t)i], b = sp[2 * (size_t)i + 1]; v4u o; o.x = pk2(a.x, a.y); o.y = pk2(a.z, a.w); o.z = pk2(b.x, b.y); o.w = pk2(b.z, b.w); dp[i] = o; }
      const GAS f32x4* sk = (const GAS f32x4*)P.sub_keys; GAS v4u* dk = (GAS v4u*)(P.ws + WS_KEYS);
      for (int i = gt; i < 16 * 128 * 128 / 8; i += NGT) { const f32x4 a = sk[2 * (size_t)i], b = sk[2 * (size_t)i + 1]; v4u o; o.x = pk2(a.x, a.y); o.y = pk2(a.z, a.w); o.z = pk2(b.x, b.y); o.w = pk2(b.z, b.w); dk[i] = o; } }
    { float* RSX = (float*)(P.ws + WS_RSX); bf16* XB = (bf16*)(P.ws + WS_XB);
      for (int m = gw; m < M; m += NGW) {
          const GAS f32x4* xr = (const GAS f32x4*)(P.x + (size_t)m * D) + lane; f32x4 v[4]; float s = 0.f;
#pragma unroll
          for (int j = 0; j < 4; ++j) { v[j] = xr[64 * j]; s += (v[j].x * v[j].x + v[j].y * v[j].y) + (v[j].z * v[j].z + v[j].w * v[j].w); }
          s = wave_sum(s); if (lane == 0) RSX[m] = s;
          GAS unsigned long long* o8 = (GAS unsigned long long*)(XB + (size_t)m * D) + lane;
#pragma unroll
          for (int j = 0; j < 4; ++j) o8[64 * j] = (unsigned long long)pk2(v[j].x, v[j].y) | ((unsigned long long)pk2(v[j].z, v[j].w) << 32);
      } }
}
__device__ __forceinline__ void p0b_phase(const Ptrs& P, LAS unsigned char* lds, int vcu, int G, int wave, int lane) {
    const int gw = vcu * NWAVES + wave, NGW = G * NWAVES; LAS float* scr = (LAS float*)(lds + wave * 16384);
    for (int it = gw; it < 16 * 16; it += NGW) p0_transpose_item((const float*)(P.ws + WS_WF), 512, P.g_mix, 1024, (bf16*)(P.ws + WS_WIN), 1536, 16, scr, it, lane);
}

__device__ __forceinline__ void p2_phase(const Ptrs& P, int vcu, int G, int tid) {
    const unsigned* PR = (const unsigned*)(P.ws + WS_PROJ);
    unsigned* MX = (unsigned*)(P.ws + WS_MIX);
    constexpr int TC = 32;
    for (int ck = vcu; ck < M / TC; ck += G) {
        const int t0 = ck * TC, s0 = t0 & (SEQ - 1);
        if (tid < 256) {
            const int half = 1 << (tid >> 6);
            const unsigned* col = PR + 768 + tid;
            float S0 = 0.f, S1 = 0.f;
            { const int lo = (s0 - half) > 0 ? (s0 - half) : 0, hi = (s0 + half) < SEQ ? (s0 + half) : SEQ;
              for (int s = lo; s < hi; ++s) { const unsigned w = col[(size_t)(t0 + s - s0) * 1024]; S0 += bf_lo(w); S1 += bf_hi(w); } }
#pragma unroll 4
            for (int i = 0; i < TC; ++i) {
                const int s = s0 + i, t = t0 + i;
                const int lo = (s - half) > 0 ? (s - half) : 0, hi = (s + half) < SEQ ? (s + half) : SEQ;
                const float inv = 1.0f / (float)(hi - lo);
                const unsigned wc = col[(size_t)t * 1024];
                const float o0 = S0 * inv - bf_lo(wc), o1 = S1 * inv - bf_hi(wc);
                MX[(size_t)t * 512 + 256 + tid] = pk2(o0, o1);
                if (s + half < SEQ) { const unsigned w = col[(size_t)(t + half) * 1024]; S0 += bf_lo(w); S1 += bf_hi(w); }
                if (s - half >= 0) { const unsigned w = col[(size_t)(t - half) * 1024]; S0 -= bf_lo(w); S1 -= bf_hi(w); }
            }
        } else {
            const int cp = tid - 256;
            const unsigned* bcol = PR + cp; const unsigned* ccol = PR + 256 + cp; const unsigned* vcol = PR + 512 + cp;
            const float w00 = P.conv_w[2 * cp], w01 = P.conv_w[2 * cp + 1], w10 = P.conv_w[512 + 2 * cp], w11 = P.conv_w[512 + 2 * cp + 1], w20 = P.conv_w[1024 + 2 * cp], w21 = P.conv_w[1024 + 2 * cp + 1];
            float zp0 = 0.f, zp1 = 0.f, zc0, zc1;
            if (s0 > 0) { const unsigned c = ccol[(size_t)(t0 - 1) * 1024], v = vcol[(size_t)(t0 - 1) * 1024]; zp0 = bf_lo(c) * bf_lo(v); zp1 = bf_hi(c) * bf_hi(v); }
            { const unsigned c = ccol[(size_t)t0 * 1024], v = vcol[(size_t)t0 * 1024]; zc0 = bf_lo(c) * bf_lo(v); zc1 = bf_hi(c) * bf_hi(v); }
#pragma unroll 4
            for (int i = 0; i < TC; ++i) {
                const int s = s0 + i, t = t0 + i;
                float zn0 = 0.f, zn1 = 0.f;
                if (s + 1 < SEQ) { const unsigned c = ccol[(size_t)(t + 1) * 1024], v = vcol[(size_t)(t + 1) * 1024]; zn0 = bf_lo(c) * bf_lo(v); zn1 = bf_hi(c) * bf_hi(v); }
                const unsigned b = bcol[(size_t)t * 1024];
                const float y0 = w00 * zp0 + w10 * zc0 + w20 * zn0, y1 = w01 * zp1 + w11 * zc1 + w21 * zn1;
                MX[(size_t)t * 512 + cp] = pk2(bf_lo(b) * y0, bf_hi(b) * y1);
                zp0 = zc0; zp1 = zc1; zc0 = zn0; zc1 = zn1;
            }
        }
    }
}

__device__ __forceinline__ float fmax_s(float a, float b) { float r; asm("v_max_f32_e32 %0, %1, %2" : "=v"(r) : "v"(a), "v"(b)); return r; }
__device__ __forceinline__ float fmin_s(float a, float b) { float r; asm("v_min_f32_e32 %0, %1, %2" : "=v"(r) : "v"(a), "v"(b)); return r; }
#define CE_DESC(a, b) do { const float _t = fmax_s(a, b); b = fmin_s(a, b); a = _t; } while (0)
#define CE_ASC(a, b)  do { const float _t = fmin_s(a, b); b = fmax_s(a, b); a = _t; } while (0)
__device__ __forceinline__ void sort16_desc(float* a) {
#pragma unroll
    for (int k = 2; k <= 16; k <<= 1)
#pragma unroll
        for (int j = k >> 1; j > 0; j >>= 1)
#pragma unroll
            for (int i = 0; i < 16; ++i) { const int l = i ^ j; if (l > i) { if ((i & k) == 0) CE_DESC(a[i], a[l]); else CE_ASC(a[i], a[l]); } }
}
__device__ __forceinline__ void merge16_desc(float* a) {
#pragma unroll
    for (int j = 8; j > 0; j >>= 1)
#pragma unroll
        for (int i = 0; i < 16; ++i) { const int l = i ^ j; if (l > i) CE_DESC(a[i], a[l]); }
}
__device__ __forceinline__ void top16_merge(float* a, const float* b) {
#pragma unroll
    for (int i = 0; i < 16; ++i) a[i] = fmax_s(a[i], b[15 - i]);
    merge16_desc(a);
}
__device__ __forceinline__ void top16_of_64(float* v) {
    sort16_desc(v); sort16_desc(v + 16); sort16_desc(v + 32); sort16_desc(v + 48);
    top16_merge(v, v + 16); top16_merge(v + 32, v + 48); top16_merge(v, v + 32);
}
__device__ __forceinline__ unsigned key_lookup(unsigned long long lo, unsigned long long hi, unsigned i) {
    const unsigned long long v = (i & 8u) ? hi : lo;
    return (unsigned)(v >> ((i & 7u) * 8u)) & 0x7fu;
}

constexpr int KROW = 272;
__device__ __forceinline__ void score_phase(const Ptrs& P, LAS unsigned char* lds, int bid, int G, int tid, int wave, int lane) {
    const bf16* Q = (const bf16*)(P.ws + WS_PROJ); const bf16* KEYS = (const bf16*)(P.ws + WS_KEYS); const float* RS1 = (const float*)(P.ws + WS_RS1);
    int* EIDX = (int*)(P.ws + WS_EIDX); float* GATE = (float*)(P.ws + WS_GATE);
    const int l31 = lane & 31, hi = lane >> 5;
    int cur_h = -1;
    for (int u = bid; u < (M / 256) * 8; u += G) {
        const int h = u & 7, tile = u >> 3;
        if (h != cur_h) {
            __syncthreads();
#pragma unroll
            for (int i = 0; i < 8; ++i) { const int q = tid + 512 * i, row = q >> 4, ch = q & 15;
                const v4u val = *(const GAS v4u*)(KEYS + ((size_t)(h * 256 + row)) * 128 + ch * 8);
                *(LAS v4u*)(lds + row * KROW + ch * 16) = val; }
            __syncthreads();
            cur_h = h;
        }
        const int tok = tile * 256 + wave * 32 + l31;
        float T0[16], T1[16];
#pragma unroll
        for (int p = 0; p < 2; ++p) {
            f32x16 acc[4];
#pragma unroll
            for (int kb = 0; kb < 4; ++kb)
#pragma unroll
                for (int r = 0; r < 16; ++r) acc[kb][r] = 0.f;
            const bf16* qp = Q + (size_t)tok * 2048 + h * 256 + p * 128 + hi * 8;
            bf16x8 bq[8];
#pragma unroll
            for (int ks = 0; ks < 8; ++ks) bq[ks] = *(const GAS bf16x8*)(qp + ks * 16);
#pragma unroll
            for (int ks = 0; ks < 8; ++ks)
#pragma unroll
                for (int kb = 0; kb < 4; ++kb) {
                    const bf16x8 ak = *(const LAS bf16x8*)(lds + (p * 128 + kb * 32 + l31) * KROW + (ks * 16 + hi * 8) * 2);
                    acc[kb] = __builtin_amdgcn_mfma_f32_32x32x16_bf16(ak, bq[ks], acc[kb], 0, 0, 0);
                }
            float v[64];
#pragma unroll
            for (int kb = 0; kb < 4; ++kb)
#pragma unroll
                for (int r = 0; r < 16; ++r) v[kb * 16 + r] = __uint_as_float((__float_as_uint(acc[kb][r]) & 0xffffff80u) | (unsigned)(kb * 32 + (r & 3) + 8 * (r >> 2)));
            top16_of_64(v);
            const unsigned hb = (unsigned)hi << 2;
#pragma unroll
            for (int i = 0; i < 16; ++i) v[i] = __uint_as_float(__float_as_uint(v[i]) | hb);
            float c[16];
#pragma unroll
            for (int i = 0; i < 16; ++i) c[i] = fmax_s(v[i], __shfl_xor(v[15 - i], 32));
            merge16_desc(c);
#pragma unroll
            for (int i = 0; i < 16; ++i) { if (p == 0) T0[i] = c[i]; else T1[i] = c[i]; }
        }
        float f0[16], f1[16];
        unsigned long long K0lo = 0ull, K0hi = 0ull, K1lo = 0ull, K1hi = 0ull;
#pragma unroll
        for (int b = 0; b < 8; ++b) {
            K0lo |= (unsigned long long)(__float_as_uint(T0[b]) & 0x7fu) << (8 * b); K0hi |= (unsigned long long)(__float_as_uint(T0[8 + b]) & 0x7fu) << (8 * b);
            K1lo |= (unsigned long long)(__float_as_uint(T1[b]) & 0x7fu) << (8 * b); K1hi |= (unsigned long long)(__float_as_uint(T1[8 + b]) & 0x7fu) << (8 * b);
        }
#pragma unroll
        for (int i = 0; i < 16; ++i) { f0[i] = __uint_as_float(__float_as_uint(T0[i]) & 0xffffff80u); f1[i] = __uint_as_float(__float_as_uint(T1[i]) & 0xffffff80u); }
        float cd[64]; int n = 0;
#pragma unroll
        for (int i = 0; i < 16; ++i)
#pragma unroll
            for (int j = 0; j < 16; ++j)
                if ((i + 1) * (j + 1) <= 16) { cd[n] = __uint_as_float((__float_as_uint(f0[i] + f1[j]) & 0xffffff00u) | (unsigned)(i * 16 + j)); ++n; }
#pragma unroll
        for (int q = 50; q < 64; ++q) cd[q] = __uint_as_float(0xff800000u);
        top16_of_64(cd);
        float rs = 0.f;
        { const GAS f32x4* rp = (const GAS f32x4*)(RS1 + (size_t)tok * 16);
#pragma unroll
          for (int i = 0; i < 4; ++i) { const f32x4 a = rp[i]; rs += (a.x + a.y) + (a.z + a.w); } }
        const float rstd = __builtin_amdgcn_rsqf(rs * (1.0f / 1024.0f) + EPS);
        int eidx[16]; float gt_[16]; float z0 = 0.f, sum = 0.f;
#pragma unroll
        for (int k = 0; k < 16; ++k) {
            const unsigned wb = __float_as_uint(cd[k]); const unsigned i = (wb >> 4) & 15u, j = wb & 15u;
            eidx[k] = (int)(key_lookup(K0lo, K0hi, i) * 128u + key_lookup(K1lo, K1hi, j));
            const float z = __uint_as_float(wb & 0xffffff00u) * rstd;
            if (k == 0) z0 = z;
            gt_[k] = __expf(z - z0); sum += gt_[k];
        }
        const float inv = 1.0f / sum;
        if (hi == 0) { GAS i32x4* ep = (GAS i32x4*)(EIDX + (size_t)tok * 128 + h * 16);
#pragma unroll
            for (int q = 0; q < 4; ++q) ep[q] = (i32x4){eidx[4 * q], eidx[4 * q + 1], eidx[4 * q + 2], eidx[4 * q + 3]};
        } else { GAS f32x4* gp = (GAS f32x4*)(GATE + (size_t)tok * 128 + h * 16);
#pragma unroll
            for (int q = 0; q < 4; ++q) gp[q] = (f32x4){gt_[4 * q] * inv, gt_[4 * q + 1] * inv, gt_[4 * q + 2] * inv, gt_[4 * q + 3] * inv};
        }
    }
}

__device__ __forceinline__ float gelu_tanh(float x) {
    const float y = 1.5957691216057308f * (x + 0.044715f * x * x * x);
    return x / (1.0f + __expf(-y));
}
__device__ __forceinline__ h2_t as_h2(unsigned u) { return __builtin_bit_cast(h2_t, u); }
__device__ __forceinline__ float dot8(const v4u& u, const h2_t* xh, float a) {
    const unsigned ux = u.x, uy = u.y, uz = u.z, uw = u.w;
    a = __builtin_amdgcn_fdot2(as_h2(ux), xh[0], a, false);
    a = __builtin_amdgcn_fdot2(as_h2(uy), xh[1], a, false);
    a = __builtin_amdgcn_fdot2(as_h2(uz), xh[2], a, false);
    a = __builtin_amdgcn_fdot2(as_h2(uw), xh[3], a, false);
    return a;
}
__device__ __forceinline__ void axpy8(float* o, float c, const v4u& v) {
    const unsigned vx = v.x, vy = v.y, vz = v.z, vw = v.w;
    const h2_t a = as_h2(vx), b = as_h2(vy), d = as_h2(vz), e = as_h2(vw);
    o[0] += c * (float)a[0]; o[1] += c * (float)a[1]; o[2] += c * (float)b[0]; o[3] += c * (float)b[1];
    o[4] += c * (float)d[0]; o[5] += c * (float)d[1]; o[6] += c * (float)e[0]; o[7] += c * (float)e[1];
}
__device__ __forceinline__ void peer_phase(const Ptrs& P, int vcu, int G, int wave, int lane) {
    const int gw = vcu * NWAVES + wave, NGW = G * NWAVES;
    float* H = P.out; bf16* HB = (bf16*)(P.ws + WS_HB); float* RS2 = (float*)(P.ws + WS_RS2);
    const int* EIDX = (const int*)(P.ws + WS_EIDX); const float* GATE = (const float*)(P.ws + WS_GATE);
    const GAS v4u* U16 = (const GAS v4u*)(P.ws + WS_U); const GAS v4u* V16 = (const GAS v4u*)(P.ws + WS_V);
    const int kl = ((lane & 1) << 3) | ((lane & 2) << 1) | ((lane & 4) >> 1) | ((lane & 8) >> 3);
    for (int t = gw; t < M; t += NGW) {
        GAS f32x4* hp = (GAS f32x4*)(H + (size_t)t * 1024 + lane * 8);
        const f32x4 a0 = hp[0], a1 = hp[1], b0 = hp[128], b1 = hp[129];
        float ss = (a0.x * a0.x + a0.y * a0.y) + (a0.z * a0.z + a0.w * a0.w) + (a1.x * a1.x + a1.y * a1.y) + (a1.z * a1.z + a1.w * a1.w)
                 + (b0.x * b0.x + b0.y * b0.y) + (b0.z * b0.z + b0.w * b0.w) + (b1.x * b1.x + b1.y * b1.y) + (b1.z * b1.z + b1.w * b1.w);
        ss = wave_sum(ss);
        const float rstd = __builtin_amdgcn_rsqf(ss * (1.0f / 1024.0f) + EPS);
        h2_t xh[8];
        xh[0] = __builtin_bit_cast(h2_t, pkh(a0.x, a0.y)); xh[1] = __builtin_bit_cast(h2_t, pkh(a0.z, a0.w)); xh[2] = __builtin_bit_cast(h2_t, pkh(a1.x, a1.y)); xh[3] = __builtin_bit_cast(h2_t, pkh(a1.z, a1.w));
        xh[4] = __builtin_bit_cast(h2_t, pkh(b0.x, b0.y)); xh[5] = __builtin_bit_cast(h2_t, pkh(b0.z, b0.w)); xh[6] = __builtin_bit_cast(h2_t, pkh(b1.x, b1.y)); xh[7] = __builtin_bit_cast(h2_t, pkh(b1.z, b1.w));
        const int ei0 = EIDX[(size_t)t * 128 + lane], ei1 = EIDX[(size_t)t * 128 + 64 + lane];
        const float gg0 = GATE[(size_t)t * 128 + lane], gg1 = GATE[(size_t)t * 128 + 64 + lane];
        float out[16];
#pragma unroll
        for (int i = 0; i < 16; ++i) out[i] = 0.f;
        for (int hh = 0; hh < 8; ++hh) {
            const int ereg = hh < 4 ? ei0 : ei1; const float greg = hh < 4 ? gg0 : gg1; const int lb = (hh & 3) * 16;
            float part[16];
#pragma unroll
            for (int k = 0; k < 16; ++k) {
                const int e = __builtin_amdgcn_readlane(ereg, lb + k);
                const GAS v4u* up = U16 + (size_t)e * 128 + lane;
                const v4u u0 = up[0], u1 = up[64];
                part[k] = dot8(u1, xh + 4, dot8(u0, xh, 0.f));
            }
#pragma unroll
            for (int st = 0; st < 4; ++st) {
                const int m = 1 << st, nh = 8 >> st; const bool up = (lane & m) != 0;
#pragma unroll
                for (int i = 0; i < nh; ++i) {
                    const float send = up ? part[i] : part[i + nh], keep = up ? part[i + nh] : part[i];
                    part[i] = keep + __shfl_xor(send, m);
                }
            }
            float d = part[0]; d += __shfl_xor(d, 16); d += __shfl_xor(d, 32);
            const float gk = __shfl(greg, lb + kl);
            const float cf = gk * gelu_tanh(d * rstd);
#pragma unroll
            for (int k = 0; k < 16; ++k) {
                const int e = __builtin_amdgcn_readlane(ereg, lb + k);
                const int src = ((k & 1) << 3) | ((k & 2) << 1) | ((k & 4) >> 1) | ((k & 8) >> 3);
                const float ck = __uint_as_float(__builtin_amdgcn_readlane(__float_as_uint(cf), src));
                const GAS v4u* vp = V16 + (size_t)e * 128 + lane;
                const v4u v0 = vp[0], v1 = vp[64];
                axpy8(out, ck, v0); axpy8(out + 8, ck, v1);
            }
        }
#ifdef DBG_NO_PEER
#pragma unroll
        for (int i = 0; i < 16; ++i) out[i] = 0.f;
#endif
        const f32x4 o0 = {a0.x + out[0], a0.y + out[1], a0.z + out[2], a0.w + out[3]}, o1 = {a1.x + out[4], a1.y + out[5], a1.z + out[6], a1.w + out[7]};
        const f32x4 o2 = {b0.x + out[8], b0.y + out[9], b0.z + out[10], b0.w + out[11]}, o3 = {b1.x + out[12], b1.y + out[13], b1.z + out[14], b1.w + out[15]};
        hp[0] = o0; hp[1] = o1; hp[128] = o2; hp[129] = o3;
        GAS v4u* hb = (GAS v4u*)(HB + (size_t)t * 1024 + lane * 8);
        v4u w0; w0.x = pk2(o0.x, o0.y); w0.y = pk2(o0.z, o0.w); w0.z = pk2(o1.x, o1.y); w0.w = pk2(o1.z, o1.w);
        v4u w1; w1.x = pk2(o2.x, o2.y); w1.y = pk2(o2.z, o2.w); w1.z = pk2(o3.x, o3.y); w1.w = pk2(o3.z, o3.w);
        hb[0] = w0; hb[64] = w1;
        float s2 = (o0.x * o0.x + o0.y * o0.y) + (o0.z * o0.z + o0.w * o0.w) + (o1.x * o1.x + o1.y * o1.y) + (o1.z * o1.z + o1.w * o1.w)
                 + (o2.x * o2.x + o2.y * o2.y) + (o2.z * o2.z + o2.w * o2.w) + (o3.x * o3.x + o3.y * o3.y) + (o3.z * o3.z + o3.w * o3.w);
        s2 = wave_sum(s2);
        if (lane == 0) RS2[t] = s2;
    }
}

__device__ __forceinline__ void final_phase(const Ptrs& P, int vcu, int G, int wave, int lane) {
    const int gw = vcu * NWAVES + wave, NGW = G * NWAVES; const float* RS3 = (const float*)(P.ws + WS_RS3);
    const GAS f32x4* gf = (const GAS f32x4*)P.g_final + lane;
    f32x4 g[4];
#pragma unroll
    for (int j = 0; j < 4; ++j) g[j] = gf[64 * j];
    for (int m = gw; m < M; m += NGW) {
        GAS f32x4* xr = (GAS f32x4*)(P.out + (size_t)m * D) + lane;
        float rs = 0.f; { const GAS f32x4* rp = (const GAS f32x4*)(RS3 + (size_t)m * 16);
#pragma unroll
            for (int i = 0; i < 4; ++i) { const f32x4 a = rp[i]; rs += (a.x + a.y) + (a.z + a.w); } }
        const float rstd = __builtin_amdgcn_rsqf(rs * (1.0f / 1024.0f) + EPS);
#pragma unroll
        for (int j = 0; j < 4; ++j) { const f32x4 v = xr[64 * j]; xr[64 * j] = v * rstd * g[j]; }
    }
}

struct Args { const float* in[17]; float* out; unsigned char* ws; int ph_lo, ph_hi; };
#ifndef PG8_SP2
#define PG8_SP2 true
#endif
#ifndef PG8_ALIGN
#define PG8_ALIGN true
#endif
__global__ void __launch_bounds__(NWAVES * 64, 2) mega_fwd(Args args) {
    extern __shared__ __attribute__((aligned(16))) unsigned char lds_raw[];
    LAS unsigned char* lds = (LAS unsigned char*)lds_raw;
    volatile LAS unsigned* MISC = (volatile LAS unsigned*)(lds + MISC_OFF);
    const int tid = threadIdx.x, lane = tid & 63, wave = __builtin_amdgcn_readfirstlane(tid >> 6);
    const int G = gridDim.x, bx = blockIdx.x; const int vcu = (G % 8 == 0) ? (bx % 8) * (G / 8) + bx / 8 : bx;
    Ptrs P;
    P.x = args.in[0]; P.p = args.in[1]; P.g_mix = args.in[2]; P.w_in = args.in[3]; P.conv_w = args.in[4]; P.pool_w = args.in[5]; P.pool_scale = args.in[6]; P.w_o = args.in[7];
    P.g_ffn = args.in[8]; P.w_q = args.in[9]; P.sub_keys = args.in[10]; P.eu = args.in[11]; P.ev = args.in[12]; P.g_ple = args.in[13]; P.w_gate = args.in[14]; P.w_proj = args.in[15]; P.g_final = args.in[16];
    P.out = args.out; P.ws = args.ws;
    gu32* ctl = (gu32*)(P.ws + WS_CTL);
    for (int u = tid; u < (LDS_BYTES - LDSCTL_OFF) / 4; u += NWAVES * 64) ((LAS unsigned*)(lds + LDSCTL_OFF))[u] = 0u;
    __syncthreads();
    XcdBarrier bar; bar.bar = (unsigned*)(ctl + CW_BAR); bar.x = 0; bar.st = nullptr;
    if (!MK_PER_PHASE) bar = xcd_barrier_post((unsigned*)(ctl + CW_BAR), MISC + 8);
    const int lo = args.ph_lo, hi = args.ph_hi;
#define IN(k) (lo <= (k) && (k) < hi)
#define SEAM(k) do { if (IN(k) && IN((k) + 1)) xcd_barrier(bar); } while (0)
    pg8::bf16_t* const WIN = (pg8::bf16_t*)(P.ws + WS_WIN); pg8::bf16_t* const WO = (pg8::bf16_t*)(P.ws + WS_WO); pg8::bf16_t* const WQ = (pg8::bf16_t*)(P.ws + WS_WQ);
    pg8::bf16_t* const WG = (pg8::bf16_t*)(P.ws + WS_WG); pg8::bf16_t* const WP = (pg8::bf16_t*)(P.ws + WS_WP);
    pg8::bf16_t* const XB = (pg8::bf16_t*)(P.ws + WS_XB); pg8::bf16_t* const PL = XB; pg8::bf16_t* const PROJ = (pg8::bf16_t*)(P.ws + WS_PROJ); pg8::bf16_t* const QB = PROJ;
    pg8::bf16_t* const MIX = (pg8::bf16_t*)(P.ws + WS_MIX); pg8::bf16_t* const HB = (pg8::bf16_t*)(P.ws + WS_HB); pg8::bf16_t* const PB = (pg8::bf16_t*)(P.ws + WS_PB);

    if (IN(0)) { p0a_phase(P, lds, vcu, G, tid, wave, lane); SEAM(0); }
    if (IN(1)) { p0b_phase(P, lds, vcu, G, wave, lane); SEAM(1); }
    if (IN(2)) {
        pg8::Gemm g{XB, WIN, M, NPROJ, D}; pg8::StaticOrder S; S.init(M, NPROJ, G, bx);
        EpiBf16Row E{PROJ, NPROJ, (const float*)(P.ws + WS_RSX)};
        pg8::gemm_phase<EpiBf16Row, pg8::StaticOrder, PG8_ALIGN, PG8_SP2>(lds, g, S, E);
        SEAM(2);
    }
    if (IN(3)) {
        p2_phase(P, vcu, G, tid);
        pg8::Gemm g{PB, WP, M, D, PLED}; pg8::StaticOrder S; S.init(M, D, G, bx);
        EpiBf16Row E{PL, D, nullptr};
        pg8::gemm_phase<EpiBf16Row, pg8::StaticOrder, PG8_ALIGN, PG8_SP2>(lds, g, S, E);
        SEAM(3);
    }
    if (IN(4)) {
        pg8::Gemm g{MIX, WO, M, D, D}; pg8::StaticOrder S; S.init(M, D, G, bx);
        EpiH1 E{P.x, P.out, HB, (float*)(P.ws + WS_RS1)};
        pg8::gemm_phase<EpiH1, pg8::StaticOrder, PG8_ALIGN, PG8_SP2>(lds, g, S, E);
        SEAM(4);
    }
    if (IN(5)) {
        pg8::Gemm g{HB, WQ, M, NQ, D}; pg8::StaticOrder S; S.init(M, NQ, G, bx);
        EpiBf16Row E{QB, NQ, nullptr};
        pg8::gemm_phase<EpiBf16Row, pg8::StaticOrder, PG8_ALIGN, PG8_SP2>(lds, g, S, E);
        SEAM(5);
    }
    if (IN(6)) { score_phase(P, lds, bx, G, tid, wave, lane); SEAM(6); }
    if (IN(7)) { peer_phase(P, vcu, G, wave, lane); SEAM(7); }
    if (IN(8)) {
        pg8::Gemm g{HB, WG, M, D, D}; pg8::StaticOrder S; S.init(M, D, G, bx);
        EpiGate E{P.out, PL, (const float*)(P.ws + WS_RS2), (float*)(P.ws + WS_RS3)};
        pg8::gemm_phase<EpiGate, pg8::StaticOrder, PG8_ALIGN, PG8_SP2>(lds, g, S, E);
        SEAM(8);
    }
    if (IN(9)) { final_phase(P, vcu, G, wave, lane); }
#undef IN
#undef SEAM
}

extern "C" void kernel_launch(void* const* d_in, const int* in_sizes, int n_in, void* d_out, int out_size, void* d_ws, size_t ws_size, hipStream_t stream) {
    static int grid = 0;
    if (grid == 0) {
        if (n_in != 17 || in_sizes[0] != M * D || out_size != M * D || ws_size < WS_END) { fprintf(stderr, "kernel_launch: unexpected shapes (n_in %d, in0 %d, out %d, ws %zu); nothing launched\n", n_in, n_in > 0 ? in_sizes[0] : -1, out_size, ws_size); grid = -1; return; }
        int dev = 0, cus = 0, per_cu = 0;
        if (hipGetDevice(&dev) != hipSuccess || hipDeviceGetAttribute(&cus, hipDeviceAttributeMultiprocessorCount, dev) != hipSuccess) { fprintf(stderr, "kernel_launch: device query failed\n"); grid = -1; return; }
        if (hipFuncSetAttribute((const void*)mega_fwd, hipFuncAttributeMaxDynamicSharedMemorySize, LDS_BYTES) != hipSuccess) { fprintf(stderr, "kernel_launch: hipFuncSetAttribute failed\n"); grid = -1; return; }
        if (hipOccupancyMaxActiveBlocksPerMultiprocessor(&per_cu, (const void*)mega_fwd, NWAVES * 64, LDS_BYTES) != hipSuccess || per_cu < 1)
            fprintf(stderr, "kernel_launch: note: occupancy query reports %d workgroups per CU\n", per_cu);
        (void)hipGetLastError();
        grid = cus;
    }
    if (grid < 0) return;
    if (hipMemsetAsync((char*)d_ws + WS_CTL, 0, CTL_ZERO_BYTES, stream) != hipSuccess) { fprintf(stderr, "kernel_launch: memset failed\n"); return; }
    Args a{};
    for (int i = 0; i < 17; ++i) a.in[i] = (const float*)d_in[i];
    a.out = (float*)d_out; a.ws = (unsigned char*)d_ws;
#if MK_PER_PHASE
    for (int ph = 0; ph < NPHASES; ++ph) { a.ph_lo = ph; a.ph_hi = ph + 1; hipLaunchKernelGGL(mega_fwd, dim3(grid), dim3(NWAVES * 64), LDS_BYTES, stream, a); }
#else
    a.ph_lo = 0; a.ph_hi = NPHASES;
    hipLaunchKernelGGL(mega_fwd, dim3(grid), dim3(NWAVES * 64), LDS_BYTES, stream, a);
#endif
    const hipError_t le = hipPeekAtLastError();
    if (le != hipSuccess) fprintf(stderr, "kernel_launch: launch failed: %s\n", hipGetErrorName(le));
}
```

```cpp
#include <hip/hip_runtime.h>
#include <cstdio>
#include <cstdint>
namespace pg8 {
#define PG8_LAS __attribute__((address_space(3)))
typedef unsigned short bf16_t;
typedef short bf16x8 __attribute__((ext_vector_type(8)));
typedef float f32x4 __attribute__((ext_vector_type(4)));
typedef unsigned u32x4 __attribute__((ext_vector_type(4)));
constexpr int BM = 256, BK = 64, HALF = 128, HTB = HALF * BK * 2  , STAGE_BYTES = 8 * HTB, NXCD = 8, WGM = 8;

__host__ __device__ __forceinline__ int lds_byte(int r, int c) { const int st = (r >> 4) * 2 + (c >> 5), rr = r & 15, cc = c & 31, ob = rr * 64 + cc * 2; return st * 1024 + (ob ^ (((ob >> 9) & 1) << 5)); }
__host__ __device__ __forceinline__ void stage_rc(int b, int& R, int& C) { const int st = b / 1024, sb = b % 1024, swz = sb ^ (((sb >> 9) & 1) << 5); R = (st >> 1) * 16 + swz / 64; C = (st & 1) * 32 + (swz % 64) / 2; }
__host__ __device__ __forceinline__ int perm32(int rho) { const int n = rho >> 4, i = rho & 15; return 8 * (i >> 2) + 4 * n + (i & 3); }

struct Unit { int pm, pn; };
struct Gemm { const bf16_t* A; const bf16_t* Bt; int M, N, K; };

struct StaticOrder {
    int nM, nN, nwg, G, c;
    __host__ __device__ void init(int M, int N, int G_, int c_) { nM = M / BM; nN = N / BM; nwg = nM * nN; G = G_; c = c_; }
    __host__ __device__ bool next(int i, Unit& u) const {
        const long L = (long)i * G + c; if (L >= nwg) return false;
        int wgid = (int)L; { const int q = nwg / NXCD, r = nwg % NXCD, xcd = wgid % NXCD, off = wgid / NXCD; wgid = (xcd < r ? xcd * (q + 1) : r * (q + 1) + (xcd - r) * q) + off; }
        const int nig = WGM * nN, gid = wgid / nig, fm = gid * WGM, gsz = (nM - fm) < WGM ? (nM - fm) : WGM;
        u.pm = fm + ((wgid % nig) % gsz); u.pn = (wgid % nig) / gsz; return true;
    }
    __device__ __forceinline__ void a_ready(const Unit&) const {}
    __device__ __forceinline__ void done(const Unit&) const {}
};

__device__ __forceinline__ unsigned cvt_pk_bf16(float lo, float hi) { unsigned r; asm volatile("v_cvt_pk_bf16_f32 %0, %1, %2" : "=v"(r) : "v"(lo), "v"(hi)); return r; }
template <class Epi, class Sched, bool ALIGN_EPI = false, bool SP2 = false>
__device__ __forceinline__ void gemm_phase(PG8_LAS unsigned char* lds, const Gemm g, const Sched& S, const Epi& E) {
    const int tid = threadIdx.x, wid = __builtin_amdgcn_readfirstlane(tid >> 6), lane = tid & 63, wr = wid >> 2, wc = wid & 3, fr = lane & 15, fq = lane >> 4;
    const int K = g.K, nt = K / BK;
    unsigned voffA[2], voffB[2];
#pragma unroll
    for (int i = 0; i < 2; ++i) { int R, C; stage_rc(tid * 16 + i * 8192, R, C); const int Rb = Epi::PERM ? ((R & ~31) + perm32(R & 31)) : R;
        voffA[i] = (unsigned)(R * K + C) * 2u; voffB[i] = (unsigned)(Rb * K + C) * 2u; }
    const size_t kstep = (size_t)(BK * 2);
    const size_t hstep = (size_t)HALF * K * 2;
    const size_t tstep = 2 * hstep;
    const unsigned ldsw = (unsigned)wid * 1024u;
    const int aoff = lds_byte(wr * 64 + fr, fq * 8), boff = lds_byte(wc * 32 + fr, fq * 8);
#define PG8_SA(b, h) (((b) * 2 + (h)) * HTB)
#define PG8_SB(b, h) ((4 + (b) * 2 + (h)) * HTB)
#define PG8_STAGE(bufoff, gbase, voff) do { _Pragma("unroll") for (int _i = 0; _i < 2; ++_i) \
        __builtin_amdgcn_global_load_lds((const unsigned*)((const char*)(gbase) + (voff)[_i]), (PG8_LAS unsigned*)(lds + (bufoff) + ldsw + _i * 8192), 16, 0, 0); } while (0)
#define PG8_LDA(dst, b, h) do { _Pragma("unroll") for (int m = 0; m < 4; ++m) _Pragma("unroll") for (int k = 0; k < 2; ++k) dst[m][k] = *(const PG8_LAS bf16x8*)(lds + PG8_SA(b, h) + aoff + m * 2048 + k * 1024); } while (0)
#define PG8_LDB(dst, b, h) do { _Pragma("unroll") for (int n = 0; n < 2; ++n) _Pragma("unroll") for (int k = 0; k < 2; ++k) dst[n][k] = *(const PG8_LAS bf16x8*)(lds + PG8_SB(b, h) + boff + n * 2048 + k * 1024); } while (0)
#define PG8_MMA(ai, bj, At, Bt) do { __builtin_amdgcn_s_setprio(1); _Pragma("unroll") for (int m = 0; m < 4; ++m) _Pragma("unroll") for (int n = 0; n < 2; ++n) _Pragma("unroll") for (int k = 0; k < 2; ++k) \
        acc[ai][bj][m][n] = __builtin_amdgcn_mfma_f32_16x16x32_bf16(Bt[n][k], At[m][k], acc[ai][bj][m][n], 0, 0, 0); __builtin_amdgcn_s_setprio(0); } while (0)
#define PG8_WAIT_V(n) asm volatile("s_waitcnt vmcnt(" #n ")" ::: "memory")
#define PG8_WAIT_L(n) asm volatile("s_waitcnt lgkmcnt(" #n ")" ::: "memory")
#define PG8_BAR __builtin_amdgcn_s_barrier()
#define PG8_SCHED __builtin_amdgcn_sched_barrier(0)
    Unit cur, nxt; int ui = 0;
    if (!S.next(0, cur)) return;
    f32x4 acc[2][2][4][2];
#pragma unroll
    for (int a = 0; a < 2; ++a)
#pragma unroll
        for (int b = 0; b < 2; ++b)
#pragma unroll
            for (int m = 0; m < 4; ++m)
#pragma unroll
                for (int n = 0; n < 2; ++n) acc[a][b][m][n] = (f32x4){0.f, 0.f, 0.f, 0.f};
    bf16x8 At[4][2], B0[2][2], B1[2][2];
    const char* cA = (const char*)g.A + (size_t)cur.pm * tstep; const char* cB = (const char*)g.Bt + (size_t)cur.pn * tstep;
    S.a_ready(cur);
    if constexpr (SP2) {
        PG8_STAGE(PG8_SB(0, 0), cB, voffB); PG8_STAGE(PG8_SB(0, 1), cB + hstep, voffB); PG8_STAGE(PG8_SA(0, 0), cA, voffA); PG8_STAGE(PG8_SA(0, 1), cA + hstep, voffA);
        if (wr == 1) PG8_BAR;
        PG8_WAIT_V(2); PG8_BAR;
        PG8_STAGE(PG8_SB(1, 0), cB + kstep, voffB); PG8_STAGE(PG8_SA(1, 0), cA + kstep, voffA); PG8_STAGE(PG8_SB(1, 1), cB + hstep + kstep, voffB);
        PG8_WAIT_V(6); PG8_BAR;
    } else {
        PG8_STAGE(PG8_SB(0, 0), cB, voffB); PG8_STAGE(PG8_SA(0, 0), cA, voffA); PG8_STAGE(PG8_SB(0, 1), cB + hstep, voffB); PG8_STAGE(PG8_SA(0, 1), cA + hstep, voffA);
        if (wr == 1) PG8_BAR;
        PG8_WAIT_V(4); PG8_BAR;
        PG8_STAGE(PG8_SB(1, 0), cB + kstep, voffB); PG8_STAGE(PG8_SA(1, 0), cA + kstep, voffA); PG8_STAGE(PG8_SB(1, 1), cB + hstep + kstep, voffB);
        PG8_WAIT_V(6); PG8_BAR;
    }
    for (;;) {
        const bool has_next = S.next(ui + 1, nxt);
        const char* nA = has_next ? (const char*)g.A + (size_t)nxt.pm * tstep : cA; const char* nB = has_next ? (const char*)g.Bt + (size_t)nxt.pn * tstep : cB;
        for (int t = 0; t < nt; t += 2) {
            const bool last = (t == nt - 2);
            const char* a1 = cA + (size_t)(t + 1) * kstep;
            const char* a2 = last ? nA : cA + (size_t)(t + 2) * kstep; const char* b2 = last ? nB : cB + (size_t)(t + 2) * kstep;
            const char* a3 = a2 + kstep; const char* b3 = b2 + kstep;
            if (last && has_next) S.a_ready(nxt);
            if constexpr (SP2) {
            PG8_LDB(B0, 0, 0); PG8_LDB(B1, 0, 1); PG8_SCHED; PG8_LDA(At, 0, 0); PG8_STAGE(PG8_SA(1, 1), a1 + hstep, voffA);
            PG8_WAIT_V(8); PG8_WAIT_L(0); PG8_BAR; PG8_MMA(0, 0, At, B0); PG8_MMA(0, 1, At, B1); PG8_BAR; PG8_SCHED;
            PG8_LDA(At, 0, 1); PG8_STAGE(PG8_SB(0, 0), b2, voffB); PG8_STAGE(PG8_SB(0, 1), b2 + hstep, voffB); PG8_STAGE(PG8_SA(0, 0), a2, voffA);
            PG8_WAIT_V(8); PG8_WAIT_L(0); PG8_BAR; PG8_MMA(1, 0, At, B0); PG8_MMA(1, 1, At, B1); PG8_BAR; PG8_SCHED;
            PG8_LDB(B0, 1, 0); PG8_LDB(B1, 1, 1); PG8_SCHED; PG8_LDA(At, 1, 0); PG8_STAGE(PG8_SA(0, 1), a2 + hstep, voffA);
            PG8_WAIT_V(8); PG8_WAIT_L(0); PG8_BAR; PG8_MMA(0, 0, At, B0); PG8_MMA(0, 1, At, B1); PG8_BAR; PG8_SCHED;
            PG8_LDA(At, 1, 1); PG8_STAGE(PG8_SB(1, 0), b3, voffB); PG8_STAGE(PG8_SB(1, 1), b3 + hstep, voffB); PG8_STAGE(PG8_SA(1, 0), a3, voffA);
            PG8_WAIT_V(8); PG8_WAIT_L(0); PG8_BAR; PG8_MMA(1, 0, At, B0); PG8_MMA(1, 1, At, B1); PG8_BAR; PG8_SCHED;
            } else {
            PG8_LDB(B0, 0, 0); PG8_SCHED; PG8_LDA(At, 0, 0); PG8_STAGE(PG8_SA(1, 1), a1 + hstep, voffA);
            PG8_WAIT_L(8); PG8_BAR; PG8_WAIT_L(0); PG8_MMA(0, 0, At, B0); PG8_BAR; PG8_SCHED;
            PG8_LDB(B1, 0, 1); PG8_STAGE(PG8_SB(0, 0), b2, voffB);
            PG8_BAR; PG8_WAIT_L(0); PG8_MMA(0, 1, At, B1); PG8_BAR;
            PG8_LDA(At, 0, 1); PG8_STAGE(PG8_SA(0, 0), a2, voffA);
            PG8_BAR; PG8_WAIT_L(0); PG8_MMA(1, 0, At, B0); PG8_BAR; PG8_SCHED;
            PG8_STAGE(PG8_SB(0, 1), b2 + hstep, voffB);
            PG8_WAIT_V(6); PG8_BAR; PG8_MMA(1, 1, At, B1); PG8_BAR;
            PG8_LDB(B0, 1, 0); PG8_SCHED; PG8_LDA(At, 1, 0); PG8_STAGE(PG8_SA(0, 1), a2 + hstep, voffA);
            PG8_WAIT_L(8); PG8_BAR; PG8_WAIT_L(0); PG8_MMA(0, 0, At, B0); PG8_BAR; PG8_SCHED;
            PG8_LDB(B1, 1, 1); PG8_STAGE(PG8_SB(1, 0), b3, voffB);
            PG8_BAR; PG8_WAIT_L(0); PG8_MMA(0, 1, At, B1); PG8_BAR;
            PG8_LDA(At, 1, 1); PG8_STAGE(PG8_SA(1, 0), a3, voffA);
            PG8_BAR; PG8_WAIT_L(0); PG8_MMA(1, 0, At, B0); PG8_BAR; PG8_SCHED;
            PG8_STAGE(PG8_SB(1, 1), b3 + hstep, voffB);
            PG8_WAIT_V(6); PG8_BAR; PG8_MMA(1, 1, At, B1); PG8_BAR;
            }
        }
        if constexpr (ALIGN_EPI) { if (wr == 0) PG8_BAR; }
        if constexpr (!Epi::AFTER_DRAIN) { E(acc, cur, wr, wc, fr, fq); S.done(cur); }
        if (!has_next) break;
#pragma unroll
        for (int a = 0; a < 2; ++a)
#pragma unroll
            for (int b = 0; b < 2; ++b)
#pragma unroll
                for (int m = 0; m < 4; ++m)
#pragma unroll
                    for (int n = 0; n < 2; ++n) acc[a][b][m][n] = (f32x4){0.f, 0.f, 0.f, 0.f};
        cur = nxt; cA = nA; cB = nB; ++ui;
        if constexpr (ALIGN_EPI) { if (wr == 1) PG8_BAR; }
    }
    PG8_WAIT_V(0);
    if constexpr (!ALIGN_EPI) { if (wr == 0) PG8_BAR; }
    PG8_BAR;
    if constexpr (Epi::AFTER_DRAIN) { E.fused(acc, cur, wr, wc, fr, fq, lds, wid, lane); S.done(cur); }
#undef PG8_SA
#undef PG8_SB
#undef PG8_STAGE
#undef PG8_LDA
#undef PG8_LDB
#undef PG8_MMA
#undef PG8_WAIT_V
#undef PG8_WAIT_L
#undef PG8_BAR
#undef PG8_SCHED
}
}

#define GAS __attribute__((address_space(1)))
#define LAS __attribute__((address_space(3)))
typedef unsigned short bf16;
typedef unsigned v4u __attribute__((ext_vector_type(4)));
typedef float f32x4 __attribute__((ext_vector_type(4)));
typedef short bf16x8 __attribute__((ext_vector_type(8)));
typedef GAS unsigned gu32;
typedef GAS unsigned long long gu64;
#define RLX_AGENT __ATOMIC_RELAXED, __HIP_MEMORY_SCOPE_AGENT
#define LDS_WAIT() asm volatile("s_waitcnt lgkmcnt(0)" ::: "memory")
#define VM_WAIT() asm volatile("s_waitcnt vmcnt(0)" ::: "memory")
__device__ __forceinline__ unsigned long long rt() { return __builtin_amdgcn_s_memrealtime(); }
__device__ __forceinline__ unsigned f2bf(float f) { unsigned u = __builtin_bit_cast(unsigned, f); return (u + 0x7fffu + ((u >> 16) & 1u)) >> 16; }
__device__ __forceinline__ unsigned pk2(float lo, float hi) { return f2bf(lo) | (f2bf(hi) << 16); }

#define XB_TMO      128
#define XB_XCNT(j)  (256  + 64 * (j))
#define XB_XSUB(j)  (1280 + 64 * (j))
#define XB_XGEN(j)  (2304 + 64 * (j))
#define XB_TOP      3328
#define XB_TOPGEN   3392
#define XCD_BAR_WORDS 3456
#define XB_SPIN_CAP (1u << 18)

__device__ __forceinline__ unsigned xb_ld(unsigned* p)              { return __hip_atomic_load(p, __ATOMIC_RELAXED, __HIP_MEMORY_SCOPE_AGENT); }
__device__ __forceinline__ unsigned xb_add(unsigned* p, unsigned v) { return __hip_atomic_fetch_add(p, v, __ATOMIC_RELAXED, __HIP_MEMORY_SCOPE_AGENT); }
__device__ __forceinline__ unsigned xb_xcc_id() { return (unsigned)__builtin_amdgcn_s_getreg((3 << 11) | 20) & 0xFu; }
#define XB_SPIN(cond, bar) do { unsigned _sp = 0; while (cond) { __builtin_amdgcn_s_sleep(1); \
    if ((++_sp & 255u) == 0u) { if (xb_ld(&(bar)[XB_TMO])) break; if (_sp > XB_SPIN_CAP) { atomicAdd(&(bar)[XB_TMO], 1u); break; } } } } while (0)

struct XcdBarrier {
    unsigned* bar; unsigned x;
    volatile LAS unsigned* st;
};

__device__ __forceinline__ XcdBarrier xcd_barrier_post(unsigned* bar, volatile LAS unsigned* st) {
    XcdBarrier b; b.bar = bar; b.x = xb_xcc_id(); b.st = st;
    if (threadIdx.x == 0) (void)xb_add(&bar[XB_XCNT(b.x)], 1u);
    return b;
}
__device__ __forceinline__ void xcd_barrier_complete(unsigned* bar, unsigned x, unsigned& nloc, unsigned& nx) {
    const unsigned G = gridDim.x * gridDim.y * gridDim.z;
    unsigned sum, cnt, mine, sp = 0u;
    for (;;) {
        sum = 0u; cnt = 0u; mine = 0u;
#pragma unroll
        for (unsigned j = 0; j < 16; ++j) { const unsigned c = xb_ld(&bar[XB_XCNT(j)]); sum += c; cnt += (c > 0u) ? 1u : 0u; mine = (j == x) ? c : mine; }
        if (sum == G) break;
        __builtin_amdgcn_s_sleep(1);
        if ((++sp & 255u) == 0u) { if (xb_ld(&bar[XB_TMO])) break; if (sp > XB_SPIN_CAP) { atomicAdd(&bar[XB_TMO], 1u); break; } }
    }
    nloc = mine > 0u ? mine : 1u; nx = cnt > 0u ? cnt : 1u;
}

__device__ __forceinline__ void xcd_barrier(const XcdBarrier& b) {
    asm volatile("s_waitcnt vmcnt(0)" ::: "memory");
    __syncthreads();
    if (threadIdx.x == 0) {
        unsigned* bar = b.bar;
        __builtin_amdgcn_s_waitcnt(0);
        unsigned nloc = b.st[0], nx = b.st[1];
        if (nloc == 0u) { xcd_barrier_complete(bar, b.x, nloc, nx); b.st[0] = nloc; b.st[1] = nx; }
        const unsigned old = xb_add(&bar[XB_XSUB(b.x)], 1u);
        const unsigned gen = old / nloc;
        if (old + 1u == (gen + 1u) * nloc) {
            __builtin_amdgcn_fence(__ATOMIC_RELEASE, "agent");
            asm volatile("s_waitcnt vmcnt(0)" ::: "memory");
            const unsigned og = xb_add(&bar[XB_TOP], 1u);
            const unsigned tg = og / nx;
            if (og + 1u == (tg + 1u) * nx) xb_add(&bar[XB_TOPGEN], 1u);
            else XB_SPIN(xb_ld(&bar[XB_TOPGEN]) == tg, bar);
            __builtin_amdgcn_fence(__ATOMIC_ACQUIRE, "agent");
            xb_add(&bar[XB_XGEN(b.x)], 1u);
            asm volatile("s_waitcnt vmcnt(0)" ::: "memory");
        } else {
            XB_SPIN(xb_ld(&bar[XB_XGEN(b.x)]) == gen, bar);
            __builtin_amdgcn_fence(__ATOMIC_ACQUIRE, "agent");
            asm volatile("s_waitcnt vmcnt(0)" ::: "memory");
        }
    }
    __syncthreads();
}

constexpr int NWAVES = 8;
constexpr int M = 32768, D = 1024, SEQ = 4096, NPROJ = 2048, NQ = 2048, PLED = 256, NEXP = 16384;
constexpr float EPS = 1e-6f;
#ifndef MK_PER_PHASE
#define MK_PER_PHASE 0
#endif
constexpr int NPHASES = 10;

constexpr size_t MiB = 1u << 20;
constexpr size_t WS_CTL = 0, CTL_ZERO_BYTES = 1 * MiB;
constexpr size_t WS_WIN = 2 * MiB, WS_WO = 6 * MiB, WS_WQ = 8 * MiB, WS_WG = 12 * MiB, WS_WP = 14 * MiB, WS_KEYS = 14 * MiB + 512 * 1024;
constexpr size_t WS_WF = 15 * MiB;
constexpr size_t WS_RSX = 17 * MiB, WS_RS2 = 17 * MiB + 512 * 1024, WS_RS1 = 18 * MiB, WS_RS3 = 20 * MiB;
constexpr size_t WS_SU = 22 * MiB, WS_SV = 22 * MiB + 65536;
constexpr size_t WS_U = 24 * MiB, WS_V = 56 * MiB;
constexpr size_t WS_XB = 88 * MiB;
constexpr size_t WS_PROJ = 152 * MiB;
constexpr size_t WS_MIX = 280 * MiB;
constexpr size_t WS_HB = 344 * MiB;
constexpr size_t WS_EIDX = 408 * MiB, WS_GATE = 424 * MiB;
constexpr size_t WS_PB = 440 * MiB;
constexpr size_t WS_END = 456 * MiB;
constexpr int CW_BAR = 4096;
static_assert((CW_BAR + XCD_BAR_WORDS) * 4 <= (int)CTL_ZERO_BYTES, "CTL words inside the memset region");

constexpr int RING_BYTES = 131072;
constexpr int LDSCTL_OFF = RING_BYTES, MISC_OFF = LDSCTL_OFF + 320;
constexpr int LDS_BYTES = 147456;

typedef float f32x16 __attribute__((ext_vector_type(16)));
typedef _Float16 h2_t __attribute__((ext_vector_type(2)));
typedef float f32x2 __attribute__((ext_vector_type(2)));
typedef int i32x4 __attribute__((ext_vector_type(4)));

__device__ __forceinline__ float wave_sum(float v) {
#pragma unroll
    for (int o = 1; o < 64; o <<= 1) v += __shfl_xor(v, o);
    return v;
}
__device__ __forceinline__ float bf_lo(unsigned w) { return __uint_as_float(w << 16); }
__device__ __forceinline__ float bf_hi(unsigned w) { return __uint_as_float(w & 0xffff0000u); }
__device__ __forceinline__ unsigned pkh(float lo, float hi) { f32x2 v = {lo, hi}; h2_t h = __builtin_convertvector(v, h2_t); return __builtin_bit_cast(unsigned, h); }

struct EpiBf16Row {
    static constexpr bool PERM = true, AFTER_DRAIN = false;
    pg8::bf16_t* O; int ldc; const float* rowss;
    __device__ __forceinline__ void operator()(const pg8::f32x4 (&acc)[2][2][4][2], const pg8::Unit& u, int wr, int wc, int fr, int fq) const {
        const int row0 = u.pm * 256 + wr * 64 + fr, col0 = u.pn * 256 + wc * 32 + 8 * fq;
#pragma unroll
        for (int ai = 0; ai < 2; ++ai)
#pragma unroll
            for (int m = 0; m < 4; ++m) {
                const int row = row0 + ai * 128 + m * 16;
                const float sc = rowss ? __builtin_amdgcn_rsqf(rowss[row] * (1.0f / 1024.0f) + EPS) : 1.0f;
                pg8::bf16_t* rowp = O + (size_t)row * ldc + col0;
#pragma unroll
                for (int bj = 0; bj < 2; ++bj) {
                    const pg8::f32x4 v0 = acc[ai][bj][m][0] * sc, v1 = acc[ai][bj][m][1] * sc;
                    pg8::u32x4 w; w.x = pg8::cvt_pk_bf16(v0[0], v0[1]); w.y = pg8::cvt_pk_bf16(v0[2], v0[3]); w.z = pg8::cvt_pk_bf16(v1[0], v1[1]); w.w = pg8::cvt_pk_bf16(v1[2], v1[3]);
                    *(pg8::u32x4*)(rowp + bj * 128) = w;
                }
            }
    }
};
struct EpiH1 {
    static constexpr bool PERM = true, AFTER_DRAIN = false;
    const float* X; float* H; pg8::bf16_t* HB; float* RS;
    __device__ __forceinline__ void operator()(const pg8::f32x4 (&acc)[2][2][4][2], const pg8::Unit& u, int wr, int wc, int fr, int fq) const {
        const int row0 = u.pm * 256 + wr * 64 + fr, col0 = u.pn * 256 + wc * 32 + 8 * fq;
#pragma unroll
        for (int ai = 0; ai < 2; ++ai)
#pragma unroll
            for (int m = 0; m < 4; ++m) {
                const int row = row0 + ai * 128 + m * 16; float s = 0.f;
#pragma unroll
                for (int bj = 0; bj < 2; ++bj) {
                    const size_t off = (size_t)row * 1024 + col0 + bj * 128;
                    const pg8::f32x4 x0 = *(const pg8::f32x4*)(X + off), x1 = *(const pg8::f32x4*)(X + off + 4);
                    const pg8::f32x4 v0 = acc[ai][bj][m][0] + x0, v1 = acc[ai][bj][m][1] + x1;
                    *(pg8::f32x4*)(H + off) = v0; *(pg8::f32x4*)(H + off + 4) = v1;
                    pg8::u32x4 w; w.x = pg8::cvt_pk_bf16(v0[0], v0[1]); w.y = pg8::cvt_pk_bf16(v0[2], v0[3]); w.z = pg8::cvt_pk_bf16(v1[0], v1[1]); w.w = pg8::cvt_pk_bf16(v1[2], v1[3]);
                    *(pg8::u32x4*)(HB + off) = w;
                    s += (v0[0] * v0[0] + v0[1] * v0[1]) + (v0[2] * v0[2] + v0[3] * v0[3]) + (v1[0] * v1[0] + v1[1] * v1[1]) + (v1[2] * v1[2] + v1[3] * v1[3]);
                }
                s += __shfl_xor(s, 16); s += __shfl_xor(s, 32);
                if (fq == 0) RS[(size_t)row * 16 + u.pn * 4 + wc] = s;
            }
    }
};
struct EpiGate {
    static constexpr bool PERM = true, AFTER_DRAIN = false;
    float* H; const pg8::bf16_t* PL; const float* RS2; float* RS3;
    __device__ __forceinline__ void operator()(const pg8::f32x4 (&acc)[2][2][4][2], const pg8::Unit& u, int wr, int wc, int fr, int fq) const {
        const int row0 = u.pm * 256 + wr * 64 + fr, col0 = u.pn * 256 + wc * 32 + 8 * fq;
#pragma unroll
        for (int ai = 0; ai < 2; ++ai)
#pragma unroll
            for (int m = 0; m < 4; ++m) {
                const int row = row0 + ai * 128 + m * 16; float s = 0.f;
                const float rstd = __builtin_amdgcn_rsqf(RS2[row] * (1.0f / 1024.0f) + EPS);
#pragma unroll
                for (int bj = 0; bj < 2; ++bj) {
                    const size_t off = (size_t)row * 1024 + col0 + bj * 128;
                    const pg8::u32x4 w = *(const pg8::u32x4*)(PL + off);
                    const pg8::f32x4 h0 = *(const pg8::f32x4*)(H + off), h1 = *(const pg8::f32x4*)(H + off + 4);
                    const pg8::f32x4 a0 = acc[ai][bj][m][0] * rstd, a1 = acc[ai][bj][m][1] * rstd;
                    pg8::f32x4 g0, g1;
#pragma unroll
                    for (int e = 0; e < 4; ++e) { g0[e] = 1.0f / (1.0f + __expf(-a0[e])); g1[e] = 1.0f / (1.0f + __expf(-a1[e])); }
                    const pg8::f32x4 p0 = {bf_lo(w.x), bf_hi(w.x), bf_lo(w.y), bf_hi(w.y)}, p1 = {bf_lo(w.z), bf_hi(w.z), bf_lo(w.w), bf_hi(w.w)};
#ifdef DBG_NO_PLE
                    const pg8::f32x4 v0 = h0, v1 = h1;
#else
                    const pg8::f32x4 v0 = h0 + g0 * p0, v1 = h1 + g1 * p1;
#endif
                    *(pg8::f32x4*)(H + off) = v0; *(pg8::f32x4*)(H + off + 4) = v1;
                    s += (v0[0] * v0[0] + v0[1] * v0[1]) + (v0[2] * v0[2] + v0[3] * v0[3]) + (v1[0] * v1[0] + v1[1] * v1[1]) + (v1[2] * v1[2] + v1[3] * v1[3]);
                }
                s += __shfl_xor(s, 16); s += __shfl_xor(s, 32);
                if (fq == 0) RS3[(size_t)row * 16 + u.pn * 4 + wc] = s;
            }
    }
};

__device__ __forceinline__ void p0_transpose_item(const float* W, int ldn, const float* gk, int K, bf16* WT, int row_off, int nblk, LAS float* scr, int item, int lane) {
    const int kb = item / nblk, nb = item % nblk, k0 = 64 * kb, n0 = 32 * nb;
#pragma unroll 8
    for (int i = 0; i < 32; ++i) { const int kk = 2 * i + (lane >> 5); float v = W[(size_t)(k0 + kk) * ldn + n0 + (lane & 31)]; if (gk) v *= gk[k0 + kk]; scr[kk * 33 + (lane & 31)] = v; }
    LDS_WAIT(); asm volatile("" ::: "memory");
    const int c = lane & 7;
#pragma unroll
    for (int j = 0; j < 4; ++j) { const int n = (lane >> 3) + 8 * j; const LAS float* s = scr + (8 * c) * 33 + n;
        v4u o; o.x = pk2(s[0 * 33], s[1 * 33]); o.y = pk2(s[2 * 33], s[3 * 33]); o.z = pk2(s[4 * 33], s[5 * 33]); o.w = pk2(s[6 * 33], s[7 * 33]);
        *(GAS v4u*)(WT + (size_t)(row_off + n0 + n) * K + k0 + 8 * c) = o; }
    LDS_WAIT(); asm volatile("" ::: "memory");
}

struct Ptrs {
    const float *x, *p, *g_mix, *w_in, *conv_w, *pool_w, *pool_scale, *w_o, *g_ffn, *w_q, *sub_keys, *eu, *ev, *g_ple, *w_gate, *w_proj, *g_final;
    float* out; unsigned char* ws;
};

__device__ __forceinline__ void p0a_phase(const Ptrs& P, LAS unsigned char* lds, int vcu, int G, int tid, int wave, int lane) {
    const int gw = vcu * NWAVES + wave, NGW = G * NWAVES;
    const int gt = vcu * (NWAVES * 64) + tid, NGT = G * NWAVES * 64;
    { float* Wf = (float*)(P.ws + WS_WF);
      for (int tk = gw; tk < 8192; tk += NGW) {
          const int k = tk >> 3, j = tk & 7, g = j >> 1, np = j * 64 + lane, d = np & 127;
          const float* wi = P.w_in + (size_t)k * 2048 + 1536 + g * 128; const float* pw = P.pool_w + (size_t)g * 128 * 128 + d;
          float a = 0.f;
#pragma unroll 8
          for (int c = 0; c < 128; ++c) a += wi[c] * pw[(size_t)c * 128];
          Wf[(size_t)k * 512 + np] = a * P.pool_scale[np];
      } }
    { LAS float* scr = (LAS float*)(lds + wave * 16384);
      constexpr int I_WO = 16 * 32, I_WQ = 16 * 64, I_WG = 16 * 32, I_WP = 4 * 32, I_WINA = 16 * 48;
      constexpr int NITEMS = I_WO + I_WQ + I_WG + I_WP + I_WINA;
      for (int it = gw; it < NITEMS; it += NGW) {
          int r = it;
          if (r < I_WO) { p0_transpose_item(P.w_o, 1024, nullptr, 1024, (bf16*)(P.ws + WS_WO), 0, 32, scr, r, lane); continue; } r -= I_WO;
          if (r < I_WQ) { p0_transpose_item(P.w_q, 2048, P.g_ffn, 1024, (bf16*)(P.ws + WS_WQ), 0, 64, scr, r, lane); continue; } r -= I_WQ;
          if (r < I_WG) { p0_transpose_item(P.w_gate, 1024, P.g_ple, 1024, (bf16*)(P.ws + WS_WG), 0, 32, scr, r, lane); continue; } r -= I_WG;
          if (r < I_WP) { p0_transpose_item(P.w_proj, 1024, nullptr, 256, (bf16*)(P.ws + WS_WP), 0, 32, scr, r, lane); continue; } r -= I_WP;
          p0_transpose_item(P.w_in, 2048, P.g_mix, 1024, (bf16*)(P.ws + WS_WIN), 0, 48, scr, r, lane);
      } }
    { const GAS f32x4* gf = (const GAS f32x4*)P.g_ffn + 4 * lane; f32x4 gq[4];
#pragma unroll
      for (int j = 0; j < 4; ++j) gq[j] = gf[j];
      for (int r = gw; r < 2 * NEXP; r += NGW) {
          const int tb = r >> 14, e = r & (NEXP - 1);
          const GAS f32x4* src = (const GAS f32x4*)((tb ? P.ev : P.eu) + (size_t)e * 1024) + 4 * lane;
          f32x4 a[4]; float m = 0.f;
#pragma unroll
          for (int j = 0; j < 4; ++j) { a[j] = src[j]; if (!tb) a[j] = a[j] * gq[j];
              m = fmaxf(fmaxf(fmaxf(m, fabsf(a[j].x)), fmaxf(fabsf(a[j].y), fabsf(a[j].z))), fabsf(a[j].w)); }
#pragma unroll
          for (int o = 1; o < 64; o <<= 1) m = fmaxf(m, __shfl_xor(m, o));
          const float sc = m > 0.f ? 400.0f / m : 0.f;
          v4u o; int w;
          w = __builtin_amdgcn_cvt_pk_fp8_f32(a[0].x * sc, a[0].y * sc, 0, false); w = __builtin_amdgcn_cvt_pk_fp8_f32(a[0].z * sc, a[0].w * sc, w, true); o.x = (unsigned)w;
          w = __builtin_amdgcn_cvt_pk_fp8_f32(a[1].x * sc, a[1].y * sc, 0, false); w = __builtin_amdgcn_cvt_pk_fp8_f32(a[1].z * sc, a[1].w * sc, w, true); o.y = (unsigned)w;
          w = __builtin_amdgcn_cvt_pk_fp8_f32(a[2].x * sc, a[2].y * sc, 0, false); w = __builtin_amdgcn_cvt_pk_fp8_f32(a[2].z * sc, a[2].w * sc, w, true); o.z = (unsigned)w;
          w = __builtin_amdgcn_cvt_pk_fp8_f32(a[3].x * sc, a[3].y * sc, 0, false); w = __builtin_amdgcn_cvt_pk_fp8_f32(a[3].z * sc, a[3].w * sc, w, true); o.w = (unsigned)w;
          ((GAS v4u*)(P.ws + (tb ? WS_V : WS_U)))[(size_t)e * 64 + lane] = o;
          if (lane == 0) ((float*)(P.ws + (tb ? WS_SV : WS_SU)))[e] = m * (1.0f / 400.0f);
      } }
    { const GAS f32x4* sp = (const GAS f32x4*)P.p; GAS v4u* dp = (GAS v4u*)(P.ws + WS_PB);
      for (int i = gt; i < M * PLED / 8; i += NGT) { const f32x4 a = sp[2 * (size_t)i], b = sp[2 * (size_t)i + 1]; v4u o; o.x = pk2(a.x, a.y); o.y = pk2(a.z, a.w); o.z = pk2(b.x, b.y); o.w = pk2(b.z, b.w); dp[i] = o; }
      const GAS f32x4* sk = (const GAS f32x4*)P.sub_keys; GAS v4u* dk = (GAS v4u*)(P.ws + WS_KEYS);
      for (int i = gt; i < 16 * 128 * 128 / 8; i += NGT) { const f32x4 a = sk[2 * (size_t)i], b = sk[2 * (size_t)i + 1]; v4u o; o.x = pk2(a.x, a.y); o.y = pk2(a.z, a.w); o.z = pk2(b.x, b.y); o.w = pk2(b.z, b.w); dk[i] = o; } }
    { float* RSX = (float*)(P.ws + WS_RSX); bf16* XB = (bf16*)(P.ws + WS_XB);
      for (int m = gw; m < M; m += NGW) {
          const GAS f32x4* xr = (const GAS f32x4*)(P.x + (size_t)m * D) + lane; f32x4 v[4]; float s = 0.f;
#pragma unroll
          for (int j = 0; j < 4; ++j) { v[j] = xr[64 * j]; s += (v[j].x * v[j].x + v[j].y * v[j].y) + (v[j].z * v[j].z + v[j].w * v[j].w); }
          s = wave_sum(s); if (lane == 0) RSX[m] = s;
          GAS unsigned long long* o8 = (GAS unsigned long long*)(XB + (size_t)m * D) + lane;
#pragma unroll
          for (int j = 0; j < 4; ++j) o8[64 * j] = (unsigned long long)pk2(v[j].x, v[j].y) | ((unsigned long long)pk2(v[j].z, v[j].w) << 32);
      } }
}
__device__ __forceinline__ void p0b_phase(const Ptrs& P, LAS unsigned char* lds, int vcu, int G, int wave, int lane) {
    const int gw = vcu * NWAVES + wave, NGW = G * NWAVES; LAS float* scr = (LAS float*)(lds + wave * 16384);
    for (int it = gw; it < 16 * 16; it += NGW) p0_transpose_item((const float*)(P.ws + WS_WF), 512, P.g_mix, 1024, (bf16*)(P.ws + WS_WIN), 1536, 16, scr, it, lane);
}

__device__ __forceinline__ void p2_phase(const Ptrs& P, int vcu, int G, int tid) {
    const unsigned* PR = (const unsigned*)(P.ws + WS_PROJ);
    unsigned* MX = (unsigned*)(P.ws + WS_MIX);
    constexpr int TC = 32;
    for (int ck = vcu; ck < M / TC; ck += G) {
        const int t0 = ck * TC, s0 = t0 & (SEQ - 1);
        if (tid < 256) {
            const int half = 1 << (tid >> 6);
            const unsigned* col = PR + 768 + tid;
            float S0 = 0.f, S1 = 0.f;
            { const int lo = (s0 - half) > 0 ? (s0 - half) : 0, hi = (s0 + half) < SEQ ? (s0 + half) : SEQ;
              for (int s = lo; s < hi; ++s) { const unsigned w = col[(size_t)(t0 + s - s0) * 1024]; S0 += bf_lo(w); S1 += bf_hi(w); } }
#pragma unroll 4
            for (int i = 0; i < TC; ++i) {
                const int s = s0 + i, t = t0 + i;
                const int lo = (s - half) > 0 ? (s - half) : 0, hi = (s + half) < SEQ ? (s + half) : SEQ;
                const float inv = 1.0f / (float)(hi - lo);
                const unsigned wc = col[(size_t)t * 1024];
                const float o0 = S0 * inv - bf_lo(wc), o1 = S1 * inv - bf_hi(wc);
                MX[(size_t)t * 512 + 256 + tid] = pk2(o0, o1);
                if (s + half < SEQ) { const unsigned w = col[(size_t)(t + half) * 1024]; S0 += bf_lo(w); S1 += bf_hi(w); }
                if (s - half >= 0) { const unsigned w = col[(size_t)(t - half) * 1024]; S0 -= bf_lo(w); S1 -= bf_hi(w); }
            }
        } else {
            const int cp = tid - 256;
            const unsigned* bcol = PR + cp; const unsigned* ccol = PR + 256 + cp; const unsigned* vcol = PR + 512 + cp;
            const float w00 = P.conv_w[2 * cp], w01 = P.conv_w[2 * cp + 1], w10 = P.conv_w[512 + 2 * cp], w11 = P.conv_w[512 + 2 * cp + 1], w20 = P.conv_w[1024 + 2 * cp], w21 = P.conv_w[1024 + 2 * cp + 1];
            float zp0 = 0.f, zp1 = 0.f, zc0, zc1;
            if (s0 > 0) { const unsigned c = ccol[(size_t)(t0 - 1) * 1024], v = vcol[(size_t)(t0 - 1) * 1024]; zp0 = bf_lo(c) * bf_lo(v); zp1 = bf_hi(c) * bf_hi(v); }
            { const unsigned c = ccol[(size_t)t0 * 1024], v = vcol[(size_t)t0 * 1024]; zc0 = bf_lo(c) * bf_lo(v); zc1 = bf_hi(c) * bf_hi(v); }
#pragma unroll 4
            for (int i = 0; i < TC; ++i) {
                const int s = s0 + i, t = t0 + i;
                float zn0 = 0.f, zn1 = 0.f;
                if (s + 1 < SEQ) { const unsigned c = ccol[(size_t)(t + 1) * 1024], v = vcol[(size_t)(t + 1) * 1024]; zn0 = bf_lo(c) * bf_lo(v); zn1 = bf_hi(c) * bf_hi(v); }
                const unsigned b = bcol[(size_t)t * 1024];
                const float y0 = w00 * zp0 + w10 * zc0 + w20 * zn0, y1 = w01 * zp1 + w11 * zc1 + w21 * zn1;
                MX[(size_t)t * 512 + cp] = pk2(bf_lo(b) * y0, bf_hi(b) * y1);
                zp0 = zc0; zp1 = zc1; zc0 = zn0; zc1 = zn1;
            }
        }
    }
}

__device__ __forceinline__ float fmax_s(float a, float b) { float r; asm("v_max_f32_e32 %0, %1, %2" : "=v"(r) : "v"(a), "v"(b)); return r; }
__device__ __forceinline__ float fmin_s(float a, float b) { float r; asm("v_min_f32_e32 %0, %1, %2" : "=v"(r) : "v"(a), "v"(b)); return r; }
#define CE_DESC(a, b) do { const float _t = fmax_s(a, b); b = fmin_s(a, b); a = _t; } while (0)
#define CE_ASC(a, b)  do { const float _t = fmin_s(a, b); b = fmax_s(a, b); a = _t; } while (0)
__device__ __forceinline__ void sort16_desc(float* a) {
#pragma unroll
    for (int k = 2; k <= 16; k <<= 1)
#pragma unroll
        for (int j = k >> 1; j > 0; j >>= 1)
#pragma unroll
            for (int i = 0; i < 16; ++i) { const int l = i ^ j; if (l > i) { if ((i & k) == 0) CE_DESC(a[i], a[l]); else CE_ASC(a[i], a[l]); } }
}
__device__ __forceinline__ void merge16_desc(float* a) {
#pragma unroll
    for (int j = 8; j > 0; j >>= 1)
#pragma unroll
        for (int i = 0; i < 16; ++i) { const int l = i ^ j; if (l > i) CE_DESC(a[i], a[l]); }
}
__device__ __forceinline__ void top16_merge(float* a, const float* b) {
#pragma unroll
    for (int i = 0; i < 16; ++i) a[i] = fmax_s(a[i], b[15 - i]);
    merge16_desc(a);
}
__device__ __forceinline__ void top16_of_64(float* v) {
    sort16_desc(v); sort16_desc(v + 16); sort16_desc(v + 32); sort16_desc(v + 48);
    top16_merge(v, v + 16); top16_merge(v + 32, v + 48); top16_merge(v, v + 32);
}
__device__ __forceinline__ unsigned key_lookup(unsigned long long lo, unsigned long long hi, unsigned i) {
    const unsigned long long v = (i & 8u) ? hi : lo;
    return (unsigned)(v >> ((i & 7u) * 8u)) & 0x7fu;
}

constexpr int KROW = 272;
__device__ __forceinline__ void score_phase(const Ptrs& P, LAS unsigned char* lds, int bid, int G, int tid, int wave, int lane) {
    const bf16* Q = (const bf16*)(P.ws + WS_PROJ); const bf16* KEYS = (const bf16*)(P.ws + WS_KEYS); const float* RS1 = (const float*)(P.ws + WS_RS1);
    int* EIDX = (int*)(P.ws + WS_EIDX); float* GATE = (float*)(P.ws + WS_GATE);
    const int l31 = lane & 31, hi = lane >> 5;
    int cur_h = -1;
    for (int u = bid; u < (M / 256) * 8; u += G) {
        const int h = u & 7, tile = u >> 3;
        if (h != cur_h) {
            __syncthreads();
#pragma unroll
            for (int i = 0; i < 8; ++i) { const int q = tid + 512 * i, row = q >> 4, ch = q & 15;
                const v4u val = *(const GAS v4u*)(KEYS + ((size_t)(h * 256 + row)) * 128 + ch * 8);
                *(LAS v4u*)(lds + row * KROW + ch * 16) = val; }
            __syncthreads();
            cur_h = h;
        }
        const int tok = tile * 256 + wave * 32 + l31;
        float T0[16], T1[16];
#pragma unroll
        for (int p = 0; p < 2; ++p) {
            f32x16 acc[4];
#pragma unroll
            for (int kb = 0; kb < 4; ++kb)
#pragma unroll
                for (int r = 0; r < 16; ++r) acc[kb][r] = 0.f;
            const bf16* qp = Q + (size_t)tok * 2048 + h * 256 + p * 128 + hi * 8;
            bf16x8 bq[8];
#pragma unroll
            for (int ks = 0; ks < 8; ++ks) bq[ks] = *(const GAS bf16x8*)(qp + ks * 16);
#pragma unroll
            for (int ks = 0; ks < 8; ++ks)
#pragma unroll
                for (int kb = 0; kb < 4; ++kb) {
                    const bf16x8 ak = *(const LAS bf16x8*)(lds + (p * 128 + kb * 32 + l31) * KROW + (ks * 16 + hi * 8) * 2);
                    acc[kb] = __builtin_amdgcn_mfma_f32_32x32x16_bf16(ak, bq[ks], acc[kb], 0, 0, 0);
                }
            float v[64];
#pragma unroll
            for (int kb = 0; kb < 4; ++kb)
#pragma unroll
                for (int r = 0; r < 16; ++r) v[kb * 16 + r] = __uint_as_float((__float_as_uint(acc[kb][r]) & 0xffffff80u) | (unsigned)(kb * 32 + (r & 3) + 8 * (r >> 2)));
            top16_of_64(v);
            const unsigned hb = (unsigned)hi << 2;
#pragma unroll
            for (int i = 0; i < 16; ++i) v[i] = __uint_as_float(__float_as_uint(v[i]) | hb);
            float c[16];
#pragma unroll
            for (int i = 0; i < 16; ++i) c[i] = fmax_s(v[i], __shfl_xor(v[15 - i], 32));
            merge16_desc(c);
#pragma unroll
            for (int i = 0; i < 16; ++i) { if (p == 0) T0[i] = c[i]; else T1[i] = c[i]; }
        }
        float f0[16], f1[16];
        unsigned long long K0lo = 0ull, K0hi = 0ull, K1lo = 0ull, K1hi = 0ull;
#pragma unroll
        for (int b = 0; b < 8; ++b) {
            K0lo |= (unsigned long long)(__float_as_uint(T0[b]) & 0x7fu) << (8 * b); K0hi |= (unsigned long long)(__float_as_uint(T0[8 + b]) & 0x7fu) << (8 * b);
            K1lo |= (unsigned long long)(__float_as_uint(T1[b]) & 0x7fu) << (8 * b); K1hi |= (unsigned long long)(__float_as_uint(T1[8 + b]) & 0x7fu) << (8 * b);
        }
#pragma unroll
        for (int i = 0; i < 16; ++i) { f0[i] = __uint_as_float(__float_as_uint(T0[i]) & 0xffffff80u); f1[i] = __uint_as_float(__float_as_uint(T1[i]) & 0xffffff80u); }
        float cd[64]; int n = 0;
#pragma unroll
        for (int i = 0; i < 16; ++i)
#pragma unroll
            for (int j = 0; j < 16; ++j)
                if ((i + 1) * (j + 1) <= 16) { cd[n] = __uint_as_float((__float_as_uint(f0[i] + f1[j]) & 0xffffff00u) | (unsigned)(i * 16 + j)); ++n; }
#pragma unroll
        for (int q = 50; q < 64; ++q) cd[q] = __uint_as_float(0xff800000u);
        top16_of_64(cd);
        float rs = 0.f;
        { const GAS f32x4* rp = (const GAS f32x4*)(RS1 + (size_t)tok * 16);
#pragma unroll
          for (int i = 0; i < 4; ++i) { const f32x4 a = rp[i]; rs += (a.x + a.y) + (a.z + a.w); } }
        const float rstd = __builtin_amdgcn_rsqf(rs * (1.0f / 1024.0f) + EPS);
        int eidx[16]; float gt_[16]; float z0 = 0.f, sum = 0.f;
#pragma unroll
        for (int k = 0; k < 16; ++k) {
            const unsigned wb = __float_as_uint(cd[k]); const unsigned i = (wb >> 4) & 15u, j = wb & 15u;
            eidx[k] = (int)(key_lookup(K0lo, K0hi, i) * 128u + key_lookup(K1lo, K1hi, j));
            const float z = __uint_as_float(wb & 0xffffff00u) * rstd;
            if (k == 0) z0 = z;
            gt_[k] = __expf(z - z0); sum += gt_[k];
        }
        const float inv = 1.0f / sum;
        if (hi == 0) { GAS i32x4* ep = (GAS i32x4*)(EIDX + (size_t)tok * 128 + h * 16);
#pragma unroll
            for (int q = 0; q < 4; ++q) ep[q] = (i32x4){eidx[4 * q], eidx[4 * q + 1], eidx[4 * q + 2], eidx[4 * q + 3]};
        } else { GAS f32x4* gp = (GAS f32x4*)(GATE + (size_t)tok * 128 + h * 16);
#pragma unroll
            for (int q = 0; q < 4; ++q) gp[q] = (f32x4){gt_[4 * q] * inv, gt_[4 * q + 1] * inv, gt_[4 * q + 2] * inv, gt_[4 * q + 3] * inv};
        }
    }
}

__device__ __forceinline__ float gelu_tanh(float x) {
    const float y = 1.5957691216057308f * (x + 0.044715f * x * x * x);
    return x / (1.0f + __expf(-y));
}
__device__ __forceinline__ float dot16(const v4u& u, const float* x, float a) {
    const unsigned w0 = u.x, w1 = u.y, w2 = u.z, w3 = u.w;
    f32x2 p;
    p = __builtin_amdgcn_cvt_pk_f32_fp8((int)w0, false); a = fmaf(p.x, x[0], a);  a = fmaf(p.y, x[1], a);
    p = __builtin_amdgcn_cvt_pk_f32_fp8((int)w0, true);  a = fmaf(p.x, x[2], a);  a = fmaf(p.y, x[3], a);
    p = __builtin_amdgcn_cvt_pk_f32_fp8((int)w1, false); a = fmaf(p.x, x[4], a);  a = fmaf(p.y, x[5], a);
    p = __builtin_amdgcn_cvt_pk_f32_fp8((int)w1, true);  a = fmaf(p.x, x[6], a);  a = fmaf(p.y, x[7], a);
    p = __builtin_amdgcn_cvt_pk_f32_fp8((int)w2, false); a = fmaf(p.x, x[8], a);  a = fmaf(p.y, x[9], a);
    p = __builtin_amdgcn_cvt_pk_f32_fp8((int)w2, true);  a = fmaf(p.x, x[10], a); a = fmaf(p.y, x[11], a);
    p = __builtin_amdgcn_cvt_pk_f32_fp8((int)w3, false); a = fmaf(p.x, x[12], a); a = fmaf(p.y, x[13], a);
    p = __builtin_amdgcn_cvt_pk_f32_fp8((int)w3, true);  a = fmaf(p.x, x[14], a); a = fmaf(p.y, x[15], a);
    return a;
}
__device__ __forceinline__ void axpy16(float* o, float c, const v4u& v) {
    const unsigned w0 = v.x, w1 = v.y, w2 = v.z, w3 = v.w;
    f32x2 p;
    p = __builtin_amdgcn_cvt_pk_f32_fp8((int)w0, false); o[0] = fmaf(c, p.x, o[0]);   o[1] = fmaf(c, p.y, o[1]);
    p = __builtin_amdgcn_cvt_pk_f32_fp8((int)w0, true);  o[2] = fmaf(c, p.x, o[2]);   o[3] = fmaf(c, p.y, o[3]);
    p = __builtin_amdgcn_cvt_pk_f32_fp8((int)w1, false); o[4] = fmaf(c, p.x, o[4]);   o[5] = fmaf(c, p.y, o[5]);
    p = __builtin_amdgcn_cvt_pk_f32_fp8((int)w1, true);  o[6] = fmaf(c, p.x, o[6]);   o[7] = fmaf(c, p.y, o[7]);
    p = __builtin_amdgcn_cvt_pk_f32_fp8((int)w2, false); o[8] = fmaf(c, p.x, o[8]);   o[9] = fmaf(c, p.y, o[9]);
    p = __builtin_amdgcn_cvt_pk_f32_fp8((int)w2, true);  o[10] = fmaf(c, p.x, o[10]); o[11] = fmaf(c, p.y, o[11]);
    p = __builtin_amdgcn_cvt_pk_f32_fp8((int)w3, false); o[12] = fmaf(c, p.x, o[12]); o[13] = fmaf(c, p.y, o[13]);
    p = __builtin_amdgcn_cvt_pk_f32_fp8((int)w3, true);  o[14] = fmaf(c, p.x, o[14]); o[15] = fmaf(c, p.y, o[15]);
}
__device__ __forceinline__ void peer_phase(const Ptrs& P, int vcu, int G, int wave, int lane) {
    const int gw = vcu * NWAVES + wave, NGW = G * NWAVES;
    float* H = P.out; bf16* HB = (bf16*)(P.ws + WS_HB); float* RS2 = (float*)(P.ws + WS_RS2);
    const int* EIDX = (const int*)(P.ws + WS_EIDX); const float* GATE = (const float*)(P.ws + WS_GATE);
    const GAS v4u* U8 = (const GAS v4u*)(P.ws + WS_U); const GAS v4u* V8 = (const GAS v4u*)(P.ws + WS_V);
    const float* SU = (const float*)(P.ws + WS_SU); const float* SV = (const float*)(P.ws + WS_SV);
    const int kl = ((lane & 1) << 3) | ((lane & 2) << 1) | ((lane & 4) >> 1) | ((lane & 8) >> 3);
    for (int t = gw; t < M; t += NGW) {
        GAS f32x4* hp = (GAS f32x4*)(H + (size_t)t * 1024 + lane * 16);
        f32x4 a[4]; float x[16]; float ss = 0.f;
#pragma unroll
        for (int j = 0; j < 4; ++j) { a[j] = hp[j]; x[4 * j] = a[j].x; x[4 * j + 1] = a[j].y; x[4 * j + 2] = a[j].z; x[4 * j + 3] = a[j].w;
            ss += (a[j].x * a[j].x + a[j].y * a[j].y) + (a[j].z * a[j].z + a[j].w * a[j].w); }
        ss = wave_sum(ss);
        const float rstd = __builtin_amdgcn_rsqf(ss * (1.0f / 1024.0f) + EPS);
        const int ei0 = EIDX[(size_t)t * 128 + lane], ei1 = EIDX[(size_t)t * 128 + 64 + lane];
        const float gg0 = GATE[(size_t)t * 128 + lane], gg1 = GATE[(size_t)t * 128 + 64 + lane];
        float out[16];
#pragma unroll
        for (int i = 0; i < 16; ++i) out[i] = 0.f;
        for (int hh = 0; hh < 8; ++hh) {
            const int ereg = hh < 4 ? ei0 : ei1; const float greg = hh < 4 ? gg0 : gg1; const int lb = (hh & 3) * 16;
            const int el = __shfl(ereg, lb + kl);
            const float su = SU[el], sv = SV[el];
            float part[16];
#pragma unroll
            for (int k = 0; k < 16; ++k) {
                const int e = __builtin_amdgcn_readlane(ereg, lb + k);
                const v4u uw = U8[(size_t)e * 64 + lane];
                part[k] = dot16(uw, x, 0.f);
            }
#pragma unroll
            for (int st = 0; st < 4; ++st) {
                const int m = 1 << st, nh = 8 >> st; const bool up = (lane & m) != 0;
#pragma unroll
                for (int i = 0; i < nh; ++i) {
                    const float send = up ? part[i] : part[i + nh], keep = up ? part[i + nh] : part[i];
                    part[i] = keep + __shfl_xor(send, m);
                }
            }
            float d = part[0]; d += __shfl_xor(d, 16); d += __shfl_xor(d, 32);
            const float gk = __shfl(greg, lb + kl);
            const float cf = gk * gelu_tanh(d * su * rstd) * sv;
#pragma unroll
            for (int k = 0; k < 16; ++k) {
                const int e = __builtin_amdgcn_readlane(ereg, lb + k);
                const int src = ((k & 1) << 3) | ((k & 2) << 1) | ((k & 4) >> 1) | ((k & 8) >> 3);
                const float ck = __uint_as_float(__builtin_amdgcn_readlane(__float_as_uint(cf), src));
                const v4u vw = V8[(size_t)e * 64 + lane];
                axpy16(out, ck, vw);
            }
        }
#ifdef DBG_NO_PEER
#pragma unroll
        for (int i = 0; i < 16; ++i) out[i] = 0.f;
#endif
        f32x4 o[4]; float s2 = 0.f;
#pragma unroll
        for (int j = 0; j < 4; ++j) { o[j] = (f32x4){a[j].x + out[4 * j], a[j].y + out[4 * j + 1], a[j].z + out[4 * j + 2], a[j].w + out[4 * j + 3]}; hp[j] = o[j];
            s2 += (o[j].x * o[j].x + o[j].y * o[j].y) + (o[j].z * o[j].z + o[j].w * o[j].w); }
        GAS v4u* hb = (GAS v4u*)(HB + (size_t)t * 1024 + lane * 16);
        v4u w0; w0.x = pk2(o[0].x, o[0].y); w0.y = pk2(o[0].z, o[0].w); w0.z = pk2(o[1].x, o[1].y); w0.w = pk2(o[1].z, o[1].w);
        v4u w1; w1.x = pk2(o[2].x, o[2].y); w1.y = pk2(o[2].z, o[2].w); w1.z = pk2(o[3].x, o[3].y); w1.w = pk2(o[3].z, o[3].w);
        hb[0] = w0; hb[1] = w1;
        s2 = wave_sum(s2);
        if (lane == 0) RS2[t] = s2;
    }
}

__device__ __forceinline__ void final_phase(const Ptrs& P, int vcu, int G, int wave, int lane) {
    const int gw = vcu * NWAVES + wave, NGW = G * NWAVES; const float* RS3 = (const float*)(P.ws + WS_RS3);
    const GAS f32x4* gf = (const GAS f32x4*)P.g_final + lane;
    f32x4 g[4];
#pragma unroll
    for (int j = 0; j < 4; ++j) g[j] = gf[64 * j];
    for (int m = gw; m < M; m += NGW) {
        GAS f32x4* xr = (GAS f32x4*)(P.out + (size_t)m * D) + lane;
        float rs = 0.f; { const GAS f32x4* rp = (const GAS f32x4*)(RS3 + (size_t)m * 16);
#pragma unroll
            for (int i = 0; i < 4; ++i) { const f32x4 a = rp[i]; rs += (a.x + a.y) + (a.z + a.w); } }
        const float rstd = __builtin_amdgcn_rsqf(rs * (1.0f / 1024.0f) + EPS);
#pragma unroll
        for (int j = 0; j < 4; ++j) { const f32x4 v = xr[64 * j]; xr[64 * j] = v * rstd * g[j]; }
    }
}

struct Args { const float* in[17]; float* out; unsigned char* ws; int ph_lo, ph_hi; };
#ifndef PG8_SP2
#define PG8_SP2 true
#endif
#ifndef PG8_ALIGN
#define PG8_ALIGN true
#endif
__global__ void __launch_bounds__(NWAVES * 64, 2) mega_fwd(Args args) {
    extern __shared__ __attribute__((aligned(16))) unsigned char lds_raw[];
    LAS unsigned char* lds = (LAS unsigned char*)lds_raw;
    volatile LAS unsigned* MISC = (volatile LAS unsigned*)(lds + MISC_OFF);
    const int tid = threadIdx.x, lane = tid & 63, wave = __builtin_amdgcn_readfirstlane(tid >> 6);
    const int G = gridDim.x, bx = blockIdx.x; const int vcu = (G % 8 == 0) ? (bx % 8) * (G / 8) + bx / 8 : bx;
    Ptrs P;
    P.x = args.in[0]; P.p = args.in[1]; P.g_mix = args.in[2]; P.w_in = args.in[3]; P.conv_w = args.in[4]; P.pool_w = args.in[5]; P.pool_scale = args.in[6]; P.w_o = args.in[7];
    P.g_ffn = args.in[8]; P.w_q = args.in[9]; P.sub_keys = args.in[10]; P.eu = args.in[11]; P.ev = args.in[12]; P.g_ple = args.in[13]; P.w_gate = args.in[14]; P.w_proj = args.in[15]; P.g_final = args.in[16];
    P.out = args.out; P.ws = args.ws;
    gu32* ctl = (gu32*)(P.ws + WS_CTL);
    for (int u = tid; u < (LDS_BYTES - LDSCTL_OFF) / 4; u += NWAVES * 64) ((LAS unsigned*)(lds + LDSCTL_OFF))[u] = 0u;
    __syncthreads();
    XcdBarrier bar; bar.bar = (unsigned*)(ctl + CW_BAR); bar.x = 0; bar.st = nullptr;
    if (!MK_PER_PHASE) bar = xcd_barrier_post((unsigned*)(ctl + CW_BAR), MISC + 8);
    const int lo = args.ph_lo, hi = args.ph_hi;
#define IN(k) (lo <= (k) && (k) < hi)
#define SEAM(k) do { if (IN(k) && IN((k) + 1)) xcd_barrier(bar); } while (0)
    pg8::bf16_t* const WIN = (pg8::bf16_t*)(P.ws + WS_WIN); pg8::bf16_t* const WO = (pg8::bf16_t*)(P.ws + WS_WO); pg8::bf16_t* const WQ = (pg8::bf16_t*)(P.ws + WS_WQ);
    pg8::bf16_t* const WG = (pg8::bf16_t*)(P.ws + WS_WG); pg8::bf16_t* const WP = (pg8::bf16_t*)(P.ws + WS_WP);
    pg8::bf16_t* const XB = (pg8::bf16_t*)(P.ws + WS_XB); pg8::bf16_t* const PL = XB; pg8::bf16_t* const PROJ = (pg8::bf16_t*)(P.ws + WS_PROJ); pg8::bf16_t* const QB = PROJ;
    pg8::bf16_t* const MIX = (pg8::bf16_t*)(P.ws + WS_MIX); pg8::bf16_t* const HB = (pg8::bf16_t*)(P.ws + WS_HB); pg8::bf16_t* const PB = (pg8::bf16_t*)(P.ws + WS_PB);

    if (IN(0)) { p0a_phase(P, lds, vcu, G, tid, wave, lane); SEAM(0); }
    if (IN(1)) { p0b_phase(P, lds, vcu, G, wave, lane); SEAM(1); }
    if (IN(2)) {
        pg8::Gemm g{XB, WIN, M, NPROJ, D}; pg8::StaticOrder S; S.init(M, NPROJ, G, bx);
        EpiBf16Row E{PROJ, NPROJ, (const float*)(P.ws + WS_RSX)};
        pg8::gemm_phase<EpiBf16Row, pg8::StaticOrder, PG8_ALIGN, PG8_SP2>(lds, g, S, E);
        SEAM(2);
    }
    if (IN(3)) {
        p2_phase(P, vcu, G, tid);
        pg8::Gemm g{PB, WP, M, D, PLED}; pg8::StaticOrder S; S.init(M, D, G, bx);
        EpiBf16Row E{PL, D, nullptr};
        pg8::gemm_phase<EpiBf16Row, pg8::StaticOrder, PG8_ALIGN, PG8_SP2>(lds, g, S, E);
        SEAM(3);
    }
    if (IN(4)) {
        pg8::Gemm g{MIX, WO, M, D, D}; pg8::StaticOrder S; S.init(M, D, G, bx);
        EpiH1 E{P.x, P.out, HB, (float*)(P.ws + WS_RS1)};
        pg8::gemm_phase<EpiH1, pg8::StaticOrder, PG8_ALIGN, PG8_SP2>(lds, g, S, E);
        SEAM(4);
    }
    if (IN(5)) {
        pg8::Gemm g{HB, WQ, M, NQ, D}; pg8::StaticOrder S; S.init(M, NQ, G, bx);
        EpiBf16Row E{QB, NQ, nullptr};
        pg8::gemm_phase<EpiBf16Row, pg8::StaticOrder, PG8_ALIGN, PG8_SP2>(lds, g, S, E);
        SEAM(5);
    }
    if (IN(6)) { score_phase(P, lds, bx, G, tid, wave, lane); SEAM(6); }
    if (IN(7)) { peer_phase(P, vcu, G, wave, lane); SEAM(7); }
    if (IN(8)) {
        pg8::Gemm g{HB, WG, M, D, D}; pg8::StaticOrder S; S.init(M, D, G, bx);
        EpiGate E{P.out, PL, (const float*)(P.ws + WS_RS2), (float*)(P.ws + WS_RS3)};
        pg8::gemm_phase<EpiGate, pg8::StaticOrder, PG8_ALIGN, PG8_SP2>(lds, g, S, E);
        SEAM(8);
    }
    if (IN(9)) { final_phase(P, vcu, G, wave, lane); }
#undef IN
#undef SEAM
}

extern "C" void kernel_launch(void* const* d_in, const int* in_sizes, int n_in, void* d_out, int out_size, void* d_ws, size_t ws_size, hipStream_t stream) {
    static int grid = 0;
    if (grid == 0) {
        if (n_in != 17 || in_sizes[0] != M * D || out_size != M * D || ws_size < WS_END) { fprintf(stderr, "kernel_launch: unexpected shapes (n_in %d, in0 %d, out %d, ws %zu); nothing launched\n", n_in, n_in > 0 ? in_sizes[0] : -1, out_size, ws_size); grid = -1; return; }
        int dev = 0, cus = 0, per_cu = 0;
        if (hipGetDevice(&dev) != hipSuccess || hipDeviceGetAttribute(&cus, hipDeviceAttributeMultiprocessorCount, dev) != hipSuccess) { fprintf(stderr, "kernel_launch: device query failed\n"); grid = -1; return; }
        if (hipFuncSetAttribute((const void*)mega_fwd, hipFuncAttributeMaxDynamicSharedMemorySize, LDS_BYTES) != hipSuccess) { fprintf(stderr, "kernel_launch: hipFuncSetAttribute failed\n"); grid = -1; return; }
        if (hipOccupancyMaxActiveBlocksPerMultiprocessor(&per_cu, (const void*)mega_fwd, NWAVES * 64, LDS_BYTES) != hipSuccess || per_cu < 1)
            fprintf(stderr, "kernel_launch: note: occupancy query reports %d workgroups per CU\n", per_cu);
        (void)hipGetLastError();
        grid = cus;
    }
    if (grid < 0) return;
    if (hipMemsetAsync((char*)d_ws + WS_CTL, 0, CTL_ZERO_BYTES, stream) != hipSuccess) { fprintf(stderr, "kernel_launch: memset failed\n"); return; }
    Args a{};
    for (int i = 0; i < 17; ++i) a.in[i] = (const float*)d_in[i];
    a.out = (float*)d_out; a.ws = (unsigned char*)d_ws;
#if MK_PER_PHASE
    for (int ph = 0; ph < NPHASES; ++ph) { a.ph_lo = ph; a.ph_hi = ph + 1; hipLaunchKernelGGL(mega_fwd, dim3(grid), dim3(NWAVES * 64), LDS_BYTES, stream, a); }
#else
    a.ph_lo = 0; a.ph_hi = NPHASES;
    hipLaunchKernelGGL(mega_fwd, dim3(grid), dim3(NWAVES * 64), LDS_BYTES, stream, a);
#endif
    const hipError_t le = hipPeekAtLastError();
    if (le != hipSuccess) fprintf(stderr, "kernel_launch: launch failed: %s\n", hipGetErrorName(le));
}
```

```cpp
#include <hip/hip_runtime.h>
#include <cstdio>
#include <cstdint>
namespace pg8 {
#define PG8_LAS __attribute__((address_space(3)))
typedef unsigned short bf16_t;
typedef short bf16x8 __attribute__((ext_vector_type(8)));
typedef float f32x4 __attribute__((ext_vector_type(4)));
typedef unsigned u32x4 __attribute__((ext_vector_type(4)));
constexpr int BM = 256, BK = 64, HALF = 128, HTB = HALF * BK * 2  , STAGE_BYTES = 8 * HTB, NXCD = 8, WGM = 8;

__host__ __device__ __forceinline__ int lds_byte(int r, int c) { const int st = (r >> 4) * 2 + (c >> 5), rr = r & 15, cc = c & 31, ob = rr * 64 + cc * 2; return st * 1024 + (ob ^ (((ob >> 9) & 1) << 5)); }
__host__ __device__ __forceinline__ void stage_rc(int b, int& R, int& C) { const int st = b / 1024, sb = b % 1024, swz = sb ^ (((sb >> 9) & 1) << 5); R = (st >> 1) * 16 + swz / 64; C = (st & 1) * 32 + (swz % 64) / 2; }
__host__ __device__ __forceinline__ int perm32(int rho) { const int n = rho >> 4, i = rho & 15; return 8 * (i >> 2) + 4 * n + (i & 3); }

struct Unit { int pm, pn; };
struct Gemm { const bf16_t* A; const bf16_t* Bt; int M, N, K; };

struct StaticOrder {
    int nM, nN, nwg, G, c;
    __host__ __device__ void init(int M, int N, int G_, int c_) { nM = M / BM; nN = N / BM; nwg = nM * nN; G = G_; c = c_; }
    __host__ __device__ bool next(int i, Unit& u) const {
        const long L = (long)i * G + c; if (L >= nwg) return false;
        int wgid = (int)L; { const int q = nwg / NXCD, r = nwg % NXCD, xcd = wgid % NXCD, off = wgid / NXCD; wgid = (xcd < r ? xcd * (q + 1) : r * (q + 1) + (xcd - r) * q) + off; }
        const int nig = WGM * nN, gid = wgid / nig, fm = gid * WGM, gsz = (nM - fm) < WGM ? (nM - fm) : WGM;
        u.pm = fm + ((wgid % nig) % gsz); u.pn = (wgid % nig) / gsz; return true;
    }
    __device__ __forceinline__ void a_ready(const Unit&) const {}
    __device__ __forceinline__ void done(const Unit&) const {}
};

__device__ __forceinline__ unsigned cvt_pk_bf16(float lo, float hi) { unsigned r; asm volatile("v_cvt_pk_bf16_f32 %0, %1, %2" : "=v"(r) : "v"(lo), "v"(hi)); return r; }
template <class Epi, class Sched, bool ALIGN_EPI = false, bool SP2 = false>
__device__ __forceinline__ void gemm_phase(PG8_LAS unsigned char* lds, const Gemm g, const Sched& S, const Epi& E) {
    const int tid = threadIdx.x, wid = __builtin_amdgcn_readfirstlane(tid >> 6), lane = tid & 63, wr = wid >> 2, wc = wid & 3, fr = lane & 15, fq = lane >> 4;
    const int K = g.K, nt = K / BK;
    unsigned voffA[2], voffB[2];
#pragma unroll
    for (int i = 0; i < 2; ++i) { int R, C; stage_rc(tid * 16 + i * 8192, R, C); const int Rb = Epi::PERM ? ((R & ~31) + perm32(R & 31)) : R;
        voffA[i] = (unsigned)(R * K + C) * 2u; voffB[i] = (unsigned)(Rb * K + C) * 2u; }
    const size_t kstep = (size_t)(BK * 2);
    const size_t hstep = (size_t)HALF * K * 2;
    const size_t tstep = 2 * hstep;
    const unsigned ldsw = (unsigned)wid * 1024u;
    const int aoff = lds_byte(wr * 64 + fr, fq * 8), boff = lds_byte(wc * 32 + fr, fq * 8);
#define PG8_SA(b, h) (((b) * 2 + (h)) * HTB)
#define PG8_SB(b, h) ((4 + (b) * 2 + (h)) * HTB)
#define PG8_STAGE(bufoff, gbase, voff) do { _Pragma("unroll") for (int _i = 0; _i < 2; ++_i) \
        __builtin_amdgcn_global_load_lds((const unsigned*)((const char*)(gbase) + (voff)[_i]), (PG8_LAS unsigned*)(lds + (bufoff) + ldsw + _i * 8192), 16, 0, 0); } while (0)
#define PG8_LDA(dst, b, h) do { _Pragma("unroll") for (int m = 0; m < 4; ++m) _Pragma("unroll") for (int k = 0; k < 2; ++k) dst[m][k] = *(const PG8_LAS bf16x8*)(lds + PG8_SA(b, h) + aoff + m * 2048 + k * 1024); } while (0)
#define PG8_LDB(dst, b, h) do { _Pragma("unroll") for (int n = 0; n < 2; ++n) _Pragma("unroll") for (int k = 0; k < 2; ++k) dst[n][k] = *(const PG8_LAS bf16x8*)(lds + PG8_SB(b, h) + boff + n * 2048 + k * 1024); } while (0)
#define PG8_MMA(ai, bj, At, Bt) do { __builtin_amdgcn_s_setprio(1); _Pragma("unroll") for (int m = 0; m < 4; ++m) _Pragma("unroll") for (int n = 0; n < 2; ++n) _Pragma("unroll") for (int k = 0; k < 2; ++k) \
        acc[ai][bj][m][n] = __builtin_amdgcn_mfma_f32_16x16x32_bf16(Bt[n][k], At[m][k], acc[ai][bj][m][n], 0, 0, 0); __builtin_amdgcn_s_setprio(0); } while (0)
#define PG8_WAIT_V(n) asm volatile("s_waitcnt vmcnt(" #n ")" ::: "memory")
#define PG8_WAIT_L(n) asm volatile("s_waitcnt lgkmcnt(" #n ")" ::: "memory")
#define PG8_BAR __builtin_amdgcn_s_barrier()
#define PG8_SCHED __builtin_amdgcn_sched_barrier(0)
    Unit cur, nxt; int ui = 0;
    if (!S.next(0, cur)) return;
    f32x4 acc[2][2][4][2];
#pragma unroll
    for (int a = 0; a < 2; ++a)
#pragma unroll
        for (int b = 0; b < 2; ++b)
#pragma unroll
            for (int m = 0; m < 4; ++m)
#pragma unroll
                for (int n = 0; n < 2; ++n) acc[a][b][m][n] = (f32x4){0.f, 0.f, 0.f, 0.f};
    bf16x8 At[4][2], B0[2][2], B1[2][2];
    const char* cA = (const char*)g.A + (size_t)cur.pm * tstep; const char* cB = (const char*)g.Bt + (size_t)cur.pn * tstep;
    S.a_ready(cur);
    if constexpr (SP2) {
        PG8_STAGE(PG8_SB(0, 0), cB, voffB); PG8_STAGE(PG8_SB(0, 1), cB + hstep, voffB); PG8_STAGE(PG8_SA(0, 0), cA, voffA); PG8_STAGE(PG8_SA(0, 1), cA + hstep, voffA);
        if (wr == 1) PG8_BAR;
        PG8_WAIT_V(2); PG8_BAR;
        PG8_STAGE(PG8_SB(1, 0), cB + kstep, voffB); PG8_STAGE(PG8_SA(1, 0), cA + kstep, voffA); PG8_STAGE(PG8_SB(1, 1), cB + hstep + kstep, voffB);
        PG8_WAIT_V(6); PG8_BAR;
    } else {
        PG8_STAGE(PG8_SB(0, 0), cB, voffB); PG8_STAGE(PG8_SA(0, 0), cA, voffA); PG8_STAGE(PG8_SB(0, 1), cB + hstep, voffB); PG8_STAGE(PG8_SA(0, 1), cA + hstep, voffA);
        if (wr == 1) PG8_BAR;
        PG8_WAIT_V(4); PG8_BAR;
        PG8_STAGE(PG8_SB(1, 0), cB + kstep, voffB); PG8_STAGE(PG8_SA(1, 0), cA + kstep, voffA); PG8_STAGE(PG8_SB(1, 1), cB + hstep + kstep, voffB);
        PG8_WAIT_V(6); PG8_BAR;
    }
    for (;;) {
        const bool has_next = S.next(ui + 1, nxt);
        const char* nA = has_next ? (const char*)g.A + (size_t)nxt.pm * tstep : cA; const char* nB = has_next ? (const char*)g.Bt + (size_t)nxt.pn * tstep : cB;
        for (int t = 0; t < nt; t += 2) {
            const bool last = (t == nt - 2);
            const char* a1 = cA + (size_t)(t + 1) * kstep;
            const char* a2 = last ? nA : cA + (size_t)(t + 2) * kstep; const char* b2 = last ? nB : cB + (size_t)(t + 2) * kstep;
            const char* a3 = a2 + kstep; const char* b3 = b2 + kstep;
            if (last && has_next) S.a_ready(nxt);
            if constexpr (SP2) {
            PG8_LDB(B0, 0, 0); PG8_LDB(B1, 0, 1); PG8_SCHED; PG8_LDA(At, 0, 0); PG8_STAGE(PG8_SA(1, 1), a1 + hstep, voffA);
            PG8_WAIT_V(8); PG8_WAIT_L(0); PG8_BAR; PG8_MMA(0, 0, At, B0); PG8_MMA(0, 1, At, B1); PG8_BAR; PG8_SCHED;
            PG8_LDA(At, 0, 1); PG8_STAGE(PG8_SB(0, 0), b2, voffB); PG8_STAGE(PG8_SB(0, 1), b2 + hstep, voffB); PG8_STAGE(PG8_SA(0, 0), a2, voffA);
            PG8_WAIT_V(8); PG8_WAIT_L(0); PG8_BAR; PG8_MMA(1, 0, At, B0); PG8_MMA(1, 1, At, B1); PG8_BAR; PG8_SCHED;
            PG8_LDB(B0, 1, 0); PG8_LDB(B1, 1, 1); PG8_SCHED; PG8_LDA(At, 1, 0); PG8_STAGE(PG8_SA(0, 1), a2 + hstep, voffA);
            PG8_WAIT_V(8); PG8_WAIT_L(0); PG8_BAR; PG8_MMA(0, 0, At, B0); PG8_MMA(0, 1, At, B1); PG8_BAR; PG8_SCHED;
            PG8_LDA(At, 1, 1); PG8_STAGE(PG8_SB(1, 0), b3, voffB); PG8_STAGE(PG8_SB(1, 1), b3 + hstep, voffB); PG8_STAGE(PG8_SA(1, 0), a3, voffA);
            PG8_WAIT_V(8); PG8_WAIT_L(0); PG8_BAR; PG8_MMA(1, 0, At, B0); PG8_MMA(1, 1, At, B1); PG8_BAR; PG8_SCHED;
            } else {
            PG8_LDB(B0, 0, 0); PG8_SCHED; PG8_LDA(At, 0, 0); PG8_STAGE(PG8_SA(1, 1), a1 + hstep, voffA);
            PG8_WAIT_L(8); PG8_BAR; PG8_WAIT_L(0); PG8_MMA(0, 0, At, B0); PG8_BAR; PG8_SCHED;
            PG8_LDB(B1, 0, 1); PG8_STAGE(PG8_SB(0, 0), b2, voffB);
            PG8_BAR; PG8_WAIT_L(0); PG8_MMA(0, 1, At, B1); PG8_BAR;
            PG8_LDA(At, 0, 1); PG8_STAGE(PG8_SA(0, 0), a2, voffA);
            PG8_BAR; PG8_WAIT_L(0); PG8_MMA(1, 0, At, B0); PG8_BAR; PG8_SCHED;
            PG8_STAGE(PG8_SB(0, 1), b2 + hstep, voffB);
            PG8_WAIT_V(6); PG8_BAR; PG8_MMA(1, 1, At, B1); PG8_BAR;
            PG8_LDB(B0, 1, 0); PG8_SCHED; PG8_LDA(At, 1, 0); PG8_STAGE(PG8_SA(0, 1), a2 + hstep, voffA);
            PG8_WAIT_L(8); PG8_BAR; PG8_WAIT_L(0); PG8_MMA(0, 0, At, B0); PG8_BAR; PG8_SCHED;
            PG8_LDB(B1, 1, 1); PG8_STAGE(PG8_SB(1, 0), b3, voffB);
            PG8_BAR; PG8_WAIT_L(0); PG8_MMA(0, 1, At, B1); PG8_BAR;
            PG8_LDA(At, 1, 1); PG8_STAGE(PG8_SA(1, 0), a3, voffA);
            PG8_BAR; PG8_WAIT_L(0); PG8_MMA(1, 0, At, B0); PG8_BAR; PG8_SCHED;
            PG8_STAGE(PG8_SB(1, 1), b3 + hstep, voffB);
            PG8_WAIT_V(6); PG8_BAR; PG8_MMA(1, 1, At, B1); PG8_BAR;
            }
        }
        if constexpr (ALIGN_EPI) { if (wr == 0) PG8_BAR; }
        if constexpr (!Epi::AFTER_DRAIN) { E(acc, cur, wr, wc, fr, fq); S.done(cur); }
        if (!has_next) break;
#pragma unroll
        for (int a = 0; a < 2; ++a)
#pragma unroll
            for (int b = 0; b < 2; ++b)
#pragma unroll
                for (int m = 0; m < 4; ++m)
#pragma unroll
                    for (int n = 0; n < 2; ++n) acc[a][b][m][n] = (f32x4){0.f, 0.f, 0.f, 0.f};
        cur = nxt; cA = nA; cB = nB; ++ui;
        if constexpr (ALIGN_EPI) { if (wr == 1) PG8_BAR; }
    }
    PG8_WAIT_V(0);
    if constexpr (!ALIGN_EPI) { if (wr == 0) PG8_BAR; }
    PG8_BAR;
    if constexpr (Epi::AFTER_DRAIN) { E.fused(acc, cur, wr, wc, fr, fq, lds, wid, lane); S.done(cur); }
#undef PG8_SA
#undef PG8_SB
#undef PG8_STAGE
#undef PG8_LDA
#undef PG8_LDB
#undef PG8_MMA
#undef PG8_WAIT_V
#undef PG8_WAIT_L
#undef PG8_BAR
#undef PG8_SCHED
}
}

#define GAS __attribute__((address_space(1)))
#define LAS __attribute__((address_space(3)))
typedef unsigned short bf16;
typedef unsigned v4u __attribute__((ext_vector_type(4)));
typedef float f32x4 __attribute__((ext_vector_type(4)));
typedef short bf16x8 __attribute__((ext_vector_type(8)));
typedef GAS unsigned gu32;
typedef GAS unsigned long long gu64;
#define RLX_AGENT __ATOMIC_RELAXED, __HIP_MEMORY_SCOPE_AGENT
#define LDS_WAIT() asm volatile("s_waitcnt lgkmcnt(0)" ::: "memory")
#define VM_WAIT() asm volatile("s_waitcnt vmcnt(0)" ::: "memory")
__device__ __forceinline__ unsigned long long rt() { return __builtin_amdgcn_s_memrealtime(); }
__device__ __forceinline__ unsigned f2bf(float f) { unsigned u = __builtin_bit_cast(unsigned, f); return (u + 0x7fffu + ((u >> 16) & 1u)) >> 16; }
__device__ __forceinline__ unsigned pk2(float lo, float hi) { return f2bf(lo) | (f2bf(hi) << 16); }

#define XB_TMO      128
#define XB_XCNT(j)  (256  + 64 * (j))
#define XB_XSUB(j)  (1280 + 64 * (j))
#define XB_XGEN(j)  (2304 + 64 * (j))
#define XB_TOP      3328
#define XB_TOPGEN   3392
#define XCD_BAR_WORDS 3456
#define XB_SPIN_CAP (1u << 18)

__device__ __forceinline__ unsigned xb_ld(unsigned* p)              { return __hip_atomic_load(p, __ATOMIC_RELAXED, __HIP_MEMORY_SCOPE_AGENT); }
__device__ __forceinline__ unsigned xb_add(unsigned* p, unsigned v) { return __hip_atomic_fetch_add(p, v, __ATOMIC_RELAXED, __HIP_MEMORY_SCOPE_AGENT); }
__device__ __forceinline__ unsigned xb_xcc_id() { return (unsigned)__builtin_amdgcn_s_getreg((3 << 11) | 20) & 0xFu; }
#define XB_SPIN(cond, bar) do { unsigned _sp = 0; while (cond) { __builtin_amdgcn_s_sleep(1); \
    if ((++_sp & 255u) == 0u) { if (xb_ld(&(bar)[XB_TMO])) break; if (_sp > XB_SPIN_CAP) { atomicAdd(&(bar)[XB_TMO], 1u); break; } } } } while (0)

struct XcdBarrier {
    unsigned* bar; unsigned x;
    volatile LAS unsigned* st;
};

__device__ __forceinline__ XcdBarrier xcd_barrier_post(unsigned* bar, volatile LAS unsigned* st) {
    XcdBarrier b; b.bar = bar; b.x = xb_xcc_id(); b.st = st;
    if (threadIdx.x == 0) (void)xb_add(&bar[XB_XCNT(b.x)], 1u);
    return b;
}
__device__ __forceinline__ void xcd_barrier_complete(unsigned* bar, unsigned x, unsigned& nloc, unsigned& nx) {
    const unsigned G = gridDim.x * gridDim.y * gridDim.z;
    unsigned sum, cnt, mine, sp = 0u;
    for (;;) {
        sum = 0u; cnt = 0u; mine = 0u;
#pragma unroll
        for (unsigned j = 0; j < 16; ++j) { const unsigned c = xb_ld(&bar[XB_XCNT(j)]); sum += c; cnt += (c > 0u) ? 1u : 0u; mine = (j == x) ? c : mine; }
        if (sum == G) break;
        __builtin_amdgcn_s_sleep(1);
        if ((++sp & 255u) == 0u) { if (xb_ld(&bar[XB_TMO])) break; if (sp > XB_SPIN_CAP) { atomicAdd(&bar[XB_TMO], 1u); break; } }
    }
    nloc = mine > 0u ? mine : 1u; nx = cnt > 0u ? cnt : 1u;
}

__device__ __forceinline__ void xcd_barrier(const XcdBarrier& b) {
    asm volatile("s_waitcnt vmcnt(0)" ::: "memory");
    __syncthreads();
    if (threadIdx.x == 0) {
        unsigned* bar = b.bar;
        __builtin_amdgcn_s_waitcnt(0);
        unsigned nloc = b.st[0], nx = b.st[1];
        if (nloc == 0u) { xcd_barrier_complete(bar, b.x, nloc, nx); b.st[0] = nloc; b.st[1] = nx; }
        const unsigned old = xb_add(&bar[XB_XSUB(b.x)], 1u);
        const unsigned gen = old / nloc;
        if (old + 1u == (gen + 1u) * nloc) {
            __builtin_amdgcn_fence(__ATOMIC_RELEASE, "agent");
            asm volatile("s_waitcnt vmcnt(0)" ::: "memory");
            const unsigned og = xb_add(&bar[XB_TOP], 1u);
            const unsigned tg = og / nx;
            if (og + 1u == (tg + 1u) * nx) xb_add(&bar[XB_TOPGEN], 1u);
            else XB_SPIN(xb_ld(&bar[XB_TOPGEN]) == tg, bar);
            __builtin_amdgcn_fence(__ATOMIC_ACQUIRE, "agent");
            xb_add(&bar[XB_XGEN(b.x)], 1u);
            asm volatile("s_waitcnt vmcnt(0)" ::: "memory");
        } else {
            XB_SPIN(xb_ld(&bar[XB_XGEN(b.x)]) == gen, bar);
            __builtin_amdgcn_fence(__ATOMIC_ACQUIRE, "agent");
            asm volatile("s_waitcnt vmcnt(0)" ::: "memory");
        }
    }
    __syncthreads();
}

constexpr int NWAVES = 8;
constexpr int M = 32768, D = 1024, SEQ = 4096, NPROJ = 2048, NQ = 2048, PLED = 256, NEXP = 16384;
constexpr float EPS = 1e-6f;
#ifndef MK_PER_PHASE
#define MK_PER_PHASE 0
#endif
#ifndef PROBE_REP
#define PROBE_REP 0
#endif
#define REPS(k) ((PROBE_REP == (k)) ? 2 : 1)
constexpr int NPHASES = 10;

constexpr size_t MiB = 1u << 20;
constexpr size_t WS_CTL = 0, CTL_ZERO_BYTES = 1 * MiB;
constexpr size_t WS_WIN = 2 * MiB, WS_WO = 6 * MiB, WS_WQ = 8 * MiB, WS_WG = 12 * MiB, WS_WP = 14 * MiB, WS_KEYS = 14 * MiB + 512 * 1024;
constexpr size_t WS_WF = 15 * MiB;
constexpr size_t WS_RSX = 17 * MiB, WS_RS2 = 17 * MiB + 512 * 1024, WS_RS1 = 18 * MiB, WS_RS3 = 20 * MiB;
constexpr size_t WS_SU = 22 * MiB, WS_SV = 22 * MiB + 65536;
constexpr size_t WS_U = 24 * MiB, WS_V = 56 * MiB;
constexpr size_t WS_XB = 88 * MiB;
constexpr size_t WS_PROJ = 152 * MiB;
constexpr size_t WS_MIX = 280 * MiB;
constexpr size_t WS_HB = 344 * MiB;
constexpr size_t WS_EIDX = 408 * MiB, WS_GATE = 424 * MiB;
constexpr size_t WS_PB = 440 * MiB;
constexpr size_t WS_END = 456 * MiB;
constexpr int CW_BAR = 4096;
static_assert((CW_BAR + XCD_BAR_WORDS) * 4 <= (int)CTL_ZERO_BYTES, "CTL words inside the memset region");

constexpr int RING_BYTES = 131072;
constexpr int LDSCTL_OFF = RING_BYTES, MISC_OFF = LDSCTL_OFF + 320;
constexpr int LDS_BYTES = 147456;

typedef float f32x16 __attribute__((ext_vector_type(16)));
typedef _Float16 h2_t __attribute__((ext_vector_type(2)));
typedef float f32x2 __attribute__((ext_vector_type(2)));
typedef int i32x4 __attribute__((ext_vector_type(4)));

__device__ __forceinline__ float wave_sum(float v) {
#pragma unroll
    for (int o = 1; o < 64; o <<= 1) v += __shfl_xor(v, o);
    return v;
}
__device__ __forceinline__ float bf_lo(unsigned w) { return __uint_as_float(w << 16); }
__device__ __forceinline__ float bf_hi(unsigned w) { return __uint_as_float(w & 0xffff0000u); }
__device__ __forceinline__ unsigned pkh(float lo, float hi) { f32x2 v = {lo, hi}; h2_t h = __builtin_convertvector(v, h2_t); return __builtin_bit_cast(unsigned, h); }

struct EpiBf16Row {
    static constexpr bool PERM = true, AFTER_DRAIN = false;
    pg8::bf16_t* O; int ldc; const float* rowss;
    __device__ __forceinline__ void operator()(const pg8::f32x4 (&acc)[2][2][4][2], const pg8::Unit& u, int wr, int wc, int fr, int fq) const {
        const int row0 = u.pm * 256 + wr * 64 + fr, col0 = u.pn * 256 + wc * 32 + 8 * fq;
#pragma unroll
        for (int ai = 0; ai < 2; ++ai)
#pragma unroll
            for (int m = 0; m < 4; ++m) {
                const int row = row0 + ai * 128 + m * 16;
                const float sc = rowss ? __builtin_amdgcn_rsqf(rowss[row] * (1.0f / 1024.0f) + EPS) : 1.0f;
                pg8::bf16_t* rowp = O + (size_t)row * ldc + col0;
#pragma unroll
                for (int bj = 0; bj < 2; ++bj) {
                    const pg8::f32x4 v0 = acc[ai][bj][m][0] * sc, v1 = acc[ai][bj][m][1] * sc;
                    pg8::u32x4 w; w.x = pg8::cvt_pk_bf16(v0[0], v0[1]); w.y = pg8::cvt_pk_bf16(v0[2], v0[3]); w.z = pg8::cvt_pk_bf16(v1[0], v1[1]); w.w = pg8::cvt_pk_bf16(v1[2], v1[3]);
                    *(pg8::u32x4*)(rowp + bj * 128) = w;
                }
            }
    }
};
struct EpiH1 {
    static constexpr bool PERM = true, AFTER_DRAIN = false;
    const float* X; float* H; pg8::bf16_t* HB; float* RS;
    __device__ __forceinline__ void operator()(const pg8::f32x4 (&acc)[2][2][4][2], const pg8::Unit& u, int wr, int wc, int fr, int fq) const {
        const int row0 = u.pm * 256 + wr * 64 + fr, col0 = u.pn * 256 + wc * 32 + 8 * fq;
#pragma unroll
        for (int ai = 0; ai < 2; ++ai)
#pragma unroll
            for (int m = 0; m < 4; ++m) {
                const int row = row0 + ai * 128 + m * 16; float s = 0.f;
#pragma unroll
                for (int bj = 0; bj < 2; ++bj) {
                    const size_t off = (size_t)row * 1024 + col0 + bj * 128;
                    const pg8::f32x4 x0 = *(const pg8::f32x4*)(X + off), x1 = *(const pg8::f32x4*)(X + off + 4);
                    const pg8::f32x4 v0 = acc[ai][bj][m][0] + x0, v1 = acc[ai][bj][m][1] + x1;
                    *(pg8::f32x4*)(H + off) = v0; *(pg8::f32x4*)(H + off + 4) = v1;
                    pg8::u32x4 w; w.x = pg8::cvt_pk_bf16(v0[0], v0[1]); w.y = pg8::cvt_pk_bf16(v0[2], v0[3]); w.z = pg8::cvt_pk_bf16(v1[0], v1[1]); w.w = pg8::cvt_pk_bf16(v1[2], v1[3]);
                    *(pg8::u32x4*)(HB + off) = w;
                    s += (v0[0] * v0[0] + v0[1] * v0[1]) + (v0[2] * v0[2] + v0[3] * v0[3]) + (v1[0] * v1[0] + v1[1] * v1[1]) + (v1[2] * v1[2] + v1[3] * v1[3]);
                }
                s += __shfl_xor(s, 16); s += __shfl_xor(s, 32);
                if (fq == 0) RS[(size_t)row * 16 + u.pn * 4 + wc] = s;
            }
    }
};
struct EpiGate {
    static constexpr bool PERM = true, AFTER_DRAIN = false;
    float* H; const pg8::bf16_t* PL; const float* RS2; float* RS3;
    __device__ __forceinline__ void operator()(const pg8::f32x4 (&acc)[2][2][4][2], const pg8::Unit& u, int wr, int wc, int fr, int fq) const {
        const int row0 = u.pm * 256 + wr * 64 + fr, col0 = u.pn * 256 + wc * 32 + 8 * fq;
#pragma unroll
        for (int ai = 0; ai < 2; ++ai)
#pragma unroll
            for (int m = 0; m < 4; ++m) {
                const int row = row0 + ai * 128 + m * 16; float s = 0.f;
                const float rstd = __builtin_amdgcn_rsqf(RS2[row] * (1.0f / 1024.0f) + EPS);
#pragma unroll
                for (int bj = 0; bj < 2; ++bj) {
                    const size_t off = (size_t)row * 1024 + col0 + bj * 128;
                    const pg8::u32x4 w = *(const pg8::u32x4*)(PL + off);
                    const pg8::f32x4 h0 = *(const pg8::f32x4*)(H + off), h1 = *(const pg8::f32x4*)(H + off + 4);
                    const pg8::f32x4 a0 = acc[ai][bj][m][0] * rstd, a1 = acc[ai][bj][m][1] * rstd;
                    pg8::f32x4 g0, g1;
#pragma unroll
                    for (int e = 0; e < 4; ++e) { g0[e] = 1.0f / (1.0f + __expf(-a0[e])); g1[e] = 1.0f / (1.0f + __expf(-a1[e])); }
                    const pg8::f32x4 p0 = {bf_lo(w.x), bf_hi(w.x), bf_lo(w.y), bf_hi(w.y)}, p1 = {bf_lo(w.z), bf_hi(w.z), bf_lo(w.w), bf_hi(w.w)};
#ifdef DBG_NO_PLE
                    const pg8::f32x4 v0 = h0, v1 = h1;
#else
                    const pg8::f32x4 v0 = h0 + g0 * p0, v1 = h1 + g1 * p1;
#endif
                    *(pg8::f32x4*)(H + off) = v0; *(pg8::f32x4*)(H + off + 4) = v1;
                    s += (v0[0] * v0[0] + v0[1] * v0[1]) + (v0[2] * v0[2] + v0[3] * v0[3]) + (v1[0] * v1[0] + v1[1] * v1[1]) + (v1[2] * v1[2] + v1[3] * v1[3]);
                }
                s += __shfl_xor(s, 16); s += __shfl_xor(s, 32);
                if (fq == 0) RS3[(size_t)row * 16 + u.pn * 4 + wc] = s;
            }
    }
};

__device__ __forceinline__ void p0_transpose_item(const float* W, int ldn, const float* gk, int K, bf16* WT, int row_off, int nblk, LAS float* scr, int item, int lane) {
    const int kb = item / nblk, nb = item % nblk, k0 = 64 * kb, n0 = 32 * nb;
#pragma unroll 8
    for (int i = 0; i < 32; ++i) { const int kk = 2 * i + (lane >> 5); float v = W[(size_t)(k0 + kk) * ldn + n0 + (lane & 31)]; if (gk) v *= gk[k0 + kk]; scr[kk * 33 + (lane & 31)] = v; }
    LDS_WAIT(); asm volatile("" ::: "memory");
    const int c = lane & 7;
#pragma unroll
    for (int j = 0; j < 4; ++j) { const int n = (lane >> 3) + 8 * j; const LAS float* s = scr + (8 * c) * 33 + n;
        v4u o; o.x = pk2(s[0 * 33], s[1 * 33]); o.y = pk2(s[2 * 33], s[3 * 33]); o.z = pk2(s[4 * 33], s[5 * 33]); o.w = pk2(s[6 * 33], s[7 * 33]);
        *(GAS v4u*)(WT + (size_t)(row_off + n0 + n) * K + k0 + 8 * c) = o; }
    LDS_WAIT(); asm volatile("" ::: "memory");
}

struct Ptrs {
    const float *x, *p, *g_mix, *w_in, *conv_w, *pool_w, *pool_scale, *w_o, *g_ffn, *w_q, *sub_keys, *eu, *ev, *g_ple, *w_gate, *w_proj, *g_final;
    float* out; unsigned char* ws;
};

__device__ __forceinline__ void p0a_phase(const Ptrs& P, LAS unsigned char* lds, int vcu, int G, int tid, int wave, int lane) {
    const int gw = vcu * NWAVES + wave, NGW = G * NWAVES;
    const int gt = vcu * (NWAVES * 64) + tid, NGT = G * NWAVES * 64;
    { float* Wf = (float*)(P.ws + WS_WF);
      for (int tk = gw; tk < 8192; tk += NGW) {
          const int k = tk >> 3, j = tk & 7, g = j >> 1, np = j * 64 + lane, d = np & 127;
          const float* wi = P.w_in + (size_t)k * 2048 + 1536 + g * 128; const float* pw = P.pool_w + (size_t)g * 128 * 128 + d;
          float a = 0.f;
#pragma unroll 8
          for (int c = 0; c < 128; ++c) a += wi[c] * pw[(size_t)c * 128];
          Wf[(size_t)k * 512 + np] = a * P.pool_scale[np];
      } }
    { LAS float* scr = (LAS float*)(lds + wave * 16384);
      constexpr int I_WO = 16 * 32, I_WQ = 16 * 64, I_WG = 16 * 32, I_WP = 4 * 32, I_WINA = 16 * 48;
      constexpr int NITEMS = I_WO + I_WQ + I_WG + I_WP + I_WINA;
      for (int it = gw; it < NITEMS; it += NGW) {
          int r = it;
          if (r < I_WO) { p0_transpose_item(P.w_o, 1024, nullptr, 1024, (bf16*)(P.ws + WS_WO), 0, 32, scr, r, lane); continue; } r -= I_WO;
          if (r < I_WQ) { p0_transpose_item(P.w_q, 2048, P.g_ffn, 1024, (bf16*)(P.ws + WS_WQ), 0, 64, scr, r, lane); continue; } r -= I_WQ;
          if (r < I_WG) { p0_transpose_item(P.w_gate, 1024, P.g_ple, 1024, (bf16*)(P.ws + WS_WG), 0, 32, scr, r, lane); continue; } r -= I_WG;
          if (r < I_WP) { p0_transpose_item(P.w_proj, 1024, nullptr, 256, (bf16*)(P.ws + WS_WP), 0, 32, scr, r, lane); continue; } r -= I_WP;
          p0_transpose_item(P.w_in, 2048, P.g_mix, 1024, (bf16*)(P.ws + WS_WIN), 0, 48, scr, r, lane);
      } }
    { const GAS f32x4* gf = (const GAS f32x4*)P.g_ffn + 4 * lane; f32x4 gq[4];
#pragma unroll
      for (int j = 0; j < 4; ++j) gq[j] = gf[j];
      for (int r = gw; r < 2 * NEXP; r += NGW) {
          const int tb = r >> 14, e = r & (NEXP - 1);
          const GAS f32x4* src = (const GAS f32x4*)((tb ? P.ev : P.eu) + (size_t)e * 1024) + 4 * lane;
          f32x4 a[4]; float m = 0.f;
#pragma unroll
          for (int j = 0; j < 4; ++j) { a[j] = src[j]; if (!tb) a[j] = a[j] * gq[j];
              m = fmaxf(fmaxf(fmaxf(m, fabsf(a[j].x)), fmaxf(fabsf(a[j].y), fabsf(a[j].z))), fabsf(a[j].w)); }
#pragma unroll
          for (int o = 1; o < 64; o <<= 1) m = fmaxf(m, __shfl_xor(m, o));
          const float sc = m > 0.f ? 400.0f / m : 0.f;
          v4u o; int w;
          w = __builtin_amdgcn_cvt_pk_fp8_f32(a[0].x * sc, a[0].y * sc, 0, false); w = __builtin_amdgcn_cvt_pk_fp8_f32(a[0].z * sc, a[0].w * sc, w, true); o.x = (unsigned)w;
          w = __builtin_amdgcn_cvt_pk_fp8_f32(a[1].x * sc, a[1].y * sc, 0, false); w = __builtin_amdgcn_cvt_pk_fp8_f32(a[1].z * sc, a[1].w * sc, w, true); o.y = (unsigned)w;
          w = __builtin_amdgcn_cvt_pk_fp8_f32(a[2].x * sc, a[2].y * sc, 0, false); w = __builtin_amdgcn_cvt_pk_fp8_f32(a[2].z * sc, a[2].w * sc, w, true); o.z = (unsigned)w;
          w = __builtin_amdgcn_cvt_pk_fp8_f32(a[3].x * sc, a[3].y * sc, 0, false); w = __builtin_amdgcn_cvt_pk_fp8_f32(a[3].z * sc, a[3].w * sc, w, true); o.w = (unsigned)w;
          ((GAS v4u*)(P.ws + (tb ? WS_V : WS_U)))[(size_t)e * 64 + lane] = o;
          if (lane == 0) ((float*)(P.ws + (tb ? WS_SV : WS_SU)))[e] = m * (1.0f / 400.0f);
      } }
    { const GAS f32x4* sp = (const GAS f32x4*)P.p; GAS v4u* dp = (GAS v4u*)(P.ws + WS_PB);
      for (int i = gt; i < M * PLED / 8; i += NGT) { const f32x4 a = sp[2 * (size_t)i], b = sp[2 * (size_t)i + 1]; v4u o; o.x = pk2(a.x, a.y); o.y = pk2(a.z, a.w); o.z = pk2(b.x, b.y); o.w = pk2(b.z, b.w); dp[i] = o; }
      const GAS f32x4* sk = (const GAS f32x4*)P.sub_keys; GAS v4u* dk = (GAS v4u*)(P.ws + WS_KEYS);
      for (int i = gt; i < 16 * 128 * 128 / 8; i += NGT) { const f32x4 a = sk[2 * (size_t)i], b = sk[2 * (size_t)i + 1]; v4u o; o.x = pk2(a.x, a.y); o.y = pk2(a.z, a.w); o.z = pk2(b.x, b.y); o.w = pk2(b.z, b.w); dk[i] = o; } }
    { float* RSX = (float*)(P.ws + WS_RSX); bf16* XB = (bf16*)(P.ws + WS_XB);
      for (int m = gw; m < M; m += NGW) {
          const GAS f32x4* xr = (const GAS f32x4*)(P.x + (size_t)m * D) + lane; f32x4 v[4]; float s = 0.f;
#pragma unroll
          for (int j = 0; j < 4; ++j) { v[j] = xr[64 * j]; s += (v[j].x * v[j].x + v[j].y * v[j].y) + (v[j].z * v[j].z + v[j].w * v[j].w); }
          s = wave_sum(s); if (lane == 0) RSX[m] = s;
          GAS unsigned long long* o8 = (GAS unsigned long long*)(XB + (size_t)m * D) + lane;
#pragma unroll
          for (int j = 0; j < 4; ++j) o8[64 * j] = (unsigned long long)pk2(v[j].x, v[j].y) | ((unsigned long long)pk2(v[j].z, v[j].w) << 32);
      } }
}
__device__ __forceinline__ void p0b_phase(const Ptrs& P, LAS unsigned char* lds, int vcu, int G, int wave, int lane) {
    const int gw = vcu * NWAVES + wave, NGW = G * NWAVES; LAS float* scr = (LAS float*)(lds + wave * 16384);
    for (int it = gw; it < 16 * 16; it += NGW) p0_transpose_item((const float*)(P.ws + WS_WF), 512, P.g_mix, 1024, (bf16*)(P.ws + WS_WIN), 1536, 16, scr, it, lane);
}

__device__ __forceinline__ void p2_phase(const Ptrs& P, int vcu, int G, int tid) {
    const unsigned* PR = (const unsigned*)(P.ws + WS_PROJ);
    unsigned* MX = (unsigned*)(P.ws + WS_MIX);
    constexpr int TC = 32;
    for (int ck = vcu; ck < M / TC; ck += G) {
        const int t0 = ck * TC, s0 = t0 & (SEQ - 1);
        if (tid < 256) {
            const int half = 1 << (tid >> 6);
            const unsigned* col = PR + 768 + tid;
            float S0 = 0.f, S1 = 0.f;
            { const int lo = (s0 - half) > 0 ? (s0 - half) : 0, hi = (s0 + half) < SEQ ? (s0 + half) : SEQ;
              for (int s = lo; s < hi; ++s) { const unsigned w = col[(size_t)(t0 + s - s0) * 1024]; S0 += bf_lo(w); S1 += bf_hi(w); } }
#pragma unroll 4
            for (int i = 0; i < TC; ++i) {
                const int s = s0 + i, t = t0 + i;
                const int lo = (s - half) > 0 ? (s - half) : 0, hi = (s + half) < SEQ ? (s + half) : SEQ;
                const float inv = 1.0f / (float)(hi - lo);
                const unsigned wc = col[(size_t)t * 1024];
                const float o0 = S0 * inv - bf_lo(wc), o1 = S1 * inv - bf_hi(wc);
                MX[(size_t)t * 512 + 256 + tid] = pk2(o0, o1);
                if (s + half < SEQ) { const unsigned w = col[(size_t)(t + half) * 1024]; S0 += bf_lo(w); S1 += bf_hi(w); }
                if (s - half >= 0) { const unsigned w = col[(size_t)(t - half) * 1024]; S0 -= bf_lo(w); S1 -= bf_hi(w); }
            }
        } else {
            const int cp = tid - 256;
            const unsigned* bcol = PR + cp; const unsigned* ccol = PR + 256 + cp; const unsigned* vcol = PR + 512 + cp;
            const float w00 = P.conv_w[2 * cp], w01 = P.conv_w[2 * cp + 1], w10 = P.conv_w[512 + 2 * cp], w11 = P.conv_w[512 + 2 * cp + 1], w20 = P.conv_w[1024 + 2 * cp], w21 = P.conv_w[1024 + 2 * cp + 1];
            float zp0 = 0.f, zp1 = 0.f, zc0, zc1;
            if (s0 > 0) { const unsigned c = ccol[(size_t)(t0 - 1) * 1024], v = vcol[(size_t)(t0 - 1) * 1024]; zp0 = bf_lo(c) * bf_lo(v); zp1 = bf_hi(c) * bf_hi(v); }
            { const unsigned c = ccol[(size_t)t0 * 1024], v = vcol[(size_t)t0 * 1024]; zc0 = bf_lo(c) * bf_lo(v); zc1 = bf_hi(c) * bf_hi(v); }
#pragma unroll 4
            for (int i = 0; i < TC; ++i) {
                const int s = s0 + i, t = t0 + i;
                float zn0 = 0.f, zn1 = 0.f;
                if (s + 1 < SEQ) { const unsigned c = ccol[(size_t)(t + 1) * 1024], v = vcol[(size_t)(t + 1) * 1024]; zn0 = bf_lo(c) * bf_lo(v); zn1 = bf_hi(c) * bf_hi(v); }
                const unsigned b = bcol[(size_t)t * 1024];
                const float y0 = w00 * zp0 + w10 * zc0 + w20 * zn0, y1 = w01 * zp1 + w11 * zc1 + w21 * zn1;
                MX[(size_t)t * 512 + cp] = pk2(bf_lo(b) * y0, bf_hi(b) * y1);
                zp0 = zc0; zp1 = zc1; zc0 = zn0; zc1 = zn1;
            }
        }
    }
}

__device__ __forceinline__ float fmax_s(float a, float b) { float r; asm("v_max_f32_e32 %0, %1, %2" : "=v"(r) : "v"(a), "v"(b)); return r; }
__device__ __forceinline__ float fmin_s(float a, float b) { float r; asm("v_min_f32_e32 %0, %1, %2" : "=v"(r) : "v"(a), "v"(b)); return r; }
#define CE_DESC(a, b) do { const float _t = fmax_s(a, b); b = fmin_s(a, b); a = _t; } while (0)
#define CE_ASC(a, b)  do { const float _t = fmin_s(a, b); b = fmax_s(a, b); a = _t; } while (0)
__device__ __forceinline__ void sort16_desc(float* a) {
#pragma unroll
    for (int k = 2; k <= 16; k <<= 1)
#pragma unroll
        for (int j = k >> 1; j > 0; j >>= 1)
#pragma unroll
            for (int i = 0; i < 16; ++i) { const int l = i ^ j; if (l > i) { if ((i & k) == 0) CE_DESC(a[i], a[l]); else CE_ASC(a[i], a[l]); } }
}
__device__ __forceinline__ void merge16_desc(float* a) {
#pragma unroll
    for (int j = 8; j > 0; j >>= 1)
#pragma unroll
        for (int i = 0; i < 16; ++i) { const int l = i ^ j; if (l > i) CE_DESC(a[i], a[l]); }
}
__device__ __forceinline__ void top16_merge(float* a, const float* b) {
#pragma unroll
    for (int i = 0; i < 16; ++i) a[i] = fmax_s(a[i], b[15 - i]);
    merge16_desc(a);
}
__device__ __forceinline__ void top16_of_64(float* v) {
    sort16_desc(v); sort16_desc(v + 16); sort16_desc(v + 32); sort16_desc(v + 48);
    top16_merge(v, v + 16); top16_merge(v + 32, v + 48); top16_merge(v, v + 32);
}
__device__ __forceinline__ unsigned key_lookup(unsigned long long lo, unsigned long long hi, unsigned i) {
    const unsigned long long v = (i & 8u) ? hi : lo;
    return (unsigned)(v >> ((i & 7u) * 8u)) & 0x7fu;
}

constexpr int KROW = 272;
__device__ __forceinline__ void score_phase(const Ptrs& P, LAS unsigned char* lds, int bid, int G, int tid, int wave, int lane) {
    const bf16* Q = (const bf16*)(P.ws + WS_PROJ); const bf16* KEYS = (const bf16*)(P.ws + WS_KEYS); const float* RS1 = (const float*)(P.ws + WS_RS1);
    int* EIDX = (int*)(P.ws + WS_EIDX); float* GATE = (float*)(P.ws + WS_GATE);
    const int l31 = lane & 31, hi = lane >> 5;
    int cur_h = -1;
    for (int u = bid; u < (M / 256) * 8; u += G) {
        const int h = u & 7, tile = u >> 3;
        if (h != cur_h) {
            __syncthreads();
#pragma unroll
            for (int i = 0; i < 8; ++i) { const int q = tid + 512 * i, row = q >> 4, ch = q & 15;
                const v4u val = *(const GAS v4u*)(KEYS + ((size_t)(h * 256 + row)) * 128 + ch * 8);
                *(LAS v4u*)(lds + row * KROW + ch * 16) = val; }
            __syncthreads();
            cur_h = h;
        }
        const int tok = tile * 256 + wave * 32 + l31;
        float T0[16], T1[16];
#pragma unroll
        for (int p = 0; p < 2; ++p) {
            f32x16 acc[4];
#pragma unroll
            for (int kb = 0; kb < 4; ++kb)
#pragma unroll
                for (int r = 0; r < 16; ++r) acc[kb][r] = 0.f;
            const bf16* qp = Q + (size_t)tok * 2048 + h * 256 + p * 128 + hi * 8;
            bf16x8 bq[8];
#pragma unroll
            for (int ks = 0; ks < 8; ++ks) bq[ks] = *(const GAS bf16x8*)(qp + ks * 16);
#pragma unroll
            for (int ks = 0; ks < 8; ++ks)
#pragma unroll
                for (int kb = 0; kb < 4; ++kb) {
                    const bf16x8 ak = *(const LAS bf16x8*)(lds + (p * 128 + kb * 32 + l31) * KROW + (ks * 16 + hi * 8) * 2);
                    acc[kb] = __builtin_amdgcn_mfma_f32_32x32x16_bf16(ak, bq[ks], acc[kb], 0, 0, 0);
                }
            float v[64];
#pragma unroll
            for (int kb = 0; kb < 4; ++kb)
#pragma unroll
                for (int r = 0; r < 16; ++r) v[kb * 16 + r] = __uint_as_float((__float_as_uint(acc[kb][r]) & 0xffffff80u) | (unsigned)(kb * 32 + (r & 3) + 8 * (r >> 2)));
            top16_of_64(v);
            const unsigned hb = (unsigned)hi << 2;
#pragma unroll
            for (int i = 0; i < 16; ++i) v[i] = __uint_as_float(__float_as_uint(v[i]) | hb);
            float c[16];
#pragma unroll
            for (int i = 0; i < 16; ++i) c[i] = fmax_s(v[i], __shfl_xor(v[15 - i], 32));
            merge16_desc(c);
#pragma unroll
            for (int i = 0; i < 16; ++i) { if (p == 0) T0[i] = c[i]; else T1[i] = c[i]; }
        }
        float f0[16], f1[16];
        unsigned long long K0lo = 0ull, K0hi = 0ull, K1lo = 0ull, K1hi = 0ull;
#pragma unroll
        for (int b = 0; b < 8; ++b) {
            K0lo |= (unsigned long long)(__float_as_uint(T0[b]) & 0x7fu) << (8 * b); K0hi |= (unsigned long long)(__float_as_uint(T0[8 + b]) & 0x7fu) << (8 * b);
            K1lo |= (unsigned long long)(__float_as_uint(T1[b]) & 0x7fu) << (8 * b); K1hi |= (unsigned long long)(__float_as_uint(T1[8 + b]) & 0x7fu) << (8 * b);
        }
#pragma unroll
        for (int i = 0; i < 16; ++i) { f0[i] = __uint_as_float(__float_as_uint(T0[i]) & 0xffffff80u); f1[i] = __uint_as_float(__float_as_uint(T1[i]) & 0xffffff80u); }
        float cd[64]; int n = 0;
#pragma unroll
        for (int i = 0; i < 16; ++i)
#pragma unroll
            for (int j = 0; j < 16; ++j)
                if ((i + 1) * (j + 1) <= 16) { cd[n] = __uint_as_float((__float_as_uint(f0[i] + f1[j]) & 0xffffff00u) | (unsigned)(i * 16 + j)); ++n; }
#pragma unroll
        for (int q = 50; q < 64; ++q) cd[q] = __uint_as_float(0xff800000u);
        top16_of_64(cd);
        float rs = 0.f;
        { const GAS f32x4* rp = (const GAS f32x4*)(RS1 + (size_t)tok * 16);
#pragma unroll
          for (int i = 0; i < 4; ++i) { const f32x4 a = rp[i]; rs += (a.x + a.y) + (a.z + a.w); } }
        const float rstd = __builtin_amdgcn_rsqf(rs * (1.0f / 1024.0f) + EPS);
        int eidx[16]; float gt_[16]; float z0 = 0.f, sum = 0.f;
#pragma unroll
        for (int k = 0; k < 16; ++k) {
            const unsigned wb = __float_as_uint(cd[k]); const unsigned i = (wb >> 4) & 15u, j = wb & 15u;
            eidx[k] = (int)(key_lookup(K0lo, K0hi, i) * 128u + key_lookup(K1lo, K1hi, j));
            const float z = __uint_as_float(wb & 0xffffff00u) * rstd;
            if (k == 0) z0 = z;
            gt_[k] = __expf(z - z0); sum += gt_[k];
        }
        const float inv = 1.0f / sum;
        if (hi == 0) { GAS i32x4* ep = (GAS i32x4*)(EIDX + (size_t)tok * 128 + h * 16);
#pragma unroll
            for (int q = 0; q < 4; ++q) ep[q] = (i32x4){eidx[4 * q], eidx[4 * q + 1], eidx[4 * q + 2], eidx[4 * q + 3]};
        } else { GAS f32x4* gp = (GAS f32x4*)(GATE + (size_t)tok * 128 + h * 16);
#pragma unroll
            for (int q = 0; q < 4; ++q) gp[q] = (f32x4){gt_[4 * q] * inv, gt_[4 * q + 1] * inv, gt_[4 * q + 2] * inv, gt_[4 * q + 3] * inv};
        }
    }
}

__device__ __forceinline__ float gelu_tanh(float x) {
    const float y = 1.5957691216057308f * (x + 0.044715f * x * x * x);
    return x / (1.0f + __expf(-y));
}
__device__ __forceinline__ f32x2 cvt8(unsigned w, bool hi) { return hi ? __builtin_amdgcn_cvt_pk_f32_fp8((int)w, true) : __builtin_amdgcn_cvt_pk_f32_fp8((int)w, false); }
__device__ __forceinline__ float dot16(const v4u& u, const f32x2* x) {
    const unsigned w0 = u.x, w1 = u.y, w2 = u.z, w3 = u.w;
    f32x2 a = cvt8(w0, false) * x[0], b = cvt8(w0, true) * x[1];
    a = cvt8(w1, false) * x[2] + a; b = cvt8(w1, true) * x[3] + b;
    a = cvt8(w2, false) * x[4] + a; b = cvt8(w2, true) * x[5] + b;
    a = cvt8(w3, false) * x[6] + a; b = cvt8(w3, true) * x[7] + b;
    a = a + b; return a.x + a.y;
}
__device__ __forceinline__ void axpy16(f32x2* o, float c, const v4u& v) {
    const unsigned w0 = v.x, w1 = v.y, w2 = v.z, w3 = v.w; const f32x2 c2 = {c, c};
    o[0] = cvt8(w0, false) * c2 + o[0]; o[1] = cvt8(w0, true) * c2 + o[1];
    o[2] = cvt8(w1, false) * c2 + o[2]; o[3] = cvt8(w1, true) * c2 + o[3];
    o[4] = cvt8(w2, false) * c2 + o[4]; o[5] = cvt8(w2, true) * c2 + o[5];
    o[6] = cvt8(w3, false) * c2 + o[6]; o[7] = cvt8(w3, true) * c2 + o[7];
}
__device__ __forceinline__ void peer_phase(const Ptrs& P, int vcu, int G, int wave, int lane) {
    const int gw = vcu * NWAVES + wave, NGW = G * NWAVES;
    float* H = P.out; bf16* HB = (bf16*)(P.ws + WS_HB); float* RS2 = (float*)(P.ws + WS_RS2);
    const int* EIDX = (const int*)(P.ws + WS_EIDX); const float* GATE = (const float*)(P.ws + WS_GATE);
    const GAS v4u* U8 = (const GAS v4u*)(P.ws + WS_U) + lane; const GAS v4u* V8 = (const GAS v4u*)(P.ws + WS_V) + lane;
    const float* SU = (const float*)(P.ws + WS_SU); const float* SV = (const float*)(P.ws + WS_SV);
    const int kl = ((lane & 1) << 3) | ((lane & 2) << 1) | ((lane & 4) >> 1) | ((lane & 8) >> 3);
    int t = gw; if (t >= M) return;
    int ei0 = EIDX[(size_t)t * 128 + lane], ei1 = EIDX[(size_t)t * 128 + 64 + lane];
    float gg0 = GATE[(size_t)t * 128 + lane], gg1 = GATE[(size_t)t * 128 + 64 + lane];
    f32x4 hrow[4];
    { const GAS f32x4* hp = (const GAS f32x4*)(H + (size_t)t * 1024 + lane * 16);
#pragma unroll
      for (int j = 0; j < 4; ++j) hrow[j] = hp[j]; }
    v4u uw[16];
#pragma unroll
    for (int k = 0; k < 16; ++k) { const int e = __builtin_amdgcn_readlane(ei0, k); uw[k] = U8[(size_t)e * 64]; }
    for (; t < M; t += NGW) {
        const int tn = (t + NGW < M) ? t + NGW : t;
        f32x2 x[8]; float ss = 0.f;
#pragma unroll
        for (int j = 0; j < 4; ++j) { x[2 * j] = (f32x2){hrow[j].x, hrow[j].y}; x[2 * j + 1] = (f32x2){hrow[j].z, hrow[j].w};
            ss += (hrow[j].x * hrow[j].x + hrow[j].y * hrow[j].y) + (hrow[j].z * hrow[j].z + hrow[j].w * hrow[j].w); }
        ss = wave_sum(ss);
        const float rstd = __builtin_amdgcn_rsqf(ss * (1.0f / 1024.0f) + EPS);
        const int nei0 = EIDX[(size_t)tn * 128 + lane], nei1 = EIDX[(size_t)tn * 128 + 64 + lane];
        const float ngg0 = GATE[(size_t)tn * 128 + lane], ngg1 = GATE[(size_t)tn * 128 + 64 + lane];
        f32x2 out[8];
#pragma unroll
        for (int i = 0; i < 8; ++i) out[i] = (f32x2){0.f, 0.f};
        for (int hq = 0; hq < 8 * REPS(7); ++hq) { const int hh = hq & 7;
            const int ereg = hh < 4 ? ei0 : ei1; const float greg = hh < 4 ? gg0 : gg1; const int lb = (hh & 3) * 16;
            v4u vw[16];
#pragma unroll
            for (int k = 0; k < 16; ++k) { const int e = __builtin_amdgcn_readlane(ereg, lb + k); vw[k] = V8[(size_t)e * 64]; }
            const int el = __shfl(ereg, lb + kl);
            const float su = SU[el], sv = SV[el];
            __builtin_amdgcn_sched_barrier(0);
            float part[16];
#pragma unroll
            for (int k = 0; k < 16; ++k) part[k] = dot16(uw[k], x);
#pragma unroll
            for (int st = 0; st < 4; ++st) {
                const int m = 1 << st, nh = 8 >> st; const bool up = (lane & m) != 0;
#pragma unroll
                for (int i = 0; i < nh; ++i) {
                    const float send = up ? part[i] : part[i + nh], keep = up ? part[i + nh] : part[i];
                    part[i] = keep + __shfl_xor(send, m);
                }
            }
            float d = part[0]; d += __shfl_xor(d, 16); d += __shfl_xor(d, 32);
            const float gk = __shfl(greg, lb + kl);
            const float cf = gk * gelu_tanh(d * su * rstd) * sv;
            __builtin_amdgcn_sched_barrier(0);
            { const bool lasth = (hq == 8 * REPS(7) - 1); const int hn = (hh + 1) & 7;
              const int nreg = lasth ? nei0 : (hn < 4 ? ei0 : ei1); const int nlb = (hn & 3) * 16;
#pragma unroll
              for (int k = 0; k < 16; ++k) { const int e = __builtin_amdgcn_readlane(nreg, nlb + k); uw[k] = U8[(size_t)e * 64]; } }
            __builtin_amdgcn_sched_barrier(0);
#pragma unroll
            for (int k = 0; k < 16; ++k) {
                const int src = ((k & 1) << 3) | ((k & 2) << 1) | ((k & 4) >> 1) | ((k & 8) >> 3);
                const float ck = __uint_as_float(__builtin_amdgcn_readlane(__float_as_uint(cf), src));
                axpy16(out, ck, vw[k]);
            }
        }
        if (REPS(7) == 2) {
#pragma unroll
            for (int i = 0; i < 8; ++i) out[i] = out[i] * 0.5f; }
        f32x4 o[4]; float s2 = 0.f;
        GAS f32x4* hp = (GAS f32x4*)(H + (size_t)t * 1024 + lane * 16);
#pragma unroll
        for (int j = 0; j < 4; ++j) { o[j] = (f32x4){hrow[j].x + out[2 * j].x, hrow[j].y + out[2 * j].y, hrow[j].z + out[2 * j + 1].x, hrow[j].w + out[2 * j + 1].y}; hp[j] = o[j];
            s2 += (o[j].x * o[j].x + o[j].y * o[j].y) + (o[j].z * o[j].z + o[j].w * o[j].w); }
        GAS v4u* hb = (GAS v4u*)(HB + (size_t)t * 1024 + lane * 16);
        v4u w0; w0.x = pk2(o[0].x, o[0].y); w0.y = pk2(o[0].z, o[0].w); w0.z = pk2(o[1].x, o[1].y); w0.w = pk2(o[1].z, o[1].w);
        v4u w1; w1.x = pk2(o[2].x, o[2].y); w1.y = pk2(o[2].z, o[2].w); w1.z = pk2(o[3].x, o[3].y); w1.w = pk2(o[3].z, o[3].w);
        hb[0] = w0; hb[1] = w1;
        s2 = wave_sum(s2);
        if (lane == 0) RS2[t] = s2;
        { const GAS f32x4* hn = (const GAS f32x4*)(H + (size_t)tn * 1024 + lane * 16);
#pragma unroll
          for (int j = 0; j < 4; ++j) hrow[j] = hn[j]; }
        ei0 = nei0; ei1 = nei1; gg0 = ngg0; gg1 = ngg1;
    }
}

__device__ __forceinline__ void final_phase(const Ptrs& P, int vcu, int G, int wave, int lane) {
    const int gw = vcu * NWAVES + wave, NGW = G * NWAVES; const float* RS3 = (const float*)(P.ws + WS_RS3);
    const GAS f32x4* gf = (const GAS f32x4*)P.g_final + lane;
    f32x4 g[4];
#pragma unroll
    for (int j = 0; j < 4; ++j) g[j] = gf[64 * j];
    for (int m = gw; m < M; m += NGW) {
        GAS f32x4* xr = (GAS f32x4*)(P.out + (size_t)m * D) + lane;
        float rs = 0.f; { const GAS f32x4* rp = (const GAS f32x4*)(RS3 + (size_t)m * 16);
#pragma unroll
            for (int i = 0; i < 4; ++i) { const f32x4 a = rp[i]; rs += (a.x + a.y) + (a.z + a.w); } }
        const float rstd = __builtin_amdgcn_rsqf(rs * (1.0f / 1024.0f) + EPS);
#pragma unroll
        for (int j = 0; j < 4; ++j) { const f32x4 v = xr[64 * j]; xr[64 * j] = v * rstd * g[j]; }
    }
}

struct Args { const float* in[17]; float* out; unsigned char* ws; int ph_lo, ph_hi; };
#ifndef PG8_SP2
#define PG8_SP2 true
#endif
#ifndef PG8_ALIGN
#define PG8_ALIGN true
#endif
__global__ void __launch_bounds__(NWAVES * 64, 2) mega_fwd(Args args) {
    extern __shared__ __attribute__((aligned(16))) unsigned char lds_raw[];
    LAS unsigned char* lds = (LAS unsigned char*)lds_raw;
    volatile LAS unsigned* MISC = (volatile LAS unsigned*)(lds + MISC_OFF);
    const int tid = threadIdx.x, lane = tid & 63, wave = __builtin_amdgcn_readfirstlane(tid >> 6);
    const int G = gridDim.x, bx = blockIdx.x; const int vcu = (G % 8 == 0) ? (bx % 8) * (G / 8) + bx / 8 : bx;
    Ptrs P;
    P.x = args.in[0]; P.p = args.in[1]; P.g_mix = args.in[2]; P.w_in = args.in[3]; P.conv_w = args.in[4]; P.pool_w = args.in[5]; P.pool_scale = args.in[6]; P.w_o = args.in[7];
    P.g_ffn = args.in[8]; P.w_q = args.in[9]; P.sub_keys = args.in[10]; P.eu = args.in[11]; P.ev = args.in[12]; P.g_ple = args.in[13]; P.w_gate = args.in[14]; P.w_proj = args.in[15]; P.g_final = args.in[16];
    P.out = args.out; P.ws = args.ws;
    gu32* ctl = (gu32*)(P.ws + WS_CTL);
    for (int u = tid; u < (LDS_BYTES - LDSCTL_OFF) / 4; u += NWAVES * 64) ((LAS unsigned*)(lds + LDSCTL_OFF))[u] = 0u;
    __syncthreads();
    XcdBarrier bar; bar.bar = (unsigned*)(ctl + CW_BAR); bar.x = 0; bar.st = nullptr;
    if (!MK_PER_PHASE) bar = xcd_barrier_post((unsigned*)(ctl + CW_BAR), MISC + 8);
    const int lo = args.ph_lo, hi = args.ph_hi;
#define IN(k) (lo <= (k) && (k) < hi)
#define SEAM(k) do { if (IN(k) && IN((k) + 1)) xcd_barrier(bar); } while (0)
    pg8::bf16_t* const WIN = (pg8::bf16_t*)(P.ws + WS_WIN); pg8::bf16_t* const WO = (pg8::bf16_t*)(P.ws + WS_WO); pg8::bf16_t* const WQ = (pg8::bf16_t*)(P.ws + WS_WQ);
    pg8::bf16_t* const WG = (pg8::bf16_t*)(P.ws + WS_WG); pg8::bf16_t* const WP = (pg8::bf16_t*)(P.ws + WS_WP);
    pg8::bf16_t* const XB = (pg8::bf16_t*)(P.ws + WS_XB); pg8::bf16_t* const PL = XB; pg8::bf16_t* const PROJ = (pg8::bf16_t*)(P.ws + WS_PROJ); pg8::bf16_t* const QB = PROJ;
    pg8::bf16_t* const MIX = (pg8::bf16_t*)(P.ws + WS_MIX); pg8::bf16_t* const HB = (pg8::bf16_t*)(P.ws + WS_HB); pg8::bf16_t* const PB = (pg8::bf16_t*)(P.ws + WS_PB);

    if (IN(0)) { for (int rep = 0; rep < REPS(1); ++rep) { p0a_phase(P, lds, vcu, G, tid, wave, lane); SEAM(0); } }
    if (IN(1)) { p0b_phase(P, lds, vcu, G, wave, lane); SEAM(1); }
    if (IN(2)) {
        pg8::Gemm g{XB, WIN, M, NPROJ, D}; pg8::StaticOrder S; S.init(M, NPROJ, G, bx);
        EpiBf16Row E{PROJ, NPROJ, (const float*)(P.ws + WS_RSX)};
        for (int rep = 0; rep < REPS(2); ++rep) { pg8::gemm_phase<EpiBf16Row, pg8::StaticOrder, PG8_ALIGN, PG8_SP2>(lds, g, S, E);
        SEAM(2); }
    }
    if (IN(3)) {
        for (int rep = 0; rep < REPS(3); ++rep) p2_phase(P, vcu, G, tid);
        pg8::Gemm g{PB, WP, M, D, PLED}; pg8::StaticOrder S; S.init(M, D, G, bx);
        EpiBf16Row E{PL, D, nullptr};
        for (int rep = 0; rep < REPS(8); ++rep) pg8::gemm_phase<EpiBf16Row, pg8::StaticOrder, PG8_ALIGN, PG8_SP2>(lds, g, S, E);
        SEAM(3);
    }
    if (IN(4)) {
        pg8::Gemm g{MIX, WO, M, D, D}; pg8::StaticOrder S; S.init(M, D, G, bx);
        EpiH1 E{P.x, P.out, HB, (float*)(P.ws + WS_RS1)};
        for (int rep = 0; rep < REPS(4); ++rep) { pg8::gemm_phase<EpiH1, pg8::StaticOrder, PG8_ALIGN, PG8_SP2>(lds, g, S, E);
        SEAM(4); }
    }
    if (IN(5)) {
        pg8::Gemm g{HB, WQ, M, NQ, D}; pg8::StaticOrder S; S.init(M, NQ, G, bx);
        EpiBf16Row E{QB, NQ, nullptr};
        for (int rep = 0; rep < REPS(5); ++rep) { pg8::gemm_phase<EpiBf16Row, pg8::StaticOrder, PG8_ALIGN, PG8_SP2>(lds, g, S, E);
        SEAM(5); }
    }
    if (IN(6)) { for (int rep = 0; rep < REPS(6); ++rep) { score_phase(P, lds, bx, G, tid, wave, lane); SEAM(6); } }
    if (IN(7)) { peer_phase(P, vcu, G, wave, lane); SEAM(7); }
    if (IN(8)) {
        pg8::Gemm g{HB, WG, M, D, D}; pg8::StaticOrder S; S.init(M, D, G, bx);
        EpiGate E{P.out, PL, (const float*)(P.ws + WS_RS2), (float*)(P.ws + WS_RS3)};
        pg8::gemm_phase<EpiGate, pg8::StaticOrder, PG8_ALIGN, PG8_SP2>(lds, g, S, E);
        SEAM(8);
    }
    if (IN(9)) { final_phase(P, vcu, G, wave, lane); }
#undef IN
#undef SEAM
}

extern "C" void kernel_launch(void* const* d_in, const int* in_sizes, int n_in, void* d_out, int out_size, void* d_ws, size_t ws_size, hipStream_t stream) {
    static int grid = 0;
    if (grid == 0) {
        if (n_in != 17 || in_sizes[0] != M * D || out_size != M * D || ws_size < WS_END) { fprintf(stderr, "kernel_launch: unexpected shapes (n_in %d, in0 %d, out %d, ws %zu); nothing launched\n", n_in, n_in > 0 ? in_sizes[0] : -1, out_size, ws_size); grid = -1; return; }
        int dev = 0, cus = 0, per_cu = 0;
        if (hipGetDevice(&dev) != hipSuccess || hipDeviceGetAttribute(&cus, hipDeviceAttributeMultiprocessorCount, dev) != hipSuccess) { fprintf(stderr, "kernel_launch: device query failed\n"); grid = -1; return; }
        if (hipFuncSetAttribute((const void*)mega_fwd, hipFuncAttributeMaxDynamicSharedMemorySize, LDS_BYTES) != hipSuccess) { fprintf(stderr, "kernel_launch: hipFuncSetAttribute failed\n"); grid = -1; return; }
        if (hipOccupancyMaxActiveBlocksPerMultiprocessor(&per_cu, (const void*)mega_fwd, NWAVES * 64, LDS_BYTES) != hipSuccess || per_cu < 1)
            fprintf(stderr, "kernel_launch: note: occupancy query reports %d workgroups per CU\n", per_cu);
        (void)hipGetLastError();
        grid = cus;
    }
    if (grid < 0) return;
    if (hipMemsetAsync((char*)d_ws + WS_CTL, 0, CTL_ZERO_BYTES, stream) != hipSuccess) { fprintf(stderr, "kernel_launch: memset failed\n"); return; }
    Args a{};
    for (int i = 0; i < 17; ++i) a.in[i] = (const float*)d_in[i];
    a.out = (float*)d_out; a.ws = (unsigned char*)d_ws;
#if MK_PER_PHASE
    for (int ph = 0; ph < NPHASES; ++ph) { a.ph_lo = ph; a.ph_hi = ph + 1; hipLaunchKernelGGL(mega_fwd, dim3(grid), dim3(NWAVES * 64), LDS_BYTES, stream, a); }
#else
    a.ph_lo = 0; a.ph_hi = NPHASES;
    hipLaunchKernelGGL(mega_fwd, dim3(grid), dim3(NWAVES * 64), LDS_BYTES, stream, a);
#endif
    const hipError_t le = hipPeekAtLastError();
    if (le != hipSuccess) fprintf(stderr, "kernel_launch: launch failed: %s\n", hipGetErrorName(le));
}
```

```cpp
#include <hip/hip_runtime.h>
#include <cstdio>
#include <cstdint>
namespace pg8 {
#define PG8_LAS __attribute__((address_space(3)))
typedef unsigned short bf16_t;
typedef short bf16x8 __attribute__((ext_vector_type(8)));
typedef float f32x4 __attribute__((ext_vector_type(4)));
typedef unsigned u32x4 __attribute__((ext_vector_type(4)));
constexpr int BM = 256, BK = 64, HALF = 128, HTB = HALF * BK * 2  , STAGE_BYTES = 8 * HTB, NXCD = 8, WGM = 8;

__host__ __device__ __forceinline__ int lds_byte(int r, int c) { const int st = (r >> 4) * 2 + (c >> 5), rr = r & 15, cc = c & 31, ob = rr * 64 + cc * 2; return st * 1024 + (ob ^ (((ob >> 9) & 1) << 5)); }
__host__ __device__ __forceinline__ void stage_rc(int b, int& R, int& C) { const int st = b / 1024, sb = b % 1024, swz = sb ^ (((sb >> 9) & 1) << 5); R = (st >> 1) * 16 + swz / 64; C = (st & 1) * 32 + (swz % 64) / 2; }
__host__ __device__ __forceinline__ int perm32(int rho) { const int n = rho >> 4, i = rho & 15; return 8 * (i >> 2) + 4 * n + (i & 3); }

struct Unit { int pm, pn; };
struct Gemm { const bf16_t* A; const bf16_t* Bt; int M, N, K; };

struct StaticOrder {
    int nM, nN, nwg, G, c;
    __host__ __device__ void init(int M, int N, int G_, int c_) { nM = M / BM; nN = N / BM; nwg = nM * nN; G = G_; c = c_; }
    __host__ __device__ bool next(int i, Unit& u) const {
        const long L = (long)i * G + c; if (L >= nwg) return false;
        int wgid = (int)L; { const int q = nwg / NXCD, r = nwg % NXCD, xcd = wgid % NXCD, off = wgid / NXCD; wgid = (xcd < r ? xcd * (q + 1) : r * (q + 1) + (xcd - r) * q) + off; }
        const int nig = WGM * nN, gid = wgid / nig, fm = gid * WGM, gsz = (nM - fm) < WGM ? (nM - fm) : WGM;
        u.pm = fm + ((wgid % nig) % gsz); u.pn = (wgid % nig) / gsz; return true;
    }
    __device__ __forceinline__ void a_ready(const Unit&) const {}
    __device__ __forceinline__ void done(const Unit&) const {}
};

__device__ __forceinline__ unsigned cvt_pk_bf16(float lo, float hi) { unsigned r; asm volatile("v_cvt_pk_bf16_f32 %0, %1, %2" : "=v"(r) : "v"(lo), "v"(hi)); return r; }
template <class Epi, class Sched, bool ALIGN_EPI = false, bool SP2 = false>
__device__ __forceinline__ void gemm_phase(PG8_LAS unsigned char* lds, const Gemm g, const Sched& S, const Epi& E) {
    const int tid = threadIdx.x, wid = __builtin_amdgcn_readfirstlane(tid >> 6), lane = tid & 63, wr = wid >> 2, wc = wid & 3, fr = lane & 15, fq = lane >> 4;
    const int K = g.K, nt = K / BK;
    unsigned voffA[2], voffB[2];
#pragma unroll
    for (int i = 0; i < 2; ++i) { int R, C; stage_rc(tid * 16 + i * 8192, R, C); const int Rb = Epi::PERM ? ((R & ~31) + perm32(R & 31)) : R;
        voffA[i] = (unsigned)(R * K + C) * 2u; voffB[i] = (unsigned)(Rb * K + C) * 2u; }
    const size_t kstep = (size_t)(BK * 2);
    const size_t hstep = (size_t)HALF * K * 2;
    const size_t tstep = 2 * hstep;
    const unsigned ldsw = (unsigned)wid * 1024u;
    const int aoff = lds_byte(wr * 64 + fr, fq * 8), boff = lds_byte(wc * 32 + fr, fq * 8);
#define PG8_SA(b, h) (((b) * 2 + (h)) * HTB)
#define PG8_SB(b, h) ((4 + (b) * 2 + (h)) * HTB)
#define PG8_STAGE(bufoff, gbase, voff) do { _Pragma("unroll") for (int _i = 0; _i < 2; ++_i) \
        __builtin_amdgcn_global_load_lds((const unsigned*)((const char*)(gbase) + (voff)[_i]), (PG8_LAS unsigned*)(lds + (bufoff) + ldsw + _i * 8192), 16, 0, 0); } while (0)
#define PG8_LDA(dst, b, h) do { _Pragma("unroll") for (int m = 0; m < 4; ++m) _Pragma("unroll") for (int k = 0; k < 2; ++k) dst[m][k] = *(const PG8_LAS bf16x8*)(lds + PG8_SA(b, h) + aoff + m * 2048 + k * 1024); } while (0)
#define PG8_LDB(dst, b, h) do { _Pragma("unroll") for (int n = 0; n < 2; ++n) _Pragma("unroll") for (int k = 0; k < 2; ++k) dst[n][k] = *(const PG8_LAS bf16x8*)(lds + PG8_SB(b, h) + boff + n * 2048 + k * 1024); } while (0)
#define PG8_MMA(ai, bj, At, Bt) do { __builtin_amdgcn_s_setprio(1); _Pragma("unroll") for (int m = 0; m < 4; ++m) _Pragma("unroll") for (int n = 0; n < 2; ++n) _Pragma("unroll") for (int k = 0; k < 2; ++k) \
        acc[ai][bj][m][n] = __builtin_amdgcn_mfma_f32_16x16x32_bf16(Bt[n][k], At[m][k], acc[ai][bj][m][n], 0, 0, 0); __builtin_amdgcn_s_setprio(0); } while (0)
#define PG8_WAIT_V(n) asm volatile("s_waitcnt vmcnt(" #n ")" ::: "memory")
#define PG8_WAIT_L(n) asm volatile("s_waitcnt lgkmcnt(" #n ")" ::: "memory")
#define PG8_BAR __builtin_amdgcn_s_barrier()
#define PG8_SCHED __builtin_amdgcn_sched_barrier(0)
    Unit cur, nxt; int ui = 0;
    if (!S.next(0, cur)) return;
    f32x4 acc[2][2][4][2];
#pragma unroll
    for (int a = 0; a < 2; ++a)
#pragma unroll
        for (int b = 0; b < 2; ++b)
#pragma unroll
            for (int m = 0; m < 4; ++m)
#pragma unroll
                for (int n = 0; n < 2; ++n) acc[a][b][m][n] = (f32x4){0.f, 0.f, 0.f, 0.f};
    bf16x8 At[4][2], B0[2][2], B1[2][2];
    const char* cA = (const char*)g.A + (size_t)cur.pm * tstep; const char* cB = (const char*)g.Bt + (size_t)cur.pn * tstep;
    S.a_ready(cur);
    if constexpr (SP2) {
        PG8_STAGE(PG8_SB(0, 0), cB, voffB); PG8_STAGE(PG8_SB(0, 1), cB + hstep, voffB); PG8_STAGE(PG8_SA(0, 0), cA, voffA); PG8_STAGE(PG8_SA(0, 1), cA + hstep, voffA);
        if (wr == 1) PG8_BAR;
        PG8_WAIT_V(2); PG8_BAR;
        PG8_STAGE(PG8_SB(1, 0), cB + kstep, voffB); PG8_STAGE(PG8_SA(1, 0), cA + kstep, voffA); PG8_STAGE(PG8_SB(1, 1), cB + hstep + kstep, voffB);
        PG8_WAIT_V(6); PG8_BAR;
    } else {
        PG8_STAGE(PG8_SB(0, 0), cB, voffB); PG8_STAGE(PG8_SA(0, 0), cA, voffA); PG8_STAGE(PG8_SB(0, 1), cB + hstep, voffB); PG8_STAGE(PG8_SA(0, 1), cA + hstep, voffA);
        if (wr == 1) PG8_BAR;
        PG8_WAIT_V(4); PG8_BAR;
        PG8_STAGE(PG8_SB(1, 0), cB + kstep, voffB); PG8_STAGE(PG8_SA(1, 0), cA + kstep, voffA); PG8_STAGE(PG8_SB(1, 1), cB + hstep + kstep, voffB);
        PG8_WAIT_V(6); PG8_BAR;
    }
    for (;;) {
        const bool has_next = S.next(ui + 1, nxt);
        const char* nA = has_next ? (const char*)g.A + (size_t)nxt.pm * tstep : cA; const char* nB = has_next ? (const char*)g.Bt + (size_t)nxt.pn * tstep : cB;
        for (int t = 0; t < nt; t += 2) {
            const bool last = (t == nt - 2);
            const char* a1 = cA + (size_t)(t + 1) * kstep;
            const char* a2 = last ? nA : cA + (size_t)(t + 2) * kstep; const char* b2 = last ? nB : cB + (size_t)(t + 2) * kstep;
            const char* a3 = a2 + kstep; const char* b3 = b2 + kstep;
            if (last && has_next) S.a_ready(nxt);
            if constexpr (SP2) {
            PG8_LDB(B0, 0, 0); PG8_LDB(B1, 0, 1); PG8_SCHED; PG8_LDA(At, 0, 0); PG8_STAGE(PG8_SA(1, 1), a1 + hstep, voffA);
            PG8_WAIT_V(8); PG8_WAIT_L(0); PG8_BAR; PG8_MMA(0, 0, At, B0); PG8_MMA(0, 1, At, B1); PG8_BAR; PG8_SCHED;
            PG8_LDA(At, 0, 1); PG8_STAGE(PG8_SB(0, 0), b2, voffB); PG8_STAGE(PG8_SB(0, 1), b2 + hstep, voffB); PG8_STAGE(PG8_SA(0, 0), a2, voffA);
            PG8_WAIT_V(8); PG8_WAIT_L(0); PG8_BAR; PG8_MMA(1, 0, At, B0); PG8_MMA(1, 1, At, B1); PG8_BAR; PG8_SCHED;
            PG8_LDB(B0, 1, 0); PG8_LDB(B1, 1, 1); PG8_SCHED; PG8_LDA(At, 1, 0); PG8_STAGE(PG8_SA(0, 1), a2 + hstep, voffA);
            PG8_WAIT_V(8); PG8_WAIT_L(0); PG8_BAR; PG8_MMA(0, 0, At, B0); PG8_MMA(0, 1, At, B1); PG8_BAR; PG8_SCHED;
            PG8_LDA(At, 1, 1); PG8_STAGE(PG8_SB(1, 0), b3, voffB); PG8_STAGE(PG8_SB(1, 1), b3 + hstep, voffB); PG8_STAGE(PG8_SA(1, 0), a3, voffA);
            PG8_WAIT_V(8); PG8_WAIT_L(0); PG8_BAR; PG8_MMA(1, 0, At, B0); PG8_MMA(1, 1, At, B1); PG8_BAR; PG8_SCHED;
            } else {
            PG8_LDB(B0, 0, 0); PG8_SCHED; PG8_LDA(At, 0, 0); PG8_STAGE(PG8_SA(1, 1), a1 + hstep, voffA);
            PG8_WAIT_L(8); PG8_BAR; PG8_WAIT_L(0); PG8_MMA(0, 0, At, B0); PG8_BAR; PG8_SCHED;
            PG8_LDB(B1, 0, 1); PG8_STAGE(PG8_SB(0, 0), b2, voffB);
            PG8_BAR; PG8_WAIT_L(0); PG8_MMA(0, 1, At, B1); PG8_BAR;
            PG8_LDA(At, 0, 1); PG8_STAGE(PG8_SA(0, 0), a2, voffA);
            PG8_BAR; PG8_WAIT_L(0); PG8_MMA(1, 0, At, B0); PG8_BAR; PG8_SCHED;
            PG8_STAGE(PG8_SB(0, 1), b2 + hstep, voffB);
            PG8_WAIT_V(6); PG8_BAR; PG8_MMA(1, 1, At, B1); PG8_BAR;
            PG8_LDB(B0, 1, 0); PG8_SCHED; PG8_LDA(At, 1, 0); PG8_STAGE(PG8_SA(0, 1), a2 + hstep, voffA);
            PG8_WAIT_L(8); PG8_BAR; PG8_WAIT_L(0); PG8_MMA(0, 0, At, B0); PG8_BAR; PG8_SCHED;
            PG8_LDB(B1, 1, 1); PG8_STAGE(PG8_SB(1, 0), b3, voffB);
            PG8_BAR; PG8_WAIT_L(0); PG8_MMA(0, 1, At, B1); PG8_BAR;
            PG8_LDA(At, 1, 1); PG8_STAGE(PG8_SA(1, 0), a3, voffA);
            PG8_BAR; PG8_WAIT_L(0); PG8_MMA(1, 0, At, B0); PG8_BAR; PG8_SCHED;
            PG8_STAGE(PG8_SB(1, 1), b3 + hstep, voffB);
            PG8_WAIT_V(6); PG8_BAR; PG8_MMA(1, 1, At, B1); PG8_BAR;
            }
        }
        if constexpr (ALIGN_EPI) { if (wr == 0) PG8_BAR; }
        if constexpr (!Epi::AFTER_DRAIN) { E(acc, cur, wr, wc, fr, fq); S.done(cur); }
        if (!has_next) break;
#pragma unroll
        for (int a = 0; a < 2; ++a)
#pragma unroll
            for (int b = 0; b < 2; ++b)
#pragma unroll
                for (int m = 0; m < 4; ++m)
#pragma unroll
                    for (int n = 0; n < 2; ++n) acc[a][b][m][n] = (f32x4){0.f, 0.f, 0.f, 0.f};
        cur = nxt; cA = nA; cB = nB; ++ui;
        if constexpr (ALIGN_EPI) { if (wr == 1) PG8_BAR; }
    }
    PG8_WAIT_V(0);
    if constexpr (!ALIGN_EPI) { if (wr == 0) PG8_BAR; }
    PG8_BAR;
    if constexpr (Epi::AFTER_DRAIN) { E.fused(acc, cur, wr, wc, fr, fq, lds, wid, lane); S.done(cur); }
#undef PG8_SA
#undef PG8_SB
#undef PG8_STAGE
#undef PG8_LDA
#undef PG8_LDB
#undef PG8_MMA
#undef PG8_WAIT_V
#undef PG8_WAIT_L
#undef PG8_BAR
#undef PG8_SCHED
}
}

#define GAS __attribute__((address_space(1)))
#define LAS __attribute__((address_space(3)))
typedef unsigned short bf16;
typedef unsigned v4u __attribute__((ext_vector_type(4)));
typedef float f32x4 __attribute__((ext_vector_type(4)));
typedef short bf16x8 __attribute__((ext_vector_type(8)));
typedef GAS unsigned gu32;
typedef GAS unsigned long long gu64;
#define RLX_AGENT __ATOMIC_RELAXED, __HIP_MEMORY_SCOPE_AGENT
#define LDS_WAIT() asm volatile("s_waitcnt lgkmcnt(0)" ::: "memory")
#define VM_WAIT() asm volatile("s_waitcnt vmcnt(0)" ::: "memory")
__device__ __forceinline__ unsigned long long rt() { return __builtin_amdgcn_s_memrealtime(); }
__device__ __forceinline__ unsigned f2bf(float f) { unsigned u = __builtin_bit_cast(unsigned, f); return (u + 0x7fffu + ((u >> 16) & 1u)) >> 16; }
__device__ __forceinline__ unsigned pk2(float lo, float hi) { return f2bf(lo) | (f2bf(hi) << 16); }

#define XB_TMO      128
#define XB_XCNT(j)  (256  + 64 * (j))
#define XB_XSUB(j)  (1280 + 64 * (j))
#define XB_XGEN(j)  (2304 + 64 * (j))
#define XB_TOP      3328
#define XB_TOPGEN   3392
#define XCD_BAR_WORDS 3456
#define XB_SPIN_CAP (1u << 18)

__device__ __forceinline__ unsigned xb_ld(unsigned* p)              { return __hip_atomic_load(p, __ATOMIC_RELAXED, __HIP_MEMORY_SCOPE_AGENT); }
__device__ __forceinline__ unsigned xb_add(unsigned* p, unsigned v) { return __hip_atomic_fetch_add(p, v, __ATOMIC_RELAXED, __HIP_MEMORY_SCOPE_AGENT); }
__device__ __forceinline__ unsigned xb_xcc_id() { return (unsigned)__builtin_amdgcn_s_getreg((3 << 11) | 20) & 0xFu; }
#define XB_SPIN(cond, bar) do { unsigned _sp = 0; while (cond) { __builtin_amdgcn_s_sleep(1); \
    if ((++_sp & 255u) == 0u) { if (xb_ld(&(bar)[XB_TMO])) break; if (_sp > XB_SPIN_CAP) { atomicAdd(&(bar)[XB_TMO], 1u); break; } } } } while (0)

struct XcdBarrier {
    unsigned* bar; unsigned x;
    volatile LAS unsigned* st;
};

__device__ __forceinline__ XcdBarrier xcd_barrier_post(unsigned* bar, volatile LAS unsigned* st) {
    XcdBarrier b; b.bar = bar; b.x = xb_xcc_id(); b.st = st;
    if (threadIdx.x == 0) (void)xb_add(&bar[XB_XCNT(b.x)], 1u);
    return b;
}
__device__ __forceinline__ void xcd_barrier_complete(unsigned* bar, unsigned x, unsigned& nloc, unsigned& nx) {
    const unsigned G = gridDim.x * gridDim.y * gridDim.z;
    unsigned sum, cnt, mine, sp = 0u;
    for (;;) {
        sum = 0u; cnt = 0u; mine = 0u;
#pragma unroll
        for (unsigned j = 0; j < 16; ++j) { const unsigned c = xb_ld(&bar[XB_XCNT(j)]); sum += c; cnt += (c > 0u) ? 1u : 0u; mine = (j == x) ? c : mine; }
        if (sum == G) break;
        __builtin_amdgcn_s_sleep(1);
        if ((++sp & 255u) == 0u) { if (xb_ld(&bar[XB_TMO])) break; if (sp > XB_SPIN_CAP) { atomicAdd(&bar[XB_TMO], 1u); break; } }
    }
    nloc = mine > 0u ? mine : 1u; nx = cnt > 0u ? cnt : 1u;
}

__device__ __forceinline__ void xcd_barrier(const XcdBarrier& b) {
    asm volatile("s_waitcnt vmcnt(0)" ::: "memory");
    __syncthreads();
    if (threadIdx.x == 0) {
        unsigned* bar = b.bar;
        __builtin_amdgcn_s_waitcnt(0);
        unsigned nloc = b.st[0], nx = b.st[1];
        if (nloc == 0u) { xcd_barrier_complete(bar, b.x, nloc, nx); b.st[0] = nloc; b.st[1] = nx; }
        const unsigned old = xb_add(&bar[XB_XSUB(b.x)], 1u);
        const unsigned gen = old / nloc;
        if (old + 1u == (gen + 1u) * nloc) {
            __builtin_amdgcn_fence(__ATOMIC_RELEASE, "agent");
            asm volatile("s_waitcnt vmcnt(0)" ::: "memory");
            const unsigned og = xb_add(&bar[XB_TOP], 1u);
            const unsigned tg = og / nx;
            if (og + 1u == (tg + 1u) * nx) xb_add(&bar[XB_TOPGEN], 1u);
            else XB_SPIN(xb_ld(&bar[XB_TOPGEN]) == tg, bar);
            __builtin_amdgcn_fence(__ATOMIC_ACQUIRE, "agent");
            xb_add(&bar[XB_XGEN(b.x)], 1u);
            asm volatile("s_waitcnt vmcnt(0)" ::: "memory");
        } else {
            XB_SPIN(xb_ld(&bar[XB_XGEN(b.x)]) == gen, bar);
            __builtin_amdgcn_fence(__ATOMIC_ACQUIRE, "agent");
            asm volatile("s_waitcnt vmcnt(0)" ::: "memory");
        }
    }
    __syncthreads();
}

constexpr int NWAVES = 8;
constexpr int M = 32768, D = 1024, SEQ = 4096, NPROJ = 2048, NQ = 2048, PLED = 256, NEXP = 16384;
constexpr float EPS = 1e-6f;
#ifndef MK_PER_PHASE
#define MK_PER_PHASE 0
#endif
#ifndef PROBE_REP
#define PROBE_REP 0
#endif
#define REPS(k) ((PROBE_REP == (k)) ? 2 : 1)
constexpr int NPHASES = 10;

constexpr size_t MiB = 1u << 20;
constexpr size_t WS_CTL = 0, CTL_ZERO_BYTES = 1 * MiB;
constexpr size_t WS_WIN = 2 * MiB, WS_WO = 6 * MiB, WS_WQ = 8 * MiB, WS_WG = 12 * MiB, WS_WP = 14 * MiB, WS_KEYS = 14 * MiB + 512 * 1024;
constexpr size_t WS_WF = 15 * MiB;
constexpr size_t WS_RSX = 17 * MiB, WS_RS2 = 17 * MiB + 512 * 1024, WS_RS1 = 18 * MiB, WS_RS3 = 20 * MiB;
constexpr size_t WS_SU = 22 * MiB, WS_SV = 22 * MiB + 65536;
constexpr size_t WS_U = 24 * MiB, WS_V = 56 * MiB;
constexpr size_t WS_XB = 88 * MiB;
constexpr size_t WS_PROJ = 152 * MiB;
constexpr size_t WS_MIX = 280 * MiB;
constexpr size_t WS_HB = 344 * MiB;
constexpr size_t WS_EIDX = 408 * MiB, WS_GATE = 424 * MiB;
constexpr size_t WS_PB = 440 * MiB;
constexpr size_t WS_END = 456 * MiB;
constexpr int CW_BAR = 4096;
static_assert((CW_BAR + XCD_BAR_WORDS) * 4 <= (int)CTL_ZERO_BYTES, "CTL words inside the memset region");

constexpr int RING_BYTES = 131072;
constexpr int LDSCTL_OFF = RING_BYTES, MISC_OFF = LDSCTL_OFF + 320;
constexpr int LDS_BYTES = 147456;

typedef float f32x16 __attribute__((ext_vector_type(16)));
typedef _Float16 h2_t __attribute__((ext_vector_type(2)));
typedef float f32x2 __attribute__((ext_vector_type(2)));
typedef int i32x4 __attribute__((ext_vector_type(4)));
typedef unsigned v2u __attribute__((ext_vector_type(2)));

__device__ __forceinline__ float wave_sum(float v) {
#pragma unroll
    for (int o = 1; o < 64; o <<= 1) v += __shfl_xor(v, o);
    return v;
}
__device__ __forceinline__ float bf_lo(unsigned w) { return __uint_as_float(w << 16); }
__device__ __forceinline__ float bf_hi(unsigned w) { return __uint_as_float(w & 0xffff0000u); }
__device__ __forceinline__ unsigned pkh(float lo, float hi) { f32x2 v = {lo, hi}; h2_t h = __builtin_convertvector(v, h2_t); return __builtin_bit_cast(unsigned, h); }

struct EpiBf16Row {
    static constexpr bool PERM = true, AFTER_DRAIN = false;
    pg8::bf16_t* O; int ldc; const float* rowss;
    __device__ __forceinline__ void operator()(const pg8::f32x4 (&acc)[2][2][4][2], const pg8::Unit& u, int wr, int wc, int fr, int fq) const {
        const int row0 = u.pm * 256 + wr * 64 + fr, col0 = u.pn * 256 + wc * 32 + 8 * fq;
#pragma unroll
        for (int ai = 0; ai < 2; ++ai)
#pragma unroll
            for (int m = 0; m < 4; ++m) {
                const int row = row0 + ai * 128 + m * 16;
                const float sc = rowss ? __builtin_amdgcn_rsqf(rowss[row] * (1.0f / 1024.0f) + EPS) : 1.0f;
                pg8::bf16_t* rowp = O + (size_t)row * ldc + col0;
#pragma unroll
                for (int bj = 0; bj < 2; ++bj) {
                    const pg8::f32x4 v0 = acc[ai][bj][m][0] * sc, v1 = acc[ai][bj][m][1] * sc;
                    pg8::u32x4 w; w.x = pg8::cvt_pk_bf16(v0[0], v0[1]); w.y = pg8::cvt_pk_bf16(v0[2], v0[3]); w.z = pg8::cvt_pk_bf16(v1[0], v1[1]); w.w = pg8::cvt_pk_bf16(v1[2], v1[3]);
                    *(pg8::u32x4*)(rowp + bj * 128) = w;
                }
            }
    }
};
struct EpiH1 {
    static constexpr bool PERM = true, AFTER_DRAIN = false;
    const float* X; float* H; pg8::bf16_t* HB; float* RS;
    __device__ __forceinline__ void operator()(const pg8::f32x4 (&acc)[2][2][4][2], const pg8::Unit& u, int wr, int wc, int fr, int fq) const {
        const int row0 = u.pm * 256 + wr * 64 + fr, col0 = u.pn * 256 + wc * 32 + 8 * fq;
#pragma unroll
        for (int ai = 0; ai < 2; ++ai)
#pragma unroll
            for (int m = 0; m < 4; ++m) {
                const int row = row0 + ai * 128 + m * 16; float s = 0.f;
#pragma unroll
                for (int bj = 0; bj < 2; ++bj) {
                    const size_t off = (size_t)row * 1024 + col0 + bj * 128;
                    const pg8::f32x4 x0 = *(const pg8::f32x4*)(X + off), x1 = *(const pg8::f32x4*)(X + off + 4);
                    const pg8::f32x4 v0 = acc[ai][bj][m][0] + x0, v1 = acc[ai][bj][m][1] + x1;
                    *(pg8::f32x4*)(H + off) = v0; *(pg8::f32x4*)(H + off + 4) = v1;
                    pg8::u32x4 w; w.x = pg8::cvt_pk_bf16(v0[0], v0[1]); w.y = pg8::cvt_pk_bf16(v0[2], v0[3]); w.z = pg8::cvt_pk_bf16(v1[0], v1[1]); w.w = pg8::cvt_pk_bf16(v1[2], v1[3]);
                    *(pg8::u32x4*)(HB + off) = w;
                    s += (v0[0] * v0[0] + v0[1] * v0[1]) + (v0[2] * v0[2] + v0[3] * v0[3]) + (v1[0] * v1[0] + v1[1] * v1[1]) + (v1[2] * v1[2] + v1[3] * v1[3]);
                }
                s += __shfl_xor(s, 16); s += __shfl_xor(s, 32);
                if (fq == 0) RS[(size_t)row * 16 + u.pn * 4 + wc] = s;
            }
    }
};
struct EpiGate {
    static constexpr bool PERM = true, AFTER_DRAIN = false;
    float* H; const pg8::bf16_t* PL; const float* RS2; float* RS3;
    __device__ __forceinline__ void operator()(const pg8::f32x4 (&acc)[2][2][4][2], const pg8::Unit& u, int wr, int wc, int fr, int fq) const {
        const int row0 = u.pm * 256 + wr * 64 + fr, col0 = u.pn * 256 + wc * 32 + 8 * fq;
#pragma unroll
        for (int ai = 0; ai < 2; ++ai)
#pragma unroll
            for (int m = 0; m < 4; ++m) {
                const int row = row0 + ai * 128 + m * 16; float s = 0.f;
                const float rstd = __builtin_amdgcn_rsqf(RS2[row] * (1.0f / 1024.0f) + EPS);
#pragma unroll
                for (int bj = 0; bj < 2; ++bj) {
                    const size_t off = (size_t)row * 1024 + col0 + bj * 128;
                    const pg8::u32x4 w = *(const pg8::u32x4*)(PL + off);
                    const pg8::f32x4 h0 = *(const pg8::f32x4*)(H + off), h1 = *(const pg8::f32x4*)(H + off + 4);
                    const pg8::f32x4 a0 = acc[ai][bj][m][0] * rstd, a1 = acc[ai][bj][m][1] * rstd;
                    pg8::f32x4 g0, g1;
#pragma unroll
                    for (int e = 0; e < 4; ++e) { g0[e] = 1.0f / (1.0f + __expf(-a0[e])); g1[e] = 1.0f / (1.0f + __expf(-a1[e])); }
                    const pg8::f32x4 p0 = {bf_lo(w.x), bf_hi(w.x), bf_lo(w.y), bf_hi(w.y)}, p1 = {bf_lo(w.z), bf_hi(w.z), bf_lo(w.w), bf_hi(w.w)};
#ifdef DBG_NO_PLE
                    const pg8::f32x4 v0 = h0, v1 = h1;
#else
                    const pg8::f32x4 v0 = h0 + g0 * p0, v1 = h1 + g1 * p1;
#endif
                    *(pg8::f32x4*)(H + off) = v0; *(pg8::f32x4*)(H + off + 4) = v1;
                    s += (v0[0] * v0[0] + v0[1] * v0[1]) + (v0[2] * v0[2] + v0[3] * v0[3]) + (v1[0] * v1[0] + v1[1] * v1[1]) + (v1[2] * v1[2] + v1[3] * v1[3]);
                }
                s += __shfl_xor(s, 16); s += __shfl_xor(s, 32);
                if (fq == 0) RS3[(size_t)row * 16 + u.pn * 4 + wc] = s;
            }
    }
};

__device__ __forceinline__ void p0_transpose_item(const float* W, int ldn, const float* gk, int K, bf16* WT, int row_off, int nblk, LAS float* scr, int item, int lane) {
    const int kb = item / nblk, nb = item % nblk, k0 = 64 * kb, n0 = 32 * nb;
#pragma unroll 8
    for (int i = 0; i < 32; ++i) { const int kk = 2 * i + (lane >> 5); float v = W[(size_t)(k0 + kk) * ldn + n0 + (lane & 31)]; if (gk) v *= gk[k0 + kk]; scr[kk * 33 + (lane & 31)] = v; }
    LDS_WAIT(); asm volatile("" ::: "memory");
    const int c = lane & 7;
#pragma unroll
    for (int j = 0; j < 4; ++j) { const int n = (lane >> 3) + 8 * j; const LAS float* s = scr + (8 * c) * 33 + n;
        v4u o; o.x = pk2(s[0 * 33], s[1 * 33]); o.y = pk2(s[2 * 33], s[3 * 33]); o.z = pk2(s[4 * 33], s[5 * 33]); o.w = pk2(s[6 * 33], s[7 * 33]);
        *(GAS v4u*)(WT + (size_t)(row_off + n0 + n) * K + k0 + 8 * c) = o; }
    LDS_WAIT(); asm volatile("" ::: "memory");
}

struct Ptrs {
    const float *x, *p, *g_mix, *w_in, *conv_w, *pool_w, *pool_scale, *w_o, *g_ffn, *w_q, *sub_keys, *eu, *ev, *g_ple, *w_gate, *w_proj, *g_final;
    float* out; unsigned char* ws;
};

__device__ __forceinline__ void p0a_phase(const Ptrs& P, LAS unsigned char* lds, int vcu, int G, int tid, int wave, int lane) {
    const int gw = vcu * NWAVES + wave, NGW = G * NWAVES;
    const int gt = vcu * (NWAVES * 64) + tid, NGT = G * NWAVES * 64;
    { float* Wf = (float*)(P.ws + WS_WF);
      for (int tk = gw; tk < 8192; tk += NGW) {
          const int k = tk >> 3, j = tk & 7, g = j >> 1, np = j * 64 + lane, d = np & 127;
          const float* wi = P.w_in + (size_t)k * 2048 + 1536 + g * 128; const float* pw = P.pool_w + (size_t)g * 128 * 128 + d;
          float a = 0.f;
#pragma unroll 8
          for (int c = 0; c < 128; ++c) a += wi[c] * pw[(size_t)c * 128];
          Wf[(size_t)k * 512 + np] = a * P.pool_scale[np];
      } }
    { LAS float* scr = (LAS float*)(lds + wave * 16384);
      constexpr int I_WO = 16 * 32, I_WQ = 16 * 64, I_WG = 16 * 32, I_WP = 4 * 32, I_WINA = 16 * 48;
      constexpr int NITEMS = I_WO + I_WQ + I_WG + I_WP + I_WINA;
      for (int it = gw; it < NITEMS; it += NGW) {
          int r = it;
          if (r < I_WO) { p0_transpose_item(P.w_o, 1024, nullptr, 1024, (bf16*)(P.ws + WS_WO), 0, 32, scr, r, lane); continue; } r -= I_WO;
          if (r < I_WQ) { p0_transpose_item(P.w_q, 2048, P.g_ffn, 1024, (bf16*)(P.ws + WS_WQ), 0, 64, scr, r, lane); continue; } r -= I_WQ;
          if (r < I_WG) { p0_transpose_item(P.w_gate, 1024, P.g_ple, 1024, (bf16*)(P.ws + WS_WG), 0, 32, scr, r, lane); continue; } r -= I_WG;
          if (r < I_WP) { p0_transpose_item(P.w_proj, 1024, nullptr, 256, (bf16*)(P.ws + WS_WP), 0, 32, scr, r, lane); continue; } r -= I_WP;
          p0_transpose_item(P.w_in, 2048, P.g_mix, 1024, (bf16*)(P.ws + WS_WIN), 0, 48, scr, r, lane);
      } }
    { const GAS f32x4* gf = (const GAS f32x4*)P.g_ffn + 4 * lane; f32x4 gq[4];
#pragma unroll
      for (int j = 0; j < 4; ++j) gq[j] = gf[j];
      for (int r = gw; r < 2 * NEXP; r += NGW) {
          const int tb = r >> 14, e = r & (NEXP - 1);
          const GAS f32x4* src = (const GAS f32x4*)((tb ? P.ev : P.eu) + (size_t)e * 1024) + 4 * lane;
          f32x4 a[4]; float m = 0.f, q = 0.f;
#pragma unroll
          for (int j = 0; j < 4; ++j) { a[j] = src[j]; if (!tb) a[j] = a[j] * gq[j];
              m = fmaxf(fmaxf(fmaxf(m, fabsf(a[j].x)), fmaxf(fabsf(a[j].y), fabsf(a[j].z))), fabsf(a[j].w));
              q += (a[j].x * a[j].x + a[j].y * a[j].y) + (a[j].z * a[j].z + a[j].w * a[j].w); }
          if (!tb) {
#pragma unroll
              for (int o = 1; o < 64; o <<= 1) m = fmaxf(m, __shfl_xor(m, o));
              const float sc = m > 0.f ? 400.0f / m : 0.f;
              v4u o; int w;
              w = __builtin_amdgcn_cvt_pk_fp8_f32(a[0].x * sc, a[0].y * sc, 0, false); w = __builtin_amdgcn_cvt_pk_fp8_f32(a[0].z * sc, a[0].w * sc, w, true); o.x = (unsigned)w;
              w = __builtin_amdgcn_cvt_pk_fp8_f32(a[1].x * sc, a[1].y * sc, 0, false); w = __builtin_amdgcn_cvt_pk_fp8_f32(a[1].z * sc, a[1].w * sc, w, true); o.y = (unsigned)w;
              w = __builtin_amdgcn_cvt_pk_fp8_f32(a[2].x * sc, a[2].y * sc, 0, false); w = __builtin_amdgcn_cvt_pk_fp8_f32(a[2].z * sc, a[2].w * sc, w, true); o.z = (unsigned)w;
              w = __builtin_amdgcn_cvt_pk_fp8_f32(a[3].x * sc, a[3].y * sc, 0, false); w = __builtin_amdgcn_cvt_pk_fp8_f32(a[3].z * sc, a[3].w * sc, w, true); o.w = (unsigned)w;
              ((GAS v4u*)(P.ws + WS_U))[(size_t)e * 64 + lane] = o;
              if (lane == 0) ((float*)(P.ws + WS_SU))[e] = m * (1.0f / 400.0f);
          } else {
              q = wave_sum(q);
              const float rms = sqrtf(q * (1.0f / 1024.0f));
              const float sc = rms > 0.f ? 2.0f / rms : 0.f;
              unsigned w0 = 0u, w1 = 0u;
              w0 = __builtin_amdgcn_cvt_scalef32_pk_fp4_f32(w0, a[0].x * sc, a[0].y * sc, 1.0f, 0); w0 = __builtin_amdgcn_cvt_scalef32_pk_fp4_f32(w0, a[0].z * sc, a[0].w * sc, 1.0f, 1);
              w0 = __builtin_amdgcn_cvt_scalef32_pk_fp4_f32(w0, a[1].x * sc, a[1].y * sc, 1.0f, 2); w0 = __builtin_amdgcn_cvt_scalef32_pk_fp4_f32(w0, a[1].z * sc, a[1].w * sc, 1.0f, 3);
              w1 = __builtin_amdgcn_cvt_scalef32_pk_fp4_f32(w1, a[2].x * sc, a[2].y * sc, 1.0f, 0); w1 = __builtin_amdgcn_cvt_scalef32_pk_fp4_f32(w1, a[2].z * sc, a[2].w * sc, 1.0f, 1);
              w1 = __builtin_amdgcn_cvt_scalef32_pk_fp4_f32(w1, a[3].x * sc, a[3].y * sc, 1.0f, 2); w1 = __builtin_amdgcn_cvt_scalef32_pk_fp4_f32(w1, a[3].z * sc, a[3].w * sc, 1.0f, 3);
              ((GAS v2u*)(P.ws + WS_V))[(size_t)e * 64 + lane] = (v2u){w0, w1};
              if (lane == 0) ((float*)(P.ws + WS_SV))[e] = rms * 0.5f;
          }
      } }
    { const GAS f32x4* sp = (const GAS f32x4*)P.p; GAS v4u* dp = (GAS v4u*)(P.ws + WS_PB);
      for (int i = gt; i < M * PLED / 8; i += NGT) { const f32x4 a = sp[2 * (size_t)i], b = sp[2 * (size_t)i + 1]; v4u o; o.x = pk2(a.x, a.y); o.y = pk2(a.z, a.w); o.z = pk2(b.x, b.y); o.w = pk2(b.z, b.w); dp[i] = o; }
      const GAS f32x4* sk = (const GAS f32x4*)P.sub_keys; GAS v4u* dk = (GAS v4u*)(P.ws + WS_KEYS);
      for (int i = gt; i < 16 * 128 * 128 / 8; i += NGT) { const f32x4 a = sk[2 * (size_t)i], b = sk[2 * (size_t)i + 1]; v4u o; o.x = pk2(a.x, a.y); o.y = pk2(a.z, a.w); o.z = pk2(b.x, b.y); o.w = pk2(b.z, b.w); dk[i] = o; } }
    { float* RSX = (float*)(P.ws + WS_RSX); bf16* XB = (bf16*)(P.ws + WS_XB);
      for (int m = gw; m < M; m += NGW) {
          const GAS f32x4* xr = (const GAS f32x4*)(P.x + (size_t)m * D) + lane; f32x4 v[4]; float s = 0.f;
#pragma unroll
          for (int j = 0; j < 4; ++j) { v[j] = xr[64 * j]; s += (v[j].x * v[j].x + v[j].y * v[j].y) + (v[j].z * v[j].z + v[j].w * v[j].w); }
          s = wave_sum(s); if (lane == 0) RSX[m] = s;
          GAS unsigned long long* o8 = (GAS unsigned long long*)(XB + (size_t)m * D) + lane;
#pragma unroll
          for (int j = 0; j < 4; ++j) o8[64 * j] = (unsigned long long)pk2(v[j].x, v[j].y) | ((unsigned long long)pk2(v[j].z, v[j].w) << 32);
      } }
}
__device__ __forceinline__ void p0b_phase(const Ptrs& P, LAS unsigned char* lds, int vcu, int G, int wave, int lane) {
    const int gw = vcu * NWAVES + wave, NGW = G * NWAVES; LAS float* scr = (LAS float*)(lds + wave * 16384);
    for (int it = gw; it < 16 * 16; it += NGW) p0_transpose_item((const float*)(P.ws + WS_WF), 512, P.g_mix, 1024, (bf16*)(P.ws + WS_WIN), 1536, 16, scr, it, lane);
}

__device__ __forceinline__ void p2_phase(const Ptrs& P, int vcu, int G, int tid) {
    const unsigned* PR = (const unsigned*)(P.ws + WS_PROJ);
    unsigned* MX = (unsigned*)(P.ws + WS_MIX);
    constexpr int TC = 32;
    for (int ck = vcu; ck < M / TC; ck += G) {
        const int t0 = ck * TC, s0 = t0 & (SEQ - 1);
        if (tid < 256) {
            const int half = 1 << (tid >> 6);
            const unsigned* col = PR + 768 + tid;
            float S0 = 0.f, S1 = 0.f;
            { const int lo = (s0 - half) > 0 ? (s0 - half) : 0, hi = (s0 + half) < SEQ ? (s0 + half) : SEQ;
              for (int s = lo; s < hi; ++s) { const unsigned w = col[(size_t)(t0 + s - s0) * 1024]; S0 += bf_lo(w); S1 += bf_hi(w); } }
#pragma unroll 4
            for (int i = 0; i < TC; ++i) {
                const int s = s0 + i, t = t0 + i;
                const int lo = (s - half) > 0 ? (s - half) : 0, hi = (s + half) < SEQ ? (s + half) : SEQ;
                const float inv = 1.0f / (float)(hi - lo);
                const unsigned wc = col[(size_t)t * 1024];
                const float o0 = S0 * inv - bf_lo(wc), o1 = S1 * inv - bf_hi(wc);
                MX[(size_t)t * 512 + 256 + tid] = pk2(o0, o1);
                if (s + half < SEQ) { const unsigned w = col[(size_t)(t + half) * 1024]; S0 += bf_lo(w); S1 += bf_hi(w); }
                if (s - half >= 0) { const unsigned w = col[(size_t)(t - half) * 1024]; S0 -= bf_lo(w); S1 -= bf_hi(w); }
            }
        } else {
            const int cp = tid - 256;
            const unsigned* bcol = PR + cp; const unsigned* ccol = PR + 256 + cp; const unsigned* vcol = PR + 512 + cp;
            const float w00 = P.conv_w[2 * cp], w01 = P.conv_w[2 * cp + 1], w10 = P.conv_w[512 + 2 * cp], w11 = P.conv_w[512 + 2 * cp + 1], w20 = P.conv_w[1024 + 2 * cp], w21 = P.conv_w[1024 + 2 * cp + 1];
            float zp0 = 0.f, zp1 = 0.f, zc0, zc1;
            if (s0 > 0) { const unsigned c = ccol[(size_t)(t0 - 1) * 1024], v = vcol[(size_t)(t0 - 1) * 1024]; zp0 = bf_lo(c) * bf_lo(v); zp1 = bf_hi(c) * bf_hi(v); }
            { const unsigned c = ccol[(size_t)t0 * 1024], v = vcol[(size_t)t0 * 1024]; zc0 = bf_lo(c) * bf_lo(v); zc1 = bf_hi(c) * bf_hi(v); }
#pragma unroll 4
            for (int i = 0; i < TC; ++i) {
                const int s = s0 + i, t = t0 + i;
                float zn0 = 0.f, zn1 = 0.f;
                if (s + 1 < SEQ) { const unsigned c = ccol[(size_t)(t + 1) * 1024], v = vcol[(size_t)(t + 1) * 1024]; zn0 = bf_lo(c) * bf_lo(v); zn1 = bf_hi(c) * bf_hi(v); }
                const unsigned b = bcol[(size_t)t * 1024];
                const float y0 = w00 * zp0 + w10 * zc0 + w20 * zn0, y1 = w01 * zp1 + w11 * zc1 + w21 * zn1;
                MX[(size_t)t * 512 + cp] = pk2(bf_lo(b) * y0, bf_hi(b) * y1);
                zp0 = zc0; zp1 = zc1; zc0 = zn0; zc1 = zn1;
            }
        }
    }
}

__device__ __forceinline__ float fmax_s(float a, float b) { float r; asm("v_max_f32_e32 %0, %1, %2" : "=v"(r) : "v"(a), "v"(b)); return r; }
__device__ __forceinline__ float fmin_s(float a, float b) { float r; asm("v_min_f32_e32 %0, %1, %2" : "=v"(r) : "v"(a), "v"(b)); return r; }
#define CE_DESC(a, b) do { const float _t = fmax_s(a, b); b = fmin_s(a, b); a = _t; } while (0)
#define CE_ASC(a, b)  do { const float _t = fmin_s(a, b); b = fmax_s(a, b); a = _t; } while (0)
__device__ __forceinline__ void sort16_desc(float* a) {
#pragma unroll
    for (int k = 2; k <= 16; k <<= 1)
#pragma unroll
        for (int j = k >> 1; j > 0; j >>= 1)
#pragma unroll
            for (int i = 0; i < 16; ++i) { const int l = i ^ j; if (l > i) { if ((i & k) == 0) CE_DESC(a[i], a[l]); else CE_ASC(a[i], a[l]); } }
}
__device__ __forceinline__ void merge16_desc(float* a) {
#pragma unroll
    for (int j = 8; j > 0; j >>= 1)
#pragma unroll
        for (int i = 0; i < 16; ++i) { const int l = i ^ j; if (l > i) CE_DESC(a[i], a[l]); }
}
__device__ __forceinline__ void top16_merge(float* a, const float* b) {
#pragma unroll
    for (int i = 0; i < 16; ++i) a[i] = fmax_s(a[i], b[15 - i]);
    merge16_desc(a);
}
__device__ __forceinline__ void top16_of_64(float* v) {
    sort16_desc(v); sort16_desc(v + 16); sort16_desc(v + 32); sort16_desc(v + 48);
    top16_merge(v, v + 16); top16_merge(v + 32, v + 48); top16_merge(v, v + 32);
}
__device__ __forceinline__ unsigned key_lookup(unsigned long long lo, unsigned long long hi, unsigned i) {
    const unsigned long long v = (i & 8u) ? hi : lo;
    return (unsigned)(v >> ((i & 7u) * 8u)) & 0x7fu;
}

constexpr int KROW = 272;
__device__ __forceinline__ void score_phase(const Ptrs& P, LAS unsigned char* lds, int bid, int G, int tid, int wave, int lane) {
    const bf16* Q = (const bf16*)(P.ws + WS_PROJ); const bf16* KEYS = (const bf16*)(P.ws + WS_KEYS); const float* RS1 = (const float*)(P.ws + WS_RS1);
    int* EIDX = (int*)(P.ws + WS_EIDX); float* GATE = (float*)(P.ws + WS_GATE);
    const int l31 = lane & 31, hi = lane >> 5;
    int cur_h = -1;
    for (int u = bid; u < (M / 256) * 8; u += G) {
        const int h = u & 7, tile = u >> 3;
        if (h != cur_h) {
            __syncthreads();
#pragma unroll
            for (int i = 0; i < 8; ++i) { const int q = tid + 512 * i, row = q >> 4, ch = q & 15;
                const v4u val = *(const GAS v4u*)(KEYS + ((size_t)(h * 256 + row)) * 128 + ch * 8);
                *(LAS v4u*)(lds + row * KROW + ch * 16) = val; }
            __syncthreads();
            cur_h = h;
        }
        const int tok = tile * 256 + wave * 32 + l31;
        float T0[16], T1[16];
#pragma unroll
        for (int p = 0; p < 2; ++p) {
            f32x16 acc[4];
#pragma unroll
            for (int kb = 0; kb < 4; ++kb)
#pragma unroll
                for (int r = 0; r < 16; ++r) acc[kb][r] = 0.f;
            const bf16* qp = Q + (size_t)tok * 2048 + h * 256 + p * 128 + hi * 8;
            bf16x8 bq[8];
#pragma unroll
            for (int ks = 0; ks < 8; ++ks) bq[ks] = *(const GAS bf16x8*)(qp + ks * 16);
#pragma unroll
            for (int ks = 0; ks < 8; ++ks)
#pragma unroll
                for (int kb = 0; kb < 4; ++kb) {
                    const bf16x8 ak = *(const LAS bf16x8*)(lds + (p * 128 + kb * 32 + l31) * KROW + (ks * 16 + hi * 8) * 2);
                    acc[kb] = __builtin_amdgcn_mfma_f32_32x32x16_bf16(ak, bq[ks], acc[kb], 0, 0, 0);
                }
            float v[64];
#pragma unroll
            for (int kb = 0; kb < 4; ++kb)
#pragma unroll
                for (int r = 0; r < 16; ++r) v[kb * 16 + r] = __uint_as_float((__float_as_uint(acc[kb][r]) & 0xffffff80u) | (unsigned)(kb * 32 + (r & 3) + 8 * (r >> 2)));
            top16_of_64(v);
            const unsigned hb = (unsigned)hi << 2;
#pragma unroll
            for (int i = 0; i < 16; ++i) v[i] = __uint_as_float(__float_as_uint(v[i]) | hb);
            float c[16];
#pragma unroll
            for (int i = 0; i < 16; ++i) c[i] = fmax_s(v[i], __shfl_xor(v[15 - i], 32));
            merge16_desc(c);
#pragma unroll
            for (int i = 0; i < 16; ++i) { if (p == 0) T0[i] = c[i]; else T1[i] = c[i]; }
        }
        float f0[16], f1[16];
        unsigned long long K0lo = 0ull, K0hi = 0ull, K1lo = 0ull, K1hi = 0ull;
#pragma unroll
        for (int b = 0; b < 8; ++b) {
            K0lo |= (unsigned long long)(__float_as_uint(T0[b]) & 0x7fu) << (8 * b); K0hi |= (unsigned long long)(__float_as_uint(T0[8 + b]) & 0x7fu) << (8 * b);
            K1lo |= (unsigned long long)(__float_as_uint(T1[b]) & 0x7fu) << (8 * b); K1hi |= (unsigned long long)(__float_as_uint(T1[8 + b]) & 0x7fu) << (8 * b);
        }
#pragma unroll
        for (int i = 0; i < 16; ++i) { f0[i] = __uint_as_float(__float_as_uint(T0[i]) & 0xffffff80u); f1[i] = __uint_as_float(__float_as_uint(T1[i]) & 0xffffff80u); }
        float cd[64]; int n = 0;
#pragma unroll
        for (int i = 0; i < 16; ++i)
#pragma unroll
            for (int j = 0; j < 16; ++j)
                if ((i + 1) * (j + 1) <= 16) { cd[n] = __uint_as_float((__float_as_uint(f0[i] + f1[j]) & 0xffffff00u) | (unsigned)(i * 16 + j)); ++n; }
#pragma unroll
        for (int q = 50; q < 64; ++q) cd[q] = __uint_as_float(0xff800000u);
        top16_of_64(cd);
        float rs = 0.f;
        { const GAS f32x4* rp = (const GAS f32x4*)(RS1 + (size_t)tok * 16);
#pragma unroll
          for (int i = 0; i < 4; ++i) { const f32x4 a = rp[i]; rs += (a.x + a.y) + (a.z + a.w); } }
        const float rstd = __builtin_amdgcn_rsqf(rs * (1.0f / 1024.0f) + EPS);
        int eidx[16]; float gt_[16]; float z0 = 0.f, sum = 0.f;
#pragma unroll
        for (int k = 0; k < 16; ++k) {
            const unsigned wb = __float_as_uint(cd[k]); const unsigned i = (wb >> 4) & 15u, j = wb & 15u;
            eidx[k] = (int)(key_lookup(K0lo, K0hi, i) * 128u + key_lookup(K1lo, K1hi, j));
            const float z = __uint_as_float(wb & 0xffffff00u) * rstd;
            if (k == 0) z0 = z;
            gt_[k] = __expf(z - z0); sum += gt_[k];
        }
        const float inv = 1.0f / sum;
        if (hi == 0) { GAS i32x4* ep = (GAS i32x4*)(EIDX + (size_t)tok * 128 + h * 16);
#pragma unroll
            for (int q = 0; q < 4; ++q) ep[q] = (i32x4){eidx[4 * q], eidx[4 * q + 1], eidx[4 * q + 2], eidx[4 * q + 3]};
        } else { GAS f32x4* gp = (GAS f32x4*)(GATE + (size_t)tok * 128 + h * 16);
#pragma unroll
            for (int q = 0; q < 4; ++q) gp[q] = (f32x4){gt_[4 * q] * inv, gt_[4 * q + 1] * inv, gt_[4 * q + 2] * inv, gt_[4 * q + 3] * inv};
        }
    }
}

__device__ __forceinline__ float gelu_tanh(float x) {
    const float y = 1.5957691216057308f * (x + 0.044715f * x * x * x);
    return x / (1.0f + __expf(-y));
}
__device__ __forceinline__ f32x2 cvt8(unsigned w, bool hi) { return hi ? __builtin_amdgcn_cvt_pk_f32_fp8((int)w, true) : __builtin_amdgcn_cvt_pk_f32_fp8((int)w, false); }
__device__ __forceinline__ float dot16(const v4u& u, const f32x2* x) {
    const unsigned w0 = u.x, w1 = u.y, w2 = u.z, w3 = u.w;
    f32x2 a = cvt8(w0, false) * x[0], b = cvt8(w0, true) * x[1];
    a = cvt8(w1, false) * x[2] + a; b = cvt8(w1, true) * x[3] + b;
    a = cvt8(w2, false) * x[4] + a; b = cvt8(w2, true) * x[5] + b;
    a = cvt8(w3, false) * x[6] + a; b = cvt8(w3, true) * x[7] + b;
    a = a + b; return a.x + a.y;
}
__device__ __forceinline__ void axpy16(f32x2* o, float c, const v2u& v) {
    const unsigned w0 = v.x, w1 = v.y; const f32x2 c2 = {c, c};
    o[0] = __builtin_amdgcn_cvt_scalef32_pk_f32_fp4(w0, 1.0f, 0) * c2 + o[0]; o[1] = __builtin_amdgcn_cvt_scalef32_pk_f32_fp4(w0, 1.0f, 1) * c2 + o[1];
    o[2] = __builtin_amdgcn_cvt_scalef32_pk_f32_fp4(w0, 1.0f, 2) * c2 + o[2]; o[3] = __builtin_amdgcn_cvt_scalef32_pk_f32_fp4(w0, 1.0f, 3) * c2 + o[3];
    o[4] = __builtin_amdgcn_cvt_scalef32_pk_f32_fp4(w1, 1.0f, 0) * c2 + o[4]; o[5] = __builtin_amdgcn_cvt_scalef32_pk_f32_fp4(w1, 1.0f, 1) * c2 + o[5];
    o[6] = __builtin_amdgcn_cvt_scalef32_pk_f32_fp4(w1, 1.0f, 2) * c2 + o[6]; o[7] = __builtin_amdgcn_cvt_scalef32_pk_f32_fp4(w1, 1.0f, 3) * c2 + o[7];
}
__device__ __forceinline__ void peer_phase(const Ptrs& P, int vcu, int G, int wave, int lane) {
    const int gw = vcu * NWAVES + wave, NGW = G * NWAVES;
    float* H = P.out; bf16* HB = (bf16*)(P.ws + WS_HB); float* RS2 = (float*)(P.ws + WS_RS2);
    const int* EIDX = (const int*)(P.ws + WS_EIDX); const float* GATE = (const float*)(P.ws + WS_GATE);
    const GAS v4u* U8 = (const GAS v4u*)(P.ws + WS_U) + lane; const GAS v2u* V8 = (const GAS v2u*)(P.ws + WS_V) + lane;
    const float* SU = (const float*)(P.ws + WS_SU); const float* SV = (const float*)(P.ws + WS_SV);
    const int kl = ((lane & 1) << 3) | ((lane & 2) << 1) | ((lane & 4) >> 1) | ((lane & 8) >> 3);
    int t = gw; if (t >= M) return;
    int ei0 = EIDX[(size_t)t * 128 + lane], ei1 = EIDX[(size_t)t * 128 + 64 + lane];
    float gg0 = GATE[(size_t)t * 128 + lane], gg1 = GATE[(size_t)t * 128 + 64 + lane];
    f32x4 hrow[4];
    { const GAS f32x4* hp = (const GAS f32x4*)(H + (size_t)t * 1024 + lane * 16);
#pragma unroll
      for (int j = 0; j < 4; ++j) hrow[j] = hp[j]; }
    v4u uw[16];
#pragma unroll
    for (int k = 0; k < 16; ++k) { const int e = __builtin_amdgcn_readlane(ei0, k); uw[k] = U8[(size_t)e * 64]; }
    for (; t < M; t += NGW) {
        const int tn = (t + NGW < M) ? t + NGW : t;
        f32x2 x[8]; float ss = 0.f;
#pragma unroll
        for (int j = 0; j < 4; ++j) { x[2 * j] = (f32x2){hrow[j].x, hrow[j].y}; x[2 * j + 1] = (f32x2){hrow[j].z, hrow[j].w};
            ss += (hrow[j].x * hrow[j].x + hrow[j].y * hrow[j].y) + (hrow[j].z * hrow[j].z + hrow[j].w * hrow[j].w); }
        ss = wave_sum(ss);
        const float rstd = __builtin_amdgcn_rsqf(ss * (1.0f / 1024.0f) + EPS);
        const int nei0 = EIDX[(size_t)tn * 128 + lane], nei1 = EIDX[(size_t)tn * 128 + 64 + lane];
        const float ngg0 = GATE[(size_t)tn * 128 + lane], ngg1 = GATE[(size_t)tn * 128 + 64 + lane];
        f32x2 out[8];
#pragma unroll
        for (int i = 0; i < 8; ++i) out[i] = (f32x2){0.f, 0.f};
        for (int hq = 0; hq < 8 * REPS(7); ++hq) { const int hh = hq & 7;
            const int ereg = hh < 4 ? ei0 : ei1; const float greg = hh < 4 ? gg0 : gg1; const int lb = (hh & 3) * 16;
            const int el = __shfl(ereg, lb + kl);
            const float su = SU[el], sv = SV[el];
            __builtin_amdgcn_sched_barrier(0);
            v2u vw[16];
#pragma unroll
            for (int k = 0; k < 16; ++k) { const int e = __builtin_amdgcn_readlane(ereg, lb + k); vw[k] = V8[(size_t)e * 64]; }
            __builtin_amdgcn_sched_barrier(0);
            float part[16];
#pragma unroll
            for (int k = 0; k < 16; ++k) {
                if (REPS(9) == 2) { v4u c2 = uw[k]; asm volatile("" : "+v"(c2)); part[k] = 0.5f * (dot16(uw[k], x) + dot16(c2, x)); }
                else part[k] = dot16(uw[k], x);
            }
#pragma unroll
            for (int st = 0; st < 4; ++st) {
                const int m = 1 << st, nh = 8 >> st; const bool up = (lane & m) != 0;
#pragma unroll
                for (int i = 0; i < nh; ++i) {
                    const float send = up ? part[i] : part[i + nh], keep = up ? part[i + nh] : part[i];
                    part[i] = keep + __shfl_xor(send, m);
                }
            }
            float d = part[0]; d += __shfl_xor(d, 16); d += __shfl_xor(d, 32);
            const float gk = __shfl(greg, lb + kl);
            const float cf = gk * gelu_tanh(d * su * rstd) * sv;
            __builtin_amdgcn_sched_barrier(0);
            { const bool lasth = (hq == 8 * REPS(7) - 1); const int hn = (hh + 1) & 7;
              const int nreg = lasth ? nei0 : (hn < 4 ? ei0 : ei1); const int nlb = (hn & 3) * 16;
#pragma unroll
              for (int k = 0; k < 16; ++k) { const int e = __builtin_amdgcn_readlane(nreg, nlb + k); uw[k] = U8[(size_t)e * 64]; } }
            __builtin_amdgcn_sched_barrier(0);
#pragma unroll
            for (int k = 0; k < 16; ++k) {
                const int src = ((k & 1) << 3) | ((k & 2) << 1) | ((k & 4) >> 1) | ((k & 8) >> 3);
                const float ck = __uint_as_float(__builtin_amdgcn_readlane(__float_as_uint(cf), src));
                if (REPS(9) == 2) { v2u c2 = vw[k]; asm volatile("" : "+v"(c2)); axpy16(out, 0.5f * ck, vw[k]); axpy16(out, 0.5f * ck, c2); }
                else axpy16(out, ck, vw[k]);
            }
        }
        if (REPS(7) == 2) {
#pragma unroll
            for (int i = 0; i < 8; ++i) out[i] = out[i] * 0.5f; }
        f32x4 o[4]; float s2 = 0.f;
        GAS f32x4* hp = (GAS f32x4*)(H + (size_t)t * 1024 + lane * 16);
#pragma unroll
        for (int j = 0; j < 4; ++j) { o[j] = (f32x4){hrow[j].x + out[2 * j].x, hrow[j].y + out[2 * j].y, hrow[j].z + out[2 * j + 1].x, hrow[j].w + out[2 * j + 1].y}; hp[j] = o[j];
            s2 += (o[j].x * o[j].x + o[j].y * o[j].y) + (o[j].z * o[j].z + o[j].w * o[j].w); }
        GAS v4u* hb = (GAS v4u*)(HB + (size_t)t * 1024 + lane * 16);
        v4u w0; w0.x = pk2(o[0].x, o[0].y); w0.y = pk2(o[0].z, o[0].w); w0.z = pk2(o[1].x, o[1].y); w0.w = pk2(o[1].z, o[1].w);
        v4u w1; w1.x = pk2(o[2].x, o[2].y); w1.y = pk2(o[2].z, o[2].w); w1.z = pk2(o[3].x, o[3].y); w1.w = pk2(o[3].z, o[3].w);
        hb[0] = w0; hb[1] = w1;
        s2 = wave_sum(s2);
        if (lane == 0) RS2[t] = s2;
        { const GAS f32x4* hn = (const GAS f32x4*)(H + (size_t)tn * 1024 + lane * 16);
#pragma unroll
          for (int j = 0; j < 4; ++j) hrow[j] = hn[j]; }
        ei0 = nei0; ei1 = nei1; gg0 = ngg0; gg1 = ngg1;
    }
}

__device__ __forceinline__ void final_phase(const Ptrs& P, int vcu, int G, int wave, int lane) {
    const int gw = vcu * NWAVES + wave, NGW = G * NWAVES; const float* RS3 = (const float*)(P.ws + WS_RS3);
    const GAS f32x4* gf = (const GAS f32x4*)P.g_final + lane;
    f32x4 g[4];
#pragma unroll
    for (int j = 0; j < 4; ++j) g[j] = gf[64 * j];
    for (int m = gw; m < M; m += NGW) {
        GAS f32x4* xr = (GAS f32x4*)(P.out + (size_t)m * D) + lane;
        float rs = 0.f; { const GAS f32x4* rp = (const GAS f32x4*)(RS3 + (size_t)m * 16);
#pragma unroll
            for (int i = 0; i < 4; ++i) { const f32x4 a = rp[i]; rs += (a.x + a.y) + (a.z + a.w); } }
        const float rstd = __builtin_amdgcn_rsqf(rs * (1.0f / 1024.0f) + EPS);
#pragma unroll
        for (int j = 0; j < 4; ++j) { const f32x4 v = xr[64 * j]; xr[64 * j] = v * rstd * g[j]; }
    }
}

struct Args { const float* in[17]; float* out; unsigned char* ws; int ph_lo, ph_hi; };
#ifndef PG8_SP2
#define PG8_SP2 true
#endif
#ifndef PG8_ALIGN
#define PG8_ALIGN true
#endif
__global__ void __launch_bounds__(NWAVES * 64, 2) mega_fwd(Args args) {
    extern __shared__ __attribute__((aligned(16))) unsigned char lds_raw[];
    LAS unsigned char* lds = (LAS unsigned char*)lds_raw;
    volatile LAS unsigned* MISC = (volatile LAS unsigned*)(lds + MISC_OFF);
    const int tid = threadIdx.x, lane = tid & 63, wave = __builtin_amdgcn_readfirstlane(tid >> 6);
    const int G = gridDim.x, bx = blockIdx.x; const int vcu = (G % 8 == 0) ? (bx % 8) * (G / 8) + bx / 8 : bx;
    Ptrs P;
    P.x = args.in[0]; P.p = args.in[1]; P.g_mix = args.in[2]; P.w_in = args.in[3]; P.conv_w = args.in[4]; P.pool_w = args.in[5]; P.pool_scale = args.in[6]; P.w_o = args.in[7];
    P.g_ffn = args.in[8]; P.w_q = args.in[9]; P.sub_keys = args.in[10]; P.eu = args.in[11]; P.ev = args.in[12]; P.g_ple = args.in[13]; P.w_gate = args.in[14]; P.w_proj = args.in[15]; P.g_final = args.in[16];
    P.out = args.out; P.ws = args.ws;
    gu32* ctl = (gu32*)(P.ws + WS_CTL);
    for (int u = tid; u < (LDS_BYTES - LDSCTL_OFF) / 4; u += NWAVES * 64) ((LAS unsigned*)(lds + LDSCTL_OFF))[u] = 0u;
    __syncthreads();
    XcdBarrier bar; bar.bar = (unsigned*)(ctl + CW_BAR); bar.x = 0; bar.st = nullptr;
    if (!MK_PER_PHASE) bar = xcd_barrier_post((unsigned*)(ctl + CW_BAR), MISC + 8);
    const int lo = args.ph_lo, hi = args.ph_hi;
#define IN(k) (lo <= (k) && (k) < hi)
#define SEAM(k) do { if (IN(k) && IN((k) + 1)) xcd_barrier(bar); } while (0)
    pg8::bf16_t* const WIN = (pg8::bf16_t*)(P.ws + WS_WIN); pg8::bf16_t* const WO = (pg8::bf16_t*)(P.ws + WS_WO); pg8::bf16_t* const WQ = (pg8::bf16_t*)(P.ws + WS_WQ);
    pg8::bf16_t* const WG = (pg8::bf16_t*)(P.ws + WS_WG); pg8::bf16_t* const WP = (pg8::bf16_t*)(P.ws + WS_WP);
    pg8::bf16_t* const XB = (pg8::bf16_t*)(P.ws + WS_XB); pg8::bf16_t* const PL = XB; pg8::bf16_t* const PROJ = (pg8::bf16_t*)(P.ws + WS_PROJ); pg8::bf16_t* const QB = PROJ;
    pg8::bf16_t* const MIX = (pg8::bf16_t*)(P.ws + WS_MIX); pg8::bf16_t* const HB = (pg8::bf16_t*)(P.ws + WS_HB); pg8::bf16_t* const PB = (pg8::bf16_t*)(P.ws + WS_PB);

    if (IN(0)) { for (int rep = 0; rep < REPS(1); ++rep) { p0a_phase(P, lds, vcu, G, tid, wave, lane); SEAM(0); } }
    if (IN(1)) { p0b_phase(P, lds, vcu, G, wave, lane); SEAM(1); }
    if (IN(2)) {
        pg8::Gemm g{XB, WIN, M, NPROJ, D}; pg8::StaticOrder S; S.init(M, NPROJ, G, bx);
        EpiBf16Row E{PROJ, NPROJ, (const float*)(P.ws + WS_RSX)};
        for (int rep = 0; rep < REPS(2); ++rep) { pg8::gemm_phase<EpiBf16Row, pg8::StaticOrder, PG8_ALIGN, PG8_SP2>(lds, g, S, E);
        SEAM(2); }
    }
    if (IN(3)) {
        for (int rep = 0; rep < REPS(3); ++rep) p2_phase(P, vcu, G, tid);
        pg8::Gemm g{PB, WP, M, D, PLED}; pg8::StaticOrder S; S.init(M, D, G, bx);
        EpiBf16Row E{PL, D, nullptr};
        for (int rep = 0; rep < REPS(8); ++rep) pg8::gemm_phase<EpiBf16Row, pg8::StaticOrder, PG8_ALIGN, PG8_SP2>(lds, g, S, E);
        SEAM(3);
    }
    if (IN(4)) {
        pg8::Gemm g{MIX, WO, M, D, D}; pg8::StaticOrder S; S.init(M, D, G, bx);
        EpiH1 E{P.x, P.out, HB, (float*)(P.ws + WS_RS1)};
        for (int rep = 0; rep < REPS(4); ++rep) { pg8::gemm_phase<EpiH1, pg8::StaticOrder, PG8_ALIGN, PG8_SP2>(lds, g, S, E);
        SEAM(4); }
    }
    if (IN(5)) {
        pg8::Gemm g{HB, WQ, M, NQ, D}; pg8::StaticOrder S; S.init(M, NQ, G, bx);
        EpiBf16Row E{QB, NQ, nullptr};
        for (int rep = 0; rep < REPS(5); ++rep) { pg8::gemm_phase<EpiBf16Row, pg8::StaticOrder, PG8_ALIGN, PG8_SP2>(lds, g, S, E);
        SEAM(5); }
    }
    if (IN(6)) { for (int rep = 0; rep < REPS(6); ++rep) { score_phase(P, lds, bx, G, tid, wave, lane); SEAM(6); } }
    if (IN(7)) { peer_phase(P, vcu, G, wave, lane); SEAM(7); }
    if (IN(8)) {
        pg8::Gemm g{HB, WG, M, D, D}; pg8::StaticOrder S; S.init(M, D, G, bx);
        EpiGate E{P.out, PL, (const float*)(P.ws + WS_RS2), (float*)(P.ws + WS_RS3)};
        pg8::gemm_phase<EpiGate, pg8::StaticOrder, PG8_ALIGN, PG8_SP2>(lds, g, S, E);
        SEAM(8);
    }
    if (IN(9)) { final_phase(P, vcu, G, wave, lane); }
#undef IN
#undef SEAM
}

extern "C" void kernel_launch(void* const* d_in, const int* in_sizes, int n_in, void* d_out, int out_size, void* d_ws, size_t ws_size, hipStream_t stream) {
    static int grid = 0;
    if (grid == 0) {
        if (n_in != 17 || in_sizes[0] != M * D || out_size != M * D || ws_size < WS_END) { fprintf(stderr, "kernel_launch: unexpected shapes (n_in %d, in0 %d, out %d, ws %zu); nothing launched\n", n_in, n_in > 0 ? in_sizes[0] : -1, out_size, ws_size); grid = -1; return; }
        int dev = 0, cus = 0, per_cu = 0;
        if (hipGetDevice(&dev) != hipSuccess || hipDeviceGetAttribute(&cus, hipDeviceAttributeMultiprocessorCount, dev) != hipSuccess) { fprintf(stderr, "kernel_launch: device query failed\n"); grid = -1; return; }
        if (hipFuncSetAttribute((const void*)mega_fwd, hipFuncAttributeMaxDynamicSharedMemorySize, LDS_BYTES) != hipSuccess) { fprintf(stderr, "kernel_launch: hipFuncSetAttribute failed\n"); grid = -1; return; }
        if (hipOccupancyMaxActiveBlocksPerMultiprocessor(&per_cu, (const void*)mega_fwd, NWAVES * 64, LDS_BYTES) != hipSuccess || per_cu < 1)
            fprintf(stderr, "kernel_launch: note: occupancy query reports %d workgroups per CU\n", per_cu);
        (void)hipGetLastError();
        grid = cus;
    }
    if (grid < 0) return;
    if (hipMemsetAsync((char*)d_ws + WS_CTL, 0, CTL_ZERO_BYTES, stream) != hipSuccess) { fprintf(stderr, "kernel_launch: memset failed\n"); return; }
    Args a{};
    for (int i = 0; i < 17; ++i) a.in[i] = (const float*)d_in[i];
    a.out = (float*)d_out; a.ws = (unsigned char*)d_ws;
#if MK_PER_PHASE
    for (int ph = 0; ph < NPHASES; ++ph) { a.ph_lo = ph; a.ph_hi = ph + 1; hipLaunchKernelGGL(mega_fwd, dim3(grid), dim3(NWAVES * 64), LDS_BYTES, stream, a); }
#else
    a.ph_lo = 0; a.ph_hi = NPHASES;
    hipLaunchKernelGGL(mega_fwd, dim3(grid), dim3(NWAVES * 64), LDS_BYTES, stream, a);
#endif
    const hipError_t le = hipPeekAtLastError();
    if (le != hipSuccess) fprintf(stderr, "kernel_launch: launch failed: %s\n", hipGetErrorName(le));
}
```

```cpp
#include <hip/hip_runtime.h>
#include <cstdio>
#include <cstdint>
namespace pg8 {
#define PG8_LAS __attribute__((address_space(3)))
typedef unsigned short bf16_t;
typedef short bf16x8 __attribute__((ext_vector_type(8)));
typedef float f32x4 __attribute__((ext_vector_type(4)));
typedef unsigned u32x4 __attribute__((ext_vector_type(4)));
constexpr int BM = 256, BK = 64, HALF = 128, HTB = HALF * BK * 2  , STAGE_BYTES = 8 * HTB, NXCD = 8, WGM = 8;

__host__ __device__ __forceinline__ int lds_byte(int r, int c) { const int st = (r >> 4) * 2 + (c >> 5), rr = r & 15, cc = c & 31, ob = rr * 64 + cc * 2; return st * 1024 + (ob ^ (((ob >> 9) & 1) << 5)); }
__host__ __device__ __forceinline__ void stage_rc(int b, int& R, int& C) { const int st = b / 1024, sb = b % 1024, swz = sb ^ (((sb >> 9) & 1) << 5); R = (st >> 1) * 16 + swz / 64; C = (st & 1) * 32 + (swz % 64) / 2; }
__host__ __device__ __forceinline__ int perm32(int rho) { const int n = rho >> 4, i = rho & 15; return 8 * (i >> 2) + 4 * n + (i & 3); }

struct Unit { int pm, pn; };
struct Gemm { const bf16_t* A; const bf16_t* Bt; int M, N, K; };

struct StaticOrder {
    int nM, nN, nwg, G, c;
    __host__ __device__ void init(int M, int N, int G_, int c_) { nM = M / BM; nN = N / BM; nwg = nM * nN; G = G_; c = c_; }
    __host__ __device__ bool next(int i, Unit& u) const {
        const long L = (long)i * G + c; if (L >= nwg) return false;
        int wgid = (int)L; { const int q = nwg / NXCD, r = nwg % NXCD, xcd = wgid % NXCD, off = wgid / NXCD; wgid = (xcd < r ? xcd * (q + 1) : r * (q + 1) + (xcd - r) * q) + off; }
        const int nig = WGM * nN, gid = wgid / nig, fm = gid * WGM, gsz = (nM - fm) < WGM ? (nM - fm) : WGM;
        u.pm = fm + ((wgid % nig) % gsz); u.pn = (wgid % nig) / gsz; return true;
    }
    __device__ __forceinline__ void a_ready(const Unit&) const {}
    __device__ __forceinline__ void done(const Unit&) const {}
};

__device__ __forceinline__ unsigned cvt_pk_bf16(float lo, float hi) { unsigned r; asm volatile("v_cvt_pk_bf16_f32 %0, %1, %2" : "=v"(r) : "v"(lo), "v"(hi)); return r; }
template <class Epi, class Sched, bool ALIGN_EPI = false, bool SP2 = false>
__device__ __forceinline__ void gemm_phase(PG8_LAS unsigned char* lds, const Gemm g, const Sched& S, const Epi& E) {
    const int tid = threadIdx.x, wid = __builtin_amdgcn_readfirstlane(tid >> 6), lane = tid & 63, wr = wid >> 2, wc = wid & 3, fr = lane & 15, fq = lane >> 4;
    const int K = g.K, nt = K / BK;
    unsigned voffA[2], voffB[2];
#pragma unroll
    for (int i = 0; i < 2; ++i) { int R, C; stage_rc(tid * 16 + i * 8192, R, C); const int Rb = Epi::PERM ? ((R & ~31) + perm32(R & 31)) : R;
        voffA[i] = (unsigned)(R * K + C) * 2u; voffB[i] = (unsigned)(Rb * K + C) * 2u; }
    const size_t kstep = (size_t)(BK * 2);
    const size_t hstep = (size_t)HALF * K * 2;
    const size_t tstep = 2 * hstep;
    const unsigned ldsw = (unsigned)wid * 1024u;
    const int aoff = lds_byte(wr * 64 + fr, fq * 8), boff = lds_byte(wc * 32 + fr, fq * 8);
#define PG8_SA(b, h) (((b) * 2 + (h)) * HTB)
#define PG8_SB(b, h) ((4 + (b) * 2 + (h)) * HTB)
#define PG8_STAGE(bufoff, gbase, voff) do { _Pragma("unroll") for (int _i = 0; _i < 2; ++_i) \
        __builtin_amdgcn_global_load_lds((const unsigned*)((const char*)(gbase) + (voff)[_i]), (PG8_LAS unsigned*)(lds + (bufoff) + ldsw + _i * 8192), 16, 0, 0); } while (0)
#define PG8_LDA(dst, b, h) do { _Pragma("unroll") for (int m = 0; m < 4; ++m) _Pragma("unroll") for (int k = 0; k < 2; ++k) dst[m][k] = *(const PG8_LAS bf16x8*)(lds + PG8_SA(b, h) + aoff + m * 2048 + k * 1024); } while (0)
#define PG8_LDB(dst, b, h) do { _Pragma("unroll") for (int n = 0; n < 2; ++n) _Pragma("unroll") for (int k = 0; k < 2; ++k) dst[n][k] = *(const PG8_LAS bf16x8*)(lds + PG8_SB(b, h) + boff + n * 2048 + k * 1024); } while (0)
#define PG8_MMA(ai, bj, At, Bt) do { __builtin_amdgcn_s_setprio(1); _Pragma("unroll") for (int m = 0; m < 4; ++m) _Pragma("unroll") for (int n = 0; n < 2; ++n) _Pragma("unroll") for (int k = 0; k < 2; ++k) \
        acc[ai][bj][m][n] = __builtin_amdgcn_mfma_f32_16x16x32_bf16(Bt[n][k], At[m][k], acc[ai][bj][m][n], 0, 0, 0); __builtin_amdgcn_s_setprio(0); } while (0)
#define PG8_WAIT_V(n) asm volatile("s_waitcnt vmcnt(" #n ")" ::: "memory")
#define PG8_WAIT_L(n) asm volatile("s_waitcnt lgkmcnt(" #n ")" ::: "memory")
#define PG8_BAR __builtin_amdgcn_s_barrier()
#define PG8_SCHED __builtin_amdgcn_sched_barrier(0)
    Unit cur, nxt; int ui = 0;
    if (!S.next(0, cur)) return;
    f32x4 acc[2][2][4][2];
#pragma unroll
    for (int a = 0; a < 2; ++a)
#pragma unroll
        for (int b = 0; b < 2; ++b)
#pragma unroll
            for (int m = 0; m < 4; ++m)
#pragma unroll
                for (int n = 0; n < 2; ++n) acc[a][b][m][n] = (f32x4){0.f, 0.f, 0.f, 0.f};
    bf16x8 At[4][2], B0[2][2], B1[2][2];
    const char* cA = (const char*)g.A + (size_t)cur.pm * tstep; const char* cB = (const char*)g.Bt + (size_t)cur.pn * tstep;
    S.a_ready(cur);
    if constexpr (SP2) {
        PG8_STAGE(PG8_SB(0, 0), cB, voffB); PG8_STAGE(PG8_SB(0, 1), cB + hstep, voffB); PG8_STAGE(PG8_SA(0, 0), cA, voffA); PG8_STAGE(PG8_SA(0, 1), cA + hstep, voffA);
        if (wr == 1) PG8_BAR;
        PG8_WAIT_V(2); PG8_BAR;
        PG8_STAGE(PG8_SB(1, 0), cB + kstep, voffB); PG8_STAGE(PG8_SA(1, 0), cA + kstep, voffA); PG8_STAGE(PG8_SB(1, 1), cB + hstep + kstep, voffB);
        PG8_WAIT_V(6); PG8_BAR;
    } else {
        PG8_STAGE(PG8_SB(0, 0), cB, voffB); PG8_STAGE(PG8_SA(0, 0), cA, voffA); PG8_STAGE(PG8_SB(0, 1), cB + hstep, voffB); PG8_STAGE(PG8_SA(0, 1), cA + hstep, voffA);
        if (wr == 1) PG8_BAR;
        PG8_WAIT_V(4); PG8_BAR;
        PG8_STAGE(PG8_SB(1, 0), cB + kstep, voffB); PG8_STAGE(PG8_SA(1, 0), cA + kstep, voffA); PG8_STAGE(PG8_SB(1, 1), cB + hstep + kstep, voffB);
        PG8_WAIT_V(6); PG8_BAR;
    }
    for (;;) {
        const bool has_next = S.next(ui + 1, nxt);
        const char* nA = has_next ? (const char*)g.A + (size_t)nxt.pm * tstep : cA; const char* nB = has_next ? (const char*)g.Bt + (size_t)nxt.pn * tstep : cB;
        for (int t = 0; t < nt; t += 2) {
            const bool last = (t == nt - 2);
            const char* a1 = cA + (size_t)(t + 1) * kstep;
            const char* a2 = last ? nA : cA + (size_t)(t + 2) * kstep; const char* b2 = last ? nB : cB + (size_t)(t + 2) * kstep;
            const char* a3 = a2 + kstep; const char* b3 = b2 + kstep;
            if (last && has_next) S.a_ready(nxt);
            if constexpr (SP2) {
            PG8_LDB(B0, 0, 0); PG8_LDB(B1, 0, 1); PG8_SCHED; PG8_LDA(At, 0, 0); PG8_STAGE(PG8_SA(1, 1), a1 + hstep, voffA);
            PG8_WAIT_V(8); PG8_WAIT_L(0); PG8_BAR; PG8_MMA(0, 0, At, B0); PG8_MMA(0, 1, At, B1); PG8_BAR; PG8_SCHED;
            PG8_LDA(At, 0, 1); PG8_STAGE(PG8_SB(0, 0), b2, voffB); PG8_STAGE(PG8_SB(0, 1), b2 + hstep, voffB); PG8_STAGE(PG8_SA(0, 0), a2, voffA);
            PG8_WAIT_V(8); PG8_WAIT_L(0); PG8_BAR; PG8_MMA(1, 0, At, B0); PG8_MMA(1, 1, At, B1); PG8_BAR; PG8_SCHED;
            PG8_LDB(B0, 1, 0); PG8_LDB(B1, 1, 1); PG8_SCHED; PG8_LDA(At, 1, 0); PG8_STAGE(PG8_SA(0, 1), a2 + hstep, voffA);
            PG8_WAIT_V(8); PG8_WAIT_L(0); PG8_BAR; PG8_MMA(0, 0, At, B0); PG8_MMA(0, 1, At, B1); PG8_BAR; PG8_SCHED;
            PG8_LDA(At, 1, 1); PG8_STAGE(PG8_SB(1, 0), b3, voffB); PG8_STAGE(PG8_SB(1, 1), b3 + hstep, voffB); PG8_STAGE(PG8_SA(1, 0), a3, voffA);
            PG8_WAIT_V(8); PG8_WAIT_L(0); PG8_BAR; PG8_MMA(1, 0, At, B0); PG8_MMA(1, 1, At, B1); PG8_BAR; PG8_SCHED;
            } else {
            PG8_LDB(B0, 0, 0); PG8_SCHED; PG8_LDA(At, 0, 0); PG8_STAGE(PG8_SA(1, 1), a1 + hstep, voffA);
            PG8_WAIT_L(8); PG8_BAR; PG8_WAIT_L(0); PG8_MMA(0, 0, At, B0); PG8_BAR; PG8_SCHED;
            PG8_LDB(B1, 0, 1); PG8_STAGE(PG8_SB(0, 0), b2, voffB);
            PG8_BAR; PG8_WAIT_L(0); PG8_MMA(0, 1, At, B1); PG8_BAR;
            PG8_LDA(At, 0, 1); PG8_STAGE(PG8_SA(0, 0), a2, voffA);
            PG8_BAR; PG8_WAIT_L(0); PG8_MMA(1, 0, At, B0); PG8_BAR; PG8_SCHED;
            PG8_STAGE(PG8_SB(0, 1), b2 + hstep, voffB);
            PG8_WAIT_V(6); PG8_BAR; PG8_MMA(1, 1, At, B1); PG8_BAR;
            PG8_LDB(B0, 1, 0); PG8_SCHED; PG8_LDA(At, 1, 0); PG8_STAGE(PG8_SA(0, 1), a2 + hstep, voffA);
            PG8_WAIT_L(8); PG8_BAR; PG8_WAIT_L(0); PG8_MMA(0, 0, At, B0); PG8_BAR; PG8_SCHED;
            PG8_LDB(B1, 1, 1); PG8_STAGE(PG8_SB(1, 0), b3, voffB);
            PG8_BAR; PG8_WAIT_L(0); PG8_MMA(0, 1, At, B1); PG8_BAR;
            PG8_LDA(At, 1, 1); PG8_STAGE(PG8_SA(1, 0), a3, voffA);
            PG8_BAR; PG8_WAIT_L(0); PG8_MMA(1, 0, At, B0); PG8_BAR; PG8_SCHED;
            PG8_STAGE(PG8_SB(1, 1), b3 + hstep, voffB);
            PG8_WAIT_V(6); PG8_BAR; PG8_MMA(1, 1, At, B1); PG8_BAR;
            }
        }
        if constexpr (ALIGN_EPI) { if (wr == 0) PG8_BAR; }
        if constexpr (!Epi::AFTER_DRAIN) { E(acc, cur, wr, wc, fr, fq); S.done(cur); }
        if (!has_next) break;
#pragma unroll
        for (int a = 0; a < 2; ++a)
#pragma unroll
            for (int b = 0; b < 2; ++b)
#pragma unroll
                for (int m = 0; m < 4; ++m)
#pragma unroll
                    for (int n = 0; n < 2; ++n) acc[a][b][m][n] = (f32x4){0.f, 0.f, 0.f, 0.f};
        cur = nxt; cA = nA; cB = nB; ++ui;
        if constexpr (ALIGN_EPI) { if (wr == 1) PG8_BAR; }
    }
    PG8_WAIT_V(0);
    if constexpr (!ALIGN_EPI) { if (wr == 0) PG8_BAR; }
    PG8_BAR;
    if constexpr (Epi::AFTER_DRAIN) { E.fused(acc, cur, wr, wc, fr, fq, lds, wid, lane); S.done(cur); }
#undef PG8_SA
#undef PG8_SB
#undef PG8_STAGE
#undef PG8_LDA
#undef PG8_LDB
#undef PG8_MMA
#undef PG8_WAIT_V
#undef PG8_WAIT_L
#undef PG8_BAR
#undef PG8_SCHED
}
}

#define GAS __attribute__((address_space(1)))
#define LAS __attribute__((address_space(3)))
typedef unsigned short bf16;
typedef unsigned v4u __attribute__((ext_vector_type(4)));
typedef float f32x4 __attribute__((ext_vector_type(4)));
typedef short bf16x8 __attribute__((ext_vector_type(8)));
typedef GAS unsigned gu32;
typedef GAS unsigned long long gu64;
#define RLX_AGENT __ATOMIC_RELAXED, __HIP_MEMORY_SCOPE_AGENT
#define LDS_WAIT() asm volatile("s_waitcnt lgkmcnt(0)" ::: "memory")
#define VM_WAIT() asm volatile("s_waitcnt vmcnt(0)" ::: "memory")
__device__ __forceinline__ unsigned long long rt() { return __builtin_amdgcn_s_memrealtime(); }
__device__ __forceinline__ unsigned f2bf(float f) { unsigned u = __builtin_bit_cast(unsigned, f); return (u + 0x7fffu + ((u >> 16) & 1u)) >> 16; }
__device__ __forceinline__ unsigned pk2(float lo, float hi) { return f2bf(lo) | (f2bf(hi) << 16); }

#define XB_TMO      128
#define XB_XCNT(j)  (256  + 64 * (j))
#define XB_XSUB(j)  (1280 + 64 * (j))
#define XB_XGEN(j)  (2304 + 64 * (j))
#define XB_TOP      3328
#define XB_TOPGEN   3392
#define XCD_BAR_WORDS 3456
#define XB_SPIN_CAP (1u << 18)

__device__ __forceinline__ unsigned xb_ld(unsigned* p)              { return __hip_atomic_load(p, __ATOMIC_RELAXED, __HIP_MEMORY_SCOPE_AGENT); }
__device__ __forceinline__ unsigned xb_add(unsigned* p, unsigned v) { return __hip_atomic_fetch_add(p, v, __ATOMIC_RELAXED, __HIP_MEMORY_SCOPE_AGENT); }
__device__ __forceinline__ unsigned xb_xcc_id() { return (unsigned)__builtin_amdgcn_s_getreg((3 << 11) | 20) & 0xFu; }
#define XB_SPIN(cond, bar) do { unsigned _sp = 0; while (cond) { __builtin_amdgcn_s_sleep(1); \
    if ((++_sp & 255u) == 0u) { if (xb_ld(&(bar)[XB_TMO])) break; if (_sp > XB_SPIN_CAP) { atomicAdd(&(bar)[XB_TMO], 1u); break; } } } } while (0)

struct XcdBarrier {
    unsigned* bar; unsigned x;
    volatile LAS unsigned* st;
};

__device__ __forceinline__ XcdBarrier xcd_barrier_post(unsigned* bar, volatile LAS unsigned* st) {
    XcdBarrier b; b.bar = bar; b.x = xb_xcc_id(); b.st = st;
    if (threadIdx.x == 0) (void)xb_add(&bar[XB_XCNT(b.x)], 1u);
    return b;
}
__device__ __forceinline__ void xcd_barrier_complete(unsigned* bar, unsigned x, unsigned& nloc, unsigned& nx) {
    const unsigned G = gridDim.x * gridDim.y * gridDim.z;
    unsigned sum, cnt, mine, sp = 0u;
    for (;;) {
        sum = 0u; cnt = 0u; mine = 0u;
#pragma unroll
        for (unsigned j = 0; j < 16; ++j) { const unsigned c = xb_ld(&bar[XB_XCNT(j)]); sum += c; cnt += (c > 0u) ? 1u : 0u; mine = (j == x) ? c : mine; }
        if (sum == G) break;
        __builtin_amdgcn_s_sleep(1);
        if ((++sp & 255u) == 0u) { if (xb_ld(&bar[XB_TMO])) break; if (sp > XB_SPIN_CAP) { atomicAdd(&bar[XB_TMO], 1u); break; } }
    }
    nloc = mine > 0u ? mine : 1u; nx = cnt > 0u ? cnt : 1u;
}

__device__ __forceinline__ void xcd_barrier(const XcdBarrier& b) {
    asm volatile("s_waitcnt vmcnt(0)" ::: "memory");
    __syncthreads();
    if (threadIdx.x == 0) {
        unsigned* bar = b.bar;
        __builtin_amdgcn_s_waitcnt(0);
        unsigned nloc = b.st[0], nx = b.st[1];
        if (nloc == 0u) { xcd_barrier_complete(bar, b.x, nloc, nx); b.st[0] = nloc; b.st[1] = nx; }
        const unsigned old = xb_add(&bar[XB_XSUB(b.x)], 1u);
        const unsigned gen = old / nloc;
        if (old + 1u == (gen + 1u) * nloc) {
            __builtin_amdgcn_fence(__ATOMIC_RELEASE, "agent");
            asm volatile("s_waitcnt vmcnt(0)" ::: "memory");
            const unsigned og = xb_add(&bar[XB_TOP], 1u);
            const unsigned tg = og / nx;
            if (og + 1u == (tg + 1u) * nx) xb_add(&bar[XB_TOPGEN], 1u);
            else XB_SPIN(xb_ld(&bar[XB_TOPGEN]) == tg, bar);
            __builtin_amdgcn_fence(__ATOMIC_ACQUIRE, "agent");
            xb_add(&bar[XB_XGEN(b.x)], 1u);
            asm volatile("s_waitcnt vmcnt(0)" ::: "memory");
        } else {
            XB_SPIN(xb_ld(&bar[XB_XGEN(b.x)]) == gen, bar);
            __builtin_amdgcn_fence(__ATOMIC_ACQUIRE, "agent");
            asm volatile("s_waitcnt vmcnt(0)" ::: "memory");
        }
    }
    __syncthreads();
}

constexpr int NWAVES = 8;
constexpr int M = 32768, D = 1024, SEQ = 4096, NPROJ = 2048, NQ = 2048, PLED = 256, NEXP = 16384;
constexpr float EPS = 1e-6f;
#ifndef MK_PER_PHASE
#define MK_PER_PHASE 0
#endif
#ifndef PROBE_REP
#define PROBE_REP 0
#endif
#define REPS(k) ((PROBE_REP == (k)) ? 2 : 1)
constexpr int NPHASES = 10;

constexpr size_t MiB = 1u << 20;
constexpr size_t WS_CTL = 0, CTL_ZERO_BYTES = 1 * MiB;
constexpr size_t WS_WIN = 2 * MiB, WS_WO = 6 * MiB, WS_WQ = 8 * MiB, WS_WG = 12 * MiB, WS_WP = 14 * MiB, WS_KEYS = 14 * MiB + 512 * 1024;
constexpr size_t WS_WF = 15 * MiB;
constexpr size_t WS_RSX = 17 * MiB, WS_RS2 = 17 * MiB + 512 * 1024, WS_RS1 = 18 * MiB, WS_RS3 = 20 * MiB;
constexpr size_t WS_SU = 22 * MiB, WS_SV = 22 * MiB + 65536;
constexpr size_t WS_U = 24 * MiB, WS_V = 56 * MiB;
constexpr size_t WS_XB = 88 * MiB;
constexpr size_t WS_PROJ = 152 * MiB;
constexpr size_t WS_MIX = 280 * MiB;
constexpr size_t WS_HB = 344 * MiB;
constexpr size_t WS_EIDX = 408 * MiB, WS_GATE = 424 * MiB;
constexpr size_t WS_PB = 440 * MiB;
constexpr size_t WS_END = 456 * MiB;
constexpr int CW_BAR = 4096;
static_assert((CW_BAR + XCD_BAR_WORDS) * 4 <= (int)CTL_ZERO_BYTES, "CTL words inside the memset region");

constexpr int RING_BYTES = 131072;
constexpr int LDSCTL_OFF = RING_BYTES, MISC_OFF = LDSCTL_OFF + 320;
constexpr int LDS_BYTES = 147456;

typedef float f32x16 __attribute__((ext_vector_type(16)));
typedef _Float16 h2_t __attribute__((ext_vector_type(2)));
typedef float f32x2 __attribute__((ext_vector_type(2)));
typedef int i32x4 __attribute__((ext_vector_type(4)));
typedef unsigned v2u __attribute__((ext_vector_type(2)));

__device__ __forceinline__ float wave_sum(float v) {
#pragma unroll
    for (int o = 1; o < 64; o <<= 1) v += __shfl_xor(v, o);
    return v;
}
__device__ __forceinline__ float bf_lo(unsigned w) { return __uint_as_float(w << 16); }
__device__ __forceinline__ float bf_hi(unsigned w) { return __uint_as_float(w & 0xffff0000u); }
__device__ __forceinline__ unsigned pkh(float lo, float hi) { f32x2 v = {lo, hi}; h2_t h = __builtin_convertvector(v, h2_t); return __builtin_bit_cast(unsigned, h); }

struct EpiBf16Row {
    static constexpr bool PERM = true, AFTER_DRAIN = false;
    pg8::bf16_t* O; int ldc; const float* rowss;
    __device__ __forceinline__ void operator()(const pg8::f32x4 (&acc)[2][2][4][2], const pg8::Unit& u, int wr, int wc, int fr, int fq) const {
        const int row0 = u.pm * 256 + wr * 64 + fr, col0 = u.pn * 256 + wc * 32 + 8 * fq;
#pragma unroll
        for (int ai = 0; ai < 2; ++ai)
#pragma unroll
            for (int m = 0; m < 4; ++m) {
                const int row = row0 + ai * 128 + m * 16;
                const float sc = rowss ? __builtin_amdgcn_rsqf(rowss[row] * (1.0f / 1024.0f) + EPS) : 1.0f;
                pg8::bf16_t* rowp = O + (size_t)row * ldc + col0;
#pragma unroll
                for (int bj = 0; bj < 2; ++bj) {
                    const pg8::f32x4 v0 = acc[ai][bj][m][0] * sc, v1 = acc[ai][bj][m][1] * sc;
                    pg8::u32x4 w; w.x = pg8::cvt_pk_bf16(v0[0], v0[1]); w.y = pg8::cvt_pk_bf16(v0[2], v0[3]); w.z = pg8::cvt_pk_bf16(v1[0], v1[1]); w.w = pg8::cvt_pk_bf16(v1[2], v1[3]);
                    *(pg8::u32x4*)(rowp + bj * 128) = w;
                }
            }
    }
};
struct EpiH1 {
    static constexpr bool PERM = true, AFTER_DRAIN = false;
    const float* X; float* H; pg8::bf16_t* HB; float* RS;
    __device__ __forceinline__ void operator()(const pg8::f32x4 (&acc)[2][2][4][2], const pg8::Unit& u, int wr, int wc, int fr, int fq) const {
        const int row0 = u.pm * 256 + wr * 64 + fr, col0 = u.pn * 256 + wc * 32 + 8 * fq;
#pragma unroll
        for (int ai = 0; ai < 2; ++ai)
#pragma unroll
            for (int m = 0; m < 4; ++m) {
                const int row = row0 + ai * 128 + m * 16; float s = 0.f;
#pragma unroll
                for (int bj = 0; bj < 2; ++bj) {
                    const size_t off = (size_t)row * 1024 + col0 + bj * 128;
                    const pg8::f32x4 x0 = *(const pg8::f32x4*)(X + off), x1 = *(const pg8::f32x4*)(X + off + 4);
                    const pg8::f32x4 v0 = acc[ai][bj][m][0] + x0, v1 = acc[ai][bj][m][1] + x1;
                    *(pg8::f32x4*)(H + off) = v0; *(pg8::f32x4*)(H + off + 4) = v1;
                    pg8::u32x4 w; w.x = pg8::cvt_pk_bf16(v0[0], v0[1]); w.y = pg8::cvt_pk_bf16(v0[2], v0[3]); w.z = pg8::cvt_pk_bf16(v1[0], v1[1]); w.w = pg8::cvt_pk_bf16(v1[2], v1[3]);
                    *(pg8::u32x4*)(HB + off) = w;
                    s += (v0[0] * v0[0] + v0[1] * v0[1]) + (v0[2] * v0[2] + v0[3] * v0[3]) + (v1[0] * v1[0] + v1[1] * v1[1]) + (v1[2] * v1[2] + v1[3] * v1[3]);
                }
                s += __shfl_xor(s, 16); s += __shfl_xor(s, 32);
                if (fq == 0) RS[(size_t)row * 16 + u.pn * 4 + wc] = s;
            }
    }
};
struct EpiGate {
    static constexpr bool PERM = true, AFTER_DRAIN = false;
    float* H; const pg8::bf16_t* PL; const float* RS2; float* RS3;
    __device__ __forceinline__ void operator()(const pg8::f32x4 (&acc)[2][2][4][2], const pg8::Unit& u, int wr, int wc, int fr, int fq) const {
        const int row0 = u.pm * 256 + wr * 64 + fr, col0 = u.pn * 256 + wc * 32 + 8 * fq;
#pragma unroll
        for (int ai = 0; ai < 2; ++ai)
#pragma unroll
            for (int m = 0; m < 4; ++m) {
                const int row = row0 + ai * 128 + m * 16; float s = 0.f;
                const float rstd = __builtin_amdgcn_rsqf(RS2[row] * (1.0f / 1024.0f) + EPS);
#pragma unroll
                for (int bj = 0; bj < 2; ++bj) {
                    const size_t off = (size_t)row * 1024 + col0 + bj * 128;
                    const pg8::u32x4 w = *(const pg8::u32x4*)(PL + off);
                    const pg8::f32x4 h0 = *(const pg8::f32x4*)(H + off), h1 = *(const pg8::f32x4*)(H + off + 4);
                    const pg8::f32x4 a0 = acc[ai][bj][m][0] * rstd, a1 = acc[ai][bj][m][1] * rstd;
                    pg8::f32x4 g0, g1;
#pragma unroll
                    for (int e = 0; e < 4; ++e) { g0[e] = 1.0f / (1.0f + __expf(-a0[e])); g1[e] = 1.0f / (1.0f + __expf(-a1[e])); }
                    const pg8::f32x4 p0 = {bf_lo(w.x), bf_hi(w.x), bf_lo(w.y), bf_hi(w.y)}, p1 = {bf_lo(w.z), bf_hi(w.z), bf_lo(w.w), bf_hi(w.w)};
#ifdef DBG_NO_PLE
                    const pg8::f32x4 v0 = h0, v1 = h1;
#else
                    const pg8::f32x4 v0 = h0 + g0 * p0, v1 = h1 + g1 * p1;
#endif
                    *(pg8::f32x4*)(H + off) = v0; *(pg8::f32x4*)(H + off + 4) = v1;
                    s += (v0[0] * v0[0] + v0[1] * v0[1]) + (v0[2] * v0[2] + v0[3] * v0[3]) + (v1[0] * v1[0] + v1[1] * v1[1]) + (v1[2] * v1[2] + v1[3] * v1[3]);
                }
                s += __shfl_xor(s, 16); s += __shfl_xor(s, 32);
                if (fq == 0) RS3[(size_t)row * 16 + u.pn * 4 + wc] = s;
            }
    }
};

__device__ __forceinline__ void p0_transpose_item(const float* W, int ldn, const float* gk, int K, bf16* WT, int row_off, int nblk, LAS float* scr, int item, int lane) {
    const int kb = item / nblk, nb = item % nblk, k0 = 64 * kb, n0 = 32 * nb;
#pragma unroll 8
    for (int i = 0; i < 32; ++i) { const int kk = 2 * i + (lane >> 5); float v = W[(size_t)(k0 + kk) * ldn + n0 + (lane & 31)]; if (gk) v *= gk[k0 + kk]; scr[kk * 33 + (lane & 31)] = v; }
    LDS_WAIT(); asm volatile("" ::: "memory");
    const int c = lane & 7;
#pragma unroll
    for (int j = 0; j < 4; ++j) { const int n = (lane >> 3) + 8 * j; const LAS float* s = scr + (8 * c) * 33 + n;
        v4u o; o.x = pk2(s[0 * 33], s[1 * 33]); o.y = pk2(s[2 * 33], s[3 * 33]); o.z = pk2(s[4 * 33], s[5 * 33]); o.w = pk2(s[6 * 33], s[7 * 33]);
        *(GAS v4u*)(WT + (size_t)(row_off + n0 + n) * K + k0 + 8 * c) = o; }
    LDS_WAIT(); asm volatile("" ::: "memory");
}

struct Ptrs {
    const float *x, *p, *g_mix, *w_in, *conv_w, *pool_w, *pool_scale, *w_o, *g_ffn, *w_q, *sub_keys, *eu, *ev, *g_ple, *w_gate, *w_proj, *g_final;
    float* out; unsigned char* ws;
};

__device__ __forceinline__ void p0a_phase(const Ptrs& P, LAS unsigned char* lds, int vcu, int G, int tid, int wave, int lane) {
    const int gw = vcu * NWAVES + wave, NGW = G * NWAVES;
    const int gt = vcu * (NWAVES * 64) + tid, NGT = G * NWAVES * 64;
    { float* Wf = (float*)(P.ws + WS_WF);
      for (int tk = gw; tk < 8192; tk += NGW) {
          const int k = tk >> 3, j = tk & 7, g = j >> 1, np = j * 64 + lane, d = np & 127;
          const float* wi = P.w_in + (size_t)k * 2048 + 1536 + g * 128; const float* pw = P.pool_w + (size_t)g * 128 * 128 + d;
          float a = 0.f;
#pragma unroll 8
          for (int c = 0; c < 128; ++c) a += wi[c] * pw[(size_t)c * 128];
          Wf[(size_t)k * 512 + np] = a * P.pool_scale[np];
      } }
    { LAS float* scr = (LAS float*)(lds + wave * 16384);
      constexpr int I_WO = 16 * 32, I_WQ = 16 * 64, I_WG = 16 * 32, I_WP = 4 * 32, I_WINA = 16 * 48;
      constexpr int NITEMS = I_WO + I_WQ + I_WG + I_WP + I_WINA;
      for (int it = gw; it < NITEMS; it += NGW) {
          int r = it;
          if (r < I_WO) { p0_transpose_item(P.w_o, 1024, nullptr, 1024, (bf16*)(P.ws + WS_WO), 0, 32, scr, r, lane); continue; } r -= I_WO;
          if (r < I_WQ) { p0_transpose_item(P.w_q, 2048, P.g_ffn, 1024, (bf16*)(P.ws + WS_WQ), 0, 64, scr, r, lane); continue; } r -= I_WQ;
          if (r < I_WG) { p0_transpose_item(P.w_gate, 1024, P.g_ple, 1024, (bf16*)(P.ws + WS_WG), 0, 32, scr, r, lane); continue; } r -= I_WG;
          if (r < I_WP) { p0_transpose_item(P.w_proj, 1024, nullptr, 256, (bf16*)(P.ws + WS_WP), 0, 32, scr, r, lane); continue; } r -= I_WP;
          p0_transpose_item(P.w_in, 2048, P.g_mix, 1024, (bf16*)(P.ws + WS_WIN), 0, 48, scr, r, lane);
      } }
    { const GAS f32x4* gf = (const GAS f32x4*)P.g_ffn + 4 * lane; f32x4 gq[4];
#pragma unroll
      for (int j = 0; j < 4; ++j) gq[j] = gf[j];
      for (int r = gw; r < 2 * NEXP; r += NGW) {
          const int tb = r >> 14, e = r & (NEXP - 1);
          const GAS f32x4* src = (const GAS f32x4*)((tb ? P.ev : P.eu) + (size_t)e * 1024) + 4 * lane;
          f32x4 a[4]; float q = 0.f;
#pragma unroll
          for (int j = 0; j < 4; ++j) { a[j] = src[j]; if (!tb) a[j] = a[j] * gq[j];
              q += (a[j].x * a[j].x + a[j].y * a[j].y) + (a[j].z * a[j].z + a[j].w * a[j].w); }
          q = wave_sum(q);
          const float rms = sqrtf(q * (1.0f / 1024.0f));
          const float sc = rms > 0.f ? 2.0f / rms : 0.f;
          unsigned w0 = 0u, w1 = 0u;
          w0 = __builtin_amdgcn_cvt_scalef32_pk_fp4_f32(w0, a[0].x * sc, a[0].y * sc, 1.0f, 0); w0 = __builtin_amdgcn_cvt_scalef32_pk_fp4_f32(w0, a[0].z * sc, a[0].w * sc, 1.0f, 1);
          w0 = __builtin_amdgcn_cvt_scalef32_pk_fp4_f32(w0, a[1].x * sc, a[1].y * sc, 1.0f, 2); w0 = __builtin_amdgcn_cvt_scalef32_pk_fp4_f32(w0, a[1].z * sc, a[1].w * sc, 1.0f, 3);
          w1 = __builtin_amdgcn_cvt_scalef32_pk_fp4_f32(w1, a[2].x * sc, a[2].y * sc, 1.0f, 0); w1 = __builtin_amdgcn_cvt_scalef32_pk_fp4_f32(w1, a[2].z * sc, a[2].w * sc, 1.0f, 1);
          w1 = __builtin_amdgcn_cvt_scalef32_pk_fp4_f32(w1, a[3].x * sc, a[3].y * sc, 1.0f, 2); w1 = __builtin_amdgcn_cvt_scalef32_pk_fp4_f32(w1, a[3].z * sc, a[3].w * sc, 1.0f, 3);
          ((GAS v2u*)(P.ws + (tb ? WS_V : WS_U)))[(size_t)e * 64 + lane] = (v2u){w0, w1};
          if (lane == 0) ((float*)(P.ws + (tb ? WS_SV : WS_SU)))[e] = rms * 0.5f;
      } }
    { const GAS f32x4* sp = (const GAS f32x4*)P.p; GAS v4u* dp = (GAS v4u*)(P.ws + WS_PB);
      for (int i = gt; i < M * PLED / 8; i += NGT) { const f32x4 a = sp[2 * (size_t)i], b = sp[2 * (size_t)i + 1]; v4u o; o.x = pk2(a.x, a.y); o.y = pk2(a.z, a.w); o.z = pk2(b.x, b.y); o.w = pk2(b.z, b.w); dp[i] = o; }
      const GAS f32x4* sk = (const GAS f32x4*)P.sub_keys; GAS v4u* dk = (GAS v4u*)(P.ws + WS_KEYS);
      for (int i = gt; i < 16 * 128 * 128 / 8; i += NGT) { const f32x4 a = sk[2 * (size_t)i], b = sk[2 * (size_t)i + 1]; v4u o; o.x = pk2(a.x, a.y); o.y = pk2(a.z, a.w); o.z = pk2(b.x, b.y); o.w = pk2(b.z, b.w); dk[i] = o; } }
    { float* RSX = (float*)(P.ws + WS_RSX); bf16* XB = (bf16*)(P.ws + WS_XB);
      for (int m = gw; m < M; m += NGW) {
          const GAS f32x4* xr = (const GAS f32x4*)(P.x + (size_t)m * D) + lane; f32x4 v[4]; float s = 0.f;
#pragma unroll
          for (int j = 0; j < 4; ++j) { v[j] = xr[64 * j]; s += (v[j].x * v[j].x + v[j].y * v[j].y) + (v[j].z * v[j].z + v[j].w * v[j].w); }
          s = wave_sum(s); if (lane == 0) RSX[m] = s;
          GAS unsigned long long* o8 = (GAS unsigned long long*)(XB + (size_t)m * D) + lane;
#pragma unroll
          for (int j = 0; j < 4; ++j) o8[64 * j] = (unsigned long long)pk2(v[j].x, v[j].y) | ((unsigned long long)pk2(v[j].z, v[j].w) << 32);
      } }
}
__device__ __forceinline__ void p0b_phase(const Ptrs& P, LAS unsigned char* lds, int vcu, int G, int wave, int lane) {
    const int gw = vcu * NWAVES + wave, NGW = G * NWAVES; LAS float* scr = (LAS float*)(lds + wave * 16384);
    for (int it = gw; it < 16 * 16; it += NGW) p0_transpose_item((const float*)(P.ws + WS_WF), 512, P.g_mix, 1024, (bf16*)(P.ws + WS_WIN), 1536, 16, scr, it, lane);
}

__device__ __forceinline__ void p2_phase(const Ptrs& P, int vcu, int G, int tid) {
    const unsigned* PR = (const unsigned*)(P.ws + WS_PROJ);
    unsigned* MX = (unsigned*)(P.ws + WS_MIX);
    constexpr int TC = 32;
    for (int ck = vcu; ck < M / TC; ck += G) {
        const int t0 = ck * TC, s0 = t0 & (SEQ - 1);
        if (tid < 256) {
            const int half = 1 << (tid >> 6);
            const unsigned* col = PR + 768 + tid;
            float S0 = 0.f, S1 = 0.f;
            { const int lo = (s0 - half) > 0 ? (s0 - half) : 0, hi = (s0 + half) < SEQ ? (s0 + half) : SEQ;
              for (int s = lo; s < hi; ++s) { const unsigned w = col[(size_t)(t0 + s - s0) * 1024]; S0 += bf_lo(w); S1 += bf_hi(w); } }
#pragma unroll 4
            for (int i = 0; i < TC; ++i) {
                const int s = s0 + i, t = t0 + i;
                const int lo = (s - half) > 0 ? (s - half) : 0, hi = (s + half) < SEQ ? (s + half) : SEQ;
                const float inv = 1.0f / (float)(hi - lo);
                const unsigned wc = col[(size_t)t * 1024];
                const float o0 = S0 * inv - bf_lo(wc), o1 = S1 * inv - bf_hi(wc);
                MX[(size_t)t * 512 + 256 + tid] = pk2(o0, o1);
                if (s + half < SEQ) { const unsigned w = col[(size_t)(t + half) * 1024]; S0 += bf_lo(w); S1 += bf_hi(w); }
                if (s - half >= 0) { const unsigned w = col[(size_t)(t - half) * 1024]; S0 -= bf_lo(w); S1 -= bf_hi(w); }
            }
        } else {
            const int cp = tid - 256;
            const unsigned* bcol = PR + cp; const unsigned* ccol = PR + 256 + cp; const unsigned* vcol = PR + 512 + cp;
            const float w00 = P.conv_w[2 * cp], w01 = P.conv_w[2 * cp + 1], w10 = P.conv_w[512 + 2 * cp], w11 = P.conv_w[512 + 2 * cp + 1], w20 = P.conv_w[1024 + 2 * cp], w21 = P.conv_w[1024 + 2 * cp + 1];
            float zp0 = 0.f, zp1 = 0.f, zc0, zc1;
            if (s0 > 0) { const unsigned c = ccol[(size_t)(t0 - 1) * 1024], v = vcol[(size_t)(t0 - 1) * 1024]; zp0 = bf_lo(c) * bf_lo(v); zp1 = bf_hi(c) * bf_hi(v); }
            { const unsigned c = ccol[(size_t)t0 * 1024], v = vcol[(size_t)t0 * 1024]; zc0 = bf_lo(c) * bf_lo(v); zc1 = bf_hi(c) * bf_hi(v); }
#pragma unroll 4
            for (int i = 0; i < TC; ++i) {
                const int s = s0 + i, t = t0 + i;
                float zn0 = 0.f, zn1 = 0.f;
                if (s + 1 < SEQ) { const unsigned c = ccol[(size_t)(t + 1) * 1024], v = vcol[(size_t)(t + 1) * 1024]; zn0 = bf_lo(c) * bf_lo(v); zn1 = bf_hi(c) * bf_hi(v); }
                const unsigned b = bcol[(size_t)t * 1024];
                const float y0 = w00 * zp0 + w10 * zc0 + w20 * zn0, y1 = w01 * zp1 + w11 * zc1 + w21 * zn1;
                MX[(size_t)t * 512 + cp] = pk2(bf_lo(b) * y0, bf_hi(b) * y1);
                zp0 = zc0; zp1 = zc1; zc0 = zn0; zc1 = zn1;
            }
        }
    }
}

__device__ __forceinline__ float fmax_s(float a, float b) { float r; asm("v_max_f32_e32 %0, %1, %2" : "=v"(r) : "v"(a), "v"(b)); return r; }
__device__ __forceinline__ float fmin_s(float a, float b) { float r; asm("v_min_f32_e32 %0, %1, %2" : "=v"(r) : "v"(a), "v"(b)); return r; }
#define CE_DESC(a, b) do { const float _t = fmax_s(a, b); b = fmin_s(a, b); a = _t; } while (0)
#define CE_ASC(a, b)  do { const float _t = fmin_s(a, b); b = fmax_s(a, b); a = _t; } while (0)
__device__ __forceinline__ void sort16_desc(float* a) {
#pragma unroll
    for (int k = 2; k <= 16; k <<= 1)
#pragma unroll
        for (int j = k >> 1; j > 0; j >>= 1)
#pragma unroll
            for (int i = 0; i < 16; ++i) { const int l = i ^ j; if (l > i) { if ((i & k) == 0) CE_DESC(a[i], a[l]); else CE_ASC(a[i], a[l]); } }
}
__device__ __forceinline__ void merge16_desc(float* a) {
#pragma unroll
    for (int j = 8; j > 0; j >>= 1)
#pragma unroll
        for (int i = 0; i < 16; ++i) { const int l = i ^ j; if (l > i) CE_DESC(a[i], a[l]); }
}
__device__ __forceinline__ void top16_merge(float* a, const float* b) {
#pragma unroll
    for (int i = 0; i < 16; ++i) a[i] = fmax_s(a[i], b[15 - i]);
    merge16_desc(a);
}
__device__ __forceinline__ void top16_of_64(float* v) {
    sort16_desc(v); sort16_desc(v + 16); sort16_desc(v + 32); sort16_desc(v + 48);
    top16_merge(v, v + 16); top16_merge(v + 32, v + 48); top16_merge(v, v + 32);
}
__device__ __forceinline__ unsigned key_lookup(unsigned long long lo, unsigned long long hi, unsigned i) {
    const unsigned long long v = (i & 8u) ? hi : lo;
    return (unsigned)(v >> ((i & 7u) * 8u)) & 0x7fu;
}

constexpr int KROW = 272;
__device__ __forceinline__ void score_phase(const Ptrs& P, LAS unsigned char* lds, int bid, int G, int tid, int wave, int lane) {
    const bf16* Q = (const bf16*)(P.ws + WS_PROJ); const bf16* KEYS = (const bf16*)(P.ws + WS_KEYS); const float* RS1 = (const float*)(P.ws + WS_RS1);
    int* EIDX = (int*)(P.ws + WS_EIDX); float* GATE = (float*)(P.ws + WS_GATE);
    const int l31 = lane & 31, hi = lane >> 5;
    int cur_h = -1;
    for (int u = bid; u < (M / 256) * 8; u += G) {
        const int h = u & 7, tile = u >> 3;
        if (h != cur_h) {
            __syncthreads();
#pragma unroll
            for (int i = 0; i < 8; ++i) { const int q = tid + 512 * i, row = q >> 4, ch = q & 15;
                const v4u val = *(const GAS v4u*)(KEYS + ((size_t)(h * 256 + row)) * 128 + ch * 8);
                *(LAS v4u*)(lds + row * KROW + ch * 16) = val; }
            __syncthreads();
            cur_h = h;
        }
        const int tok = tile * 256 + wave * 32 + l31;
        float T0[16], T1[16];
#pragma unroll
        for (int p = 0; p < 2; ++p) {
            f32x16 acc[4];
#pragma unroll
            for (int kb = 0; kb < 4; ++kb)
#pragma unroll
                for (int r = 0; r < 16; ++r) acc[kb][r] = 0.f;
            const bf16* qp = Q + (size_t)tok * 2048 + h * 256 + p * 128 + hi * 8;
            bf16x8 bq[8];
#pragma unroll
            for (int ks = 0; ks < 8; ++ks) bq[ks] = *(const GAS bf16x8*)(qp + ks * 16);
#pragma unroll
            for (int ks = 0; ks < 8; ++ks)
#pragma unroll
                for (int kb = 0; kb < 4; ++kb) {
                    const bf16x8 ak = *(const LAS bf16x8*)(lds + (p * 128 + kb * 32 + l31) * KROW + (ks * 16 + hi * 8) * 2);
                    acc[kb] = __builtin_amdgcn_mfma_f32_32x32x16_bf16(ak, bq[ks], acc[kb], 0, 0, 0);
                }
            float v[64];
#pragma unroll
            for (int kb = 0; kb < 4; ++kb)
#pragma unroll
                for (int r = 0; r < 16; ++r) v[kb * 16 + r] = __uint_as_float((__float_as_uint(acc[kb][r]) & 0xffffff80u) | (unsigned)(kb * 32 + (r & 3) + 8 * (r >> 2)));
            top16_of_64(v);
            const unsigned hb = (unsigned)hi << 2;
#pragma unroll
            for (int i = 0; i < 16; ++i) v[i] = __uint_as_float(__float_as_uint(v[i]) | hb);
            float c[16];
#pragma unroll
            for (int i = 0; i < 16; ++i) c[i] = fmax_s(v[i], __shfl_xor(v[15 - i], 32));
            merge16_desc(c);
#pragma unroll
            for (int i = 0; i < 16; ++i) { if (p == 0) T0[i] = c[i]; else T1[i] = c[i]; }
        }
        float f0[16], f1[16];
        unsigned long long K0lo = 0ull, K0hi = 0ull, K1lo = 0ull, K1hi = 0ull;
#pragma unroll
        for (int b = 0; b < 8; ++b) {
            K0lo |= (unsigned long long)(__float_as_uint(T0[b]) & 0x7fu) << (8 * b); K0hi |= (unsigned long long)(__float_as_uint(T0[8 + b]) & 0x7fu) << (8 * b);
            K1lo |= (unsigned long long)(__float_as_uint(T1[b]) & 0x7fu) << (8 * b); K1hi |= (unsigned long long)(__float_as_uint(T1[8 + b]) & 0x7fu) << (8 * b);
        }
#pragma unroll
        for (int i = 0; i < 16; ++i) { f0[i] = __uint_as_float(__float_as_uint(T0[i]) & 0xffffff80u); f1[i] = __uint_as_float(__float_as_uint(T1[i]) & 0xffffff80u); }
        float cd[64]; int n = 0;
#pragma unroll
        for (int i = 0; i < 16; ++i)
#pragma unroll
            for (int j = 0; j < 16; ++j)
                if ((i + 1) * (j + 1) <= 16) { cd[n] = __uint_as_float((__float_as_uint(f0[i] + f1[j]) & 0xffffff00u) | (unsigned)(i * 16 + j)); ++n; }
#pragma unroll
        for (int q = 50; q < 64; ++q) cd[q] = __uint_as_float(0xff800000u);
        top16_of_64(cd);
        float rs = 0.f;
        { const GAS f32x4* rp = (const GAS f32x4*)(RS1 + (size_t)tok * 16);
#pragma unroll
          for (int i = 0; i < 4; ++i) { const f32x4 a = rp[i]; rs += (a.x + a.y) + (a.z + a.w); } }
        const float rstd = __builtin_amdgcn_rsqf(rs * (1.0f / 1024.0f) + EPS);
        int eidx[16]; float gt_[16]; float z0 = 0.f, sum = 0.f;
#pragma unroll
        for (int k = 0; k < 16; ++k) {
            const unsigned wb = __float_as_uint(cd[k]); const unsigned i = (wb >> 4) & 15u, j = wb & 15u;
            eidx[k] = (int)(key_lookup(K0lo, K0hi, i) * 128u + key_lookup(K1lo, K1hi, j));
            const float z = __uint_as_float(wb & 0xffffff00u) * rstd;
            if (k == 0) z0 = z;
            gt_[k] = __expf(z - z0); sum += gt_[k];
        }
        const float inv = 1.0f / sum;
        if (hi == 0) { GAS i32x4* ep = (GAS i32x4*)(EIDX + (size_t)tok * 128 + h * 16);
#pragma unroll
            for (int q = 0; q < 4; ++q) ep[q] = (i32x4){eidx[4 * q], eidx[4 * q + 1], eidx[4 * q + 2], eidx[4 * q + 3]};
        } else { GAS f32x4* gp = (GAS f32x4*)(GATE + (size_t)tok * 128 + h * 16);
#pragma unroll
            for (int q = 0; q < 4; ++q) gp[q] = (f32x4){gt_[4 * q] * inv, gt_[4 * q + 1] * inv, gt_[4 * q + 2] * inv, gt_[4 * q + 3] * inv};
        }
    }
}

__device__ __forceinline__ float gelu_tanh(float x) {
    const float y = 1.5957691216057308f * (x + 0.044715f * x * x * x);
    return x / (1.0f + __expf(-y));
}
__device__ __forceinline__ float dot16(const v2u& u, const f32x2* x) {
    const unsigned w0 = u.x, w1 = u.y;
    f32x2 a = __builtin_amdgcn_cvt_scalef32_pk_f32_fp4(w0, 1.0f, 0) * x[0], b = __builtin_amdgcn_cvt_scalef32_pk_f32_fp4(w0, 1.0f, 1) * x[1];
    a = __builtin_amdgcn_cvt_scalef32_pk_f32_fp4(w0, 1.0f, 2) * x[2] + a; b = __builtin_amdgcn_cvt_scalef32_pk_f32_fp4(w0, 1.0f, 3) * x[3] + b;
    a = __builtin_amdgcn_cvt_scalef32_pk_f32_fp4(w1, 1.0f, 0) * x[4] + a; b = __builtin_amdgcn_cvt_scalef32_pk_f32_fp4(w1, 1.0f, 1) * x[5] + b;
    a = __builtin_amdgcn_cvt_scalef32_pk_f32_fp4(w1, 1.0f, 2) * x[6] + a; b = __builtin_amdgcn_cvt_scalef32_pk_f32_fp4(w1, 1.0f, 3) * x[7] + b;
    a = a + b; return a.x + a.y;
}
__device__ __forceinline__ void axpy16(f32x2* o, float c, const v2u& v) {
    const unsigned w0 = v.x, w1 = v.y; const f32x2 c2 = {c, c};
    o[0] = __builtin_amdgcn_cvt_scalef32_pk_f32_fp4(w0, 1.0f, 0) * c2 + o[0]; o[1] = __builtin_amdgcn_cvt_scalef32_pk_f32_fp4(w0, 1.0f, 1) * c2 + o[1];
    o[2] = __builtin_amdgcn_cvt_scalef32_pk_f32_fp4(w0, 1.0f, 2) * c2 + o[2]; o[3] = __builtin_amdgcn_cvt_scalef32_pk_f32_fp4(w0, 1.0f, 3) * c2 + o[3];
    o[4] = __builtin_amdgcn_cvt_scalef32_pk_f32_fp4(w1, 1.0f, 0) * c2 + o[4]; o[5] = __builtin_amdgcn_cvt_scalef32_pk_f32_fp4(w1, 1.0f, 1) * c2 + o[5];
    o[6] = __builtin_amdgcn_cvt_scalef32_pk_f32_fp4(w1, 1.0f, 2) * c2 + o[6]; o[7] = __builtin_amdgcn_cvt_scalef32_pk_f32_fp4(w1, 1.0f, 3) * c2 + o[7];
}
__device__ __forceinline__ void peer_phase(const Ptrs& P, int vcu, int G, int wave, int lane) {
    const int gw = vcu * NWAVES + wave, NGW = G * NWAVES;
    float* H = P.out; bf16* HB = (bf16*)(P.ws + WS_HB); float* RS2 = (float*)(P.ws + WS_RS2);
    const int* EIDX = (const int*)(P.ws + WS_EIDX); const float* GATE = (const float*)(P.ws + WS_GATE);
    const GAS v2u* U8 = (const GAS v2u*)(P.ws + WS_U) + lane; const GAS v2u* V8 = (const GAS v2u*)(P.ws + WS_V) + lane;
    const float* SU = (const float*)(P.ws + WS_SU); const float* SV = (const float*)(P.ws + WS_SV);
    const int kl = ((lane & 1) << 3) | ((lane & 2) << 1) | ((lane & 4) >> 1) | ((lane & 8) >> 3);
    int t = gw; if (t >= M) return;
    int ei0 = EIDX[(size_t)t * 128 + lane], ei1 = EIDX[(size_t)t * 128 + 64 + lane];
    float gg0 = GATE[(size_t)t * 128 + lane], gg1 = GATE[(size_t)t * 128 + 64 + lane];
    f32x4 hrow[4];
    { const GAS f32x4* hp = (const GAS f32x4*)(H + (size_t)t * 1024 + lane * 16);
#pragma unroll
      for (int j = 0; j < 4; ++j) hrow[j] = hp[j]; }
    v2u uw[16];
#pragma unroll
    for (int k = 0; k < 16; ++k) { const int e = __builtin_amdgcn_readlane(ei0, k); uw[k] = U8[(size_t)e * 64]; }
    for (; t < M; t += NGW) {
        const int tn = (t + NGW < M) ? t + NGW : t;
        f32x2 x[8]; float ss = 0.f;
#pragma unroll
        for (int j = 0; j < 4; ++j) { x[2 * j] = (f32x2){hrow[j].x, hrow[j].y}; x[2 * j + 1] = (f32x2){hrow[j].z, hrow[j].w};
            ss += (hrow[j].x * hrow[j].x + hrow[j].y * hrow[j].y) + (hrow[j].z * hrow[j].z + hrow[j].w * hrow[j].w); }
        ss = wave_sum(ss);
        const float rstd = __builtin_amdgcn_rsqf(ss * (1.0f / 1024.0f) + EPS);
        const int nei0 = EIDX[(size_t)tn * 128 + lane], nei1 = EIDX[(size_t)tn * 128 + 64 + lane];
        const float ngg0 = GATE[(size_t)tn * 128 + lane], ngg1 = GATE[(size_t)tn * 128 + 64 + lane];
        f32x2 out[8];
#pragma unroll
        for (int i = 0; i < 8; ++i) out[i] = (f32x2){0.f, 0.f};
        for (int hq = 0; hq < 8 * REPS(7); ++hq) { const int hh = hq & 7;
            const int ereg = hh < 4 ? ei0 : ei1; const float greg = hh < 4 ? gg0 : gg1; const int lb = (hh & 3) * 16;
            const int el = __shfl(ereg, lb + kl);
            const float su = SU[el], sv = SV[el];
            __builtin_amdgcn_sched_barrier(0);
            v2u vw[16];
#pragma unroll
            for (int k = 0; k < 16; ++k) { const int e = __builtin_amdgcn_readlane(ereg, lb + k); vw[k] = V8[(size_t)e * 64]; }
            __builtin_amdgcn_sched_barrier(0);
            float part[16];
#pragma unroll
            for (int k = 0; k < 16; ++k) {
                if (REPS(9) == 2) { v2u c2 = uw[k]; asm volatile("" : "+v"(c2)); part[k] = 0.5f * (dot16(uw[k], x) + dot16(c2, x)); }
                else part[k] = dot16(uw[k], x);
            }
#pragma unroll
            for (int st = 0; st < 4; ++st) {
                const int m = 1 << st, nh = 8 >> st; const bool up = (lane & m) != 0;
#pragma unroll
                for (int i = 0; i < nh; ++i) {
                    const float send = up ? part[i] : part[i + nh], keep = up ? part[i + nh] : part[i];
                    part[i] = keep + __shfl_xor(send, m);
                }
            }
            float d = part[0]; d += __shfl_xor(d, 16); d += __shfl_xor(d, 32);
            const float gk = __shfl(greg, lb + kl);
            const float cf = gk * gelu_tanh(d * su * rstd) * sv;
            __builtin_amdgcn_sched_barrier(0);
            { const bool lasth = (hq == 8 * REPS(7) - 1); const int hn = (hh + 1) & 7;
              const int nreg = lasth ? nei0 : (hn < 4 ? ei0 : ei1); const int nlb = (hn & 3) * 16;
#pragma unroll
              for (int k = 0; k < 16; ++k) { const int e = __builtin_amdgcn_readlane(nreg, nlb + k); uw[k] = U8[(size_t)e * 64]; } }
            __builtin_amdgcn_sched_barrier(0);
#pragma unroll
            for (int k = 0; k < 16; ++k) {
                const int src = ((k & 1) << 3) | ((k & 2) << 1) | ((k & 4) >> 1) | ((k & 8) >> 3);
                const float ck = __uint_as_float(__builtin_amdgcn_readlane(__float_as_uint(cf), src));
                if (REPS(9) == 2) { v2u c2 = vw[k]; asm volatile("" : "+v"(c2)); axpy16(out, 0.5f * ck, vw[k]); axpy16(out, 0.5f * ck, c2); }
                else axpy16(out, ck, vw[k]);
            }
        }
        if (REPS(7) == 2) {
#pragma unroll
            for (int i = 0; i < 8; ++i) out[i] = out[i] * 0.5f; }
        f32x4 o[4]; float s2 = 0.f;
        GAS f32x4* hp = (GAS f32x4*)(H + (size_t)t * 1024 + lane * 16);
#pragma unroll
        for (int j = 0; j < 4; ++j) { o[j] = (f32x4){hrow[j].x + out[2 * j].x, hrow[j].y + out[2 * j].y, hrow[j].z + out[2 * j + 1].x, hrow[j].w + out[2 * j + 1].y}; hp[j] = o[j];
            s2 += (o[j].x * o[j].x + o[j].y * o[j].y) + (o[j].z * o[j].z + o[j].w * o[j].w); }
        GAS v4u* hb = (GAS v4u*)(HB + (size_t)t * 1024 + lane * 16);
        v4u w0; w0.x = pk2(o[0].x, o[0].y); w0.y = pk2(o[0].z, o[0].w); w0.z = pk2(o[1].x, o[1].y); w0.w = pk2(o[1].z, o[1].w);
        v4u w1; w1.x = pk2(o[2].x, o[2].y); w1.y = pk2(o[2].z, o[2].w); w1.z = pk2(o[3].x, o[3].y); w1.w = pk2(o[3].z, o[3].w);
        hb[0] = w0; hb[1] = w1;
        s2 = wave_sum(s2);
        if (lane == 0) RS2[t] = s2;
        { const GAS f32x4* hn = (const GAS f32x4*)(H + (size_t)tn * 1024 + lane * 16);
#pragma unroll
          for (int j = 0; j < 4; ++j) hrow[j] = hn[j]; }
        ei0 = nei0; ei1 = nei1; gg0 = ngg0; gg1 = ngg1;
    }
}

__device__ __forceinline__ void final_phase(const Ptrs& P, int vcu, int G, int wave, int lane) {
    const int gw = vcu * NWAVES + wave, NGW = G * NWAVES; const float* RS3 = (const float*)(P.ws + WS_RS3);
    const GAS f32x4* gf = (const GAS f32x4*)P.g_final + lane;
    f32x4 g[4];
#pragma unroll
    for (int j = 0; j < 4; ++j) g[j] = gf[64 * j];
    for (int m = gw; m < M; m += NGW) {
        GAS f32x4* xr = (GAS f32x4*)(P.out + (size_t)m * D) + lane;
        float rs = 0.f; { const GAS f32x4* rp = (const GAS f32x4*)(RS3 + (size_t)m * 16);
#pragma unroll
            for (int i = 0; i < 4; ++i) { const f32x4 a = rp[i]; rs += (a.x + a.y) + (a.z + a.w); } }
        const float rstd = __builtin_amdgcn_rsqf(rs * (1.0f / 1024.0f) + EPS);
#pragma unroll
        for (int j = 0; j < 4; ++j) { const f32x4 v = xr[64 * j]; xr[64 * j] = v * rstd * g[j]; }
    }
}

struct Args { const float* in[17]; float* out; unsigned char* ws; int ph_lo, ph_hi; };
#ifndef PG8_SP2
#define PG8_SP2 true
#endif
#ifndef PG8_ALIGN
#define PG8_ALIGN true
#endif
__global__ void __launch_bounds__(NWAVES * 64, 2) mega_fwd(Args args) {
    extern __shared__ __attribute__((aligned(16))) unsigned char lds_raw[];
    LAS unsigned char* lds = (LAS unsigned char*)lds_raw;
    volatile LAS unsigned* MISC = (volatile LAS unsigned*)(lds + MISC_OFF);
    const int tid = threadIdx.x, lane = tid & 63, wave = __builtin_amdgcn_readfirstlane(tid >> 6);
    const int G = gridDim.x, bx = blockIdx.x; const int vcu = (G % 8 == 0) ? (bx % 8) * (G / 8) + bx / 8 : bx;
    Ptrs P;
    P.x = args.in[0]; P.p = args.in[1]; P.g_mix = args.in[2]; P.w_in = args.in[3]; P.conv_w = args.in[4]; P.pool_w = args.in[5]; P.pool_scale = args.in[6]; P.w_o = args.in[7];
    P.g_ffn = args.in[8]; P.w_q = args.in[9]; P.sub_keys = args.in[10]; P.eu = args.in[11]; P.ev = args.in[12]; P.g_ple = args.in[13]; P.w_gate = args.in[14]; P.w_proj = args.in[15]; P.g_final = args.in[16];
    P.out = args.out; P.ws = args.ws;
    gu32* ctl = (gu32*)(P.ws + WS_CTL);
    for (int u = tid; u < (LDS_BYTES - LDSCTL_OFF) / 4; u += NWAVES * 64) ((LAS unsigned*)(lds + LDSCTL_OFF))[u] = 0u;
    __syncthreads();
    XcdBarrier bar; bar.bar = (unsigned*)(ctl + CW_BAR); bar.x = 0; bar.st = nullptr;
    if (!MK_PER_PHASE) bar = xcd_barrier_post((unsigned*)(ctl + CW_BAR), MISC + 8);
    const int lo = args.ph_lo, hi = args.ph_hi;
#define IN(k) (lo <= (k) && (k) < hi)
#define SEAM(k) do { if (IN(k) && IN((k) + 1)) xcd_barrier(bar); } while (0)
    pg8::bf16_t* const WIN = (pg8::bf16_t*)(P.ws + WS_WIN); pg8::bf16_t* const WO = (pg8::bf16_t*)(P.ws + WS_WO); pg8::bf16_t* const WQ = (pg8::bf16_t*)(P.ws + WS_WQ);
    pg8::bf16_t* const WG = (pg8::bf16_t*)(P.ws + WS_WG); pg8::bf16_t* const WP = (pg8::bf16_t*)(P.ws + WS_WP);
    pg8::bf16_t* const XB = (pg8::bf16_t*)(P.ws + WS_XB); pg8::bf16_t* const PL = XB; pg8::bf16_t* const PROJ = (pg8::bf16_t*)(P.ws + WS_PROJ); pg8::bf16_t* const QB = PROJ;
    pg8::bf16_t* const MIX = (pg8::bf16_t*)(P.ws + WS_MIX); pg8::bf16_t* const HB = (pg8::bf16_t*)(P.ws + WS_HB); pg8::bf16_t* const PB = (pg8::bf16_t*)(P.ws + WS_PB);

    if (IN(0)) { for (int rep = 0; rep < REPS(1); ++rep) { p0a_phase(P, lds, vcu, G, tid, wave, lane); SEAM(0); } }
    if (IN(1)) { p0b_phase(P, lds, vcu, G, wave, lane); SEAM(1); }
    if (IN(2)) {
        pg8::Gemm g{XB, WIN, M, NPROJ, D}; pg8::StaticOrder S; S.init(M, NPROJ, G, bx);
        EpiBf16Row E{PROJ, NPROJ, (const float*)(P.ws + WS_RSX)};
        for (int rep = 0; rep < REPS(2); ++rep) { pg8::gemm_phase<EpiBf16Row, pg8::StaticOrder, PG8_ALIGN, PG8_SP2>(lds, g, S, E);
        SEAM(2); }
    }
    if (IN(3)) {
        for (int rep = 0; rep < REPS(3); ++rep) p2_phase(P, vcu, G, tid);
        pg8::Gemm g{PB, WP, M, D, PLED}; pg8::StaticOrder S; S.init(M, D, G, bx);
        EpiBf16Row E{PL, D, nullptr};
        for (int rep = 0; rep < REPS(8); ++rep) pg8::gemm_phase<EpiBf16Row, pg8::StaticOrder, PG8_ALIGN, PG8_SP2>(lds, g, S, E);
        SEAM(3);
    }
    if (IN(4)) {
        pg8::Gemm g{MIX, WO, M, D, D}; pg8::StaticOrder S; S.init(M, D, G, bx);
        EpiH1 E{P.x, P.out, HB, (float*)(P.ws + WS_RS1)};
        for (int rep = 0; rep < REPS(4); ++rep) { pg8::gemm_phase<EpiH1, pg8::StaticOrder, PG8_ALIGN, PG8_SP2>(lds, g, S, E);
        SEAM(4); }
    }
    if (IN(5)) {
        pg8::Gemm g{HB, WQ, M, NQ, D}; pg8::StaticOrder S; S.init(M, NQ, G, bx);
        EpiBf16Row E{QB, NQ, nullptr};
        for (int rep = 0; rep < REPS(5); ++rep) { pg8::gemm_phase<EpiBf16Row, pg8::StaticOrder, PG8_ALIGN, PG8_SP2>(lds, g, S, E);
        SEAM(5); }
    }
    if (IN(6)) { for (int rep = 0; rep < REPS(6); ++rep) { score_phase(P, lds, bx, G, tid, wave, lane); SEAM(6); } }
    if (IN(7)) { peer_phase(P, vcu, G, wave, lane); SEAM(7); }
    if (IN(8)) {
        pg8::Gemm g{HB, WG, M, D, D}; pg8::StaticOrder S; S.init(M, D, G, bx);
        EpiGate E{P.out, PL, (const float*)(P.ws + WS_RS2), (float*)(P.ws + WS_RS3)};
        pg8::gemm_phase<EpiGate, pg8::StaticOrder, PG8_ALIGN, PG8_SP2>(lds, g, S, E);
        SEAM(8);
    }
    if (IN(9)) { final_phase(P, vcu, G, wave, lane); }
#undef IN
#undef SEAM
}

extern "C" void kernel_launch(void* const* d_in, const int* in_sizes, int n_in, void* d_out, int out_size, void* d_ws, size_t ws_size, hipStream_t stream) {
    static int grid = 0;
    if (grid == 0) {
        if (n_in != 17 || in_sizes[0] != M * D || out_size != M * D || ws_size < WS_END) { fprintf(stderr, "kernel_launch: unexpected shapes (n_in %d, in0 %d, out %d, ws %zu); nothing launched\n", n_in, n_in > 0 ? in_sizes[0] : -1, out_size, ws_size); grid = -1; return; }
        int dev = 0, cus = 0, per_cu = 0;
        if (hipGetDevice(&dev) != hipSuccess || hipDeviceGetAttribute(&cus, hipDeviceAttributeMultiprocessorCount, dev) != hipSuccess) { fprintf(stderr, "kernel_launch: device query failed\n"); grid = -1; return; }
        if (hipFuncSetAttribute((const void*)mega_fwd, hipFuncAttributeMaxDynamicSharedMemorySize, LDS_BYTES) != hipSuccess) { fprintf(stderr, "kernel_launch: hipFuncSetAttribute failed\n"); grid = -1; return; }
        if (hipOccupancyMaxActiveBlocksPerMultiprocessor(&per_cu, (const void*)mega_fwd, NWAVES * 64, LDS_BYTES) != hipSuccess || per_cu < 1)
            fprintf(stderr, "kernel_launch: note: occupancy query reports %d workgroups per CU\n", per_cu);
        (void)hipGetLastError();
        grid = cus;
    }
    if (grid < 0) return;
    if (hipMemsetAsync((char*)d_ws + WS_CTL, 0, CTL_ZERO_BYTES, stream) != hipSuccess) { fprintf(stderr, "kernel_launch: memset failed\n"); return; }
    Args a{};
    for (int i = 0; i < 17; ++i) a.in[i] = (const float*)d_in[i];
    a.out = (float*)d_out; a.ws = (unsigned char*)d_ws;
#if MK_PER_PHASE
    for (int ph = 0; ph < NPHASES; ++ph) { a.ph_lo = ph; a.ph_hi = ph + 1; hipLaunchKernelGGL(mega_fwd, dim3(grid), dim3(NWAVES * 64), LDS_BYTES, stream, a); }
#else
    a.ph_lo = 0; a.ph_hi = NPHASES;
    hipLaunchKernelGGL(mega_fwd, dim3(grid), dim3(NWAVES * 64), LDS_BYTES, stream, a);
#endif
    const hipError_t le = hipPeekAtLastError();
    if (le != hipSuccess) fprintf(stderr, "kernel_launch: launch failed: %s\n", hipGetErrorName(le));
}
```

```cpp
#include <hip/hip_runtime.h>
#include <cstdio>
#include <cstdint>
namespace pg8 {
#define PG8_LAS __attribute__((address_space(3)))
typedef unsigned short bf16_t;
typedef short bf16x8 __attribute__((ext_vector_type(8)));
typedef float f32x4 __attribute__((ext_vector_type(4)));
typedef unsigned u32x4 __attribute__((ext_vector_type(4)));
constexpr int BM = 256, BK = 64, HALF = 128, HTB = HALF * BK * 2  , STAGE_BYTES = 8 * HTB, NXCD = 8, WGM = 8;

__host__ __device__ __forceinline__ int lds_byte(int r, int c) { const int st = (r >> 4) * 2 + (c >> 5), rr = r & 15, cc = c & 31, ob = rr * 64 + cc * 2; return st * 1024 + (ob ^ (((ob >> 9) & 1) << 5)); }
__host__ __device__ __forceinline__ void stage_rc(int b, int& R, int& C) { const int st = b / 1024, sb = b % 1024, swz = sb ^ (((sb >> 9) & 1) << 5); R = (st >> 1) * 16 + swz / 64; C = (st & 1) * 32 + (swz % 64) / 2; }
__host__ __device__ __forceinline__ int perm32(int rho) { const int n = rho >> 4, i = rho & 15; return 8 * (i >> 2) + 4 * n + (i & 3); }

struct Unit { int pm, pn; };
struct Gemm { const bf16_t* A; const bf16_t* Bt; int M, N, K; };

struct StaticOrder {
    int nM, nN, nwg, G, c;
    __host__ __device__ void init(int M, int N, int G_, int c_) { nM = M / BM; nN = N / BM; nwg = nM * nN; G = G_; c = c_; }
    __host__ __device__ bool next(int i, Unit& u) const {
        const long L = (long)i * G + c; if (L >= nwg) return false;
        int wgid = (int)L; { const int q = nwg / NXCD, r = nwg % NXCD, xcd = wgid % NXCD, off = wgid / NXCD; wgid = (xcd < r ? xcd * (q + 1) : r * (q + 1) + (xcd - r) * q) + off; }
        const int nig = WGM * nN, gid = wgid / nig, fm = gid * WGM, gsz = (nM - fm) < WGM ? (nM - fm) : WGM;
        u.pm = fm + ((wgid % nig) % gsz); u.pn = (wgid % nig) / gsz; return true;
    }
    __device__ __forceinline__ void a_ready(const Unit&) const {}
    __device__ __forceinline__ void done(const Unit&) const {}
};

__device__ __forceinline__ unsigned cvt_pk_bf16(float lo, float hi) { unsigned r; asm volatile("v_cvt_pk_bf16_f32 %0, %1, %2" : "=v"(r) : "v"(lo), "v"(hi)); return r; }
template <class Epi, class Sched, bool ALIGN_EPI = false, bool SP2 = false>
__device__ __forceinline__ void gemm_phase(PG8_LAS unsigned char* lds, const Gemm g, const Sched& S, const Epi& E) {
    const int tid = threadIdx.x, wid = __builtin_amdgcn_readfirstlane(tid >> 6), lane = tid & 63, wr = wid >> 2, wc = wid & 3, fr = lane & 15, fq = lane >> 4;
    const int K = g.K, nt = K / BK;
    unsigned voffA[2], voffB[2];
#pragma unroll
    for (int i = 0; i < 2; ++i) { int R, C; stage_rc(tid * 16 + i * 8192, R, C); const int Rb = Epi::PERM ? ((R & ~31) + perm32(R & 31)) : R;
        voffA[i] = (unsigned)(R * K + C) * 2u; voffB[i] = (unsigned)(Rb * K + C) * 2u; }
    const size_t kstep = (size_t)(BK * 2);
    const size_t hstep = (size_t)HALF * K * 2;
    const size_t tstep = 2 * hstep;
    const unsigned ldsw = (unsigned)wid * 1024u;
    const int aoff = lds_byte(wr * 64 + fr, fq * 8), boff = lds_byte(wc * 32 + fr, fq * 8);
#define PG8_SA(b, h) (((b) * 2 + (h)) * HTB)
#define PG8_SB(b, h) ((4 + (b) * 2 + (h)) * HTB)
#define PG8_STAGE(bufoff, gbase, voff) do { _Pragma("unroll") for (int _i = 0; _i < 2; ++_i) \
        __builtin_amdgcn_global_load_lds((const unsigned*)((const char*)(gbase) + (voff)[_i]), (PG8_LAS unsigned*)(lds + (bufoff) + ldsw + _i * 8192), 16, 0, 0); } while (0)
#define PG8_LDA(dst, b, h) do { _Pragma("unroll") for (int m = 0; m < 4; ++m) _Pragma("unroll") for (int k = 0; k < 2; ++k) dst[m][k] = *(const PG8_LAS bf16x8*)(lds + PG8_SA(b, h) + aoff + m * 2048 + k * 1024); } while (0)
#define PG8_LDB(dst, b, h) do { _Pragma("unroll") for (int n = 0; n < 2; ++n) _Pragma("unroll") for (int k = 0; k < 2; ++k) dst[n][k] = *(const PG8_LAS bf16x8*)(lds + PG8_SB(b, h) + boff + n * 2048 + k * 1024); } while (0)
#define PG8_MMA(ai, bj, At, Bt) do { __builtin_amdgcn_s_setprio(1); _Pragma("unroll") for (int m = 0; m < 4; ++m) _Pragma("unroll") for (int n = 0; n < 2; ++n) _Pragma("unroll") for (int k = 0; k < 2; ++k) \
        acc[ai][bj][m][n] = __builtin_amdgcn_mfma_f32_16x16x32_bf16(Bt[n][k], At[m][k], acc[ai][bj][m][n], 0, 0, 0); __builtin_amdgcn_s_setprio(0); } while (0)
#define PG8_WAIT_V(n) asm volatile("s_waitcnt vmcnt(" #n ")" ::: "memory")
#define PG8_WAIT_L(n) asm volatile("s_waitcnt lgkmcnt(" #n ")" ::: "memory")
#define PG8_BAR __builtin_amdgcn_s_barrier()
#define PG8_SCHED __builtin_amdgcn_sched_barrier(0)
    Unit cur, nxt; int ui = 0;
    if (!S.next(0, cur)) return;
    f32x4 acc[2][2][4][2];
#pragma unroll
    for (int a = 0; a < 2; ++a)
#pragma unroll
        for (int b = 0; b < 2; ++b)
#pragma unroll
            for (int m = 0; m < 4; ++m)
#pragma unroll
                for (int n = 0; n < 2; ++n) acc[a][b][m][n] = (f32x4){0.f, 0.f, 0.f, 0.f};
    bf16x8 At[4][2], B0[2][2], B1[2][2];
    const char* cA = (const char*)g.A + (size_t)cur.pm * tstep; const char* cB = (const char*)g.Bt + (size_t)cur.pn * tstep;
    S.a_ready(cur);
    if constexpr (SP2) {
        PG8_STAGE(PG8_SB(0, 0), cB, voffB); PG8_STAGE(PG8_SB(0, 1), cB + hstep, voffB); PG8_STAGE(PG8_SA(0, 0), cA, voffA); PG8_STAGE(PG8_SA(0, 1), cA + hstep, voffA);
        if (wr == 1) PG8_BAR;
        PG8_WAIT_V(2); PG8_BAR;
        PG8_STAGE(PG8_SB(1, 0), cB + kstep, voffB); PG8_STAGE(PG8_SA(1, 0), cA + kstep, voffA); PG8_STAGE(PG8_SB(1, 1), cB + hstep + kstep, voffB);
        PG8_WAIT_V(6); PG8_BAR;
    } else {
        PG8_STAGE(PG8_SB(0, 0), cB, voffB); PG8_STAGE(PG8_SA(0, 0), cA, voffA); PG8_STAGE(PG8_SB(0, 1), cB + hstep, voffB); PG8_STAGE(PG8_SA(0, 1), cA + hstep, voffA);
        if (wr == 1) PG8_BAR;
        PG8_WAIT_V(4); PG8_BAR;
        PG8_STAGE(PG8_SB(1, 0), cB + kstep, voffB); PG8_STAGE(PG8_SA(1, 0), cA + kstep, voffA); PG8_STAGE(PG8_SB(1, 1), cB + hstep + kstep, voffB);
        PG8_WAIT_V(6); PG8_BAR;
    }
    for (;;) {
        const bool has_next = S.next(ui + 1, nxt);
        const char* nA = has_next ? (const char*)g.A + (size_t)nxt.pm * tstep : cA; const char* nB = has_next ? (const char*)g.Bt + (size_t)nxt.pn * tstep : cB;
        for (int t = 0; t < nt; t += 2) {
            const bool last = (t == nt - 2);
            const char* a1 = cA + (size_t)(t + 1) * kstep;
            const char* a2 = last ? nA : cA + (size_t)(t + 2) * kstep; const char* b2 = last ? nB : cB + (size_t)(t + 2) * kstep;
            const char* a3 = a2 + kstep; const char* b3 = b2 + kstep;
            if (last && has_next) S.a_ready(nxt);
            if constexpr (SP2) {
            PG8_LDB(B0, 0, 0); PG8_LDB(B1, 0, 1); PG8_SCHED; PG8_LDA(At, 0, 0); PG8_STAGE(PG8_SA(1, 1), a1 + hstep, voffA);
            PG8_WAIT_V(8); PG8_WAIT_L(0); PG8_BAR; PG8_MMA(0, 0, At, B0); PG8_MMA(0, 1, At, B1); PG8_BAR; PG8_SCHED;
            PG8_LDA(At, 0, 1); PG8_STAGE(PG8_SB(0, 0), b2, voffB); PG8_STAGE(PG8_SB(0, 1), b2 + hstep, voffB); PG8_STAGE(PG8_SA(0, 0), a2, voffA);
            PG8_WAIT_V(8); PG8_WAIT_L(0); PG8_BAR; PG8_MMA(1, 0, At, B0); PG8_MMA(1, 1, At, B1); PG8_BAR; PG8_SCHED;
            PG8_LDB(B0, 1, 0); PG8_LDB(B1, 1, 1); PG8_SCHED; PG8_LDA(At, 1, 0); PG8_STAGE(PG8_SA(0, 1), a2 + hstep, voffA);
            PG8_WAIT_V(8); PG8_WAIT_L(0); PG8_BAR; PG8_MMA(0, 0, At, B0); PG8_MMA(0, 1, At, B1); PG8_BAR; PG8_SCHED;
            PG8_LDA(At, 1, 1); PG8_STAGE(PG8_SB(1, 0), b3, voffB); PG8_STAGE(PG8_SB(1, 1), b3 + hstep, voffB); PG8_STAGE(PG8_SA(1, 0), a3, voffA);
            PG8_WAIT_V(8); PG8_WAIT_L(0); PG8_BAR; PG8_MMA(1, 0, At, B0); PG8_MMA(1, 1, At, B1); PG8_BAR; PG8_SCHED;
            } else {
            PG8_LDB(B0, 0, 0); PG8_SCHED; PG8_LDA(At, 0, 0); PG8_STAGE(PG8_SA(1, 1), a1 + hstep, voffA);
            PG8_WAIT_L(8); PG8_BAR; PG8_WAIT_L(0); PG8_MMA(0, 0, At, B0); PG8_BAR; PG8_SCHED;
            PG8_LDB(B1, 0, 1); PG8_STAGE(PG8_SB(0, 0), b2, voffB);
            PG8_BAR; PG8_WAIT_L(0); PG8_MMA(0, 1, At, B1); PG8_BAR;
            PG8_LDA(At, 0, 1); PG8_STAGE(PG8_SA(0, 0), a2, voffA);
            PG8_BAR; PG8_WAIT_L(0); PG8_MMA(1, 0, At, B0); PG8_BAR; PG8_SCHED;
            PG8_STAGE(PG8_SB(0, 1), b2 + hstep, voffB);
            PG8_WAIT_V(6); PG8_BAR; PG8_MMA(1, 1, At, B1); PG8_BAR;
            PG8_LDB(B0, 1, 0); PG8_SCHED; PG8_LDA(At, 1, 0); PG8_STAGE(PG8_SA(0, 1), a2 + hstep, voffA);
            PG8_WAIT_L(8); PG8_BAR; PG8_WAIT_L(0); PG8_MMA(0, 0, At, B0); PG8_BAR; PG8_SCHED;
            PG8_LDB(B1, 1, 1); PG8_STAGE(PG8_SB(1, 0), b3, voffB);
            PG8_BAR; PG8_WAIT_L(0); PG8_MMA(0, 1, At, B1); PG8_BAR;
            PG8_LDA(At, 1, 1); PG8_STAGE(PG8_SA(1, 0), a3, voffA);
            PG8_BAR; PG8_WAIT_L(0); PG8_MMA(1, 0, At, B0); PG8_BAR; PG8_SCHED;
            PG8_STAGE(PG8_SB(1, 1), b3 + hstep, voffB);
            PG8_WAIT_V(6); PG8_BAR; PG8_MMA(1, 1, At, B1); PG8_BAR;
            }
        }
        if constexpr (ALIGN_EPI) { if (wr == 0) PG8_BAR; }
        if constexpr (!Epi::AFTER_DRAIN) { E(acc, cur, wr, wc, fr, fq); S.done(cur); }
        if (!has_next) break;
#pragma unroll
        for (int a = 0; a < 2; ++a)
#pragma unroll
            for (int b = 0; b < 2; ++b)
#pragma unroll
                for (int m = 0; m < 4; ++m)
#pragma unroll
                    for (int n = 0; n < 2; ++n) acc[a][b][m][n] = (f32x4){0.f, 0.f, 0.f, 0.f};
        cur = nxt; cA = nA; cB = nB; ++ui;
        if constexpr (ALIGN_EPI) { if (wr == 1) PG8_BAR; }
    }
    PG8_WAIT_V(0);
    if constexpr (!ALIGN_EPI) { if (wr == 0) PG8_BAR; }
    PG8_BAR;
    if constexpr (Epi::AFTER_DRAIN) { E.fused(acc, cur, wr, wc, fr, fq, lds, wid, lane); S.done(cur); }
#undef PG8_SA
#undef PG8_SB
#undef PG8_STAGE
#undef PG8_LDA
#undef PG8_LDB
#undef PG8_MMA
#undef PG8_WAIT_V
#undef PG8_WAIT_L
#undef PG8_BAR
#undef PG8_SCHED
}
}

#define GAS __attribute__((address_space(1)))
#define LAS __attribute__((address_space(3)))
typedef unsigned short bf16;
typedef unsigned v4u __attribute__((ext_vector_type(4)));
typedef float f32x4 __attribute__((ext_vector_type(4)));
typedef short bf16x8 __attribute__((ext_vector_type(8)));
typedef GAS unsigned gu32;
typedef GAS unsigned long long gu64;
#define RLX_AGENT __ATOMIC_RELAXED, __HIP_MEMORY_SCOPE_AGENT
#define LDS_WAIT() asm volatile("s_waitcnt lgkmcnt(0)" ::: "memory")
#define VM_WAIT() asm volatile("s_waitcnt vmcnt(0)" ::: "memory")
__device__ __forceinline__ unsigned long long rt() { return __builtin_amdgcn_s_memrealtime(); }
__device__ __forceinline__ unsigned f2bf(float f) { unsigned u = __builtin_bit_cast(unsigned, f); return (u + 0x7fffu + ((u >> 16) & 1u)) >> 16; }
__device__ __forceinline__ unsigned pk2(float lo, float hi) { return f2bf(lo) | (f2bf(hi) << 16); }

#define XB_TMO      128
#define XB_XCNT(j)  (256  + 64 * (j))
#define XB_XSUB(j)  (1280 + 64 * (j))
#define XB_XGEN(j)  (2304 + 64 * (j))
#define XB_TOP      3328
#define XB_TOPGEN   3392
#define XCD_BAR_WORDS 3456
#define XB_SPIN_CAP (1u << 18)

__device__ __forceinline__ unsigned xb_ld(unsigned* p)              { return __hip_atomic_load(p, __ATOMIC_RELAXED, __HIP_MEMORY_SCOPE_AGENT); }
__device__ __forceinline__ unsigned xb_add(unsigned* p, unsigned v) { return __hip_atomic_fetch_add(p, v, __ATOMIC_RELAXED, __HIP_MEMORY_SCOPE_AGENT); }
__device__ __forceinline__ unsigned xb_xcc_id() { return (unsigned)__builtin_amdgcn_s_getreg((3 << 11) | 20) & 0xFu; }
#define XB_SPIN(cond, bar) do { unsigned _sp = 0; while (cond) { __builtin_amdgcn_s_sleep(1); \
    if ((++_sp & 255u) == 0u) { if (xb_ld(&(bar)[XB_TMO])) break; if (_sp > XB_SPIN_CAP) { atomicAdd(&(bar)[XB_TMO], 1u); break; } } } } while (0)

struct XcdBarrier {
    unsigned* bar; unsigned x;
    volatile LAS unsigned* st;
};

__device__ __forceinline__ XcdBarrier xcd_barrier_post(unsigned* bar, volatile LAS unsigned* st) {
    XcdBarrier b; b.bar = bar; b.x = xb_xcc_id(); b.st = st;
    if (threadIdx.x == 0) (void)xb_add(&bar[XB_XCNT(b.x)], 1u);
    return b;
}
__device__ __forceinline__ void xcd_barrier_complete(unsigned* bar, unsigned x, unsigned& nloc, unsigned& nx) {
    const unsigned G = gridDim.x * gridDim.y * gridDim.z;
    unsigned sum, cnt, mine, sp = 0u;
    for (;;) {
        sum = 0u; cnt = 0u; mine = 0u;
#pragma unroll
        for (unsigned j = 0; j < 16; ++j) { const unsigned c = xb_ld(&bar[XB_XCNT(j)]); sum += c; cnt += (c > 0u) ? 1u : 0u; mine = (j == x) ? c : mine; }
        if (sum == G) break;
        __builtin_amdgcn_s_sleep(1);
        if ((++sp & 255u) == 0u) { if (xb_ld(&bar[XB_TMO])) break; if (sp > XB_SPIN_CAP) { atomicAdd(&bar[XB_TMO], 1u); break; } }
    }
    nloc = mine > 0u ? mine : 1u; nx = cnt > 0u ? cnt : 1u;
}

__device__ __forceinline__ void xcd_barrier(const XcdBarrier& b) {
    asm volatile("s_waitcnt vmcnt(0)" ::: "memory");
    __syncthreads();
    if (threadIdx.x == 0) {
        unsigned* bar = b.bar;
        __builtin_amdgcn_s_waitcnt(0);
        unsigned nloc = b.st[0], nx = b.st[1];
        if (nloc == 0u) { xcd_barrier_complete(bar, b.x, nloc, nx); b.st[0] = nloc; b.st[1] = nx; }
        const unsigned old = xb_add(&bar[XB_XSUB(b.x)], 1u);
        const unsigned gen = old / nloc;
        if (old + 1u == (gen + 1u) * nloc) {
            __builtin_amdgcn_fence(__ATOMIC_RELEASE, "agent");
            asm volatile("s_waitcnt vmcnt(0)" ::: "memory");
            const unsigned og = xb_add(&bar[XB_TOP], 1u);
            const unsigned tg = og / nx;
            if (og + 1u == (tg + 1u) * nx) xb_add(&bar[XB_TOPGEN], 1u);
            else XB_SPIN(xb_ld(&bar[XB_TOPGEN]) == tg, bar);
            __builtin_amdgcn_fence(__ATOMIC_ACQUIRE, "agent");
            xb_add(&bar[XB_XGEN(b.x)], 1u);
            asm volatile("s_waitcnt vmcnt(0)" ::: "memory");
        } else {
            XB_SPIN(xb_ld(&bar[XB_XGEN(b.x)]) == gen, bar);
            __builtin_amdgcn_fence(__ATOMIC_ACQUIRE, "agent");
            asm volatile("s_waitcnt vmcnt(0)" ::: "memory");
        }
    }
    __syncthreads();
}

constexpr int NWAVES = 8;
constexpr int M = 32768, D = 1024, SEQ = 4096, NPROJ = 2048, NQ = 2048, PLED = 256, NEXP = 16384;
constexpr float EPS = 1e-6f;
#ifndef MK_PER_PHASE
#define MK_PER_PHASE 0
#endif
#ifndef PROBE_REP
#define PROBE_REP 0
#endif
#define REPS(k) ((PROBE_REP == (k)) ? 2 : 1)
constexpr int NPHASES = 10;

constexpr size_t MiB = 1u << 20;
constexpr size_t WS_CTL = 0, CTL_ZERO_BYTES = 1 * MiB;
constexpr size_t WS_WIN = 2 * MiB, WS_WO = 6 * MiB, WS_WQ = 8 * MiB, WS_WG = 12 * MiB, WS_WP = 14 * MiB, WS_KEYS = 14 * MiB + 512 * 1024;
constexpr size_t WS_WF = 15 * MiB;
constexpr size_t WS_RSX = 17 * MiB, WS_RS2 = 17 * MiB + 512 * 1024, WS_RS1 = 18 * MiB, WS_RS3 = 20 * MiB;
constexpr size_t WS_SU = 22 * MiB, WS_SV = 22 * MiB + 65536;
constexpr size_t WS_U = 24 * MiB, WS_V = 56 * MiB;
constexpr size_t WS_XB = 88 * MiB;
constexpr size_t WS_PROJ = 152 * MiB;
constexpr size_t WS_MIX = 280 * MiB;
constexpr size_t WS_HB = 344 * MiB;
constexpr size_t WS_EIDX = 408 * MiB, WS_GATE = 424 * MiB;
constexpr size_t WS_PB = 440 * MiB;
constexpr size_t WS_END = 456 * MiB;
constexpr int CW_BAR = 4096;
static_assert((CW_BAR + XCD_BAR_WORDS) * 4 <= (int)CTL_ZERO_BYTES, "CTL words inside the memset region");

constexpr int RING_BYTES = 131072;
constexpr int LDSCTL_OFF = RING_BYTES, MISC_OFF = LDSCTL_OFF + 320;
constexpr int LDS_BYTES = 147456;

typedef float f32x16 __attribute__((ext_vector_type(16)));
typedef _Float16 h2_t __attribute__((ext_vector_type(2)));
typedef float f32x2 __attribute__((ext_vector_type(2)));
typedef int i32x4 __attribute__((ext_vector_type(4)));
typedef unsigned v2u __attribute__((ext_vector_type(2)));

__device__ __forceinline__ float wave_sum(float v) {
#pragma unroll
    for (int o = 1; o < 64; o <<= 1) v += __shfl_xor(v, o);
    return v;
}
__device__ __forceinline__ float bf_lo(unsigned w) { return __uint_as_float(w << 16); }
__device__ __forceinline__ float bf_hi(unsigned w) { return __uint_as_float(w & 0xffff0000u); }
__device__ __forceinline__ unsigned pkh(float lo, float hi) { f32x2 v = {lo, hi}; h2_t h = __builtin_convertvector(v, h2_t); return __builtin_bit_cast(unsigned, h); }

struct EpiBf16Row {
    static constexpr bool PERM = true, AFTER_DRAIN = false;
    pg8::bf16_t* O; int ldc; const float* rowss;
    __device__ __forceinline__ void operator()(const pg8::f32x4 (&acc)[2][2][4][2], const pg8::Unit& u, int wr, int wc, int fr, int fq) const {
        const int row0 = u.pm * 256 + wr * 64 + fr, col0 = u.pn * 256 + wc * 32 + 8 * fq;
#pragma unroll
        for (int ai = 0; ai < 2; ++ai)
#pragma unroll
            for (int m = 0; m < 4; ++m) {
                const int row = row0 + ai * 128 + m * 16;
                const float sc = rowss ? __builtin_amdgcn_rsqf(rowss[row] * (1.0f / 1024.0f) + EPS) : 1.0f;
                pg8::bf16_t* rowp = O + (size_t)row * ldc + col0;
#pragma unroll
                for (int bj = 0; bj < 2; ++bj) {
                    const pg8::f32x4 v0 = acc[ai][bj][m][0] * sc, v1 = acc[ai][bj][m][1] * sc;
                    pg8::u32x4 w; w.x = pg8::cvt_pk_bf16(v0[0], v0[1]); w.y = pg8::cvt_pk_bf16(v0[2], v0[3]); w.z = pg8::cvt_pk_bf16(v1[0], v1[1]); w.w = pg8::cvt_pk_bf16(v1[2], v1[3]);
                    *(pg8::u32x4*)(rowp + bj * 128) = w;
                }
            }
    }
};
struct EpiH1 {
    static constexpr bool PERM = true, AFTER_DRAIN = false;
    const float* X; float* H; pg8::bf16_t* HB; float* RS;
    __device__ __forceinline__ void operator()(const pg8::f32x4 (&acc)[2][2][4][2], const pg8::Unit& u, int wr, int wc, int fr, int fq) const {
        const int row0 = u.pm * 256 + wr * 64 + fr, col0 = u.pn * 256 + wc * 32 + 8 * fq;
#pragma unroll
        for (int ai = 0; ai < 2; ++ai)
#pragma unroll
            for (int m = 0; m < 4; ++m) {
                const int row = row0 + ai * 128 + m * 16; float s = 0.f;
#pragma unroll
                for (int bj = 0; bj < 2; ++bj) {
                    const size_t off = (size_t)row * 1024 + col0 + bj * 128;
                    const pg8::f32x4 x0 = *(const pg8::f32x4*)(X + off), x1 = *(const pg8::f32x4*)(X + off + 4);
                    const pg8::f32x4 v0 = acc[ai][bj][m][0] + x0, v1 = acc[ai][bj][m][1] + x1;
                    *(pg8::f32x4*)(H + off) = v0; *(pg8::f32x4*)(H + off + 4) = v1;
                    pg8::u32x4 w; w.x = pg8::cvt_pk_bf16(v0[0], v0[1]); w.y = pg8::cvt_pk_bf16(v0[2], v0[3]); w.z = pg8::cvt_pk_bf16(v1[0], v1[1]); w.w = pg8::cvt_pk_bf16(v1[2], v1[3]);
                    *(pg8::u32x4*)(HB + off) = w;
                    s += (v0[0] * v0[0] + v0[1] * v0[1]) + (v0[2] * v0[2] + v0[3] * v0[3]) + (v1[0] * v1[0] + v1[1] * v1[1]) + (v1[2] * v1[2] + v1[3] * v1[3]);
                }
                s += __shfl_xor(s, 16); s += __shfl_xor(s, 32);
                if (fq == 0) RS[(size_t)row * 16 + u.pn * 4 + wc] = s;
            }
    }
};
struct EpiGate {
    static constexpr bool PERM = true, AFTER_DRAIN = false;
    float* H; const pg8::bf16_t* PL; const float* RS2; float* RS3;
    __device__ __forceinline__ void operator()(const pg8::f32x4 (&acc)[2][2][4][2], const pg8::Unit& u, int wr, int wc, int fr, int fq) const {
        const int row0 = u.pm * 256 + wr * 64 + fr, col0 = u.pn * 256 + wc * 32 + 8 * fq;
#pragma unroll
        for (int ai = 0; ai < 2; ++ai)
#pragma unroll
            for (int m = 0; m < 4; ++m) {
                const int row = row0 + ai * 128 + m * 16; float s = 0.f;
                const float rstd = __builtin_amdgcn_rsqf(RS2[row] * (1.0f / 1024.0f) + EPS);
#pragma unroll
                for (int bj = 0; bj < 2; ++bj) {
                    const size_t off = (size_t)row * 1024 + col0 + bj * 128;
                    const pg8::u32x4 w = *(const pg8::u32x4*)(PL + off);
                    const pg8::f32x4 h0 = *(const pg8::f32x4*)(H + off), h1 = *(const pg8::f32x4*)(H + off + 4);
                    const pg8::f32x4 a0 = acc[ai][bj][m][0] * rstd, a1 = acc[ai][bj][m][1] * rstd;
                    pg8::f32x4 g0, g1;
#pragma unroll
                    for (int e = 0; e < 4; ++e) { g0[e] = 1.0f / (1.0f + __expf(-a0[e])); g1[e] = 1.0f / (1.0f + __expf(-a1[e])); }
                    const pg8::f32x4 p0 = {bf_lo(w.x), bf_hi(w.x), bf_lo(w.y), bf_hi(w.y)}, p1 = {bf_lo(w.z), bf_hi(w.z), bf_lo(w.w), bf_hi(w.w)};
#ifdef DBG_NO_PLE
                    const pg8::f32x4 v0 = h0, v1 = h1;
#else
                    const pg8::f32x4 v0 = h0 + g0 * p0, v1 = h1 + g1 * p1;
#endif
                    *(pg8::f32x4*)(H + off) = v0; *(pg8::f32x4*)(H + off + 4) = v1;
                    s += (v0[0] * v0[0] + v0[1] * v0[1]) + (v0[2] * v0[2] + v0[3] * v0[3]) + (v1[0] * v1[0] + v1[1] * v1[1]) + (v1[2] * v1[2] + v1[3] * v1[3]);
                }
                s += __shfl_xor(s, 16); s += __shfl_xor(s, 32);
                if (fq == 0) RS3[(size_t)row * 16 + u.pn * 4 + wc] = s;
            }
    }
};

__device__ __forceinline__ void p0_transpose_item(const float* W, int ldn, const float* gk, int K, bf16* WT, int row_off, int nblk, LAS float* scr, int item, int lane) {
    const int kb = item / nblk, nb = item % nblk, k0 = 64 * kb, n0 = 32 * nb;
#pragma unroll 8
    for (int i = 0; i < 32; ++i) { const int kk = 2 * i + (lane >> 5); float v = W[(size_t)(k0 + kk) * ldn + n0 + (lane & 31)]; if (gk) v *= gk[k0 + kk]; scr[kk * 33 + (lane & 31)] = v; }
    LDS_WAIT(); asm volatile("" ::: "memory");
    const int c = lane & 7;
#pragma unroll
    for (int j = 0; j < 4; ++j) { const int n = (lane >> 3) + 8 * j; const LAS float* s = scr + (8 * c) * 33 + n;
        v4u o; o.x = pk2(s[0 * 33], s[1 * 33]); o.y = pk2(s[2 * 33], s[3 * 33]); o.z = pk2(s[4 * 33], s[5 * 33]); o.w = pk2(s[6 * 33], s[7 * 33]);
        *(GAS v4u*)(WT + (size_t)(row_off + n0 + n) * K + k0 + 8 * c) = o; }
    LDS_WAIT(); asm volatile("" ::: "memory");
}

struct Ptrs {
    const float *x, *p, *g_mix, *w_in, *conv_w, *pool_w, *pool_scale, *w_o, *g_ffn, *w_q, *sub_keys, *eu, *ev, *g_ple, *w_gate, *w_proj, *g_final;
    float* out; unsigned char* ws;
};

__device__ __forceinline__ void p0a_phase(const Ptrs& P, LAS unsigned char* lds, int vcu, int G, int tid, int wave, int lane) {
    const int gw = vcu * NWAVES + wave, NGW = G * NWAVES;
    const int gt = vcu * (NWAVES * 64) + tid, NGT = G * NWAVES * 64;
    { float* Wf = (float*)(P.ws + WS_WF);
      for (int tk = gw; tk < 8192; tk += NGW) {
          const int k = tk >> 3, j = tk & 7, g = j >> 1, np = j * 64 + lane, d = np & 127;
          const float* wi = P.w_in + (size_t)k * 2048 + 1536 + g * 128; const float* pw = P.pool_w + (size_t)g * 128 * 128 + d;
          float a = 0.f;
#pragma unroll 8
          for (int c = 0; c < 128; ++c) a += wi[c] * pw[(size_t)c * 128];
          Wf[(size_t)k * 512 + np] = a * P.pool_scale[np];
      } }
    { LAS float* scr = (LAS float*)(lds + wave * 16384);
      constexpr int I_WO = 16 * 32, I_WQ = 16 * 64, I_WG = 16 * 32, I_WP = 4 * 32, I_WINA = 16 * 48;
      constexpr int NITEMS = I_WO + I_WQ + I_WG + I_WP + I_WINA;
      for (int it = gw; it < NITEMS; it += NGW) {
          int r = it;
          if (r < I_WO) { p0_transpose_item(P.w_o, 1024, nullptr, 1024, (bf16*)(P.ws + WS_WO), 0, 32, scr, r, lane); continue; } r -= I_WO;
          if (r < I_WQ) { p0_transpose_item(P.w_q, 2048, P.g_ffn, 1024, (bf16*)(P.ws + WS_WQ), 0, 64, scr, r, lane); continue; } r -= I_WQ;
          if (r < I_WG) { p0_transpose_item(P.w_gate, 1024, P.g_ple, 1024, (bf16*)(P.ws + WS_WG), 0, 32, scr, r, lane); continue; } r -= I_WG;
          if (r < I_WP) { p0_transpose_item(P.w_proj, 1024, nullptr, 256, (bf16*)(P.ws + WS_WP), 0, 32, scr, r, lane); continue; } r -= I_WP;
          p0_transpose_item(P.w_in, 2048, P.g_mix, 1024, (bf16*)(P.ws + WS_WIN), 0, 48, scr, r, lane);
      } }
    { const GAS f32x4* gf = (const GAS f32x4*)P.g_ffn + 4 * lane; f32x4 gq[4];
#pragma unroll
      for (int j = 0; j < 4; ++j) gq[j] = gf[j];
      for (int r = gw; r < 2 * NEXP; r += NGW) {
          const int tb = r >> 14, e = r & (NEXP - 1);
          const GAS f32x4* src = (const GAS f32x4*)((tb ? P.ev : P.eu) + (size_t)e * 1024) + 4 * lane;
          f32x4 a[4]; float q = 0.f;
#pragma unroll
          for (int j = 0; j < 4; ++j) { a[j] = src[j]; if (!tb) a[j] = a[j] * gq[j];
              q += (a[j].x * a[j].x + a[j].y * a[j].y) + (a[j].z * a[j].z + a[j].w * a[j].w); }
          q = wave_sum(q);
          const float rms = sqrtf(q * (1.0f / 1024.0f));
          const float sc = rms > 0.f ? 2.0f / rms : 0.f;
          unsigned w0 = 0u, w1 = 0u;
          w0 = __builtin_amdgcn_cvt_scalef32_pk_fp4_f32(w0, a[0].x * sc, a[0].y * sc, 1.0f, 0); w0 = __builtin_amdgcn_cvt_scalef32_pk_fp4_f32(w0, a[0].z * sc, a[0].w * sc, 1.0f, 1);
          w0 = __builtin_amdgcn_cvt_scalef32_pk_fp4_f32(w0, a[1].x * sc, a[1].y * sc, 1.0f, 2); w0 = __builtin_amdgcn_cvt_scalef32_pk_fp4_f32(w0, a[1].z * sc, a[1].w * sc, 1.0f, 3);
          w1 = __builtin_amdgcn_cvt_scalef32_pk_fp4_f32(w1, a[2].x * sc, a[2].y * sc, 1.0f, 0); w1 = __builtin_amdgcn_cvt_scalef32_pk_fp4_f32(w1, a[2].z * sc, a[2].w * sc, 1.0f, 1);
          w1 = __builtin_amdgcn_cvt_scalef32_pk_fp4_f32(w1, a[3].x * sc, a[3].y * sc, 1.0f, 2); w1 = __builtin_amdgcn_cvt_scalef32_pk_fp4_f32(w1, a[3].z * sc, a[3].w * sc, 1.0f, 3);
          ((GAS v2u*)(P.ws + (tb ? WS_V : WS_U)))[(size_t)e * 64 + lane] = (v2u){w0, w1};
          if (lane == 0) ((float*)(P.ws + (tb ? WS_SV : WS_SU)))[e] = rms * 0.5f;
      } }
    { const GAS f32x4* sp = (const GAS f32x4*)P.p; GAS v4u* dp = (GAS v4u*)(P.ws + WS_PB);
      for (int i = gt; i < M * PLED / 8; i += NGT) { const f32x4 a = sp[2 * (size_t)i], b = sp[2 * (size_t)i + 1]; v4u o; o.x = pk2(a.x, a.y); o.y = pk2(a.z, a.w); o.z = pk2(b.x, b.y); o.w = pk2(b.z, b.w); dp[i] = o; }
      const GAS f32x4* sk = (const GAS f32x4*)P.sub_keys; GAS v4u* dk = (GAS v4u*)(P.ws + WS_KEYS);
      for (int i = gt; i < 16 * 128 * 128 / 8; i += NGT) { const f32x4 a = sk[2 * (size_t)i], b = sk[2 * (size_t)i + 1]; v4u o; o.x = pk2(a.x, a.y); o.y = pk2(a.z, a.w); o.z = pk2(b.x, b.y); o.w = pk2(b.z, b.w); dk[i] = o; } }
    { float* RSX = (float*)(P.ws + WS_RSX); bf16* XB = (bf16*)(P.ws + WS_XB);
      for (int m = gw; m < M; m += NGW) {
          const GAS f32x4* xr = (const GAS f32x4*)(P.x + (size_t)m * D) + lane; f32x4 v[4]; float s = 0.f;
#pragma unroll
          for (int j = 0; j < 4; ++j) { v[j] = xr[64 * j]; s += (v[j].x * v[j].x + v[j].y * v[j].y) + (v[j].z * v[j].z + v[j].w * v[j].w); }
          s = wave_sum(s); if (lane == 0) RSX[m] = s;
          GAS unsigned long long* o8 = (GAS unsigned long long*)(XB + (size_t)m * D) + lane;
#pragma unroll
          for (int j = 0; j < 4; ++j) o8[64 * j] = (unsigned long long)pk2(v[j].x, v[j].y) | ((unsigned long long)pk2(v[j].z, v[j].w) << 32);
      } }
}
__device__ __forceinline__ void p0b_phase(const Ptrs& P, LAS unsigned char* lds, int vcu, int G, int wave, int lane) {
    const int gw = vcu * NWAVES + wave, NGW = G * NWAVES; LAS float* scr = (LAS float*)(lds + wave * 16384);
    for (int it = gw; it < 16 * 16; it += NGW) p0_transpose_item((const float*)(P.ws + WS_WF), 512, P.g_mix, 1024, (bf16*)(P.ws + WS_WIN), 1536, 16, scr, it, lane);
}

template <int HALF>
__device__ __forceinline__ void pool_chunk(const unsigned* col, unsigned* mx, int t0, int s0) {
    constexpr int TC = 32, NV = TC + 2 * HALF;
    float v0[NV], v1[NV];
#pragma unroll
    for (int i = 0; i < NV; ++i) {
        const int s = s0 - HALF + i; const bool ok = (s >= 0) && (s < SEQ);
        const unsigned w = col[(size_t)(ok ? (t0 - HALF + i) : t0) * 1024];
        v0[i] = ok ? bf_lo(w) : 0.f; v1[i] = ok ? bf_hi(w) : 0.f;
    }
    float S0 = 0.f, S1 = 0.f;
#pragma unroll
    for (int j = 0; j < 2 * HALF; ++j) { S0 += v0[j]; S1 += v1[j]; }
#pragma unroll
    for (int i = 0; i < TC; ++i) {
        const int s = s0 + i; const int lo = (s - HALF) > 0 ? (s - HALF) : 0, hi = (s + HALF) < SEQ ? (s + HALF) : SEQ;
        const float inv = 1.0f / (float)(hi - lo);
        mx[(size_t)(t0 + i) * 512] = pk2(S0 * inv - v0[i + HALF], S1 * inv - v1[i + HALF]);
        if (i + 1 < TC) { S0 += v0[i + 2 * HALF] - v0[i]; S1 += v1[i + 2 * HALF] - v1[i]; }
    }
}
__device__ __forceinline__ void p2_phase(const Ptrs& P, int vcu, int G, int tid, int wave) {
    const unsigned* PR = (const unsigned*)(P.ws + WS_PROJ);
    unsigned* MX = (unsigned*)(P.ws + WS_MIX);
    constexpr int TC = 32;
    for (int ck = vcu; ck < M / TC; ck += G) {
        const int t0 = ck * TC, s0 = t0 & (SEQ - 1);
        if (tid < 256) {
            const unsigned* col = PR + 768 + tid; unsigned* mx = MX + 256 + tid;
            if (wave == 0) pool_chunk<1>(col, mx, t0, s0); else if (wave == 1) pool_chunk<2>(col, mx, t0, s0); else if (wave == 2) pool_chunk<4>(col, mx, t0, s0); else pool_chunk<8>(col, mx, t0, s0);
        } else {
            const int cp = tid - 256;
            const unsigned* bcol = PR + cp; const unsigned* ccol = PR + 256 + cp; const unsigned* vcol = PR + 512 + cp;
            const float w00 = P.conv_w[2 * cp], w01 = P.conv_w[2 * cp + 1], w10 = P.conv_w[512 + 2 * cp], w11 = P.conv_w[512 + 2 * cp + 1], w20 = P.conv_w[1024 + 2 * cp], w21 = P.conv_w[1024 + 2 * cp + 1];
            float z0[TC + 2], z1[TC + 2]; unsigned bw[TC];
#pragma unroll
            for (int i = 0; i < TC + 2; ++i) {
                const int s = s0 - 1 + i; const bool ok = (s >= 0) && (s < SEQ); const size_t t = (size_t)(ok ? (t0 - 1 + i) : t0) * 1024;
                const unsigned c = ccol[t], v = vcol[t];
                z0[i] = ok ? bf_lo(c) * bf_lo(v) : 0.f; z1[i] = ok ? bf_hi(c) * bf_hi(v) : 0.f;
            }
#pragma unroll
            for (int i = 0; i < TC; ++i) bw[i] = bcol[(size_t)(t0 + i) * 1024];
#pragma unroll
            for (int i = 0; i < TC; ++i) {
                const float y0 = w00 * z0[i] + w10 * z0[i + 1] + w20 * z0[i + 2], y1 = w01 * z1[i] + w11 * z1[i + 1] + w21 * z1[i + 2];
                MX[(size_t)(t0 + i) * 512 + cp] = pk2(bf_lo(bw[i]) * y0, bf_hi(bw[i]) * y1);
            }
        }
    }
}

__device__ __forceinline__ float fmax_s(float a, float b) { float r; asm("v_max_f32_e32 %0, %1, %2" : "=v"(r) : "v"(a), "v"(b)); return r; }
__device__ __forceinline__ float fmin_s(float a, float b) { float r; asm("v_min_f32_e32 %0, %1, %2" : "=v"(r) : "v"(a), "v"(b)); return r; }
#define CE_DESC(a, b) do { const float _t = fmax_s(a, b); b = fmin_s(a, b); a = _t; } while (0)
#define CE_ASC(a, b)  do { const float _t = fmin_s(a, b); b = fmax_s(a, b); a = _t; } while (0)
__device__ __forceinline__ void sort16_desc(float* a) {
#pragma unroll
    for (int k = 2; k <= 16; k <<= 1)
#pragma unroll
        for (int j = k >> 1; j > 0; j >>= 1)
#pragma unroll
            for (int i = 0; i < 16; ++i) { const int l = i ^ j; if (l > i) { if ((i & k) == 0) CE_DESC(a[i], a[l]); else CE_ASC(a[i], a[l]); } }
}
__device__ __forceinline__ void merge16_desc(float* a) {
#pragma unroll
    for (int j = 8; j > 0; j >>= 1)
#pragma unroll
        for (int i = 0; i < 16; ++i) { const int l = i ^ j; if (l > i) CE_DESC(a[i], a[l]); }
}
__device__ __forceinline__ void top16_merge(float* a, const float* b) {
#pragma unroll
    for (int i = 0; i < 16; ++i) a[i] = fmax_s(a[i], b[15 - i]);
    merge16_desc(a);
}
__device__ __forceinline__ void top16_of_64(float* v) {
    sort16_desc(v); sort16_desc(v + 16); sort16_desc(v + 32); sort16_desc(v + 48);
    top16_merge(v, v + 16); top16_merge(v + 32, v + 48); top16_merge(v, v + 32);
}
__device__ __forceinline__ unsigned key_lookup(unsigned long long lo, unsigned long long hi, unsigned i) {
    const unsigned long long v = (i & 8u) ? hi : lo;
    return (unsigned)(v >> ((i & 7u) * 8u)) & 0x7fu;
}

constexpr int KROW = 272;
__device__ __forceinline__ void score_phase(const Ptrs& P, LAS unsigned char* lds, int bid, int G, int tid, int wave, int lane) {
    const bf16* Q = (const bf16*)(P.ws + WS_PROJ); const bf16* KEYS = (const bf16*)(P.ws + WS_KEYS); const float* RS1 = (const float*)(P.ws + WS_RS1);
    int* EIDX = (int*)(P.ws + WS_EIDX); float* GATE = (float*)(P.ws + WS_GATE);
    const int l31 = lane & 31, hi = lane >> 5;
    int cur_h = -1;
    for (int u = bid; u < (M / 256) * 8; u += G) {
        const int h = u & 7, tile = u >> 3;
        if (h != cur_h) {
            __syncthreads();
#pragma unroll
            for (int i = 0; i < 8; ++i) { const int q = tid + 512 * i, row = q >> 4, ch = q & 15;
                const v4u val = *(const GAS v4u*)(KEYS + ((size_t)(h * 256 + row)) * 128 + ch * 8);
                *(LAS v4u*)(lds + row * KROW + ch * 16) = val; }
            __syncthreads();
            cur_h = h;
        }
        const int tok = tile * 256 + wave * 32 + l31;
        float T0[16], T1[16];
#pragma unroll
        for (int p = 0; p < 2; ++p) {
            f32x16 acc[4];
#pragma unroll
            for (int kb = 0; kb < 4; ++kb)
#pragma unroll
                for (int r = 0; r < 16; ++r) acc[kb][r] = 0.f;
            const bf16* qp = Q + (size_t)tok * 2048 + h * 256 + p * 128 + hi * 8;
            bf16x8 bq[8];
#pragma unroll
            for (int ks = 0; ks < 8; ++ks) bq[ks] = *(const GAS bf16x8*)(qp + ks * 16);
#pragma unroll
            for (int ks = 0; ks < 8; ++ks)
#pragma unroll
                for (int kb = 0; kb < 4; ++kb) {
                    const bf16x8 ak = *(const LAS bf16x8*)(lds + (p * 128 + kb * 32 + l31) * KROW + (ks * 16 + hi * 8) * 2);
                    acc[kb] = __builtin_amdgcn_mfma_f32_32x32x16_bf16(ak, bq[ks], acc[kb], 0, 0, 0);
                }
            float v[64];
#pragma unroll
            for (int kb = 0; kb < 4; ++kb)
#pragma unroll
                for (int r = 0; r < 16; ++r) v[kb * 16 + r] = __uint_as_float((__float_as_uint(acc[kb][r]) & 0xffffff80u) | (unsigned)(kb * 32 + (r & 3) + 8 * (r >> 2)));
            top16_of_64(v);
            const unsigned hb = (unsigned)hi << 2;
#pragma unroll
            for (int i = 0; i < 16; ++i) v[i] = __uint_as_float(__float_as_uint(v[i]) | hb);
            float c[16];
#pragma unroll
            for (int i = 0; i < 16; ++i) c[i] = fmax_s(v[i], __shfl_xor(v[15 - i], 32));
            merge16_desc(c);
#pragma unroll
            for (int i = 0; i < 16; ++i) { if (p == 0) T0[i] = c[i]; else T1[i] = c[i]; }
        }
        float f0[16], f1[16];
        unsigned long long K0lo = 0ull, K0hi = 0ull, K1lo = 0ull, K1hi = 0ull;
#pragma unroll
        for (int b = 0; b < 8; ++b) {
            K0lo |= (unsigned long long)(__float_as_uint(T0[b]) & 0x7fu) << (8 * b); K0hi |= (unsigned long long)(__float_as_uint(T0[8 + b]) & 0x7fu) << (8 * b);
            K1lo |= (unsigned long long)(__float_as_uint(T1[b]) & 0x7fu) << (8 * b); K1hi |= (unsigned long long)(__float_as_uint(T1[8 + b]) & 0x7fu) << (8 * b);
        }
#pragma unroll
        for (int i = 0; i < 16; ++i) { f0[i] = __uint_as_float(__float_as_uint(T0[i]) & 0xffffff80u); f1[i] = __uint_as_float(__float_as_uint(T1[i]) & 0xffffff80u); }
        float cd[64]; int n = 0;
#pragma unroll
        for (int i = 0; i < 16; ++i)
#pragma unroll
            for (int j = 0; j < 16; ++j)
                if ((i + 1) * (j + 1) <= 16) { cd[n] = __uint_as_float((__float_as_uint(f0[i] + f1[j]) & 0xffffff00u) | (unsigned)(i * 16 + j)); ++n; }
#pragma unroll
        for (int q = 50; q < 64; ++q) cd[q] = __uint_as_float(0xff800000u);
        top16_of_64(cd);
        float rs = 0.f;
        { const GAS f32x4* rp = (const GAS f32x4*)(RS1 + (size_t)tok * 16);
#pragma unroll
          for (int i = 0; i < 4; ++i) { const f32x4 a = rp[i]; rs += (a.x + a.y) + (a.z + a.w); } }
        const float rstd = __builtin_amdgcn_rsqf(rs * (1.0f / 1024.0f) + EPS);
        int eidx[16]; float gt_[16]; float z0 = 0.f, sum = 0.f;
#pragma unroll
        for (int k = 0; k < 16; ++k) {
            const unsigned wb = __float_as_uint(cd[k]); const unsigned i = (wb >> 4) & 15u, j = wb & 15u;
            eidx[k] = (int)(key_lookup(K0lo, K0hi, i) * 128u + key_lookup(K1lo, K1hi, j));
            const float z = __uint_as_float(wb & 0xffffff00u) * rstd;
            if (k == 0) z0 = z;
            gt_[k] = __expf(z - z0); sum += gt_[k];
        }
        const float inv = 1.0f / sum;
        if (hi == 0) { GAS i32x4* ep = (GAS i32x4*)(EIDX + (size_t)tok * 128 + h * 16);
#pragma unroll
            for (int q = 0; q < 4; ++q) ep[q] = (i32x4){eidx[4 * q], eidx[4 * q + 1], eidx[4 * q + 2], eidx[4 * q + 3]};
        } else { GAS f32x4* gp = (GAS f32x4*)(GATE + (size_t)tok * 128 + h * 16);
#pragma unroll
            for (int q = 0; q < 4; ++q) gp[q] = (f32x4){gt_[4 * q] * inv, gt_[4 * q + 1] * inv, gt_[4 * q + 2] * inv, gt_[4 * q + 3] * inv};
        }
    }
}

__device__ __forceinline__ float gelu_tanh(float x) {
    const float y = 1.5957691216057308f * (x + 0.044715f * x * x * x);
    return x / (1.0f + __expf(-y));
}
__device__ __forceinline__ float dot16(const v2u& u, const f32x2* x) {
    const unsigned w0 = u.x, w1 = u.y;
    f32x2 a = __builtin_amdgcn_cvt_scalef32_pk_f32_fp4(w0, 1.0f, 0) * x[0], b = __builtin_amdgcn_cvt_scalef32_pk_f32_fp4(w0, 1.0f, 1) * x[1];
    a = __builtin_amdgcn_cvt_scalef32_pk_f32_fp4(w0, 1.0f, 2) * x[2] + a; b = __builtin_amdgcn_cvt_scalef32_pk_f32_fp4(w0, 1.0f, 3) * x[3] + b;
    a = __builtin_amdgcn_cvt_scalef32_pk_f32_fp4(w1, 1.0f, 0) * x[4] + a; b = __builtin_amdgcn_cvt_scalef32_pk_f32_fp4(w1, 1.0f, 1) * x[5] + b;
    a = __builtin_amdgcn_cvt_scalef32_pk_f32_fp4(w1, 1.0f, 2) * x[6] + a; b = __builtin_amdgcn_cvt_scalef32_pk_f32_fp4(w1, 1.0f, 3) * x[7] + b;
    a = a + b; return a.x + a.y;
}
__device__ __forceinline__ void axpy16(f32x2* o, float c, const v2u& v) {
    const unsigned w0 = v.x, w1 = v.y; const f32x2 c2 = {c, c};
    o[0] = __builtin_amdgcn_cvt_scalef32_pk_f32_fp4(w0, 1.0f, 0) * c2 + o[0]; o[1] = __builtin_amdgcn_cvt_scalef32_pk_f32_fp4(w0, 1.0f, 1) * c2 + o[1];
    o[2] = __builtin_amdgcn_cvt_scalef32_pk_f32_fp4(w0, 1.0f, 2) * c2 + o[2]; o[3] = __builtin_amdgcn_cvt_scalef32_pk_f32_fp4(w0, 1.0f, 3) * c2 + o[3];
    o[4] = __builtin_amdgcn_cvt_scalef32_pk_f32_fp4(w1, 1.0f, 0) * c2 + o[4]; o[5] = __builtin_amdgcn_cvt_scalef32_pk_f32_fp4(w1, 1.0f, 1) * c2 + o[5];
    o[6] = __builtin_amdgcn_cvt_scalef32_pk_f32_fp4(w1, 1.0f, 2) * c2 + o[6]; o[7] = __builtin_amdgcn_cvt_scalef32_pk_f32_fp4(w1, 1.0f, 3) * c2 + o[7];
}
__device__ __forceinline__ void peer_phase(const Ptrs& P, int vcu, int G, int wave, int lane) {
    const int gw = vcu * NWAVES + wave, NGW = G * NWAVES;
    float* H = P.out; bf16* HB = (bf16*)(P.ws + WS_HB); float* RS2 = (float*)(P.ws + WS_RS2);
    const int* EIDX = (const int*)(P.ws + WS_EIDX); const float* GATE = (const float*)(P.ws + WS_GATE);
    const GAS v2u* U8 = (const GAS v2u*)(P.ws + WS_U) + lane; const GAS v2u* V8 = (const GAS v2u*)(P.ws + WS_V) + lane;
    const float* SU = (const float*)(P.ws + WS_SU); const float* SV = (const float*)(P.ws + WS_SV);
    const int kl = ((lane & 1) << 3) | ((lane & 2) << 1) | ((lane & 4) >> 1) | ((lane & 8) >> 3);
    int t = gw; if (t >= M) return;
    int ei0 = EIDX[(size_t)t * 128 + lane], ei1 = EIDX[(size_t)t * 128 + 64 + lane];
    float gg0 = GATE[(size_t)t * 128 + lane], gg1 = GATE[(size_t)t * 128 + 64 + lane];
    f32x4 hrow[4];
    { const GAS f32x4* hp = (const GAS f32x4*)(H + (size_t)t * 1024 + lane * 16);
#pragma unroll
      for (int j = 0; j < 4; ++j) hrow[j] = hp[j]; }
    v2u uw[16];
#pragma unroll
    for (int k = 0; k < 16; ++k) { const int e = __builtin_amdgcn_readlane(ei0, k); uw[k] = U8[(size_t)e * 64]; }
    for (; t < M; t += NGW) {
        const int tn = (t + NGW < M) ? t + NGW : t;
        f32x2 x[8]; float ss = 0.f;
#pragma unroll
        for (int j = 0; j < 4; ++j) { x[2 * j] = (f32x2){hrow[j].x, hrow[j].y}; x[2 * j + 1] = (f32x2){hrow[j].z, hrow[j].w};
            ss += (hrow[j].x * hrow[j].x + hrow[j].y * hrow[j].y) + (hrow[j].z * hrow[j].z + hrow[j].w * hrow[j].w); }
        ss = wave_sum(ss);
        const float rstd = __builtin_amdgcn_rsqf(ss * (1.0f / 1024.0f) + EPS);
        const int nei0 = EIDX[(size_t)tn * 128 + lane], nei1 = EIDX[(size_t)tn * 128 + 64 + lane];
        const float ngg0 = GATE[(size_t)tn * 128 + lane], ngg1 = GATE[(size_t)tn * 128 + 64 + lane];
        f32x2 out[8];
#pragma unroll
        for (int i = 0; i < 8; ++i) out[i] = (f32x2){0.f, 0.f};
        for (int hq = 0; hq < 8 * REPS(7); ++hq) { const int hh = hq & 7;
            const int ereg = hh < 4 ? ei0 : ei1; const float greg = hh < 4 ? gg0 : gg1; const int lb = (hh & 3) * 16;
            const int el = __shfl(ereg, lb + kl);
            const float su = SU[el], sv = SV[el];
            __builtin_amdgcn_sched_barrier(0);
            v2u vw[16];
#pragma unroll
            for (int k = 0; k < 16; ++k) { const int e = __builtin_amdgcn_readlane(ereg, lb + k); vw[k] = V8[(size_t)e * 64]; }
            __builtin_amdgcn_sched_barrier(0);
            float part[16];
#pragma unroll
            for (int k = 0; k < 16; ++k) {
                if (REPS(9) == 2) { v2u c2 = uw[k]; asm volatile("" : "+v"(c2)); part[k] = 0.5f * (dot16(uw[k], x) + dot16(c2, x)); }
                else part[k] = dot16(uw[k], x);
            }
#pragma unroll
            for (int st = 0; st < 4; ++st) {
                const int m = 1 << st, nh = 8 >> st; const bool up = (lane & m) != 0;
#pragma unroll
                for (int i = 0; i < nh; ++i) {
                    const float send = up ? part[i] : part[i + nh], keep = up ? part[i + nh] : part[i];
                    part[i] = keep + __shfl_xor(send, m);
                }
            }
            float d = part[0]; d += __shfl_xor(d, 16); d += __shfl_xor(d, 32);
            const float gk = __shfl(greg, lb + kl);
            const float cf = gk * gelu_tanh(d * su * rstd) * sv;
            __builtin_amdgcn_sched_barrier(0);
            { const bool lasth = (hq == 8 * REPS(7) - 1); const int hn = (hh + 1) & 7;
              const int nreg = lasth ? nei0 : (hn < 4 ? ei0 : ei1); const int nlb = (hn & 3) * 16;
#pragma unroll
              for (int k = 0; k < 16; ++k) { const int e = __builtin_amdgcn_readlane(nreg, nlb + k); uw[k] = U8[(size_t)e * 64]; } }
            __builtin_amdgcn_sched_barrier(0);
#pragma unroll
            for (int k = 0; k < 16; ++k) {
                const int src = ((k & 1) << 3) | ((k & 2) << 1) | ((k & 4) >> 1) | ((k & 8) >> 3);
                const float ck = __uint_as_float(__builtin_amdgcn_readlane(__float_as_uint(cf), src));
                if (REPS(9) == 2) { v2u c2 = vw[k]; asm volatile("" : "+v"(c2)); axpy16(out, 0.5f * ck, vw[k]); axpy16(out, 0.5f * ck, c2); }
                else axpy16(out, ck, vw[k]);
            }
        }
        if (REPS(7) == 2) {
#pragma unroll
            for (int i = 0; i < 8; ++i) out[i] = out[i] * 0.5f; }
        f32x4 o[4]; float s2 = 0.f;
        GAS f32x4* hp = (GAS f32x4*)(H + (size_t)t * 1024 + lane * 16);
#pragma unroll
        for (int j = 0; j < 4; ++j) { o[j] = (f32x4){hrow[j].x + out[2 * j].x, hrow[j].y + out[2 * j].y, hrow[j].z + out[2 * j + 1].x, hrow[j].w + out[2 * j + 1].y}; hp[j] = o[j];
            s2 += (o[j].x * o[j].x + o[j].y * o[j].y) + (o[j].z * o[j].z + o[j].w * o[j].w); }
        GAS v4u* hb = (GAS v4u*)(HB + (size_t)t * 1024 + lane * 16);
        v4u w0; w0.x = pk2(o[0].x, o[0].y); w0.y = pk2(o[0].z, o[0].w); w0.z = pk2(o[1].x, o[1].y); w0.w = pk2(o[1].z, o[1].w);
        v4u w1; w1.x = pk2(o[2].x, o[2].y); w1.y = pk2(o[2].z, o[2].w); w1.z = pk2(o[3].x, o[3].y); w1.w = pk2(o[3].z, o[3].w);
        hb[0] = w0; hb[1] = w1;
        s2 = wave_sum(s2);
        if (lane == 0) RS2[t] = s2;
        { const GAS f32x4* hn = (const GAS f32x4*)(H + (size_t)tn * 1024 + lane * 16);
#pragma unroll
          for (int j = 0; j < 4; ++j) hrow[j] = hn[j]; }
        ei0 = nei0; ei1 = nei1; gg0 = ngg0; gg1 = ngg1;
    }
}

__device__ __forceinline__ void final_phase(const Ptrs& P, int vcu, int G, int wave, int lane) {
    const int gw = vcu * NWAVES + wave, NGW = G * NWAVES; const float* RS3 = (const float*)(P.ws + WS_RS3);
    const GAS f32x4* gf = (const GAS f32x4*)P.g_final + lane;
    f32x4 g[4];
#pragma unroll
    for (int j = 0; j < 4; ++j) g[j] = gf[64 * j];
    for (int m = gw; m < M; m += NGW) {
        GAS f32x4* xr = (GAS f32x4*)(P.out + (size_t)m * D) + lane;
        float rs = 0.f; { const GAS f32x4* rp = (const GAS f32x4*)(RS3 + (size_t)m * 16);
#pragma unroll
            for (int i = 0; i < 4; ++i) { const f32x4 a = rp[i]; rs += (a.x + a.y) + (a.z + a.w); } }
        const float rstd = __builtin_amdgcn_rsqf(rs * (1.0f / 1024.0f) + EPS);
#pragma unroll
        for (int j = 0; j < 4; ++j) { const f32x4 v = xr[64 * j]; xr[64 * j] = v * rstd * g[j]; }
    }
}

struct Args { const float* in[17]; float* out; unsigned char* ws; int ph_lo, ph_hi; };
#ifndef PG8_SP2
#define PG8_SP2 true
#endif
#ifndef PG8_ALIGN
#define PG8_ALIGN true
#endif
__global__ void __launch_bounds__(NWAVES * 64, 2) mega_fwd(Args args) {
    extern __shared__ __attribute__((aligned(16))) unsigned char lds_raw[];
    LAS unsigned char* lds = (LAS unsigned char*)lds_raw;
    volatile LAS unsigned* MISC = (volatile LAS unsigned*)(lds + MISC_OFF);
    const int tid = threadIdx.x, lane = tid & 63, wave = __builtin_amdgcn_readfirstlane(tid >> 6);
    const int G = gridDim.x, bx = blockIdx.x; const int vcu = (G % 8 == 0) ? (bx % 8) * (G / 8) + bx / 8 : bx;
    Ptrs P;
    P.x = args.in[0]; P.p = args.in[1]; P.g_mix = args.in[2]; P.w_in = args.in[3]; P.conv_w = args.in[4]; P.pool_w = args.in[5]; P.pool_scale = args.in[6]; P.w_o = args.in[7];
    P.g_ffn = args.in[8]; P.w_q = args.in[9]; P.sub_keys = args.in[10]; P.eu = args.in[11]; P.ev = args.in[12]; P.g_ple = args.in[13]; P.w_gate = args.in[14]; P.w_proj = args.in[15]; P.g_final = args.in[16];
    P.out = args.out; P.ws = args.ws;
    gu32* ctl = (gu32*)(P.ws + WS_CTL);
    for (int u = tid; u < (LDS_BYTES - LDSCTL_OFF) / 4; u += NWAVES * 64) ((LAS unsigned*)(lds + LDSCTL_OFF))[u] = 0u;
    __syncthreads();
    XcdBarrier bar; bar.bar = (unsigned*)(ctl + CW_BAR); bar.x = 0; bar.st = nullptr;
    if (!MK_PER_PHASE) bar = xcd_barrier_post((unsigned*)(ctl + CW_BAR), MISC + 8);
    const int lo = args.ph_lo, hi = args.ph_hi;
#define IN(k) (lo <= (k) && (k) < hi)
#define SEAM(k) do { if (IN(k) && IN((k) + 1)) xcd_barrier(bar); } while (0)
    pg8::bf16_t* const WIN = (pg8::bf16_t*)(P.ws + WS_WIN); pg8::bf16_t* const WO = (pg8::bf16_t*)(P.ws + WS_WO); pg8::bf16_t* const WQ = (pg8::bf16_t*)(P.ws + WS_WQ);
    pg8::bf16_t* const WG = (pg8::bf16_t*)(P.ws + WS_WG); pg8::bf16_t* const WP = (pg8::bf16_t*)(P.ws + WS_WP);
    pg8::bf16_t* const XB = (pg8::bf16_t*)(P.ws + WS_XB); pg8::bf16_t* const PL = XB; pg8::bf16_t* const PROJ = (pg8::bf16_t*)(P.ws + WS_PROJ); pg8::bf16_t* const QB = PROJ;
    pg8::bf16_t* const MIX = (pg8::bf16_t*)(P.ws + WS_MIX); pg8::bf16_t* const HB = (pg8::bf16_t*)(P.ws + WS_HB); pg8::bf16_t* const PB = (pg8::bf16_t*)(P.ws + WS_PB);

    if (IN(0)) { for (int rep = 0; rep < REPS(1); ++rep) { p0a_phase(P, lds, vcu, G, tid, wave, lane); SEAM(0); } }
    if (IN(1)) { p0b_phase(P, lds, vcu, G, wave, lane); SEAM(1); }
    if (IN(2)) {
        pg8::Gemm g{XB, WIN, M, NPROJ, D}; pg8::StaticOrder S; S.init(M, NPROJ, G, bx);
        EpiBf16Row E{PROJ, NPROJ, (const float*)(P.ws + WS_RSX)};
        for (int rep = 0; rep < REPS(2); ++rep) { pg8::gemm_phase<EpiBf16Row, pg8::StaticOrder, PG8_ALIGN, PG8_SP2>(lds, g, S, E);
        SEAM(2); }
    }
    if (IN(3)) {
        for (int rep = 0; rep < REPS(3); ++rep) p2_phase(P, vcu, G, tid, wave);
        pg8::Gemm g{PB, WP, M, D, PLED}; pg8::StaticOrder S; S.init(M, D, G, bx);
        EpiBf16Row E{PL, D, nullptr};
        for (int rep = 0; rep < REPS(8); ++rep) pg8::gemm_phase<EpiBf16Row, pg8::StaticOrder, PG8_ALIGN, PG8_SP2>(lds, g, S, E);
        SEAM(3);
    }
    if (IN(4)) {
        pg8::Gemm g{MIX, WO, M, D, D}; pg8::StaticOrder S; S.init(M, D, G, bx);
        EpiH1 E{P.x, P.out, HB, (float*)(P.ws + WS_RS1)};
        for (int rep = 0; rep < REPS(4); ++rep) { pg8::gemm_phase<EpiH1, pg8::StaticOrder, PG8_ALIGN, PG8_SP2>(lds, g, S, E);
        SEAM(4); }
    }
    if (IN(5)) {
        pg8::Gemm g{HB, WQ, M, NQ, D}; pg8::StaticOrder S; S.init(M, NQ, G, bx);
        EpiBf16Row E{QB, NQ, nullptr};
        for (int rep = 0; rep < REPS(5); ++rep) { pg8::gemm_phase<EpiBf16Row, pg8::StaticOrder, PG8_ALIGN, PG8_SP2>(lds, g, S, E);
        SEAM(5); }
    }
    if (IN(6)) { for (int rep = 0; rep < REPS(6); ++rep) { score_phase(P, lds, bx, G, tid, wave, lane); SEAM(6); } }
    if (IN(7)) { peer_phase(P, vcu, G, wave, lane); SEAM(7); }
    if (IN(8)) {
        pg8::Gemm g{HB, WG, M, D, D}; pg8::StaticOrder S; S.init(M, D, G, bx);
        EpiGate E{P.out, PL, (const float*)(P.ws + WS_RS2), (float*)(P.ws + WS_RS3)};
        pg8::gemm_phase<EpiGate, pg8::StaticOrder, PG8_ALIGN, PG8_SP2>(lds, g, S, E);
        SEAM(8);
    }
    if (IN(9)) { final_phase(P, vcu, G, wave, lane); }
#undef IN
#undef SEAM
}

extern "C" void kernel_launch(void* const* d_in, const int* in_sizes, int n_in, void* d_out, int out_size, void* d_ws, size_t ws_size, hipStream_t stream) {
    static int grid = 0;
    if (grid == 0) {
        if (n_in != 17 || in_sizes[0] != M * D || out_size != M * D || ws_size < WS_END) { fprintf(stderr, "kernel_launch: unexpected shapes (n_in %d, in0 %d, out %d, ws %zu); nothing launched\n", n_in, n_in > 0 ? in_sizes[0] : -1, out_size, ws_size); grid = -1; return; }
        int dev = 0, cus = 0, per_cu = 0;
        if (hipGetDevice(&dev) != hipSuccess || hipDeviceGetAttribute(&cus, hipDeviceAttributeMultiprocessorCount, dev) != hipSuccess) { fprintf(stderr, "kernel_launch: device query failed\n"); grid = -1; return; }
        if (hipFuncSetAttribute((const void*)mega_fwd, hipFuncAttributeMaxDynamicSharedMemorySize, LDS_BYTES) != hipSuccess) { fprintf(stderr, "kernel_launch: hipFuncSetAttribute failed\n"); grid = -1; return; }
        if (hipOccupancyMaxActiveBlocksPerMultiprocessor(&per_cu, (const void*)mega_fwd, NWAVES * 64, LDS_BYTES) != hipSuccess || per_cu < 1)
            fprintf(stderr, "kernel_launch: note: occupancy query reports %d workgroups per CU\n", per_cu);
        (void)hipGetLastError();
        grid = cus;
    }
    if (grid < 0) return;
    if (hipMemsetAsync((char*)d_ws + WS_CTL, 0, CTL_ZERO_BYTES, stream) != hipSuccess) { fprintf(stderr, "kernel_launch: memset failed\n"); return; }
    Args a{};
    for (int i = 0; i < 17; ++i) a.in[i] = (const float*)d_in[i];
    a.out = (float*)d_out; a.ws = (unsigned char*)d_ws;
#if MK_PER_PHASE
    for (int ph = 0; ph < NPHASES; ++ph) { a.ph_lo = ph; a.ph_hi = ph + 1; hipLaunchKernelGGL(mega_fwd, dim3(grid), dim3(NWAVES * 64), LDS_BYTES, stream, a); }
#else
    a.ph_lo = 0; a.ph_hi = NPHASES;
    hipLaunchKernelGGL(mega_fwd, dim3(grid), dim3(NWAVES * 64), LDS_BYTES, stream, a);
#endif
    const hipError_t le = hipPeekAtLastError();
    if (le != hipSuccess) fprintf(stderr, "kernel_launch: launch failed: %s\n", hipGetErrorName(le));
}
```

```cpp
#include <hip/hip_runtime.h>
#include <cstdio>
#include <cstdint>
namespace pg8 {
#define PG8_LAS __attribute__((address_space(3)))
typedef unsigned short bf16_t;
typedef short bf16x8 __attribute__((ext_vector_type(8)));
typedef float f32x4 __attribute__((ext_vector_type(4)));
typedef unsigned u32x4 __attribute__((ext_vector_type(4)));
constexpr int BM = 256, BK = 64, HALF = 128, HTB = HALF * BK * 2  , STAGE_BYTES = 8 * HTB, NXCD = 8, WGM = 8;

__host__ __device__ __forceinline__ int lds_byte(int r, int c) { const int st = (r >> 4) * 2 + (c >> 5), rr = r & 15, cc = c & 31, ob = rr * 64 + cc * 2; return st * 1024 + (ob ^ (((ob >> 9) & 1) << 5)); }
__host__ __device__ __forceinline__ void stage_rc(int b, int& R, int& C) { const int st = b / 1024, sb = b % 1024, swz = sb ^ (((sb >> 9) & 1) << 5); R = (st >> 1) * 16 + swz / 64; C = (st & 1) * 32 + (swz % 64) / 2; }
__host__ __device__ __forceinline__ int perm32(int rho) { const int n = rho >> 4, i = rho & 15; return 8 * (i >> 2) + 4 * n + (i & 3); }

struct Unit { int pm, pn; };
struct Gemm { const bf16_t* A; const bf16_t* Bt; int M, N, K; };

struct StaticOrder {
    int nM, nN, nwg, G, c;
    __host__ __device__ void init(int M, int N, int G_, int c_) { nM = M / BM; nN = N / BM; nwg = nM * nN; G = G_; c = c_; }
    __host__ __device__ bool next(int i, Unit& u) const {
        const long L = (long)i * G + c; if (L >= nwg) return false;
        int wgid = (int)L; { const int q = nwg / NXCD, r = nwg % NXCD, xcd = wgid % NXCD, off = wgid / NXCD; wgid = (xcd < r ? xcd * (q + 1) : r * (q + 1) + (xcd - r) * q) + off; }
        const int nig = WGM * nN, gid = wgid / nig, fm = gid * WGM, gsz = (nM - fm) < WGM ? (nM - fm) : WGM;
        u.pm = fm + ((wgid % nig) % gsz); u.pn = (wgid % nig) / gsz; return true;
    }
    __device__ __forceinline__ void a_ready(const Unit&) const {}
    __device__ __forceinline__ void done(const Unit&) const {}
};

__device__ __forceinline__ unsigned cvt_pk_bf16(float lo, float hi) { unsigned r; asm volatile("v_cvt_pk_bf16_f32 %0, %1, %2" : "=v"(r) : "v"(lo), "v"(hi)); return r; }
template <class Epi, class Sched, bool ALIGN_EPI = false, bool SP2 = false>
__device__ __forceinline__ void gemm_phase(PG8_LAS unsigned char* lds, const Gemm g, const Sched& S, const Epi& E) {
    const int tid = threadIdx.x, wid = __builtin_amdgcn_readfirstlane(tid >> 6), lane = tid & 63, wr = wid >> 2, wc = wid & 3, fr = lane & 15, fq = lane >> 4;
    const int K = g.K, nt = K / BK;
    unsigned voffA[2], voffB[2];
#pragma unroll
    for (int i = 0; i < 2; ++i) { int R, C; stage_rc(tid * 16 + i * 8192, R, C); const int Rb = Epi::PERM ? ((R & ~31) + perm32(R & 31)) : R;
        voffA[i] = (unsigned)(R * K + C) * 2u; voffB[i] = (unsigned)(Rb * K + C) * 2u; }
    const size_t kstep = (size_t)(BK * 2);
    const size_t hstep = (size_t)HALF * K * 2;
    const size_t tstep = 2 * hstep;
    const unsigned ldsw = (unsigned)wid * 1024u;
    const int aoff = lds_byte(wr * 64 + fr, fq * 8), boff = lds_byte(wc * 32 + fr, fq * 8);
#define PG8_SA(b, h) (((b) * 2 + (h)) * HTB)
#define PG8_SB(b, h) ((4 + (b) * 2 + (h)) * HTB)
#define PG8_STAGE(bufoff, gbase, voff) do { _Pragma("unroll") for (int _i = 0; _i < 2; ++_i) \
        __builtin_amdgcn_global_load_lds((const unsigned*)((const char*)(gbase) + (voff)[_i]), (PG8_LAS unsigned*)(lds + (bufoff) + ldsw + _i * 8192), 16, 0, 0); } while (0)
#define PG8_LDA(dst, b, h) do { _Pragma("unroll") for (int m = 0; m < 4; ++m) _Pragma("unroll") for (int k = 0; k < 2; ++k) dst[m][k] = *(const PG8_LAS bf16x8*)(lds + PG8_SA(b, h) + aoff + m * 2048 + k * 1024); } while (0)
#define PG8_LDB(dst, b, h) do { _Pragma("unroll") for (int n = 0; n < 2; ++n) _Pragma("unroll") for (int k = 0; k < 2; ++k) dst[n][k] = *(const PG8_LAS bf16x8*)(lds + PG8_SB(b, h) + boff + n * 2048 + k * 1024); } while (0)
#define PG8_MMA(ai, bj, At, Bt) do { __builtin_amdgcn_s_setprio(1); _Pragma("unroll") for (int m = 0; m < 4; ++m) _Pragma("unroll") for (int n = 0; n < 2; ++n) _Pragma("unroll") for (int k = 0; k < 2; ++k) \
        acc[ai][bj][m][n] = __builtin_amdgcn_mfma_f32_16x16x32_bf16(Bt[n][k], At[m][k], acc[ai][bj][m][n], 0, 0, 0); __builtin_amdgcn_s_setprio(0); } while (0)
#define PG8_WAIT_V(n) asm volatile("s_waitcnt vmcnt(" #n ")" ::: "memory")
#define PG8_WAIT_L(n) asm volatile("s_waitcnt lgkmcnt(" #n ")" ::: "memory")
#define PG8_BAR __builtin_amdgcn_s_barrier()
#define PG8_SCHED __builtin_amdgcn_sched_barrier(0)
    Unit cur, nxt; int ui = 0;
    if (!S.next(0, cur)) return;
    f32x4 acc[2][2][4][2];
#pragma unroll
    for (int a = 0; a < 2; ++a)
#pragma unroll
        for (int b = 0; b < 2; ++b)
#pragma unroll
            for (int m = 0; m < 4; ++m)
#pragma unroll
                for (int n = 0; n < 2; ++n) acc[a][b][m][n] = (f32x4){0.f, 0.f, 0.f, 0.f};
    bf16x8 At[4][2], B0[2][2], B1[2][2];
    const char* cA = (const char*)g.A + (size_t)cur.pm * tstep; const char* cB = (const char*)g.Bt + (size_t)cur.pn * tstep;
    S.a_ready(cur);
    if constexpr (SP2) {
        PG8_STAGE(PG8_SB(0, 0), cB, voffB); PG8_STAGE(PG8_SB(0, 1), cB + hstep, voffB); PG8_STAGE(PG8_SA(0, 0), cA, voffA); PG8_STAGE(PG8_SA(0, 1), cA + hstep, voffA);
        if (wr == 1) PG8_BAR;
        PG8_WAIT_V(2); PG8_BAR;
        PG8_STAGE(PG8_SB(1, 0), cB + kstep, voffB); PG8_STAGE(PG8_SA(1, 0), cA + kstep, voffA); PG8_STAGE(PG8_SB(1, 1), cB + hstep + kstep, voffB);
        PG8_WAIT_V(6); PG8_BAR;
    } else {
        PG8_STAGE(PG8_SB(0, 0), cB, voffB); PG8_STAGE(PG8_SA(0, 0), cA, voffA); PG8_STAGE(PG8_SB(0, 1), cB + hstep, voffB); PG8_STAGE(PG8_SA(0, 1), cA + hstep, voffA);
        if (wr == 1) PG8_BAR;
        PG8_WAIT_V(4); PG8_BAR;
        PG8_STAGE(PG8_SB(1, 0), cB + kstep, voffB); PG8_STAGE(PG8_SA(1, 0), cA + kstep, voffA); PG8_STAGE(PG8_SB(1, 1), cB + hstep + kstep, voffB);
        PG8_WAIT_V(6); PG8_BAR;
    }
    for (;;) {
        const bool has_next = S.next(ui + 1, nxt);
        const char* nA = has_next ? (const char*)g.A + (size_t)nxt.pm * tstep : cA; const char* nB = has_next ? (const char*)g.Bt + (size_t)nxt.pn * tstep : cB;
        for (int t = 0; t < nt; t += 2) {
            const bool last = (t == nt - 2);
            const char* a1 = cA + (size_t)(t + 1) * kstep;
            const char* a2 = last ? nA : cA + (size_t)(t + 2) * kstep; const char* b2 = last ? nB : cB + (size_t)(t + 2) * kstep;
            const char* a3 = a2 + kstep; const char* b3 = b2 + kstep;
            if (last && has_next) S.a_ready(nxt);
            if constexpr (SP2) {
            PG8_LDB(B0, 0, 0); PG8_LDB(B1, 0, 1); PG8_SCHED; PG8_LDA(At, 0, 0); PG8_STAGE(PG8_SA(1, 1), a1 + hstep, voffA);
            PG8_WAIT_V(8); PG8_WAIT_L(0); PG8_BAR; PG8_MMA(0, 0, At, B0); PG8_MMA(0, 1, At, B1); PG8_BAR; PG8_SCHED;
            PG8_LDA(At, 0, 1); PG8_STAGE(PG8_SB(0, 0), b2, voffB); PG8_STAGE(PG8_SB(0, 1), b2 + hstep, voffB); PG8_STAGE(PG8_SA(0, 0), a2, voffA);
            PG8_WAIT_V(8); PG8_WAIT_L(0); PG8_BAR; PG8_MMA(1, 0, At, B0); PG8_MMA(1, 1, At, B1); PG8_BAR; PG8_SCHED;
            PG8_LDB(B0, 1, 0); PG8_LDB(B1, 1, 1); PG8_SCHED; PG8_LDA(At, 1, 0); PG8_STAGE(PG8_SA(0, 1), a2 + hstep, voffA);
            PG8_WAIT_V(8); PG8_WAIT_L(0); PG8_BAR; PG8_MMA(0, 0, At, B0); PG8_MMA(0, 1, At, B1); PG8_BAR; PG8_SCHED;
            PG8_LDA(At, 1, 1); PG8_STAGE(PG8_SB(1, 0), b3, voffB); PG8_STAGE(PG8_SB(1, 1), b3 + hstep, voffB); PG8_STAGE(PG8_SA(1, 0), a3, voffA);
            PG8_WAIT_V(8); PG8_WAIT_L(0); PG8_BAR; PG8_MMA(1, 0, At, B0); PG8_MMA(1, 1, At, B1); PG8_BAR; PG8_SCHED;
            } else {
            PG8_LDB(B0, 0, 0); PG8_SCHED; PG8_LDA(At, 0, 0); PG8_STAGE(PG8_SA(1, 1), a1 + hstep, voffA);
            PG8_WAIT_L(8); PG8_BAR; PG8_WAIT_L(0); PG8_MMA(0, 0, At, B0); PG8_BAR; PG8_SCHED;
            PG8_LDB(B1, 0, 1); PG8_STAGE(PG8_SB(0, 0), b2, voffB);
            PG8_BAR; PG8_WAIT_L(0); PG8_MMA(0, 1, At, B1); PG8_BAR;
            PG8_LDA(At, 0, 1); PG8_STAGE(PG8_SA(0, 0), a2, voffA);
            PG8_BAR; PG8_WAIT_L(0); PG8_MMA(1, 0, At, B0); PG8_BAR; PG8_SCHED;
            PG8_STAGE(PG8_SB(0, 1), b2 + hstep, voffB);
            PG8_WAIT_V(6); PG8_BAR; PG8_MMA(1, 1, At, B1); PG8_BAR;
            PG8_LDB(B0, 1, 0); PG8_SCHED; PG8_LDA(At, 1, 0); PG8_STAGE(PG8_SA(0, 1), a2 + hstep, voffA);
            PG8_WAIT_L(8); PG8_BAR; PG8_WAIT_L(0); PG8_MMA(0, 0, At, B0); PG8_BAR; PG8_SCHED;
            PG8_LDB(B1, 1, 1); PG8_STAGE(PG8_SB(1, 0), b3, voffB);
            PG8_BAR; PG8_WAIT_L(0); PG8_MMA(0, 1, At, B1); PG8_BAR;
            PG8_LDA(At, 1, 1); PG8_STAGE(PG8_SA(1, 0), a3, voffA);
            PG8_BAR; PG8_WAIT_L(0); PG8_MMA(1, 0, At, B0); PG8_BAR; PG8_SCHED;
            PG8_STAGE(PG8_SB(1, 1), b3 + hstep, voffB);
            PG8_WAIT_V(6); PG8_BAR; PG8_MMA(1, 1, At, B1); PG8_BAR;
            }
        }
        if constexpr (ALIGN_EPI) { if (wr == 0) PG8_BAR; }
        if constexpr (!Epi::AFTER_DRAIN) { E(acc, cur, wr, wc, fr, fq); S.done(cur); }
        if (!has_next) break;
#pragma unroll
        for (int a = 0; a < 2; ++a)
#pragma unroll
            for (int b = 0; b < 2; ++b)
#pragma unroll
                for (int m = 0; m < 4; ++m)
#pragma unroll
                    for (int n = 0; n < 2; ++n) acc[a][b][m][n] = (f32x4){0.f, 0.f, 0.f, 0.f};
        cur = nxt; cA = nA; cB = nB; ++ui;
        if constexpr (ALIGN_EPI) { if (wr == 1) PG8_BAR; }
    }
    PG8_WAIT_V(0);
    if constexpr (!ALIGN_EPI) { if (wr == 0) PG8_BAR; }
    PG8_BAR;
    if constexpr (Epi::AFTER_DRAIN) { E.fused(acc, cur, wr, wc, fr, fq, lds, wid, lane); S.done(cur); }
#undef PG8_SA
#undef PG8_SB
#undef PG8_STAGE
#undef PG8_LDA
#undef PG8_LDB
#undef PG8_MMA
#undef PG8_WAIT_V
#undef PG8_WAIT_L
#undef PG8_BAR
#undef PG8_SCHED
}
}

#define GAS __attribute__((address_space(1)))
#define LAS __attribute__((address_space(3)))
typedef unsigned short bf16;
typedef unsigned v4u __attribute__((ext_vector_type(4)));
typedef float f32x4 __attribute__((ext_vector_type(4)));
typedef short bf16x8 __attribute__((ext_vector_type(8)));
typedef GAS unsigned gu32;
typedef GAS unsigned long long gu64;
#define RLX_AGENT __ATOMIC_RELAXED, __HIP_MEMORY_SCOPE_AGENT
#define LDS_WAIT() asm volatile("s_waitcnt lgkmcnt(0)" ::: "memory")
#define VM_WAIT() asm volatile("s_waitcnt vmcnt(0)" ::: "memory")
__device__ __forceinline__ unsigned long long rt() { return __builtin_amdgcn_s_memrealtime(); }
__device__ __forceinline__ unsigned f2bf(float f) { unsigned u = __builtin_bit_cast(unsigned, f); return (u + 0x7fffu + ((u >> 16) & 1u)) >> 16; }
__device__ __forceinline__ unsigned pk2(float lo, float hi) { return f2bf(lo) | (f2bf(hi) << 16); }

#define XB_TMO      128
#define XB_XCNT(j)  (256  + 64 * (j))
#define XB_XSUB(j)  (1280 + 64 * (j))
#define XB_XGEN(j)  (2304 + 64 * (j))
#define XB_TOP      3328
#define XB_TOPGEN   3392
#define XCD_BAR_WORDS 3456
#define XB_SPIN_CAP (1u << 18)

__device__ __forceinline__ unsigned xb_ld(unsigned* p)              { return __hip_atomic_load(p, __ATOMIC_RELAXED, __HIP_MEMORY_SCOPE_AGENT); }
__device__ __forceinline__ unsigned xb_add(unsigned* p, unsigned v) { return __hip_atomic_fetch_add(p, v, __ATOMIC_RELAXED, __HIP_MEMORY_SCOPE_AGENT); }
__device__ __forceinline__ unsigned xb_xcc_id() { return (unsigned)__builtin_amdgcn_s_getreg((3 << 11) | 20) & 0xFu; }
#define XB_SPIN(cond, bar) do { unsigned _sp = 0; while (cond) { __builtin_amdgcn_s_sleep(1); \
    if ((++_sp & 255u) == 0u) { if (xb_ld(&(bar)[XB_TMO])) break; if (_sp > XB_SPIN_CAP) { atomicAdd(&(bar)[XB_TMO], 1u); break; } } } } while (0)

struct XcdBarrier {
    unsigned* bar; unsigned x;
    volatile LAS unsigned* st;
};

__device__ __forceinline__ XcdBarrier xcd_barrier_post(unsigned* bar, volatile LAS unsigned* st) {
    XcdBarrier b; b.bar = bar; b.x = xb_xcc_id(); b.st = st;
    if (threadIdx.x == 0) (void)xb_add(&bar[XB_XCNT(b.x)], 1u);
    return b;
}
__device__ __forceinline__ void xcd_barrier_complete(unsigned* bar, unsigned x, unsigned& nloc, unsigned& nx) {
    const unsigned G = gridDim.x * gridDim.y * gridDim.z;
    unsigned sum, cnt, mine, sp = 0u;
    for (;;) {
        sum = 0u; cnt = 0u; mine = 0u;
#pragma unroll
        for (unsigned j = 0; j < 16; ++j) { const unsigned c = xb_ld(&bar[XB_XCNT(j)]); sum += c; cnt += (c > 0u) ? 1u : 0u; mine = (j == x) ? c : mine; }
        if (sum == G) break;
        __builtin_amdgcn_s_sleep(1);
        if ((++sp & 255u) == 0u) { if (xb_ld(&bar[XB_TMO])) break; if (sp > XB_SPIN_CAP) { atomicAdd(&bar[XB_TMO], 1u); break; } }
    }
    nloc = mine > 0u ? mine : 1u; nx = cnt > 0u ? cnt : 1u;
}

__device__ __forceinline__ void xcd_barrier(const XcdBarrier& b) {
    asm volatile("s_waitcnt vmcnt(0)" ::: "memory");
    __syncthreads();
    if (threadIdx.x == 0) {
        unsigned* bar = b.bar;
        __builtin_amdgcn_s_waitcnt(0);
        unsigned nloc = b.st[0], nx = b.st[1];
        if (nloc == 0u) { xcd_barrier_complete(bar, b.x, nloc, nx); b.st[0] = nloc; b.st[1] = nx; }
        const unsigned old = xb_add(&bar[XB_XSUB(b.x)], 1u);
        const unsigned gen = old / nloc;
        if (old + 1u == (gen + 1u) * nloc) {
            __builtin_amdgcn_fence(__ATOMIC_RELEASE, "agent");
            asm volatile("s_waitcnt vmcnt(0)" ::: "memory");
            const unsigned og = xb_add(&bar[XB_TOP], 1u);
            const unsigned tg = og / nx;
            if (og + 1u == (tg + 1u) * nx) xb_add(&bar[XB_TOPGEN], 1u);
            else XB_SPIN(xb_ld(&bar[XB_TOPGEN]) == tg, bar);
            __builtin_amdgcn_fence(__ATOMIC_ACQUIRE, "agent");
            xb_add(&bar[XB_XGEN(b.x)], 1u);
            asm volatile("s_waitcnt vmcnt(0)" ::: "memory");
        } else {
            XB_SPIN(xb_ld(&bar[XB_XGEN(b.x)]) == gen, bar);
            __builtin_amdgcn_fence(__ATOMIC_ACQUIRE, "agent");
            asm volatile("s_waitcnt vmcnt(0)" ::: "memory");
        }
    }
    __syncthreads();
}

constexpr int NWAVES = 8;
constexpr int M = 32768, D = 1024, SEQ = 4096, NPROJ = 2048, NQ = 2048, PLED = 256, NEXP = 16384;
constexpr float EPS = 1e-6f;
#ifndef MK_PER_PHASE
#define MK_PER_PHASE 0
#endif
#ifndef PROBE_REP
#define PROBE_REP 0
#endif
#define REPS(k) ((PROBE_REP == (k)) ? 2 : 1)
constexpr int NPHASES = 10;

constexpr size_t MiB = 1u << 20;
constexpr size_t WS_CTL = 0, CTL_ZERO_BYTES = 1 * MiB;
constexpr size_t WS_WIN = 2 * MiB, WS_WO = 6 * MiB, WS_WQ = 8 * MiB, WS_WG = 12 * MiB, WS_WP = 14 * MiB, WS_KEYS = 14 * MiB + 512 * 1024;
constexpr size_t WS_WF = 15 * MiB;
constexpr size_t WS_RSX = 17 * MiB, WS_RS2 = 17 * MiB + 512 * 1024, WS_RS1 = 18 * MiB, WS_RS3 = 20 * MiB;
constexpr size_t WS_SU = 22 * MiB, WS_SV = 22 * MiB + 65536;
constexpr size_t WS_U = 24 * MiB, WS_V = 56 * MiB;
constexpr size_t WS_XB = 88 * MiB;
constexpr size_t WS_PROJ = 152 * MiB;
constexpr size_t WS_MIX = 280 * MiB;
constexpr size_t WS_HB = 344 * MiB;
constexpr size_t WS_EIDX = 408 * MiB, WS_GATE = 424 * MiB;
constexpr size_t WS_PB = 440 * MiB;
constexpr size_t WS_END = 456 * MiB;
constexpr int CW_BAR = 4096;
static_assert((CW_BAR + XCD_BAR_WORDS) * 4 <= (int)CTL_ZERO_BYTES, "CTL words inside the memset region");

constexpr int RING_BYTES = 131072;
constexpr int LDSCTL_OFF = RING_BYTES, MISC_OFF = LDSCTL_OFF + 320;
constexpr int LDS_BYTES = 147456;

typedef float f32x16 __attribute__((ext_vector_type(16)));
typedef _Float16 h2_t __attribute__((ext_vector_type(2)));
typedef float f32x2 __attribute__((ext_vector_type(2)));
typedef int i32x4 __attribute__((ext_vector_type(4)));
typedef unsigned v2u __attribute__((ext_vector_type(2)));

__device__ __forceinline__ float wave_sum(float v) {
#pragma unroll
    for (int o = 1; o < 64; o <<= 1) v += __shfl_xor(v, o);
    return v;
}
__device__ __forceinline__ float bf_lo(unsigned w) { return __uint_as_float(w << 16); }
__device__ __forceinline__ float bf_hi(unsigned w) { return __uint_as_float(w & 0xffff0000u); }
__device__ __forceinline__ unsigned pkh(float lo, float hi) { f32x2 v = {lo, hi}; h2_t h = __builtin_convertvector(v, h2_t); return __builtin_bit_cast(unsigned, h); }

struct EpiBf16Row {
    static constexpr bool PERM = true, AFTER_DRAIN = false;
    pg8::bf16_t* O; int ldc; const float* rowss;
    __device__ __forceinline__ void operator()(const pg8::f32x4 (&acc)[2][2][4][2], const pg8::Unit& u, int wr, int wc, int fr, int fq) const {
        const int row0 = u.pm * 256 + wr * 64 + fr, col0 = u.pn * 256 + wc * 32 + 8 * fq;
#pragma unroll
        for (int ai = 0; ai < 2; ++ai)
#pragma unroll
            for (int m = 0; m < 4; ++m) {
                const int row = row0 + ai * 128 + m * 16;
                const float sc = rowss ? __builtin_amdgcn_rsqf(rowss[row] * (1.0f / 1024.0f) + EPS) : 1.0f;
                pg8::bf16_t* rowp = O + (size_t)row * ldc + col0;
#pragma unroll
                for (int bj = 0; bj < 2; ++bj) {
                    const pg8::f32x4 v0 = acc[ai][bj][m][0] * sc, v1 = acc[ai][bj][m][1] * sc;
                    pg8::u32x4 w; w.x = pg8::cvt_pk_bf16(v0[0], v0[1]); w.y = pg8::cvt_pk_bf16(v0[2], v0[3]); w.z = pg8::cvt_pk_bf16(v1[0], v1[1]); w.w = pg8::cvt_pk_bf16(v1[2], v1[3]);
                    *(pg8::u32x4*)(rowp + bj * 128) = w;
                }
            }
    }
};
struct EpiH1 {
    static constexpr bool PERM = true, AFTER_DRAIN = false;
    const float* X; pg8::bf16_t* HB; float* RS;
    __device__ __forceinline__ void operator()(const pg8::f32x4 (&acc)[2][2][4][2], const pg8::Unit& u, int wr, int wc, int fr, int fq) const {
        const int row0 = u.pm * 256 + wr * 64 + fr, col0 = u.pn * 256 + wc * 32 + 8 * fq;
#pragma unroll
        for (int ai = 0; ai < 2; ++ai)
#pragma unroll
            for (int m = 0; m < 4; ++m) {
                const int row = row0 + ai * 128 + m * 16; float s = 0.f;
#pragma unroll
                for (int bj = 0; bj < 2; ++bj) {
                    const size_t off = (size_t)row * 1024 + col0 + bj * 128;
                    const pg8::f32x4 x0 = *(const pg8::f32x4*)(X + off), x1 = *(const pg8::f32x4*)(X + off + 4);
                    const pg8::f32x4 v0 = acc[ai][bj][m][0] + x0, v1 = acc[ai][bj][m][1] + x1;
                    pg8::u32x4 w; w.x = pg8::cvt_pk_bf16(v0[0], v0[1]); w.y = pg8::cvt_pk_bf16(v0[2], v0[3]); w.z = pg8::cvt_pk_bf16(v1[0], v1[1]); w.w = pg8::cvt_pk_bf16(v1[2], v1[3]);
                    *(pg8::u32x4*)(HB + off) = w;
                    s += (v0[0] * v0[0] + v0[1] * v0[1]) + (v0[2] * v0[2] + v0[3] * v0[3]) + (v1[0] * v1[0] + v1[1] * v1[1]) + (v1[2] * v1[2] + v1[3] * v1[3]);
                }
                s += __shfl_xor(s, 16); s += __shfl_xor(s, 32);
                if (fq == 0) RS[(size_t)row * 16 + u.pn * 4 + wc] = s;
            }
    }
};
struct EpiGate {
    static constexpr bool PERM = true, AFTER_DRAIN = false;
    float* OUT; const pg8::bf16_t* HB; const pg8::bf16_t* PL; const float* RS2; float* RS3;
    __device__ __forceinline__ void operator()(const pg8::f32x4 (&acc)[2][2][4][2], const pg8::Unit& u, int wr, int wc, int fr, int fq) const {
        const int row0 = u.pm * 256 + wr * 64 + fr, col0 = u.pn * 256 + wc * 32 + 8 * fq;
#pragma unroll
        for (int ai = 0; ai < 2; ++ai)
#pragma unroll
            for (int m = 0; m < 4; ++m) {
                const int row = row0 + ai * 128 + m * 16; float s = 0.f;
                const float rstd = __builtin_amdgcn_rsqf(RS2[row] * (1.0f / 1024.0f) + EPS);
#pragma unroll
                for (int bj = 0; bj < 2; ++bj) {
                    const size_t off = (size_t)row * 1024 + col0 + bj * 128;
                    const pg8::u32x4 w = *(const pg8::u32x4*)(PL + off), hw = *(const pg8::u32x4*)(HB + off);
                    const pg8::f32x4 h0 = {bf_lo(hw.x), bf_hi(hw.x), bf_lo(hw.y), bf_hi(hw.y)}, h1 = {bf_lo(hw.z), bf_hi(hw.z), bf_lo(hw.w), bf_hi(hw.w)};
                    const pg8::f32x4 a0 = acc[ai][bj][m][0] * rstd, a1 = acc[ai][bj][m][1] * rstd;
                    pg8::f32x4 g0, g1;
#pragma unroll
                    for (int e = 0; e < 4; ++e) { g0[e] = 1.0f / (1.0f + __expf(-a0[e])); g1[e] = 1.0f / (1.0f + __expf(-a1[e])); }
                    const pg8::f32x4 p0 = {bf_lo(w.x), bf_hi(w.x), bf_lo(w.y), bf_hi(w.y)}, p1 = {bf_lo(w.z), bf_hi(w.z), bf_lo(w.w), bf_hi(w.w)};
                    const pg8::f32x4 v0 = h0 + g0 * p0, v1 = h1 + g1 * p1;
                    *(pg8::f32x4*)(OUT + off) = v0; *(pg8::f32x4*)(OUT + off + 4) = v1;
                    s += (v0[0] * v0[0] + v0[1] * v0[1]) + (v0[2] * v0[2] + v0[3] * v0[3]) + (v1[0] * v1[0] + v1[1] * v1[1]) + (v1[2] * v1[2] + v1[3] * v1[3]);
                }
                s += __shfl_xor(s, 16); s += __shfl_xor(s, 32);
                if (fq == 0) RS3[(size_t)row * 16 + u.pn * 4 + wc] = s;
            }
    }
};

__device__ __forceinline__ void p0_transpose_item(const float* W, int ldn, const float* gk, int K, bf16* WT, int row_off, int nblk, LAS float* scr, int item, int lane) {
    const int kb = item / nblk, nb = item % nblk, k0 = 64 * kb, n0 = 32 * nb;
#pragma unroll 8
    for (int i = 0; i < 32; ++i) { const int kk = 2 * i + (lane >> 5); float v = W[(size_t)(k0 + kk) * ldn + n0 + (lane & 31)]; if (gk) v *= gk[k0 + kk]; scr[kk * 33 + (lane & 31)] = v; }
    LDS_WAIT(); asm volatile("" ::: "memory");
    const int c = lane & 7;
#pragma unroll
    for (int j = 0; j < 4; ++j) { const int n = (lane >> 3) + 8 * j; const LAS float* s = scr + (8 * c) * 33 + n;
        v4u o; o.x = pk2(s[0 * 33], s[1 * 33]); o.y = pk2(s[2 * 33], s[3 * 33]); o.z = pk2(s[4 * 33], s[5 * 33]); o.w = pk2(s[6 * 33], s[7 * 33]);
        *(GAS v4u*)(WT + (size_t)(row_off + n0 + n) * K + k0 + 8 * c) = o; }
    LDS_WAIT(); asm volatile("" ::: "memory");
}

struct Ptrs {
    const float *x, *p, *g_mix, *w_in, *conv_w, *pool_w, *pool_scale, *w_o, *g_ffn, *w_q, *sub_keys, *eu, *ev, *g_ple, *w_gate, *w_proj, *g_final;
    float* out; unsigned char* ws;
};

__device__ __forceinline__ void p0a_phase(const Ptrs& P, LAS unsigned char* lds, int vcu, int G, int tid, int wave, int lane) {
    const int gw = vcu * NWAVES + wave, NGW = G * NWAVES;
    const int gt = vcu * (NWAVES * 64) + tid, NGT = G * NWAVES * 64;
    { float* Wf = (float*)(P.ws + WS_WF);
      for (int tk = gw; tk < 8192; tk += NGW) {
          const int k = tk >> 3, j = tk & 7, g = j >> 1, np = j * 64 + lane, d = np & 127;
          const float* wi = P.w_in + (size_t)k * 2048 + 1536 + g * 128; const float* pw = P.pool_w + (size_t)g * 128 * 128 + d;
          float a = 0.f;
#pragma unroll 8
          for (int c = 0; c < 128; ++c) a += wi[c] * pw[(size_t)c * 128];
          Wf[(size_t)k * 512 + np] = a * P.pool_scale[np];
      } }
    { LAS float* scr = (LAS float*)(lds + wave * 16384);
      constexpr int I_WO = 16 * 32, I_WQ = 16 * 64, I_WG = 16 * 32, I_WP = 4 * 32, I_WINA = 16 * 48;
      constexpr int NITEMS = I_WO + I_WQ + I_WG + I_WP + I_WINA;
      for (int it = gw; it < NITEMS; it += NGW) {
          int r = it;
          if (r < I_WO) { p0_transpose_item(P.w_o, 1024, nullptr, 1024, (bf16*)(P.ws + WS_WO), 0, 32, scr, r, lane); continue; } r -= I_WO;
          if (r < I_WQ) { p0_transpose_item(P.w_q, 2048, P.g_ffn, 1024, (bf16*)(P.ws + WS_WQ), 0, 64, scr, r, lane); continue; } r -= I_WQ;
          if (r < I_WG) { p0_transpose_item(P.w_gate, 1024, P.g_ple, 1024, (bf16*)(P.ws + WS_WG), 0, 32, scr, r, lane); continue; } r -= I_WG;
          if (r < I_WP) { p0_transpose_item(P.w_proj, 1024, nullptr, 256, (bf16*)(P.ws + WS_WP), 0, 32, scr, r, lane); continue; } r -= I_WP;
          p0_transpose_item(P.w_in, 2048, P.g_mix, 1024, (bf16*)(P.ws + WS_WIN), 0, 48, scr, r, lane);
      } }
    { const GAS f32x4* gf = (const GAS f32x4*)P.g_ffn + lane; f32x4 gq[4];
#pragma unroll
      for (int j = 0; j < 4; ++j) gq[j] = gf[64 * j];
      for (int r0 = 2 * gw; r0 < 2 * NEXP; r0 += 2 * NGW) {
          f32x4 a[2][4]; float q[2];
#pragma unroll
          for (int rr = 0; rr < 2; ++rr) { const int r = r0 + rr, tb = r >> 14, e = r & (NEXP - 1);
              const GAS f32x4* src = (const GAS f32x4*)((tb ? P.ev : P.eu) + (size_t)e * 1024) + lane;
#pragma unroll
              for (int j = 0; j < 4; ++j) a[rr][j] = src[64 * j]; }
#pragma unroll
          for (int rr = 0; rr < 2; ++rr) { const int tb = (r0 + rr) >> 14; q[rr] = 0.f;
#pragma unroll
              for (int j = 0; j < 4; ++j) { if (!tb) a[rr][j] = a[rr][j] * gq[j];
                  q[rr] += (a[rr][j].x * a[rr][j].x + a[rr][j].y * a[rr][j].y) + (a[rr][j].z * a[rr][j].z + a[rr][j].w * a[rr][j].w); } }
#pragma unroll
          for (int o = 1; o < 64; o <<= 1) { q[0] += __shfl_xor(q[0], o); q[1] += __shfl_xor(q[1], o); }
#pragma unroll
          for (int rr = 0; rr < 2; ++rr) { const int r = r0 + rr, tb = r >> 14, e = r & (NEXP - 1);
              const float rms = sqrtf(q[rr] * (1.0f / 1024.0f)); const float sc = rms > 0.f ? 2.0f / rms : 0.f;
              unsigned w0 = 0u, w1 = 0u;
              w0 = __builtin_amdgcn_cvt_scalef32_pk_fp4_f32(w0, a[rr][0].x * sc, a[rr][0].y * sc, 1.0f, 0); w0 = __builtin_amdgcn_cvt_scalef32_pk_fp4_f32(w0, a[rr][0].z * sc, a[rr][0].w * sc, 1.0f, 1);
              w0 = __builtin_amdgcn_cvt_scalef32_pk_fp4_f32(w0, a[rr][1].x * sc, a[rr][1].y * sc, 1.0f, 2); w0 = __builtin_amdgcn_cvt_scalef32_pk_fp4_f32(w0, a[rr][1].z * sc, a[rr][1].w * sc, 1.0f, 3);
              w1 = __builtin_amdgcn_cvt_scalef32_pk_fp4_f32(w1, a[rr][2].x * sc, a[rr][2].y * sc, 1.0f, 0); w1 = __builtin_amdgcn_cvt_scalef32_pk_fp4_f32(w1, a[rr][2].z * sc, a[rr][2].w * sc, 1.0f, 1);
              w1 = __builtin_amdgcn_cvt_scalef32_pk_fp4_f32(w1, a[rr][3].x * sc, a[rr][3].y * sc, 1.0f, 2); w1 = __builtin_amdgcn_cvt_scalef32_pk_fp4_f32(w1, a[rr][3].z * sc, a[rr][3].w * sc, 1.0f, 3);
              ((GAS v2u*)(P.ws + (tb ? WS_V : WS_U)))[(size_t)e * 64 + lane] = (v2u){w0, w1};
              if (lane == 0) ((float*)(P.ws + (tb ? WS_SV : WS_SU)))[e] = rms * 0.5f; }
      } }
    { const GAS f32x4* sp = (const GAS f32x4*)P.p; GAS v4u* dp = (GAS v4u*)(P.ws + WS_PB);
      for (int i = gt; i < M * PLED / 8; i += NGT) { const f32x4 a = sp[2 * (size_t)i], b = sp[2 * (size_t)i + 1]; v4u o; o.x = pk2(a.x, a.y); o.y = pk2(a.z, a.w); o.z = pk2(b.x, b.y); o.w = pk2(b.z, b.w); dp[i] = o; }
      const GAS f32x4* sk = (const GAS f32x4*)P.sub_keys; GAS v4u* dk = (GAS v4u*)(P.ws + WS_KEYS);
      for (int i = gt; i < 16 * 128 * 128 / 8; i += NGT) { const f32x4 a = sk[2 * (size_t)i], b = sk[2 * (size_t)i + 1]; v4u o; o.x = pk2(a.x, a.y); o.y = pk2(a.z, a.w); o.z = pk2(b.x, b.y); o.w = pk2(b.z, b.w); dk[i] = o; } }
    { float* RSX = (float*)(P.ws + WS_RSX); bf16* XB = (bf16*)(P.ws + WS_XB);
      for (int m = gw; m < M; m += NGW) {
          const GAS f32x4* xr = (const GAS f32x4*)(P.x + (size_t)m * D) + lane; f32x4 v[4]; float s = 0.f;
#pragma unroll
          for (int j = 0; j < 4; ++j) { v[j] = xr[64 * j]; s += (v[j].x * v[j].x + v[j].y * v[j].y) + (v[j].z * v[j].z + v[j].w * v[j].w); }
          s = wave_sum(s); if (lane == 0) RSX[m] = s;
          GAS unsigned long long* o8 = (GAS unsigned long long*)(XB + (size_t)m * D) + lane;
#pragma unroll
          for (int j = 0; j < 4; ++j) o8[64 * j] = (unsigned long long)pk2(v[j].x, v[j].y) | ((unsigned long long)pk2(v[j].z, v[j].w) << 32);
      } }
}
__device__ __forceinline__ void p0b_phase(const Ptrs& P, LAS unsigned char* lds, int vcu, int G, int wave, int lane) {
    const int gw = vcu * NWAVES + wave, NGW = G * NWAVES; LAS float* scr = (LAS float*)(lds + wave * 16384);
    for (int it = gw; it < 16 * 16; it += NGW) p0_transpose_item((const float*)(P.ws + WS_WF), 512, P.g_mix, 1024, (bf16*)(P.ws + WS_WIN), 1536, 16, scr, it, lane);
}

template <int HALF>
__device__ __forceinline__ void pool_chunk(const unsigned* col, unsigned* mx, int t0, int s0) {
    constexpr int TC = 32, NV = TC + 2 * HALF;
    float v0[NV], v1[NV];
#pragma unroll
    for (int i = 0; i < NV; ++i) {
        const int s = s0 - HALF + i; const bool ok = (s >= 0) && (s < SEQ);
        const unsigned w = col[(size_t)(ok ? (t0 - HALF + i) : t0) * 1024];
        v0[i] = ok ? bf_lo(w) : 0.f; v1[i] = ok ? bf_hi(w) : 0.f;
    }
    float S0 = 0.f, S1 = 0.f;
#pragma unroll
    for (int j = 0; j < 2 * HALF; ++j) { S0 += v0[j]; S1 += v1[j]; }
#pragma unroll
    for (int i = 0; i < TC; ++i) {
        const int s = s0 + i; const int lo = (s - HALF) > 0 ? (s - HALF) : 0, hi = (s + HALF) < SEQ ? (s + HALF) : SEQ;
        const float inv = 1.0f / (float)(hi - lo);
        mx[(size_t)(t0 + i) * 512] = pk2(S0 * inv - v0[i + HALF], S1 * inv - v1[i + HALF]);
        if (i + 1 < TC) { S0 += v0[i + 2 * HALF] - v0[i]; S1 += v1[i + 2 * HALF] - v1[i]; }
    }
}
__device__ __forceinline__ void p2_phase(const Ptrs& P, int vcu, int G, int tid, int wave) {
    const unsigned* PR = (const unsigned*)(P.ws + WS_PROJ);
    unsigned* MX = (unsigned*)(P.ws + WS_MIX);
    constexpr int TC = 32;
    for (int ck = vcu; ck < M / TC; ck += G) {
        const int t0 = ck * TC, s0 = t0 & (SEQ - 1);
        if (tid < 256) {
            const unsigned* col = PR + 768 + tid; unsigned* mx = MX + 256 + tid;
            if (wave == 0) pool_chunk<1>(col, mx, t0, s0); else if (wave == 1) pool_chunk<2>(col, mx, t0, s0); else if (wave == 2) pool_chunk<4>(col, mx, t0, s0); else pool_chunk<8>(col, mx, t0, s0);
        } else {
            const int cp = tid - 256;
            const unsigned* bcol = PR + cp; const unsigned* ccol = PR + 256 + cp; const unsigned* vcol = PR + 512 + cp;
            const float w00 = P.conv_w[2 * cp], w01 = P.conv_w[2 * cp + 1], w10 = P.conv_w[512 + 2 * cp], w11 = P.conv_w[512 + 2 * cp + 1], w20 = P.conv_w[1024 + 2 * cp], w21 = P.conv_w[1024 + 2 * cp + 1];
            float z0[TC + 2], z1[TC + 2]; unsigned bw[TC];
#pragma unroll
            for (int i = 0; i < TC + 2; ++i) {
                const int s = s0 - 1 + i; const bool ok = (s >= 0) && (s < SEQ); const size_t t = (size_t)(ok ? (t0 - 1 + i) : t0) * 1024;
                const unsigned c = ccol[t], v = vcol[t];
                z0[i] = ok ? bf_lo(c) * bf_lo(v) : 0.f; z1[i] = ok ? bf_hi(c) * bf_hi(v) : 0.f;
            }
#pragma unroll
            for (int i = 0; i < TC; ++i) bw[i] = bcol[(size_t)(t0 + i) * 1024];
#pragma unroll
            for (int i = 0; i < TC; ++i) {
                const float y0 = w00 * z0[i] + w10 * z0[i + 1] + w20 * z0[i + 2], y1 = w01 * z1[i] + w11 * z1[i + 1] + w21 * z1[i + 2];
                MX[(size_t)(t0 + i) * 512 + cp] = pk2(bf_lo(bw[i]) * y0, bf_hi(bw[i]) * y1);
            }
        }
    }
}

__device__ __forceinline__ float fmax_s(float a, float b) { float r; asm("v_max_f32_e32 %0, %1, %2" : "=v"(r) : "v"(a), "v"(b)); return r; }
__device__ __forceinline__ float fmin_s(float a, float b) { float r; asm("v_min_f32_e32 %0, %1, %2" : "=v"(r) : "v"(a), "v"(b)); return r; }
#define CE_DESC(a, b) do { const float _t = fmax_s(a, b); b = fmin_s(a, b); a = _t; } while (0)
#define CE_ASC(a, b)  do { const float _t = fmin_s(a, b); b = fmax_s(a, b); a = _t; } while (0)
__device__ __forceinline__ void sort16_desc(float* a) {
#pragma unroll
    for (int k = 2; k <= 16; k <<= 1)
#pragma unroll
        for (int j = k >> 1; j > 0; j >>= 1)
#pragma unroll
            for (int i = 0; i < 16; ++i) { const int l = i ^ j; if (l > i) { if ((i & k) == 0) CE_DESC(a[i], a[l]); else CE_ASC(a[i], a[l]); } }
}
__device__ __forceinline__ void merge16_desc(float* a) {
#pragma unroll
    for (int j = 8; j > 0; j >>= 1)
#pragma unroll
        for (int i = 0; i < 16; ++i) { const int l = i ^ j; if (l > i) CE_DESC(a[i], a[l]); }
}
__device__ __forceinline__ void top16_merge(float* a, const float* b) {
#pragma unroll
    for (int i = 0; i < 16; ++i) a[i] = fmax_s(a[i], b[15 - i]);
    merge16_desc(a);
}
__device__ __forceinline__ void top16_of_64(float* v) {
    sort16_desc(v); sort16_desc(v + 16); sort16_desc(v + 32); sort16_desc(v + 48);
    top16_merge(v, v + 16); top16_merge(v + 32, v + 48); top16_merge(v, v + 32);
}
__device__ __forceinline__ unsigned key_lookup(unsigned long long lo, unsigned long long hi, unsigned i) {
    const unsigned long long v = (i & 8u) ? hi : lo;
    return (unsigned)(v >> ((i & 7u) * 8u)) & 0x7fu;
}

constexpr int KROW = 272;
__device__ __forceinline__ void score_phase(const Ptrs& P, LAS unsigned char* lds, int bid, int G, int tid, int wave, int lane) {
    const bf16* Q = (const bf16*)(P.ws + WS_PROJ); const bf16* KEYS = (const bf16*)(P.ws + WS_KEYS); const float* RS1 = (const float*)(P.ws + WS_RS1);
    int* EIDX = (int*)(P.ws + WS_EIDX); float* GATE = (float*)(P.ws + WS_GATE);
    const int l31 = lane & 31, hi = lane >> 5;
    int cur_h = -1;
    for (int u = bid; u < (M / 256) * 8; u += G) {
        const int h = u & 7, tile = u >> 3;
        if (h != cur_h) {
            __syncthreads();
#pragma unroll
            for (int i = 0; i < 8; ++i) { const int q = tid + 512 * i, row = q >> 4, ch = q & 15;
                const v4u val = *(const GAS v4u*)(KEYS + ((size_t)(h * 256 + row)) * 128 + ch * 8);
                *(LAS v4u*)(lds + row * KROW + ch * 16) = val; }
            __syncthreads();
            cur_h = h;
        }
        const int tok = tile * 256 + wave * 32 + l31;
        float T0[16], T1[16];
#pragma unroll
        for (int p = 0; p < 2; ++p) {
            f32x16 acc[4];
#pragma unroll
            for (int kb = 0; kb < 4; ++kb)
#pragma unroll
                for (int r = 0; r < 16; ++r) acc[kb][r] = 0.f;
            const bf16* qp = Q + (size_t)tok * 2048 + h * 256 + p * 128 + hi * 8;
            bf16x8 bq[8];
#pragma unroll
            for (int ks = 0; ks < 8; ++ks) bq[ks] = *(const GAS bf16x8*)(qp + ks * 16);
#pragma unroll
            for (int ks = 0; ks < 8; ++ks)
#pragma unroll
                for (int kb = 0; kb < 4; ++kb) {
                    const bf16x8 ak = *(const LAS bf16x8*)(lds + (p * 128 + kb * 32 + l31) * KROW + (ks * 16 + hi * 8) * 2);
                    acc[kb] = __builtin_amdgcn_mfma_f32_32x32x16_bf16(ak, bq[ks], acc[kb], 0, 0, 0);
                }
            float v[64];
#pragma unroll
            for (int kb = 0; kb < 4; ++kb)
#pragma unroll
                for (int r = 0; r < 16; ++r) v[kb * 16 + r] = __uint_as_float((__float_as_uint(acc[kb][r]) & 0xffffff80u) | (unsigned)(kb * 32 + (r & 3) + 8 * (r >> 2)));
            top16_of_64(v);
            const unsigned hb = (unsigned)hi << 2;
#pragma unroll
            for (int i = 0; i < 16; ++i) v[i] = __uint_as_float(__float_as_uint(v[i]) | hb);
            float c[16];
#pragma unroll
            for (int i = 0; i < 16; ++i) c[i] = fmax_s(v[i], __shfl_xor(v[15 - i], 32));
            merge16_desc(c);
#pragma unroll
            for (int i = 0; i < 16; ++i) { if (p == 0) T0[i] = c[i]; else T1[i] = c[i]; }
        }
        float f0[16], f1[16];
        unsigned long long K0lo = 0ull, K0hi = 0ull, K1lo = 0ull, K1hi = 0ull;
#pragma unroll
        for (int b = 0; b < 8; ++b) {
            K0lo |= (unsigned long long)(__float_as_uint(T0[b]) & 0x7fu) << (8 * b); K0hi |= (unsigned long long)(__float_as_uint(T0[8 + b]) & 0x7fu) << (8 * b);
            K1lo |= (unsigned long long)(__float_as_uint(T1[b]) & 0x7fu) << (8 * b); K1hi |= (unsigned long long)(__float_as_uint(T1[8 + b]) & 0x7fu) << (8 * b);
        }
#pragma unroll
        for (int i = 0; i < 16; ++i) { f0[i] = __uint_as_float(__float_as_uint(T0[i]) & 0xffffff80u); f1[i] = __uint_as_float(__float_as_uint(T1[i]) & 0xffffff80u); }
        float cd[64]; int n = 0;
#pragma unroll
        for (int i = 0; i < 16; ++i)
#pragma unroll
            for (int j = 0; j < 16; ++j)
                if ((i + 1) * (j + 1) <= 16) { cd[n] = __uint_as_float((__float_as_uint(f0[i] + f1[j]) & 0xffffff00u) | (unsigned)(i * 16 + j)); ++n; }
#pragma unroll
        for (int q = 50; q < 64; ++q) cd[q] = __uint_as_float(0xff800000u);
        top16_of_64(cd);
        float rs = 0.f;
        { const GAS f32x4* rp = (const GAS f32x4*)(RS1 + (size_t)tok * 16);
#pragma unroll
          for (int i = 0; i < 4; ++i) { const f32x4 a = rp[i]; rs += (a.x + a.y) + (a.z + a.w); } }
        const float rstd = __builtin_amdgcn_rsqf(rs * (1.0f / 1024.0f) + EPS);
        int eidx[16]; float gt_[16]; float z0 = 0.f, sum = 0.f;
#pragma unroll
        for (int k = 0; k < 16; ++k) {
            const unsigned wb = __float_as_uint(cd[k]); const unsigned i = (wb >> 4) & 15u, j = wb & 15u;
            eidx[k] = (int)(key_lookup(K0lo, K0hi, i) * 128u + key_lookup(K1lo, K1hi, j));
            const float z = __uint_as_float(wb & 0xffffff00u) * rstd;
            if (k == 0) z0 = z;
            gt_[k] = __expf(z - z0); sum += gt_[k];
        }
        const float inv = 1.0f / sum;
        if (hi == 0) { GAS i32x4* ep = (GAS i32x4*)(EIDX + (size_t)tok * 128 + h * 16);
#pragma unroll
            for (int q = 0; q < 4; ++q) ep[q] = (i32x4){eidx[4 * q], eidx[4 * q + 1], eidx[4 * q + 2], eidx[4 * q + 3]};
        } else { GAS f32x4* gp = (GAS f32x4*)(GATE + (size_t)tok * 128 + h * 16);
#pragma unroll
            for (int q = 0; q < 4; ++q) gp[q] = (f32x4){gt_[4 * q] * inv, gt_[4 * q + 1] * inv, gt_[4 * q + 2] * inv, gt_[4 * q + 3] * inv};
        }
    }
}

__device__ __forceinline__ float gelu_tanh(float x) {
    const float y = 1.5957691216057308f * (x + 0.044715f * x * x * x);
    return x / (1.0f + __expf(-y));
}
__device__ __forceinline__ float dot16(const v2u& u, const f32x2* x) {
    const unsigned w0 = u.x, w1 = u.y;
    f32x2 a = __builtin_amdgcn_cvt_scalef32_pk_f32_fp4(w0, 1.0f, 0) * x[0], b = __builtin_amdgcn_cvt_scalef32_pk_f32_fp4(w0, 1.0f, 1) * x[1];
    a = __builtin_amdgcn_cvt_scalef32_pk_f32_fp4(w0, 1.0f, 2) * x[2] + a; b = __builtin_amdgcn_cvt_scalef32_pk_f32_fp4(w0, 1.0f, 3) * x[3] + b;
    a = __builtin_amdgcn_cvt_scalef32_pk_f32_fp4(w1, 1.0f, 0) * x[4] + a; b = __builtin_amdgcn_cvt_scalef32_pk_f32_fp4(w1, 1.0f, 1) * x[5] + b;
    a = __builtin_amdgcn_cvt_scalef32_pk_f32_fp4(w1, 1.0f, 2) * x[6] + a; b = __builtin_amdgcn_cvt_scalef32_pk_f32_fp4(w1, 1.0f, 3) * x[7] + b;
    a = a + b; return a.x + a.y;
}
__device__ __forceinline__ void axpy16(f32x2* o, float c, const v2u& v) {
    const unsigned w0 = v.x, w1 = v.y; const f32x2 c2 = {c, c};
    o[0] = __builtin_amdgcn_cvt_scalef32_pk_f32_fp4(w0, 1.0f, 0) * c2 + o[0]; o[1] = __builtin_amdgcn_cvt_scalef32_pk_f32_fp4(w0, 1.0f, 1) * c2 + o[1];
    o[2] = __builtin_amdgcn_cvt_scalef32_pk_f32_fp4(w0, 1.0f, 2) * c2 + o[2]; o[3] = __builtin_amdgcn_cvt_scalef32_pk_f32_fp4(w0, 1.0f, 3) * c2 + o[3];
    o[4] = __builtin_amdgcn_cvt_scalef32_pk_f32_fp4(w1, 1.0f, 0) * c2 + o[4]; o[5] = __builtin_amdgcn_cvt_scalef32_pk_f32_fp4(w1, 1.0f, 1) * c2 + o[5];
    o[6] = __builtin_amdgcn_cvt_scalef32_pk_f32_fp4(w1, 1.0f, 2) * c2 + o[6]; o[7] = __builtin_amdgcn_cvt_scalef32_pk_f32_fp4(w1, 1.0f, 3) * c2 + o[7];
}
__device__ __forceinline__ void peer_phase(const Ptrs& P, int vcu, int G, int wave, int lane) {
    const int gw = vcu * NWAVES + wave, NGW = G * NWAVES;
    bf16* HB = (bf16*)(P.ws + WS_HB); float* RS2 = (float*)(P.ws + WS_RS2);
    const int* EIDX = (const int*)(P.ws + WS_EIDX); const float* GATE = (const float*)(P.ws + WS_GATE);
    const GAS v2u* U8 = (const GAS v2u*)(P.ws + WS_U) + lane; const GAS v2u* V8 = (const GAS v2u*)(P.ws + WS_V) + lane;
    const float* SU = (const float*)(P.ws + WS_SU); const float* SV = (const float*)(P.ws + WS_SV);
    const int kl = ((lane & 1) << 3) | ((lane & 2) << 1) | ((lane & 4) >> 1) | ((lane & 8) >> 3);
    int t = gw; if (t >= M) return;
    int ei0 = EIDX[(size_t)t * 128 + lane], ei1 = EIDX[(size_t)t * 128 + 64 + lane];
    float gg0 = GATE[(size_t)t * 128 + lane], gg1 = GATE[(size_t)t * 128 + 64 + lane];
    v2u hrow[4];
    { const GAS v2u* hp = (const GAS v2u*)(HB + (size_t)t * 1024) + lane;
#pragma unroll
      for (int j = 0; j < 4; ++j) hrow[j] = hp[64 * j]; }
    v2u uw[16];
#pragma unroll
    for (int k = 0; k < 16; ++k) { const int e = __builtin_amdgcn_readlane(ei0, k); uw[k] = U8[(size_t)e * 64]; }
    for (; t < M; t += NGW) {
        const int tn = (t + NGW < M) ? t + NGW : t;
        f32x2 x[8]; float ss = 0.f;
#pragma unroll
        for (int j = 0; j < 4; ++j) { const unsigned wa = hrow[j].x, wb = hrow[j].y; x[2 * j] = (f32x2){bf_lo(wa), bf_hi(wa)}; x[2 * j + 1] = (f32x2){bf_lo(wb), bf_hi(wb)};
            ss += (x[2 * j].x * x[2 * j].x + x[2 * j].y * x[2 * j].y) + (x[2 * j + 1].x * x[2 * j + 1].x + x[2 * j + 1].y * x[2 * j + 1].y); }
        ss = wave_sum(ss);
        const float rstd = __builtin_amdgcn_rsqf(ss * (1.0f / 1024.0f) + EPS);
        const int nei0 = EIDX[(size_t)tn * 128 + lane], nei1 = EIDX[(size_t)tn * 128 + 64 + lane];
        const float ngg0 = GATE[(size_t)tn * 128 + lane], ngg1 = GATE[(size_t)tn * 128 + 64 + lane];
        f32x2 out[8];
#pragma unroll
        for (int i = 0; i < 8; ++i) out[i] = (f32x2){0.f, 0.f};
        for (int hq = 0; hq < 8 * REPS(7); ++hq) { const int hh = hq & 7;
            const int ereg = hh < 4 ? ei0 : ei1; const float greg = hh < 4 ? gg0 : gg1; const int lb = (hh & 3) * 16;
            const int el = __shfl(ereg, lb + kl);
            const float su = SU[el], sv = SV[el];
            __builtin_amdgcn_sched_barrier(0);
            v2u vw[16];
#pragma unroll
            for (int k = 0; k < 16; ++k) { const int e = __builtin_amdgcn_readlane(ereg, lb + k); vw[k] = V8[(size_t)e * 64]; }
            __builtin_amdgcn_sched_barrier(0);
            float part[16];
#pragma unroll
            for (int k = 0; k < 16; ++k) {
                if (REPS(9) == 2) { v2u c2 = uw[k]; asm volatile("" : "+v"(c2)); part[k] = 0.5f * (dot16(uw[k], x) + dot16(c2, x)); }
                else part[k] = dot16(uw[k], x);
            }
#pragma unroll
            for (int st = 0; st < 4; ++st) {
                const int m = 1 << st, nh = 8 >> st; const bool up = (lane & m) != 0;
#pragma unroll
                for (int i = 0; i < nh; ++i) {
                    const float send = up ? part[i] : part[i + nh], keep = up ? part[i + nh] : part[i];
                    part[i] = keep + __shfl_xor(send, m);
                }
            }
            float d = part[0]; d += __shfl_xor(d, 16); d += __shfl_xor(d, 32);
            const float gk = __shfl(greg, lb + kl);
            const float cf = gk * gelu_tanh(d * su * rstd) * sv;
            __builtin_amdgcn_sched_barrier(0);
            { const bool lasth = (hq == 8 * REPS(7) - 1); const int hn = (hh + 1) & 7;
              const int nreg = lasth ? nei0 : (hn < 4 ? ei0 : ei1); const int nlb = (hn & 3) * 16;
#pragma unroll
              for (int k = 0; k < 16; ++k) { const int e = __builtin_amdgcn_readlane(nreg, nlb + k); uw[k] = U8[(size_t)e * 64]; } }
            __builtin_amdgcn_sched_barrier(0);
#pragma unroll
            for (int k = 0; k < 16; ++k) {
                const int src = ((k & 1) << 3) | ((k & 2) << 1) | ((k & 4) >> 1) | ((k & 8) >> 3);
                const float ck = __uint_as_float(__builtin_amdgcn_readlane(__float_as_uint(cf), src));
                if (REPS(9) == 2) { v2u c2 = vw[k]; asm volatile("" : "+v"(c2)); axpy16(out, 0.5f * ck, vw[k]); axpy16(out, 0.5f * ck, c2); }
                else axpy16(out, ck, vw[k]);
            }
        }
        if (REPS(7) == 2) {
#pragma unroll
            for (int i = 0; i < 8; ++i) out[i] = out[i] * 0.5f; }
        float s2 = 0.f;
        GAS v2u* hb = (GAS v2u*)(HB + (size_t)t * 1024) + lane;
#pragma unroll
        for (int j = 0; j < 4; ++j) { const f32x2 o0 = x[2 * j] + out[2 * j], o1 = x[2 * j + 1] + out[2 * j + 1];
            hb[64 * j] = (v2u){pk2(o0.x, o0.y), pk2(o1.x, o1.y)};
            s2 += (o0.x * o0.x + o0.y * o0.y) + (o1.x * o1.x + o1.y * o1.y); }
        s2 = wave_sum(s2);
        if (lane == 0) RS2[t] = s2;
        { const GAS v2u* hn = (const GAS v2u*)(HB + (size_t)tn * 1024) + lane;
#pragma unroll
          for (int j = 0; j < 4; ++j) hrow[j] = hn[64 * j]; }
        ei0 = nei0; ei1 = nei1; gg0 = ngg0; gg1 = ngg1;
    }
}

__device__ __forceinline__ void final_phase(const Ptrs& P, int vcu, int G, int wave, int lane) {
    const int gw = vcu * NWAVES + wave, NGW = G * NWAVES; const float* RS3 = (const float*)(P.ws + WS_RS3);
    const GAS f32x4* gf = (const GAS f32x4*)P.g_final + lane;
    f32x4 g[4];
#pragma unroll
    for (int j = 0; j < 4; ++j) g[j] = gf[64 * j];
    for (int m = gw; m < M; m += NGW) {
        GAS f32x4* xr = (GAS f32x4*)(P.out + (size_t)m * D) + lane;
        float rs = 0.f; { const GAS f32x4* rp = (const GAS f32x4*)(RS3 + (size_t)m * 16);
#pragma unroll
            for (int i = 0; i < 4; ++i) { const f32x4 a = rp[i]; rs += (a.x + a.y) + (a.z + a.w); } }
        const float rstd = __builtin_amdgcn_rsqf(rs * (1.0f / 1024.0f) + EPS);
#pragma unroll
        for (int j = 0; j < 4; ++j) { const f32x4 v = xr[64 * j]; xr[64 * j] = v * rstd * g[j]; }
    }
}

struct Args { const float* in[17]; float* out; unsigned char* ws; int ph_lo, ph_hi; };
#ifndef PG8_SP2
#define PG8_SP2 true
#endif
#ifndef PG8_ALIGN
#define PG8_ALIGN true
#endif
__global__ void __launch_bounds__(NWAVES * 64, 2) mega_fwd(Args args) {
    extern __shared__ __attribute__((aligned(16))) unsigned char lds_raw[];
    LAS unsigned char* lds = (LAS unsigned char*)lds_raw;
    volatile LAS unsigned* MISC = (volatile LAS unsigned*)(lds + MISC_OFF);
    const int tid = threadIdx.x, lane = tid & 63, wave = __builtin_amdgcn_readfirstlane(tid >> 6);
    const int G = gridDim.x, bx = blockIdx.x; const int vcu = (G % 8 == 0) ? (bx % 8) * (G / 8) + bx / 8 : bx;
    Ptrs P;
    P.x = args.in[0]; P.p = args.in[1]; P.g_mix = args.in[2]; P.w_in = args.in[3]; P.conv_w = args.in[4]; P.pool_w = args.in[5]; P.pool_scale = args.in[6]; P.w_o = args.in[7];
    P.g_ffn = args.in[8]; P.w_q = args.in[9]; P.sub_keys = args.in[10]; P.eu = args.in[11]; P.ev = args.in[12]; P.g_ple = args.in[13]; P.w_gate = args.in[14]; P.w_proj = args.in[15]; P.g_final = args.in[16];
    P.out = args.out; P.ws = args.ws;
    gu32* ctl = (gu32*)(P.ws + WS_CTL);
    for (int u = tid; u < (LDS_BYTES - LDSCTL_OFF) / 4; u += NWAVES * 64) ((LAS unsigned*)(lds + LDSCTL_OFF))[u] = 0u;
    __syncthreads();
    XcdBarrier bar; bar.bar = (unsigned*)(ctl + CW_BAR); bar.x = 0; bar.st = nullptr;
    if (!MK_PER_PHASE) bar = xcd_barrier_post((unsigned*)(ctl + CW_BAR), MISC + 8);
    const int lo = args.ph_lo, hi = args.ph_hi;
#define IN(k) (lo <= (k) && (k) < hi)
#define SEAM(k) do { if (IN(k) && IN((k) + 1)) xcd_barrier(bar); } while (0)
    pg8::bf16_t* const WIN = (pg8::bf16_t*)(P.ws + WS_WIN); pg8::bf16_t* const WO = (pg8::bf16_t*)(P.ws + WS_WO); pg8::bf16_t* const WQ = (pg8::bf16_t*)(P.ws + WS_WQ);
    pg8::bf16_t* const WG = (pg8::bf16_t*)(P.ws + WS_WG); pg8::bf16_t* const WP = (pg8::bf16_t*)(P.ws + WS_WP);
    pg8::bf16_t* const XB = (pg8::bf16_t*)(P.ws + WS_XB); pg8::bf16_t* const PL = XB; pg8::bf16_t* const PROJ = (pg8::bf16_t*)(P.ws + WS_PROJ); pg8::bf16_t* const QB = PROJ;
    pg8::bf16_t* const MIX = (pg8::bf16_t*)(P.ws + WS_MIX); pg8::bf16_t* const HB = (pg8::bf16_t*)(P.ws + WS_HB); pg8::bf16_t* const PB = (pg8::bf16_t*)(P.ws + WS_PB);

    if (IN(0)) { for (int rep = 0; rep < REPS(1); ++rep) { p0a_phase(P, lds, vcu, G, tid, wave, lane); SEAM(0); } }
    if (IN(1)) { p0b_phase(P, lds, vcu, G, wave, lane); SEAM(1); }
    if (IN(2)) {
        pg8::Gemm g{XB, WIN, M, NPROJ, D}; pg8::StaticOrder S; S.init(M, NPROJ, G, bx);
        EpiBf16Row E{PROJ, NPROJ, (const float*)(P.ws + WS_RSX)};
        for (int rep = 0; rep < REPS(2); ++rep) { pg8::gemm_phase<EpiBf16Row, pg8::StaticOrder, PG8_ALIGN, PG8_SP2>(lds, g, S, E);
        SEAM(2); }
    }
    if (IN(3)) {
        for (int rep = 0; rep < REPS(3); ++rep) p2_phase(P, vcu, G, tid, wave);
        pg8::Gemm g{PB, WP, M, D, PLED}; pg8::StaticOrder S; S.init(M, D, G, bx);
        EpiBf16Row E{PL, D, nullptr};
        for (int rep = 0; rep < REPS(8); ++rep) pg8::gemm_phase<EpiBf16Row, pg8::StaticOrder, PG8_ALIGN, PG8_SP2>(lds, g, S, E);
        SEAM(3);
    }
    if (IN(4)) {
        pg8::Gemm g{MIX, WO, M, D, D}; pg8::StaticOrder S; S.init(M, D, G, bx);
        EpiH1 E{P.x, HB, (float*)(P.ws + WS_RS1)};
        for (int rep = 0; rep < REPS(4); ++rep) { pg8::gemm_phase<EpiH1, pg8::StaticOrder, PG8_ALIGN, PG8_SP2>(lds, g, S, E);
        SEAM(4); }
    }
    if (IN(5)) {
        pg8::Gemm g{HB, WQ, M, NQ, D}; pg8::StaticOrder S; S.init(M, NQ, G, bx);
        EpiBf16Row E{QB, NQ, nullptr};
        for (int rep = 0; rep < REPS(5); ++rep) { pg8::gemm_phase<EpiBf16Row, pg8::StaticOrder, PG8_ALIGN, PG8_SP2>(lds, g, S, E);
        SEAM(5); }
    }
    if (IN(6)) { for (int rep = 0; rep < REPS(6); ++rep) { score_phase(P, lds, bx, G, tid, wave, lane); SEAM(6); } }
    if (IN(7)) { peer_phase(P, vcu, G, wave, lane); SEAM(7); }
    if (IN(8)) {
        pg8::Gemm g{HB, WG, M, D, D}; pg8::StaticOrder S; S.init(M, D, G, bx);
        EpiGate E{P.out, HB, PL, (const float*)(P.ws + WS_RS2), (float*)(P.ws + WS_RS3)};
        pg8::gemm_phase<EpiGate, pg8::StaticOrder, PG8_ALIGN, PG8_SP2>(lds, g, S, E);
        SEAM(8);
    }
    if (IN(9)) { final_phase(P, vcu, G, wave, lane); }
#undef IN
#undef SEAM
}

extern "C" void kernel_launch(void* const* d_in, const int* in_sizes, int n_in, void* d_out, int out_size, void* d_ws, size_t ws_size, hipStream_t stream) {
    static int grid = 0;
    if (grid == 0) {
        if (n_in != 17 || in_sizes[0] != M * D || out_size != M * D || ws_size < WS_END) { fprintf(stderr, "kernel_launch: unexpected shapes (n_in %d, in0 %d, out %d, ws %zu); nothing launched\n", n_in, n_in > 0 ? in_sizes[0] : -1, out_size, ws_size); grid = -1; return; }
        int dev = 0, cus = 0, per_cu = 0;
        if (hipGetDevice(&dev) != hipSuccess || hipDeviceGetAttribute(&cus, hipDeviceAttributeMultiprocessorCount, dev) != hipSuccess) { fprintf(stderr, "kernel_launch: device query failed\n"); grid = -1; return; }
        if (hipFuncSetAttribute((const void*)mega_fwd, hipFuncAttributeMaxDynamicSharedMemorySize, LDS_BYTES) != hipSuccess) { fprintf(stderr, "kernel_launch: hipFuncSetAttribute failed\n"); grid = -1; return; }
        if (hipOccupancyMaxActiveBlocksPerMultiprocessor(&per_cu, (const void*)mega_fwd, NWAVES * 64, LDS_BYTES) != hipSuccess || per_cu < 1)
            fprintf(stderr, "kernel_launch: note: occupancy query reports %d workgroups per CU\n", per_cu);
        (void)hipGetLastError();
        grid = cus;
    }
    if (grid < 0) return;
    if (hipMemsetAsync((char*)d_ws + WS_CTL, 0, CTL_ZERO_BYTES, stream) != hipSuccess) { fprintf(stderr, "kernel_launch: memset failed\n"); return; }
    Args a{};
    for (int i = 0; i < 17; ++i) a.in[i] = (const float*)d_in[i];
    a.out = (float*)d_out; a.ws = (unsigned char*)d_ws;
#if MK_PER_PHASE
    for (int ph = 0; ph < NPHASES; ++ph) { a.ph_lo = ph; a.ph_hi = ph + 1; hipLaunchKernelGGL(mega_fwd, dim3(grid), dim3(NWAVES * 64), LDS_BYTES, stream, a); }
#else
    a.ph_lo = 0; a.ph_hi = NPHASES;
    hipLaunchKernelGGL(mega_fwd, dim3(grid), dim3(NWAVES * 64), LDS_BYTES, stream, a);
#endif
    const hipError_t le = hipPeekAtLastError();
    if (le != hipSuccess) fprintf(stderr, "kernel_launch: launch failed: %s\n", hipGetErrorName(le));
}
```

```cpp
#include <hip/hip_runtime.h>
#include <cstdio>
#include <cstdint>
namespace pg8 {
#define PG8_LAS __attribute__((address_space(3)))
typedef unsigned short bf16_t;
typedef short bf16x8 __attribute__((ext_vector_type(8)));
typedef float f32x4 __attribute__((ext_vector_type(4)));
typedef unsigned u32x4 __attribute__((ext_vector_type(4)));
constexpr int BM = 256, BK = 64, HALF = 128, HTB = HALF * BK * 2  , STAGE_BYTES = 8 * HTB, NXCD = 8, WGM = 8;

__host__ __device__ __forceinline__ int lds_byte(int r, int c) { const int st = (r >> 4) * 2 + (c >> 5), rr = r & 15, cc = c & 31, ob = rr * 64 + cc * 2; return st * 1024 + (ob ^ (((ob >> 9) & 1) << 5)); }
__host__ __device__ __forceinline__ void stage_rc(int b, int& R, int& C) { const int st = b / 1024, sb = b % 1024, swz = sb ^ (((sb >> 9) & 1) << 5); R = (st >> 1) * 16 + swz / 64; C = (st & 1) * 32 + (swz % 64) / 2; }
__host__ __device__ __forceinline__ int perm32(int rho) { const int n = rho >> 4, i = rho & 15; return 8 * (i >> 2) + 4 * n + (i & 3); }

struct Unit { int pm, pn; };
struct Gemm { const bf16_t* A; const bf16_t* Bt; int M, N, K; };

struct StaticOrder {
    int nM, nN, nwg, G, c;
    __host__ __device__ void init(int M, int N, int G_, int c_) { nM = M / BM; nN = N / BM; nwg = nM * nN; G = G_; c = c_; }
    __host__ __device__ bool next(int i, Unit& u) const {
        const long L = (long)i * G + c; if (L >= nwg) return false;
        int wgid = (int)L; { const int q = nwg / NXCD, r = nwg % NXCD, xcd = wgid % NXCD, off = wgid / NXCD; wgid = (xcd < r ? xcd * (q + 1) : r * (q + 1) + (xcd - r) * q) + off; }
        const int nig = WGM * nN, gid = wgid / nig, fm = gid * WGM, gsz = (nM - fm) < WGM ? (nM - fm) : WGM;
        u.pm = fm + ((wgid % nig) % gsz); u.pn = (wgid % nig) / gsz; return true;
    }
    __device__ __forceinline__ void a_ready(const Unit&) const {}
    __device__ __forceinline__ void done(const Unit&) const {}
};

__device__ __forceinline__ unsigned cvt_pk_bf16(float lo, float hi) { unsigned r; asm volatile("v_cvt_pk_bf16_f32 %0, %1, %2" : "=v"(r) : "v"(lo), "v"(hi)); return r; }
template <class Epi, class Sched, bool ALIGN_EPI = false, bool SP2 = false>
__device__ __forceinline__ void gemm_phase(PG8_LAS unsigned char* lds, const Gemm g, const Sched& S, const Epi& E) {
    const int tid = threadIdx.x, wid = __builtin_amdgcn_readfirstlane(tid >> 6), lane = tid & 63, wr = wid >> 2, wc = wid & 3, fr = lane & 15, fq = lane >> 4;
    const int K = g.K, nt = K / BK;
    unsigned voffA[2], voffB[2];
#pragma unroll
    for (int i = 0; i < 2; ++i) { int R, C; stage_rc(tid * 16 + i * 8192, R, C); const int Rb = Epi::PERM ? ((R & ~31) + perm32(R & 31)) : R;
        voffA[i] = (unsigned)(R * K + C) * 2u; voffB[i] = (unsigned)(Rb * K + C) * 2u; }
    const size_t kstep = (size_t)(BK * 2);
    const size_t hstep = (size_t)HALF * K * 2;
    const size_t tstep = 2 * hstep;
    const unsigned ldsw = (unsigned)wid * 1024u;
    const int aoff = lds_byte(wr * 64 + fr, fq * 8), boff = lds_byte(wc * 32 + fr, fq * 8);
#define PG8_SA(b, h) (((b) * 2 + (h)) * HTB)
#define PG8_SB(b, h) ((4 + (b) * 2 + (h)) * HTB)
#define PG8_STAGE(bufoff, gbase, voff) do { _Pragma("unroll") for (int _i = 0; _i < 2; ++_i) \
        __builtin_amdgcn_global_load_lds((const unsigned*)((const char*)(gbase) + (voff)[_i]), (PG8_LAS unsigned*)(lds + (bufoff) + ldsw + _i * 8192), 16, 0, 0); } while (0)
#define PG8_LDA(dst, b, h) do { _Pragma("unroll") for (int m = 0; m < 4; ++m) _Pragma("unroll") for (int k = 0; k < 2; ++k) dst[m][k] = *(const PG8_LAS bf16x8*)(lds + PG8_SA(b, h) + aoff + m * 2048 + k * 1024); } while (0)
#define PG8_LDB(dst, b, h) do { _Pragma("unroll") for (int n = 0; n < 2; ++n) _Pragma("unroll") for (int k = 0; k < 2; ++k) dst[n][k] = *(const PG8_LAS bf16x8*)(lds + PG8_SB(b, h) + boff + n * 2048 + k * 1024); } while (0)
#define PG8_MMA(ai, bj, At, Bt) do { __builtin_amdgcn_s_setprio(1); _Pragma("unroll") for (int m = 0; m < 4; ++m) _Pragma("unroll") for (int n = 0; n < 2; ++n) _Pragma("unroll") for (int k = 0; k < 2; ++k) \
        acc[ai][bj][m][n] = __builtin_amdgcn_mfma_f32_16x16x32_bf16(Bt[n][k], At[m][k], acc[ai][bj][m][n], 0, 0, 0); __builtin_amdgcn_s_setprio(0); } while (0)
#define PG8_WAIT_V(n) asm volatile("s_waitcnt vmcnt(" #n ")" ::: "memory")
#define PG8_WAIT_L(n) asm volatile("s_waitcnt lgkmcnt(" #n ")" ::: "memory")
#define PG8_BAR __builtin_amdgcn_s_barrier()
#define PG8_SCHED __builtin_amdgcn_sched_barrier(0)
    Unit cur, nxt; int ui = 0;
    if (!S.next(0, cur)) return;
    f32x4 acc[2][2][4][2];
#pragma unroll
    for (int a = 0; a < 2; ++a)
#pragma unroll
        for (int b = 0; b < 2; ++b)
#pragma unroll
            for (int m = 0; m < 4; ++m)
#pragma unroll
                for (int n = 0; n < 2; ++n) acc[a][b][m][n] = (f32x4){0.f, 0.f, 0.f, 0.f};
    bf16x8 At[4][2], B0[2][2], B1[2][2];
    const char* cA = (const char*)g.A + (size_t)cur.pm * tstep; const char* cB = (const char*)g.Bt + (size_t)cur.pn * tstep;
    S.a_ready(cur);
    if constexpr (SP2) {
        PG8_STAGE(PG8_SB(0, 0), cB, voffB); PG8_STAGE(PG8_SB(0, 1), cB + hstep, voffB); PG8_STAGE(PG8_SA(0, 0), cA, voffA); PG8_STAGE(PG8_SA(0, 1), cA + hstep, voffA);
        if (wr == 1) PG8_BAR;
        PG8_WAIT_V(2); PG8_BAR;
        PG8_STAGE(PG8_SB(1, 0), cB + kstep, voffB); PG8_STAGE(PG8_SA(1, 0), cA + kstep, voffA); PG8_STAGE(PG8_SB(1, 1), cB + hstep + kstep, voffB);
        PG8_WAIT_V(6); PG8_BAR;
    } else {
        PG8_STAGE(PG8_SB(0, 0), cB, voffB); PG8_STAGE(PG8_SA(0, 0), cA, voffA); PG8_STAGE(PG8_SB(0, 1), cB + hstep, voffB); PG8_STAGE(PG8_SA(0, 1), cA + hstep, voffA);
        if (wr == 1) PG8_BAR;
        PG8_WAIT_V(4); PG8_BAR;
        PG8_STAGE(PG8_SB(1, 0), cB + kstep, voffB); PG8_STAGE(PG8_SA(1, 0), cA + kstep, voffA); PG8_STAGE(PG8_SB(1, 1), cB + hstep + kstep, voffB);
        PG8_WAIT_V(6); PG8_BAR;
    }
    for (;;) {
        const bool has_next = S.next(ui + 1, nxt);
        const char* nA = has_next ? (const char*)g.A + (size_t)nxt.pm * tstep : cA; const char* nB = has_next ? (const char*)g.Bt + (size_t)nxt.pn * tstep : cB;
        for (int t = 0; t < nt; t += 2) {
            const bool last = (t == nt - 2);
            const char* a1 = cA + (size_t)(t + 1) * kstep;
            const char* a2 = last ? nA : cA + (size_t)(t + 2) * kstep; const char* b2 = last ? nB : cB + (size_t)(t + 2) * kstep;
            const char* a3 = a2 + kstep; const char* b3 = b2 + kstep;
            if (last && has_next) S.a_ready(nxt);
            if constexpr (SP2) {
            PG8_LDB(B0, 0, 0); PG8_LDB(B1, 0, 1); PG8_SCHED; PG8_LDA(At, 0, 0); PG8_STAGE(PG8_SA(1, 1), a1 + hstep, voffA);
            PG8_WAIT_V(8); PG8_WAIT_L(0); PG8_BAR; PG8_MMA(0, 0, At, B0); PG8_MMA(0, 1, At, B1); PG8_BAR; PG8_SCHED;
            PG8_LDA(At, 0, 1); PG8_STAGE(PG8_SB(0, 0), b2, voffB); PG8_STAGE(PG8_SB(0, 1), b2 + hstep, voffB); PG8_STAGE(PG8_SA(0, 0), a2, voffA);
            PG8_WAIT_V(8); PG8_WAIT_L(0); PG8_BAR; PG8_MMA(1, 0, At, B0); PG8_MMA(1, 1, At, B1); PG8_BAR; PG8_SCHED;
            PG8_LDB(B0, 1, 0); PG8_LDB(B1, 1, 1); PG8_SCHED; PG8_LDA(At, 1, 0); PG8_STAGE(PG8_SA(0, 1), a2 + hstep, voffA);
            PG8_WAIT_V(8); PG8_WAIT_L(0); PG8_BAR; PG8_MMA(0, 0, At, B0); PG8_MMA(0, 1, At, B1); PG8_BAR; PG8_SCHED;
            PG8_LDA(At, 1, 1); PG8_STAGE(PG8_SB(1, 0), b3, voffB); PG8_STAGE(PG8_SB(1, 1), b3 + hstep, voffB); PG8_STAGE(PG8_SA(1, 0), a3, voffA);
            PG8_WAIT_V(8); PG8_WAIT_L(0); PG8_BAR; PG8_MMA(1, 0, At, B0); PG8_MMA(1, 1, At, B1); PG8_BAR; PG8_SCHED;
            } else {
            PG8_LDB(B0, 0, 0); PG8_SCHED; PG8_LDA(At, 0, 0); PG8_STAGE(PG8_SA(1, 1), a1 + hstep, voffA);
            PG8_WAIT_L(8); PG8_BAR; PG8_WAIT_L(0); PG8_MMA(0, 0, At, B0); PG8_BAR; PG8_SCHED;
            PG8_LDB(B1, 0, 1); PG8_STAGE(PG8_SB(0, 0), b2, voffB);
            PG8_BAR; PG8_WAIT_L(0); PG8_MMA(0, 1, At, B1); PG8_BAR;
            PG8_LDA(At, 0, 1); PG8_STAGE(PG8_SA(0, 0), a2, voffA);
            PG8_BAR; PG8_WAIT_L(0); PG8_MMA(1, 0, At, B0); PG8_BAR; PG8_SCHED;
            PG8_STAGE(PG8_SB(0, 1), b2 + hstep, voffB);
            PG8_WAIT_V(6); PG8_BAR; PG8_MMA(1, 1, At, B1); PG8_BAR;
            PG8_LDB(B0, 1, 0); PG8_SCHED; PG8_LDA(At, 1, 0); PG8_STAGE(PG8_SA(0, 1), a2 + hstep, voffA);
            PG8_WAIT_L(8); PG8_BAR; PG8_WAIT_L(0); PG8_MMA(0, 0, At, B0); PG8_BAR; PG8_SCHED;
            PG8_LDB(B1, 1, 1); PG8_STAGE(PG8_SB(1, 0), b3, voffB);
            PG8_BAR; PG8_WAIT_L(0); PG8_MMA(0, 1, At, B1); PG8_BAR;
            PG8_LDA(At, 1, 1); PG8_STAGE(PG8_SA(1, 0), a3, voffA);
            PG8_BAR; PG8_WAIT_L(0); PG8_MMA(1, 0, At, B0); PG8_BAR; PG8_SCHED;
            PG8_STAGE(PG8_SB(1, 1), b3 + hstep, voffB);
            PG8_WAIT_V(6); PG8_BAR; PG8_MMA(1, 1, At, B1); PG8_BAR;
            }
        }
        if constexpr (ALIGN_EPI) { if (wr == 0) PG8_BAR; }
        if constexpr (!Epi::AFTER_DRAIN) { E(acc, cur, wr, wc, fr, fq); S.done(cur); }
        if (!has_next) break;
#pragma unroll
        for (int a = 0; a < 2; ++a)
#pragma unroll
            for (int b = 0; b < 2; ++b)
#pragma unroll
                for (int m = 0; m < 4; ++m)
#pragma unroll
                    for (int n = 0; n < 2; ++n) acc[a][b][m][n] = (f32x4){0.f, 0.f, 0.f, 0.f};
        cur = nxt; cA = nA; cB = nB; ++ui;
        if constexpr (ALIGN_EPI) { if (wr == 1) PG8_BAR; }
    }
    PG8_WAIT_V(0);
    if constexpr (!ALIGN_EPI) { if (wr == 0) PG8_BAR; }
    PG8_BAR;
    if constexpr (Epi::AFTER_DRAIN) { E.fused(acc, cur, wr, wc, fr, fq, lds, wid, lane); S.done(cur); }
#undef PG8_SA
#undef PG8_SB
#undef PG8_STAGE
#undef PG8_LDA
#undef PG8_LDB
#undef PG8_MMA
#undef PG8_WAIT_V
#undef PG8_WAIT_L
#undef PG8_BAR
#undef PG8_SCHED
}
}

#define GAS __attribute__((address_space(1)))
#define LAS __attribute__((address_space(3)))
typedef unsigned short bf16;
typedef unsigned v4u __attribute__((ext_vector_type(4)));
typedef float f32x4 __attribute__((ext_vector_type(4)));
typedef short bf16x8 __attribute__((ext_vector_type(8)));
typedef GAS unsigned gu32;
typedef GAS unsigned long long gu64;
#define RLX_AGENT __ATOMIC_RELAXED, __HIP_MEMORY_SCOPE_AGENT
#define LDS_WAIT() asm volatile("s_waitcnt lgkmcnt(0)" ::: "memory")
#define VM_WAIT() asm volatile("s_waitcnt vmcnt(0)" ::: "memory")
__device__ __forceinline__ unsigned long long rt() { return __builtin_amdgcn_s_memrealtime(); }
__device__ __forceinline__ unsigned f2bf(float f) { unsigned u = __builtin_bit_cast(unsigned, f); return (u + 0x7fffu + ((u >> 16) & 1u)) >> 16; }
__device__ __forceinline__ unsigned pk2(float lo, float hi) { return f2bf(lo) | (f2bf(hi) << 16); }

#define XB_TMO      128
#define XB_XCNT(j)  (256  + 64 * (j))
#define XB_XSUB(j)  (1280 + 64 * (j))
#define XB_XGEN(j)  (2304 + 64 * (j))
#define XB_TOP      3328
#define XB_TOPGEN   3392
#define XCD_BAR_WORDS 3456
#define XB_SPIN_CAP (1u << 18)

__device__ __forceinline__ unsigned xb_ld(unsigned* p)              { return __hip_atomic_load(p, __ATOMIC_RELAXED, __HIP_MEMORY_SCOPE_AGENT); }
__device__ __forceinline__ unsigned xb_add(unsigned* p, unsigned v) { return __hip_atomic_fetch_add(p, v, __ATOMIC_RELAXED, __HIP_MEMORY_SCOPE_AGENT); }
__device__ __forceinline__ unsigned xb_xcc_id() { return (unsigned)__builtin_amdgcn_s_getreg((3 << 11) | 20) & 0xFu; }
#define XB_SPIN(cond, bar) do { unsigned _sp = 0; while (cond) { __builtin_amdgcn_s_sleep(1); \
    if ((++_sp & 255u) == 0u) { if (xb_ld(&(bar)[XB_TMO])) break; if (_sp > XB_SPIN_CAP) { atomicAdd(&(bar)[XB_TMO], 1u); break; } } } } while (0)

struct XcdBarrier {
    unsigned* bar; unsigned x;
    volatile LAS unsigned* st;
};

__device__ __forceinline__ XcdBarrier xcd_barrier_post(unsigned* bar, volatile LAS unsigned* st) {
    XcdBarrier b; b.bar = bar; b.x = xb_xcc_id(); b.st = st;
    if (threadIdx.x == 0) (void)xb_add(&bar[XB_XCNT(b.x)], 1u);
    return b;
}
__device__ __forceinline__ void xcd_barrier_complete(unsigned* bar, unsigned x, unsigned& nloc, unsigned& nx) {
    const unsigned G = gridDim.x * gridDim.y * gridDim.z;
    unsigned sum, cnt, mine, sp = 0u;
    for (;;) {
        sum = 0u; cnt = 0u; mine = 0u;
#pragma unroll
        for (unsigned j = 0; j < 16; ++j) { const unsigned c = xb_ld(&bar[XB_XCNT(j)]); sum += c; cnt += (c > 0u) ? 1u : 0u; mine = (j == x) ? c : mine; }
        if (sum == G) break;
        __builtin_amdgcn_s_sleep(1);
        if ((++sp & 255u) == 0u) { if (xb_ld(&bar[XB_TMO])) break; if (sp > XB_SPIN_CAP) { atomicAdd(&bar[XB_TMO], 1u); break; } }
    }
    nloc = mine > 0u ? mine : 1u; nx = cnt > 0u ? cnt : 1u;
}

__device__ __forceinline__ void xcd_barrier(const XcdBarrier& b) {
    asm volatile("s_waitcnt vmcnt(0)" ::: "memory");
    __syncthreads();
    if (threadIdx.x == 0) {
        unsigned* bar = b.bar;
        __builtin_amdgcn_s_waitcnt(0);
        unsigned nloc = b.st[0], nx = b.st[1];
        if (nloc == 0u) { xcd_barrier_complete(bar, b.x, nloc, nx); b.st[0] = nloc; b.st[1] = nx; }
        const unsigned old = xb_add(&bar[XB_XSUB(b.x)], 1u);
        const unsigned gen = old / nloc;
        if (old + 1u == (gen + 1u) * nloc) {
            __builtin_amdgcn_fence(__ATOMIC_RELEASE, "agent");
            asm volatile("s_waitcnt vmcnt(0)" ::: "memory");
            const unsigned og = xb_add(&bar[XB_TOP], 1u);
            const unsigned tg = og / nx;
            if (og + 1u == (tg + 1u) * nx) xb_add(&bar[XB_TOPGEN], 1u);
            else XB_SPIN(xb_ld(&bar[XB_TOPGEN]) == tg, bar);
            __builtin_amdgcn_fence(__ATOMIC_ACQUIRE, "agent");
            xb_add(&bar[XB_XGEN(b.x)], 1u);
            asm volatile("s_waitcnt vmcnt(0)" ::: "memory");
        } else {
            XB_SPIN(xb_ld(&bar[XB_XGEN(b.x)]) == gen, bar);
            __builtin_amdgcn_fence(__ATOMIC_ACQUIRE, "agent");
            asm volatile("s_waitcnt vmcnt(0)" ::: "memory");
        }
    }
    __syncthreads();
}

constexpr int NWAVES = 8;
constexpr int M = 32768, D = 1024, SEQ = 4096, NPROJ = 2048, NQ = 2048, PLED = 256, NEXP = 16384;
constexpr float EPS = 1e-6f;
#ifndef MK_PER_PHASE
#define MK_PER_PHASE 0
#endif
#ifndef PROBE_REP
#define PROBE_REP 0
#endif
#define REPS(k) ((PROBE_REP == (k)) ? 2 : 1)
constexpr int NPHASES = 10;

constexpr size_t MiB = 1u << 20;
constexpr size_t WS_CTL = 0, CTL_ZERO_BYTES = 1 * MiB;
constexpr size_t WS_WIN = 2 * MiB, WS_WO = 6 * MiB, WS_WQ = 8 * MiB, WS_WG = 12 * MiB, WS_WP = 14 * MiB, WS_KEYS = 14 * MiB + 512 * 1024;
constexpr size_t WS_WF = 15 * MiB;
constexpr size_t WS_RSX = 17 * MiB, WS_RS2 = 17 * MiB + 512 * 1024, WS_RS1 = 18 * MiB, WS_RS3 = 20 * MiB;
constexpr size_t WS_SU = 22 * MiB, WS_SV = 22 * MiB + 65536;
constexpr size_t WS_U = 24 * MiB, WS_V = 56 * MiB;
constexpr size_t WS_XB = 88 * MiB;
constexpr size_t WS_PROJ = 152 * MiB;
constexpr size_t WS_MIX = 280 * MiB;
constexpr size_t WS_HB = 344 * MiB;
constexpr size_t WS_EIDX = 408 * MiB, WS_GATE = 424 * MiB;
constexpr size_t WS_PB = 440 * MiB;
constexpr size_t WS_END = 456 * MiB;
constexpr int CW_BAR = 4096;
static_assert((CW_BAR + XCD_BAR_WORDS) * 4 <= (int)CTL_ZERO_BYTES, "CTL words inside the memset region");

constexpr int RING_BYTES = 131072;
constexpr int LDSCTL_OFF = RING_BYTES, MISC_OFF = LDSCTL_OFF + 320;
constexpr int LDS_BYTES = 147456;

typedef float f32x16 __attribute__((ext_vector_type(16)));
typedef _Float16 h2_t __attribute__((ext_vector_type(2)));
typedef float f32x2 __attribute__((ext_vector_type(2)));
typedef int i32x4 __attribute__((ext_vector_type(4)));
typedef unsigned v2u __attribute__((ext_vector_type(2)));

__device__ __forceinline__ float wave_sum(float v) {
#pragma unroll
    for (int o = 1; o < 64; o <<= 1) v += __shfl_xor(v, o);
    return v;
}
__device__ __forceinline__ float bf_lo(unsigned w) { return __uint_as_float(w << 16); }
__device__ __forceinline__ float bf_hi(unsigned w) { return __uint_as_float(w & 0xffff0000u); }
__device__ __forceinline__ unsigned pkh(float lo, float hi) { f32x2 v = {lo, hi}; h2_t h = __builtin_convertvector(v, h2_t); return __builtin_bit_cast(unsigned, h); }

struct EpiBf16Row {
    static constexpr bool PERM = true, AFTER_DRAIN = false;
    pg8::bf16_t* O; int ldc; const float* rowss;
    __device__ __forceinline__ void operator()(const pg8::f32x4 (&acc)[2][2][4][2], const pg8::Unit& u, int wr, int wc, int fr, int fq) const {
        const int row0 = u.pm * 256 + wr * 64 + fr, col0 = u.pn * 256 + wc * 32 + 8 * fq;
#pragma unroll
        for (int ai = 0; ai < 2; ++ai)
#pragma unroll
            for (int m = 0; m < 4; ++m) {
                const int row = row0 + ai * 128 + m * 16;
                const float sc = rowss ? __builtin_amdgcn_rsqf(rowss[row] * (1.0f / 1024.0f) + EPS) : 1.0f;
                pg8::bf16_t* rowp = O + (size_t)row * ldc + col0;
#pragma unroll
                for (int bj = 0; bj < 2; ++bj) {
                    const pg8::f32x4 v0 = acc[ai][bj][m][0] * sc, v1 = acc[ai][bj][m][1] * sc;
                    pg8::u32x4 w; w.x = pg8::cvt_pk_bf16(v0[0], v0[1]); w.y = pg8::cvt_pk_bf16(v0[2], v0[3]); w.z = pg8::cvt_pk_bf16(v1[0], v1[1]); w.w = pg8::cvt_pk_bf16(v1[2], v1[3]);
                    *(pg8::u32x4*)(rowp + bj * 128) = w;
                }
            }
    }
};
struct EpiH1 {
    static constexpr bool PERM = true, AFTER_DRAIN = false;
    const float* X; pg8::bf16_t* HB; float* RS;
    __device__ __forceinline__ void operator()(const pg8::f32x4 (&acc)[2][2][4][2], const pg8::Unit& u, int wr, int wc, int fr, int fq) const {
        const int row0 = u.pm * 256 + wr * 64 + fr, col0 = u.pn * 256 + wc * 32 + 8 * fq;
#pragma unroll
        for (int ai = 0; ai < 2; ++ai)
#pragma unroll
            for (int m = 0; m < 4; ++m) {
                const int row = row0 + ai * 128 + m * 16; float s = 0.f;
#pragma unroll
                for (int bj = 0; bj < 2; ++bj) {
                    const size_t off = (size_t)row * 1024 + col0 + bj * 128;
                    const pg8::f32x4 x0 = *(const pg8::f32x4*)(X + off), x1 = *(const pg8::f32x4*)(X + off + 4);
                    const pg8::f32x4 v0 = acc[ai][bj][m][0] + x0, v1 = acc[ai][bj][m][1] + x1;
                    pg8::u32x4 w; w.x = pg8::cvt_pk_bf16(v0[0], v0[1]); w.y = pg8::cvt_pk_bf16(v0[2], v0[3]); w.z = pg8::cvt_pk_bf16(v1[0], v1[1]); w.w = pg8::cvt_pk_bf16(v1[2], v1[3]);
                    *(pg8::u32x4*)(HB + off) = w;
                    s += (v0[0] * v0[0] + v0[1] * v0[1]) + (v0[2] * v0[2] + v0[3] * v0[3]) + (v1[0] * v1[0] + v1[1] * v1[1]) + (v1[2] * v1[2] + v1[3] * v1[3]);
                }
                s += __shfl_xor(s, 16); s += __shfl_xor(s, 32);
                if (fq == 0) RS[(size_t)row * 16 + u.pn * 4 + wc] = s;
            }
    }
};
struct EpiGate {
    static constexpr bool PERM = true, AFTER_DRAIN = false;
    float* OUT; const pg8::bf16_t* HB; const pg8::bf16_t* PL; const float* RS2; float* RS3;
    __device__ __forceinline__ void operator()(const pg8::f32x4 (&acc)[2][2][4][2], const pg8::Unit& u, int wr, int wc, int fr, int fq) const {
        const int row0 = u.pm * 256 + wr * 64 + fr, col0 = u.pn * 256 + wc * 32 + 8 * fq;
#pragma unroll
        for (int ai = 0; ai < 2; ++ai)
#pragma unroll
            for (int m = 0; m < 4; ++m) {
                const int row = row0 + ai * 128 + m * 16; float s = 0.f;
                const float rstd = __builtin_amdgcn_rsqf(RS2[row] * (1.0f / 1024.0f) + EPS);
#pragma unroll
                for (int bj = 0; bj < 2; ++bj) {
                    const size_t off = (size_t)row * 1024 + col0 + bj * 128;
                    const pg8::u32x4 w = *(const pg8::u32x4*)(PL + off), hw = *(const pg8::u32x4*)(HB + off);
                    const pg8::f32x4 h0 = {bf_lo(hw.x), bf_hi(hw.x), bf_lo(hw.y), bf_hi(hw.y)}, h1 = {bf_lo(hw.z), bf_hi(hw.z), bf_lo(hw.w), bf_hi(hw.w)};
                    const pg8::f32x4 a0 = acc[ai][bj][m][0] * rstd, a1 = acc[ai][bj][m][1] * rstd;
                    pg8::f32x4 g0, g1;
#pragma unroll
                    for (int e = 0; e < 4; ++e) { g0[e] = 1.0f / (1.0f + __expf(-a0[e])); g1[e] = 1.0f / (1.0f + __expf(-a1[e])); }
                    const pg8::f32x4 p0 = {bf_lo(w.x), bf_hi(w.x), bf_lo(w.y), bf_hi(w.y)}, p1 = {bf_lo(w.z), bf_hi(w.z), bf_lo(w.w), bf_hi(w.w)};
                    const pg8::f32x4 v0 = h0 + g0 * p0, v1 = h1 + g1 * p1;
                    *(pg8::f32x4*)(OUT + off) = v0; *(pg8::f32x4*)(OUT + off + 4) = v1;
                    s += (v0[0] * v0[0] + v0[1] * v0[1]) + (v0[2] * v0[2] + v0[3] * v0[3]) + (v1[0] * v1[0] + v1[1] * v1[1]) + (v1[2] * v1[2] + v1[3] * v1[3]);
                }
                s += __shfl_xor(s, 16); s += __shfl_xor(s, 32);
                if (fq == 0) RS3[(size_t)row * 16 + u.pn * 4 + wc] = s;
            }
    }
};

__device__ __forceinline__ void p0_transpose_item(const float* W, int ldn, const float* gk, int K, bf16* WT, int row_off, int nblk, LAS float* scr, int item, int lane) {
    const int kb = item / nblk, nb = item % nblk, k0 = 64 * kb, n0 = 32 * nb;
#pragma unroll 8
    for (int i = 0; i < 32; ++i) { const int kk = 2 * i + (lane >> 5); float v = W[(size_t)(k0 + kk) * ldn + n0 + (lane & 31)]; if (gk) v *= gk[k0 + kk]; scr[kk * 33 + (lane & 31)] = v; }
    LDS_WAIT(); asm volatile("" ::: "memory");
    const int c = lane & 7;
#pragma unroll
    for (int j = 0; j < 4; ++j) { const int n = (lane >> 3) + 8 * j; const LAS float* s = scr + (8 * c) * 33 + n;
        v4u o; o.x = pk2(s[0 * 33], s[1 * 33]); o.y = pk2(s[2 * 33], s[3 * 33]); o.z = pk2(s[4 * 33], s[5 * 33]); o.w = pk2(s[6 * 33], s[7 * 33]);
        *(GAS v4u*)(WT + (size_t)(row_off + n0 + n) * K + k0 + 8 * c) = o; }
    LDS_WAIT(); asm volatile("" ::: "memory");
}

struct Ptrs {
    const float *x, *p, *g_mix, *w_in, *conv_w, *pool_w, *pool_scale, *w_o, *g_ffn, *w_q, *sub_keys, *eu, *ev, *g_ple, *w_gate, *w_proj, *g_final;
    float* out; unsigned char* ws;
};

__device__ __forceinline__ void p0a_phase(const Ptrs& P, LAS unsigned char* lds, int vcu, int G, int tid, int wave, int lane) {
    const int gw = vcu * NWAVES + wave, NGW = G * NWAVES;
    const int gt = vcu * (NWAVES * 64) + tid, NGT = G * NWAVES * 64;
    { float* Wf = (float*)(P.ws + WS_WF);
      for (int tk = gw; tk < 2048; tk += NGW) {
          const int k4 = (tk >> 3) * 4, j = tk & 7, g = j >> 1, np = j * 64 + lane, d = np & 127;
          const float* wi = P.w_in + (size_t)k4 * 2048 + 1536 + g * 128; const float* pw = P.pool_w + (size_t)g * 128 * 128 + d;
          float a0 = 0.f, a1 = 0.f, a2 = 0.f, a3 = 0.f;
          for (int c0 = 0; c0 < 128; c0 += 16) {
              float pv[16], w0[16], w1[16], w2[16], w3[16];
#pragma unroll
              for (int c = 0; c < 16; ++c) { pv[c] = pw[(size_t)(c0 + c) * 128]; w0[c] = wi[c0 + c]; w1[c] = wi[2048 + c0 + c]; w2[c] = wi[4096 + c0 + c]; w3[c] = wi[6144 + c0 + c]; }
#pragma unroll
              for (int c = 0; c < 16; ++c) { a0 += w0[c] * pv[c]; a1 += w1[c] * pv[c]; a2 += w2[c] * pv[c]; a3 += w3[c] * pv[c]; }
          }
          const float sc = P.pool_scale[np];
          Wf[(size_t)k4 * 512 + np] = a0 * sc; Wf[(size_t)(k4 + 1) * 512 + np] = a1 * sc; Wf[(size_t)(k4 + 2) * 512 + np] = a2 * sc; Wf[(size_t)(k4 + 3) * 512 + np] = a3 * sc;
      } }
    { LAS float* scr = (LAS float*)(lds + wave * 16384);
      constexpr int I_WO = 16 * 32, I_WQ = 16 * 64, I_WG = 16 * 32, I_WP = 4 * 32, I_WINA = 16 * 48;
      constexpr int NITEMS = I_WO + I_WQ + I_WG + I_WP + I_WINA;
      for (int it = gw; it < NITEMS; it += NGW) {
          int r = it;
          if (r < I_WO) { p0_transpose_item(P.w_o, 1024, nullptr, 1024, (bf16*)(P.ws + WS_WO), 0, 32, scr, r, lane); continue; } r -= I_WO;
          if (r < I_WQ) { p0_transpose_item(P.w_q, 2048, P.g_ffn, 1024, (bf16*)(P.ws + WS_WQ), 0, 64, scr, r, lane); continue; } r -= I_WQ;
          if (r < I_WG) { p0_transpose_item(P.w_gate, 1024, P.g_ple, 1024, (bf16*)(P.ws + WS_WG), 0, 32, scr, r, lane); continue; } r -= I_WG;
          if (r < I_WP) { p0_transpose_item(P.w_proj, 1024, nullptr, 256, (bf16*)(P.ws + WS_WP), 0, 32, scr, r, lane); continue; } r -= I_WP;
          p0_transpose_item(P.w_in, 2048, P.g_mix, 1024, (bf16*)(P.ws + WS_WIN), 0, 48, scr, r, lane);
      } }
    { for (int r0 = 4 * gw; r0 < 2 * NEXP; r0 += 4 * NGW) {
          const int tb = r0 >> 14;
          f32x4 a[4][4]; float q[4];
#pragma unroll
          for (int rr = 0; rr < 4; ++rr) { const int e = (r0 + rr) & (NEXP - 1);
              const GAS f32x4* src = (const GAS f32x4*)((tb ? P.ev : P.eu) + (size_t)e * 1024);
#pragma unroll
              for (int j = 0; j < 4; ++j) a[rr][j] = tb ? src[lane + 64 * j] : src[4 * lane + j]; }
          if (!tb) { const GAS f32x4* gf = (const GAS f32x4*)P.g_ffn + 4 * lane;
#pragma unroll
              for (int j = 0; j < 4; ++j) { const f32x4 g = gf[j];
#pragma unroll
                  for (int rr = 0; rr < 4; ++rr) a[rr][j] = a[rr][j] * g; } }
#pragma unroll
          for (int rr = 0; rr < 4; ++rr) { q[rr] = 0.f;
#pragma unroll
              for (int j = 0; j < 4; ++j) q[rr] += (a[rr][j].x * a[rr][j].x + a[rr][j].y * a[rr][j].y) + (a[rr][j].z * a[rr][j].z + a[rr][j].w * a[rr][j].w); }
#pragma unroll
          for (int o = 1; o < 64; o <<= 1) { q[0] += __shfl_xor(q[0], o); q[1] += __shfl_xor(q[1], o); q[2] += __shfl_xor(q[2], o); q[3] += __shfl_xor(q[3], o); }
#pragma unroll
          for (int rr = 0; rr < 4; ++rr) { const int e = (r0 + rr) & (NEXP - 1);
              const float rms = sqrtf(q[rr] * (1.0f / 1024.0f)); const float sc = rms > 0.f ? 2.0f / rms : 0.f;
              unsigned w0 = 0u, w1 = 0u;
              w0 = __builtin_amdgcn_cvt_scalef32_pk_fp4_f32(w0, a[rr][0].x * sc, a[rr][0].y * sc, 1.0f, 0); w0 = __builtin_amdgcn_cvt_scalef32_pk_fp4_f32(w0, a[rr][0].z * sc, a[rr][0].w * sc, 1.0f, 1);
              w0 = __builtin_amdgcn_cvt_scalef32_pk_fp4_f32(w0, a[rr][1].x * sc, a[rr][1].y * sc, 1.0f, 2); w0 = __builtin_amdgcn_cvt_scalef32_pk_fp4_f32(w0, a[rr][1].z * sc, a[rr][1].w * sc, 1.0f, 3);
              w1 = __builtin_amdgcn_cvt_scalef32_pk_fp4_f32(w1, a[rr][2].x * sc, a[rr][2].y * sc, 1.0f, 0); w1 = __builtin_amdgcn_cvt_scalef32_pk_fp4_f32(w1, a[rr][2].z * sc, a[rr][2].w * sc, 1.0f, 1);
              w1 = __builtin_amdgcn_cvt_scalef32_pk_fp4_f32(w1, a[rr][3].x * sc, a[rr][3].y * sc, 1.0f, 2); w1 = __builtin_amdgcn_cvt_scalef32_pk_fp4_f32(w1, a[rr][3].z * sc, a[rr][3].w * sc, 1.0f, 3);
              ((GAS v2u*)(P.ws + (tb ? WS_V : WS_U)))[(size_t)e * 64 + lane] = (v2u){w0, w1};
              if (lane == 0) ((float*)(P.ws + (tb ? WS_SV : WS_SU)))[e] = rms * 0.5f; }
      } }
    { const GAS f32x4* sp = (const GAS f32x4*)P.p; GAS v4u* dp = (GAS v4u*)(P.ws + WS_PB);
      for (int i0 = gt; i0 < M * PLED / 8; i0 += 4 * NGT) {
          f32x4 a[4], b[4];
#pragma unroll
          for (int q = 0; q < 4; ++q) { const int i = i0 + q * NGT; if (i < M * PLED / 8) { a[q] = sp[2 * (size_t)i]; b[q] = sp[2 * (size_t)i + 1]; } }
#pragma unroll
          for (int q = 0; q < 4; ++q) { const int i = i0 + q * NGT; if (i < M * PLED / 8) { v4u o; o.x = pk2(a[q].x, a[q].y); o.y = pk2(a[q].z, a[q].w); o.z = pk2(b[q].x, b[q].y); o.w = pk2(b[q].z, b[q].w); dp[i] = o; } }
      }
      const GAS f32x4* sk = (const GAS f32x4*)P.sub_keys; GAS v4u* dk = (GAS v4u*)(P.ws + WS_KEYS);
      for (int i = gt; i < 16 * 128 * 128 / 8; i += NGT) { const f32x4 a = sk[2 * (size_t)i], b = sk[2 * (size_t)i + 1]; v4u o; o.x = pk2(a.x, a.y); o.y = pk2(a.z, a.w); o.z = pk2(b.x, b.y); o.w = pk2(b.z, b.w); dk[i] = o; } }
    { float* RSX = (float*)(P.ws + WS_RSX); bf16* XB = (bf16*)(P.ws + WS_XB);
      for (int m0 = 4 * gw; m0 < M; m0 += 4 * NGW) {
          f32x4 v[4][4]; float sq[4];
#pragma unroll
          for (int r = 0; r < 4; ++r) { const GAS f32x4* xr = (const GAS f32x4*)(P.x + (size_t)(m0 + r) * D) + lane;
#pragma unroll
              for (int j = 0; j < 4; ++j) v[r][j] = xr[64 * j]; }
#pragma unroll
          for (int r = 0; r < 4; ++r) { sq[r] = 0.f;
#pragma unroll
              for (int j = 0; j < 4; ++j) sq[r] += (v[r][j].x * v[r][j].x + v[r][j].y * v[r][j].y) + (v[r][j].z * v[r][j].z + v[r][j].w * v[r][j].w); }
#pragma unroll
          for (int o = 1; o < 64; o <<= 1) {
#pragma unroll
              for (int r = 0; r < 4; ++r) sq[r] += __shfl_xor(sq[r], o); }
#pragma unroll
          for (int r = 0; r < 4; ++r) { if (lane == 0) RSX[m0 + r] = sq[r];
              GAS unsigned long long* o8 = (GAS unsigned long long*)(XB + (size_t)(m0 + r) * D) + lane;
#pragma unroll
              for (int j = 0; j < 4; ++j) o8[64 * j] = (unsigned long long)pk2(v[r][j].x, v[r][j].y) | ((unsigned long long)pk2(v[r][j].z, v[r][j].w) << 32); }
      } }
}
__device__ __forceinline__ void p0b_phase(const Ptrs& P, LAS unsigned char* lds, int vcu, int G, int wave, int lane) {
    const int gw = vcu * NWAVES + wave, NGW = G * NWAVES; LAS float* scr = (LAS float*)(lds + wave * 16384);
    for (int it = gw; it < 16 * 16; it += NGW) p0_transpose_item((const float*)(P.ws + WS_WF), 512, P.g_mix, 1024, (bf16*)(P.ws + WS_WIN), 1536, 16, scr, it, lane);
}

template <int HALF>
__device__ __forceinline__ void pool_chunk(const unsigned* col, unsigned* mx, int t0, int s0) {
    constexpr int TC = 32, NV = TC + 2 * HALF;
    float v0[NV], v1[NV];
#pragma unroll
    for (int i = 0; i < NV; ++i) {
        const int s = s0 - HALF + i; const bool ok = (s >= 0) && (s < SEQ);
        const unsigned w = col[(size_t)(ok ? (t0 - HALF + i) : t0) * 1024];
        v0[i] = ok ? bf_lo(w) : 0.f; v1[i] = ok ? bf_hi(w) : 0.f;
    }
    float S0 = 0.f, S1 = 0.f;
#pragma unroll
    for (int j = 0; j < 2 * HALF; ++j) { S0 += v0[j]; S1 += v1[j]; }
#pragma unroll
    for (int i = 0; i < TC; ++i) {
        const int s = s0 + i; const int lo = (s - HALF) > 0 ? (s - HALF) : 0, hi = (s + HALF) < SEQ ? (s + HALF) : SEQ;
        const float inv = 1.0f / (float)(hi - lo);
        mx[(size_t)(t0 + i) * 512] = pk2(S0 * inv - v0[i + HALF], S1 * inv - v1[i + HALF]);
        if (i + 1 < TC) { S0 += v0[i + 2 * HALF] - v0[i]; S1 += v1[i + 2 * HALF] - v1[i]; }
    }
}
__device__ __forceinline__ void p2_phase(const Ptrs& P, int vcu, int G, int tid, int wave) {
    const unsigned* PR = (const unsigned*)(P.ws + WS_PROJ);
    unsigned* MX = (unsigned*)(P.ws + WS_MIX);
    constexpr int TC = 32;
    for (int ck = vcu; ck < M / TC; ck += G) {
        const int t0 = ck * TC, s0 = t0 & (SEQ - 1);
        if (tid < 256) {
            const unsigned* col = PR + 768 + tid; unsigned* mx = MX + 256 + tid;
            if (wave == 0) pool_chunk<1>(col, mx, t0, s0); else if (wave == 1) pool_chunk<2>(col, mx, t0, s0); else if (wave == 2) pool_chunk<4>(col, mx, t0, s0); else pool_chunk<8>(col, mx, t0, s0);
        } else {
            const int cp = tid - 256;
            const unsigned* bcol = PR + cp; const unsigned* ccol = PR + 256 + cp; const unsigned* vcol = PR + 512 + cp;
            const float w00 = P.conv_w[2 * cp], w01 = P.conv_w[2 * cp + 1], w10 = P.conv_w[512 + 2 * cp], w11 = P.conv_w[512 + 2 * cp + 1], w20 = P.conv_w[1024 + 2 * cp], w21 = P.conv_w[1024 + 2 * cp + 1];
            float z0[TC + 2], z1[TC + 2]; unsigned bw[TC];
#pragma unroll
            for (int i = 0; i < TC + 2; ++i) {
                const int s = s0 - 1 + i; const bool ok = (s >= 0) && (s < SEQ); const size_t t = (size_t)(ok ? (t0 - 1 + i) : t0) * 1024;
                const unsigned c = ccol[t], v = vcol[t];
                z0[i] = ok ? bf_lo(c) * bf_lo(v) : 0.f; z1[i] = ok ? bf_hi(c) * bf_hi(v) : 0.f;
            }
#pragma unroll
            for (int i = 0; i < TC; ++i) bw[i] = bcol[(size_t)(t0 + i) * 1024];
#pragma unroll
            for (int i = 0; i < TC; ++i) {
                const float y0 = w00 * z0[i] + w10 * z0[i + 1] + w20 * z0[i + 2], y1 = w01 * z1[i] + w11 * z1[i + 1] + w21 * z1[i + 2];
                MX[(size_t)(t0 + i) * 512 + cp] = pk2(bf_lo(bw[i]) * y0, bf_hi(bw[i]) * y1);
            }
        }
    }
}

__device__ __forceinline__ float fmax_s(float a, float b) { float r; asm("v_max_f32_e32 %0, %1, %2" : "=v"(r) : "v"(a), "v"(b)); return r; }
__device__ __forceinline__ float fmin_s(float a, float b) { float r; asm("v_min_f32_e32 %0, %1, %2" : "=v"(r) : "v"(a), "v"(b)); return r; }
#define CE_DESC(a, b) do { const float _t = fmax_s(a, b); b = fmin_s(a, b); a = _t; } while (0)
#define CE_ASC(a, b)  do { const float _t = fmin_s(a, b); b = fmax_s(a, b); a = _t; } while (0)
__device__ __forceinline__ void sort16_desc(float* a) {
#pragma unroll
    for (int k = 2; k <= 16; k <<= 1)
#pragma unroll
        for (int j = k >> 1; j > 0; j >>= 1)
#pragma unroll
            for (int i = 0; i < 16; ++i) { const int l = i ^ j; if (l > i) { if ((i & k) == 0) CE_DESC(a[i], a[l]); else CE_ASC(a[i], a[l]); } }
}
__device__ __forceinline__ void merge16_desc(float* a) {
#pragma unroll
    for (int j = 8; j > 0; j >>= 1)
#pragma unroll
        for (int i = 0; i < 16; ++i) { const int l = i ^ j; if (l > i) CE_DESC(a[i], a[l]); }
}
__device__ __forceinline__ void top16_merge(float* a, const float* b) {
#pragma unroll
    for (int i = 0; i < 16; ++i) a[i] = fmax_s(a[i], b[15 - i]);
    merge16_desc(a);
}
__device__ __forceinline__ void top16_of_64(float* v) {
    sort16_desc(v); sort16_desc(v + 16); sort16_desc(v + 32); sort16_desc(v + 48);
    top16_merge(v, v + 16); top16_merge(v + 32, v + 48); top16_merge(v, v + 32);
}
__device__ __forceinline__ unsigned key_lookup(unsigned long long lo, unsigned long long hi, unsigned i) {
    const unsigned long long v = (i & 8u) ? hi : lo;
    return (unsigned)(v >> ((i & 7u) * 8u)) & 0x7fu;
}

constexpr int KROW = 272;
__device__ __forceinline__ void score_phase(const Ptrs& P, LAS unsigned char* lds, int bid, int G, int tid, int wave, int lane) {
    const bf16* Q = (const bf16*)(P.ws + WS_PROJ); const bf16* KEYS = (const bf16*)(P.ws + WS_KEYS); const float* RS1 = (const float*)(P.ws + WS_RS1);
    int* EIDX = (int*)(P.ws + WS_EIDX); float* GATE = (float*)(P.ws + WS_GATE);
    const int l31 = lane & 31, hi = lane >> 5;
    int cur_h = -1;
    for (int u = bid; u < (M / 256) * 8; u += G) {
        const int h = u & 7, tile = u >> 3;
        if (h != cur_h) {
            __syncthreads();
#pragma unroll
            for (int i = 0; i < 8; ++i) { const int q = tid + 512 * i, row = q >> 4, ch = q & 15;
                const v4u val = *(const GAS v4u*)(KEYS + ((size_t)(h * 256 + row)) * 128 + ch * 8);
                *(LAS v4u*)(lds + row * KROW + ch * 16) = val; }
            __syncthreads();
            cur_h = h;
        }
        const int tok = tile * 256 + wave * 32 + l31;
        float T0[16], T1[16];
#pragma unroll
        for (int p = 0; p < 2; ++p) {
            f32x16 acc[4];
#pragma unroll
            for (int kb = 0; kb < 4; ++kb)
#pragma unroll
                for (int r = 0; r < 16; ++r) acc[kb][r] = 0.f;
            const bf16* qp = Q + (size_t)tok * 2048 + h * 256 + p * 128 + hi * 8;
            bf16x8 bq[8];
#pragma unroll
            for (int ks = 0; ks < 8; ++ks) bq[ks] = *(const GAS bf16x8*)(qp + ks * 16);
#pragma unroll
            for (int ks = 0; ks < 8; ++ks)
#pragma unroll
                for (int kb = 0; kb < 4; ++kb) {
                    const bf16x8 ak = *(const LAS bf16x8*)(lds + (p * 128 + kb * 32 + l31) * KROW + (ks * 16 + hi * 8) * 2);
                    acc[kb] = __builtin_amdgcn_mfma_f32_32x32x16_bf16(ak, bq[ks], acc[kb], 0, 0, 0);
                }
            float v[64];
#pragma unroll
            for (int kb = 0; kb < 4; ++kb)
#pragma unroll
                for (int r = 0; r < 16; ++r) v[kb * 16 + r] = __uint_as_float((__float_as_uint(acc[kb][r]) & 0xffffff80u) | (unsigned)(kb * 32 + (r & 3) + 8 * (r >> 2)));
            top16_of_64(v);
            const unsigned hb = (unsigned)hi << 2;
#pragma unroll
            for (int i = 0; i < 16; ++i) v[i] = __uint_as_float(__float_as_uint(v[i]) | hb);
            float c[16];
#pragma unroll
            for (int i = 0; i < 16; ++i) c[i] = fmax_s(v[i], __shfl_xor(v[15 - i], 32));
            merge16_desc(c);
#pragma unroll
            for (int i = 0; i < 16; ++i) { if (p == 0) T0[i] = c[i]; else T1[i] = c[i]; }
        }
        float f0[16], f1[16];
        unsigned long long K0lo = 0ull, K0hi = 0ull, K1lo = 0ull, K1hi = 0ull;
#pragma unroll
        for (int b = 0; b < 8; ++b) {
            K0lo |= (unsigned long long)(__float_as_uint(T0[b]) & 0x7fu) << (8 * b); K0hi |= (unsigned long long)(__float_as_uint(T0[8 + b]) & 0x7fu) << (8 * b);
            K1lo |= (unsigned long long)(__float_as_uint(T1[b]) & 0x7fu) << (8 * b); K1hi |= (unsigned long long)(__float_as_uint(T1[8 + b]) & 0x7fu) << (8 * b);
        }
#pragma unroll
        for (int i = 0; i < 16; ++i) { f0[i] = __uint_as_float(__float_as_uint(T0[i]) & 0xffffff80u); f1[i] = __uint_as_float(__float_as_uint(T1[i]) & 0xffffff80u); }
        float cd[64]; int n = 0;
#pragma unroll
        for (int i = 0; i < 16; ++i)
#pragma unroll
            for (int j = 0; j < 16; ++j)
                if ((i + 1) * (j + 1) <= 16) { cd[n] = __uint_as_float((__float_as_uint(f0[i] + f1[j]) & 0xffffff00u) | (unsigned)(i * 16 + j)); ++n; }
#pragma unroll
        for (int q = 50; q < 64; ++q) cd[q] = __uint_as_float(0xff800000u);
        top16_of_64(cd);
        float rs = 0.f;
        { const GAS f32x4* rp = (const GAS f32x4*)(RS1 + (size_t)tok * 16);
#pragma unroll
          for (int i = 0; i < 4; ++i) { const f32x4 a = rp[i]; rs += (a.x + a.y) + (a.z + a.w); } }
        const float rstd = __builtin_amdgcn_rsqf(rs * (1.0f / 1024.0f) + EPS);
        int eidx[16]; float gt_[16]; float z0 = 0.f, sum = 0.f;
#pragma unroll
        for (int k = 0; k < 16; ++k) {
            const unsigned wb = __float_as_uint(cd[k]); const unsigned i = (wb >> 4) & 15u, j = wb & 15u;
            eidx[k] = (int)(key_lookup(K0lo, K0hi, i) * 128u + key_lookup(K1lo, K1hi, j));
            const float z = __uint_as_float(wb & 0xffffff00u) * rstd;
            if (k == 0) z0 = z;
            gt_[k] = __expf(z - z0); sum += gt_[k];
        }
        const float inv = 1.0f / sum;
        if (hi == 0) { GAS i32x4* ep = (GAS i32x4*)(EIDX + (size_t)tok * 128 + h * 16);
#pragma unroll
            for (int q = 0; q < 4; ++q) ep[q] = (i32x4){eidx[4 * q], eidx[4 * q + 1], eidx[4 * q + 2], eidx[4 * q + 3]};
        } else { GAS f32x4* gp = (GAS f32x4*)(GATE + (size_t)tok * 128 + h * 16);
#pragma unroll
            for (int q = 0; q < 4; ++q) gp[q] = (f32x4){gt_[4 * q] * inv, gt_[4 * q + 1] * inv, gt_[4 * q + 2] * inv, gt_[4 * q + 3] * inv};
        }
    }
}

__device__ __forceinline__ float gelu_tanh(float x) {
    const float y = 1.5957691216057308f * (x + 0.044715f * x * x * x);
    return x / (1.0f + __expf(-y));
}
__device__ __forceinline__ void axpy16(f32x2* o, float c, const v2u& v) {
    const unsigned w0 = v.x, w1 = v.y; const f32x2 c2 = {c, c};
    o[0] = __builtin_amdgcn_cvt_scalef32_pk_f32_fp4(w0, 1.0f, 0) * c2 + o[0]; o[1] = __builtin_amdgcn_cvt_scalef32_pk_f32_fp4(w0, 1.0f, 1) * c2 + o[1];
    o[2] = __builtin_amdgcn_cvt_scalef32_pk_f32_fp4(w0, 1.0f, 2) * c2 + o[2]; o[3] = __builtin_amdgcn_cvt_scalef32_pk_f32_fp4(w0, 1.0f, 3) * c2 + o[3];
    o[4] = __builtin_amdgcn_cvt_scalef32_pk_f32_fp4(w1, 1.0f, 0) * c2 + o[4]; o[5] = __builtin_amdgcn_cvt_scalef32_pk_f32_fp4(w1, 1.0f, 1) * c2 + o[5];
    o[6] = __builtin_amdgcn_cvt_scalef32_pk_f32_fp4(w1, 1.0f, 2) * c2 + o[6]; o[7] = __builtin_amdgcn_cvt_scalef32_pk_f32_fp4(w1, 1.0f, 3) * c2 + o[7];
}
typedef int v8i __attribute__((ext_vector_type(8)));
__device__ __forceinline__ void peer_phase(const Ptrs& P, LAS unsigned char* lds, int vcu, int G, int wave, int lane) {
    const int gw = vcu * NWAVES + wave, NGW = G * NWAVES;
    bf16* HB = (bf16*)(P.ws + WS_HB); float* RS2 = (float*)(P.ws + WS_RS2);
    const int* EIDX = (const int*)(P.ws + WS_EIDX); const float* GATE = (const float*)(P.ws + WS_GATE);
    const unsigned char* U4 = P.ws + WS_U; const GAS v2u* V8 = (const GAS v2u*)(P.ws + WS_V) + lane;
    const float* SU = (const float*)(P.ws + WS_SU); const float* SV = (const float*)(P.ws + WS_SV);
    LAS unsigned char* xl = lds + wave * 1024;
    const int li = lane & 15, lq = lane >> 4;
    const int kl = 4 * lq + (li & 3);
    int t = gw; if (t >= M) return;
    int ei0 = EIDX[(size_t)t * 128 + lane], ei1 = EIDX[(size_t)t * 128 + 64 + lane];
    float gg0 = GATE[(size_t)t * 128 + lane], gg1 = GATE[(size_t)t * 128 + 64 + lane];
    v2u hrow[4];
    { const GAS v2u* hp = (const GAS v2u*)(HB + (size_t)t * 1024) + lane;
#pragma unroll
      for (int j = 0; j < 4; ++j) hrow[j] = hp[64 * j]; }
    v4u uw[8];
    { const int e = __shfl(ei0, li); const GAS v4u* up = (const GAS v4u*)(U4 + (size_t)e * 512 + 16 * lq);
#pragma unroll
      for (int sI = 0; sI < 8; ++sI) uw[sI] = up[4 * sI]; }
    for (; t < M; t += NGW) {
        const int tn = (t + NGW < M) ? t + NGW : t;
        f32x2 x[8]; float ss = 0.f;
#pragma unroll
        for (int j = 0; j < 4; ++j) { const unsigned wa = hrow[j].x, wb = hrow[j].y; x[2 * j] = (f32x2){bf_lo(wa), bf_hi(wa)}; x[2 * j + 1] = (f32x2){bf_lo(wb), bf_hi(wb)};
            ss += (x[2 * j].x * x[2 * j].x + x[2 * j].y * x[2 * j].y) + (x[2 * j + 1].x * x[2 * j + 1].x + x[2 * j + 1].y * x[2 * j + 1].y); }
        ss = wave_sum(ss);
        const float rstd = __builtin_amdgcn_rsqf(ss * (1.0f / 1024.0f) + EPS);
        { const float sx = 16.0f * rstd;
#pragma unroll
          for (int j = 0; j < 4; ++j) { int w = __builtin_amdgcn_cvt_pk_fp8_f32(x[2 * j].x * sx, x[2 * j].y * sx, 0, false); w = __builtin_amdgcn_cvt_pk_fp8_f32(x[2 * j + 1].x * sx, x[2 * j + 1].y * sx, w, true);
              { const int n = 4 * lane + 256 * j, sN = n >> 7, nn = n & 127;
                const int hN = nn >> 6, qN = (nn & 63) >> 4, jN = nn & 15;
                const int ad = 128 * sN + 32 * qN + 16 * hN + jN;
                *(LAS unsigned*)(xl + ad) = (unsigned)w; } }
          asm volatile("s_waitcnt lgkmcnt(0)" ::: "memory"); }
        v8i xb[8];
#pragma unroll
        for (int sI = 0; sI < 8; ++sI) { const v4u b0 = *(const LAS v4u*)(xl + 128 * sI + 32 * lq), b1 = *(const LAS v4u*)(xl + 128 * sI + 32 * lq + 16);
            xb[sI] = (v8i){(int)b0.x, (int)b0.y, (int)b0.z, (int)b0.w, (int)b1.x, (int)b1.y, (int)b1.z, (int)b1.w}; }
        const int nei0 = EIDX[(size_t)tn * 128 + lane], nei1 = EIDX[(size_t)tn * 128 + 64 + lane];
        const float ngg0 = GATE[(size_t)tn * 128 + lane], ngg1 = GATE[(size_t)tn * 128 + 64 + lane];
        f32x2 out[8];
#pragma unroll
        for (int i = 0; i < 8; ++i) out[i] = (f32x2){0.f, 0.f};
        for (int hq = 0; hq < 8 * REPS(7); ++hq) { const int hh = hq & 7;
            const int ereg = hh < 4 ? ei0 : ei1; const float greg = hh < 4 ? gg0 : gg1; const int lb = (hh & 3) * 16;
            const int el = __shfl(ereg, lb + kl);
            const float su = SU[el], sv = SV[el];
            __builtin_amdgcn_sched_barrier(0);
            v2u vw[16];
#pragma unroll
            for (int k = 0; k < 16; ++k) { const int e = __builtin_amdgcn_readlane(ereg, lb + k); vw[k] = V8[(size_t)e * 64]; }
            __builtin_amdgcn_sched_barrier(0);
            f32x4 acc = {0.f, 0.f, 0.f, 0.f};
#pragma unroll
            for (int sI = 0; sI < 8; ++sI) { const v8i av = {(int)uw[sI].x, (int)uw[sI].y, (int)uw[sI].z, (int)uw[sI].w, 0, 0, 0, 0};
                acc = __builtin_amdgcn_mfma_scale_f32_16x16x128_f8f6f4(av, xb[sI], acc, 4  , 0  , 0, 0x7F7F7F7F, 0, 0x7F7F7F7F); }
            const int rsel = li & 3;
            const float d = rsel == 0 ? acc[0] : (rsel == 1 ? acc[1] : (rsel == 2 ? acc[2] : acc[3]));
            const float gk = __shfl(greg, lb + kl);
            const float cf = gk * gelu_tanh(d * su * (1.0f / 16.0f)) * sv;
            __builtin_amdgcn_sched_barrier(0);
            { const bool lasth = (hq == 8 * REPS(7) - 1); const int hn = (hh + 1) & 7;
              const int nreg = lasth ? nei0 : (hn < 4 ? ei0 : ei1); const int nlb = (hn & 3) * 16;
              const int e = __shfl(nreg, nlb + li); const GAS v4u* up = (const GAS v4u*)(U4 + (size_t)e * 512 + 16 * lq);
#pragma unroll
              for (int sI = 0; sI < 8; ++sI) uw[sI] = up[4 * sI]; }
            __builtin_amdgcn_sched_barrier(0);
#pragma unroll
            for (int k = 0; k < 16; ++k) {
                const float ck = __uint_as_float(__builtin_amdgcn_readlane(__float_as_uint(cf), 16 * (k >> 2) + (k & 3)));
                if (REPS(9) == 2) { v2u c2 = vw[k]; asm volatile("" : "+v"(c2)); axpy16(out, 0.5f * ck, vw[k]); axpy16(out, 0.5f * ck, c2); }
                else axpy16(out, ck, vw[k]);
            }
        }
        if (REPS(7) == 2) {
#pragma unroll
            for (int i = 0; i < 8; ++i) out[i] = out[i] * 0.5f; }
        float s2 = 0.f;
        GAS v2u* hb = (GAS v2u*)(HB + (size_t)t * 1024) + lane;
#pragma unroll
        for (int j = 0; j < 4; ++j) { const f32x2 o0 = x[2 * j] + out[2 * j], o1 = x[2 * j + 1] + out[2 * j + 1];
            hb[64 * j] = (v2u){pk2(o0.x, o0.y), pk2(o1.x, o1.y)};
            s2 += (o0.x * o0.x + o0.y * o0.y) + (o1.x * o1.x + o1.y * o1.y); }
        s2 = wave_sum(s2);
        if (lane == 0) RS2[t] = s2;
        { const GAS v2u* hn = (const GAS v2u*)(HB + (size_t)tn * 1024) + lane;
#pragma unroll
          for (int j = 0; j < 4; ++j) hrow[j] = hn[64 * j]; }
        ei0 = nei0; ei1 = nei1; gg0 = ngg0; gg1 = ngg1;
    }
}

__device__ __forceinline__ void final_phase(const Ptrs& P, int vcu, int G, int wave, int lane) {
    const int gw = vcu * NWAVES + wave, NGW = G * NWAVES; const float* RS3 = (const float*)(P.ws + WS_RS3);
    const GAS f32x4* gf = (const GAS f32x4*)P.g_final + lane;
    f32x4 g[4];
#pragma unroll
    for (int j = 0; j < 4; ++j) g[j] = gf[64 * j];
    for (int m = gw; m < M; m += NGW) {
        GAS f32x4* xr = (GAS f32x4*)(P.out + (size_t)m * D) + lane;
        float rs = 0.f; { const GAS f32x4* rp = (const GAS f32x4*)(RS3 + (size_t)m * 16);
#pragma unroll
            for (int i = 0; i < 4; ++i) { const f32x4 a = rp[i]; rs += (a.x + a.y) + (a.z + a.w); } }
        const float rstd = __builtin_amdgcn_rsqf(rs * (1.0f / 1024.0f) + EPS);
#pragma unroll
        for (int j = 0; j < 4; ++j) { const f32x4 v = xr[64 * j]; xr[64 * j] = v * rstd * g[j]; }
    }
}

struct Args { const float* in[17]; float* out; unsigned char* ws; int ph_lo, ph_hi; };
#ifndef PG8_SP2
#define PG8_SP2 true
#endif
#ifndef PG8_ALIGN
#define PG8_ALIGN true
#endif
__global__ void __launch_bounds__(NWAVES * 64, 2) mega_fwd(Args args) {
    extern __shared__ __attribute__((aligned(16))) unsigned char lds_raw[];
    LAS unsigned char* lds = (LAS unsigned char*)lds_raw;
    volatile LAS unsigned* MISC = (volatile LAS unsigned*)(lds + MISC_OFF);
    const int tid = threadIdx.x, lane = tid & 63, wave = __builtin_amdgcn_readfirstlane(tid >> 6);
    const int G = gridDim.x, bx = blockIdx.x; const int vcu = (G % 8 == 0) ? (bx % 8) * (G / 8) + bx / 8 : bx;
    Ptrs P;
    P.x = args.in[0]; P.p = args.in[1]; P.g_mix = args.in[2]; P.w_in = args.in[3]; P.conv_w = args.in[4]; P.pool_w = args.in[5]; P.pool_scale = args.in[6]; P.w_o = args.in[7];
    P.g_ffn = args.in[8]; P.w_q = args.in[9]; P.sub_keys = args.in[10]; P.eu = args.in[11]; P.ev = args.in[12]; P.g_ple = args.in[13]; P.w_gate = args.in[14]; P.w_proj = args.in[15]; P.g_final = args.in[16];
    P.out = args.out; P.ws = args.ws;
    gu32* ctl = (gu32*)(P.ws + WS_CTL);
    for (int u = tid; u < (LDS_BYTES - LDSCTL_OFF) / 4; u += NWAVES * 64) ((LAS unsigned*)(lds + LDSCTL_OFF))[u] = 0u;
    __syncthreads();
    XcdBarrier bar; bar.bar = (unsigned*)(ctl + CW_BAR); bar.x = 0; bar.st = nullptr;
    if (!MK_PER_PHASE) bar = xcd_barrier_post((unsigned*)(ctl + CW_BAR), MISC + 8);
    const int lo = args.ph_lo, hi = args.ph_hi;
#define IN(k) (lo <= (k) && (k) < hi)
#define SEAM(k) do { if (IN(k) && IN((k) + 1)) xcd_barrier(bar); } while (0)
    pg8::bf16_t* const WIN = (pg8::bf16_t*)(P.ws + WS_WIN); pg8::bf16_t* const WO = (pg8::bf16_t*)(P.ws + WS_WO); pg8::bf16_t* const WQ = (pg8::bf16_t*)(P.ws + WS_WQ);
    pg8::bf16_t* const WG = (pg8::bf16_t*)(P.ws + WS_WG); pg8::bf16_t* const WP = (pg8::bf16_t*)(P.ws + WS_WP);
    pg8::bf16_t* const XB = (pg8::bf16_t*)(P.ws + WS_XB); pg8::bf16_t* const PL = XB; pg8::bf16_t* const PROJ = (pg8::bf16_t*)(P.ws + WS_PROJ); pg8::bf16_t* const QB = PROJ;
    pg8::bf16_t* const MIX = (pg8::bf16_t*)(P.ws + WS_MIX); pg8::bf16_t* const HB = (pg8::bf16_t*)(P.ws + WS_HB); pg8::bf16_t* const PB = (pg8::bf16_t*)(P.ws + WS_PB);

    if (IN(0)) { for (int rep = 0; rep < REPS(1); ++rep) { p0a_phase(P, lds, vcu, G, tid, wave, lane); SEAM(0); } }
    if (IN(1)) { p0b_phase(P, lds, vcu, G, wave, lane); SEAM(1); }
    if (IN(2)) {
        pg8::Gemm g{XB, WIN, M, NPROJ, D}; pg8::StaticOrder S; S.init(M, NPROJ, G, bx);
        EpiBf16Row E{PROJ, NPROJ, (const float*)(P.ws + WS_RSX)};
        for (int rep = 0; rep < REPS(2); ++rep) { pg8::gemm_phase<EpiBf16Row, pg8::StaticOrder, PG8_ALIGN, PG8_SP2>(lds, g, S, E);
        SEAM(2); }
    }
    if (IN(3)) {
        for (int rep = 0; rep < REPS(3); ++rep) p2_phase(P, vcu, G, tid, wave);
        pg8::Gemm g{PB, WP, M, D, PLED}; pg8::StaticOrder S; S.init(M, D, G, bx);
        EpiBf16Row E{PL, D, nullptr};
        for (int rep = 0; rep < REPS(8); ++rep) pg8::gemm_phase<EpiBf16Row, pg8::StaticOrder, PG8_ALIGN, PG8_SP2>(lds, g, S, E);
        SEAM(3);
    }
    if (IN(4)) {
        pg8::Gemm g{MIX, WO, M, D, D}; pg8::StaticOrder S; S.init(M, D, G, bx);
        EpiH1 E{P.x, HB, (float*)(P.ws + WS_RS1)};
        for (int rep = 0; rep < REPS(4); ++rep) { pg8::gemm_phase<EpiH1, pg8::StaticOrder, PG8_ALIGN, PG8_SP2>(lds, g, S, E);
        SEAM(4); }
    }
    if (IN(5)) {
        pg8::Gemm g{HB, WQ, M, NQ, D}; pg8::StaticOrder S; S.init(M, NQ, G, bx);
        EpiBf16Row E{QB, NQ, nullptr};
        for (int rep = 0; rep < REPS(5); ++rep) { pg8::gemm_phase<EpiBf16Row, pg8::StaticOrder, PG8_ALIGN, PG8_SP2>(lds, g, S, E);
        SEAM(5); }
    }
    if (IN(6)) { for (int rep = 0; rep < REPS(6); ++rep) { score_phase(P, lds, bx, G, tid, wave, lane); SEAM(6); } }
    if (IN(7)) { peer_phase(P, lds, vcu, G, wave, lane); SEAM(7); }
    if (IN(8)) {
        pg8::Gemm g{HB, WG, M, D, D}; pg8::StaticOrder S; S.init(M, D, G, bx);
        EpiGate E{P.out, HB, PL, (const float*)(P.ws + WS_RS2), (float*)(P.ws + WS_RS3)};
        pg8::gemm_phase<EpiGate, pg8::StaticOrder, PG8_ALIGN, PG8_SP2>(lds, g, S, E);
        SEAM(8);
    }
    if (IN(9)) { final_phase(P, vcu, G, wave, lane); }
#undef IN
#undef SEAM
}

extern "C" void kernel_launch(void* const* d_in, const int* in_sizes, int n_in, void* d_out, int out_size, void* d_ws, size_t ws_size, hipStream_t stream) {
    static int grid = 0;
    if (grid == 0) {
        if (n_in != 17 || in_sizes[0] != M * D || out_size != M * D || ws_size < WS_END) { fprintf(stderr, "kernel_launch: unexpected shapes (n_in %d, in0 %d, out %d, ws %zu); nothing launched\n", n_in, n_in > 0 ? in_sizes[0] : -1, out_size, ws_size); grid = -1; return; }
        int dev = 0, cus = 0, per_cu = 0;
        if (hipGetDevice(&dev) != hipSuccess || hipDeviceGetAttribute(&cus, hipDeviceAttributeMultiprocessorCount, dev) != hipSuccess) { fprintf(stderr, "kernel_launch: device query failed\n"); grid = -1; return; }
        if (hipFuncSetAttribute((const void*)mega_fwd, hipFuncAttributeMaxDynamicSharedMemorySize, LDS_BYTES) != hipSuccess) { fprintf(stderr, "kernel_launch: hipFuncSetAttribute failed\n"); grid = -1; return; }
        if (hipOccupancyMaxActiveBlocksPerMultiprocessor(&per_cu, (const void*)mega_fwd, NWAVES * 64, LDS_BYTES) != hipSuccess || per_cu < 1)
            fprintf(stderr, "kernel_launch: note: occupancy query reports %d workgroups per CU\n", per_cu);
        (void)hipGetLastError();
        grid = cus;
    }
    if (grid < 0) return;
    if (hipMemsetAsync((char*)d_ws + WS_CTL, 0, CTL_ZERO_BYTES, stream) != hipSuccess) { fprintf(stderr, "kernel_launch: memset failed\n"); return; }
    Args a{};
    for (int i = 0; i < 17; ++i) a.in[i] = (const float*)d_in[i];
    a.out = (float*)d_out; a.ws = (unsigned char*)d_ws;
#if MK_PER_PHASE
    for (int ph = 0; ph < NPHASES; ++ph) { a.ph_lo = ph; a.ph_hi = ph + 1; hipLaunchKernelGGL(mega_fwd, dim3(grid), dim3(NWAVES * 64), LDS_BYTES, stream, a); }
#else
    a.ph_lo = 0; a.ph_hi = NPHASES;
    hipLaunchKernelGGL(mega_fwd, dim3(grid), dim3(NWAVES * 64), LDS_BYTES, stream, a);
#endif
    const hipError_t le = hipPeekAtLastError();
    if (le != hipSuccess) fprintf(stderr, "kernel_launch: launch failed: %s\n", hipGetErrorName(le));
}
```

```cpp
#include <hip/hip_runtime.h>
#include <cstdio>
#include <cstdint>
namespace pg8 {
#define PG8_LAS __attribute__((address_space(3)))
typedef unsigned short bf16_t;
typedef short bf16x8 __attribute__((ext_vector_type(8)));
typedef float f32x4 __attribute__((ext_vector_type(4)));
typedef unsigned u32x4 __attribute__((ext_vector_type(4)));
constexpr int BM = 256, BK = 64, HALF = 128, HTB = HALF * BK * 2  , STAGE_BYTES = 8 * HTB, NXCD = 8, WGM = 8;

__host__ __device__ __forceinline__ int lds_byte(int r, int c) { const int st = (r >> 4) * 2 + (c >> 5), rr = r & 15, cc = c & 31, ob = rr * 64 + cc * 2; return st * 1024 + (ob ^ (((ob >> 9) & 1) << 5)); }
__host__ __device__ __forceinline__ void stage_rc(int b, int& R, int& C) { const int st = b / 1024, sb = b % 1024, swz = sb ^ (((sb >> 9) & 1) << 5); R = (st >> 1) * 16 + swz / 64; C = (st & 1) * 32 + (swz % 64) / 2; }
__host__ __device__ __forceinline__ int perm32(int rho) { const int n = rho >> 4, i = rho & 15; return 8 * (i >> 2) + 4 * n + (i & 3); }

struct Unit { int pm, pn; };
struct Gemm { const bf16_t* A; const bf16_t* Bt; int M, N, K; };

struct StaticOrder {
    int nM, nN, nwg, G, c;
    __host__ __device__ void init(int M, int N, int G_, int c_) { nM = M / BM; nN = N / BM; nwg = nM * nN; G = G_; c = c_; }
    __host__ __device__ bool next(int i, Unit& u) const {
        const long L = (long)i * G + c; if (L >= nwg) return false;
        int wgid = (int)L; { const int q = nwg / NXCD, r = nwg % NXCD, xcd = wgid % NXCD, off = wgid / NXCD; wgid = (xcd < r ? xcd * (q + 1) : r * (q + 1) + (xcd - r) * q) + off; }
        const int nig = WGM * nN, gid = wgid / nig, fm = gid * WGM, gsz = (nM - fm) < WGM ? (nM - fm) : WGM;
        u.pm = fm + ((wgid % nig) % gsz); u.pn = (wgid % nig) / gsz; return true;
    }
    __device__ __forceinline__ void a_ready(const Unit&) const {}
    __device__ __forceinline__ void done(const Unit&) const {}
};

__device__ __forceinline__ unsigned cvt_pk_bf16(float lo, float hi) { unsigned r; asm volatile("v_cvt_pk_bf16_f32 %0, %1, %2" : "=v"(r) : "v"(lo), "v"(hi)); return r; }
template <class Epi, class Sched, bool ALIGN_EPI = false, bool SP2 = false>
__device__ __forceinline__ void gemm_phase(PG8_LAS unsigned char* lds, const Gemm g, const Sched& S, const Epi& E) {
    const int tid = threadIdx.x, wid = __builtin_amdgcn_readfirstlane(tid >> 6), lane = tid & 63, wr = wid >> 2, wc = wid & 3, fr = lane & 15, fq = lane >> 4;
    const int K = g.K, nt = K / BK;
    unsigned voffA[2], voffB[2];
#pragma unroll
    for (int i = 0; i < 2; ++i) { int R, C; stage_rc(tid * 16 + i * 8192, R, C); const int Rb = Epi::PERM ? ((R & ~31) + perm32(R & 31)) : R;
        voffA[i] = (unsigned)(R * K + C) * 2u; voffB[i] = (unsigned)(Rb * K + C) * 2u; }
    const size_t kstep = (size_t)(BK * 2);
    const size_t hstep = (size_t)HALF * K * 2;
    const size_t tstep = 2 * hstep;
    const unsigned ldsw = (unsigned)wid * 1024u;
    const int aoff = lds_byte(wr * 64 + fr, fq * 8), boff = lds_byte(wc * 32 + fr, fq * 8);
#define PG8_SA(b, h) (((b) * 2 + (h)) * HTB)
#define PG8_SB(b, h) ((4 + (b) * 2 + (h)) * HTB)
#define PG8_STAGE(bufoff, gbase, voff) do { _Pragma("unroll") for (int _i = 0; _i < 2; ++_i) \
        __builtin_amdgcn_global_load_lds((const unsigned*)((const char*)(gbase) + (voff)[_i]), (PG8_LAS unsigned*)(lds + (bufoff) + ldsw + _i * 8192), 16, 0, 0); } while (0)
#define PG8_LDA(dst, b, h) do { _Pragma("unroll") for (int m = 0; m < 4; ++m) _Pragma("unroll") for (int k = 0; k < 2; ++k) dst[m][k] = *(const PG8_LAS bf16x8*)(lds + PG8_SA(b, h) + aoff + m * 2048 + k * 1024); } while (0)
#define PG8_LDB(dst, b, h) do { _Pragma("unroll") for (int n = 0; n < 2; ++n) _Pragma("unroll") for (int k = 0; k < 2; ++k) dst[n][k] = *(const PG8_LAS bf16x8*)(lds + PG8_SB(b, h) + boff + n * 2048 + k * 1024); } while (0)
#define PG8_MMA(ai, bj, At, Bt) do { __builtin_amdgcn_s_setprio(1); _Pragma("unroll") for (int m = 0; m < 4; ++m) _Pragma("unroll") for (int n = 0; n < 2; ++n) _Pragma("unroll") for (int k = 0; k < 2; ++k) \
        acc[ai][bj][m][n] = __builtin_amdgcn_mfma_f32_16x16x32_bf16(Bt[n][k], At[m][k], acc[ai][bj][m][n], 0, 0, 0); __builtin_amdgcn_s_setprio(0); } while (0)
#define PG8_WAIT_V(n) asm volatile("s_waitcnt vmcnt(" #n ")" ::: "memory")
#define PG8_WAIT_L(n) asm volatile("s_waitcnt lgkmcnt(" #n ")" ::: "memory")
#define PG8_BAR __builtin_amdgcn_s_barrier()
#define PG8_SCHED __builtin_amdgcn_sched_barrier(0)
    Unit cur, nxt; int ui = 0;
    if (!S.next(0, cur)) return;
    f32x4 acc[2][2][4][2];
#pragma unroll
    for (int a = 0; a < 2; ++a)
#pragma unroll
        for (int b = 0; b < 2; ++b)
#pragma unroll
            for (int m = 0; m < 4; ++m)
#pragma unroll
                for (int n = 0; n < 2; ++n) acc[a][b][m][n] = (f32x4){0.f, 0.f, 0.f, 0.f};
    bf16x8 At[4][2], B0[2][2], B1[2][2];
    const char* cA = (const char*)g.A + (size_t)cur.pm * tstep; const char* cB = (const char*)g.Bt + (size_t)cur.pn * tstep;
    S.a_ready(cur);
    if constexpr (SP2) {
        PG8_STAGE(PG8_SB(0, 0), cB, voffB); PG8_STAGE(PG8_SB(0, 1), cB + hstep, voffB); PG8_STAGE(PG8_SA(0, 0), cA, voffA); PG8_STAGE(PG8_SA(0, 1), cA + hstep, voffA);
        if (wr == 1) PG8_BAR;
        PG8_WAIT_V(2); PG8_BAR;
        PG8_STAGE(PG8_SB(1, 0), cB + kstep, voffB); PG8_STAGE(PG8_SA(1, 0), cA + kstep, voffA); PG8_STAGE(PG8_SB(1, 1), cB + hstep + kstep, voffB);
        PG8_WAIT_V(6); PG8_BAR;
    } else {
        PG8_STAGE(PG8_SB(0, 0), cB, voffB); PG8_STAGE(PG8_SA(0, 0), cA, voffA); PG8_STAGE(PG8_SB(0, 1), cB + hstep, voffB); PG8_STAGE(PG8_SA(0, 1), cA + hstep, voffA);
        if (wr == 1) PG8_BAR;
        PG8_WAIT_V(4); PG8_BAR;
        PG8_STAGE(PG8_SB(1, 0), cB + kstep, voffB); PG8_STAGE(PG8_SA(1, 0), cA + kstep, voffA); PG8_STAGE(PG8_SB(1, 1), cB + hstep + kstep, voffB);
        PG8_WAIT_V(6); PG8_BAR;
    }
    for (;;) {
        const bool has_next = S.next(ui + 1, nxt);
        const char* nA = has_next ? (const char*)g.A + (size_t)nxt.pm * tstep : cA; const char* nB = has_next ? (const char*)g.Bt + (size_t)nxt.pn * tstep : cB;
        for (int t = 0; t < nt; t += 2) {
            const bool last = (t == nt - 2);
            const char* a1 = cA + (size_t)(t + 1) * kstep;
            const char* a2 = last ? nA : cA + (size_t)(t + 2) * kstep; const char* b2 = last ? nB : cB + (size_t)(t + 2) * kstep;
            const char* a3 = a2 + kstep; const char* b3 = b2 + kstep;
            if (last && has_next) S.a_ready(nxt);
            if constexpr (SP2) {
            PG8_LDB(B0, 0, 0); PG8_LDB(B1, 0, 1); PG8_SCHED; PG8_LDA(At, 0, 0); PG8_STAGE(PG8_SA(1, 1), a1 + hstep, voffA);
            PG8_WAIT_V(8); PG8_WAIT_L(0); PG8_BAR; PG8_MMA(0, 0, At, B0); PG8_MMA(0, 1, At, B1); PG8_BAR; PG8_SCHED;
            PG8_LDA(At, 0, 1); PG8_STAGE(PG8_SB(0, 0), b2, voffB); PG8_STAGE(PG8_SB(0, 1), b2 + hstep, voffB); PG8_STAGE(PG8_SA(0, 0), a2, voffA);
            PG8_WAIT_V(8); PG8_WAIT_L(0); PG8_BAR; PG8_MMA(1, 0, At, B0); PG8_MMA(1, 1, At, B1); PG8_BAR; PG8_SCHED;
            PG8_LDB(B0, 1, 0); PG8_LDB(B1, 1, 1); PG8_SCHED; PG8_LDA(At, 1, 0); PG8_STAGE(PG8_SA(0, 1), a2 + hstep, voffA);
            PG8_WAIT_V(8); PG8_WAIT_L(0); PG8_BAR; PG8_MMA(0, 0, At, B0); PG8_MMA(0, 1, At, B1); PG8_BAR; PG8_SCHED;
            PG8_LDA(At, 1, 1); PG8_STAGE(PG8_SB(1, 0), b3, voffB); PG8_STAGE(PG8_SB(1, 1), b3 + hstep, voffB); PG8_STAGE(PG8_SA(1, 0), a3, voffA);
            PG8_WAIT_V(8); PG8_WAIT_L(0); PG8_BAR; PG8_MMA(1, 0, At, B0); PG8_MMA(1, 1, At, B1); PG8_BAR; PG8_SCHED;
            } else {
            PG8_LDB(B0, 0, 0); PG8_SCHED; PG8_LDA(At, 0, 0); PG8_STAGE(PG8_SA(1, 1), a1 + hstep, voffA);
            PG8_WAIT_L(8); PG8_BAR; PG8_WAIT_L(0); PG8_MMA(0, 0, At, B0); PG8_BAR; PG8_SCHED;
            PG8_LDB(B1, 0, 1); PG8_STAGE(PG8_SB(0, 0), b2, voffB);
            PG8_BAR; PG8_WAIT_L(0); PG8_MMA(0, 1, At, B1); PG8_BAR;
            PG8_LDA(At, 0, 1); PG8_STAGE(PG8_SA(0, 0), a2, voffA);
            PG8_BAR; PG8_WAIT_L(0); PG8_MMA(1, 0, At, B0); PG8_BAR; PG8_SCHED;
            PG8_STAGE(PG8_SB(0, 1), b2 + hstep, voffB);
            PG8_WAIT_V(6); PG8_BAR; PG8_MMA(1, 1, At, B1); PG8_BAR;
            PG8_LDB(B0, 1, 0); PG8_SCHED; PG8_LDA(At, 1, 0); PG8_STAGE(PG8_SA(0, 1), a2 + hstep, voffA);
            PG8_WAIT_L(8); PG8_BAR; PG8_WAIT_L(0); PG8_MMA(0, 0, At, B0); PG8_BAR; PG8_SCHED;
            PG8_LDB(B1, 1, 1); PG8_STAGE(PG8_SB(1, 0), b3, voffB);
            PG8_BAR; PG8_WAIT_L(0); PG8_MMA(0, 1, At, B1); PG8_BAR;
            PG8_LDA(At, 1, 1); PG8_STAGE(PG8_SA(1, 0), a3, voffA);
            PG8_BAR; PG8_WAIT_L(0); PG8_MMA(1, 0, At, B0); PG8_BAR; PG8_SCHED;
            PG8_STAGE(PG8_SB(1, 1), b3 + hstep, voffB);
            PG8_WAIT_V(6); PG8_BAR; PG8_MMA(1, 1, At, B1); PG8_BAR;
            }
        }
        if constexpr (ALIGN_EPI) { if (wr == 0) PG8_BAR; }
        if constexpr (!Epi::AFTER_DRAIN) { E(acc, cur, wr, wc, fr, fq); S.done(cur); }
        if (!has_next) break;
#pragma unroll
        for (int a = 0; a < 2; ++a)
#pragma unroll
            for (int b = 0; b < 2; ++b)
#pragma unroll
                for (int m = 0; m < 4; ++m)
#pragma unroll
                    for (int n = 0; n < 2; ++n) acc[a][b][m][n] = (f32x4){0.f, 0.f, 0.f, 0.f};
        cur = nxt; cA = nA; cB = nB; ++ui;
        if constexpr (ALIGN_EPI) { if (wr == 1) PG8_BAR; }
    }
    PG8_WAIT_V(0);
    if constexpr (!ALIGN_EPI) { if (wr == 0) PG8_BAR; }
    PG8_BAR;
    if constexpr (Epi::AFTER_DRAIN) { E.fused(acc, cur, wr, wc, fr, fq, lds, wid, lane); S.done(cur); }
#undef PG8_SA
#undef PG8_SB
#undef PG8_STAGE
#undef PG8_LDA
#undef PG8_LDB
#undef PG8_MMA
#undef PG8_WAIT_V
#undef PG8_WAIT_L
#undef PG8_BAR
#undef PG8_SCHED
}
}

#define GAS __attribute__((address_space(1)))
#define LAS __attribute__((address_space(3)))
typedef unsigned short bf16;
typedef unsigned v4u __attribute__((ext_vector_type(4)));
typedef float f32x4 __attribute__((ext_vector_type(4)));
typedef short bf16x8 __attribute__((ext_vector_type(8)));
typedef GAS unsigned gu32;
typedef GAS unsigned long long gu64;
#define RLX_AGENT __ATOMIC_RELAXED, __HIP_MEMORY_SCOPE_AGENT
#define LDS_WAIT() asm volatile("s_waitcnt lgkmcnt(0)" ::: "memory")
#define VM_WAIT() asm volatile("s_waitcnt vmcnt(0)" ::: "memory")
__device__ __forceinline__ unsigned long long rt() { return __builtin_amdgcn_s_memrealtime(); }
__device__ __forceinline__ unsigned f2bf(float f) { unsigned u = __builtin_bit_cast(unsigned, f); return (u + 0x7fffu + ((u >> 16) & 1u)) >> 16; }
__device__ __forceinline__ unsigned pk2(float lo, float hi) { return f2bf(lo) | (f2bf(hi) << 16); }

#define XB_TMO      128
#define XB_XCNT(j)  (256  + 64 * (j))
#define XB_XSUB(j)  (1280 + 64 * (j))
#define XB_XGEN(j)  (2304 + 64 * (j))
#define XB_TOP      3328
#define XB_TOPGEN   3392
#define XCD_BAR_WORDS 3456
#define XB_SPIN_CAP (1u << 18)

__device__ __forceinline__ unsigned xb_ld(unsigned* p)              { return __hip_atomic_load(p, __ATOMIC_RELAXED, __HIP_MEMORY_SCOPE_AGENT); }
__device__ __forceinline__ unsigned xb_add(unsigned* p, unsigned v) { return __hip_atomic_fetch_add(p, v, __ATOMIC_RELAXED, __HIP_MEMORY_SCOPE_AGENT); }
__device__ __forceinline__ unsigned xb_xcc_id() { return (unsigned)__builtin_amdgcn_s_getreg((3 << 11) | 20) & 0xFu; }
#define XB_SPIN(cond, bar) do { unsigned _sp = 0; while (cond) { __builtin_amdgcn_s_sleep(1); \
    if ((++_sp & 255u) == 0u) { if (xb_ld(&(bar)[XB_TMO])) break; if (_sp > XB_SPIN_CAP) { atomicAdd(&(bar)[XB_TMO], 1u); break; } } } } while (0)

struct XcdBarrier {
    unsigned* bar; unsigned x;
    volatile LAS unsigned* st;
};

__device__ __forceinline__ XcdBarrier xcd_barrier_post(unsigned* bar, volatile LAS unsigned* st) {
    XcdBarrier b; b.bar = bar; b.x = xb_xcc_id(); b.st = st;
    if (threadIdx.x == 0) (void)xb_add(&bar[XB_XCNT(b.x)], 1u);
    return b;
}
__device__ __forceinline__ void xcd_barrier_complete(unsigned* bar, unsigned x, unsigned& nloc, unsigned& nx) {
    const unsigned G = gridDim.x * gridDim.y * gridDim.z;
    unsigned sum, cnt, mine, sp = 0u;
    for (;;) {
        sum = 0u; cnt = 0u; mine = 0u;
#pragma unroll
        for (unsigned j = 0; j < 16; ++j) { const unsigned c = xb_ld(&bar[XB_XCNT(j)]); sum += c; cnt += (c > 0u) ? 1u : 0u; mine = (j == x) ? c : mine; }
        if (sum == G) break;
        __builtin_amdgcn_s_sleep(1);
        if ((++sp & 255u) == 0u) { if (xb_ld(&bar[XB_TMO])) break; if (sp > XB_SPIN_CAP) { atomicAdd(&bar[XB_TMO], 1u); break; } }
    }
    nloc = mine > 0u ? mine : 1u; nx = cnt > 0u ? cnt : 1u;
}

__device__ __forceinline__ void xcd_barrier(const XcdBarrier& b) {
    asm volatile("s_waitcnt vmcnt(0)" ::: "memory");
    __syncthreads();
    if (threadIdx.x == 0) {
        unsigned* bar = b.bar;
        __builtin_amdgcn_s_waitcnt(0);
        unsigned nloc = b.st[0], nx = b.st[1];
        if (nloc == 0u) { xcd_barrier_complete(bar, b.x, nloc, nx); b.st[0] = nloc; b.st[1] = nx; }
        const unsigned old = xb_add(&bar[XB_XSUB(b.x)], 1u);
        const unsigned gen = old / nloc;
        if (old + 1u == (gen + 1u) * nloc) {
            __builtin_amdgcn_fence(__ATOMIC_RELEASE, "agent");
            asm volatile("s_waitcnt vmcnt(0)" ::: "memory");
            const unsigned og = xb_add(&bar[XB_TOP], 1u);
            const unsigned tg = og / nx;
            if (og + 1u == (tg + 1u) * nx) xb_add(&bar[XB_TOPGEN], 1u);
            else XB_SPIN(xb_ld(&bar[XB_TOPGEN]) == tg, bar);
            __builtin_amdgcn_fence(__ATOMIC_ACQUIRE, "agent");
            xb_add(&bar[XB_XGEN(b.x)], 1u);
            asm volatile("s_waitcnt vmcnt(0)" ::: "memory");
        } else {
            XB_SPIN(xb_ld(&bar[XB_XGEN(b.x)]) == gen, bar);
            __builtin_amdgcn_fence(__ATOMIC_ACQUIRE, "agent");
            asm volatile("s_waitcnt vmcnt(0)" ::: "memory");
        }
    }
    __syncthreads();
}

constexpr int NWAVES = 8;
constexpr int M = 32768, D = 1024, SEQ = 4096, NPROJ = 2048, NQ = 2048, PLED = 256, NEXP = 16384;
constexpr float EPS = 1e-6f;
#ifndef MK_PER_PHASE
#define MK_PER_PHASE 0
#endif
#ifndef PROBE_REP
#define PROBE_REP 0
#endif
#define REPS(k) ((PROBE_REP == (k)) ? 2 : 1)
constexpr int NPHASES = 11;

constexpr size_t MiB = 1u << 20;
constexpr size_t WS_CTL = 0, CTL_ZERO_BYTES = 1 * MiB;
constexpr size_t WS_WIN = 2 * MiB, WS_WO = 6 * MiB, WS_WQ = 8 * MiB, WS_WG = 12 * MiB, WS_WP = 14 * MiB, WS_KEYS = 14 * MiB + 512 * 1024;
constexpr size_t WS_WF = 15 * MiB;
constexpr size_t WS_RSX = 17 * MiB, WS_RS2 = 17 * MiB + 512 * 1024, WS_RS1 = 18 * MiB, WS_RS3 = 20 * MiB;
constexpr size_t WS_SU = 22 * MiB, WS_SV = 22 * MiB + 65536;
constexpr size_t WS_U = 24 * MiB, WS_V = 56 * MiB;
constexpr size_t WS_XB = 88 * MiB;
constexpr size_t WS_PROJ = 152 * MiB;
constexpr size_t WS_MIX = 280 * MiB;
constexpr size_t WS_CF = WS_MIX;
constexpr size_t WS_HB = 344 * MiB;
constexpr size_t WS_EIDX = 408 * MiB, WS_GATE = 424 * MiB;
constexpr size_t WS_PB = 440 * MiB;
constexpr size_t WS_END = 456 * MiB;
constexpr int CW_BAR = 4096;
static_assert((CW_BAR + XCD_BAR_WORDS) * 4 <= (int)CTL_ZERO_BYTES, "CTL words inside the memset region");

constexpr int RING_BYTES = 131072;
constexpr int LDSCTL_OFF = RING_BYTES, MISC_OFF = LDSCTL_OFF + 320;
constexpr int LDS_BYTES = 147456;

typedef float f32x16 __attribute__((ext_vector_type(16)));
typedef _Float16 h2_t __attribute__((ext_vector_type(2)));
typedef float f32x2 __attribute__((ext_vector_type(2)));
typedef int i32x4 __attribute__((ext_vector_type(4)));
typedef unsigned v2u __attribute__((ext_vector_type(2)));

__device__ __forceinline__ float wave_sum(float v) {
#pragma unroll
    for (int o = 1; o < 64; o <<= 1) v += __shfl_xor(v, o);
    return v;
}
__device__ __forceinline__ float bf_lo(unsigned w) { return __uint_as_float(w << 16); }
__device__ __forceinline__ float bf_hi(unsigned w) { return __uint_as_float(w & 0xffff0000u); }
__device__ __forceinline__ unsigned pkh(float lo, float hi) { f32x2 v = {lo, hi}; h2_t h = __builtin_convertvector(v, h2_t); return __builtin_bit_cast(unsigned, h); }

struct EpiBf16Row {
    static constexpr bool PERM = true, AFTER_DRAIN = false;
    pg8::bf16_t* O; int ldc; const float* rowss;
    __device__ __forceinline__ void operator()(const pg8::f32x4 (&acc)[2][2][4][2], const pg8::Unit& u, int wr, int wc, int fr, int fq) const {
        const int row0 = u.pm * 256 + wr * 64 + fr, col0 = u.pn * 256 + wc * 32 + 8 * fq;
#pragma unroll
        for (int ai = 0; ai < 2; ++ai)
#pragma unroll
            for (int m = 0; m < 4; ++m) {
                const int row = row0 + ai * 128 + m * 16;
                const float sc = rowss ? __builtin_amdgcn_rsqf(rowss[row] * (1.0f / 1024.0f) + EPS) : 1.0f;
                pg8::bf16_t* rowp = O + (size_t)row * ldc + col0;
#pragma unroll
                for (int bj = 0; bj < 2; ++bj) {
                    const pg8::f32x4 v0 = acc[ai][bj][m][0] * sc, v1 = acc[ai][bj][m][1] * sc;
                    pg8::u32x4 w; w.x = pg8::cvt_pk_bf16(v0[0], v0[1]); w.y = pg8::cvt_pk_bf16(v0[2], v0[3]); w.z = pg8::cvt_pk_bf16(v1[0], v1[1]); w.w = pg8::cvt_pk_bf16(v1[2], v1[3]);
                    *(pg8::u32x4*)(rowp + bj * 128) = w;
                }
            }
    }
};
struct EpiH1 {
    static constexpr bool PERM = true, AFTER_DRAIN = false;
    const float* X; pg8::bf16_t* HB; float* RS;
    __device__ __forceinline__ void operator()(const pg8::f32x4 (&acc)[2][2][4][2], const pg8::Unit& u, int wr, int wc, int fr, int fq) const {
        const int row0 = u.pm * 256 + wr * 64 + fr, col0 = u.pn * 256 + wc * 32 + 8 * fq;
#pragma unroll
        for (int ai = 0; ai < 2; ++ai)
#pragma unroll
            for (int m = 0; m < 4; ++m) {
                const int row = row0 + ai * 128 + m * 16; float s = 0.f;
#pragma unroll
                for (int bj = 0; bj < 2; ++bj) {
                    const size_t off = (size_t)row * 1024 + col0 + bj * 128;
                    const pg8::f32x4 x0 = *(const pg8::f32x4*)(X + off), x1 = *(const pg8::f32x4*)(X + off + 4);
                    const pg8::f32x4 v0 = acc[ai][bj][m][0] + x0, v1 = acc[ai][bj][m][1] + x1;
                    pg8::u32x4 w; w.x = pg8::cvt_pk_bf16(v0[0], v0[1]); w.y = pg8::cvt_pk_bf16(v0[2], v0[3]); w.z = pg8::cvt_pk_bf16(v1[0], v1[1]); w.w = pg8::cvt_pk_bf16(v1[2], v1[3]);
                    *(pg8::u32x4*)(HB + off) = w;
                    s += (v0[0] * v0[0] + v0[1] * v0[1]) + (v0[2] * v0[2] + v0[3] * v0[3]) + (v1[0] * v1[0] + v1[1] * v1[1]) + (v1[2] * v1[2] + v1[3] * v1[3]);
                }
                s += __shfl_xor(s, 16); s += __shfl_xor(s, 32);
                if (fq == 0) RS[(size_t)row * 16 + u.pn * 4 + wc] = s;
            }
    }
};
struct EpiGate {
    static constexpr bool PERM = true, AFTER_DRAIN = false;
    float* OUT; const pg8::bf16_t* HB; const pg8::bf16_t* PL; const float* RS2; float* RS3;
    __device__ __forceinline__ void operator()(const pg8::f32x4 (&acc)[2][2][4][2], const pg8::Unit& u, int wr, int wc, int fr, int fq) const {
        const int row0 = u.pm * 256 + wr * 64 + fr, col0 = u.pn * 256 + wc * 32 + 8 * fq;
#pragma unroll
        for (int ai = 0; ai < 2; ++ai)
#pragma unroll
            for (int m = 0; m < 4; ++m) {
                const int row = row0 + ai * 128 + m * 16; float s = 0.f;
                const float rstd = __builtin_amdgcn_rsqf(RS2[row] * (1.0f / 1024.0f) + EPS);
#pragma unroll
                for (int bj = 0; bj < 2; ++bj) {
                    const size_t off = (size_t)row * 1024 + col0 + bj * 128;
                    const pg8::u32x4 w = *(const pg8::u32x4*)(PL + off), hw = *(const pg8::u32x4*)(HB + off);
                    const pg8::f32x4 h0 = {bf_lo(hw.x), bf_hi(hw.x), bf_lo(hw.y), bf_hi(hw.y)}, h1 = {bf_lo(hw.z), bf_hi(hw.z), bf_lo(hw.w), bf_hi(hw.w)};
                    const pg8::f32x4 a0 = acc[ai][bj][m][0] * rstd, a1 = acc[ai][bj][m][1] * rstd;
                    pg8::f32x4 g0, g1;
#pragma unroll
                    for (int e = 0; e < 4; ++e) { g0[e] = 1.0f / (1.0f + __expf(-a0[e])); g1[e] = 1.0f / (1.0f + __expf(-a1[e])); }
                    const pg8::f32x4 p0 = {bf_lo(w.x), bf_hi(w.x), bf_lo(w.y), bf_hi(w.y)}, p1 = {bf_lo(w.z), bf_hi(w.z), bf_lo(w.w), bf_hi(w.w)};
                    const pg8::f32x4 v0 = h0 + g0 * p0, v1 = h1 + g1 * p1;
                    *(pg8::f32x4*)(OUT + off) = v0; *(pg8::f32x4*)(OUT + off + 4) = v1;
                    s += (v0[0] * v0[0] + v0[1] * v0[1]) + (v0[2] * v0[2] + v0[3] * v0[3]) + (v1[0] * v1[0] + v1[1] * v1[1]) + (v1[2] * v1[2] + v1[3] * v1[3]);
                }
                s += __shfl_xor(s, 16); s += __shfl_xor(s, 32);
                if (fq == 0) RS3[(size_t)row * 16 + u.pn * 4 + wc] = s;
            }
    }
};

__device__ __forceinline__ void p0_transpose_item(const float* W, int ldn, const float* gk, int K, bf16* WT, int row_off, int nblk, LAS float* scr, int item, int lane) {
    const int kb = item / nblk, nb = item % nblk, k0 = 64 * kb, n0 = 32 * nb;
#pragma unroll 8
    for (int i = 0; i < 32; ++i) { const int kk = 2 * i + (lane >> 5); float v = W[(size_t)(k0 + kk) * ldn + n0 + (lane & 31)]; if (gk) v *= gk[k0 + kk]; scr[kk * 33 + (lane & 31)] = v; }
    LDS_WAIT(); asm volatile("" ::: "memory");
    const int c = lane & 7;
#pragma unroll
    for (int j = 0; j < 4; ++j) { const int n = (lane >> 3) + 8 * j; const LAS float* s = scr + (8 * c) * 33 + n;
        v4u o; o.x = pk2(s[0 * 33], s[1 * 33]); o.y = pk2(s[2 * 33], s[3 * 33]); o.z = pk2(s[4 * 33], s[5 * 33]); o.w = pk2(s[6 * 33], s[7 * 33]);
        *(GAS v4u*)(WT + (size_t)(row_off + n0 + n) * K + k0 + 8 * c) = o; }
    LDS_WAIT(); asm volatile("" ::: "memory");
}

struct Ptrs {
    const float *x, *p, *g_mix, *w_in, *conv_w, *pool_w, *pool_scale, *w_o, *g_ffn, *w_q, *sub_keys, *eu, *ev, *g_ple, *w_gate, *w_proj, *g_final;
    float* out; unsigned char* ws;
};

__device__ __forceinline__ void p0a_phase(const Ptrs& P, LAS unsigned char* lds, int vcu, int G, int tid, int wave, int lane) {
    const int gw = vcu * NWAVES + wave, NGW = G * NWAVES;
    const int gt = vcu * (NWAVES * 64) + tid, NGT = G * NWAVES * 64;
    { float* Wf = (float*)(P.ws + WS_WF);
      for (int tk = gw; tk < 2048; tk += NGW) {
          const int k4 = (tk >> 3) * 4, j = tk & 7, g = j >> 1, np = j * 64 + lane, d = np & 127;
          const float* wi = P.w_in + (size_t)k4 * 2048 + 1536 + g * 128; const float* pw = P.pool_w + (size_t)g * 128 * 128 + d;
          float a0 = 0.f, a1 = 0.f, a2 = 0.f, a3 = 0.f;
          for (int c0 = 0; c0 < 128; c0 += 16) {
              float pv[16], w0[16], w1[16], w2[16], w3[16];
#pragma unroll
              for (int c = 0; c < 16; ++c) { pv[c] = pw[(size_t)(c0 + c) * 128]; w0[c] = wi[c0 + c]; w1[c] = wi[2048 + c0 + c]; w2[c] = wi[4096 + c0 + c]; w3[c] = wi[6144 + c0 + c]; }
#pragma unroll
              for (int c = 0; c < 16; ++c) { a0 += w0[c] * pv[c]; a1 += w1[c] * pv[c]; a2 += w2[c] * pv[c]; a3 += w3[c] * pv[c]; }
          }
          const float sc = P.pool_scale[np];
          Wf[(size_t)k4 * 512 + np] = a0 * sc; Wf[(size_t)(k4 + 1) * 512 + np] = a1 * sc; Wf[(size_t)(k4 + 2) * 512 + np] = a2 * sc; Wf[(size_t)(k4 + 3) * 512 + np] = a3 * sc;
      } }
    { LAS float* scr = (LAS float*)(lds + wave * 16384);
      constexpr int I_WO = 16 * 32, I_WQ = 16 * 64, I_WG = 16 * 32, I_WP = 4 * 32, I_WINA = 16 * 48;
      constexpr int NITEMS = I_WO + I_WQ + I_WG + I_WP + I_WINA;
      for (int it = gw; it < NITEMS; it += NGW) {
          int r = it;
          if (r < I_WO) { p0_transpose_item(P.w_o, 1024, nullptr, 1024, (bf16*)(P.ws + WS_WO), 0, 32, scr, r, lane); continue; } r -= I_WO;
          if (r < I_WQ) { p0_transpose_item(P.w_q, 2048, P.g_ffn, 1024, (bf16*)(P.ws + WS_WQ), 0, 64, scr, r, lane); continue; } r -= I_WQ;
          if (r < I_WG) { p0_transpose_item(P.w_gate, 1024, P.g_ple, 1024, (bf16*)(P.ws + WS_WG), 0, 32, scr, r, lane); continue; } r -= I_WG;
          if (r < I_WP) { p0_transpose_item(P.w_proj, 1024, nullptr, 256, (bf16*)(P.ws + WS_WP), 0, 32, scr, r, lane); continue; } r -= I_WP;
          p0_transpose_item(P.w_in, 2048, P.g_mix, 1024, (bf16*)(P.ws + WS_WIN), 0, 48, scr, r, lane);
      } }
    { for (int r0 = 4 * gw; r0 < NEXP; r0 += 4 * NGW) {
          f32x4 a[4][4]; float q[4];
#pragma unroll
          for (int rr = 0; rr < 4; ++rr) { const GAS f32x4* src = (const GAS f32x4*)(P.eu + (size_t)(r0 + rr) * 1024);
#pragma unroll
              for (int j = 0; j < 4; ++j) a[rr][j] = src[4 * lane + j]; }
          { const GAS f32x4* gf = (const GAS f32x4*)P.g_ffn + 4 * lane;
#pragma unroll
            for (int j = 0; j < 4; ++j) { const f32x4 g = gf[j];
#pragma unroll
                for (int rr = 0; rr < 4; ++rr) a[rr][j] = a[rr][j] * g; } }
#pragma unroll
          for (int rr = 0; rr < 4; ++rr) { q[rr] = 0.f;
#pragma unroll
              for (int j = 0; j < 4; ++j) q[rr] += (a[rr][j].x * a[rr][j].x + a[rr][j].y * a[rr][j].y) + (a[rr][j].z * a[rr][j].z + a[rr][j].w * a[rr][j].w); }
#pragma unroll
          for (int o = 1; o < 64; o <<= 1) { q[0] += __shfl_xor(q[0], o); q[1] += __shfl_xor(q[1], o); q[2] += __shfl_xor(q[2], o); q[3] += __shfl_xor(q[3], o); }
#pragma unroll
          for (int rr = 0; rr < 4; ++rr) { const int e = r0 + rr;
              const float rms = sqrtf(q[rr] * (1.0f / 1024.0f)); const float sc = rms > 0.f ? 2.0f / rms : 0.f;
              unsigned w0 = 0u, w1 = 0u;
              w0 = __builtin_amdgcn_cvt_scalef32_pk_fp4_f32(w0, a[rr][0].x * sc, a[rr][0].y * sc, 1.0f, 0); w0 = __builtin_amdgcn_cvt_scalef32_pk_fp4_f32(w0, a[rr][0].z * sc, a[rr][0].w * sc, 1.0f, 1);
              w0 = __builtin_amdgcn_cvt_scalef32_pk_fp4_f32(w0, a[rr][1].x * sc, a[rr][1].y * sc, 1.0f, 2); w0 = __builtin_amdgcn_cvt_scalef32_pk_fp4_f32(w0, a[rr][1].z * sc, a[rr][1].w * sc, 1.0f, 3);
              w1 = __builtin_amdgcn_cvt_scalef32_pk_fp4_f32(w1, a[rr][2].x * sc, a[rr][2].y * sc, 1.0f, 0); w1 = __builtin_amdgcn_cvt_scalef32_pk_fp4_f32(w1, a[rr][2].z * sc, a[rr][2].w * sc, 1.0f, 1);
              w1 = __builtin_amdgcn_cvt_scalef32_pk_fp4_f32(w1, a[rr][3].x * sc, a[rr][3].y * sc, 1.0f, 2); w1 = __builtin_amdgcn_cvt_scalef32_pk_fp4_f32(w1, a[rr][3].z * sc, a[rr][3].w * sc, 1.0f, 3);
              ((GAS v2u*)(P.ws + WS_U))[(size_t)e * 64 + lane] = (v2u){w0, w1};
              if (lane == 0) ((float*)(P.ws + WS_SU))[e] = rms * 0.5f; }
      } }
    { const int ci = lane >> 2, cb = lane & 3; const int eoff = 256 * cb + 64 * (ci >> 2) + (ci & 3);
      for (int r0 = 2 * gw; r0 < NEXP; r0 += 2 * NGW) {
          float v[2][16]; float q[2];
#pragma unroll
          for (int rr = 0; rr < 2; ++rr) { const float* src = P.ev + (size_t)(r0 + rr) * 1024 + eoff;
#pragma unroll
              for (int n = 0; n < 16; ++n) v[rr][n] = src[4 * n]; }
#pragma unroll
          for (int rr = 0; rr < 2; ++rr) { q[rr] = 0.f;
#pragma unroll
              for (int n = 0; n < 16; ++n) q[rr] += v[rr][n] * v[rr][n]; }
#pragma unroll
          for (int o = 1; o < 64; o <<= 1) { q[0] += __shfl_xor(q[0], o); q[1] += __shfl_xor(q[1], o); }
#pragma unroll
          for (int rr = 0; rr < 2; ++rr) { const int e = r0 + rr;
              const float rms = sqrtf(q[rr] * (1.0f / 1024.0f)); const float sc = rms > 0.f ? 2.0f / rms : 0.f;
              unsigned w0 = 0u, w1 = 0u;
              w0 = __builtin_amdgcn_cvt_scalef32_pk_fp4_f32(w0, v[rr][0] * sc, v[rr][1] * sc, 1.0f, 0); w0 = __builtin_amdgcn_cvt_scalef32_pk_fp4_f32(w0, v[rr][2] * sc, v[rr][3] * sc, 1.0f, 1);
              w0 = __builtin_amdgcn_cvt_scalef32_pk_fp4_f32(w0, v[rr][4] * sc, v[rr][5] * sc, 1.0f, 2); w0 = __builtin_amdgcn_cvt_scalef32_pk_fp4_f32(w0, v[rr][6] * sc, v[rr][7] * sc, 1.0f, 3);
              w1 = __builtin_amdgcn_cvt_scalef32_pk_fp4_f32(w1, v[rr][8] * sc, v[rr][9] * sc, 1.0f, 0); w1 = __builtin_amdgcn_cvt_scalef32_pk_fp4_f32(w1, v[rr][10] * sc, v[rr][11] * sc, 1.0f, 1);
              w1 = __builtin_amdgcn_cvt_scalef32_pk_fp4_f32(w1, v[rr][12] * sc, v[rr][13] * sc, 1.0f, 2); w1 = __builtin_amdgcn_cvt_scalef32_pk_fp4_f32(w1, v[rr][14] * sc, v[rr][15] * sc, 1.0f, 3);
              ((GAS v2u*)(P.ws + WS_V))[(size_t)e * 64 + (cb >> 1) * 32 + 2 * ci + (cb & 1)] = (v2u){w0, w1};
              if (lane == 0) ((float*)(P.ws + WS_SV))[e] = rms * 0.5f; }
      } }
    { const GAS f32x4* sp = (const GAS f32x4*)P.p; GAS v4u* dp = (GAS v4u*)(P.ws + WS_PB);
      for (int i0 = gt; i0 < M * PLED / 8; i0 += 4 * NGT) {
          f32x4 a[4], b[4];
#pragma unroll
          for (int q = 0; q < 4; ++q) { const int i = i0 + q * NGT; if (i < M * PLED / 8) { a[q] = sp[2 * (size_t)i]; b[q] = sp[2 * (size_t)i + 1]; } }
#pragma unroll
          for (int q = 0; q < 4; ++q) { const int i = i0 + q * NGT; if (i < M * PLED / 8) { v4u o; o.x = pk2(a[q].x, a[q].y); o.y = pk2(a[q].z, a[q].w); o.z = pk2(b[q].x, b[q].y); o.w = pk2(b[q].z, b[q].w); dp[i] = o; } }
      }
      const GAS f32x4* sk = (const GAS f32x4*)P.sub_keys; GAS v4u* dk = (GAS v4u*)(P.ws + WS_KEYS);
      for (int i = gt; i < 16 * 128 * 128 / 8; i += NGT) { const f32x4 a = sk[2 * (size_t)i], b = sk[2 * (size_t)i + 1]; v4u o; o.x = pk2(a.x, a.y); o.y = pk2(a.z, a.w); o.z = pk2(b.x, b.y); o.w = pk2(b.z, b.w); dk[i] = o; } }
    { float* RSX = (float*)(P.ws + WS_RSX); bf16* XB = (bf16*)(P.ws + WS_XB);
      for (int m0 = 4 * gw; m0 < M; m0 += 4 * NGW) {
          f32x4 v[4][4]; float sq[4];
#pragma unroll
          for (int r = 0; r < 4; ++r) { const GAS f32x4* xr = (const GAS f32x4*)(P.x + (size_t)(m0 + r) * D) + lane;
#pragma unroll
              for (int j = 0; j < 4; ++j) v[r][j] = xr[64 * j]; }
#pragma unroll
          for (int r = 0; r < 4; ++r) { sq[r] = 0.f;
#pragma unroll
              for (int j = 0; j < 4; ++j) sq[r] += (v[r][j].x * v[r][j].x + v[r][j].y * v[r][j].y) + (v[r][j].z * v[r][j].z + v[r][j].w * v[r][j].w); }
#pragma unroll
          for (int o = 1; o < 64; o <<= 1) {
#pragma unroll
              for (int r = 0; r < 4; ++r) sq[r] += __shfl_xor(sq[r], o); }
#pragma unroll
          for (int r = 0; r < 4; ++r) { if (lane == 0) RSX[m0 + r] = sq[r];
              GAS unsigned long long* o8 = (GAS unsigned long long*)(XB + (size_t)(m0 + r) * D) + lane;
#pragma unroll
              for (int j = 0; j < 4; ++j) o8[64 * j] = (unsigned long long)pk2(v[r][j].x, v[r][j].y) | ((unsigned long long)pk2(v[r][j].z, v[r][j].w) << 32); }
      } }
}
__device__ __forceinline__ void p0b_phase(const Ptrs& P, LAS unsigned char* lds, int vcu, int G, int wave, int lane) {
    const int gw = vcu * NWAVES + wave, NGW = G * NWAVES; LAS float* scr = (LAS float*)(lds + wave * 16384);
    for (int it = gw; it < 16 * 16; it += NGW) p0_transpose_item((const float*)(P.ws + WS_WF), 512, P.g_mix, 1024, (bf16*)(P.ws + WS_WIN), 1536, 16, scr, it, lane);
}

template <int HALF>
__device__ __forceinline__ void pool_chunk(const unsigned* col, unsigned* mx, int t0, int s0) {
    constexpr int TC = 32, NV = TC + 2 * HALF;
    float v0[NV], v1[NV];
#pragma unroll
    for (int i = 0; i < NV; ++i) {
        const int s = s0 - HALF + i; const bool ok = (s >= 0) && (s < SEQ);
        const unsigned w = col[(size_t)(ok ? (t0 - HALF + i) : t0) * 1024];
        v0[i] = ok ? bf_lo(w) : 0.f; v1[i] = ok ? bf_hi(w) : 0.f;
    }
    float S0 = 0.f, S1 = 0.f;
#pragma unroll
    for (int j = 0; j < 2 * HALF; ++j) { S0 += v0[j]; S1 += v1[j]; }
#pragma unroll
    for (int i = 0; i < TC; ++i) {
        const int s = s0 + i; const int lo = (s - HALF) > 0 ? (s - HALF) : 0, hi = (s + HALF) < SEQ ? (s + HALF) : SEQ;
        const float inv = 1.0f / (float)(hi - lo);
        mx[(size_t)(t0 + i) * 512] = pk2(S0 * inv - v0[i + HALF], S1 * inv - v1[i + HALF]);
        if (i + 1 < TC) { S0 += v0[i + 2 * HALF] - v0[i]; S1 += v1[i + 2 * HALF] - v1[i]; }
    }
}
__device__ __forceinline__ void p2_phase(const Ptrs& P, int vcu, int G, int tid, int wave) {
    const unsigned* PR = (const unsigned*)(P.ws + WS_PROJ);
    unsigned* MX = (unsigned*)(P.ws + WS_MIX);
    constexpr int TC = 32;
    for (int ck = vcu; ck < M / TC; ck += G) {
        const int t0 = ck * TC, s0 = t0 & (SEQ - 1);
        if (tid < 256) {
            const unsigned* col = PR + 768 + tid; unsigned* mx = MX + 256 + tid;
            if (wave == 0) pool_chunk<1>(col, mx, t0, s0); else if (wave == 1) pool_chunk<2>(col, mx, t0, s0); else if (wave == 2) pool_chunk<4>(col, mx, t0, s0); else pool_chunk<8>(col, mx, t0, s0);
        } else {
            const int cp = tid - 256;
            const unsigned* bcol = PR + cp; const unsigned* ccol = PR + 256 + cp; const unsigned* vcol = PR + 512 + cp;
            const float w00 = P.conv_w[2 * cp], w01 = P.conv_w[2 * cp + 1], w10 = P.conv_w[512 + 2 * cp], w11 = P.conv_w[512 + 2 * cp + 1], w20 = P.conv_w[1024 + 2 * cp], w21 = P.conv_w[1024 + 2 * cp + 1];
            float z0[TC + 2], z1[TC + 2]; unsigned bw[TC];
#pragma unroll
            for (int i = 0; i < TC + 2; ++i) {
                const int s = s0 - 1 + i; const bool ok = (s >= 0) && (s < SEQ); const size_t t = (size_t)(ok ? (t0 - 1 + i) : t0) * 1024;
                const unsigned c = ccol[t], v = vcol[t];
                z0[i] = ok ? bf_lo(c) * bf_lo(v) : 0.f; z1[i] = ok ? bf_hi(c) * bf_hi(v) : 0.f;
            }
#pragma unroll
            for (int i = 0; i < TC; ++i) bw[i] = bcol[(size_t)(t0 + i) * 1024];
#pragma unroll
            for (int i = 0; i < TC; ++i) {
                const float y0 = w00 * z0[i] + w10 * z0[i + 1] + w20 * z0[i + 2], y1 = w01 * z1[i] + w11 * z1[i + 1] + w21 * z1[i + 2];
                MX[(size_t)(t0 + i) * 512 + cp] = pk2(bf_lo(bw[i]) * y0, bf_hi(bw[i]) * y1);
            }
        }
    }
}

__device__ __forceinline__ float fmax_s(float a, float b) { float r; asm("v_max_f32_e32 %0, %1, %2" : "=v"(r) : "v"(a), "v"(b)); return r; }
__device__ __forceinline__ float fmin_s(float a, float b) { float r; asm("v_min_f32_e32 %0, %1, %2" : "=v"(r) : "v"(a), "v"(b)); return r; }
#define CE_DESC(a, b) do { const float _t = fmax_s(a, b); b = fmin_s(a, b); a = _t; } while (0)
#define CE_ASC(a, b)  do { const float _t = fmin_s(a, b); b = fmax_s(a, b); a = _t; } while (0)
__device__ __forceinline__ void sort16_desc(float* a) {
#pragma unroll
    for (int k = 2; k <= 16; k <<= 1)
#pragma unroll
        for (int j = k >> 1; j > 0; j >>= 1)
#pragma unroll
            for (int i = 0; i < 16; ++i) { const int l = i ^ j; if (l > i) { if ((i & k) == 0) CE_DESC(a[i], a[l]); else CE_ASC(a[i], a[l]); } }
}
__device__ __forceinline__ void merge16_desc(float* a) {
#pragma unroll
    for (int j = 8; j > 0; j >>= 1)
#pragma unroll
        for (int i = 0; i < 16; ++i) { const int l = i ^ j; if (l > i) CE_DESC(a[i], a[l]); }
}
__device__ __forceinline__ void top16_merge(float* a, const float* b) {
#pragma unroll
    for (int i = 0; i < 16; ++i) a[i] = fmax_s(a[i], b[15 - i]);
    merge16_desc(a);
}
__device__ __forceinline__ void top16_of_64(float* v) {
    sort16_desc(v); sort16_desc(v + 16); sort16_desc(v + 32); sort16_desc(v + 48);
    top16_merge(v, v + 16); top16_merge(v + 32, v + 48); top16_merge(v, v + 32);
}
__device__ __forceinline__ unsigned key_lookup(unsigned long long lo, unsigned long long hi, unsigned i) {
    const unsigned long long v = (i & 8u) ? hi : lo;
    return (unsigned)(v >> ((i & 7u) * 8u)) & 0x7fu;
}

constexpr int KROW = 272;
__device__ __forceinline__ void score_phase(const Ptrs& P, LAS unsigned char* lds, int bid, int G, int tid, int wave, int lane) {
    const bf16* Q = (const bf16*)(P.ws + WS_PROJ); const bf16* KEYS = (const bf16*)(P.ws + WS_KEYS); const float* RS1 = (const float*)(P.ws + WS_RS1);
    int* EIDX = (int*)(P.ws + WS_EIDX); float* GATE = (float*)(P.ws + WS_GATE);
    const int l31 = lane & 31, hi = lane >> 5;
    int cur_h = -1;
    for (int u = bid; u < (M / 256) * 8; u += G) {
        const int h = u & 7, tile = u >> 3;
        if (h != cur_h) {
            __syncthreads();
#pragma unroll
            for (int i = 0; i < 8; ++i) { const int q = tid + 512 * i, row = q >> 4, ch = q & 15;
                const v4u val = *(const GAS v4u*)(KEYS + ((size_t)(h * 256 + row)) * 128 + ch * 8);
                *(LAS v4u*)(lds + row * KROW + ch * 16) = val; }
            __syncthreads();
            cur_h = h;
        }
        const int tok = tile * 256 + wave * 32 + l31;
        float T0[16], T1[16];
#pragma unroll
        for (int p = 0; p < 2; ++p) {
            f32x16 acc[4];
#pragma unroll
            for (int kb = 0; kb < 4; ++kb)
#pragma unroll
                for (int r = 0; r < 16; ++r) acc[kb][r] = 0.f;
            const bf16* qp = Q + (size_t)tok * 2048 + h * 256 + p * 128 + hi * 8;
            bf16x8 bq[8];
#pragma unroll
            for (int ks = 0; ks < 8; ++ks) bq[ks] = *(const GAS bf16x8*)(qp + ks * 16);
#pragma unroll
            for (int ks = 0; ks < 8; ++ks)
#pragma unroll
                for (int kb = 0; kb < 4; ++kb) {
                    const bf16x8 ak = *(const LAS bf16x8*)(lds + (p * 128 + kb * 32 + l31) * KROW + (ks * 16 + hi * 8) * 2);
                    acc[kb] = __builtin_amdgcn_mfma_f32_32x32x16_bf16(ak, bq[ks], acc[kb], 0, 0, 0);
                }
            float v[64];
#pragma unroll
            for (int kb = 0; kb < 4; ++kb)
#pragma unroll
                for (int r = 0; r < 16; ++r) v[kb * 16 + r] = __uint_as_float((__float_as_uint(acc[kb][r]) & 0xffffff80u) | (unsigned)(kb * 32 + (r & 3) + 8 * (r >> 2)));
            top16_of_64(v);
            const unsigned hb = (unsigned)hi << 2;
#pragma unroll
            for (int i = 0; i < 16; ++i) v[i] = __uint_as_float(__float_as_uint(v[i]) | hb);
            float c[16];
#pragma unroll
            for (int i = 0; i < 16; ++i) c[i] = fmax_s(v[i], __shfl_xor(v[15 - i], 32));
            merge16_desc(c);
#pragma unroll
            for (int i = 0; i < 16; ++i) { if (p == 0) T0[i] = c[i]; else T1[i] = c[i]; }
        }
        float f0[16], f1[16];
        unsigned long long K0lo = 0ull, K0hi = 0ull, K1lo = 0ull, K1hi = 0ull;
#pragma unroll
        for (int b = 0; b < 8; ++b) {
            K0lo |= (unsigned long long)(__float_as_uint(T0[b]) & 0x7fu) << (8 * b); K0hi |= (unsigned long long)(__float_as_uint(T0[8 + b]) & 0x7fu) << (8 * b);
            K1lo |= (unsigned long long)(__float_as_uint(T1[b]) & 0x7fu) << (8 * b); K1hi |= (unsigned long long)(__float_as_uint(T1[8 + b]) & 0x7fu) << (8 * b);
        }
#pragma unroll
        for (int i = 0; i < 16; ++i) { f0[i] = __uint_as_float(__float_as_uint(T0[i]) & 0xffffff80u); f1[i] = __uint_as_float(__float_as_uint(T1[i]) & 0xffffff80u); }
        float cd[64]; int n = 0;
#pragma unroll
        for (int i = 0; i < 16; ++i)
#pragma unroll
            for (int j = 0; j < 16; ++j)
                if ((i + 1) * (j + 1) <= 16) { cd[n] = __uint_as_float((__float_as_uint(f0[i] + f1[j]) & 0xffffff00u) | (unsigned)(i * 16 + j)); ++n; }
#pragma unroll
        for (int q = 50; q < 64; ++q) cd[q] = __uint_as_float(0xff800000u);
        top16_of_64(cd);
        float rs = 0.f;
        { const GAS f32x4* rp = (const GAS f32x4*)(RS1 + (size_t)tok * 16);
#pragma unroll
          for (int i = 0; i < 4; ++i) { const f32x4 a = rp[i]; rs += (a.x + a.y) + (a.z + a.w); } }
        const float rstd = __builtin_amdgcn_rsqf(rs * (1.0f / 1024.0f) + EPS);
        int eidx[16]; float gt_[16]; float z0 = 0.f, sum = 0.f;
#pragma unroll
        for (int k = 0; k < 16; ++k) {
            const unsigned wb = __float_as_uint(cd[k]); const unsigned i = (wb >> 4) & 15u, j = wb & 15u;
            eidx[k] = (int)(key_lookup(K0lo, K0hi, i) * 128u + key_lookup(K1lo, K1hi, j));
            const float z = __uint_as_float(wb & 0xffffff00u) * rstd;
            if (k == 0) z0 = z;
            gt_[k] = __expf(z - z0); sum += gt_[k];
        }
        const float inv = 1.0f / sum;
        if (hi == 0) { GAS i32x4* ep = (GAS i32x4*)(EIDX + (size_t)tok * 128 + h * 16);
#pragma unroll
            for (int q = 0; q < 4; ++q) ep[q] = (i32x4){eidx[4 * q], eidx[4 * q + 1], eidx[4 * q + 2], eidx[4 * q + 3]};
        } else { GAS f32x4* gp = (GAS f32x4*)(GATE + (size_t)tok * 128 + h * 16);
#pragma unroll
            for (int q = 0; q < 4; ++q) gp[q] = (f32x4){gt_[4 * q] * inv, gt_[4 * q + 1] * inv, gt_[4 * q + 2] * inv, gt_[4 * q + 3] * inv};
        }
    }
}

__device__ __forceinline__ float gelu_tanh(float x) {
    const float y = 1.5957691216057308f * (x + 0.044715f * x * x * x);
    return x / (1.0f + __expf(-y));
}
typedef int v8i __attribute__((ext_vector_type(8)));
#define PEER_MFMA(a, b, c) __builtin_amdgcn_mfma_scale_f32_16x16x128_f8f6f4(a, b, c, 4  , 0  , 0, 0x7F7F7F7F, 0, 0x7F7F7F7F)
__device__ __forceinline__ void peer_dots_phase(const Ptrs& P, LAS unsigned char* lds, int vcu, int G, int wave, int lane) {
    const int gw = vcu * NWAVES + wave, NGW = G * NWAVES;
    const bf16* HB = (const bf16*)(P.ws + WS_HB); float* CF = (float*)(P.ws + WS_CF);
    const int* EIDX = (const int*)(P.ws + WS_EIDX); const float* GATE = (const float*)(P.ws + WS_GATE);
    const unsigned char* U4 = P.ws + WS_U;
    const float* SU = (const float*)(P.ws + WS_SU); const float* SV = (const float*)(P.ws + WS_SV);
    LAS unsigned char* xl = lds + 65536 + wave * 1024;
    LAS unsigned char* tb = lds + wave * 8192;
    const int lr = lane >> 5, lp = lane & 31;
    const int li = lane & 15, lq = lane >> 4;
    const int kl = 4 * lq + (li & 3);
    int t = gw; if (t >= M) return;
    int ei0 = EIDX[(size_t)t * 128 + lane], ei1 = EIDX[(size_t)t * 128 + 64 + lane];
    float gg0 = GATE[(size_t)t * 128 + lane], gg1 = GATE[(size_t)t * 128 + 64 + lane];
    v2u hrow[4];
    { const GAS v2u* hp = (const GAS v2u*)(HB + (size_t)t * 1024) + lane;
#pragma unroll
      for (int j = 0; j < 4; ++j) hrow[j] = hp[64 * j]; }
    v4u uw[8];
#pragma unroll
    for (int v = 0; v < 8; ++v) { const int e = __shfl(ei0, 2 * v + lr); uw[v] = *(const GAS v4u*)(U4 + (size_t)e * 512 + 16 * lp); }
    for (; t < M; t += NGW) {
        const int tn = (t + NGW < M) ? t + NGW : t;
        f32x2 x[8]; float ss = 0.f;
#pragma unroll
        for (int j = 0; j < 4; ++j) { const unsigned wa = hrow[j].x, wb = hrow[j].y; x[2 * j] = (f32x2){bf_lo(wa), bf_hi(wa)}; x[2 * j + 1] = (f32x2){bf_lo(wb), bf_hi(wb)};
            ss += (x[2 * j].x * x[2 * j].x + x[2 * j].y * x[2 * j].y) + (x[2 * j + 1].x * x[2 * j + 1].x + x[2 * j + 1].y * x[2 * j + 1].y); }
        ss = wave_sum(ss);
        const float rstd = __builtin_amdgcn_rsqf(ss * (1.0f / 1024.0f) + EPS);
        { const float sx = 16.0f * rstd;
#pragma unroll
          for (int j = 0; j < 4; ++j) { int w = __builtin_amdgcn_cvt_pk_fp8_f32(x[2 * j].x * sx, x[2 * j].y * sx, 0, false); w = __builtin_amdgcn_cvt_pk_fp8_f32(x[2 * j + 1].x * sx, x[2 * j + 1].y * sx, w, true);
              const int n = 4 * lane + 256 * j, sN = n >> 7, nn = n & 127, hN = nn >> 6, qN = (nn & 63) >> 4, jN = nn & 15;
              *(LAS unsigned*)(xl + 128 * sN + 32 * qN + 16 * hN + jN) = (unsigned)w; }
          asm volatile("s_waitcnt lgkmcnt(0)" ::: "memory"); }
        v8i xb[8];
#pragma unroll
        for (int sI = 0; sI < 8; ++sI) { const v4u b0 = *(const LAS v4u*)(xl + 128 * sI + 32 * lq), b1 = *(const LAS v4u*)(xl + 128 * sI + 32 * lq + 16);
            xb[sI] = (v8i){(int)b0.x, (int)b0.y, (int)b0.z, (int)b0.w, (int)b1.x, (int)b1.y, (int)b1.z, (int)b1.w}; }
        const int nei0 = EIDX[(size_t)tn * 128 + lane], nei1 = EIDX[(size_t)tn * 128 + 64 + lane];
        const float ngg0 = GATE[(size_t)tn * 128 + lane], ngg1 = GATE[(size_t)tn * 128 + 64 + lane];
        { const GAS v2u* hn = (const GAS v2u*)(HB + (size_t)tn * 1024) + lane;
#pragma unroll
          for (int j = 0; j < 4; ++j) hrow[j] = hn[64 * j]; }
        for (int hq = 0; hq < 8 * REPS(7); ++hq) { const int hh = hq & 7;
            const int ereg = hh < 4 ? ei0 : ei1; const float greg = hh < 4 ? gg0 : gg1; const int lb = (hh & 3) * 16;
            const int el = __shfl(ereg, lb + kl);
            const float su = SU[el], sv = SV[el];
#pragma unroll
            for (int v = 0; v < 8; ++v) { const int r = 2 * v + lr; *(LAS v4u*)(tb + 512 * r + 16 * (lp ^ r)) = uw[v]; }
            __builtin_amdgcn_sched_barrier(0);
            { const bool lasth = (hq == 8 * REPS(7) - 1); const int hn = (hh + 1) & 7;
              const int nreg = lasth ? nei0 : (hn < 4 ? ei0 : ei1); const int nlb = (hn & 3) * 16;
#pragma unroll
              for (int v = 0; v < 8; ++v) { const int e = __shfl(nreg, nlb + 2 * v + lr); uw[v] = *(const GAS v4u*)(U4 + (size_t)e * 512 + 16 * lp); } }
            __builtin_amdgcn_sched_barrier(0);
            f32x4 acc = {0.f, 0.f, 0.f, 0.f};
#pragma unroll
            for (int sI = 0; sI < 8; ++sI) { const v4u af = *(const LAS v4u*)(tb + 512 * li + 16 * ((4 * sI + lq) ^ li));
                const v8i av = {(int)af.x, (int)af.y, (int)af.z, (int)af.w, 0, 0, 0, 0}; acc = PEER_MFMA(av, xb[sI], acc); }
            const int rsel = li & 3;
            const float d = rsel == 0 ? acc[0] : (rsel == 1 ? acc[1] : (rsel == 2 ? acc[2] : acc[3]));
            const float gk = __shfl(greg, lb + kl);
            const float cf = gk * gelu_tanh(d * su * (1.0f / 16.0f)) * sv * 1024.0f;
            if (li < 4) CF[(size_t)t * 128 + hh * 16 + kl] = cf;
        }
        ei0 = nei0; ei1 = nei1; gg0 = ngg0; gg1 = ngg1;
    }
}
__device__ __forceinline__ void peer_sum_phase(const Ptrs& P, int vcu, int G, int wave, int lane) {
    const int gw = vcu * NWAVES + wave, NGW = G * NWAVES;
    bf16* HB = (bf16*)(P.ws + WS_HB); float* RS2 = (float*)(P.ws + WS_RS2); const float* CF = (const float*)(P.ws + WS_CF);
    const int* EIDX = (const int*)(P.ws + WS_EIDX); const unsigned char* V4 = P.ws + WS_V;
    const int li = lane & 15, lq = lane >> 4;
    const unsigned bsh = 8u * (unsigned)(li & 3); const int breg = li >> 2;
    int t = gw; if (t >= M) return;
    int ei0 = EIDX[(size_t)t * 128 + lane], ei1 = EIDX[(size_t)t * 128 + 64 + lane];
    float cf0 = CF[(size_t)t * 128 + lane], cf1 = CF[(size_t)t * 128 + 64 + lane];
    v2u hrow[4];
    { const GAS v2u* hp = (const GAS v2u*)(HB + (size_t)t * 1024) + lane;
#pragma unroll
      for (int j = 0; j < 4; ++j) hrow[j] = hp[64 * j]; }
    v4u va[2][2], vb[2][2];
#pragma unroll
    for (int g8 = 0; g8 < 2; ++g8) {
        const int eA = __shfl(ei0, 8 * g8 + 2 * lq), eB = __shfl(ei0, 8 * g8 + 2 * lq + 1);
        const GAS v4u* pa = (const GAS v4u*)(V4 + (size_t)eA * 512 + 16 * li); const GAS v4u* pb = (const GAS v4u*)(V4 + (size_t)eB * 512 + 16 * li);
        va[g8][0] = pa[0]; va[g8][1] = pa[16]; vb[g8][0] = pb[0]; vb[g8][1] = pb[16];
    }
    for (; t < M; t += NGW) {
        const int tn = (t + NGW < M) ? t + NGW : t;
        const int nei0 = EIDX[(size_t)tn * 128 + lane], nei1 = EIDX[(size_t)tn * 128 + 64 + lane];
        const float ncf0 = CF[(size_t)tn * 128 + lane], ncf1 = CF[(size_t)tn * 128 + 64 + lane];
        f32x4 oacc[4];
#pragma unroll
        for (int b = 0; b < 4; ++b) oacc[b] = (f32x4){0.f, 0.f, 0.f, 0.f};
        for (int hq = 0; hq < 8 * REPS(11); ++hq) { const int hh = hq & 7;
            const float creg = hh < 4 ? cf0 : cf1; const int lb = (hh & 3) * 16;
            v8i bv[2];
#pragma unroll
            for (int g8 = 0; g8 < 2; ++g8) {
                float cA = __shfl(creg, lb + 8 * g8 + lq), cB = __shfl(creg, lb + 8 * g8 + 4 + lq);
                cA = fminf(fmaxf(cA, -448.0f), 448.0f); cB = fminf(fmaxf(cB, -448.0f), 448.0f);
                const unsigned pk = (unsigned)__builtin_amdgcn_cvt_pk_fp8_f32(cA, cB, 0, false);
                const unsigned wA = (pk & 0xffu) << bsh, wB = ((pk >> 8) & 0xffu) << bsh;
                bv[g8] = (v8i){breg == 0 ? (int)wA : 0, breg == 1 ? (int)wA : 0, breg == 2 ? (int)wA : 0, breg == 3 ? (int)wA : 0,
                               breg == 0 ? (int)wB : 0, breg == 1 ? (int)wB : 0, breg == 2 ? (int)wB : 0, breg == 3 ? (int)wB : 0};
            }
#pragma unroll
            for (int g8 = 0; g8 < 2; ++g8) {
                { const v8i a0 = {(int)va[g8][0].x, (int)va[g8][0].y, (int)vb[g8][0].x, (int)vb[g8][0].y, 0, 0, 0, 0}; oacc[0] = PEER_MFMA(a0, bv[g8], oacc[0]); }
                { const v8i a1 = {(int)va[g8][0].z, (int)va[g8][0].w, (int)vb[g8][0].z, (int)vb[g8][0].w, 0, 0, 0, 0}; oacc[1] = PEER_MFMA(a1, bv[g8], oacc[1]); }
                { const v8i a2 = {(int)va[g8][1].x, (int)va[g8][1].y, (int)vb[g8][1].x, (int)vb[g8][1].y, 0, 0, 0, 0}; oacc[2] = PEER_MFMA(a2, bv[g8], oacc[2]); }
                { const v8i a3 = {(int)va[g8][1].z, (int)va[g8][1].w, (int)vb[g8][1].z, (int)vb[g8][1].w, 0, 0, 0, 0}; oacc[3] = PEER_MFMA(a3, bv[g8], oacc[3]); }
            }
            __builtin_amdgcn_sched_barrier(0);
            { const bool lasth = (hq == 8 * REPS(11) - 1); const int hn = (hh + 1) & 7;
              const int nreg = lasth ? nei0 : (hn < 4 ? ei0 : ei1); const int nlb = (hn & 3) * 16;
#pragma unroll
              for (int g8 = 0; g8 < 2; ++g8) {
                  const int eA = __shfl(nreg, nlb + 8 * g8 + 2 * lq), eB = __shfl(nreg, nlb + 8 * g8 + 2 * lq + 1);
                  const GAS v4u* pa = (const GAS v4u*)(V4 + (size_t)eA * 512 + 16 * li); const GAS v4u* pb = (const GAS v4u*)(V4 + (size_t)eB * 512 + 16 * li);
                  va[g8][0] = pa[0]; va[g8][1] = pa[16]; vb[g8][0] = pb[0]; vb[g8][1] = pb[16];
              } }
            __builtin_amdgcn_sched_barrier(0);
        }
        const float osc = (REPS(11) == 2 ? 0.5f : 1.0f) * (1.0f / 1024.0f);
        float s2 = 0.f;
        GAS v2u* hb = (GAS v2u*)(HB + (size_t)t * 1024) + lane;
#pragma unroll
        for (int j = 0; j < 4; ++j) { const unsigned wa = hrow[j].x, wb = hrow[j].y;
            const f32x2 o0 = (f32x2){bf_lo(wa) + oacc[j][0] * osc, bf_hi(wa) + oacc[j][1] * osc}, o1 = (f32x2){bf_lo(wb) + oacc[j][2] * osc, bf_hi(wb) + oacc[j][3] * osc};
            hb[64 * j] = (v2u){pk2(o0.x, o0.y), pk2(o1.x, o1.y)};
            s2 += (o0.x * o0.x + o0.y * o0.y) + (o1.x * o1.x + o1.y * o1.y); }
        s2 = wave_sum(s2);
        if (lane == 0) RS2[t] = s2;
        { const GAS v2u* hn = (const GAS v2u*)(HB + (size_t)tn * 1024) + lane;
#pragma unroll
          for (int j = 0; j < 4; ++j) hrow[j] = hn[64 * j]; }
        ei0 = nei0; ei1 = nei1; cf0 = ncf0; cf1 = ncf1;
    }
}

__device__ __forceinline__ void final_phase(const Ptrs& P, int vcu, int G, int wave, int lane) {
    const int gw = vcu * NWAVES + wave, NGW = G * NWAVES; const float* RS3 = (const float*)(P.ws + WS_RS3);
    const GAS f32x4* gf = (const GAS f32x4*)P.g_final + lane;
    f32x4 g[4];
#pragma unroll
    for (int j = 0; j < 4; ++j) g[j] = gf[64 * j];
    for (int m = gw; m < M; m += NGW) {
        GAS f32x4* xr = (GAS f32x4*)(P.out + (size_t)m * D) + lane;
        float rs = 0.f; { const GAS f32x4* rp = (const GAS f32x4*)(RS3 + (size_t)m * 16);
#pragma unroll
            for (int i = 0; i < 4; ++i) { const f32x4 a = rp[i]; rs += (a.x + a.y) + (a.z + a.w); } }
        const float rstd = __builtin_amdgcn_rsqf(rs * (1.0f / 1024.0f) + EPS);
#pragma unroll
        for (int j = 0; j < 4; ++j) { const f32x4 v = xr[64 * j]; xr[64 * j] = v * rstd * g[j]; }
    }
}

struct Args { const float* in[17]; float* out; unsigned char* ws; int ph_lo, ph_hi; };
#ifndef PG8_SP2
#define PG8_SP2 true
#endif
#ifndef PG8_ALIGN
#define PG8_ALIGN true
#endif
__global__ void __launch_bounds__(NWAVES * 64, 2) mega_fwd(Args args) {
    extern __shared__ __attribute__((aligned(16))) unsigned char lds_raw[];
    LAS unsigned char* lds = (LAS unsigned char*)lds_raw;
    volatile LAS unsigned* MISC = (volatile LAS unsigned*)(lds + MISC_OFF);
    const int tid = threadIdx.x, lane = tid & 63, wave = __builtin_amdgcn_readfirstlane(tid >> 6);
    const int G = gridDim.x, bx = blockIdx.x; const int vcu = (G % 8 == 0) ? (bx % 8) * (G / 8) + bx / 8 : bx;
    Ptrs P;
    P.x = args.in[0]; P.p = args.in[1]; P.g_mix = args.in[2]; P.w_in = args.in[3]; P.conv_w = args.in[4]; P.pool_w = args.in[5]; P.pool_scale = args.in[6]; P.w_o = args.in[7];
    P.g_ffn = args.in[8]; P.w_q = args.in[9]; P.sub_keys = args.in[10]; P.eu = args.in[11]; P.ev = args.in[12]; P.g_ple = args.in[13]; P.w_gate = args.in[14]; P.w_proj = args.in[15]; P.g_final = args.in[16];
    P.out = args.out; P.ws = args.ws;
    gu32* ctl = (gu32*)(P.ws + WS_CTL);
    for (int u = tid; u < (LDS_BYTES - LDSCTL_OFF) / 4; u += NWAVES * 64) ((LAS unsigned*)(lds + LDSCTL_OFF))[u] = 0u;
    __syncthreads();
    XcdBarrier bar; bar.bar = (unsigned*)(ctl + CW_BAR); bar.x = 0; bar.st = nullptr;
    if (!MK_PER_PHASE) bar = xcd_barrier_post((unsigned*)(ctl + CW_BAR), MISC + 8);
    const int lo = args.ph_lo, hi = args.ph_hi;
#define IN(k) (lo <= (k) && (k) < hi)
#define SEAM(k) do { if (IN(k) && IN((k) + 1)) xcd_barrier(bar); } while (0)
    pg8::bf16_t* const WIN = (pg8::bf16_t*)(P.ws + WS_WIN); pg8::bf16_t* const WO = (pg8::bf16_t*)(P.ws + WS_WO); pg8::bf16_t* const WQ = (pg8::bf16_t*)(P.ws + WS_WQ);
    pg8::bf16_t* const WG = (pg8::bf16_t*)(P.ws + WS_WG); pg8::bf16_t* const WP = (pg8::bf16_t*)(P.ws + WS_WP);
    pg8::bf16_t* const XB = (pg8::bf16_t*)(P.ws + WS_XB); pg8::bf16_t* const PL = XB; pg8::bf16_t* const PROJ = (pg8::bf16_t*)(P.ws + WS_PROJ); pg8::bf16_t* const QB = PROJ;
    pg8::bf16_t* const MIX = (pg8::bf16_t*)(P.ws + WS_MIX); pg8::bf16_t* const HB = (pg8::bf16_t*)(P.ws + WS_HB); pg8::bf16_t* const PB = (pg8::bf16_t*)(P.ws + WS_PB);

    if (IN(0)) { for (int rep = 0; rep < REPS(1); ++rep) { p0a_phase(P, lds, vcu, G, tid, wave, lane); SEAM(0); } }
    if (IN(1)) { p0b_phase(P, lds, vcu, G, wave, lane); SEAM(1); }
    if (IN(2)) {
        pg8::Gemm g{XB, WIN, M, NPROJ, D}; pg8::StaticOrder S; S.init(M, NPROJ, G, bx);
        EpiBf16Row E{PROJ, NPROJ, (const float*)(P.ws + WS_RSX)};
        for (int rep = 0; rep < REPS(2); ++rep) { pg8::gemm_phase<EpiBf16Row, pg8::StaticOrder, PG8_ALIGN, PG8_SP2>(lds, g, S, E);
        SEAM(2); }
    }
    if (IN(3)) {
        for (int rep = 0; rep < REPS(3); ++rep) p2_phase(P, vcu, G, tid, wave);
        pg8::Gemm g{PB, WP, M, D, PLED}; pg8::StaticOrder S; S.init(M, D, G, bx);
        EpiBf16Row E{PL, D, nullptr};
        for (int rep = 0; rep < REPS(8); ++rep) pg8::gemm_phase<EpiBf16Row, pg8::StaticOrder, PG8_ALIGN, PG8_SP2>(lds, g, S, E);
        SEAM(3);
    }
    if (IN(4)) {
        pg8::Gemm g{MIX, WO, M, D, D}; pg8::StaticOrder S; S.init(M, D, G, bx);
        EpiH1 E{P.x, HB, (float*)(P.ws + WS_RS1)};
        for (int rep = 0; rep < REPS(4); ++rep) { pg8::gemm_phase<EpiH1, pg8::StaticOrder, PG8_ALIGN, PG8_SP2>(lds, g, S, E);
        SEAM(4); }
    }
    if (IN(5)) {
        pg8::Gemm g{HB, WQ, M, NQ, D}; pg8::StaticOrder S; S.init(M, NQ, G, bx);
        EpiBf16Row E{QB, NQ, nullptr};
        for (int rep = 0; rep < REPS(5); ++rep) { pg8::gemm_phase<EpiBf16Row, pg8::StaticOrder, PG8_ALIGN, PG8_SP2>(lds, g, S, E);
        SEAM(5); }
    }
    if (IN(6)) { for (int rep = 0; rep < REPS(6); ++rep) { score_phase(P, lds, bx, G, tid, wave, lane); SEAM(6); } }
    if (IN(7)) { peer_dots_phase(P, lds, vcu, G, wave, lane); SEAM(7); }
    if (IN(8)) { peer_sum_phase(P, vcu, G, wave, lane); SEAM(8); }
    if (IN(9)) {
        pg8::Gemm g{HB, WG, M, D, D}; pg8::StaticOrder S; S.init(M, D, G, bx);
        EpiGate E{P.out, HB, PL, (const float*)(P.ws + WS_RS2), (float*)(P.ws + WS_RS3)};
        pg8::gemm_phase<EpiGate, pg8::StaticOrder, PG8_ALIGN, PG8_SP2>(lds, g, S, E);
        SEAM(9);
    }
    if (IN(10)) { final_phase(P, vcu, G, wave, lane); }
#undef IN
#undef SEAM
}

extern "C" void kernel_launch(void* const* d_in, const int* in_sizes, int n_in, void* d_out, int out_size, void* d_ws, size_t ws_size, hipStream_t stream) {
    static int grid = 0;
    if (grid == 0) {
        if (n_in != 17 || in_sizes[0] != M * D || out_size != M * D || ws_size < WS_END) { fprintf(stderr, "kernel_launch: unexpected shapes (n_in %d, in0 %d, out %d, ws %zu); nothing launched\n", n_in, n_in > 0 ? in_sizes[0] : -1, out_size, ws_size); grid = -1; return; }
        int dev = 0, cus = 0, per_cu = 0;
        if (hipGetDevice(&dev) != hipSuccess || hipDeviceGetAttribute(&cus, hipDeviceAttributeMultiprocessorCount, dev) != hipSuccess) { fprintf(stderr, "kernel_launch: device query failed\n"); grid = -1; return; }
        if (hipFuncSetAttribute((const void*)mega_fwd, hipFuncAttributeMaxDynamicSharedMemorySize, LDS_BYTES) != hipSuccess) { fprintf(stderr, "kernel_launch: hipFuncSetAttribute failed\n"); grid = -1; return; }
        if (hipOccupancyMaxActiveBlocksPerMultiprocessor(&per_cu, (const void*)mega_fwd, NWAVES * 64, LDS_BYTES) != hipSuccess || per_cu < 1)
            fprintf(stderr, "kernel_launch: note: occupancy query reports %d workgroups per CU\n", per_cu);
        (void)hipGetLastError();
        grid = cus;
    }
    if (grid < 0) return;
    if (hipMemsetAsync((char*)d_ws + WS_CTL, 0, CTL_ZERO_BYTES, stream) != hipSuccess) { fprintf(stderr, "kernel_launch: memset failed\n"); return; }
    Args a{};
    for (int i = 0; i < 17; ++i) a.in[i] = (const float*)d_in[i];
    a.out = (float*)d_out; a.ws = (unsigned char*)d_ws;
#if MK_PER_PHASE
    for (int ph = 0; ph < NPHASES; ++ph) { a.ph_lo = ph; a.ph_hi = ph + 1; hipLaunchKernelGGL(mega_fwd, dim3(grid), dim3(NWAVES * 64), LDS_BYTES, stream, a); }
#else
    a.ph_lo = 0; a.ph_hi = NPHASES;
    hipLaunchKernelGGL(mega_fwd, dim3(grid), dim3(NWAVES * 64), LDS_BYTES, stream, a);
#endif
    const hipError_t le = hipPeekAtLastError();
    if (le != hipSuccess) fprintf(stderr, "kernel_launch: launch failed: %s\n", hipGetErrorName(le));
}
```

```cpp
#include <hip/hip_runtime.h>
#include <cstdio>
#include <cstdint>
namespace pg8 {
#define PG8_LAS __attribute__((address_space(3)))
typedef unsigned short bf16_t;
typedef short bf16x8 __attribute__((ext_vector_type(8)));
typedef float f32x4 __attribute__((ext_vector_type(4)));
typedef unsigned u32x4 __attribute__((ext_vector_type(4)));
constexpr int BM = 256, BK = 64, HALF = 128, HTB = HALF * BK * 2  , STAGE_BYTES = 8 * HTB, NXCD = 8, WGM = 8;

__host__ __device__ __forceinline__ int lds_byte(int r, int c) { const int st = (r >> 4) * 2 + (c >> 5), rr = r & 15, cc = c & 31, ob = rr * 64 + cc * 2; return st * 1024 + (ob ^ (((ob >> 9) & 1) << 5)); }
__host__ __device__ __forceinline__ void stage_rc(int b, int& R, int& C) { const int st = b / 1024, sb = b % 1024, swz = sb ^ (((sb >> 9) & 1) << 5); R = (st >> 1) * 16 + swz / 64; C = (st & 1) * 32 + (swz % 64) / 2; }
__host__ __device__ __forceinline__ int perm32(int rho) { const int n = rho >> 4, i = rho & 15; return 8 * (i >> 2) + 4 * n + (i & 3); }

struct Unit { int pm, pn; };
struct Gemm { const bf16_t* A; const bf16_t* Bt; int M, N, K; };

struct StaticOrder {
    int nM, nN, nwg, G, c;
    __host__ __device__ void init(int M, int N, int G_, int c_) { nM = M / BM; nN = N / BM; nwg = nM * nN; G = G_; c = c_; }
    __host__ __device__ bool next(int i, Unit& u) const {
        const long L = (long)i * G + c; if (L >= nwg) return false;
        int wgid = (int)L; { const int q = nwg / NXCD, r = nwg % NXCD, xcd = wgid % NXCD, off = wgid / NXCD; wgid = (xcd < r ? xcd * (q + 1) : r * (q + 1) + (xcd - r) * q) + off; }
        const int nig = WGM * nN, gid = wgid / nig, fm = gid * WGM, gsz = (nM - fm) < WGM ? (nM - fm) : WGM;
        u.pm = fm + ((wgid % nig) % gsz); u.pn = (wgid % nig) / gsz; return true;
    }
    __device__ __forceinline__ void a_ready(const Unit&) const {}
    __device__ __forceinline__ void done(const Unit&) const {}
};

__device__ __forceinline__ unsigned cvt_pk_bf16(float lo, float hi) { unsigned r; asm volatile("v_cvt_pk_bf16_f32 %0, %1, %2" : "=v"(r) : "v"(lo), "v"(hi)); return r; }
template <class Epi, class Sched, bool ALIGN_EPI = false, bool SP2 = false>
__device__ __forceinline__ void gemm_phase(PG8_LAS unsigned char* lds, const Gemm g, const Sched& S, const Epi& E) {
    const int tid = threadIdx.x, wid = __builtin_amdgcn_readfirstlane(tid >> 6), lane = tid & 63, wr = wid >> 2, wc = wid & 3, fr = lane & 15, fq = lane >> 4;
    const int K = g.K, nt = K / BK;
    unsigned voffA[2], voffB[2];
#pragma unroll
    for (int i = 0; i < 2; ++i) { int R, C; stage_rc(tid * 16 + i * 8192, R, C); const int Rb = Epi::PERM ? ((R & ~31) + perm32(R & 31)) : R;
        voffA[i] = (unsigned)(R * K + C) * 2u; voffB[i] = (unsigned)(Rb * K + C) * 2u; }
    const size_t kstep = (size_t)(BK * 2);
    const size_t hstep = (size_t)HALF * K * 2;
    const size_t tstep = 2 * hstep;
    const unsigned ldsw = (unsigned)wid * 1024u;
    const int aoff = lds_byte(wr * 64 + fr, fq * 8), boff = lds_byte(wc * 32 + fr, fq * 8);
#define PG8_SA(b, h) (((b) * 2 + (h)) * HTB)
#define PG8_SB(b, h) ((4 + (b) * 2 + (h)) * HTB)
#define PG8_STAGE(bufoff, gbase, voff) do { _Pragma("unroll") for (int _i = 0; _i < 2; ++_i) \
        __builtin_amdgcn_global_load_lds((const unsigned*)((const char*)(gbase) + (voff)[_i]), (PG8_LAS unsigned*)(lds + (bufoff) + ldsw + _i * 8192), 16, 0, 0); } while (0)
#define PG8_LDA(dst, b, h) do { _Pragma("unroll") for (int m = 0; m < 4; ++m) _Pragma("unroll") for (int k = 0; k < 2; ++k) dst[m][k] = *(const PG8_LAS bf16x8*)(lds + PG8_SA(b, h) + aoff + m * 2048 + k * 1024); } while (0)
#define PG8_LDB(dst, b, h) do { _Pragma("unroll") for (int n = 0; n < 2; ++n) _Pragma("unroll") for (int k = 0; k < 2; ++k) dst[n][k] = *(const PG8_LAS bf16x8*)(lds + PG8_SB(b, h) + boff + n * 2048 + k * 1024); } while (0)
#define PG8_MMA(ai, bj, At, Bt) do { __builtin_amdgcn_s_setprio(1); _Pragma("unroll") for (int m = 0; m < 4; ++m) _Pragma("unroll") for (int n = 0; n < 2; ++n) _Pragma("unroll") for (int k = 0; k < 2; ++k) \
        acc[ai][bj][m][n] = __builtin_amdgcn_mfma_f32_16x16x32_bf16(Bt[n][k], At[m][k], acc[ai][bj][m][n], 0, 0, 0); __builtin_amdgcn_s_setprio(0); } while (0)
#define PG8_WAIT_V(n) asm volatile("s_waitcnt vmcnt(" #n ")" ::: "memory")
#define PG8_WAIT_L(n) asm volatile("s_waitcnt lgkmcnt(" #n ")" ::: "memory")
#define PG8_BAR __builtin_amdgcn_s_barrier()
#define PG8_SCHED __builtin_amdgcn_sched_barrier(0)
    Unit cur, nxt; int ui = 0;
    if (!S.next(0, cur)) return;
    f32x4 acc[2][2][4][2];
#pragma unroll
    for (int a = 0; a < 2; ++a)
#pragma unroll
        for (int b = 0; b < 2; ++b)
#pragma unroll
            for (int m = 0; m < 4; ++m)
#pragma unroll
                for (int n = 0; n < 2; ++n) acc[a][b][m][n] = (f32x4){0.f, 0.f, 0.f, 0.f};
    bf16x8 At[4][2], B0[2][2], B1[2][2];
    const char* cA = (const char*)g.A + (size_t)cur.pm * tstep; const char* cB = (const char*)g.Bt + (size_t)cur.pn * tstep;
    S.a_ready(cur);
    if constexpr (SP2) {
        PG8_STAGE(PG8_SB(0, 0), cB, voffB); PG8_STAGE(PG8_SB(0, 1), cB + hstep, voffB); PG8_STAGE(PG8_SA(0, 0), cA, voffA); PG8_STAGE(PG8_SA(0, 1), cA + hstep, voffA);
        if (wr == 1) PG8_BAR;
        PG8_WAIT_V(2); PG8_BAR;
        PG8_STAGE(PG8_SB(1, 0), cB + kstep, voffB); PG8_STAGE(PG8_SA(1, 0), cA + kstep, voffA); PG8_STAGE(PG8_SB(1, 1), cB + hstep + kstep, voffB);
        PG8_WAIT_V(6); PG8_BAR;
    } else {
        PG8_STAGE(PG8_SB(0, 0), cB, voffB); PG8_STAGE(PG8_SA(0, 0), cA, voffA); PG8_STAGE(PG8_SB(0, 1), cB + hstep, voffB); PG8_STAGE(PG8_SA(0, 1), cA + hstep, voffA);
        if (wr == 1) PG8_BAR;
        PG8_WAIT_V(4); PG8_BAR;
        PG8_STAGE(PG8_SB(1, 0), cB + kstep, voffB); PG8_STAGE(PG8_SA(1, 0), cA + kstep, voffA); PG8_STAGE(PG8_SB(1, 1), cB + hstep + kstep, voffB);
        PG8_WAIT_V(6); PG8_BAR;
    }
    for (;;) {
        const bool has_next = S.next(ui + 1, nxt);
        const char* nA = has_next ? (const char*)g.A + (size_t)nxt.pm * tstep : cA; const char* nB = has_next ? (const char*)g.Bt + (size_t)nxt.pn * tstep : cB;
        for (int t = 0; t < nt; t += 2) {
            const bool last = (t == nt - 2);
            const char* a1 = cA + (size_t)(t + 1) * kstep;
            const char* a2 = last ? nA : cA + (size_t)(t + 2) * kstep; const char* b2 = last ? nB : cB + (size_t)(t + 2) * kstep;
            const char* a3 = a2 + kstep; const char* b3 = b2 + kstep;
            if (last && has_next) S.a_ready(nxt);
            if constexpr (SP2) {
            PG8_LDB(B0, 0, 0); PG8_LDB(B1, 0, 1); PG8_SCHED; PG8_LDA(At, 0, 0); PG8_STAGE(PG8_SA(1, 1), a1 + hstep, voffA);
            PG8_WAIT_V(8); PG8_WAIT_L(0); PG8_BAR; PG8_MMA(0, 0, At, B0); PG8_MMA(0, 1, At, B1); PG8_BAR; PG8_SCHED;
            PG8_LDA(At, 0, 1); PG8_STAGE(PG8_SB(0, 0), b2, voffB); PG8_STAGE(PG8_SB(0, 1), b2 + hstep, voffB); PG8_STAGE(PG8_SA(0, 0), a2, voffA);
            PG8_WAIT_V(8); PG8_WAIT_L(0); PG8_BAR; PG8_MMA(1, 0, At, B0); PG8_MMA(1, 1, At, B1); PG8_BAR; PG8_SCHED;
            PG8_LDB(B0, 1, 0); PG8_LDB(B1, 1, 1); PG8_SCHED; PG8_LDA(At, 1, 0); PG8_STAGE(PG8_SA(0, 1), a2 + hstep, voffA);
            PG8_WAIT_V(8); PG8_WAIT_L(0); PG8_BAR; PG8_MMA(0, 0, At, B0); PG8_MMA(0, 1, At, B1); PG8_BAR; PG8_SCHED;
            PG8_LDA(At, 1, 1); PG8_STAGE(PG8_SB(1, 0), b3, voffB); PG8_STAGE(PG8_SB(1, 1), b3 + hstep, voffB); PG8_STAGE(PG8_SA(1, 0), a3, voffA);
            PG8_WAIT_V(8); PG8_WAIT_L(0); PG8_BAR; PG8_MMA(1, 0, At, B0); PG8_MMA(1, 1, At, B1); PG8_BAR; PG8_SCHED;
            } else {
            PG8_LDB(B0, 0, 0); PG8_SCHED; PG8_LDA(At, 0, 0); PG8_STAGE(PG8_SA(1, 1), a1 + hstep, voffA);
            PG8_WAIT_L(8); PG8_BAR; PG8_WAIT_L(0); PG8_MMA(0, 0, At, B0); PG8_BAR; PG8_SCHED;
            PG8_LDB(B1, 0, 1); PG8_STAGE(PG8_SB(0, 0), b2, voffB);
            PG8_BAR; PG8_WAIT_L(0); PG8_MMA(0, 1, At, B1); PG8_BAR;
            PG8_LDA(At, 0, 1); PG8_STAGE(PG8_SA(0, 0), a2, voffA);
            PG8_BAR; PG8_WAIT_L(0); PG8_MMA(1, 0, At, B0); PG8_BAR; PG8_SCHED;
            PG8_STAGE(PG8_SB(0, 1), b2 + hstep, voffB);
            PG8_WAIT_V(6); PG8_BAR; PG8_MMA(1, 1, At, B1); PG8_BAR;
            PG8_LDB(B0, 1, 0); PG8_SCHED; PG8_LDA(At, 1, 0); PG8_STAGE(PG8_SA(0, 1), a2 + hstep, voffA);
            PG8_WAIT_L(8); PG8_BAR; PG8_WAIT_L(0); PG8_MMA(0, 0, At, B0); PG8_BAR; PG8_SCHED;
            PG8_LDB(B1, 1, 1); PG8_STAGE(PG8_SB(1, 0), b3, voffB);
            PG8_BAR; PG8_WAIT_L(0); PG8_MMA(0, 1, At, B1); PG8_BAR;
            PG8_LDA(At, 1, 1); PG8_STAGE(PG8_SA(1, 0), a3, voffA);
            PG8_BAR; PG8_WAIT_L(0); PG8_MMA(1, 0, At, B0); PG8_BAR; PG8_SCHED;
            PG8_STAGE(PG8_SB(1, 1), b3 + hstep, voffB);
            PG8_WAIT_V(6); PG8_BAR; PG8_MMA(1, 1, At, B1); PG8_BAR;
            }
        }
        if constexpr (ALIGN_EPI) { if (wr == 0) PG8_BAR; }
        if constexpr (!Epi::AFTER_DRAIN) { E(acc, cur, wr, wc, fr, fq); S.done(cur); }
        if (!has_next) break;
#pragma unroll
        for (int a = 0; a < 2; ++a)
#pragma unroll
            for (int b = 0; b < 2; ++b)
#pragma unroll
                for (int m = 0; m < 4; ++m)
#pragma unroll
                    for (int n = 0; n < 2; ++n) acc[a][b][m][n] = (f32x4){0.f, 0.f, 0.f, 0.f};
        cur = nxt; cA = nA; cB = nB; ++ui;
        if constexpr (ALIGN_EPI) { if (wr == 1) PG8_BAR; }
    }
    PG8_WAIT_V(0);
    if constexpr (!ALIGN_EPI) { if (wr == 0) PG8_BAR; }
    PG8_BAR;
    if constexpr (Epi::AFTER_DRAIN) { E.fused(acc, cur, wr, wc, fr, fq, lds, wid, lane); S.done(cur); }
#undef PG8_SA
#undef PG8_SB
#undef PG8_STAGE
#undef PG8_LDA
#undef PG8_LDB
#undef PG8_MMA
#undef PG8_WAIT_V
#undef PG8_WAIT_L
#undef PG8_BAR
#undef PG8_SCHED
}
}

#define GAS __attribute__((address_space(1)))
#define LAS __attribute__((address_space(3)))
typedef unsigned short bf16;
typedef unsigned v4u __attribute__((ext_vector_type(4)));
typedef float f32x4 __attribute__((ext_vector_type(4)));
typedef short bf16x8 __attribute__((ext_vector_type(8)));
typedef GAS unsigned gu32;
typedef GAS unsigned long long gu64;
#define RLX_AGENT __ATOMIC_RELAXED, __HIP_MEMORY_SCOPE_AGENT
#define LDS_WAIT() asm volatile("s_waitcnt lgkmcnt(0)" ::: "memory")
#define VM_WAIT() asm volatile("s_waitcnt vmcnt(0)" ::: "memory")
__device__ __forceinline__ unsigned long long rt() { return __builtin_amdgcn_s_memrealtime(); }
__device__ __forceinline__ unsigned f2bf(float f) { unsigned u = __builtin_bit_cast(unsigned, f); return (u + 0x7fffu + ((u >> 16) & 1u)) >> 16; }
__device__ __forceinline__ unsigned pk2(float lo, float hi) { return f2bf(lo) | (f2bf(hi) << 16); }

#define XB_TMO      128
#define XB_XCNT(j)  (256  + 64 * (j))
#define XB_XSUB(j)  (1280 + 64 * (j))
#define XB_XGEN(j)  (2304 + 64 * (j))
#define XB_TOP      3328
#define XB_TOPGEN   3392
#define XCD_BAR_WORDS 3456
#define XB_SPIN_CAP (1u << 18)

__device__ __forceinline__ unsigned xb_ld(unsigned* p)              { return __hip_atomic_load(p, __ATOMIC_RELAXED, __HIP_MEMORY_SCOPE_AGENT); }
__device__ __forceinline__ unsigned xb_add(unsigned* p, unsigned v) { return __hip_atomic_fetch_add(p, v, __ATOMIC_RELAXED, __HIP_MEMORY_SCOPE_AGENT); }
__device__ __forceinline__ unsigned xb_xcc_id() { return (unsigned)__builtin_amdgcn_s_getreg((3 << 11) | 20) & 0xFu; }
#define XB_SPIN(cond, bar) do { unsigned _sp = 0; while (cond) { __builtin_amdgcn_s_sleep(1); \
    if ((++_sp & 255u) == 0u) { if (xb_ld(&(bar)[XB_TMO])) break; if (_sp > XB_SPIN_CAP) { atomicAdd(&(bar)[XB_TMO], 1u); break; } } } } while (0)

struct XcdBarrier {
    unsigned* bar; unsigned x;
    volatile LAS unsigned* st;
};

__device__ __forceinline__ XcdBarrier xcd_barrier_post(unsigned* bar, volatile LAS unsigned* st) {
    XcdBarrier b; b.bar = bar; b.x = xb_xcc_id(); b.st = st;
    if (threadIdx.x == 0) (void)xb_add(&bar[XB_XCNT(b.x)], 1u);
    return b;
}
__device__ __forceinline__ void xcd_barrier_complete(unsigned* bar, unsigned x, unsigned& nloc, unsigned& nx) {
    const unsigned G = gridDim.x * gridDim.y * gridDim.z;
    unsigned sum, cnt, mine, sp = 0u;
    for (;;) {
        sum = 0u; cnt = 0u; mine = 0u;
#pragma unroll
        for (unsigned j = 0; j < 16; ++j) { const unsigned c = xb_ld(&bar[XB_XCNT(j)]); sum += c; cnt += (c > 0u) ? 1u : 0u; mine = (j == x) ? c : mine; }
        if (sum == G) break;
        __builtin_amdgcn_s_sleep(1);
        if ((++sp & 255u) == 0u) { if (xb_ld(&bar[XB_TMO])) break; if (sp > XB_SPIN_CAP) { atomicAdd(&bar[XB_TMO], 1u); break; } }
    }
    nloc = mine > 0u ? mine : 1u; nx = cnt > 0u ? cnt : 1u;
}

__device__ __forceinline__ void xcd_barrier(const XcdBarrier& b) {
    asm volatile("s_waitcnt vmcnt(0)" ::: "memory");
    __syncthreads();
    if (threadIdx.x == 0) {
        unsigned* bar = b.bar;
        __builtin_amdgcn_s_waitcnt(0);
        unsigned nloc = b.st[0], nx = b.st[1];
        if (nloc == 0u) { xcd_barrier_complete(bar, b.x, nloc, nx); b.st[0] = nloc; b.st[1] = nx; }
        const unsigned old = xb_add(&bar[XB_XSUB(b.x)], 1u);
        const unsigned gen = old / nloc;
        if (old + 1u == (gen + 1u) * nloc) {
            __builtin_amdgcn_fence(__ATOMIC_RELEASE, "agent");
            asm volatile("s_waitcnt vmcnt(0)" ::: "memory");
            const unsigned og = xb_add(&bar[XB_TOP], 1u);
            const unsigned tg = og / nx;
            if (og + 1u == (tg + 1u) * nx) xb_add(&bar[XB_TOPGEN], 1u);
            else XB_SPIN(xb_ld(&bar[XB_TOPGEN]) == tg, bar);
            __builtin_amdgcn_fence(__ATOMIC_ACQUIRE, "agent");
            xb_add(&bar[XB_XGEN(b.x)], 1u);
            asm volatile("s_waitcnt vmcnt(0)" ::: "memory");
        } else {
            XB_SPIN(xb_ld(&bar[XB_XGEN(b.x)]) == gen, bar);
            __builtin_amdgcn_fence(__ATOMIC_ACQUIRE, "agent");
            asm volatile("s_waitcnt vmcnt(0)" ::: "memory");
        }
    }
    __syncthreads();
}

constexpr int NWAVES = 8;
constexpr int M = 32768, D = 1024, SEQ = 4096, NPROJ = 2048, NQ = 2048, PLED = 256, NEXP = 16384;
constexpr float EPS = 1e-6f;
#ifndef MK_PER_PHASE
#define MK_PER_PHASE 0
#endif
#ifndef PROBE_REP
#define PROBE_REP 0
#endif
#define REPS(k) ((PROBE_REP == (k)) ? 2 : 1)
constexpr int NPHASES = 11;

constexpr size_t MiB = 1u << 20;
constexpr size_t WS_CTL = 0, CTL_ZERO_BYTES = 1 * MiB;
constexpr size_t WS_WIN = 2 * MiB, WS_WO = 6 * MiB, WS_WQ = 8 * MiB, WS_WG = 12 * MiB, WS_WP = 14 * MiB, WS_KEYS = 14 * MiB + 512 * 1024;
constexpr size_t WS_WF = 15 * MiB;
constexpr size_t WS_RSX = 17 * MiB, WS_RS2 = 17 * MiB + 512 * 1024, WS_RS1 = 18 * MiB, WS_RS3 = 20 * MiB;
constexpr size_t WS_SU = 22 * MiB, WS_SV = 22 * MiB + 65536;
constexpr size_t WS_U = 24 * MiB, WS_V = 56 * MiB;
constexpr size_t WS_XB = 88 * MiB;
constexpr size_t WS_PROJ = 152 * MiB;
constexpr size_t WS_MIX = 280 * MiB;
constexpr size_t WS_CF = WS_MIX;
constexpr size_t WS_HB = 344 * MiB;
constexpr size_t WS_EIDX = 408 * MiB, WS_GATE = 424 * MiB;
constexpr size_t WS_PB = 440 * MiB;
constexpr size_t WS_END = 456 * MiB;
constexpr int CW_BAR = 4096;
static_assert((CW_BAR + XCD_BAR_WORDS) * 4 <= (int)CTL_ZERO_BYTES, "CTL words inside the memset region");

constexpr int RING_BYTES = 131072;
constexpr int LDSCTL_OFF = RING_BYTES, MISC_OFF = LDSCTL_OFF + 320;
constexpr int LDS_BYTES = 147456;

typedef float f32x16 __attribute__((ext_vector_type(16)));
typedef _Float16 h2_t __attribute__((ext_vector_type(2)));
typedef float f32x2 __attribute__((ext_vector_type(2)));
typedef int i32x4 __attribute__((ext_vector_type(4)));
typedef unsigned v2u __attribute__((ext_vector_type(2)));

__device__ __forceinline__ float wave_sum(float v) {
#pragma unroll
    for (int o = 1; o < 64; o <<= 1) v += __shfl_xor(v, o);
    return v;
}
__device__ __forceinline__ float bf_lo(unsigned w) { return __uint_as_float(w << 16); }
__device__ __forceinline__ float bf_hi(unsigned w) { return __uint_as_float(w & 0xffff0000u); }
__device__ __forceinline__ unsigned pkh(float lo, float hi) { f32x2 v = {lo, hi}; h2_t h = __builtin_convertvector(v, h2_t); return __builtin_bit_cast(unsigned, h); }

struct EpiBf16Row {
    static constexpr bool PERM = true, AFTER_DRAIN = false;
    pg8::bf16_t* O; int ldc; const float* rowss;
    __device__ __forceinline__ void operator()(const pg8::f32x4 (&acc)[2][2][4][2], const pg8::Unit& u, int wr, int wc, int fr, int fq) const {
        const int row0 = u.pm * 256 + wr * 64 + fr, col0 = u.pn * 256 + wc * 32 + 8 * fq;
#pragma unroll
        for (int ai = 0; ai < 2; ++ai)
#pragma unroll
            for (int m = 0; m < 4; ++m) {
                const int row = row0 + ai * 128 + m * 16;
                const float sc = rowss ? __builtin_amdgcn_rsqf(rowss[row] * (1.0f / 1024.0f) + EPS) : 1.0f;
                pg8::bf16_t* rowp = O + (size_t)row * ldc + col0;
#pragma unroll
                for (int bj = 0; bj < 2; ++bj) {
                    const pg8::f32x4 v0 = acc[ai][bj][m][0] * sc, v1 = acc[ai][bj][m][1] * sc;
                    pg8::u32x4 w; w.x = pg8::cvt_pk_bf16(v0[0], v0[1]); w.y = pg8::cvt_pk_bf16(v0[2], v0[3]); w.z = pg8::cvt_pk_bf16(v1[0], v1[1]); w.w = pg8::cvt_pk_bf16(v1[2], v1[3]);
                    *(pg8::u32x4*)(rowp + bj * 128) = w;
                }
            }
    }
};
struct EpiH1 {
    static constexpr bool PERM = true, AFTER_DRAIN = false;
    const float* X; pg8::bf16_t* HB; float* RS;
    __device__ __forceinline__ void operator()(const pg8::f32x4 (&acc)[2][2][4][2], const pg8::Unit& u, int wr, int wc, int fr, int fq) const {
        const int row0 = u.pm * 256 + wr * 64 + fr, col0 = u.pn * 256 + wc * 32 + 8 * fq;
#pragma unroll
        for (int ai = 0; ai < 2; ++ai)
#pragma unroll
            for (int m = 0; m < 4; ++m) {
                const int row = row0 + ai * 128 + m * 16; float s = 0.f;
#pragma unroll
                for (int bj = 0; bj < 2; ++bj) {
                    const size_t off = (size_t)row * 1024 + col0 + bj * 128;
                    const pg8::f32x4 x0 = *(const pg8::f32x4*)(X + off), x1 = *(const pg8::f32x4*)(X + off + 4);
                    const pg8::f32x4 v0 = acc[ai][bj][m][0] + x0, v1 = acc[ai][bj][m][1] + x1;
                    pg8::u32x4 w; w.x = pg8::cvt_pk_bf16(v0[0], v0[1]); w.y = pg8::cvt_pk_bf16(v0[2], v0[3]); w.z = pg8::cvt_pk_bf16(v1[0], v1[1]); w.w = pg8::cvt_pk_bf16(v1[2], v1[3]);
                    *(pg8::u32x4*)(HB + off) = w;
                    s += (v0[0] * v0[0] + v0[1] * v0[1]) + (v0[2] * v0[2] + v0[3] * v0[3]) + (v1[0] * v1[0] + v1[1] * v1[1]) + (v1[2] * v1[2] + v1[3] * v1[3]);
                }
                s += __shfl_xor(s, 16); s += __shfl_xor(s, 32);
                if (fq == 0) RS[(size_t)row * 16 + u.pn * 4 + wc] = s;
            }
    }
};
struct EpiGate {
    static constexpr bool PERM = true, AFTER_DRAIN = false;
    pg8::bf16_t* OUT; const pg8::bf16_t* HB; const pg8::bf16_t* PL; const float* RS2; float* RS3;
    __device__ __forceinline__ void operator()(const pg8::f32x4 (&acc)[2][2][4][2], const pg8::Unit& u, int wr, int wc, int fr, int fq) const {
        const int row0 = u.pm * 256 + wr * 64 + fr, col0 = u.pn * 256 + wc * 32 + 8 * fq;
#pragma unroll
        for (int ai = 0; ai < 2; ++ai)
#pragma unroll
            for (int m = 0; m < 4; ++m) {
                const int row = row0 + ai * 128 + m * 16; float s = 0.f;
                const float rstd = __builtin_amdgcn_rsqf(RS2[row] * (1.0f / 1024.0f) + EPS);
#pragma unroll
                for (int bj = 0; bj < 2; ++bj) {
                    const size_t off = (size_t)row * 1024 + col0 + bj * 128;
                    const pg8::u32x4 w = *(const pg8::u32x4*)(PL + off), hw = *(const pg8::u32x4*)(HB + off);
                    const pg8::f32x4 h0 = {bf_lo(hw.x), bf_hi(hw.x), bf_lo(hw.y), bf_hi(hw.y)}, h1 = {bf_lo(hw.z), bf_hi(hw.z), bf_lo(hw.w), bf_hi(hw.w)};
                    const pg8::f32x4 a0 = acc[ai][bj][m][0] * rstd, a1 = acc[ai][bj][m][1] * rstd;
                    pg8::f32x4 g0, g1;
#pragma unroll
                    for (int e = 0; e < 4; ++e) { g0[e] = 1.0f / (1.0f + __expf(-a0[e])); g1[e] = 1.0f / (1.0f + __expf(-a1[e])); }
                    const pg8::f32x4 p0 = {bf_lo(w.x), bf_hi(w.x), bf_lo(w.y), bf_hi(w.y)}, p1 = {bf_lo(w.z), bf_hi(w.z), bf_lo(w.w), bf_hi(w.w)};
                    const pg8::f32x4 v0 = h0 + g0 * p0, v1 = h1 + g1 * p1;
                    { pg8::u32x4 ow; ow.x = pg8::cvt_pk_bf16(v0[0], v0[1]); ow.y = pg8::cvt_pk_bf16(v0[2], v0[3]); ow.z = pg8::cvt_pk_bf16(v1[0], v1[1]); ow.w = pg8::cvt_pk_bf16(v1[2], v1[3]); *(pg8::u32x4*)(OUT + off) = ow; }
                    s += (v0[0] * v0[0] + v0[1] * v0[1]) + (v0[2] * v0[2] + v0[3] * v0[3]) + (v1[0] * v1[0] + v1[1] * v1[1]) + (v1[2] * v1[2] + v1[3] * v1[3]);
                }
                s += __shfl_xor(s, 16); s += __shfl_xor(s, 32);
                if (fq == 0) RS3[(size_t)row * 16 + u.pn * 4 + wc] = s;
            }
    }
};

__device__ __forceinline__ void p0_transpose_item(const float* W, int ldn, const float* gk, int K, bf16* WT, int row_off, int nblk, LAS float* scr, int item, int lane) {
    const int kb = item / nblk, nb = item % nblk, k0 = 64 * kb, n0 = 32 * nb;
#pragma unroll 8
    for (int i = 0; i < 32; ++i) { const int kk = 2 * i + (lane >> 5); float v = W[(size_t)(k0 + kk) * ldn + n0 + (lane & 31)]; if (gk) v *= gk[k0 + kk]; scr[kk * 33 + (lane & 31)] = v; }
    LDS_WAIT(); asm volatile("" ::: "memory");
    const int c = lane & 7;
#pragma unroll
    for (int j = 0; j < 4; ++j) { const int n = (lane >> 3) + 8 * j; const LAS float* s = scr + (8 * c) * 33 + n;
        v4u o; o.x = pk2(s[0 * 33], s[1 * 33]); o.y = pk2(s[2 * 33], s[3 * 33]); o.z = pk2(s[4 * 33], s[5 * 33]); o.w = pk2(s[6 * 33], s[7 * 33]);
        *(GAS v4u*)(WT + (size_t)(row_off + n0 + n) * K + k0 + 8 * c) = o; }
    LDS_WAIT(); asm volatile("" ::: "memory");
}

struct Ptrs {
    const float *x, *p, *g_mix, *w_in, *conv_w, *pool_w, *pool_scale, *w_o, *g_ffn, *w_q, *sub_keys, *eu, *ev, *g_ple, *w_gate, *w_proj, *g_final;
    float* out; unsigned char* ws;
};

__device__ __forceinline__ void p0a_phase(const Ptrs& P, LAS unsigned char* lds, int vcu, int G, int tid, int wave, int lane) {
    const int gw = vcu * NWAVES + wave, NGW = G * NWAVES;
    const int gt = vcu * (NWAVES * 64) + tid, NGT = G * NWAVES * 64;
    { float* Wf = (float*)(P.ws + WS_WF);
      for (int tk = gw; tk < 2048; tk += NGW) {
          const int k4 = (tk >> 3) * 4, j = tk & 7, g = j >> 1, np = j * 64 + lane, d = np & 127;
          const float* wi = P.w_in + (size_t)k4 * 2048 + 1536 + g * 128; const float* pw = P.pool_w + (size_t)g * 128 * 128 + d;
          float a0 = 0.f, a1 = 0.f, a2 = 0.f, a3 = 0.f;
          for (int c0 = 0; c0 < 128; c0 += 16) {
              float pv[16], w0[16], w1[16], w2[16], w3[16];
#pragma unroll
              for (int c = 0; c < 16; ++c) { pv[c] = pw[(size_t)(c0 + c) * 128]; w0[c] = wi[c0 + c]; w1[c] = wi[2048 + c0 + c]; w2[c] = wi[4096 + c0 + c]; w3[c] = wi[6144 + c0 + c]; }
#pragma unroll
              for (int c = 0; c < 16; ++c) { a0 += w0[c] * pv[c]; a1 += w1[c] * pv[c]; a2 += w2[c] * pv[c]; a3 += w3[c] * pv[c]; }
          }
          const float sc = P.pool_scale[np];
          Wf[(size_t)k4 * 512 + np] = a0 * sc; Wf[(size_t)(k4 + 1) * 512 + np] = a1 * sc; Wf[(size_t)(k4 + 2) * 512 + np] = a2 * sc; Wf[(size_t)(k4 + 3) * 512 + np] = a3 * sc;
      } }
    { LAS float* scr = (LAS float*)(lds + wave * 16384);
      constexpr int I_WO = 16 * 32, I_WQ = 16 * 64, I_WG = 16 * 32, I_WP = 4 * 32, I_WINA = 16 * 48;
      constexpr int NITEMS = I_WO + I_WQ + I_WG + I_WP + I_WINA;
      for (int it = gw; it < NITEMS; it += NGW) {
          int r = it;
          if (r < I_WO) { p0_transpose_item(P.w_o, 1024, nullptr, 1024, (bf16*)(P.ws + WS_WO), 0, 32, scr, r, lane); continue; } r -= I_WO;
          if (r < I_WQ) { p0_transpose_item(P.w_q, 2048, P.g_ffn, 1024, (bf16*)(P.ws + WS_WQ), 0, 64, scr, r, lane); continue; } r -= I_WQ;
          if (r < I_WG) { p0_transpose_item(P.w_gate, 1024, P.g_ple, 1024, (bf16*)(P.ws + WS_WG), 0, 32, scr, r, lane); continue; } r -= I_WG;
          if (r < I_WP) { p0_transpose_item(P.w_proj, 1024, nullptr, 256, (bf16*)(P.ws + WS_WP), 0, 32, scr, r, lane); continue; } r -= I_WP;
          p0_transpose_item(P.w_in, 2048, P.g_mix, 1024, (bf16*)(P.ws + WS_WIN), 0, 48, scr, r, lane);
      } }
    { for (int r0 = 4 * gw; r0 < NEXP; r0 += 4 * NGW) {
          f32x4 a[4][4]; float q[4];
#pragma unroll
          for (int rr = 0; rr < 4; ++rr) { const GAS f32x4* src = (const GAS f32x4*)(P.eu + (size_t)(r0 + rr) * 1024);
#pragma unroll
              for (int j = 0; j < 4; ++j) a[rr][j] = src[4 * lane + j]; }
          { const GAS f32x4* gf = (const GAS f32x4*)P.g_ffn + 4 * lane;
#pragma unroll
            for (int j = 0; j < 4; ++j) { const f32x4 g = gf[j];
#pragma unroll
                for (int rr = 0; rr < 4; ++rr) a[rr][j] = a[rr][j] * g; } }
#pragma unroll
          for (int rr = 0; rr < 4; ++rr) { q[rr] = 0.f;
#pragma unroll
              for (int j = 0; j < 4; ++j) q[rr] += (a[rr][j].x * a[rr][j].x + a[rr][j].y * a[rr][j].y) + (a[rr][j].z * a[rr][j].z + a[rr][j].w * a[rr][j].w); }
#pragma unroll
          for (int o = 1; o < 64; o <<= 1) { q[0] += __shfl_xor(q[0], o); q[1] += __shfl_xor(q[1], o); q[2] += __shfl_xor(q[2], o); q[3] += __shfl_xor(q[3], o); }
#pragma unroll
          for (int rr = 0; rr < 4; ++rr) { const int e = r0 + rr;
              const float rms = sqrtf(q[rr] * (1.0f / 1024.0f)); const float sc = rms > 0.f ? 2.0f / rms : 0.f;
              unsigned w0 = 0u, w1 = 0u;
              w0 = __builtin_amdgcn_cvt_scalef32_pk_fp4_f32(w0, a[rr][0].x * sc, a[rr][0].y * sc, 1.0f, 0); w0 = __builtin_amdgcn_cvt_scalef32_pk_fp4_f32(w0, a[rr][0].z * sc, a[rr][0].w * sc, 1.0f, 1);
              w0 = __builtin_amdgcn_cvt_scalef32_pk_fp4_f32(w0, a[rr][1].x * sc, a[rr][1].y * sc, 1.0f, 2); w0 = __builtin_amdgcn_cvt_scalef32_pk_fp4_f32(w0, a[rr][1].z * sc, a[rr][1].w * sc, 1.0f, 3);
              w1 = __builtin_amdgcn_cvt_scalef32_pk_fp4_f32(w1, a[rr][2].x * sc, a[rr][2].y * sc, 1.0f, 0); w1 = __builtin_amdgcn_cvt_scalef32_pk_fp4_f32(w1, a[rr][2].z * sc, a[rr][2].w * sc, 1.0f, 1);
              w1 = __builtin_amdgcn_cvt_scalef32_pk_fp4_f32(w1, a[rr][3].x * sc, a[rr][3].y * sc, 1.0f, 2); w1 = __builtin_amdgcn_cvt_scalef32_pk_fp4_f32(w1, a[rr][3].z * sc, a[rr][3].w * sc, 1.0f, 3);
              ((GAS v2u*)(P.ws + WS_U))[(size_t)e * 64 + lane] = (v2u){w0, w1};
              if (lane == 0) ((float*)(P.ws + WS_SU))[e] = rms * 0.5f; }
      } }
    { const int ci = lane >> 2, cb = lane & 3; const int eoff = 256 * cb + 64 * (ci >> 2) + (ci & 3);
      for (int r0 = 2 * gw; r0 < NEXP; r0 += 2 * NGW) {
          float v[2][16]; float q[2];
#pragma unroll
          for (int rr = 0; rr < 2; ++rr) { const float* src = P.ev + (size_t)(r0 + rr) * 1024 + eoff;
#pragma unroll
              for (int n = 0; n < 16; ++n) v[rr][n] = src[4 * n]; }
#pragma unroll
          for (int rr = 0; rr < 2; ++rr) { q[rr] = 0.f;
#pragma unroll
              for (int n = 0; n < 16; ++n) q[rr] += v[rr][n] * v[rr][n]; }
#pragma unroll
          for (int o = 1; o < 64; o <<= 1) { q[0] += __shfl_xor(q[0], o); q[1] += __shfl_xor(q[1], o); }
#pragma unroll
          for (int rr = 0; rr < 2; ++rr) { const int e = r0 + rr;
              const float rms = sqrtf(q[rr] * (1.0f / 1024.0f)); const float sc = rms > 0.f ? 2.0f / rms : 0.f;
              unsigned w0 = 0u, w1 = 0u;
              w0 = __builtin_amdgcn_cvt_scalef32_pk_fp4_f32(w0, v[rr][0] * sc, v[rr][1] * sc, 1.0f, 0); w0 = __builtin_amdgcn_cvt_scalef32_pk_fp4_f32(w0, v[rr][2] * sc, v[rr][3] * sc, 1.0f, 1);
              w0 = __builtin_amdgcn_cvt_scalef32_pk_fp4_f32(w0, v[rr][4] * sc, v[rr][5] * sc, 1.0f, 2); w0 = __builtin_amdgcn_cvt_scalef32_pk_fp4_f32(w0, v[rr][6] * sc, v[rr][7] * sc, 1.0f, 3);
              w1 = __builtin_amdgcn_cvt_scalef32_pk_fp4_f32(w1, v[rr][8] * sc, v[rr][9] * sc, 1.0f, 0); w1 = __builtin_amdgcn_cvt_scalef32_pk_fp4_f32(w1, v[rr][10] * sc, v[rr][11] * sc, 1.0f, 1);
              w1 = __builtin_amdgcn_cvt_scalef32_pk_fp4_f32(w1, v[rr][12] * sc, v[rr][13] * sc, 1.0f, 2); w1 = __builtin_amdgcn_cvt_scalef32_pk_fp4_f32(w1, v[rr][14] * sc, v[rr][15] * sc, 1.0f, 3);
              ((GAS v2u*)(P.ws + WS_V))[(size_t)e * 64 + (cb >> 1) * 32 + 2 * ci + (cb & 1)] = (v2u){w0, w1};
              if (lane == 0) ((float*)(P.ws + WS_SV))[e] = rms * 0.5f; }
      } }
    { const GAS f32x4* sp = (const GAS f32x4*)P.p; GAS v4u* dp = (GAS v4u*)(P.ws + WS_PB);
      for (int i0 = gt; i0 < M * PLED / 8; i0 += 4 * NGT) {
          f32x4 a[4], b[4];
#pragma unroll
          for (int q = 0; q < 4; ++q) { const int i = i0 + q * NGT; if (i < M * PLED / 8) { a[q] = sp[2 * (size_t)i]; b[q] = sp[2 * (size_t)i + 1]; } }
#pragma unroll
          for (int q = 0; q < 4; ++q) { const int i = i0 + q * NGT; if (i < M * PLED / 8) { v4u o; o.x = pk2(a[q].x, a[q].y); o.y = pk2(a[q].z, a[q].w); o.z = pk2(b[q].x, b[q].y); o.w = pk2(b[q].z, b[q].w); dp[i] = o; } }
      }
      const GAS f32x4* sk = (const GAS f32x4*)P.sub_keys; GAS v4u* dk = (GAS v4u*)(P.ws + WS_KEYS);
      for (int i = gt; i < 16 * 128 * 128 / 8; i += NGT) { const f32x4 a = sk[2 * (size_t)i], b = sk[2 * (size_t)i + 1]; v4u o; o.x = pk2(a.x, a.y); o.y = pk2(a.z, a.w); o.z = pk2(b.x, b.y); o.w = pk2(b.z, b.w); dk[i] = o; } }
    { float* RSX = (float*)(P.ws + WS_RSX); bf16* XB = (bf16*)(P.ws + WS_XB);
      for (int m0 = 4 * gw; m0 < M; m0 += 4 * NGW) {
          f32x4 v[4][4]; float sq[4];
#pragma unroll
          for (int r = 0; r < 4; ++r) { const GAS f32x4* xr = (const GAS f32x4*)(P.x + (size_t)(m0 + r) * D) + lane;
#pragma unroll
              for (int j = 0; j < 4; ++j) v[r][j] = xr[64 * j]; }
#pragma unroll
          for (int r = 0; r < 4; ++r) { sq[r] = 0.f;
#pragma unroll
              for (int j = 0; j < 4; ++j) sq[r] += (v[r][j].x * v[r][j].x + v[r][j].y * v[r][j].y) + (v[r][j].z * v[r][j].z + v[r][j].w * v[r][j].w); }
#pragma unroll
          for (int o = 1; o < 64; o <<= 1) {
#pragma unroll
              for (int r = 0; r < 4; ++r) sq[r] += __shfl_xor(sq[r], o); }
#pragma unroll
          for (int r = 0; r < 4; ++r) { if (lane == 0) RSX[m0 + r] = sq[r];
              GAS unsigned long long* o8 = (GAS unsigned long long*)(XB + (size_t)(m0 + r) * D) + lane;
#pragma unroll
              for (int j = 0; j < 4; ++j) o8[64 * j] = (unsigned long long)pk2(v[r][j].x, v[r][j].y) | ((unsigned long long)pk2(v[r][j].z, v[r][j].w) << 32); }
      } }
}
__device__ __forceinline__ void p0b_phase(const Ptrs& P, LAS unsigned char* lds, int vcu, int G, int wave, int lane) {
    const int gw = vcu * NWAVES + wave, NGW = G * NWAVES; LAS float* scr = (LAS float*)(lds + wave * 16384);
    for (int it = gw; it < 16 * 16; it += NGW) p0_transpose_item((const float*)(P.ws + WS_WF), 512, P.g_mix, 1024, (bf16*)(P.ws + WS_WIN), 1536, 16, scr, it, lane);
}

template <int HALF>
__device__ __forceinline__ void pool_chunk(const unsigned* col, unsigned* mx, int t0, int s0) {
    constexpr int TC = 32, NV = TC + 2 * HALF;
    float v0[NV], v1[NV];
#pragma unroll
    for (int i = 0; i < NV; ++i) {
        const int s = s0 - HALF + i; const bool ok = (s >= 0) && (s < SEQ);
        const unsigned w = col[(size_t)(ok ? (t0 - HALF + i) : t0) * 1024];
        v0[i] = ok ? bf_lo(w) : 0.f; v1[i] = ok ? bf_hi(w) : 0.f;
    }
    float S0 = 0.f, S1 = 0.f;
#pragma unroll
    for (int j = 0; j < 2 * HALF; ++j) { S0 += v0[j]; S1 += v1[j]; }
#pragma unroll
    for (int i = 0; i < TC; ++i) {
        const int s = s0 + i; const int lo = (s - HALF) > 0 ? (s - HALF) : 0, hi = (s + HALF) < SEQ ? (s + HALF) : SEQ;
        const float inv = 1.0f / (float)(hi - lo);
        mx[(size_t)(t0 + i) * 512] = pk2(S0 * inv - v0[i + HALF], S1 * inv - v1[i + HALF]);
        if (i + 1 < TC) { S0 += v0[i + 2 * HALF] - v0[i]; S1 += v1[i + 2 * HALF] - v1[i]; }
    }
}
__device__ __forceinline__ void p2_phase(const Ptrs& P, int vcu, int G, int tid, int wave) {
    const unsigned* PR = (const unsigned*)(P.ws + WS_PROJ);
    unsigned* MX = (unsigned*)(P.ws + WS_MIX);
    constexpr int TC = 32;
    for (int ck = vcu; ck < M / TC; ck += G) {
        const int t0 = ck * TC, s0 = t0 & (SEQ - 1);
        if (tid < 256) {
            const unsigned* col = PR + 768 + tid; unsigned* mx = MX + 256 + tid;
            if (wave == 0) pool_chunk<1>(col, mx, t0, s0); else if (wave == 1) pool_chunk<2>(col, mx, t0, s0); else if (wave == 2) pool_chunk<4>(col, mx, t0, s0); else pool_chunk<8>(col, mx, t0, s0);
        } else {
            const int cp = tid - 256;
            const unsigned* bcol = PR + cp; const unsigned* ccol = PR + 256 + cp; const unsigned* vcol = PR + 512 + cp;
            const float w00 = P.conv_w[2 * cp], w01 = P.conv_w[2 * cp + 1], w10 = P.conv_w[512 + 2 * cp], w11 = P.conv_w[512 + 2 * cp + 1], w20 = P.conv_w[1024 + 2 * cp], w21 = P.conv_w[1024 + 2 * cp + 1];
            float z0[TC + 2], z1[TC + 2]; unsigned bw[TC];
#pragma unroll
            for (int i = 0; i < TC + 2; ++i) {
                const int s = s0 - 1 + i; const bool ok = (s >= 0) && (s < SEQ); const size_t t = (size_t)(ok ? (t0 - 1 + i) : t0) * 1024;
                const unsigned c = ccol[t], v = vcol[t];
                z0[i] = ok ? bf_lo(c) * bf_lo(v) : 0.f; z1[i] = ok ? bf_hi(c) * bf_hi(v) : 0.f;
            }
#pragma unroll
            for (int i = 0; i < TC; ++i) bw[i] = bcol[(size_t)(t0 + i) * 1024];
#pragma unroll
            for (int i = 0; i < TC; ++i) {
                const float y0 = w00 * z0[i] + w10 * z0[i + 1] + w20 * z0[i + 2], y1 = w01 * z1[i] + w11 * z1[i + 1] + w21 * z1[i + 2];
                MX[(size_t)(t0 + i) * 512 + cp] = pk2(bf_lo(bw[i]) * y0, bf_hi(bw[i]) * y1);
            }
        }
    }
}

__device__ __forceinline__ float fmax_s(float a, float b) { float r; asm("v_max_f32_e32 %0, %1, %2" : "=v"(r) : "v"(a), "v"(b)); return r; }
__device__ __forceinline__ float fmin_s(float a, float b) { float r; asm("v_min_f32_e32 %0, %1, %2" : "=v"(r) : "v"(a), "v"(b)); return r; }
#define CE_DESC(a, b) do { const float _t = fmax_s(a, b); b = fmin_s(a, b); a = _t; } while (0)
#define CE_ASC(a, b)  do { const float _t = fmin_s(a, b); b = fmax_s(a, b); a = _t; } while (0)
__device__ __forceinline__ void sort16_desc(float* a) {
#pragma unroll
    for (int k = 2; k <= 16; k <<= 1)
#pragma unroll
        for (int j = k >> 1; j > 0; j >>= 1)
#pragma unroll
            for (int i = 0; i < 16; ++i) { const int l = i ^ j; if (l > i) { if ((i & k) == 0) CE_DESC(a[i], a[l]); else CE_ASC(a[i], a[l]); } }
}
__device__ __forceinline__ void merge16_desc(float* a) {
#pragma unroll
    for (int j = 8; j > 0; j >>= 1)
#pragma unroll
        for (int i = 0; i < 16; ++i) { const int l = i ^ j; if (l > i) CE_DESC(a[i], a[l]); }
}
__device__ __forceinline__ void top16_merge(float* a, const float* b) {
#pragma unroll
    for (int i = 0; i < 16; ++i) a[i] = fmax_s(a[i], b[15 - i]);
    merge16_desc(a);
}
__device__ __forceinline__ void top16_of_64(float* v) {
    sort16_desc(v); sort16_desc(v + 16); sort16_desc(v + 32); sort16_desc(v + 48);
    top16_merge(v, v + 16); top16_merge(v + 32, v + 48); top16_merge(v, v + 32);
}
__device__ __forceinline__ unsigned key_lookup(unsigned long long lo, unsigned long long hi, unsigned i) {
    const unsigned long long v = (i & 8u) ? hi : lo;
    return (unsigned)(v >> ((i & 7u) * 8u)) & 0x7fu;
}

constexpr int KROW = 272;
__device__ __forceinline__ void score_phase(const Ptrs& P, LAS unsigned char* lds, int bid, int G, int tid, int wave, int lane) {
    const bf16* Q = (const bf16*)(P.ws + WS_PROJ); const bf16* KEYS = (const bf16*)(P.ws + WS_KEYS); const float* RS1 = (const float*)(P.ws + WS_RS1);
    int* EIDX = (int*)(P.ws + WS_EIDX); float* GATE = (float*)(P.ws + WS_GATE);
    const int l31 = lane & 31, hi = lane >> 5;
    int cur_h = -1;
    for (int u = bid; u < (M / 256) * 8; u += G) {
        const int h = u & 7, tile = u >> 3;
        if (h != cur_h) {
            __syncthreads();
#pragma unroll
            for (int i = 0; i < 8; ++i) { const int q = tid + 512 * i, row = q >> 4, ch = q & 15;
                const v4u val = *(const GAS v4u*)(KEYS + ((size_t)(h * 256 + row)) * 128 + ch * 8);
                *(LAS v4u*)(lds + row * KROW + ch * 16) = val; }
            __syncthreads();
            cur_h = h;
        }
        const int tok = tile * 256 + wave * 32 + l31;
        float T0[16], T1[16];
#pragma unroll
        for (int p = 0; p < 2; ++p) {
            f32x16 acc[4];
#pragma unroll
            for (int kb = 0; kb < 4; ++kb)
#pragma unroll
                for (int r = 0; r < 16; ++r) acc[kb][r] = 0.f;
            const bf16* qp = Q + (size_t)tok * 2048 + h * 256 + p * 128 + hi * 8;
            bf16x8 bq[8];
#pragma unroll
            for (int ks = 0; ks < 8; ++ks) bq[ks] = *(const GAS bf16x8*)(qp + ks * 16);
#pragma unroll
            for (int ks = 0; ks < 8; ++ks)
#pragma unroll
                for (int kb = 0; kb < 4; ++kb) {
                    const bf16x8 ak = *(const LAS bf16x8*)(lds + (p * 128 + kb * 32 + l31) * KROW + (ks * 16 + hi * 8) * 2);
                    acc[kb] = __builtin_amdgcn_mfma_f32_32x32x16_bf16(ak, bq[ks], acc[kb], 0, 0, 0);
                }
            float v[64];
#pragma unroll
            for (int kb = 0; kb < 4; ++kb)
#pragma unroll
                for (int r = 0; r < 16; ++r) v[kb * 16 + r] = __uint_as_float((__float_as_uint(acc[kb][r]) & 0xffffff80u) | (unsigned)(kb * 32 + (r & 3) + 8 * (r >> 2)));
            top16_of_64(v);
            const unsigned hb = (unsigned)hi << 2;
#pragma unroll
            for (int i = 0; i < 16; ++i) v[i] = __uint_as_float(__float_as_uint(v[i]) | hb);
            float c[16];
#pragma unroll
            for (int i = 0; i < 16; ++i) c[i] = fmax_s(v[i], __shfl_xor(v[15 - i], 32));
            merge16_desc(c);
#pragma unroll
            for (int i = 0; i < 16; ++i) { if (p == 0) T0[i] = c[i]; else T1[i] = c[i]; }
        }
        float f0[16], f1[16];
        unsigned long long K0lo = 0ull, K0hi = 0ull, K1lo = 0ull, K1hi = 0ull;
#pragma unroll
        for (int b = 0; b < 8; ++b) {
            K0lo |= (unsigned long long)(__float_as_uint(T0[b]) & 0x7fu) << (8 * b); K0hi |= (unsigned long long)(__float_as_uint(T0[8 + b]) & 0x7fu) << (8 * b);
            K1lo |= (unsigned long long)(__float_as_uint(T1[b]) & 0x7fu) << (8 * b); K1hi |= (unsigned long long)(__float_as_uint(T1[8 + b]) & 0x7fu) << (8 * b);
        }
#pragma unroll
        for (int i = 0; i < 16; ++i) { f0[i] = __uint_as_float(__float_as_uint(T0[i]) & 0xffffff80u); f1[i] = __uint_as_float(__float_as_uint(T1[i]) & 0xffffff80u); }
        float cd[64]; int n = 0;
#pragma unroll
        for (int i = 0; i < 16; ++i)
#pragma unroll
            for (int j = 0; j < 16; ++j)
                if ((i + 1) * (j + 1) <= 16) { cd[n] = __uint_as_float((__float_as_uint(f0[i] + f1[j]) & 0xffffff00u) | (unsigned)(i * 16 + j)); ++n; }
#pragma unroll
        for (int q = 50; q < 64; ++q) cd[q] = __uint_as_float(0xff800000u);
        top16_of_64(cd);
        float rs = 0.f;
        { const GAS f32x4* rp = (const GAS f32x4*)(RS1 + (size_t)tok * 16);
#pragma unroll
          for (int i = 0; i < 4; ++i) { const f32x4 a = rp[i]; rs += (a.x + a.y) + (a.z + a.w); } }
        const float rstd = __builtin_amdgcn_rsqf(rs * (1.0f / 1024.0f) + EPS);
        int eidx[16]; float gt_[16]; float z0 = 0.f, sum = 0.f;
#pragma unroll
        for (int k = 0; k < 16; ++k) {
            const unsigned wb = __float_as_uint(cd[k]); const unsigned i = (wb >> 4) & 15u, j = wb & 15u;
            eidx[k] = (int)(key_lookup(K0lo, K0hi, i) * 128u + key_lookup(K1lo, K1hi, j));
            const float z = __uint_as_float(wb & 0xffffff00u) * rstd;
            if (k == 0) z0 = z;
            gt_[k] = __expf(z - z0); sum += gt_[k];
        }
        const float inv = 1.0f / sum;
        if (hi == 0) { GAS i32x4* ep = (GAS i32x4*)(EIDX + (size_t)tok * 128 + h * 16);
#pragma unroll
            for (int q = 0; q < 4; ++q) ep[q] = (i32x4){eidx[4 * q], eidx[4 * q + 1], eidx[4 * q + 2], eidx[4 * q + 3]};
        } else { GAS f32x4* gp = (GAS f32x4*)(GATE + (size_t)tok * 128 + h * 16);
#pragma unroll
            for (int q = 0; q < 4; ++q) gp[q] = (f32x4){gt_[4 * q] * inv, gt_[4 * q + 1] * inv, gt_[4 * q + 2] * inv, gt_[4 * q + 3] * inv};
        }
    }
}

__device__ __forceinline__ float gelu_tanh(float x) {
    const float y = 1.5957691216057308f * (x + 0.044715f * x * x * x);
    return x / (1.0f + __expf(-y));
}
typedef int v8i __attribute__((ext_vector_type(8)));
#define PEER_MFMA(a, b, c) __builtin_amdgcn_mfma_scale_f32_16x16x128_f8f6f4(a, b, c, 4  , 0  , 0, 0x7F7F7F7F, 0, 0x7F7F7F7F)
__device__ __forceinline__ void peer_dots_phase(const Ptrs& P, LAS unsigned char* lds, int vcu, int G, int wave, int lane) {
    const int gw = vcu * NWAVES + wave, NGW = G * NWAVES;
    const bf16* HB = (const bf16*)(P.ws + WS_HB); float* CF = (float*)(P.ws + WS_CF);
    const int* EIDX = (const int*)(P.ws + WS_EIDX); const float* GATE = (const float*)(P.ws + WS_GATE);
    const unsigned char* U4 = P.ws + WS_U;
    const float* SU = (const float*)(P.ws + WS_SU); const float* SV = (const float*)(P.ws + WS_SV);
    LAS unsigned char* xl = lds + 65536 + wave * 1024;
    LAS unsigned char* tb = lds + wave * 8192;
    const int lr = lane >> 5, lp = lane & 31;
    const int li = lane & 15, lq = lane >> 4;
    const int kl = 4 * lq + (li & 3);
    int t = gw; if (t >= M) return;
    int ei0 = EIDX[(size_t)t * 128 + lane], ei1 = EIDX[(size_t)t * 128 + 64 + lane];
    float gg0 = GATE[(size_t)t * 128 + lane], gg1 = GATE[(size_t)t * 128 + 64 + lane];
    v2u hrow[4];
    { const GAS v2u* hp = (const GAS v2u*)(HB + (size_t)t * 1024) + lane;
#pragma unroll
      for (int j = 0; j < 4; ++j) hrow[j] = hp[64 * j]; }
    v4u uw[8];
#pragma unroll
    for (int v = 0; v < 8; ++v) { const int e = __shfl(ei0, 2 * v + lr); uw[v] = *(const GAS v4u*)(U4 + (size_t)e * 512 + 16 * lp); }
    for (; t < M; t += NGW) {
        const int tn = (t + NGW < M) ? t + NGW : t;
        f32x2 x[8]; float ss = 0.f;
#pragma unroll
        for (int j = 0; j < 4; ++j) { const unsigned wa = hrow[j].x, wb = hrow[j].y; x[2 * j] = (f32x2){bf_lo(wa), bf_hi(wa)}; x[2 * j + 1] = (f32x2){bf_lo(wb), bf_hi(wb)};
            ss += (x[2 * j].x * x[2 * j].x + x[2 * j].y * x[2 * j].y) + (x[2 * j + 1].x * x[2 * j + 1].x + x[2 * j + 1].y * x[2 * j + 1].y); }
        ss = wave_sum(ss);
        const float rstd = __builtin_amdgcn_rsqf(ss * (1.0f / 1024.0f) + EPS);
        { const float sx = 16.0f * rstd;
#pragma unroll
          for (int j = 0; j < 4; ++j) { int w = __builtin_amdgcn_cvt_pk_fp8_f32(x[2 * j].x * sx, x[2 * j].y * sx, 0, false); w = __builtin_amdgcn_cvt_pk_fp8_f32(x[2 * j + 1].x * sx, x[2 * j + 1].y * sx, w, true);
              const int n = 4 * lane + 256 * j, sN = n >> 7, nn = n & 127, hN = nn >> 6, qN = (nn & 63) >> 4, jN = nn & 15;
              *(LAS unsigned*)(xl + 128 * sN + 32 * qN + 16 * hN + jN) = (unsigned)w; }
          asm volatile("s_waitcnt lgkmcnt(0)" ::: "memory"); }
        v8i xb[8];
#pragma unroll
        for (int sI = 0; sI < 8; ++sI) { const v4u b0 = *(const LAS v4u*)(xl + 128 * sI + 32 * lq), b1 = *(const LAS v4u*)(xl + 128 * sI + 32 * lq + 16);
            xb[sI] = (v8i){(int)b0.x, (int)b0.y, (int)b0.z, (int)b0.w, (int)b1.x, (int)b1.y, (int)b1.z, (int)b1.w}; }
        const int nei0 = EIDX[(size_t)tn * 128 + lane], nei1 = EIDX[(size_t)tn * 128 + 64 + lane];
        const float ngg0 = GATE[(size_t)tn * 128 + lane], ngg1 = GATE[(size_t)tn * 128 + 64 + lane];
        { const GAS v2u* hn = (const GAS v2u*)(HB + (size_t)tn * 1024) + lane;
#pragma unroll
          for (int j = 0; j < 4; ++j) hrow[j] = hn[64 * j]; }
        for (int hq = 0; hq < 8 * REPS(7); ++hq) { const int hh = hq & 7;
            const int ereg = hh < 4 ? ei0 : ei1; const float greg = hh < 4 ? gg0 : gg1; const int lb = (hh & 3) * 16;
            const int el = __shfl(ereg, lb + kl);
            const float su = SU[el], sv = SV[el];
#pragma unroll
            for (int v = 0; v < 8; ++v) { const int r = 2 * v + lr; *(LAS v4u*)(tb + 512 * r + 16 * (lp ^ r)) = uw[v]; }
            __builtin_amdgcn_sched_barrier(0);
            { const bool lasth = (hq == 8 * REPS(7) - 1); const int hn = (hh + 1) & 7;
              const int nreg = lasth ? nei0 : (hn < 4 ? ei0 : ei1); const int nlb = (hn & 3) * 16;
#pragma unroll
              for (int v = 0; v < 8; ++v) { const int e = __shfl(nreg, nlb + 2 * v + lr); uw[v] = *(const GAS v4u*)(U4 + (size_t)e * 512 + 16 * lp); } }
            __builtin_amdgcn_sched_barrier(0);
            f32x4 acc = {0.f, 0.f, 0.f, 0.f};
#pragma unroll
            for (int sI = 0; sI < 8; ++sI) { const v4u af = *(const LAS v4u*)(tb + 512 * li + 16 * ((4 * sI + lq) ^ li));
                const v8i av = {(int)af.x, (int)af.y, (int)af.z, (int)af.w, 0, 0, 0, 0}; acc = PEER_MFMA(av, xb[sI], acc); }
            const int rsel = li & 3;
            const float d = rsel == 0 ? acc[0] : (rsel == 1 ? acc[1] : (rsel == 2 ? acc[2] : acc[3]));
            const float gk = __shfl(greg, lb + kl);
            const float cf = gk * gelu_tanh(d * su * (1.0f / 16.0f)) * sv * 1024.0f;
            if (li < 4) CF[(size_t)t * 128 + hh * 16 + kl] = cf;
        }
        ei0 = nei0; ei1 = nei1; gg0 = ngg0; gg1 = ngg1;
    }
}
__device__ __forceinline__ void peer_sum_phase(const Ptrs& P, int vcu, int G, int wave, int lane) {
    const int gw = vcu * NWAVES + wave, NGW = G * NWAVES;
    bf16* HB = (bf16*)(P.ws + WS_HB); float* RS2 = (float*)(P.ws + WS_RS2); const float* CF = (const float*)(P.ws + WS_CF);
    const int* EIDX = (const int*)(P.ws + WS_EIDX); const unsigned char* V4 = P.ws + WS_V;
    const int li = lane & 15, lq = lane >> 4;
    const unsigned bsh = 8u * (unsigned)(li & 3); const int breg = li >> 2;
    int t = gw; if (t >= M) return;
    int ei0 = EIDX[(size_t)t * 128 + lane], ei1 = EIDX[(size_t)t * 128 + 64 + lane];
    float cf0 = CF[(size_t)t * 128 + lane], cf1 = CF[(size_t)t * 128 + 64 + lane];
    v2u hrow[4];
    { const GAS v2u* hp = (const GAS v2u*)(HB + (size_t)t * 1024) + lane;
#pragma unroll
      for (int j = 0; j < 4; ++j) hrow[j] = hp[64 * j]; }
    v4u va[2][2], vb[2][2];
#pragma unroll
    for (int g8 = 0; g8 < 2; ++g8) {
        const int eA = __shfl(ei0, 8 * g8 + 2 * lq), eB = __shfl(ei0, 8 * g8 + 2 * lq + 1);
        const GAS v4u* pa = (const GAS v4u*)(V4 + (size_t)eA * 512 + 16 * li); const GAS v4u* pb = (const GAS v4u*)(V4 + (size_t)eB * 512 + 16 * li);
        va[g8][0] = pa[0]; va[g8][1] = pa[16]; vb[g8][0] = pb[0]; vb[g8][1] = pb[16];
    }
    for (; t < M; t += NGW) {
        const int tn = (t + NGW < M) ? t + NGW : t;
        const int nei0 = EIDX[(size_t)tn * 128 + lane], nei1 = EIDX[(size_t)tn * 128 + 64 + lane];
        const float ncf0 = CF[(size_t)tn * 128 + lane], ncf1 = CF[(size_t)tn * 128 + 64 + lane];
        f32x4 oacc[4];
#pragma unroll
        for (int b = 0; b < 4; ++b) oacc[b] = (f32x4){0.f, 0.f, 0.f, 0.f};
        for (int hq = 0; hq < 8 * REPS(11); ++hq) { const int hh = hq & 7;
            const float creg = hh < 4 ? cf0 : cf1; const int lb = (hh & 3) * 16;
            v8i bv[2];
#pragma unroll
            for (int g8 = 0; g8 < 2; ++g8) {
                float cA = __shfl(creg, lb + 8 * g8 + lq), cB = __shfl(creg, lb + 8 * g8 + 4 + lq);
                cA = fminf(fmaxf(cA, -448.0f), 448.0f); cB = fminf(fmaxf(cB, -448.0f), 448.0f);
                const unsigned pk = (unsigned)__builtin_amdgcn_cvt_pk_fp8_f32(cA, cB, 0, false);
                const unsigned wA = (pk & 0xffu) << bsh, wB = ((pk >> 8) & 0xffu) << bsh;
                bv[g8] = (v8i){breg == 0 ? (int)wA : 0, breg == 1 ? (int)wA : 0, breg == 2 ? (int)wA : 0, breg == 3 ? (int)wA : 0,
                               breg == 0 ? (int)wB : 0, breg == 1 ? (int)wB : 0, breg == 2 ? (int)wB : 0, breg == 3 ? (int)wB : 0};
            }
#pragma unroll
            for (int g8 = 0; g8 < 2; ++g8) {
                { const v8i a0 = {(int)va[g8][0].x, (int)va[g8][0].y, (int)vb[g8][0].x, (int)vb[g8][0].y, 0, 0, 0, 0}; oacc[0] = PEER_MFMA(a0, bv[g8], oacc[0]); }
                { const v8i a1 = {(int)va[g8][0].z, (int)va[g8][0].w, (int)vb[g8][0].z, (int)vb[g8][0].w, 0, 0, 0, 0}; oacc[1] = PEER_MFMA(a1, bv[g8], oacc[1]); }
                { const v8i a2 = {(int)va[g8][1].x, (int)va[g8][1].y, (int)vb[g8][1].x, (int)vb[g8][1].y, 0, 0, 0, 0}; oacc[2] = PEER_MFMA(a2, bv[g8], oacc[2]); }
                { const v8i a3 = {(int)va[g8][1].z, (int)va[g8][1].w, (int)vb[g8][1].z, (int)vb[g8][1].w, 0, 0, 0, 0}; oacc[3] = PEER_MFMA(a3, bv[g8], oacc[3]); }
            }
            __builtin_amdgcn_sched_barrier(0);
            { const bool lasth = (hq == 8 * REPS(11) - 1); const int hn = (hh + 1) & 7;
              const int nreg = lasth ? nei0 : (hn < 4 ? ei0 : ei1); const int nlb = (hn & 3) * 16;
#pragma unroll
              for (int g8 = 0; g8 < 2; ++g8) {
                  const int eA = __shfl(nreg, nlb + 8 * g8 + 2 * lq), eB = __shfl(nreg, nlb + 8 * g8 + 2 * lq + 1);
                  const GAS v4u* pa = (const GAS v4u*)(V4 + (size_t)eA * 512 + 16 * li); const GAS v4u* pb = (const GAS v4u*)(V4 + (size_t)eB * 512 + 16 * li);
                  va[g8][0] = pa[0]; va[g8][1] = pa[16]; vb[g8][0] = pb[0]; vb[g8][1] = pb[16];
              } }
            __builtin_amdgcn_sched_barrier(0);
        }
        const float osc = (REPS(11) == 2 ? 0.5f : 1.0f) * (1.0f / 1024.0f);
        float s2 = 0.f;
        GAS v2u* hb = (GAS v2u*)(HB + (size_t)t * 1024) + lane;
#pragma unroll
        for (int j = 0; j < 4; ++j) { const unsigned wa = hrow[j].x, wb = hrow[j].y;
            const f32x2 o0 = (f32x2){bf_lo(wa) + oacc[j][0] * osc, bf_hi(wa) + oacc[j][1] * osc}, o1 = (f32x2){bf_lo(wb) + oacc[j][2] * osc, bf_hi(wb) + oacc[j][3] * osc};
            hb[64 * j] = (v2u){pk2(o0.x, o0.y), pk2(o1.x, o1.y)};
            s2 += (o0.x * o0.x + o0.y * o0.y) + (o1.x * o1.x + o1.y * o1.y); }
        s2 = wave_sum(s2);
        if (lane == 0) RS2[t] = s2;
        { const GAS v2u* hn = (const GAS v2u*)(HB + (size_t)tn * 1024) + lane;
#pragma unroll
          for (int j = 0; j < 4; ++j) hrow[j] = hn[64 * j]; }
        ei0 = nei0; ei1 = nei1; cf0 = ncf0; cf1 = ncf1;
    }
}

__device__ __forceinline__ void final_phase(const Ptrs& P, int vcu, int G, int wave, int lane) {
    const int gw = vcu * NWAVES + wave, NGW = G * NWAVES; const float* RS3 = (const float*)(P.ws + WS_RS3); const bf16* H3 = (const bf16*)(P.ws + WS_PROJ);
    const GAS f32x4* gf = (const GAS f32x4*)P.g_final + lane;
    f32x4 g[4];
#pragma unroll
    for (int j = 0; j < 4; ++j) g[j] = gf[64 * j];
    for (int m0 = 2 * gw; m0 < M; m0 += 2 * NGW) {
        v2u hv[2][4]; float rs[2];
#pragma unroll
        for (int r = 0; r < 2; ++r) { const GAS v2u* hp = (const GAS v2u*)(H3 + (size_t)(m0 + r) * D) + lane;
#pragma unroll
            for (int j = 0; j < 4; ++j) hv[r][j] = hp[64 * j];
            rs[r] = 0.f; const GAS f32x4* rp = (const GAS f32x4*)(RS3 + (size_t)(m0 + r) * 16);
#pragma unroll
            for (int i = 0; i < 4; ++i) { const f32x4 a = rp[i]; rs[r] += (a.x + a.y) + (a.z + a.w); } }
#pragma unroll
        for (int r = 0; r < 2; ++r) { const float rstd = __builtin_amdgcn_rsqf(rs[r] * (1.0f / 1024.0f) + EPS);
            GAS f32x4* xr = (GAS f32x4*)(P.out + (size_t)(m0 + r) * D) + lane;
#pragma unroll
            for (int j = 0; j < 4; ++j) { const unsigned wa = hv[r][j].x, wb = hv[r][j].y; const f32x4 v = {bf_lo(wa), bf_hi(wa), bf_lo(wb), bf_hi(wb)}; xr[64 * j] = v * rstd * g[j]; } }
    }
}

struct Args { const float* in[17]; float* out; unsigned char* ws; int ph_lo, ph_hi; };
#ifndef PG8_SP2
#define PG8_SP2 true
#endif
#ifndef PG8_ALIGN
#define PG8_ALIGN true
#endif
__global__ void __launch_bounds__(NWAVES * 64, 2) mega_fwd(Args args) {
    extern __shared__ __attribute__((aligned(16))) unsigned char lds_raw[];
    LAS unsigned char* lds = (LAS unsigned char*)lds_raw;
    volatile LAS unsigned* MISC = (volatile LAS unsigned*)(lds + MISC_OFF);
    const int tid = threadIdx.x, lane = tid & 63, wave = __builtin_amdgcn_readfirstlane(tid >> 6);
    const int G = gridDim.x, bx = blockIdx.x; const int vcu = (G % 8 == 0) ? (bx % 8) * (G / 8) + bx / 8 : bx;
    Ptrs P;
    P.x = args.in[0]; P.p = args.in[1]; P.g_mix = args.in[2]; P.w_in = args.in[3]; P.conv_w = args.in[4]; P.pool_w = args.in[5]; P.pool_scale = args.in[6]; P.w_o = args.in[7];
    P.g_ffn = args.in[8]; P.w_q = args.in[9]; P.sub_keys = args.in[10]; P.eu = args.in[11]; P.ev = args.in[12]; P.g_ple = args.in[13]; P.w_gate = args.in[14]; P.w_proj = args.in[15]; P.g_final = args.in[16];
    P.out = args.out; P.ws = args.ws;
    gu32* ctl = (gu32*)(P.ws + WS_CTL);
    for (int u = tid; u < (LDS_BYTES - LDSCTL_OFF) / 4; u += NWAVES * 64) ((LAS unsigned*)(lds + LDSCTL_OFF))[u] = 0u;
    __syncthreads();
    XcdBarrier bar; bar.bar = (unsigned*)(ctl + CW_BAR); bar.x = 0; bar.st = nullptr;
    if (!MK_PER_PHASE) bar = xcd_barrier_post((unsigned*)(ctl + CW_BAR), MISC + 8);
    const int lo = args.ph_lo, hi = args.ph_hi;
#define IN(k) (lo <= (k) && (k) < hi)
#define SEAM(k) do { if (IN(k) && IN((k) + 1)) xcd_barrier(bar); } while (0)
    pg8::bf16_t* const WIN = (pg8::bf16_t*)(P.ws + WS_WIN); pg8::bf16_t* const WO = (pg8::bf16_t*)(P.ws + WS_WO); pg8::bf16_t* const WQ = (pg8::bf16_t*)(P.ws + WS_WQ);
    pg8::bf16_t* const WG = (pg8::bf16_t*)(P.ws + WS_WG); pg8::bf16_t* const WP = (pg8::bf16_t*)(P.ws + WS_WP);
    pg8::bf16_t* const XB = (pg8::bf16_t*)(P.ws + WS_XB); pg8::bf16_t* const PL = XB; pg8::bf16_t* const PROJ = (pg8::bf16_t*)(P.ws + WS_PROJ); pg8::bf16_t* const QB = PROJ;
    pg8::bf16_t* const MIX = (pg8::bf16_t*)(P.ws + WS_MIX); pg8::bf16_t* const HB = (pg8::bf16_t*)(P.ws + WS_HB); pg8::bf16_t* const PB = (pg8::bf16_t*)(P.ws + WS_PB);

    if (IN(0)) { for (int rep = 0; rep < REPS(1); ++rep) { p0a_phase(P, lds, vcu, G, tid, wave, lane); SEAM(0); } }
    if (IN(1)) { p0b_phase(P, lds, vcu, G, wave, lane); SEAM(1); }
    if (IN(2)) {
        pg8::Gemm g{XB, WIN, M, NPROJ, D}; pg8::StaticOrder S; S.init(M, NPROJ, G, bx);
        EpiBf16Row E{PROJ, NPROJ, (const float*)(P.ws + WS_RSX)};
        for (int rep = 0; rep < REPS(2); ++rep) { pg8::gemm_phase<EpiBf16Row, pg8::StaticOrder, PG8_ALIGN, PG8_SP2>(lds, g, S, E);
        SEAM(2); }
    }
    if (IN(3)) {
        for (int rep = 0; rep < REPS(3); ++rep) p2_phase(P, vcu, G, tid, wave);
        pg8::Gemm g{PB, WP, M, D, PLED}; pg8::StaticOrder S; S.init(M, D, G, bx);
        EpiBf16Row E{PL, D, nullptr};
        for (int rep = 0; rep < REPS(8); ++rep) pg8::gemm_phase<EpiBf16Row, pg8::StaticOrder, PG8_ALIGN, PG8_SP2>(lds, g, S, E);
        SEAM(3);
    }
    if (IN(4)) {
        pg8::Gemm g{MIX, WO, M, D, D}; pg8::StaticOrder S; S.init(M, D, G, bx);
        EpiH1 E{P.x, HB, (float*)(P.ws + WS_RS1)};
        for (int rep = 0; rep < REPS(4); ++rep) { pg8::gemm_phase<EpiH1, pg8::StaticOrder, PG8_ALIGN, PG8_SP2>(lds, g, S, E);
        SEAM(4); }
    }
    if (IN(5)) {
        pg8::Gemm g{HB, WQ, M, NQ, D}; pg8::StaticOrder S; S.init(M, NQ, G, bx);
        EpiBf16Row E{QB, NQ, nullptr};
        for (int rep = 0; rep < REPS(5); ++rep) { pg8::gemm_phase<EpiBf16Row, pg8::StaticOrder, PG8_ALIGN, PG8_SP2>(lds, g, S, E);
        SEAM(5); }
    }
    if (IN(6)) { for (int rep = 0; rep < REPS(6); ++rep) { score_phase(P, lds, bx, G, tid, wave, lane); SEAM(6); } }
    if (IN(7)) { peer_dots_phase(P, lds, vcu, G, wave, lane); SEAM(7); }
    if (IN(8)) { peer_sum_phase(P, vcu, G, wave, lane); SEAM(8); }
    if (IN(9)) {
        pg8::Gemm g{HB, WG, M, D, D}; pg8::StaticOrder S; S.init(M, D, G, bx);
        EpiGate E{PROJ  , HB, PL, (const float*)(P.ws + WS_RS2), (float*)(P.ws + WS_RS3)};
        pg8::gemm_phase<EpiGate, pg8::StaticOrder, PG8_ALIGN, PG8_SP2>(lds, g, S, E);
        SEAM(9);
    }
    if (IN(10)) { final_phase(P, vcu, G, wave, lane); }
#undef IN
#undef SEAM
}

extern "C" void kernel_launch(void* const* d_in, const int* in_sizes, int n_in, void* d_out, int out_size, void* d_ws, size_t ws_size, hipStream_t stream) {
    static int grid = 0;
    if (grid == 0) {
        if (n_in != 17 || in_sizes[0] != M * D || out_size != M * D || ws_size < WS_END) { fprintf(stderr, "kernel_launch: unexpected shapes (n_in %d, in0 %d, out %d, ws %zu); nothing launched\n", n_in, n_in > 0 ? in_sizes[0] : -1, out_size, ws_size); grid = -1; return; }
        int dev = 0, cus = 0, per_cu = 0;
        if (hipGetDevice(&dev) != hipSuccess || hipDeviceGetAttribute(&cus, hipDeviceAttributeMultiprocessorCount, dev) != hipSuccess) { fprintf(stderr, "kernel_launch: device query failed\n"); grid = -1; return; }
        if (hipFuncSetAttribute((const void*)mega_fwd, hipFuncAttributeMaxDynamicSharedMemorySize, LDS_BYTES) != hipSuccess) { fprintf(stderr, "kernel_launch: hipFuncSetAttribute failed\n"); grid = -1; return; }
        if (hipOccupancyMaxActiveBlocksPerMultiprocessor(&per_cu, (const void*)mega_fwd, NWAVES * 64, LDS_BYTES) != hipSuccess || per_cu < 1)
            fprintf(stderr, "kernel_launch: note: occupancy query reports %d workgroups per CU\n", per_cu);
        (void)hipGetLastError();
        grid = cus;
    }
    if (grid < 0) return;
    if (hipMemsetAsync((char*)d_ws + WS_CTL, 0, CTL_ZERO_BYTES, stream) != hipSuccess) { fprintf(stderr, "kernel_launch: memset failed\n"); return; }
    Args a{};
    for (int i = 0; i < 17; ++i) a.in[i] = (const float*)d_in[i];
    a.out = (float*)d_out; a.ws = (unsigned char*)d_ws;
#if MK_PER_PHASE
    for (int ph = 0; ph < NPHASES; ++ph) { a.ph_lo = ph; a.ph_hi = ph + 1; hipLaunchKernelGGL(mega_fwd, dim3(grid), dim3(NWAVES * 64), LDS_BYTES, stream, a); }
#else
    a.ph_lo = 0; a.ph_hi = NPHASES;
    hipLaunchKernelGGL(mega_fwd, dim3(grid), dim3(NWAVES * 64), LDS_BYTES, stream, a);
#endif
    const hipError_t le = hipPeekAtLastError();
    if (le != hipSuccess) fprintf(stderr, "kernel_launch: launch failed: %s\n", hipGetErrorName(le));
}
```

```cpp
#include <hip/hip_runtime.h>
#include <cstdio>
#include <cstdint>
namespace pg8 {
#define PG8_LAS __attribute__((address_space(3)))
typedef unsigned short bf16_t;
typedef short bf16x8 __attribute__((ext_vector_type(8)));
typedef float f32x4 __attribute__((ext_vector_type(4)));
typedef unsigned u32x4 __attribute__((ext_vector_type(4)));
constexpr int BM = 256, BK = 64, HALF = 128, HTB = HALF * BK * 2  , STAGE_BYTES = 8 * HTB, NXCD = 8, WGM = 8;

__host__ __device__ __forceinline__ int lds_byte(int r, int c) { const int st = (r >> 4) * 2 + (c >> 5), rr = r & 15, cc = c & 31, ob = rr * 64 + cc * 2; return st * 1024 + (ob ^ (((ob >> 9) & 1) << 5)); }
__host__ __device__ __forceinline__ void stage_rc(int b, int& R, int& C) { const int st = b / 1024, sb = b % 1024, swz = sb ^ (((sb >> 9) & 1) << 5); R = (st >> 1) * 16 + swz / 64; C = (st & 1) * 32 + (swz % 64) / 2; }
__host__ __device__ __forceinline__ int perm32(int rho) { const int n = rho >> 4, i = rho & 15; return 8 * (i >> 2) + 4 * n + (i & 3); }

struct Unit { int pm, pn; };
struct Gemm { const bf16_t* A; const bf16_t* Bt; int M, N, K; };

struct StaticOrder {
    int nM, nN, nwg, G, c;
    __host__ __device__ void init(int M, int N, int G_, int c_) { nM = M / BM; nN = N / BM; nwg = nM * nN; G = G_; c = c_; }
    __host__ __device__ bool next(int i, Unit& u) const {
        const long L = (long)i * G + c; if (L >= nwg) return false;
        int wgid = (int)L; { const int q = nwg / NXCD, r = nwg % NXCD, xcd = wgid % NXCD, off = wgid / NXCD; wgid = (xcd < r ? xcd * (q + 1) : r * (q + 1) + (xcd - r) * q) + off; }
        const int nig = WGM * nN, gid = wgid / nig, fm = gid * WGM, gsz = (nM - fm) < WGM ? (nM - fm) : WGM;
        u.pm = fm + ((wgid % nig) % gsz); u.pn = (wgid % nig) / gsz; return true;
    }
    __device__ __forceinline__ void a_ready(const Unit&) const {}
    __device__ __forceinline__ void done(const Unit&) const {}
};

__device__ __forceinline__ unsigned cvt_pk_bf16(float lo, float hi) { unsigned r; asm volatile("v_cvt_pk_bf16_f32 %0, %1, %2" : "=v"(r) : "v"(lo), "v"(hi)); return r; }
template <class Epi, class Sched, bool ALIGN_EPI = false, bool SP2 = false>
__device__ __forceinline__ void gemm_phase(PG8_LAS unsigned char* lds, const Gemm g, const Sched& S, const Epi& E) {
    const int tid = threadIdx.x, wid = __builtin_amdgcn_readfirstlane(tid >> 6), lane = tid & 63, wr = wid >> 2, wc = wid & 3, fr = lane & 15, fq = lane >> 4;
    const int K = g.K, nt = K / BK;
    unsigned voffA[2], voffB[2];
#pragma unroll
    for (int i = 0; i < 2; ++i) { int R, C; stage_rc(tid * 16 + i * 8192, R, C); const int Rb = Epi::PERM ? ((R & ~31) + perm32(R & 31)) : R;
        voffA[i] = (unsigned)(R * K + C) * 2u; voffB[i] = (unsigned)(Rb * K + C) * 2u; }
    const size_t kstep = (size_t)(BK * 2);
    const size_t hstep = (size_t)HALF * K * 2;
    const size_t tstep = 2 * hstep;
    const unsigned ldsw = (unsigned)wid * 1024u;
    const int aoff = lds_byte(wr * 64 + fr, fq * 8), boff = lds_byte(wc * 32 + fr, fq * 8);
#define PG8_SA(b, h) (((b) * 2 + (h)) * HTB)
#define PG8_SB(b, h) ((4 + (b) * 2 + (h)) * HTB)
#define PG8_STAGE(bufoff, gbase, voff) do { _Pragma("unroll") for (int _i = 0; _i < 2; ++_i) \
        __builtin_amdgcn_global_load_lds((const unsigned*)((const char*)(gbase) + (voff)[_i]), (PG8_LAS unsigned*)(lds + (bufoff) + ldsw + _i * 8192), 16, 0, 0); } while (0)
#define PG8_LDA(dst, b, h) do { _Pragma("unroll") for (int m = 0; m < 4; ++m) _Pragma("unroll") for (int k = 0; k < 2; ++k) dst[m][k] = *(const PG8_LAS bf16x8*)(lds + PG8_SA(b, h) + aoff + m * 2048 + k * 1024); } while (0)
#define PG8_LDB(dst, b, h) do { _Pragma("unroll") for (int n = 0; n < 2; ++n) _Pragma("unroll") for (int k = 0; k < 2; ++k) dst[n][k] = *(const PG8_LAS bf16x8*)(lds + PG8_SB(b, h) + boff + n * 2048 + k * 1024); } while (0)
#define PG8_MMA(ai, bj, At, Bt) do { __builtin_amdgcn_s_setprio(1); _Pragma("unroll") for (int m = 0; m < 4; ++m) _Pragma("unroll") for (int n = 0; n < 2; ++n) _Pragma("unroll") for (int k = 0; k < 2; ++k) \
        acc[ai][bj][m][n] = __builtin_amdgcn_mfma_f32_16x16x32_bf16(Bt[n][k], At[m][k], acc[ai][bj][m][n], 0, 0, 0); __builtin_amdgcn_s_setprio(0); } while (0)
#define PG8_WAIT_V(n) asm volatile("s_waitcnt vmcnt(" #n ")" ::: "memory")
#define PG8_WAIT_L(n) asm volatile("s_waitcnt lgkmcnt(" #n ")" ::: "memory")
#define PG8_BAR __builtin_amdgcn_s_barrier()
#define PG8_SCHED __builtin_amdgcn_sched_barrier(0)
    Unit cur, nxt; int ui = 0;
    if (!S.next(0, cur)) return;
    f32x4 acc[2][2][4][2];
#pragma unroll
    for (int a = 0; a < 2; ++a)
#pragma unroll
        for (int b = 0; b < 2; ++b)
#pragma unroll
            for (int m = 0; m < 4; ++m)
#pragma unroll
                for (int n = 0; n < 2; ++n) acc[a][b][m][n] = (f32x4){0.f, 0.f, 0.f, 0.f};
    bf16x8 At[4][2], B0[2][2], B1[2][2];
    const char* cA = (const char*)g.A + (size_t)cur.pm * tstep; const char* cB = (const char*)g.Bt + (size_t)cur.pn * tstep;
    S.a_ready(cur);
    if constexpr (SP2) {
        PG8_STAGE(PG8_SB(0, 0), cB, voffB); PG8_STAGE(PG8_SB(0, 1), cB + hstep, voffB); PG8_STAGE(PG8_SA(0, 0), cA, voffA); PG8_STAGE(PG8_SA(0, 1), cA + hstep, voffA);
        if (wr == 1) PG8_BAR;
        PG8_WAIT_V(2); PG8_BAR;
        PG8_STAGE(PG8_SB(1, 0), cB + kstep, voffB); PG8_STAGE(PG8_SA(1, 0), cA + kstep, voffA); PG8_STAGE(PG8_SB(1, 1), cB + hstep + kstep, voffB);
        PG8_WAIT_V(6); PG8_BAR;
    } else {
        PG8_STAGE(PG8_SB(0, 0), cB, voffB); PG8_STAGE(PG8_SA(0, 0), cA, voffA); PG8_STAGE(PG8_SB(0, 1), cB + hstep, voffB); PG8_STAGE(PG8_SA(0, 1), cA + hstep, voffA);
        if (wr == 1) PG8_BAR;
        PG8_WAIT_V(4); PG8_BAR;
        PG8_STAGE(PG8_SB(1, 0), cB + kstep, voffB); PG8_STAGE(PG8_SA(1, 0), cA + kstep, voffA); PG8_STAGE(PG8_SB(1, 1), cB + hstep + kstep, voffB);
        PG8_WAIT_V(6); PG8_BAR;
    }
    for (;;) {
        const bool has_next = S.next(ui + 1, nxt);
        const char* nA = has_next ? (const char*)g.A + (size_t)nxt.pm * tstep : cA; const char* nB = has_next ? (const char*)g.Bt + (size_t)nxt.pn * tstep : cB;
        for (int t = 0; t < nt; t += 2) {
            const bool last = (t == nt - 2);
            const char* a1 = cA + (size_t)(t + 1) * kstep;
            const char* a2 = last ? nA : cA + (size_t)(t + 2) * kstep; const char* b2 = last ? nB : cB + (size_t)(t + 2) * kstep;
            const char* a3 = a2 + kstep; const char* b3 = b2 + kstep;
            if (last && has_next) S.a_ready(nxt);
            if constexpr (SP2) {
            PG8_LDB(B0, 0, 0); PG8_LDB(B1, 0, 1); PG8_SCHED; PG8_LDA(At, 0, 0); PG8_STAGE(PG8_SA(1, 1), a1 + hstep, voffA);
            PG8_WAIT_V(8); PG8_WAIT_L(0); PG8_BAR; PG8_MMA(0, 0, At, B0); PG8_MMA(0, 1, At, B1); PG8_BAR; PG8_SCHED;
            PG8_LDA(At, 0, 1); PG8_STAGE(PG8_SB(0, 0), b2, voffB); PG8_STAGE(PG8_SB(0, 1), b2 + hstep, voffB); PG8_STAGE(PG8_SA(0, 0), a2, voffA);
            PG8_WAIT_V(8); PG8_WAIT_L(0); PG8_BAR; PG8_MMA(1, 0, At, B0); PG8_MMA(1, 1, At, B1); PG8_BAR; PG8_SCHED;
            PG8_LDB(B0, 1, 0); PG8_LDB(B1, 1, 1); PG8_SCHED; PG8_LDA(At, 1, 0); PG8_STAGE(PG8_SA(0, 1), a2 + hstep, voffA);
            PG8_WAIT_V(8); PG8_WAIT_L(0); PG8_BAR; PG8_MMA(0, 0, At, B0); PG8_MMA(0, 1, At, B1); PG8_BAR; PG8_SCHED;
            PG8_LDA(At, 1, 1); PG8_STAGE(PG8_SB(1, 0), b3, voffB); PG8_STAGE(PG8_SB(1, 1), b3 + hstep, voffB); PG8_STAGE(PG8_SA(1, 0), a3, voffA);
            PG8_WAIT_V(8); PG8_WAIT_L(0); PG8_BAR; PG8_MMA(1, 0, At, B0); PG8_MMA(1, 1, At, B1); PG8_BAR; PG8_SCHED;
            } else {
            PG8_LDB(B0, 0, 0); PG8_SCHED; PG8_LDA(At, 0, 0); PG8_STAGE(PG8_SA(1, 1), a1 + hstep, voffA);
            PG8_WAIT_L(8); PG8_BAR; PG8_WAIT_L(0); PG8_MMA(0, 0, At, B0); PG8_BAR; PG8_SCHED;
            PG8_LDB(B1, 0, 1); PG8_STAGE(PG8_SB(0, 0), b2, voffB);
            PG8_BAR; PG8_WAIT_L(0); PG8_MMA(0, 1, At, B1); PG8_BAR;
            PG8_LDA(At, 0, 1); PG8_STAGE(PG8_SA(0, 0), a2, voffA);
            PG8_BAR; PG8_WAIT_L(0); PG8_MMA(1, 0, At, B0); PG8_BAR; PG8_SCHED;
            PG8_STAGE(PG8_SB(0, 1), b2 + hstep, voffB);
            PG8_WAIT_V(6); PG8_BAR; PG8_MMA(1, 1, At, B1); PG8_BAR;
            PG8_LDB(B0, 1, 0); PG8_SCHED; PG8_LDA(At, 1, 0); PG8_STAGE(PG8_SA(0, 1), a2 + hstep, voffA);
            PG8_WAIT_L(8); PG8_BAR; PG8_WAIT_L(0); PG8_MMA(0, 0, At, B0); PG8_BAR; PG8_SCHED;
            PG8_LDB(B1, 1, 1); PG8_STAGE(PG8_SB(1, 0), b3, voffB);
            PG8_BAR; PG8_WAIT_L(0); PG8_MMA(0, 1, At, B1); PG8_BAR;
            PG8_LDA(At, 1, 1); PG8_STAGE(PG8_SA(1, 0), a3, voffA);
            PG8_BAR; PG8_WAIT_L(0); PG8_MMA(1, 0, At, B0); PG8_BAR; PG8_SCHED;
            PG8_STAGE(PG8_SB(1, 1), b3 + hstep, voffB);
            PG8_WAIT_V(6); PG8_BAR; PG8_MMA(1, 1, At, B1); PG8_BAR;
            }
        }
        if constexpr (ALIGN_EPI) { if (wr == 0) PG8_BAR; }
        if constexpr (!Epi::AFTER_DRAIN) { E(acc, cur, wr, wc, fr, fq);
            if constexpr (Epi::TWICE) { asm volatile("" ::: "memory"); E(acc, cur, wr, wc, fr, fq); }
            S.done(cur); }
        if (!has_next) break;
#pragma unroll
        for (int a = 0; a < 2; ++a)
#pragma unroll
            for (int b = 0; b < 2; ++b)
#pragma unroll
                for (int m = 0; m < 4; ++m)
#pragma unroll
                    for (int n = 0; n < 2; ++n) acc[a][b][m][n] = (f32x4){0.f, 0.f, 0.f, 0.f};
        cur = nxt; cA = nA; cB = nB; ++ui;
        if constexpr (ALIGN_EPI) { if (wr == 1) PG8_BAR; }
    }
    PG8_WAIT_V(0);
    if constexpr (!ALIGN_EPI) { if (wr == 0) PG8_BAR; }
    PG8_BAR;
    if constexpr (Epi::AFTER_DRAIN) { E.fused(acc, cur, wr, wc, fr, fq, lds, wid, lane); S.done(cur); }
#undef PG8_SA
#undef PG8_SB
#undef PG8_STAGE
#undef PG8_LDA
#undef PG8_LDB
#undef PG8_MMA
#undef PG8_WAIT_V
#undef PG8_WAIT_L
#undef PG8_BAR
#undef PG8_SCHED
}
}

#define GAS __attribute__((address_space(1)))
#define LAS __attribute__((address_space(3)))
typedef unsigned short bf16;
typedef unsigned v4u __attribute__((ext_vector_type(4)));
typedef float f32x4 __attribute__((ext_vector_type(4)));
typedef short bf16x8 __attribute__((ext_vector_type(8)));
typedef GAS unsigned gu32;
typedef GAS unsigned long long gu64;
#define RLX_AGENT __ATOMIC_RELAXED, __HIP_MEMORY_SCOPE_AGENT
#define LDS_WAIT() asm volatile("s_waitcnt lgkmcnt(0)" ::: "memory")
#define VM_WAIT() asm volatile("s_waitcnt vmcnt(0)" ::: "memory")
__device__ __forceinline__ unsigned long long rt() { return __builtin_amdgcn_s_memrealtime(); }
__device__ __forceinline__ unsigned f2bf(float f) { unsigned u = __builtin_bit_cast(unsigned, f); return (u + 0x7fffu + ((u >> 16) & 1u)) >> 16; }
__device__ __forceinline__ unsigned pk2(float lo, float hi) { return f2bf(lo) | (f2bf(hi) << 16); }

#define XB_TMO      128
#define XB_XCNT(j)  (256  + 64 * (j))
#define XB_XSUB(j)  (1280 + 64 * (j))
#define XB_XGEN(j)  (2304 + 64 * (j))
#define XB_TOP      3328
#define XB_TOPGEN   3392
#define XCD_BAR_WORDS 3456
#define XB_SPIN_CAP (1u << 18)

__device__ __forceinline__ unsigned xb_ld(unsigned* p)              { return __hip_atomic_load(p, __ATOMIC_RELAXED, __HIP_MEMORY_SCOPE_AGENT); }
__device__ __forceinline__ unsigned xb_add(unsigned* p, unsigned v) { return __hip_atomic_fetch_add(p, v, __ATOMIC_RELAXED, __HIP_MEMORY_SCOPE_AGENT); }
__device__ __forceinline__ unsigned xb_xcc_id() { return (unsigned)__builtin_amdgcn_s_getreg((3 << 11) | 20) & 0xFu; }
#define XB_SPIN(cond, bar) do { unsigned _sp = 0; while (cond) { __builtin_amdgcn_s_sleep(1); \
    if ((++_sp & 255u) == 0u) { if (xb_ld(&(bar)[XB_TMO])) break; if (_sp > XB_SPIN_CAP) { atomicAdd(&(bar)[XB_TMO], 1u); break; } } } } while (0)

struct XcdBarrier {
    unsigned* bar; unsigned x;
    volatile LAS unsigned* st;
};

__device__ __forceinline__ XcdBarrier xcd_barrier_post(unsigned* bar, volatile LAS unsigned* st) {
    XcdBarrier b; b.bar = bar; b.x = xb_xcc_id(); b.st = st;
    if (threadIdx.x == 0) (void)xb_add(&bar[XB_XCNT(b.x)], 1u);
    return b;
}
__device__ __forceinline__ void xcd_barrier_complete(unsigned* bar, unsigned x, unsigned& nloc, unsigned& nx) {
    const unsigned G = gridDim.x * gridDim.y * gridDim.z;
    unsigned sum, cnt, mine, sp = 0u;
    for (;;) {
        sum = 0u; cnt = 0u; mine = 0u;
#pragma unroll
        for (unsigned j = 0; j < 16; ++j) { const unsigned c = xb_ld(&bar[XB_XCNT(j)]); sum += c; cnt += (c > 0u) ? 1u : 0u; mine = (j == x) ? c : mine; }
        if (sum == G) break;
        __builtin_amdgcn_s_sleep(1);
        if ((++sp & 255u) == 0u) { if (xb_ld(&bar[XB_TMO])) break; if (sp > XB_SPIN_CAP) { atomicAdd(&bar[XB_TMO], 1u); break; } }
    }
    nloc = mine > 0u ? mine : 1u; nx = cnt > 0u ? cnt : 1u;
}

__device__ __forceinline__ void xcd_barrier(const XcdBarrier& b) {
    asm volatile("s_waitcnt vmcnt(0)" ::: "memory");
    __syncthreads();
    if (threadIdx.x == 0) {
        unsigned* bar = b.bar;
        __builtin_amdgcn_s_waitcnt(0);
        unsigned nloc = b.st[0], nx = b.st[1];
        if (nloc == 0u) { xcd_barrier_complete(bar, b.x, nloc, nx); b.st[0] = nloc; b.st[1] = nx; }
        const unsigned old = xb_add(&bar[XB_XSUB(b.x)], 1u);
        const unsigned gen = old / nloc;
        if (old + 1u == (gen + 1u) * nloc) {
            __builtin_amdgcn_fence(__ATOMIC_RELEASE, "agent");
            asm volatile("s_waitcnt vmcnt(0)" ::: "memory");
            const unsigned og = xb_add(&bar[XB_TOP], 1u);
            const unsigned tg = og / nx;
            if (og + 1u == (tg + 1u) * nx) xb_add(&bar[XB_TOPGEN], 1u);
            else XB_SPIN(xb_ld(&bar[XB_TOPGEN]) == tg, bar);
            __builtin_amdgcn_fence(__ATOMIC_ACQUIRE, "agent");
            xb_add(&bar[XB_XGEN(b.x)], 1u);
            asm volatile("s_waitcnt vmcnt(0)" ::: "memory");
        } else {
            XB_SPIN(xb_ld(&bar[XB_XGEN(b.x)]) == gen, bar);
            __builtin_amdgcn_fence(__ATOMIC_ACQUIRE, "agent");
            asm volatile("s_waitcnt vmcnt(0)" ::: "memory");
        }
    }
    __syncthreads();
}

#ifndef PROBE_REP
#define PROBE_REP 0
#endif
#define REPS(k) ((PROBE_REP == (k)) ? 2 : 1)
constexpr int NWAVES = 8;
constexpr int M = 32768, D = 1024, SEQ = 4096, NPROJ = 2048, NQ = 2048, PLED = 256, NEXP = 16384;
constexpr float EPS = 1e-6f;
#ifndef MK_PER_PHASE
#define MK_PER_PHASE 0
#endif
constexpr int NPHASES = 11;

constexpr size_t MiB = 1u << 20;
constexpr size_t WS_CTL = 0, CTL_ZERO_BYTES = 1 * MiB;
constexpr size_t WS_WIN = 2 * MiB, WS_WO = 6 * MiB, WS_WQ = 8 * MiB, WS_WG = 12 * MiB, WS_WP = 14 * MiB, WS_KEYS = 14 * MiB + 512 * 1024;
constexpr size_t WS_WF = 15 * MiB;
constexpr size_t WS_RSX = 17 * MiB, WS_RS2 = 17 * MiB + 512 * 1024, WS_RS1 = 18 * MiB, WS_RS3 = 20 * MiB;
constexpr size_t WS_SU = 22 * MiB, WS_SV = 22 * MiB + 65536;
constexpr size_t WS_U = 24 * MiB, WS_V = 56 * MiB;
constexpr size_t WS_XB = 88 * MiB;
constexpr size_t WS_PROJ = 152 * MiB;
constexpr size_t WS_MIX = 280 * MiB;
constexpr size_t WS_CF = WS_MIX;
constexpr size_t WS_HB = 344 * MiB;
constexpr size_t WS_EIDX = 408 * MiB, WS_GATE = 424 * MiB;
constexpr size_t WS_PB = 440 * MiB;
constexpr size_t WS_END = 456 * MiB;
constexpr int CW_BAR = 4096;
static_assert((CW_BAR + XCD_BAR_WORDS) * 4 <= (int)CTL_ZERO_BYTES, "CTL words inside the memset region");

constexpr int RING_BYTES = 131072;
constexpr int LDSCTL_OFF = RING_BYTES, MISC_OFF = LDSCTL_OFF + 320;
constexpr int LDS_BYTES = 147456;

typedef float f32x16 __attribute__((ext_vector_type(16)));
typedef _Float16 h2_t __attribute__((ext_vector_type(2)));
typedef float f32x2 __attribute__((ext_vector_type(2)));
typedef int i32x4 __attribute__((ext_vector_type(4)));
typedef unsigned v2u __attribute__((ext_vector_type(2)));

__device__ __forceinline__ float wave_sum(float v) {
#pragma unroll
    for (int o = 1; o < 64; o <<= 1) v += __shfl_xor(v, o);
    return v;
}
__device__ __forceinline__ float bf_lo(unsigned w) { return __uint_as_float(w << 16); }
__device__ __forceinline__ float bf_hi(unsigned w) { return __uint_as_float(w & 0xffff0000u); }
__device__ __forceinline__ unsigned pkh(float lo, float hi) { f32x2 v = {lo, hi}; h2_t h = __builtin_convertvector(v, h2_t); return __builtin_bit_cast(unsigned, h); }

struct EpiBf16Row {
    static constexpr bool PERM = true, AFTER_DRAIN = false, TWICE = (PROBE_REP == 12);
    pg8::bf16_t* O; int ldc; const float* rowss;
    __device__ __forceinline__ void operator()(const pg8::f32x4 (&acc)[2][2][4][2], const pg8::Unit& u, int wr, int wc, int fr, int fq) const {
        const int row0 = u.pm * 256 + wr * 64 + fr, col0 = u.pn * 256 + wc * 32 + 8 * fq;
#pragma unroll
        for (int ai = 0; ai < 2; ++ai)
#pragma unroll
            for (int m = 0; m < 4; ++m) {
                const int row = row0 + ai * 128 + m * 16;
                const float sc = rowss ? __builtin_amdgcn_rsqf(rowss[row] * (1.0f / 1024.0f) + EPS) : 1.0f;
                pg8::bf16_t* rowp = O + (size_t)row * ldc + col0;
#pragma unroll
                for (int bj = 0; bj < 2; ++bj) {
                    const pg8::f32x4 v0 = acc[ai][bj][m][0] * sc, v1 = acc[ai][bj][m][1] * sc;
                    pg8::u32x4 w; w.x = pg8::cvt_pk_bf16(v0[0], v0[1]); w.y = pg8::cvt_pk_bf16(v0[2], v0[3]); w.z = pg8::cvt_pk_bf16(v1[0], v1[1]); w.w = pg8::cvt_pk_bf16(v1[2], v1[3]);
                    *(pg8::u32x4*)(rowp + bj * 128) = w;
                }
            }
    }
};
struct EpiH1 {
    static constexpr bool PERM = true, AFTER_DRAIN = false, TWICE = (PROBE_REP == 13);
    const float* X; pg8::bf16_t* HB; float* RS;
    __device__ __forceinline__ void operator()(const pg8::f32x4 (&acc)[2][2][4][2], const pg8::Unit& u, int wr, int wc, int fr, int fq) const {
        const int row0 = u.pm * 256 + wr * 64 + fr, col0 = u.pn * 256 + wc * 32 + 8 * fq;
#pragma unroll
        for (int ai = 0; ai < 2; ++ai)
#pragma unroll
            for (int m = 0; m < 4; ++m) {
                const int row = row0 + ai * 128 + m * 16; float s = 0.f;
#pragma unroll
                for (int bj = 0; bj < 2; ++bj) {
                    const size_t off = (size_t)row * 1024 + col0 + bj * 128;
                    const pg8::f32x4 x0 = *(const pg8::f32x4*)(X + off), x1 = *(const pg8::f32x4*)(X + off + 4);
                    const pg8::f32x4 v0 = acc[ai][bj][m][0] + x0, v1 = acc[ai][bj][m][1] + x1;
                    pg8::u32x4 w; w.x = pg8::cvt_pk_bf16(v0[0], v0[1]); w.y = pg8::cvt_pk_bf16(v0[2], v0[3]); w.z = pg8::cvt_pk_bf16(v1[0], v1[1]); w.w = pg8::cvt_pk_bf16(v1[2], v1[3]);
                    *(pg8::u32x4*)(HB + off) = w;
                    s += (v0[0] * v0[0] + v0[1] * v0[1]) + (v0[2] * v0[2] + v0[3] * v0[3]) + (v1[0] * v1[0] + v1[1] * v1[1]) + (v1[2] * v1[2] + v1[3] * v1[3]);
                }
                s += __shfl_xor(s, 16); s += __shfl_xor(s, 32);
                if (fq == 0) RS[(size_t)row * 16 + u.pn * 4 + wc] = s;
            }
    }
};
struct EpiGate {
    static constexpr bool PERM = true, AFTER_DRAIN = false, TWICE = (PROBE_REP == 14);
    pg8::bf16_t* OUT; const pg8::bf16_t* HB; const pg8::bf16_t* PL; const float* RS2; float* RS3;
    __device__ __forceinline__ void operator()(const pg8::f32x4 (&acc)[2][2][4][2], const pg8::Unit& u, int wr, int wc, int fr, int fq) const {
        const int row0 = u.pm * 256 + wr * 64 + fr, col0 = u.pn * 256 + wc * 32 + 8 * fq;
#pragma unroll
        for (int ai = 0; ai < 2; ++ai)
#pragma unroll
            for (int m = 0; m < 4; ++m) {
                const int row = row0 + ai * 128 + m * 16; float s = 0.f;
                const float rstd = __builtin_amdgcn_rsqf(RS2[row] * (1.0f / 1024.0f) + EPS);
#pragma unroll
                for (int bj = 0; bj < 2; ++bj) {
                    const size_t off = (size_t)row * 1024 + col0 + bj * 128;
                    const pg8::u32x4 w = *(const pg8::u32x4*)(PL + off), hw = *(const pg8::u32x4*)(HB + off);
                    const pg8::f32x4 h0 = {bf_lo(hw.x), bf_hi(hw.x), bf_lo(hw.y), bf_hi(hw.y)}, h1 = {bf_lo(hw.z), bf_hi(hw.z), bf_lo(hw.w), bf_hi(hw.w)};
                    const pg8::f32x4 a0 = acc[ai][bj][m][0] * rstd, a1 = acc[ai][bj][m][1] * rstd;
                    pg8::f32x4 g0, g1;
#pragma unroll
                    for (int e = 0; e < 4; ++e) { g0[e] = 1.0f / (1.0f + __expf(-a0[e])); g1[e] = 1.0f / (1.0f + __expf(-a1[e])); }
                    const pg8::f32x4 p0 = {bf_lo(w.x), bf_hi(w.x), bf_lo(w.y), bf_hi(w.y)}, p1 = {bf_lo(w.z), bf_hi(w.z), bf_lo(w.w), bf_hi(w.w)};
                    const pg8::f32x4 v0 = h0 + g0 * p0, v1 = h1 + g1 * p1;
                    { pg8::u32x4 ow; ow.x = pg8::cvt_pk_bf16(v0[0], v0[1]); ow.y = pg8::cvt_pk_bf16(v0[2], v0[3]); ow.z = pg8::cvt_pk_bf16(v1[0], v1[1]); ow.w = pg8::cvt_pk_bf16(v1[2], v1[3]); *(pg8::u32x4*)(OUT + off) = ow; }
                    s += (v0[0] * v0[0] + v0[1] * v0[1]) + (v0[2] * v0[2] + v0[3] * v0[3]) + (v1[0] * v1[0] + v1[1] * v1[1]) + (v1[2] * v1[2] + v1[3] * v1[3]);
                }
                s += __shfl_xor(s, 16); s += __shfl_xor(s, 32);
                if (fq == 0) RS3[(size_t)row * 16 + u.pn * 4 + wc] = s;
            }
    }
};

__device__ __forceinline__ void p0_transpose_item(const float* W, int ldn, const float* gk, int K, bf16* WT, int row_off, int nblk, LAS float* scr, int item, int lane) {
    const int kb = item / nblk, nb = item % nblk, k0 = 64 * kb, n0 = 32 * nb;
    float wv[32];
#pragma unroll
    for (int i = 0; i < 32; ++i) wv[i] = W[(size_t)(k0 + 2 * i + (lane >> 5)) * ldn + n0 + (lane & 31)];
#pragma unroll
    for (int i = 0; i < 32; ++i) { const int kk = 2 * i + (lane >> 5); float v = wv[i]; if (gk) v *= gk[k0 + kk]; scr[kk * 33 + (lane & 31)] = v; }
    LDS_WAIT(); asm volatile("" ::: "memory");
    const int c = lane & 7;
#pragma unroll
    for (int j = 0; j < 4; ++j) { const int n = (lane >> 3) + 8 * j; const LAS float* s = scr + (8 * c) * 33 + n;
        v4u o; o.x = pk2(s[0 * 33], s[1 * 33]); o.y = pk2(s[2 * 33], s[3 * 33]); o.z = pk2(s[4 * 33], s[5 * 33]); o.w = pk2(s[6 * 33], s[7 * 33]);
        *(GAS v4u*)(WT + (size_t)(row_off + n0 + n) * K + k0 + 8 * c) = o; }
    LDS_WAIT(); asm volatile("" ::: "memory");
}

struct Ptrs {
    const float *x, *p, *g_mix, *w_in, *conv_w, *pool_w, *pool_scale, *w_o, *g_ffn, *w_q, *sub_keys, *eu, *ev, *g_ple, *w_gate, *w_proj, *g_final;
    float* out; unsigned char* ws;
};

__device__ __forceinline__ void p0a_phase(const Ptrs& P, LAS unsigned char* lds, int vcu, int G, int tid, int wave, int lane) {
    const int gw = vcu * 4 + (wave & 3), NGW = G * 4;
    const int gt = gw * 64 + lane, NGT = NGW * 64;
    if (wave < 4) {
    { float* Wf = (float*)(P.ws + WS_WF);
      for (int tk = gw; tk < 2048; tk += NGW) {
          const int k4 = (tk >> 3) * 4, j = tk & 7, g = j >> 1, np = j * 64 + lane, d = np & 127;
          const float* wi = P.w_in + (size_t)k4 * 2048 + 1536 + g * 128; const float* pw = P.pool_w + (size_t)g * 128 * 128 + d;
          float a0 = 0.f, a1 = 0.f, a2 = 0.f, a3 = 0.f;
          for (int c0 = 0; c0 < 128; c0 += 16) {
              float pv[16], w0[16], w1[16], w2[16], w3[16];
#pragma unroll
              for (int c = 0; c < 16; ++c) { pv[c] = pw[(size_t)(c0 + c) * 128]; w0[c] = wi[c0 + c]; w1[c] = wi[2048 + c0 + c]; w2[c] = wi[4096 + c0 + c]; w3[c] = wi[6144 + c0 + c]; }
#pragma unroll
              for (int c = 0; c < 16; ++c) { a0 += w0[c] * pv[c]; a1 += w1[c] * pv[c]; a2 += w2[c] * pv[c]; a3 += w3[c] * pv[c]; }
          }
          const float sc = P.pool_scale[np];
          Wf[(size_t)k4 * 512 + np] = a0 * sc; Wf[(size_t)(k4 + 1) * 512 + np] = a1 * sc; Wf[(size_t)(k4 + 2) * 512 + np] = a2 * sc; Wf[(size_t)(k4 + 3) * 512 + np] = a3 * sc;
      } }
    { LAS float* scr = (LAS float*)(lds + wave * 16384);
      constexpr int I_WO = 16 * 32, I_WQ = 16 * 64, I_WG = 16 * 32, I_WP = 4 * 32, I_WINA = 16 * 48;
      constexpr int NITEMS = I_WO + I_WQ + I_WG + I_WP + I_WINA;
      for (int it = gw; it < NITEMS; it += NGW) {
          int r = it;
          if (r < I_WO) { p0_transpose_item(P.w_o, 1024, nullptr, 1024, (bf16*)(P.ws + WS_WO), 0, 32, scr, r, lane); continue; } r -= I_WO;
          if (r < I_WQ) { p0_transpose_item(P.w_q, 2048, P.g_ffn, 1024, (bf16*)(P.ws + WS_WQ), 0, 64, scr, r, lane); continue; } r -= I_WQ;
          if (r < I_WG) { p0_transpose_item(P.w_gate, 1024, P.g_ple, 1024, (bf16*)(P.ws + WS_WG), 0, 32, scr, r, lane); continue; } r -= I_WG;
          if (r < I_WP) { p0_transpose_item(P.w_proj, 1024, nullptr, 256, (bf16*)(P.ws + WS_WP), 0, 32, scr, r, lane); continue; } r -= I_WP;
          p0_transpose_item(P.w_in, 2048, P.g_mix, 1024, (bf16*)(P.ws + WS_WIN), 0, 48, scr, r, lane);
      } }
    } else {
    { for (int r0 = 4 * gw; r0 < NEXP; r0 += 4 * NGW) {
          f32x4 a[4][4]; float q[4];
#pragma unroll
          for (int rr = 0; rr < 4; ++rr) { const GAS f32x4* src = (const GAS f32x4*)(P.eu + (size_t)(r0 + rr) * 1024);
#pragma unroll
              for (int j = 0; j < 4; ++j) a[rr][j] = src[4 * lane + j]; }
          { const GAS f32x4* gf = (const GAS f32x4*)P.g_ffn + 4 * lane;
#pragma unroll
            for (int j = 0; j < 4; ++j) { const f32x4 g = gf[j];
#pragma unroll
                for (int rr = 0; rr < 4; ++rr) a[rr][j] = a[rr][j] * g; } }
#pragma unroll
          for (int rr = 0; rr < 4; ++rr) { q[rr] = 0.f;
#pragma unroll
              for (int j = 0; j < 4; ++j) q[rr] += (a[rr][j].x * a[rr][j].x + a[rr][j].y * a[rr][j].y) + (a[rr][j].z * a[rr][j].z + a[rr][j].w * a[rr][j].w); }
#pragma unroll
          for (int o = 1; o < 64; o <<= 1) { q[0] += __shfl_xor(q[0], o); q[1] += __shfl_xor(q[1], o); q[2] += __shfl_xor(q[2], o); q[3] += __shfl_xor(q[3], o); }
#pragma unroll
          for (int rr = 0; rr < 4; ++rr) { const int e = r0 + rr;
              const float rms = sqrtf(q[rr] * (1.0f / 1024.0f)); const float sc = rms > 0.f ? 2.0f / rms : 0.f;
              unsigned w0 = 0u, w1 = 0u;
              w0 = __builtin_amdgcn_cvt_scalef32_pk_fp4_f32(w0, a[rr][0].x * sc, a[rr][0].y * sc, 1.0f, 0); w0 = __builtin_amdgcn_cvt_scalef32_pk_fp4_f32(w0, a[rr][0].z * sc, a[rr][0].w * sc, 1.0f, 1);
              w0 = __builtin_amdgcn_cvt_scalef32_pk_fp4_f32(w0, a[rr][1].x * sc, a[rr][1].y * sc, 1.0f, 2); w0 = __builtin_amdgcn_cvt_scalef32_pk_fp4_f32(w0, a[rr][1].z * sc, a[rr][1].w * sc, 1.0f, 3);
              w1 = __builtin_amdgcn_cvt_scalef32_pk_fp4_f32(w1, a[rr][2].x * sc, a[rr][2].y * sc, 1.0f, 0); w1 = __builtin_amdgcn_cvt_scalef32_pk_fp4_f32(w1, a[rr][2].z * sc, a[rr][2].w * sc, 1.0f, 1);
              w1 = __builtin_amdgcn_cvt_scalef32_pk_fp4_f32(w1, a[rr][3].x * sc, a[rr][3].y * sc, 1.0f, 2); w1 = __builtin_amdgcn_cvt_scalef32_pk_fp4_f32(w1, a[rr][3].z * sc, a[rr][3].w * sc, 1.0f, 3);
              ((GAS v2u*)(P.ws + WS_U))[(size_t)e * 64 + lane] = (v2u){w0, w1};
              if (lane == 0) ((float*)(P.ws + WS_SU))[e] = rms * 0.5f; }
      } }
    { const int ci = lane >> 2, cb = lane & 3; const int eoff = 256 * cb + 64 * (ci >> 2) + (ci & 3);
      for (int r0 = 2 * gw; r0 < NEXP; r0 += 2 * NGW) {
          float v[2][16]; float q[2];
#pragma unroll
          for (int rr = 0; rr < 2; ++rr) { const float* src = P.ev + (size_t)(r0 + rr) * 1024 + eoff;
#pragma unroll
              for (int n = 0; n < 16; ++n) v[rr][n] = src[4 * n]; }
#pragma unroll
          for (int rr = 0; rr < 2; ++rr) { q[rr] = 0.f;
#pragma unroll
              for (int n = 0; n < 16; ++n) q[rr] += v[rr][n] * v[rr][n]; }
#pragma unroll
          for (int o = 1; o < 64; o <<= 1) { q[0] += __shfl_xor(q[0], o); q[1] += __shfl_xor(q[1], o); }
#pragma unroll
          for (int rr = 0; rr < 2; ++rr) { const int e = r0 + rr;
              const float rms = sqrtf(q[rr] * (1.0f / 1024.0f)); const float sc = rms > 0.f ? 2.0f / rms : 0.f;
              unsigned w0 = 0u, w1 = 0u;
              w0 = __builtin_amdgcn_cvt_scalef32_pk_fp4_f32(w0, v[rr][0] * sc, v[rr][1] * sc, 1.0f, 0); w0 = __builtin_amdgcn_cvt_scalef32_pk_fp4_f32(w0, v[rr][2] * sc, v[rr][3] * sc, 1.0f, 1);
              w0 = __builtin_amdgcn_cvt_scalef32_pk_fp4_f32(w0, v[rr][4] * sc, v[rr][5] * sc, 1.0f, 2); w0 = __builtin_amdgcn_cvt_scalef32_pk_fp4_f32(w0, v[rr][6] * sc, v[rr][7] * sc, 1.0f, 3);
              w1 = __builtin_amdgcn_cvt_scalef32_pk_fp4_f32(w1, v[rr][8] * sc, v[rr][9] * sc, 1.0f, 0); w1 = __builtin_amdgcn_cvt_scalef32_pk_fp4_f32(w1, v[rr][10] * sc, v[rr][11] * sc, 1.0f, 1);
              w1 = __builtin_amdgcn_cvt_scalef32_pk_fp4_f32(w1, v[rr][12] * sc, v[rr][13] * sc, 1.0f, 2); w1 = __builtin_amdgcn_cvt_scalef32_pk_fp4_f32(w1, v[rr][14] * sc, v[rr][15] * sc, 1.0f, 3);
              ((GAS v2u*)(P.ws + WS_V))[(size_t)e * 64 + (cb >> 1) * 32 + 2 * ci + (cb & 1)] = (v2u){w0, w1};
              if (lane == 0) ((float*)(P.ws + WS_SV))[e] = rms * 0.5f; }
      } }
    { const GAS f32x4* sp = (const GAS f32x4*)P.p; GAS v4u* dp = (GAS v4u*)(P.ws + WS_PB);
      for (int i0 = gt; i0 < M * PLED / 8; i0 += 4 * NGT) {
          f32x4 a[4], b[4];
#pragma unroll
          for (int q = 0; q < 4; ++q) { const int i = i0 + q * NGT; if (i < M * PLED / 8) { a[q] = sp[2 * (size_t)i]; b[q] = sp[2 * (size_t)i + 1]; } }
#pragma unroll
          for (int q = 0; q < 4; ++q) { const int i = i0 + q * NGT; if (i < M * PLED / 8) { v4u o; o.x = pk2(a[q].x, a[q].y); o.y = pk2(a[q].z, a[q].w); o.z = pk2(b[q].x, b[q].y); o.w = pk2(b[q].z, b[q].w); dp[i] = o; } }
      }
      const GAS f32x4* sk = (const GAS f32x4*)P.sub_keys; GAS v4u* dk = (GAS v4u*)(P.ws + WS_KEYS);
      for (int i = gt; i < 16 * 128 * 128 / 8; i += NGT) { const f32x4 a = sk[2 * (size_t)i], b = sk[2 * (size_t)i + 1]; v4u o; o.x = pk2(a.x, a.y); o.y = pk2(a.z, a.w); o.z = pk2(b.x, b.y); o.w = pk2(b.z, b.w); dk[i] = o; } }
    { float* RSX = (float*)(P.ws + WS_RSX); bf16* XB = (bf16*)(P.ws + WS_XB);
      for (int m0 = 4 * gw; m0 < M; m0 += 4 * NGW) {
          f32x4 v[4][4]; float sq[4];
#pragma unroll
          for (int r = 0; r < 4; ++r) { const GAS f32x4* xr = (const GAS f32x4*)(P.x + (size_t)(m0 + r) * D) + lane;
#pragma unroll
              for (int j = 0; j < 4; ++j) v[r][j] = xr[64 * j]; }
#pragma unroll
          for (int r = 0; r < 4; ++r) { sq[r] = 0.f;
#pragma unroll
              for (int j = 0; j < 4; ++j) sq[r] += (v[r][j].x * v[r][j].x + v[r][j].y * v[r][j].y) + (v[r][j].z * v[r][j].z + v[r][j].w * v[r][j].w); }
#pragma unroll
          for (int o = 1; o < 64; o <<= 1) {
#pragma unroll
              for (int r = 0; r < 4; ++r) sq[r] += __shfl_xor(sq[r], o); }
#pragma unroll
          for (int r = 0; r < 4; ++r) { if (lane == 0) RSX[m0 + r] = sq[r];
              GAS unsigned long long* o8 = (GAS unsigned long long*)(XB + (size_t)(m0 + r) * D) + lane;
#pragma unroll
              for (int j = 0; j < 4; ++j) o8[64 * j] = (unsigned long long)pk2(v[r][j].x, v[r][j].y) | ((unsigned long long)pk2(v[r][j].z, v[r][j].w) << 32); }
      } }
    }
}
__device__ __forceinline__ void p0b_phase(const Ptrs& P, LAS unsigned char* lds, int vcu, int G, int wave, int lane) {
    const int gw = vcu * NWAVES + wave, NGW = G * NWAVES; LAS float* scr = (LAS float*)(lds + wave * 16384);
    for (int it = gw; it < 16 * 16; it += NGW) p0_transpose_item((const float*)(P.ws + WS_WF), 512, P.g_mix, 1024, (bf16*)(P.ws + WS_WIN), 1536, 16, scr, it, lane);
}

template <int HALF>
__device__ __forceinline__ void pool_chunk(const unsigned* col, unsigned* mx, int t0, int s0) {
    constexpr int TC = 32, NV = TC + 2 * HALF;
    float v0[NV], v1[NV];
#pragma unroll
    for (int i = 0; i < NV; ++i) {
        const int s = s0 - HALF + i; const bool ok = (s >= 0) && (s < SEQ);
        const unsigned w = col[(size_t)(ok ? (t0 - HALF + i) : t0) * 1024];
        v0[i] = ok ? bf_lo(w) : 0.f; v1[i] = ok ? bf_hi(w) : 0.f;
    }
    float S0 = 0.f, S1 = 0.f;
#pragma unroll
    for (int j = 0; j < 2 * HALF; ++j) { S0 += v0[j]; S1 += v1[j]; }
#pragma unroll
    for (int i = 0; i < TC; ++i) {
        const int s = s0 + i; const int lo = (s - HALF) > 0 ? (s - HALF) : 0, hi = (s + HALF) < SEQ ? (s + HALF) : SEQ;
        const float inv = 1.0f / (float)(hi - lo);
        mx[(size_t)(t0 + i) * 512] = pk2(S0 * inv - v0[i + HALF], S1 * inv - v1[i + HALF]);
        if (i + 1 < TC) { S0 += v0[i + 2 * HALF] - v0[i]; S1 += v1[i + 2 * HALF] - v1[i]; }
    }
}
__device__ __forceinline__ void p2_phase(const Ptrs& P, int vcu, int G, int tid, int wave) {
    const unsigned* PR = (const unsigned*)(P.ws + WS_PROJ);
    unsigned* MX = (unsigned*)(P.ws + WS_MIX);
    constexpr int TC = 32;
    for (int ck = vcu; ck < M / TC; ck += G) {
        const int t0 = ck * TC, s0 = t0 & (SEQ - 1);
        if (tid < 256) {
            const unsigned* col = PR + 768 + tid; unsigned* mx = MX + 256 + tid;
            if (wave == 0) pool_chunk<1>(col, mx, t0, s0); else if (wave == 1) pool_chunk<2>(col, mx, t0, s0); else if (wave == 2) pool_chunk<4>(col, mx, t0, s0); else pool_chunk<8>(col, mx, t0, s0);
        } else {
            const int cp = tid - 256;
            const unsigned* bcol = PR + cp; const unsigned* ccol = PR + 256 + cp; const unsigned* vcol = PR + 512 + cp;
            const float w00 = P.conv_w[2 * cp], w01 = P.conv_w[2 * cp + 1], w10 = P.conv_w[512 + 2 * cp], w11 = P.conv_w[512 + 2 * cp + 1], w20 = P.conv_w[1024 + 2 * cp], w21 = P.conv_w[1024 + 2 * cp + 1];
            float z0[TC + 2], z1[TC + 2]; unsigned bw[TC];
#pragma unroll
            for (int i = 0; i < TC + 2; ++i) {
                const int s = s0 - 1 + i; const bool ok = (s >= 0) && (s < SEQ); const size_t t = (size_t)(ok ? (t0 - 1 + i) : t0) * 1024;
                const unsigned c = ccol[t], v = vcol[t];
                z0[i] = ok ? bf_lo(c) * bf_lo(v) : 0.f; z1[i] = ok ? bf_hi(c) * bf_hi(v) : 0.f;
            }
#pragma unroll
            for (int i = 0; i < TC; ++i) bw[i] = bcol[(size_t)(t0 + i) * 1024];
#pragma unroll
            for (int i = 0; i < TC; ++i) {
                const float y0 = w00 * z0[i] + w10 * z0[i + 1] + w20 * z0[i + 2], y1 = w01 * z1[i] + w11 * z1[i + 1] + w21 * z1[i + 2];
                MX[(size_t)(t0 + i) * 512 + cp] = pk2(bf_lo(bw[i]) * y0, bf_hi(bw[i]) * y1);
            }
        }
    }
}

__device__ __forceinline__ float fmax_s(float a, float b) { float r; asm("v_max_f32_e32 %0, %1, %2" : "=v"(r) : "v"(a), "v"(b)); return r; }
__device__ __forceinline__ float fmin_s(float a, float b) { float r; asm("v_min_f32_e32 %0, %1, %2" : "=v"(r) : "v"(a), "v"(b)); return r; }
#define CE_DESC(a, b) do { const float _t = fmax_s(a, b); b = fmin_s(a, b); a = _t; } while (0)
#define CE_ASC(a, b)  do { const float _t = fmin_s(a, b); b = fmax_s(a, b); a = _t; } while (0)
__device__ __forceinline__ void sort16_desc(float* a) {
#pragma unroll
    for (int k = 2; k <= 16; k <<= 1)
#pragma unroll
        for (int j = k >> 1; j > 0; j >>= 1)
#pragma unroll
            for (int i = 0; i < 16; ++i) { const int l = i ^ j; if (l > i) { if ((i & k) == 0) CE_DESC(a[i], a[l]); else CE_ASC(a[i], a[l]); } }
}
__device__ __forceinline__ void merge16_desc(float* a) {
#pragma unroll
    for (int j = 8; j > 0; j >>= 1)
#pragma unroll
        for (int i = 0; i < 16; ++i) { const int l = i ^ j; if (l > i) CE_DESC(a[i], a[l]); }
}
__device__ __forceinline__ void top16_merge(float* a, const float* b) {
#pragma unroll
    for (int i = 0; i < 16; ++i) a[i] = fmax_s(a[i], b[15 - i]);
    merge16_desc(a);
}
__device__ __forceinline__ void top16_of_64(float* v) {
    sort16_desc(v); sort16_desc(v + 16); sort16_desc(v + 32); sort16_desc(v + 48);
    top16_merge(v, v + 16); top16_merge(v + 32, v + 48); top16_merge(v, v + 32);
}
__device__ __forceinline__ unsigned key_lookup(unsigned long long lo, unsigned long long hi, unsigned i) {
    const unsigned long long v = (i & 8u) ? hi : lo;
    return (unsigned)(v >> ((i & 7u) * 8u)) & 0x7fu;
}

constexpr int KROW = 272;
__device__ __forceinline__ void score_phase(const Ptrs& P, LAS unsigned char* lds, int bid, int G, int tid, int wave, int lane) {
    const bf16* Q = (const bf16*)(P.ws + WS_PROJ); const bf16* KEYS = (const bf16*)(P.ws + WS_KEYS); const float* RS1 = (const float*)(P.ws + WS_RS1);
    int* EIDX = (int*)(P.ws + WS_EIDX); float* GATE = (float*)(P.ws + WS_GATE);
    const int l31 = lane & 31, hi = lane >> 5;
    int cur_h = -1;
    for (int u = bid; u < (M / 256) * 8; u += G) {
        const int h = u & 7, tile = u >> 3;
        if (h != cur_h) {
            __syncthreads();
#pragma unroll
            for (int i = 0; i < 8; ++i) { const int q = tid + 512 * i, row = q >> 4, ch = q & 15;
                const v4u val = *(const GAS v4u*)(KEYS + ((size_t)(h * 256 + row)) * 128 + ch * 8);
                *(LAS v4u*)(lds + row * KROW + ch * 16) = val; }
            __syncthreads();
            cur_h = h;
        }
        const int tok = tile * 256 + wave * 32 + l31;
        float T0[16], T1[16];
#pragma unroll
        for (int p = 0; p < 2; ++p) {
            f32x16 acc[4];
#pragma unroll
            for (int kb = 0; kb < 4; ++kb)
#pragma unroll
                for (int r = 0; r < 16; ++r) acc[kb][r] = 0.f;
            const bf16* qp = Q + (size_t)tok * 2048 + h * 256 + p * 128 + hi * 8;
            bf16x8 bq[8];
#pragma unroll
            for (int ks = 0; ks < 8; ++ks) bq[ks] = *(const GAS bf16x8*)(qp + ks * 16);
#pragma unroll
            for (int ks = 0; ks < 8; ++ks)
#pragma unroll
                for (int kb = 0; kb < 4; ++kb) {
                    const bf16x8 ak = *(const LAS bf16x8*)(lds + (p * 128 + kb * 32 + l31) * KROW + (ks * 16 + hi * 8) * 2);
                    acc[kb] = __builtin_amdgcn_mfma_f32_32x32x16_bf16(ak, bq[ks], acc[kb], 0, 0, 0);
                }
            float v[64];
#pragma unroll
            for (int kb = 0; kb < 4; ++kb)
#pragma unroll
                for (int r = 0; r < 16; ++r) v[kb * 16 + r] = __uint_as_float((__float_as_uint(acc[kb][r]) & 0xffffff80u) | (unsigned)(kb * 32 + (r & 3) + 8 * (r >> 2)));
            top16_of_64(v);
            const unsigned hb = (unsigned)hi << 2;
#pragma unroll
            for (int i = 0; i < 16; ++i) v[i] = __uint_as_float(__float_as_uint(v[i]) | hb);
            float c[16];
#pragma unroll
            for (int i = 0; i < 16; ++i) c[i] = fmax_s(v[i], __shfl_xor(v[15 - i], 32));
            merge16_desc(c);
#pragma unroll
            for (int i = 0; i < 16; ++i) { if (p == 0) T0[i] = c[i]; else T1[i] = c[i]; }
        }
        float f0[16], f1[16];
        unsigned long long K0lo = 0ull, K0hi = 0ull, K1lo = 0ull, K1hi = 0ull;
#pragma unroll
        for (int b = 0; b < 8; ++b) {
            K0lo |= (unsigned long long)(__float_as_uint(T0[b]) & 0x7fu) << (8 * b); K0hi |= (unsigned long long)(__float_as_uint(T0[8 + b]) & 0x7fu) << (8 * b);
            K1lo |= (unsigned long long)(__float_as_uint(T1[b]) & 0x7fu) << (8 * b); K1hi |= (unsigned long long)(__float_as_uint(T1[8 + b]) & 0x7fu) << (8 * b);
        }
#pragma unroll
        for (int i = 0; i < 16; ++i) { f0[i] = __uint_as_float(__float_as_uint(T0[i]) & 0xffffff80u); f1[i] = __uint_as_float(__float_as_uint(T1[i]) & 0xffffff80u); }
        float cd[64]; int n = 0;
#pragma unroll
        for (int i = 0; i < 16; ++i)
#pragma unroll
            for (int j = 0; j < 16; ++j)
                if ((i + 1) * (j + 1) <= 16) { cd[n] = __uint_as_float((__float_as_uint(f0[i] + f1[j]) & 0xffffff00u) | (unsigned)(i * 16 + j)); ++n; }
#pragma unroll
        for (int q = 50; q < 64; ++q) cd[q] = __uint_as_float(0xff800000u);
        top16_of_64(cd);
        float rs = 0.f;
        { const GAS f32x4* rp = (const GAS f32x4*)(RS1 + (size_t)tok * 16);
#pragma unroll
          for (int i = 0; i < 4; ++i) { const f32x4 a = rp[i]; rs += (a.x + a.y) + (a.z + a.w); } }
        const float rstd = __builtin_amdgcn_rsqf(rs * (1.0f / 1024.0f) + EPS);
        int eidx[16]; float gt_[16]; float z0 = 0.f, sum = 0.f;
#pragma unroll
        for (int k = 0; k < 16; ++k) {
            const unsigned wb = __float_as_uint(cd[k]); const unsigned i = (wb >> 4) & 15u, j = wb & 15u;
            eidx[k] = (int)(key_lookup(K0lo, K0hi, i) * 128u + key_lookup(K1lo, K1hi, j));
            const float z = __uint_as_float(wb & 0xffffff00u) * rstd;
            if (k == 0) z0 = z;
            gt_[k] = __expf(z - z0); sum += gt_[k];
        }
        const float inv = 1.0f / sum;
        if (hi == 0) { GAS i32x4* ep = (GAS i32x4*)(EIDX + (size_t)tok * 128 + h * 16);
#pragma unroll
            for (int q = 0; q < 4; ++q) ep[q] = (i32x4){eidx[4 * q], eidx[4 * q + 1], eidx[4 * q + 2], eidx[4 * q + 3]};
        } else { GAS f32x4* gp = (GAS f32x4*)(GATE + (size_t)tok * 128 + h * 16);
#pragma unroll
            for (int q = 0; q < 4; ++q) gp[q] = (f32x4){gt_[4 * q] * inv, gt_[4 * q + 1] * inv, gt_[4 * q + 2] * inv, gt_[4 * q + 3] * inv};
        }
    }
}

__device__ __forceinline__ float gelu_tanh(float x) {
    const float y = 1.5957691216057308f * (x + 0.044715f * x * x * x);
    return x / (1.0f + __expf(-y));
}
typedef int v8i __attribute__((ext_vector_type(8)));
#define PEER_MFMA(a, b, c) __builtin_amdgcn_mfma_scale_f32_16x16x128_f8f6f4(a, b, c, 4  , 0  , 0, 0x7F7F7F7F, 0, 0x7F7F7F7F)
__device__ __forceinline__ void peer_dots_phase(const Ptrs& P, LAS unsigned char* lds, int vcu, int G, int wave, int lane) {
    const int gw = vcu * NWAVES + wave, NGW = G * NWAVES;
    const bf16* HB = (const bf16*)(P.ws + WS_HB); float* CF = (float*)(P.ws + WS_CF);
    const int* EIDX = (const int*)(P.ws + WS_EIDX); const float* GATE = (const float*)(P.ws + WS_GATE);
    const unsigned char* U4 = P.ws + WS_U;
    const float* SU = (const float*)(P.ws + WS_SU); const float* SV = (const float*)(P.ws + WS_SV);
    LAS unsigned char* xl = lds + 65536 + wave * 1024;
    LAS unsigned char* tb = lds + wave * 8192;
    const int lr = lane >> 5, lp = lane & 31;
    const int li = lane & 15, lq = lane >> 4;
    const int kl = 4 * lq + (li & 3);
    int t = gw; if (t >= M) return;
    int ei0 = EIDX[(size_t)t * 128 + lane], ei1 = EIDX[(size_t)t * 128 + 64 + lane];
    float gg0 = GATE[(size_t)t * 128 + lane], gg1 = GATE[(size_t)t * 128 + 64 + lane];
    v2u hrow[4];
    { const GAS v2u* hp = (const GAS v2u*)(HB + (size_t)t * 1024) + lane;
#pragma unroll
      for (int j = 0; j < 4; ++j) hrow[j] = hp[64 * j]; }
    v4u uw[8];
#pragma unroll
    for (int v = 0; v < 8; ++v) { const int e = __shfl(ei0, 2 * v + lr); uw[v] = *(const GAS v4u*)(U4 + (size_t)e * 512 + 16 * lp); }
    for (; t < M; t += NGW) {
        const int tn = (t + NGW < M) ? t + NGW : t;
        f32x2 x[8]; float ss = 0.f;
#pragma unroll
        for (int j = 0; j < 4; ++j) { const unsigned wa = hrow[j].x, wb = hrow[j].y; x[2 * j] = (f32x2){bf_lo(wa), bf_hi(wa)}; x[2 * j + 1] = (f32x2){bf_lo(wb), bf_hi(wb)};
            ss += (x[2 * j].x * x[2 * j].x + x[2 * j].y * x[2 * j].y) + (x[2 * j + 1].x * x[2 * j + 1].x + x[2 * j + 1].y * x[2 * j + 1].y); }
        ss = wave_sum(ss);
        const float rstd = __builtin_amdgcn_rsqf(ss * (1.0f / 1024.0f) + EPS);
        { const float sx = 16.0f * rstd;
#pragma unroll
          for (int j = 0; j < 4; ++j) { int w = __builtin_amdgcn_cvt_pk_fp8_f32(x[2 * j].x * sx, x[2 * j].y * sx, 0, false); w = __builtin_amdgcn_cvt_pk_fp8_f32(x[2 * j + 1].x * sx, x[2 * j + 1].y * sx, w, true);
              const int n = 4 * lane + 256 * j, sN = n >> 7, nn = n & 127, hN = nn >> 6, qN = (nn & 63) >> 4, jN = nn & 15;
              *(LAS unsigned*)(xl + 128 * sN + 32 * qN + 16 * hN + jN) = (unsigned)w; }
          asm volatile("s_waitcnt lgkmcnt(0)" ::: "memory"); }
        v8i xb[8];
#pragma unroll
        for (int sI = 0; sI < 8; ++sI) { const v4u b0 = *(const LAS v4u*)(xl + 128 * sI + 32 * lq), b1 = *(const LAS v4u*)(xl + 128 * sI + 32 * lq + 16);
            xb[sI] = (v8i){(int)b0.x, (int)b0.y, (int)b0.z, (int)b0.w, (int)b1.x, (int)b1.y, (int)b1.z, (int)b1.w}; }
        const int nei0 = EIDX[(size_t)tn * 128 + lane], nei1 = EIDX[(size_t)tn * 128 + 64 + lane];
        const float ngg0 = GATE[(size_t)tn * 128 + lane], ngg1 = GATE[(size_t)tn * 128 + 64 + lane];
        { const GAS v2u* hn = (const GAS v2u*)(HB + (size_t)tn * 1024) + lane;
#pragma unroll
          for (int j = 0; j < 4; ++j) hrow[j] = hn[64 * j]; }
        for (int hq = 0; hq < 8 * REPS(7); ++hq) { const int hh = hq & 7;
            const int ereg = hh < 4 ? ei0 : ei1; const float greg = hh < 4 ? gg0 : gg1; const int lb = (hh & 3) * 16;
            const int el = __shfl(ereg, lb + kl);
            const float su = SU[el], sv = SV[el];
#pragma unroll
            for (int v = 0; v < 8; ++v) { const int r = 2 * v + lr; *(LAS v4u*)(tb + 512 * r + 16 * (lp ^ r)) = uw[v]; }
            __builtin_amdgcn_sched_barrier(0);
            { const bool lasth = (hq == 8 * REPS(7) - 1); const int hn = (hh + 1) & 7;
              const int nreg = lasth ? nei0 : (hn < 4 ? ei0 : ei1); const int nlb = (hn & 3) * 16;
#pragma unroll
              for (int v = 0; v < 8; ++v) { const int e = __shfl(nreg, nlb + 2 * v + lr); uw[v] = *(const GAS v4u*)(U4 + (size_t)e * 512 + 16 * lp); } }
            __builtin_amdgcn_sched_barrier(0);
            f32x4 acc = {0.f, 0.f, 0.f, 0.f};
#pragma unroll
            for (int sI = 0; sI < 8; ++sI) { const v4u af = *(const LAS v4u*)(tb + 512 * li + 16 * ((4 * sI + lq) ^ li));
                const v8i av = {(int)af.x, (int)af.y, (int)af.z, (int)af.w, 0, 0, 0, 0}; acc = PEER_MFMA(av, xb[sI], acc); }
            const int rsel = li & 3;
            const float d = rsel == 0 ? acc[0] : (rsel == 1 ? acc[1] : (rsel == 2 ? acc[2] : acc[3]));
            const float gk = __shfl(greg, lb + kl);
            const float cf = gk * gelu_tanh(d * su * (1.0f / 16.0f)) * sv * 1024.0f;
            if (li < 4) CF[(size_t)t * 128 + hh * 16 + kl] = cf;
        }
        ei0 = nei0; ei1 = nei1; gg0 = ngg0; gg1 = ngg1;
    }
}
__device__ __forceinline__ void peer_sum_phase(const Ptrs& P, int vcu, int G, int wave, int lane) {
    const int gw = vcu * NWAVES + wave, NGW = G * NWAVES;
    bf16* HB = (bf16*)(P.ws + WS_HB); float* RS2 = (float*)(P.ws + WS_RS2); const float* CF = (const float*)(P.ws + WS_CF);
    const int* EIDX = (const int*)(P.ws + WS_EIDX); const unsigned char* V4 = P.ws + WS_V;
    const int li = lane & 15, lq = lane >> 4;
    const unsigned bsh = 8u * (unsigned)(li & 3); const int breg = li >> 2;
    int t = gw; if (t >= M) return;
    int ei0 = EIDX[(size_t)t * 128 + lane], ei1 = EIDX[(size_t)t * 128 + 64 + lane];
    float cf0 = CF[(size_t)t * 128 + lane], cf1 = CF[(size_t)t * 128 + 64 + lane];
    v2u hrow[4];
    { const GAS v2u* hp = (const GAS v2u*)(HB + (size_t)t * 1024) + lane;
#pragma unroll
      for (int j = 0; j < 4; ++j) hrow[j] = hp[64 * j]; }
    v4u va[2][2], vb[2][2];
#pragma unroll
    for (int g8 = 0; g8 < 2; ++g8) {
        const int eA = __shfl(ei0, 8 * g8 + 2 * lq), eB = __shfl(ei0, 8 * g8 + 2 * lq + 1);
        const GAS v4u* pa = (const GAS v4u*)(V4 + (size_t)eA * 512 + 16 * li); const GAS v4u* pb = (const GAS v4u*)(V4 + (size_t)eB * 512 + 16 * li);
        va[g8][0] = pa[0]; va[g8][1] = pa[16]; vb[g8][0] = pb[0]; vb[g8][1] = pb[16];
    }
    for (; t < M; t += NGW) {
        const int tn = (t + NGW < M) ? t + NGW : t;
        const int nei0 = EIDX[(size_t)tn * 128 + lane], nei1 = EIDX[(size_t)tn * 128 + 64 + lane];
        const float ncf0 = CF[(size_t)tn * 128 + lane], ncf1 = CF[(size_t)tn * 128 + 64 + lane];
        f32x4 oacc[4];
#pragma unroll
        for (int b = 0; b < 4; ++b) oacc[b] = (f32x4){0.f, 0.f, 0.f, 0.f};
        for (int hq = 0; hq < 8 * REPS(11); ++hq) { const int hh = hq & 7;
            const float creg = hh < 4 ? cf0 : cf1; const int lb = (hh & 3) * 16;
            v8i bv[2];
#pragma unroll
            for (int g8 = 0; g8 < 2; ++g8) {
                float cA = __shfl(creg, lb + 8 * g8 + lq), cB = __shfl(creg, lb + 8 * g8 + 4 + lq);
                cA = fminf(fmaxf(cA, -448.0f), 448.0f); cB = fminf(fmaxf(cB, -448.0f), 448.0f);
                const unsigned pk = (unsigned)__builtin_amdgcn_cvt_pk_fp8_f32(cA, cB, 0, false);
                const unsigned wA = (pk & 0xffu) << bsh, wB = ((pk >> 8) & 0xffu) << bsh;
                bv[g8] = (v8i){breg == 0 ? (int)wA : 0, breg == 1 ? (int)wA : 0, breg == 2 ? (int)wA : 0, breg == 3 ? (int)wA : 0,
                               breg == 0 ? (int)wB : 0, breg == 1 ? (int)wB : 0, breg == 2 ? (int)wB : 0, breg == 3 ? (int)wB : 0};
            }
#pragma unroll
            for (int g8 = 0; g8 < 2; ++g8) {
                { const v8i a0 = {(int)va[g8][0].x, (int)va[g8][0].y, (int)vb[g8][0].x, (int)vb[g8][0].y, 0, 0, 0, 0}; oacc[0] = PEER_MFMA(a0, bv[g8], oacc[0]); }
                { const v8i a1 = {(int)va[g8][0].z, (int)va[g8][0].w, (int)vb[g8][0].z, (int)vb[g8][0].w, 0, 0, 0, 0}; oacc[1] = PEER_MFMA(a1, bv[g8], oacc[1]); }
                { const v8i a2 = {(int)va[g8][1].x, (int)va[g8][1].y, (int)vb[g8][1].x, (int)vb[g8][1].y, 0, 0, 0, 0}; oacc[2] = PEER_MFMA(a2, bv[g8], oacc[2]); }
                { const v8i a3 = {(int)va[g8][1].z, (int)va[g8][1].w, (int)vb[g8][1].z, (int)vb[g8][1].w, 0, 0, 0, 0}; oacc[3] = PEER_MFMA(a3, bv[g8], oacc[3]); }
            }
            __builtin_amdgcn_sched_barrier(0);
            { const bool lasth = (hq == 8 * REPS(11) - 1); const int hn = (hh + 1) & 7;
              const int nreg = lasth ? nei0 : (hn < 4 ? ei0 : ei1); const int nlb = (hn & 3) * 16;
#pragma unroll
              for (int g8 = 0; g8 < 2; ++g8) {
                  const int eA = __shfl(nreg, nlb + 8 * g8 + 2 * lq), eB = __shfl(nreg, nlb + 8 * g8 + 2 * lq + 1);
                  const GAS v4u* pa = (const GAS v4u*)(V4 + (size_t)eA * 512 + 16 * li); const GAS v4u* pb = (const GAS v4u*)(V4 + (size_t)eB * 512 + 16 * li);
                  va[g8][0] = pa[0]; va[g8][1] = pa[16]; vb[g8][0] = pb[0]; vb[g8][1] = pb[16];
              } }
            __builtin_amdgcn_sched_barrier(0);
        }
        const float osc = (REPS(11) == 2 ? 0.5f : 1.0f) * (1.0f / 1024.0f);
        float s2 = 0.f;
        GAS v2u* hb = (GAS v2u*)(HB + (size_t)t * 1024) + lane;
#pragma unroll
        for (int j = 0; j < 4; ++j) { const unsigned wa = hrow[j].x, wb = hrow[j].y;
            const f32x2 o0 = (f32x2){bf_lo(wa) + oacc[j][0] * osc, bf_hi(wa) + oacc[j][1] * osc}, o1 = (f32x2){bf_lo(wb) + oacc[j][2] * osc, bf_hi(wb) + oacc[j][3] * osc};
            hb[64 * j] = (v2u){pk2(o0.x, o0.y), pk2(o1.x, o1.y)};
            s2 += (o0.x * o0.x + o0.y * o0.y) + (o1.x * o1.x + o1.y * o1.y); }
        s2 = wave_sum(s2);
        if (lane == 0) RS2[t] = s2;
        { const GAS v2u* hn = (const GAS v2u*)(HB + (size_t)tn * 1024) + lane;
#pragma unroll
          for (int j = 0; j < 4; ++j) hrow[j] = hn[64 * j]; }
        ei0 = nei0; ei1 = nei1; cf0 = ncf0; cf1 = ncf1;
    }
}

__device__ __forceinline__ void final_phase(const Ptrs& P, int vcu, int G, int wave, int lane) {
    const int gw = vcu * NWAVES + wave, NGW = G * NWAVES; const float* RS3 = (const float*)(P.ws + WS_RS3); const bf16* H3 = (const bf16*)(P.ws + WS_PROJ);
    const GAS f32x4* gf = (const GAS f32x4*)P.g_final + lane;
    f32x4 g[4];
#pragma unroll
    for (int j = 0; j < 4; ++j) g[j] = gf[64 * j];
    for (int m0 = 2 * gw; m0 < M; m0 += 2 * NGW) {
        v2u hv[2][4]; float rs[2];
#pragma unroll
        for (int r = 0; r < 2; ++r) { const GAS v2u* hp = (const GAS v2u*)(H3 + (size_t)(m0 + r) * D) + lane;
#pragma unroll
            for (int j = 0; j < 4; ++j) hv[r][j] = hp[64 * j];
            rs[r] = 0.f; const GAS f32x4* rp = (const GAS f32x4*)(RS3 + (size_t)(m0 + r) * 16);
#pragma unroll
            for (int i = 0; i < 4; ++i) { const f32x4 a = rp[i]; rs[r] += (a.x + a.y) + (a.z + a.w); } }
#pragma unroll
        for (int r = 0; r < 2; ++r) { const float rstd = __builtin_amdgcn_rsqf(rs[r] * (1.0f / 1024.0f) + EPS);
            GAS f32x4* xr = (GAS f32x4*)(P.out + (size_t)(m0 + r) * D) + lane;
#pragma unroll
            for (int j = 0; j < 4; ++j) { const unsigned wa = hv[r][j].x, wb = hv[r][j].y; const f32x4 v = {bf_lo(wa), bf_hi(wa), bf_lo(wb), bf_hi(wb)}; xr[64 * j] = v * rstd * g[j]; } }
    }
}

struct Args { const float* in[17]; float* out; unsigned char* ws; int ph_lo, ph_hi; };
#ifndef PG8_SP2
#define PG8_SP2 true
#endif
#ifndef PG8_ALIGN
#define PG8_ALIGN true
#endif
__global__ void __launch_bounds__(NWAVES * 64, 2) mega_fwd(Args args) {
    extern __shared__ __attribute__((aligned(16))) unsigned char lds_raw[];
    LAS unsigned char* lds = (LAS unsigned char*)lds_raw;
    volatile LAS unsigned* MISC = (volatile LAS unsigned*)(lds + MISC_OFF);
    const int tid = threadIdx.x, lane = tid & 63, wave = __builtin_amdgcn_readfirstlane(tid >> 6);
    const int G = gridDim.x, bx = blockIdx.x; const int vcu = (G % 8 == 0) ? (bx % 8) * (G / 8) + bx / 8 : bx;
    Ptrs P;
    P.x = args.in[0]; P.p = args.in[1]; P.g_mix = args.in[2]; P.w_in = args.in[3]; P.conv_w = args.in[4]; P.pool_w = args.in[5]; P.pool_scale = args.in[6]; P.w_o = args.in[7];
    P.g_ffn = args.in[8]; P.w_q = args.in[9]; P.sub_keys = args.in[10]; P.eu = args.in[11]; P.ev = args.in[12]; P.g_ple = args.in[13]; P.w_gate = args.in[14]; P.w_proj = args.in[15]; P.g_final = args.in[16];
    P.out = args.out; P.ws = args.ws;
    gu32* ctl = (gu32*)(P.ws + WS_CTL);
    for (int u = tid; u < (LDS_BYTES - LDSCTL_OFF) / 4; u += NWAVES * 64) ((LAS unsigned*)(lds + LDSCTL_OFF))[u] = 0u;
    __syncthreads();
    XcdBarrier bar; bar.bar = (unsigned*)(ctl + CW_BAR); bar.x = 0; bar.st = nullptr;
    if (!MK_PER_PHASE) bar = xcd_barrier_post((unsigned*)(ctl + CW_BAR), MISC + 8);
    const int lo = args.ph_lo, hi = args.ph_hi;
#define IN(k) (lo <= (k) && (k) < hi)
#define SEAM(k) do { if (IN(k) && IN((k) + 1)) xcd_barrier(bar); } while (0)
    pg8::bf16_t* const WIN = (pg8::bf16_t*)(P.ws + WS_WIN); pg8::bf16_t* const WO = (pg8::bf16_t*)(P.ws + WS_WO); pg8::bf16_t* const WQ = (pg8::bf16_t*)(P.ws + WS_WQ);
    pg8::bf16_t* const WG = (pg8::bf16_t*)(P.ws + WS_WG); pg8::bf16_t* const WP = (pg8::bf16_t*)(P.ws + WS_WP);
    pg8::bf16_t* const XB = (pg8::bf16_t*)(P.ws + WS_XB); pg8::bf16_t* const PL = XB; pg8::bf16_t* const PROJ = (pg8::bf16_t*)(P.ws + WS_PROJ); pg8::bf16_t* const QB = PROJ;
    pg8::bf16_t* const MIX = (pg8::bf16_t*)(P.ws + WS_MIX); pg8::bf16_t* const HB = (pg8::bf16_t*)(P.ws + WS_HB); pg8::bf16_t* const PB = (pg8::bf16_t*)(P.ws + WS_PB);

    if (IN(0)) { for (int rep = 0; rep < REPS(1); ++rep) { p0a_phase(P, lds, vcu, G, tid, wave, lane); SEAM(0); } }
    if (IN(1)) { p0b_phase(P, lds, vcu, G, wave, lane); SEAM(1); }
    if (IN(2)) {
        pg8::Gemm g{XB, WIN, M, NPROJ, D}; pg8::StaticOrder S; S.init(M, NPROJ, G, bx);
        EpiBf16Row E{PROJ, NPROJ, (const float*)(P.ws + WS_RSX)};
        for (int rep = 0; rep < REPS(2); ++rep) { pg8::gemm_phase<EpiBf16Row, pg8::StaticOrder, PG8_ALIGN, PG8_SP2>(lds, g, S, E);
        SEAM(2); }
    }
    if (IN(3)) {
        for (int rep = 0; rep < REPS(3); ++rep) p2_phase(P, vcu, G, tid, wave);
        pg8::Gemm g{PB, WP, M, D, PLED}; pg8::StaticOrder S; S.init(M, D, G, bx);
        EpiBf16Row E{PL, D, nullptr};
        for (int rep = 0; rep < REPS(8); ++rep) pg8::gemm_phase<EpiBf16Row, pg8::StaticOrder, PG8_ALIGN, PG8_SP2>(lds, g, S, E);
        SEAM(3);
    }
    if (IN(4)) {
        pg8::Gemm g{MIX, WO, M, D, D}; pg8::StaticOrder S; S.init(M, D, G, bx);
        EpiH1 E{P.x, HB, (float*)(P.ws + WS_RS1)};
        for (int rep = 0; rep < REPS(4); ++rep) { pg8::gemm_phase<EpiH1, pg8::StaticOrder, PG8_ALIGN, PG8_SP2>(lds, g, S, E);
        SEAM(4); }
    }
    if (IN(5)) {
        pg8::Gemm g{HB, WQ, M, NQ, D}; pg8::StaticOrder S; S.init(M, NQ, G, bx);
        EpiBf16Row E{QB, NQ, nullptr};
        for (int rep = 0; rep < REPS(5); ++rep) { pg8::gemm_phase<EpiBf16Row, pg8::StaticOrder, PG8_ALIGN, PG8_SP2>(lds, g, S, E);
        SEAM(5); }
    }
    if (IN(6)) { for (int rep = 0; rep < REPS(6); ++rep) { score_phase(P, lds, bx, G, tid, wave, lane); SEAM(6); } }
    if (IN(7)) { peer_dots_phase(P, lds, vcu, G, wave, lane); SEAM(7); }
    if (IN(8)) { peer_sum_phase(P, vcu, G, wave, lane); SEAM(8); }
    if (IN(9)) {
        pg8::Gemm g{HB, WG, M, D, D}; pg8::StaticOrder S; S.init(M, D, G, bx);
        EpiGate E{PROJ  , HB, PL, (const float*)(P.ws + WS_RS2), (float*)(P.ws + WS_RS3)};
        pg8::gemm_phase<EpiGate, pg8::StaticOrder, PG8_ALIGN, PG8_SP2>(lds, g, S, E);
        SEAM(9);
    }
    if (IN(10)) { final_phase(P, vcu, G, wave, lane); }
#undef IN
#undef SEAM
}

extern "C" void kernel_launch(void* const* d_in, const int* in_sizes, int n_in, void* d_out, int out_size, void* d_ws, size_t ws_size, hipStream_t stream) {
    static int grid = 0;
    if (grid == 0) {
        if (n_in != 17 || in_sizes[0] != M * D || out_size != M * D || ws_size < WS_END) { fprintf(stderr, "kernel_launch: unexpected shapes (n_in %d, in0 %d, out %d, ws %zu); nothing launched\n", n_in, n_in > 0 ? in_sizes[0] : -1, out_size, ws_size); grid = -1; return; }
        int dev = 0, cus = 0, per_cu = 0;
        if (hipGetDevice(&dev) != hipSuccess || hipDeviceGetAttribute(&cus, hipDeviceAttributeMultiprocessorCount, dev) != hipSuccess) { fprintf(stderr, "kernel_launch: device query failed\n"); grid = -1; return; }
        if (hipFuncSetAttribute((const void*)mega_fwd, hipFuncAttributeMaxDynamicSharedMemorySize, LDS_BYTES) != hipSuccess) { fprintf(stderr, "kernel_launch: hipFuncSetAttribute failed\n"); grid = -1; return; }
        if (hipOccupancyMaxActiveBlocksPerMultiprocessor(&per_cu, (const void*)mega_fwd, NWAVES * 64, LDS_BYTES) != hipSuccess || per_cu < 1)
            fprintf(stderr, "kernel_launch: note: occupancy query reports %d workgroups per CU\n", per_cu);
        (void)hipGetLastError();
        grid = cus;
    }
    if (grid < 0) return;
    if (hipMemsetAsync((char*)d_ws + WS_CTL, 0, CTL_ZERO_BYTES, stream) != hipSuccess) { fprintf(stderr, "kernel_launch: memset failed\n"); return; }
    Args a{};
    for (int i = 0; i < 17; ++i) a.in[i] = (const float*)d_in[i];
    a.out = (float*)d_out; a.ws = (unsigned char*)d_ws;
#if MK_PER_PHASE
    for (int ph = 0; ph < NPHASES; ++ph) { a.ph_lo = ph; a.ph_hi = ph + 1; hipLaunchKernelGGL(mega_fwd, dim3(grid), dim3(NWAVES * 64), LDS_BYTES, stream, a); }
#else
    a.ph_lo = 0; a.ph_hi = NPHASES;
    hipLaunchKernelGGL(mega_fwd, dim3(grid), dim3(NWAVES * 64), LDS_BYTES, stream, a);
#endif
    const hipError_t le = hipPeekAtLastError();
    if (le != hipSuccess) fprintf(stderr, "kernel_launch: launch failed: %s\n", hipGetErrorName(le));
}
```

```cpp
#include <hip/hip_runtime.h>
#include <cstdio>
#include <cstdint>
namespace pg8 {
#define PG8_LAS __attribute__((address_space(3)))
typedef unsigned short bf16_t;
typedef short bf16x8 __attribute__((ext_vector_type(8)));
typedef float f32x4 __attribute__((ext_vector_type(4)));
typedef unsigned u32x4 __attribute__((ext_vector_type(4)));
constexpr int BM = 256, BK = 64, HALF = 128, HTB = HALF * BK * 2  , STAGE_BYTES = 8 * HTB, NXCD = 8, WGM = 8;

__host__ __device__ __forceinline__ int lds_byte(int r, int c) { const int st = (r >> 4) * 2 + (c >> 5), rr = r & 15, cc = c & 31, ob = rr * 64 + cc * 2; return st * 1024 + (ob ^ (((ob >> 9) & 1) << 5)); }
__host__ __device__ __forceinline__ void stage_rc(int b, int& R, int& C) { const int st = b / 1024, sb = b % 1024, swz = sb ^ (((sb >> 9) & 1) << 5); R = (st >> 1) * 16 + swz / 64; C = (st & 1) * 32 + (swz % 64) / 2; }
__host__ __device__ __forceinline__ int perm32(int rho) { const int n = rho >> 4, i = rho & 15; return 8 * (i >> 2) + 4 * n + (i & 3); }

struct Unit { int pm, pn; };
struct Gemm { const bf16_t* A; const bf16_t* Bt; int M, N, K; };

struct StaticOrder {
    int nM, nN, nwg, G, c;
    __host__ __device__ void init(int M, int N, int G_, int c_) { nM = M / BM; nN = N / BM; nwg = nM * nN; G = G_; c = c_; }
    __host__ __device__ bool next(int i, Unit& u) const {
        const long L = (long)i * G + c; if (L >= nwg) return false;
        int wgid = (int)L; { const int q = nwg / NXCD, r = nwg % NXCD, xcd = wgid % NXCD, off = wgid / NXCD; wgid = (xcd < r ? xcd * (q + 1) : r * (q + 1) + (xcd - r) * q) + off; }
        const int nig = WGM * nN, gid = wgid / nig, fm = gid * WGM, gsz = (nM - fm) < WGM ? (nM - fm) : WGM;
        u.pm = fm + ((wgid % nig) % gsz); u.pn = (wgid % nig) / gsz; return true;
    }
    __device__ __forceinline__ void a_ready(const Unit&) const {}
    __device__ __forceinline__ void done(const Unit&) const {}
};

__device__ __forceinline__ unsigned cvt_pk_bf16(float lo, float hi) { unsigned r; asm volatile("v_cvt_pk_bf16_f32 %0, %1, %2" : "=v"(r) : "v"(lo), "v"(hi)); return r; }
template <class Epi, class Sched, bool ALIGN_EPI = false, bool SP2 = false>
__device__ __forceinline__ void gemm_phase(PG8_LAS unsigned char* lds, const Gemm g, const Sched& S, const Epi& E) {
    const int tid = threadIdx.x, wid = __builtin_amdgcn_readfirstlane(tid >> 6), lane = tid & 63, wr = wid >> 2, wc = wid & 3, fr = lane & 15, fq = lane >> 4;
    const int K = g.K, nt = K / BK;
    unsigned voffA[2], voffB[2];
#pragma unroll
    for (int i = 0; i < 2; ++i) { int R, C; stage_rc(tid * 16 + i * 8192, R, C); const int Rb = Epi::PERM ? ((R & ~31) + perm32(R & 31)) : R;
        voffA[i] = (unsigned)(R * K + C) * 2u; voffB[i] = (unsigned)(Rb * K + C) * 2u; }
    const size_t kstep = (size_t)(BK * 2);
    const size_t hstep = (size_t)HALF * K * 2;
    const size_t tstep = 2 * hstep;
    const unsigned ldsw = (unsigned)wid * 1024u;
    const int aoff = lds_byte(wr * 64 + fr, fq * 8), boff = lds_byte(wc * 32 + fr, fq * 8);
#define PG8_SA(b, h) (((b) * 2 + (h)) * HTB)
#define PG8_SB(b, h) ((4 + (b) * 2 + (h)) * HTB)
#define PG8_STAGE(bufoff, gbase, voff) do { _Pragma("unroll") for (int _i = 0; _i < 2; ++_i) \
        __builtin_amdgcn_global_load_lds((const unsigned*)((const char*)(gbase) + (voff)[_i]), (PG8_LAS unsigned*)(lds + (bufoff) + ldsw + _i * 8192), 16, 0, 0); } while (0)
#define PG8_LDA(dst, b, h) do { _Pragma("unroll") for (int m = 0; m < 4; ++m) _Pragma("unroll") for (int k = 0; k < 2; ++k) dst[m][k] = *(const PG8_LAS bf16x8*)(lds + PG8_SA(b, h) + aoff + m * 2048 + k * 1024); } while (0)
#define PG8_LDB(dst, b, h) do { _Pragma("unroll") for (int n = 0; n < 2; ++n) _Pragma("unroll") for (int k = 0; k < 2; ++k) dst[n][k] = *(const PG8_LAS bf16x8*)(lds + PG8_SB(b, h) + boff + n * 2048 + k * 1024); } while (0)
#define PG8_MMA(ai, bj, At, Bt) do { __builtin_amdgcn_s_setprio(1); _Pragma("unroll") for (int m = 0; m < 4; ++m) _Pragma("unroll") for (int n = 0; n < 2; ++n) _Pragma("unroll") for (int k = 0; k < 2; ++k) \
        acc[ai][bj][m][n] = __builtin_amdgcn_mfma_f32_16x16x32_bf16(Bt[n][k], At[m][k], acc[ai][bj][m][n], 0, 0, 0); __builtin_amdgcn_s_setprio(0); } while (0)
#define PG8_WAIT_V(n) asm volatile("s_waitcnt vmcnt(" #n ")" ::: "memory")
#define PG8_WAIT_L(n) asm volatile("s_waitcnt lgkmcnt(" #n ")" ::: "memory")
#define PG8_BAR __builtin_amdgcn_s_barrier()
#define PG8_SCHED __builtin_amdgcn_sched_barrier(0)
    Unit cur, nxt; int ui = 0;
    if (!S.next(0, cur)) return;
    f32x4 acc[2][2][4][2];
#pragma unroll
    for (int a = 0; a < 2; ++a)
#pragma unroll
        for (int b = 0; b < 2; ++b)
#pragma unroll
            for (int m = 0; m < 4; ++m)
#pragma unroll
                for (int n = 0; n < 2; ++n) acc[a][b][m][n] = (f32x4){0.f, 0.f, 0.f, 0.f};
    bf16x8 At[4][2], B0[2][2], B1[2][2];
    const char* cA = (const char*)g.A + (size_t)cur.pm * tstep; const char* cB = (const char*)g.Bt + (size_t)cur.pn * tstep;
    S.a_ready(cur);
    if constexpr (SP2) {
        PG8_STAGE(PG8_SB(0, 0), cB, voffB); PG8_STAGE(PG8_SB(0, 1), cB + hstep, voffB); PG8_STAGE(PG8_SA(0, 0), cA, voffA); PG8_STAGE(PG8_SA(0, 1), cA + hstep, voffA);
        if (wr == 1) PG8_BAR;
        PG8_WAIT_V(2); PG8_BAR;
        PG8_STAGE(PG8_SB(1, 0), cB + kstep, voffB); PG8_STAGE(PG8_SA(1, 0), cA + kstep, voffA); PG8_STAGE(PG8_SB(1, 1), cB + hstep + kstep, voffB);
        PG8_WAIT_V(6); PG8_BAR;
    } else {
        PG8_STAGE(PG8_SB(0, 0), cB, voffB); PG8_STAGE(PG8_SA(0, 0), cA, voffA); PG8_STAGE(PG8_SB(0, 1), cB + hstep, voffB); PG8_STAGE(PG8_SA(0, 1), cA + hstep, voffA);
        if (wr == 1) PG8_BAR;
        PG8_WAIT_V(4); PG8_BAR;
        PG8_STAGE(PG8_SB(1, 0), cB + kstep, voffB); PG8_STAGE(PG8_SA(1, 0), cA + kstep, voffA); PG8_STAGE(PG8_SB(1, 1), cB + hstep + kstep, voffB);
        PG8_WAIT_V(6); PG8_BAR;
    }
    for (;;) {
        const bool has_next = S.next(ui + 1, nxt);
        const char* nA = has_next ? (const char*)g.A + (size_t)nxt.pm * tstep : cA; const char* nB = has_next ? (const char*)g.Bt + (size_t)nxt.pn * tstep : cB;
        for (int t = 0; t < nt; t += 2) {
            const bool last = (t == nt - 2);
            const char* a1 = cA + (size_t)(t + 1) * kstep;
            const char* a2 = last ? nA : cA + (size_t)(t + 2) * kstep; const char* b2 = last ? nB : cB + (size_t)(t + 2) * kstep;
            const char* a3 = a2 + kstep; const char* b3 = b2 + kstep;
            if (last && has_next) S.a_ready(nxt);
            if constexpr (SP2) {
            PG8_LDB(B0, 0, 0); PG8_LDB(B1, 0, 1); PG8_SCHED; PG8_LDA(At, 0, 0); PG8_STAGE(PG8_SA(1, 1), a1 + hstep, voffA);
            PG8_WAIT_V(8); PG8_WAIT_L(0); PG8_BAR; PG8_MMA(0, 0, At, B0); PG8_MMA(0, 1, At, B1); PG8_BAR; PG8_SCHED;
            PG8_LDA(At, 0, 1); PG8_STAGE(PG8_SB(0, 0), b2, voffB); PG8_STAGE(PG8_SB(0, 1), b2 + hstep, voffB); PG8_STAGE(PG8_SA(0, 0), a2, voffA);
            PG8_WAIT_V(8); PG8_WAIT_L(0); PG8_BAR; PG8_MMA(1, 0, At, B0); PG8_MMA(1, 1, At, B1); PG8_BAR; PG8_SCHED;
            PG8_LDB(B0, 1, 0); PG8_LDB(B1, 1, 1); PG8_SCHED; PG8_LDA(At, 1, 0); PG8_STAGE(PG8_SA(0, 1), a2 + hstep, voffA);
            PG8_WAIT_V(8); PG8_WAIT_L(0); PG8_BAR; PG8_MMA(0, 0, At, B0); PG8_MMA(0, 1, At, B1); PG8_BAR; PG8_SCHED;
            PG8_LDA(At, 1, 1); PG8_STAGE(PG8_SB(1, 0), b3, voffB); PG8_STAGE(PG8_SB(1, 1), b3 + hstep, voffB); PG8_STAGE(PG8_SA(1, 0), a3, voffA);
            PG8_WAIT_V(8); PG8_WAIT_L(0); PG8_BAR; PG8_MMA(1, 0, At, B0); PG8_MMA(1, 1, At, B1); PG8_BAR; PG8_SCHED;
            } else {
            PG8_LDB(B0, 0, 0); PG8_SCHED; PG8_LDA(At, 0, 0); PG8_STAGE(PG8_SA(1, 1), a1 + hstep, voffA);
            PG8_WAIT_L(8); PG8_BAR; PG8_WAIT_L(0); PG8_MMA(0, 0, At, B0); PG8_BAR; PG8_SCHED;
            PG8_LDB(B1, 0, 1); PG8_STAGE(PG8_SB(0, 0), b2, voffB);
            PG8_BAR; PG8_WAIT_L(0); PG8_MMA(0, 1, At, B1); PG8_BAR;
            PG8_LDA(At, 0, 1); PG8_STAGE(PG8_SA(0, 0), a2, voffA);
            PG8_BAR; PG8_WAIT_L(0); PG8_MMA(1, 0, At, B0); PG8_BAR; PG8_SCHED;
            PG8_STAGE(PG8_SB(0, 1), b2 + hstep, voffB);
            PG8_WAIT_V(6); PG8_BAR; PG8_MMA(1, 1, At, B1); PG8_BAR;
            PG8_LDB(B0, 1, 0); PG8_SCHED; PG8_LDA(At, 1, 0); PG8_STAGE(PG8_SA(0, 1), a2 + hstep, voffA);
            PG8_WAIT_L(8); PG8_BAR; PG8_WAIT_L(0); PG8_MMA(0, 0, At, B0); PG8_BAR; PG8_SCHED;
            PG8_LDB(B1, 1, 1); PG8_STAGE(PG8_SB(1, 0), b3, voffB);
            PG8_BAR; PG8_WAIT_L(0); PG8_MMA(0, 1, At, B1); PG8_BAR;
            PG8_LDA(At, 1, 1); PG8_STAGE(PG8_SA(1, 0), a3, voffA);
            PG8_BAR; PG8_WAIT_L(0); PG8_MMA(1, 0, At, B0); PG8_BAR; PG8_SCHED;
            PG8_STAGE(PG8_SB(1, 1), b3 + hstep, voffB);
            PG8_WAIT_V(6); PG8_BAR; PG8_MMA(1, 1, At, B1); PG8_BAR;
            }
        }
        if constexpr (ALIGN_EPI) { if (wr == 0) PG8_BAR; }
        if constexpr (!Epi::AFTER_DRAIN) { E(acc, cur, wr, wc, fr, fq);
            if constexpr (Epi::TWICE) { asm volatile("" ::: "memory"); E(acc, cur, wr, wc, fr, fq); }
            S.done(cur); }
        if (!has_next) break;
#pragma unroll
        for (int a = 0; a < 2; ++a)
#pragma unroll
            for (int b = 0; b < 2; ++b)
#pragma unroll
                for (int m = 0; m < 4; ++m)
#pragma unroll
                    for (int n = 0; n < 2; ++n) acc[a][b][m][n] = (f32x4){0.f, 0.f, 0.f, 0.f};
        cur = nxt; cA = nA; cB = nB; ++ui;
        if constexpr (ALIGN_EPI) { if (wr == 1) PG8_BAR; }
    }
    PG8_WAIT_V(0);
    if constexpr (!ALIGN_EPI) { if (wr == 0) PG8_BAR; }
    PG8_BAR;
    if constexpr (Epi::AFTER_DRAIN) { E.fused(acc, cur, wr, wc, fr, fq, lds, wid, lane); S.done(cur); }
#undef PG8_SA
#undef PG8_SB
#undef PG8_STAGE
#undef PG8_LDA
#undef PG8_LDB
#undef PG8_MMA
#undef PG8_WAIT_V
#undef PG8_WAIT_L
#undef PG8_BAR
#undef PG8_SCHED
}
}

#define GAS __attribute__((address_space(1)))
#define LAS __attribute__((address_space(3)))
typedef unsigned short bf16;
typedef unsigned v4u __attribute__((ext_vector_type(4)));
typedef float f32x4 __attribute__((ext_vector_type(4)));
typedef short bf16x8 __attribute__((ext_vector_type(8)));
typedef GAS unsigned gu32;
typedef GAS unsigned long long gu64;
#define RLX_AGENT __ATOMIC_RELAXED, __HIP_MEMORY_SCOPE_AGENT
#define LDS_WAIT() asm volatile("s_waitcnt lgkmcnt(0)" ::: "memory")
#define VM_WAIT() asm volatile("s_waitcnt vmcnt(0)" ::: "memory")
__device__ __forceinline__ unsigned long long rt() { return __builtin_amdgcn_s_memrealtime(); }
__device__ __forceinline__ unsigned f2bf(float f) { unsigned u = __builtin_bit_cast(unsigned, f); return (u + 0x7fffu + ((u >> 16) & 1u)) >> 16; }
__device__ __forceinline__ unsigned pk2(float lo, float hi) { return f2bf(lo) | (f2bf(hi) << 16); }

#define XB_TMO      128
#define XB_XCNT(j)  (256  + 64 * (j))
#define XB_XSUB(j)  (1280 + 64 * (j))
#define XB_XGEN(j)  (2304 + 64 * (j))
#define XB_TOP      3328
#define XB_TOPGEN   3392
#define XCD_BAR_WORDS 3456
#define XB_SPIN_CAP (1u << 18)

__device__ __forceinline__ unsigned xb_ld(unsigned* p)              { return __hip_atomic_load(p, __ATOMIC_RELAXED, __HIP_MEMORY_SCOPE_AGENT); }
__device__ __forceinline__ unsigned xb_add(unsigned* p, unsigned v) { return __hip_atomic_fetch_add(p, v, __ATOMIC_RELAXED, __HIP_MEMORY_SCOPE_AGENT); }
__device__ __forceinline__ unsigned xb_xcc_id() { return (unsigned)__builtin_amdgcn_s_getreg((3 << 11) | 20) & 0xFu; }
#define XB_SPIN(cond, bar) do { unsigned _sp = 0; while (cond) { __builtin_amdgcn_s_sleep(1); \
    if ((++_sp & 255u) == 0u) { if (xb_ld(&(bar)[XB_TMO])) break; if (_sp > XB_SPIN_CAP) { atomicAdd(&(bar)[XB_TMO], 1u); break; } } } } while (0)

struct XcdBarrier {
    unsigned* bar; unsigned x;
    volatile LAS unsigned* st;
};

__device__ __forceinline__ XcdBarrier xcd_barrier_post(unsigned* bar, volatile LAS unsigned* st) {
    XcdBarrier b; b.bar = bar; b.x = xb_xcc_id(); b.st = st;
    if (threadIdx.x == 0) (void)xb_add(&bar[XB_XCNT(b.x)], 1u);
    return b;
}
__device__ __forceinline__ void xcd_barrier_complete(unsigned* bar, unsigned x, unsigned& nloc, unsigned& nx) {
    const unsigned G = gridDim.x * gridDim.y * gridDim.z;
    unsigned sum, cnt, mine, sp = 0u;
    for (;;) {
        sum = 0u; cnt = 0u; mine = 0u;
#pragma unroll
        for (unsigned j = 0; j < 16; ++j) { const unsigned c = xb_ld(&bar[XB_XCNT(j)]); sum += c; cnt += (c > 0u) ? 1u : 0u; mine = (j == x) ? c : mine; }
        if (sum == G) break;
        __builtin_amdgcn_s_sleep(1);
        if ((++sp & 255u) == 0u) { if (xb_ld(&bar[XB_TMO])) break; if (sp > XB_SPIN_CAP) { atomicAdd(&bar[XB_TMO], 1u); break; } }
    }
    nloc = mine > 0u ? mine : 1u; nx = cnt > 0u ? cnt : 1u;
}

__device__ __forceinline__ void xcd_barrier(const XcdBarrier& b) {
    asm volatile("s_waitcnt vmcnt(0)" ::: "memory");
    __syncthreads();
    if (threadIdx.x == 0) {
        unsigned* bar = b.bar;
        __builtin_amdgcn_s_waitcnt(0);
        unsigned nloc = b.st[0], nx = b.st[1];
        if (nloc == 0u) { xcd_barrier_complete(bar, b.x, nloc, nx); b.st[0] = nloc; b.st[1] = nx; }
        const unsigned old = xb_add(&bar[XB_XSUB(b.x)], 1u);
        const unsigned gen = old / nloc;
        if (old + 1u == (gen + 1u) * nloc) {
            __builtin_amdgcn_fence(__ATOMIC_RELEASE, "agent");
            asm volatile("s_waitcnt vmcnt(0)" ::: "memory");
            const unsigned og = xb_add(&bar[XB_TOP], 1u);
            const unsigned tg = og / nx;
            if (og + 1u == (tg + 1u) * nx) xb_add(&bar[XB_TOPGEN], 1u);
            else XB_SPIN(xb_ld(&bar[XB_TOPGEN]) == tg, bar);
            __builtin_amdgcn_fence(__ATOMIC_ACQUIRE, "agent");
            xb_add(&bar[XB_XGEN(b.x)], 1u);
            asm volatile("s_waitcnt vmcnt(0)" ::: "memory");
        } else {
            XB_SPIN(xb_ld(&bar[XB_XGEN(b.x)]) == gen, bar);
            __builtin_amdgcn_fence(__ATOMIC_ACQUIRE, "agent");
            asm volatile("s_waitcnt vmcnt(0)" ::: "memory");
        }
    }
    __syncthreads();
}

#ifndef PROBE_REP
#define PROBE_REP 0
#endif
#define REPS(k) ((PROBE_REP == (k)) ? 2 : 1)
constexpr int NWAVES = 8;
constexpr int M = 32768, D = 1024, SEQ = 4096, NPROJ = 2048, NQ = 2048, PLED = 256, NEXP = 16384;
constexpr float EPS = 1e-6f;
#ifndef MK_PER_PHASE
#define MK_PER_PHASE 0
#endif
constexpr int NPHASES = 11;

constexpr size_t MiB = 1u << 20;
constexpr size_t WS_CTL = 0, CTL_ZERO_BYTES = 1 * MiB;
constexpr size_t WS_WIN = 2 * MiB, WS_WO = 6 * MiB, WS_WQ = 8 * MiB, WS_WG = 12 * MiB, WS_WP = 14 * MiB, WS_KEYS = 14 * MiB + 512 * 1024;
constexpr size_t WS_WF = 15 * MiB;
constexpr size_t WS_RSX = 17 * MiB, WS_RS2 = 17 * MiB + 512 * 1024, WS_RS1 = 18 * MiB, WS_RS3 = 20 * MiB;
constexpr size_t WS_SU = 22 * MiB, WS_SV = 22 * MiB + 65536;
constexpr size_t WS_U = 24 * MiB, WS_V = 56 * MiB;
constexpr size_t WS_XB = 88 * MiB;
constexpr size_t WS_PROJ = 152 * MiB;
constexpr size_t WS_MIX = 280 * MiB;
constexpr size_t WS_CF = WS_MIX;
constexpr size_t WS_HB = 344 * MiB;
constexpr size_t WS_EIDX = 408 * MiB, WS_GATE = 424 * MiB;
constexpr size_t WS_PB = 440 * MiB;
constexpr size_t WS_END = 456 * MiB;
constexpr int CW_BAR = 4096;
static_assert((CW_BAR + XCD_BAR_WORDS) * 4 <= (int)CTL_ZERO_BYTES, "CTL words inside the memset region");

constexpr int RING_BYTES = 131072;
constexpr int LDSCTL_OFF = RING_BYTES, MISC_OFF = LDSCTL_OFF + 320;
constexpr int LDS_BYTES = 147456;

typedef float f32x16 __attribute__((ext_vector_type(16)));
typedef _Float16 h2_t __attribute__((ext_vector_type(2)));
typedef float f32x2 __attribute__((ext_vector_type(2)));
typedef int i32x4 __attribute__((ext_vector_type(4)));
typedef unsigned v2u __attribute__((ext_vector_type(2)));

__device__ __forceinline__ float wave_sum(float v) {
#pragma unroll
    for (int o = 1; o < 64; o <<= 1) v += __shfl_xor(v, o);
    return v;
}
__device__ __forceinline__ float bf_lo(unsigned w) { return __uint_as_float(w << 16); }
__device__ __forceinline__ float bf_hi(unsigned w) { return __uint_as_float(w & 0xffff0000u); }
__device__ __forceinline__ unsigned pkh(float lo, float hi) { f32x2 v = {lo, hi}; h2_t h = __builtin_convertvector(v, h2_t); return __builtin_bit_cast(unsigned, h); }

struct EpiProj {
    static constexpr bool PERM = true, AFTER_DRAIN = false, TWICE = false;
    pg8::bf16_t* O; const float* rowss;
    __device__ __forceinline__ void operator()(const pg8::f32x4 (&acc)[2][2][4][2], const pg8::Unit& u, int wr, int wc, int fr, int fq) const {
        const int row0 = u.pm * 256 + wr * 64 + fr, cw = wc * 32 + 8 * fq; const int pn = u.pn;
        const bool prod = (pn >= 2) && (pn < 6);
        const int cbase = prod ? 512 + (pn - 2) * 128 : (pn < 2 ? pn * 256 : 1024 + (pn - 6) * 256);
#pragma unroll
        for (int ai = 0; ai < 2; ++ai)
#pragma unroll
            for (int m = 0; m < 4; ++m) {
                const int row = row0 + ai * 128 + m * 16;
                const float sc = __builtin_amdgcn_rsqf(rowss[row] * (1.0f / 1024.0f) + EPS);
                pg8::bf16_t* rowp = O + (size_t)row * 1536 + cbase + cw;
                if (prod) {
                    const float s2 = sc * sc;
                    const pg8::f32x4 v0 = acc[ai][0][m][0] * acc[ai][1][m][0] * s2, v1 = acc[ai][0][m][1] * acc[ai][1][m][1] * s2;
                    pg8::u32x4 w; w.x = pg8::cvt_pk_bf16(v0[0], v0[1]); w.y = pg8::cvt_pk_bf16(v0[2], v0[3]); w.z = pg8::cvt_pk_bf16(v1[0], v1[1]); w.w = pg8::cvt_pk_bf16(v1[2], v1[3]);
                    *(pg8::u32x4*)rowp = w;
                } else {
#pragma unroll
                    for (int bj = 0; bj < 2; ++bj) {
                        const pg8::f32x4 v0 = acc[ai][bj][m][0] * sc, v1 = acc[ai][bj][m][1] * sc;
                        pg8::u32x4 w; w.x = pg8::cvt_pk_bf16(v0[0], v0[1]); w.y = pg8::cvt_pk_bf16(v0[2], v0[3]); w.z = pg8::cvt_pk_bf16(v1[0], v1[1]); w.w = pg8::cvt_pk_bf16(v1[2], v1[3]);
                        *(pg8::u32x4*)(rowp + bj * 128) = w;
                    }
                }
            }
    }
};
struct EpiBf16Row {
    static constexpr bool PERM = true, AFTER_DRAIN = false, TWICE = (PROBE_REP == 12);
    pg8::bf16_t* O; int ldc; const float* rowss;
    __device__ __forceinline__ void operator()(const pg8::f32x4 (&acc)[2][2][4][2], const pg8::Unit& u, int wr, int wc, int fr, int fq) const {
        const int row0 = u.pm * 256 + wr * 64 + fr, col0 = u.pn * 256 + wc * 32 + 8 * fq;
#pragma unroll
        for (int ai = 0; ai < 2; ++ai)
#pragma unroll
            for (int m = 0; m < 4; ++m) {
                const int row = row0 + ai * 128 + m * 16;
                const float sc = rowss ? __builtin_amdgcn_rsqf(rowss[row] * (1.0f / 1024.0f) + EPS) : 1.0f;
                pg8::bf16_t* rowp = O + (size_t)row * ldc + col0;
#pragma unroll
                for (int bj = 0; bj < 2; ++bj) {
                    const pg8::f32x4 v0 = acc[ai][bj][m][0] * sc, v1 = acc[ai][bj][m][1] * sc;
                    pg8::u32x4 w; w.x = pg8::cvt_pk_bf16(v0[0], v0[1]); w.y = pg8::cvt_pk_bf16(v0[2], v0[3]); w.z = pg8::cvt_pk_bf16(v1[0], v1[1]); w.w = pg8::cvt_pk_bf16(v1[2], v1[3]);
                    *(pg8::u32x4*)(rowp + bj * 128) = w;
                }
            }
    }
};
struct EpiH1 {
    static constexpr bool PERM = true, AFTER_DRAIN = false, TWICE = (PROBE_REP == 13);
    const float* X; pg8::bf16_t* HB; float* RS;
    __device__ __forceinline__ void operator()(const pg8::f32x4 (&acc)[2][2][4][2], const pg8::Unit& u, int wr, int wc, int fr, int fq) const {
        const int row0 = u.pm * 256 + wr * 64 + fr, col0 = u.pn * 256 + wc * 32 + 8 * fq;
#pragma unroll
        for (int ai = 0; ai < 2; ++ai)
#pragma unroll
            for (int m = 0; m < 4; ++m) {
                const int row = row0 + ai * 128 + m * 16; float s = 0.f;
#pragma unroll
                for (int bj = 0; bj < 2; ++bj) {
                    const size_t off = (size_t)row * 1024 + col0 + bj * 128;
                    const pg8::f32x4 x0 = *(const pg8::f32x4*)(X + off), x1 = *(const pg8::f32x4*)(X + off + 4);
                    const pg8::f32x4 v0 = acc[ai][bj][m][0] + x0, v1 = acc[ai][bj][m][1] + x1;
                    pg8::u32x4 w; w.x = pg8::cvt_pk_bf16(v0[0], v0[1]); w.y = pg8::cvt_pk_bf16(v0[2], v0[3]); w.z = pg8::cvt_pk_bf16(v1[0], v1[1]); w.w = pg8::cvt_pk_bf16(v1[2], v1[3]);
                    *(pg8::u32x4*)(HB + off) = w;
                    s += (v0[0] * v0[0] + v0[1] * v0[1]) + (v0[2] * v0[2] + v0[3] * v0[3]) + (v1[0] * v1[0] + v1[1] * v1[1]) + (v1[2] * v1[2] + v1[3] * v1[3]);
                }
                s += __shfl_xor(s, 16); s += __shfl_xor(s, 32);
                if (fq == 0) RS[(size_t)row * 16 + u.pn * 4 + wc] = s;
            }
    }
};
struct EpiGate {
    static constexpr bool PERM = true, AFTER_DRAIN = false, TWICE = (PROBE_REP == 14);
    pg8::bf16_t* OUT; const pg8::bf16_t* HB; const pg8::bf16_t* PL; const float* RS2; float* RS3;
    __device__ __forceinline__ void operator()(const pg8::f32x4 (&acc)[2][2][4][2], const pg8::Unit& u, int wr, int wc, int fr, int fq) const {
        const int row0 = u.pm * 256 + wr * 64 + fr, col0 = u.pn * 256 + wc * 32 + 8 * fq;
#pragma unroll
        for (int ai = 0; ai < 2; ++ai)
#pragma unroll
            for (int m = 0; m < 4; ++m) {
                const int row = row0 + ai * 128 + m * 16; float s = 0.f;
                const float rstd = __builtin_amdgcn_rsqf(RS2[row] * (1.0f / 1024.0f) + EPS);
#pragma unroll
                for (int bj = 0; bj < 2; ++bj) {
                    const size_t off = (size_t)row * 1024 + col0 + bj * 128;
                    const pg8::u32x4 w = *(const pg8::u32x4*)(PL + off), hw = *(const pg8::u32x4*)(HB + off);
                    const pg8::f32x4 h0 = {bf_lo(hw.x), bf_hi(hw.x), bf_lo(hw.y), bf_hi(hw.y)}, h1 = {bf_lo(hw.z), bf_hi(hw.z), bf_lo(hw.w), bf_hi(hw.w)};
                    const pg8::f32x4 a0 = acc[ai][bj][m][0] * rstd, a1 = acc[ai][bj][m][1] * rstd;
                    pg8::f32x4 g0, g1;
#pragma unroll
                    for (int e = 0; e < 4; ++e) { g0[e] = 1.0f / (1.0f + __expf(-a0[e])); g1[e] = 1.0f / (1.0f + __expf(-a1[e])); }
                    const pg8::f32x4 p0 = {bf_lo(w.x), bf_hi(w.x), bf_lo(w.y), bf_hi(w.y)}, p1 = {bf_lo(w.z), bf_hi(w.z), bf_lo(w.w), bf_hi(w.w)};
                    const pg8::f32x4 v0 = h0 + g0 * p0, v1 = h1 + g1 * p1;
                    { pg8::u32x4 ow; ow.x = pg8::cvt_pk_bf16(v0[0], v0[1]); ow.y = pg8::cvt_pk_bf16(v0[2], v0[3]); ow.z = pg8::cvt_pk_bf16(v1[0], v1[1]); ow.w = pg8::cvt_pk_bf16(v1[2], v1[3]); *(pg8::u32x4*)(OUT + off) = ow; }
                    s += (v0[0] * v0[0] + v0[1] * v0[1]) + (v0[2] * v0[2] + v0[3] * v0[3]) + (v1[0] * v1[0] + v1[1] * v1[1]) + (v1[2] * v1[2] + v1[3] * v1[3]);
                }
                s += __shfl_xor(s, 16); s += __shfl_xor(s, 32);
                if (fq == 0) RS3[(size_t)row * 16 + u.pn * 4 + wc] = s;
            }
    }
};

__device__ __forceinline__ void p0_transpose_item(const float* W, int ldn, const float* gk, int K, bf16* WT, int row_off, int nblk, LAS float* scr, int item, int lane) {
    const int kb = item / nblk, nb = item % nblk, k0 = 64 * kb, n0 = 32 * nb;
    float wv[32];
#pragma unroll
    for (int i = 0; i < 32; ++i) wv[i] = W[(size_t)(k0 + 2 * i + (lane >> 5)) * ldn + n0 + (lane & 31)];
#pragma unroll
    for (int i = 0; i < 32; ++i) { const int kk = 2 * i + (lane >> 5); float v = wv[i]; if (gk) v *= gk[k0 + kk]; scr[kk * 33 + (lane & 31)] = v; }
    LDS_WAIT(); asm volatile("" ::: "memory");
    const int c = lane & 7;
#pragma unroll
    for (int j = 0; j < 4; ++j) { const int n = (lane >> 3) + 8 * j; const LAS float* s = scr + (8 * c) * 33 + n;
        v4u o; o.x = pk2(s[0 * 33], s[1 * 33]); o.y = pk2(s[2 * 33], s[3 * 33]); o.z = pk2(s[4 * 33], s[5 * 33]); o.w = pk2(s[6 * 33], s[7 * 33]);
        *(GAS v4u*)(WT + (size_t)(row_off + n0 + n) * K + k0 + 8 * c) = o; }
    LDS_WAIT(); asm volatile("" ::: "memory");
}

struct Ptrs {
    const float *x, *p, *g_mix, *w_in, *conv_w, *pool_w, *pool_scale, *w_o, *g_ffn, *w_q, *sub_keys, *eu, *ev, *g_ple, *w_gate, *w_proj, *g_final;
    float* out; unsigned char* ws;
};

__device__ __forceinline__ void p0a_phase(const Ptrs& P, LAS unsigned char* lds, int vcu, int G, int tid, int wave, int lane) {
    const int gw = vcu * 4 + (wave & 3), NGW = G * 4;
    const int gt = gw * 64 + lane, NGT = NGW * 64;
    if (wave < 4) {
    { float* Wf = (float*)(P.ws + WS_WF);
      for (int tk = gw; tk < 2048; tk += NGW) {
          const int k4 = (tk >> 3) * 4, j = tk & 7, g = j >> 1, np = j * 64 + lane, d = np & 127;
          const float* wi = P.w_in + (size_t)k4 * 2048 + 1536 + g * 128; const float* pw = P.pool_w + (size_t)g * 128 * 128 + d;
          float a0 = 0.f, a1 = 0.f, a2 = 0.f, a3 = 0.f;
          for (int c0 = 0; c0 < 128; c0 += 16) {
              float pv[16], w0[16], w1[16], w2[16], w3[16];
#pragma unroll
              for (int c = 0; c < 16; ++c) { pv[c] = pw[(size_t)(c0 + c) * 128]; w0[c] = wi[c0 + c]; w1[c] = wi[2048 + c0 + c]; w2[c] = wi[4096 + c0 + c]; w3[c] = wi[6144 + c0 + c]; }
#pragma unroll
              for (int c = 0; c < 16; ++c) { a0 += w0[c] * pv[c]; a1 += w1[c] * pv[c]; a2 += w2[c] * pv[c]; a3 += w3[c] * pv[c]; }
          }
          const float sc = P.pool_scale[np];
          Wf[(size_t)k4 * 512 + np] = a0 * sc; Wf[(size_t)(k4 + 1) * 512 + np] = a1 * sc; Wf[(size_t)(k4 + 2) * 512 + np] = a2 * sc; Wf[(size_t)(k4 + 3) * 512 + np] = a3 * sc;
      } }
    { LAS float* scr = (LAS float*)(lds + wave * 16384);
      constexpr int I_WO = 16 * 32, I_WQ = 16 * 64, I_WG = 16 * 32, I_WP = 4 * 32, I_WINA = 16 * 48;
      constexpr int NITEMS = I_WO + I_WQ + I_WG + I_WP + I_WINA;
      for (int it = gw; it < NITEMS; it += NGW) {
          int r = it;
          if (r < I_WO) { p0_transpose_item(P.w_o, 1024, nullptr, 1024, (bf16*)(P.ws + WS_WO), 0, 32, scr, r, lane); continue; } r -= I_WO;
          if (r < I_WQ) { p0_transpose_item(P.w_q, 2048, P.g_ffn, 1024, (bf16*)(P.ws + WS_WQ), 0, 64, scr, r, lane); continue; } r -= I_WQ;
          if (r < I_WG) { p0_transpose_item(P.w_gate, 1024, P.g_ple, 1024, (bf16*)(P.ws + WS_WG), 0, 32, scr, r, lane); continue; } r -= I_WG;
          if (r < I_WP) { p0_transpose_item(P.w_proj, 1024, nullptr, 256, (bf16*)(P.ws + WS_WP), 0, 32, scr, r, lane); continue; } r -= I_WP;
          {
            const int nb = r % 48, n0 = 32 * nb; int sc0 = n0;
            if (n0 >= 512) { const int jj = (n0 - 512) >> 8, rr = (n0 - 512) & 255; sc0 = rr < 128 ? 512 + 128 * jj + rr : 1024 + 128 * jj + (rr - 128); }
            p0_transpose_item(P.w_in + (sc0 - n0), 2048, P.g_mix, 1024, (bf16*)(P.ws + WS_WIN), 0, 48, scr, r, lane); }
      } }
    } else {
    { for (int r0 = 4 * gw; r0 < NEXP; r0 += 4 * NGW) {
          f32x4 a[4][4]; float q[4];
#pragma unroll
          for (int rr = 0; rr < 4; ++rr) { const GAS f32x4* src = (const GAS f32x4*)(P.eu + (size_t)(r0 + rr) * 1024);
#pragma unroll
              for (int j = 0; j < 4; ++j) a[rr][j] = src[4 * lane + j]; }
          { const GAS f32x4* gf = (const GAS f32x4*)P.g_ffn + 4 * lane;
#pragma unroll
            for (int j = 0; j < 4; ++j) { const f32x4 g = gf[j];
#pragma unroll
                for (int rr = 0; rr < 4; ++rr) a[rr][j] = a[rr][j] * g; } }
#pragma unroll
          for (int rr = 0; rr < 4; ++rr) { q[rr] = 0.f;
#pragma unroll
              for (int j = 0; j < 4; ++j) q[rr] += (a[rr][j].x * a[rr][j].x + a[rr][j].y * a[rr][j].y) + (a[rr][j].z * a[rr][j].z + a[rr][j].w * a[rr][j].w); }
#pragma unroll
          for (int o = 1; o < 64; o <<= 1) { q[0] += __shfl_xor(q[0], o); q[1] += __shfl_xor(q[1], o); q[2] += __shfl_xor(q[2], o); q[3] += __shfl_xor(q[3], o); }
#pragma unroll
          for (int rr = 0; rr < 4; ++rr) { const int e = r0 + rr;
              const float rms = sqrtf(q[rr] * (1.0f / 1024.0f)); const float sc = rms > 0.f ? 2.0f / rms : 0.f;
              unsigned w0 = 0u, w1 = 0u;
              w0 = __builtin_amdgcn_cvt_scalef32_pk_fp4_f32(w0, a[rr][0].x * sc, a[rr][0].y * sc, 1.0f, 0); w0 = __builtin_amdgcn_cvt_scalef32_pk_fp4_f32(w0, a[rr][0].z * sc, a[rr][0].w * sc, 1.0f, 1);
              w0 = __builtin_amdgcn_cvt_scalef32_pk_fp4_f32(w0, a[rr][1].x * sc, a[rr][1].y * sc, 1.0f, 2); w0 = __builtin_amdgcn_cvt_scalef32_pk_fp4_f32(w0, a[rr][1].z * sc, a[rr][1].w * sc, 1.0f, 3);
              w1 = __builtin_amdgcn_cvt_scalef32_pk_fp4_f32(w1, a[rr][2].x * sc, a[rr][2].y * sc, 1.0f, 0); w1 = __builtin_amdgcn_cvt_scalef32_pk_fp4_f32(w1, a[rr][2].z * sc, a[rr][2].w * sc, 1.0f, 1);
              w1 = __builtin_amdgcn_cvt_scalef32_pk_fp4_f32(w1, a[rr][3].x * sc, a[rr][3].y * sc, 1.0f, 2); w1 = __builtin_amdgcn_cvt_scalef32_pk_fp4_f32(w1, a[rr][3].z * sc, a[rr][3].w * sc, 1.0f, 3);
              ((GAS v2u*)(P.ws + WS_U))[(size_t)e * 64 + lane] = (v2u){w0, w1};
              if (lane == 0) ((float*)(P.ws + WS_SU))[e] = rms * 0.5f; }
      } }
    { const int ci = lane >> 2, cb = lane & 3; const int eoff = 256 * cb + 64 * (ci >> 2) + (ci & 3);
      for (int r0 = 2 * gw; r0 < NEXP; r0 += 2 * NGW) {
          float v[2][16]; float q[2];
#pragma unroll
          for (int rr = 0; rr < 2; ++rr) { const float* src = P.ev + (size_t)(r0 + rr) * 1024 + eoff;
#pragma unroll
              for (int n = 0; n < 16; ++n) v[rr][n] = src[4 * n]; }
#pragma unroll
          for (int rr = 0; rr < 2; ++rr) { q[rr] = 0.f;
#pragma unroll
              for (int n = 0; n < 16; ++n) q[rr] += v[rr][n] * v[rr][n]; }
#pragma unroll
          for (int o = 1; o < 64; o <<= 1) { q[0] += __shfl_xor(q[0], o); q[1] += __shfl_xor(q[1], o); }
#pragma unroll
          for (int rr = 0; rr < 2; ++rr) { const int e = r0 + rr;
              const float rms = sqrtf(q[rr] * (1.0f / 1024.0f)); const float sc = rms > 0.f ? 2.0f / rms : 0.f;
              unsigned w0 = 0u, w1 = 0u;
              w0 = __builtin_amdgcn_cvt_scalef32_pk_fp4_f32(w0, v[rr][0] * sc, v[rr][1] * sc, 1.0f, 0); w0 = __builtin_amdgcn_cvt_scalef32_pk_fp4_f32(w0, v[rr][2] * sc, v[rr][3] * sc, 1.0f, 1);
              w0 = __builtin_amdgcn_cvt_scalef32_pk_fp4_f32(w0, v[rr][4] * sc, v[rr][5] * sc, 1.0f, 2); w0 = __builtin_amdgcn_cvt_scalef32_pk_fp4_f32(w0, v[rr][6] * sc, v[rr][7] * sc, 1.0f, 3);
              w1 = __builtin_amdgcn_cvt_scalef32_pk_fp4_f32(w1, v[rr][8] * sc, v[rr][9] * sc, 1.0f, 0); w1 = __builtin_amdgcn_cvt_scalef32_pk_fp4_f32(w1, v[rr][10] * sc, v[rr][11] * sc, 1.0f, 1);
              w1 = __builtin_amdgcn_cvt_scalef32_pk_fp4_f32(w1, v[rr][12] * sc, v[rr][13] * sc, 1.0f, 2); w1 = __builtin_amdgcn_cvt_scalef32_pk_fp4_f32(w1, v[rr][14] * sc, v[rr][15] * sc, 1.0f, 3);
              ((GAS v2u*)(P.ws + WS_V))[(size_t)e * 64 + (cb >> 1) * 32 + 2 * ci + (cb & 1)] = (v2u){w0, w1};
              if (lane == 0) ((float*)(P.ws + WS_SV))[e] = rms * 0.5f; }
      } }
    { const GAS f32x4* sp = (const GAS f32x4*)P.p; GAS v4u* dp = (GAS v4u*)(P.ws + WS_PB);
      for (int i0 = gt; i0 < M * PLED / 8; i0 += 4 * NGT) {
          f32x4 a[4], b[4];
#pragma unroll
          for (int q = 0; q < 4; ++q) { const int i = i0 + q * NGT; if (i < M * PLED / 8) { a[q] = sp[2 * (size_t)i]; b[q] = sp[2 * (size_t)i + 1]; } }
#pragma unroll
          for (int q = 0; q < 4; ++q) { const int i = i0 + q * NGT; if (i < M * PLED / 8) { v4u o; o.x = pk2(a[q].x, a[q].y); o.y = pk2(a[q].z, a[q].w); o.z = pk2(b[q].x, b[q].y); o.w = pk2(b[q].z, b[q].w); dp[i] = o; } }
      }
      const GAS f32x4* sk = (const GAS f32x4*)P.sub_keys; GAS v4u* dk = (GAS v4u*)(P.ws + WS_KEYS);
      for (int i = gt; i < 16 * 128 * 128 / 8; i += NGT) { const f32x4 a = sk[2 * (size_t)i], b = sk[2 * (size_t)i + 1]; v4u o; o.x = pk2(a.x, a.y); o.y = pk2(a.z, a.w); o.z = pk2(b.x, b.y); o.w = pk2(b.z, b.w); dk[i] = o; } }
    { float* RSX = (float*)(P.ws + WS_RSX); bf16* XB = (bf16*)(P.ws + WS_XB);
      for (int m0 = 4 * gw; m0 < M; m0 += 4 * NGW) {
          f32x4 v[4][4]; float sq[4];
#pragma unroll
          for (int r = 0; r < 4; ++r) { const GAS f32x4* xr = (const GAS f32x4*)(P.x + (size_t)(m0 + r) * D) + lane;
#pragma unroll
              for (int j = 0; j < 4; ++j) v[r][j] = xr[64 * j]; }
#pragma unroll
          for (int r = 0; r < 4; ++r) { sq[r] = 0.f;
#pragma unroll
              for (int j = 0; j < 4; ++j) sq[r] += (v[r][j].x * v[r][j].x + v[r][j].y * v[r][j].y) + (v[r][j].z * v[r][j].z + v[r][j].w * v[r][j].w); }
#pragma unroll
          for (int o = 1; o < 64; o <<= 1) {
#pragma unroll
              for (int r = 0; r < 4; ++r) sq[r] += __shfl_xor(sq[r], o); }
#pragma unroll
          for (int r = 0; r < 4; ++r) { if (lane == 0) RSX[m0 + r] = sq[r];
              GAS unsigned long long* o8 = (GAS unsigned long long*)(XB + (size_t)(m0 + r) * D) + lane;
#pragma unroll
              for (int j = 0; j < 4; ++j) o8[64 * j] = (unsigned long long)pk2(v[r][j].x, v[r][j].y) | ((unsigned long long)pk2(v[r][j].z, v[r][j].w) << 32); }
      } }
    }
}
__device__ __forceinline__ void p0b_phase(const Ptrs& P, LAS unsigned char* lds, int vcu, int G, int wave, int lane) {
    const int gw = vcu * NWAVES + wave, NGW = G * NWAVES; LAS float* scr = (LAS float*)(lds + wave * 16384);
    for (int it = gw; it < 16 * 16; it += NGW) p0_transpose_item((const float*)(P.ws + WS_WF), 512, P.g_mix, 1024, (bf16*)(P.ws + WS_WIN), 1536, 16, scr, it, lane);
}

template <int HALF>
__device__ __forceinline__ void pool_chunk(const unsigned* col, unsigned* mx, int t0, int s0) {
    constexpr int TC = 32, NV = TC + 2 * HALF;
    float v0[NV], v1[NV];
#pragma unroll
    for (int i = 0; i < NV; ++i) {
        const int s = s0 - HALF + i; const bool ok = (s >= 0) && (s < SEQ);
        const unsigned w = col[(size_t)(ok ? (t0 - HALF + i) : t0) * 768];
        v0[i] = ok ? bf_lo(w) : 0.f; v1[i] = ok ? bf_hi(w) : 0.f;
    }
    float S0 = 0.f, S1 = 0.f;
#pragma unroll
    for (int j = 0; j < 2 * HALF; ++j) { S0 += v0[j]; S1 += v1[j]; }
#pragma unroll
    for (int i = 0; i < TC; ++i) {
        const int s = s0 + i; const int lo = (s - HALF) > 0 ? (s - HALF) : 0, hi = (s + HALF) < SEQ ? (s + HALF) : SEQ;
        const float inv = 1.0f / (float)(hi - lo);
        mx[(size_t)(t0 + i) * 512] = pk2(S0 * inv - v0[i + HALF], S1 * inv - v1[i + HALF]);
        if (i + 1 < TC) { S0 += v0[i + 2 * HALF] - v0[i]; S1 += v1[i + 2 * HALF] - v1[i]; }
    }
}
__device__ __forceinline__ void p2_phase(const Ptrs& P, int vcu, int G, int tid, int wave) {
    const unsigned* PR = (const unsigned*)(P.ws + WS_PROJ);
    unsigned* MX = (unsigned*)(P.ws + WS_MIX);
    constexpr int TC = 32;
    for (int ck = vcu; ck < M / TC; ck += G) {
        const int t0 = ck * TC, s0 = t0 & (SEQ - 1);
        if (tid < 256) {
            const unsigned* col = PR + 512 + tid; unsigned* mx = MX + 256 + tid;
            if (wave == 0) pool_chunk<1>(col, mx, t0, s0); else if (wave == 1) pool_chunk<2>(col, mx, t0, s0); else if (wave == 2) pool_chunk<4>(col, mx, t0, s0); else pool_chunk<8>(col, mx, t0, s0);
        } else {
            const int cp = tid - 256;
            const unsigned* bcol = PR + cp; const unsigned* zcol = PR + 256 + cp;
            const float w00 = P.conv_w[2 * cp], w01 = P.conv_w[2 * cp + 1], w10 = P.conv_w[512 + 2 * cp], w11 = P.conv_w[512 + 2 * cp + 1], w20 = P.conv_w[1024 + 2 * cp], w21 = P.conv_w[1024 + 2 * cp + 1];
            float z0[TC + 2], z1[TC + 2]; unsigned bw[TC];
#pragma unroll
            for (int i = 0; i < TC + 2; ++i) {
                const int s = s0 - 1 + i; const bool ok = (s >= 0) && (s < SEQ);
                const unsigned z = zcol[(size_t)(ok ? (t0 - 1 + i) : t0) * 768];
                z0[i] = ok ? bf_lo(z) : 0.f; z1[i] = ok ? bf_hi(z) : 0.f;
            }
#pragma unroll
            for (int i = 0; i < TC; ++i) bw[i] = bcol[(size_t)(t0 + i) * 768];
#pragma unroll
            for (int i = 0; i < TC; ++i) {
                const float y0 = w00 * z0[i] + w10 * z0[i + 1] + w20 * z0[i + 2], y1 = w01 * z1[i] + w11 * z1[i + 1] + w21 * z1[i + 2];
                MX[(size_t)(t0 + i) * 512 + cp] = pk2(bf_lo(bw[i]) * y0, bf_hi(bw[i]) * y1);
            }
        }
    }
}

__device__ __forceinline__ float fmax_s(float a, float b) { float r; asm("v_max_f32_e32 %0, %1, %2" : "=v"(r) : "v"(a), "v"(b)); return r; }
__device__ __forceinline__ float fmin_s(float a, float b) { float r; asm("v_min_f32_e32 %0, %1, %2" : "=v"(r) : "v"(a), "v"(b)); return r; }
#define CE_DESC(a, b) do { const float _t = fmax_s(a, b); b = fmin_s(a, b); a = _t; } while (0)
#define CE_ASC(a, b)  do { const float _t = fmin_s(a, b); b = fmax_s(a, b); a = _t; } while (0)
__device__ __forceinline__ void sort16_desc(float* a) {
#pragma unroll
    for (int k = 2; k <= 16; k <<= 1)
#pragma unroll
        for (int j = k >> 1; j > 0; j >>= 1)
#pragma unroll
            for (int i = 0; i < 16; ++i) { const int l = i ^ j; if (l > i) { if ((i & k) == 0) CE_DESC(a[i], a[l]); else CE_ASC(a[i], a[l]); } }
}
__device__ __forceinline__ void merge16_desc(float* a) {
#pragma unroll
    for (int j = 8; j > 0; j >>= 1)
#pragma unroll
        for (int i = 0; i < 16; ++i) { const int l = i ^ j; if (l > i) CE_DESC(a[i], a[l]); }
}
__device__ __forceinline__ void top16_merge(float* a, const float* b) {
#pragma unroll
    for (int i = 0; i < 16; ++i) a[i] = fmax_s(a[i], b[15 - i]);
    merge16_desc(a);
}
__device__ __forceinline__ void top16_of_64(float* v) {
    sort16_desc(v); sort16_desc(v + 16); sort16_desc(v + 32); sort16_desc(v + 48);
    top16_merge(v, v + 16); top16_merge(v + 32, v + 48); top16_merge(v, v + 32);
}
__device__ __forceinline__ unsigned key_lookup(unsigned long long lo, unsigned long long hi, unsigned i) {
    const unsigned long long v = (i & 8u) ? hi : lo;
    return (unsigned)(v >> ((i & 7u) * 8u)) & 0x7fu;
}

constexpr int KROW = 272;
__device__ __forceinline__ void score_phase(const Ptrs& P, LAS unsigned char* lds, int bid, int G, int tid, int wave, int lane) {
    const bf16* Q = (const bf16*)(P.ws + WS_PROJ); const bf16* KEYS = (const bf16*)(P.ws + WS_KEYS); const float* RS1 = (const float*)(P.ws + WS_RS1);
    int* EIDX = (int*)(P.ws + WS_EIDX); float* GATE = (float*)(P.ws + WS_GATE);
    const int l31 = lane & 31, hi = lane >> 5;
    int cur_h = -1;
    bf16x8 bqa[2][8];
    if (bid < (M / 256) * 8) { const int tok0 = (bid >> 3) * 256 + wave * 32 + l31;
#pragma unroll
        for (int p = 0; p < 2; ++p) { const bf16* qp = Q + (size_t)tok0 * 2048 + (bid & 7) * 256 + p * 128 + hi * 8;
#pragma unroll
            for (int ks = 0; ks < 8; ++ks) bqa[p][ks] = *(const GAS bf16x8*)(qp + ks * 16); } }
    for (int u = bid; u < (M / 256) * 8; u += G) {
        const int h = u & 7, tile = u >> 3;
        if (h != cur_h) {
            __syncthreads();
#pragma unroll
            for (int i = 0; i < 8; ++i) { const int q = tid + 512 * i, row = q >> 4, ch = q & 15;
                const v4u val = *(const GAS v4u*)(KEYS + ((size_t)(h * 256 + row)) * 128 + ch * 8);
                *(LAS v4u*)(lds + row * KROW + ch * 16) = val; }
            __syncthreads();
            cur_h = h;
        }
        const int tok = tile * 256 + wave * 32 + l31;
        float T0[16], T1[16];
#pragma unroll
        for (int p = 0; p < 2; ++p) {
            f32x16 acc[4];
#pragma unroll
            for (int kb = 0; kb < 4; ++kb)
#pragma unroll
                for (int r = 0; r < 16; ++r) acc[kb][r] = 0.f;
#pragma unroll
            for (int ks = 0; ks < 8; ++ks)
#pragma unroll
                for (int kb = 0; kb < 4; ++kb) {
                    const bf16x8 ak = *(const LAS bf16x8*)(lds + (p * 128 + kb * 32 + l31) * KROW + (ks * 16 + hi * 8) * 2);
                    acc[kb] = __builtin_amdgcn_mfma_f32_32x32x16_bf16(ak, bqa[p][ks], acc[kb], 0, 0, 0);
                }
            if (p == 1) {
                const int un = (u + G < (M / 256) * 8) ? u + G : u; const int tokn = (un >> 3) * 256 + wave * 32 + l31;
                asm volatile("" : "+v"(acc[0]), "+v"(acc[1]), "+v"(acc[2]), "+v"(acc[3]));
#pragma unroll
                for (int pp = 0; pp < 2; ++pp) { const bf16* qp = Q + (size_t)tokn * 2048 + (un & 7) * 256 + pp * 128 + hi * 8;
#pragma unroll
                    for (int ks = 0; ks < 8; ++ks) bqa[pp][ks] = *(const GAS bf16x8*)(qp + ks * 16); }
            }
            float v[64];
#pragma unroll
            for (int kb = 0; kb < 4; ++kb)
#pragma unroll
                for (int r = 0; r < 16; ++r) v[kb * 16 + r] = __uint_as_float((__float_as_uint(acc[kb][r]) & 0xffffff80u) | (unsigned)(kb * 32 + (r & 3) + 8 * (r >> 2)));
            top16_of_64(v);
            const unsigned hb = (unsigned)hi << 2;
#pragma unroll
            for (int i = 0; i < 16; ++i) v[i] = __uint_as_float(__float_as_uint(v[i]) | hb);
            float c[16];
#pragma unroll
            for (int i = 0; i < 16; ++i) c[i] = fmax_s(v[i], __shfl_xor(v[15 - i], 32));
            merge16_desc(c);
#pragma unroll
            for (int i = 0; i < 16; ++i) { if (p == 0) T0[i] = c[i]; else T1[i] = c[i]; }
        }
        float f0[16], f1[16];
        unsigned long long K0lo = 0ull, K0hi = 0ull, K1lo = 0ull, K1hi = 0ull;
#pragma unroll
        for (int b = 0; b < 8; ++b) {
            K0lo |= (unsigned long long)(__float_as_uint(T0[b]) & 0x7fu) << (8 * b); K0hi |= (unsigned long long)(__float_as_uint(T0[8 + b]) & 0x7fu) << (8 * b);
            K1lo |= (unsigned long long)(__float_as_uint(T1[b]) & 0x7fu) << (8 * b); K1hi |= (unsigned long long)(__float_as_uint(T1[8 + b]) & 0x7fu) << (8 * b);
        }
#pragma unroll
        for (int i = 0; i < 16; ++i) { f0[i] = __uint_as_float(__float_as_uint(T0[i]) & 0xffffff80u); f1[i] = __uint_as_float(__float_as_uint(T1[i]) & 0xffffff80u); }
        float cd[32]; int n = 0;
#pragma unroll
        for (int i = 0; i < 16; ++i)
#pragma unroll
            for (int j = 0; j < 16; ++j)
                if ((i + 1) * (j + 1) <= 16) {
                    const float cv = __uint_as_float((__float_as_uint(f0[i] + f1[j]) & 0xffffff00u) | (unsigned)(i * 16 + j));
                    if ((n & 1) == 0) cd[n >> 1] = cv; else cd[n >> 1] = hi ? cv : cd[n >> 1];
                    ++n;
                }
#pragma unroll
        for (int q = 25; q < 32; ++q) cd[q] = __uint_as_float(0xff800000u);
        sort16_desc(cd); sort16_desc(cd + 16); top16_merge(cd, cd + 16);
        { float cm[16];
#pragma unroll
          for (int i = 0; i < 16; ++i) cm[i] = fmax_s(cd[i], __shfl_xor(cd[15 - i], 32));
          merge16_desc(cm);
#pragma unroll
          for (int i = 0; i < 16; ++i) cd[i] = cm[i]; }
        float rs = 0.f;
        { const GAS f32x4* rp = (const GAS f32x4*)(RS1 + (size_t)tok * 16);
#pragma unroll
          for (int i = 0; i < 4; ++i) { const f32x4 a = rp[i]; rs += (a.x + a.y) + (a.z + a.w); } }
        const float rstd = __builtin_amdgcn_rsqf(rs * (1.0f / 1024.0f) + EPS);
        int eidx[16]; float gt_[16]; float z0 = 0.f, sum = 0.f;
#pragma unroll
        for (int k = 0; k < 16; ++k) {
            const unsigned wb = __float_as_uint(cd[k]); const unsigned i = (wb >> 4) & 15u, j = wb & 15u;
            eidx[k] = (int)(key_lookup(K0lo, K0hi, i) * 128u + key_lookup(K1lo, K1hi, j));
            const float z = __uint_as_float(wb & 0xffffff00u) * rstd;
            if (k == 0) z0 = z;
            gt_[k] = __expf(z - z0); sum += gt_[k];
        }
        const float inv = 1.0f / sum;
        if (hi == 0) { GAS i32x4* ep = (GAS i32x4*)(EIDX + (size_t)tok * 128 + h * 16);
#pragma unroll
            for (int q = 0; q < 4; ++q) ep[q] = (i32x4){eidx[4 * q], eidx[4 * q + 1], eidx[4 * q + 2], eidx[4 * q + 3]};
        } else { GAS f32x4* gp = (GAS f32x4*)(GATE + (size_t)tok * 128 + h * 16);
#pragma unroll
            for (int q = 0; q < 4; ++q) gp[q] = (f32x4){gt_[4 * q] * inv, gt_[4 * q + 1] * inv, gt_[4 * q + 2] * inv, gt_[4 * q + 3] * inv};
        }
    }
}

__device__ __forceinline__ float gelu_tanh(float x) {
    const float y = 1.5957691216057308f * (x + 0.044715f * x * x * x);
    return x / (1.0f + __expf(-y));
}
typedef int v8i __attribute__((ext_vector_type(8)));
#define PEER_MFMA(a, b, c) __builtin_amdgcn_mfma_scale_f32_16x16x128_f8f6f4(a, b, c, 4  , 0  , 0, 0x7F7F7F7F, 0, 0x7F7F7F7F)
__device__ __forceinline__ void peer_dots_phase(const Ptrs& P, LAS unsigned char* lds, int vcu, int G, int wave, int lane) {
    const int gw = vcu * NWAVES + wave, NGW = G * NWAVES;
    const bf16* HB = (const bf16*)(P.ws + WS_HB); float* CF = (float*)(P.ws + WS_CF);
    const int* EIDX = (const int*)(P.ws + WS_EIDX); const float* GATE = (const float*)(P.ws + WS_GATE);
    const unsigned char* U4 = P.ws + WS_U;
    const float* SU = (const float*)(P.ws + WS_SU); const float* SV = (const float*)(P.ws + WS_SV);
    LAS unsigned char* xl = lds + 65536 + wave * 1024;
    LAS unsigned char* tb = lds + wave * 8192;
    const int lr = lane >> 5, lp = lane & 31;
    const int li = lane & 15, lq = lane >> 4;
    const int kl = 4 * lq + (li & 3);
    int t = gw; if (t >= M) return;
    int ei0 = EIDX[(size_t)t * 128 + lane], ei1 = EIDX[(size_t)t * 128 + 64 + lane];
    float gg0 = GATE[(size_t)t * 128 + lane], gg1 = GATE[(size_t)t * 128 + 64 + lane];
    v2u hrow[4];
    { const GAS v2u* hp = (const GAS v2u*)(HB + (size_t)t * 1024) + lane;
#pragma unroll
      for (int j = 0; j < 4; ++j) hrow[j] = hp[64 * j]; }
    v4u uw[8];
#pragma unroll
    for (int v = 0; v < 8; ++v) { const int e = __shfl(ei0, 2 * v + lr); uw[v] = *(const GAS v4u*)(U4 + (size_t)e * 512 + 16 * lp); }
    for (; t < M; t += NGW) {
        const int tn = (t + NGW < M) ? t + NGW : t;
        f32x2 x[8]; float ss = 0.f;
#pragma unroll
        for (int j = 0; j < 4; ++j) { const unsigned wa = hrow[j].x, wb = hrow[j].y; x[2 * j] = (f32x2){bf_lo(wa), bf_hi(wa)}; x[2 * j + 1] = (f32x2){bf_lo(wb), bf_hi(wb)};
            ss += (x[2 * j].x * x[2 * j].x + x[2 * j].y * x[2 * j].y) + (x[2 * j + 1].x * x[2 * j + 1].x + x[2 * j + 1].y * x[2 * j + 1].y); }
        ss = wave_sum(ss);
        const float rstd = __builtin_amdgcn_rsqf(ss * (1.0f / 1024.0f) + EPS);
        { const float sx = 16.0f * rstd;
#pragma unroll
          for (int j = 0; j < 4; ++j) { int w = __builtin_amdgcn_cvt_pk_fp8_f32(x[2 * j].x * sx, x[2 * j].y * sx, 0, false); w = __builtin_amdgcn_cvt_pk_fp8_f32(x[2 * j + 1].x * sx, x[2 * j + 1].y * sx, w, true);
              const int n = 4 * lane + 256 * j, sN = n >> 7, nn = n & 127, hN = nn >> 6, qN = (nn & 63) >> 4, jN = nn & 15;
              *(LAS unsigned*)(xl + 128 * sN + 32 * qN + 16 * hN + jN) = (unsigned)w; }
          asm volatile("s_waitcnt lgkmcnt(0)" ::: "memory"); }
        v8i xb[8];
#pragma unroll
        for (int sI = 0; sI < 8; ++sI) { const v4u b0 = *(const LAS v4u*)(xl + 128 * sI + 32 * lq), b1 = *(const LAS v4u*)(xl + 128 * sI + 32 * lq + 16);
            xb[sI] = (v8i){(int)b0.x, (int)b0.y, (int)b0.z, (int)b0.w, (int)b1.x, (int)b1.y, (int)b1.z, (int)b1.w}; }
        const int nei0 = EIDX[(size_t)tn * 128 + lane], nei1 = EIDX[(size_t)tn * 128 + 64 + lane];
        const float ngg0 = GATE[(size_t)tn * 128 + lane], ngg1 = GATE[(size_t)tn * 128 + 64 + lane];
        { const GAS v2u* hn = (const GAS v2u*)(HB + (size_t)tn * 1024) + lane;
#pragma unroll
          for (int j = 0; j < 4; ++j) hrow[j] = hn[64 * j]; }
        for (int hq = 0; hq < 8 * REPS(7); ++hq) { const int hh = hq & 7;
            const int ereg = hh < 4 ? ei0 : ei1; const float greg = hh < 4 ? gg0 : gg1; const int lb = (hh & 3) * 16;
            const int el = __shfl(ereg, lb + kl);
            const float su = SU[el], sv = SV[el];
#pragma unroll
            for (int v = 0; v < 8; ++v) { const int r = 2 * v + lr; *(LAS v4u*)(tb + 512 * r + 16 * (lp ^ r)) = uw[v]; }
            __builtin_amdgcn_sched_barrier(0);
            { const bool lasth = (hq == 8 * REPS(7) - 1); const int hn = (hh + 1) & 7;
              const int nreg = lasth ? nei0 : (hn < 4 ? ei0 : ei1); const int nlb = (hn & 3) * 16;
#pragma unroll
              for (int v = 0; v < 8; ++v) { const int e = __shfl(nreg, nlb + 2 * v + lr); uw[v] = *(const GAS v4u*)(U4 + (size_t)e * 512 + 16 * lp); } }
            __builtin_amdgcn_sched_barrier(0);
            f32x4 acc = {0.f, 0.f, 0.f, 0.f};
#pragma unroll
            for (int sI = 0; sI < 8; ++sI) { const v4u af = *(const LAS v4u*)(tb + 512 * li + 16 * ((4 * sI + lq) ^ li));
                const v8i av = {(int)af.x, (int)af.y, (int)af.z, (int)af.w, 0, 0, 0, 0}; acc = PEER_MFMA(av, xb[sI], acc); }
            const int rsel = li & 3;
            const float d = rsel == 0 ? acc[0] : (rsel == 1 ? acc[1] : (rsel == 2 ? acc[2] : acc[3]));
            const float gk = __shfl(greg, lb + kl);
            const float cf = gk * gelu_tanh(d * su * (1.0f / 16.0f)) * sv * 1024.0f;
            if (li < 4) CF[(size_t)t * 128 + hh * 16 + kl] = cf;
        }
        ei0 = nei0; ei1 = nei1; gg0 = ngg0; gg1 = ngg1;
    }
}
__device__ __forceinline__ void peer_sum_phase(const Ptrs& P, int vcu, int G, int wave, int lane) {
    const int gw = vcu * NWAVES + wave, NGW = G * NWAVES;
    bf16* HB = (bf16*)(P.ws + WS_HB); float* RS2 = (float*)(P.ws + WS_RS2); const float* CF = (const float*)(P.ws + WS_CF);
    const int* EIDX = (const int*)(P.ws + WS_EIDX); const unsigned char* V4 = P.ws + WS_V;
    const int li = lane & 15, lq = lane >> 4;
    const unsigned bsh = 8u * (unsigned)(li & 3); const int breg = li >> 2;
    int t = gw; if (t >= M) return;
    int ei0 = EIDX[(size_t)t * 128 + lane], ei1 = EIDX[(size_t)t * 128 + 64 + lane];
    float cf0 = CF[(size_t)t * 128 + lane], cf1 = CF[(size_t)t * 128 + 64 + lane];
    v2u hrow[4];
    { const GAS v2u* hp = (const GAS v2u*)(HB + (size_t)t * 1024) + lane;
#pragma unroll
      for (int j = 0; j < 4; ++j) hrow[j] = hp[64 * j]; }
    v4u va[2][2], vb[2][2];
#pragma unroll
    for (int g8 = 0; g8 < 2; ++g8) {
        const int eA = __shfl(ei0, 8 * g8 + 2 * lq), eB = __shfl(ei0, 8 * g8 + 2 * lq + 1);
        const GAS v4u* pa = (const GAS v4u*)(V4 + (size_t)eA * 512 + 16 * li); const GAS v4u* pb = (const GAS v4u*)(V4 + (size_t)eB * 512 + 16 * li);
        va[g8][0] = pa[0]; va[g8][1] = pa[16]; vb[g8][0] = pb[0]; vb[g8][1] = pb[16];
    }
    for (; t < M; t += NGW) {
        const int tn = (t + NGW < M) ? t + NGW : t;
        const int nei0 = EIDX[(size_t)tn * 128 + lane], nei1 = EIDX[(size_t)tn * 128 + 64 + lane];
        const float ncf0 = CF[(size_t)tn * 128 + lane], ncf1 = CF[(size_t)tn * 128 + 64 + lane];
        f32x4 oacc[4];
#pragma unroll
        for (int b = 0; b < 4; ++b) oacc[b] = (f32x4){0.f, 0.f, 0.f, 0.f};
        for (int hq = 0; hq < 8 * REPS(11); ++hq) { const int hh = hq & 7;
            const float creg = hh < 4 ? cf0 : cf1; const int lb = (hh & 3) * 16;
            v8i bv[2];
#pragma unroll
            for (int g8 = 0; g8 < 2; ++g8) {
                float cA = __shfl(creg, lb + 8 * g8 + lq), cB = __shfl(creg, lb + 8 * g8 + 4 + lq);
                cA = fminf(fmaxf(cA, -448.0f), 448.0f); cB = fminf(fmaxf(cB, -448.0f), 448.0f);
                const unsigned pk = (unsigned)__builtin_amdgcn_cvt_pk_fp8_f32(cA, cB, 0, false);
                const unsigned wA = (pk & 0xffu) << bsh, wB = ((pk >> 8) & 0xffu) << bsh;
                bv[g8] = (v8i){breg == 0 ? (int)wA : 0, breg == 1 ? (int)wA : 0, breg == 2 ? (int)wA : 0, breg == 3 ? (int)wA : 0,
                               breg == 0 ? (int)wB : 0, breg == 1 ? (int)wB : 0, breg == 2 ? (int)wB : 0, breg == 3 ? (int)wB : 0};
            }
#pragma unroll
            for (int g8 = 0; g8 < 2; ++g8) {
                { const v8i a0 = {(int)va[g8][0].x, (int)va[g8][0].y, (int)vb[g8][0].x, (int)vb[g8][0].y, 0, 0, 0, 0}; oacc[0] = PEER_MFMA(a0, bv[g8], oacc[0]); }
                { const v8i a1 = {(int)va[g8][0].z, (int)va[g8][0].w, (int)vb[g8][0].z, (int)vb[g8][0].w, 0, 0, 0, 0}; oacc[1] = PEER_MFMA(a1, bv[g8], oacc[1]); }
                { const v8i a2 = {(int)va[g8][1].x, (int)va[g8][1].y, (int)vb[g8][1].x, (int)vb[g8][1].y, 0, 0, 0, 0}; oacc[2] = PEER_MFMA(a2, bv[g8], oacc[2]); }
                { const v8i a3 = {(int)va[g8][1].z, (int)va[g8][1].w, (int)vb[g8][1].z, (int)vb[g8][1].w, 0, 0, 0, 0}; oacc[3] = PEER_MFMA(a3, bv[g8], oacc[3]); }
            }
            __builtin_amdgcn_sched_barrier(0);
            { const bool lasth = (hq == 8 * REPS(11) - 1); const int hn = (hh + 1) & 7;
              const int nreg = lasth ? nei0 : (hn < 4 ? ei0 : ei1); const int nlb = (hn & 3) * 16;
#pragma unroll
              for (int g8 = 0; g8 < 2; ++g8) {
                  const int eA = __shfl(nreg, nlb + 8 * g8 + 2 * lq), eB = __shfl(nreg, nlb + 8 * g8 + 2 * lq + 1);
                  const GAS v4u* pa = (const GAS v4u*)(V4 + (size_t)eA * 512 + 16 * li); const GAS v4u* pb = (const GAS v4u*)(V4 + (size_t)eB * 512 + 16 * li);
                  va[g8][0] = pa[0]; va[g8][1] = pa[16]; vb[g8][0] = pb[0]; vb[g8][1] = pb[16];
              } }
            __builtin_amdgcn_sched_barrier(0);
        }
        const float osc = (REPS(11) == 2 ? 0.5f : 1.0f) * (1.0f / 1024.0f);
        float s2 = 0.f;
        GAS v2u* hb = (GAS v2u*)(HB + (size_t)t * 1024) + lane;
#pragma unroll
        for (int j = 0; j < 4; ++j) { const unsigned wa = hrow[j].x, wb = hrow[j].y;
            const f32x2 o0 = (f32x2){bf_lo(wa) + oacc[j][0] * osc, bf_hi(wa) + oacc[j][1] * osc}, o1 = (f32x2){bf_lo(wb) + oacc[j][2] * osc, bf_hi(wb) + oacc[j][3] * osc};
            hb[64 * j] = (v2u){pk2(o0.x, o0.y), pk2(o1.x, o1.y)};
            s2 += (o0.x * o0.x + o0.y * o0.y) + (o1.x * o1.x + o1.y * o1.y); }
        s2 = wave_sum(s2);
        if (lane == 0) RS2[t] = s2;
        { const GAS v2u* hn = (const GAS v2u*)(HB + (size_t)tn * 1024) + lane;
#pragma unroll
          for (int j = 0; j < 4; ++j) hrow[j] = hn[64 * j]; }
        ei0 = nei0; ei1 = nei1; cf0 = ncf0; cf1 = ncf1;
    }
}

__device__ __forceinline__ void final_phase(const Ptrs& P, int vcu, int G, int wave, int lane) {
    const int gw = vcu * NWAVES + wave, NGW = G * NWAVES; const float* RS3 = (const float*)(P.ws + WS_RS3); const bf16* H3 = (const bf16*)(P.ws + WS_PROJ);
    const GAS f32x4* gf = (const GAS f32x4*)P.g_final + lane;
    f32x4 g[4];
#pragma unroll
    for (int j = 0; j < 4; ++j) g[j] = gf[64 * j];
    for (int m0 = 2 * gw; m0 < M; m0 += 2 * NGW) {
        v2u hv[2][4]; float rs[2];
#pragma unroll
        for (int r = 0; r < 2; ++r) { const GAS v2u* hp = (const GAS v2u*)(H3 + (size_t)(m0 + r) * D) + lane;
#pragma unroll
            for (int j = 0; j < 4; ++j) hv[r][j] = hp[64 * j];
            rs[r] = 0.f; const GAS f32x4* rp = (const GAS f32x4*)(RS3 + (size_t)(m0 + r) * 16);
#pragma unroll
            for (int i = 0; i < 4; ++i) { const f32x4 a = rp[i]; rs[r] += (a.x + a.y) + (a.z + a.w); } }
#pragma unroll
        for (int r = 0; r < 2; ++r) { const float rstd = __builtin_amdgcn_rsqf(rs[r] * (1.0f / 1024.0f) + EPS);
            GAS f32x4* xr = (GAS f32x4*)(P.out + (size_t)(m0 + r) * D) + lane;
#pragma unroll
            for (int j = 0; j < 4; ++j) { const unsigned wa = hv[r][j].x, wb = hv[r][j].y; const f32x4 v = {bf_lo(wa), bf_hi(wa), bf_lo(wb), bf_hi(wb)}; xr[64 * j] = v * rstd * g[j]; } }
    }
}

struct Args { const float* in[17]; float* out; unsigned char* ws; int ph_lo, ph_hi; };
#ifndef PG8_SP2
#define PG8_SP2 true
#endif
#ifndef PG8_ALIGN
#define PG8_ALIGN true
#endif
__global__ void __launch_bounds__(NWAVES * 64, 2) mega_fwd(Args args) {
    extern __shared__ __attribute__((aligned(16))) unsigned char lds_raw[];
    LAS unsigned char* lds = (LAS unsigned char*)lds_raw;
    volatile LAS unsigned* MISC = (volatile LAS unsigned*)(lds + MISC_OFF);
    const int tid = threadIdx.x, lane = tid & 63, wave = __builtin_amdgcn_readfirstlane(tid >> 6);
    const int G = gridDim.x, bx = blockIdx.x; const int vcu = (G % 8 == 0) ? (bx % 8) * (G / 8) + bx / 8 : bx;
    Ptrs P;
    P.x = args.in[0]; P.p = args.in[1]; P.g_mix = args.in[2]; P.w_in = args.in[3]; P.conv_w = args.in[4]; P.pool_w = args.in[5]; P.pool_scale = args.in[6]; P.w_o = args.in[7];
    P.g_ffn = args.in[8]; P.w_q = args.in[9]; P.sub_keys = args.in[10]; P.eu = args.in[11]; P.ev = args.in[12]; P.g_ple = args.in[13]; P.w_gate = args.in[14]; P.w_proj = args.in[15]; P.g_final = args.in[16];
    P.out = args.out; P.ws = args.ws;
    gu32* ctl = (gu32*)(P.ws + WS_CTL);
    for (int u = tid; u < (LDS_BYTES - LDSCTL_OFF) / 4; u += NWAVES * 64) ((LAS unsigned*)(lds + LDSCTL_OFF))[u] = 0u;
    __syncthreads();
    XcdBarrier bar; bar.bar = (unsigned*)(ctl + CW_BAR); bar.x = 0; bar.st = nullptr;
    if (!MK_PER_PHASE) bar = xcd_barrier_post((unsigned*)(ctl + CW_BAR), MISC + 8);
    const int lo = args.ph_lo, hi = args.ph_hi;
#define IN(k) (lo <= (k) && (k) < hi)
#define SEAM(k) do { if (IN(k) && IN((k) + 1)) xcd_barrier(bar); } while (0)
    pg8::bf16_t* const WIN = (pg8::bf16_t*)(P.ws + WS_WIN); pg8::bf16_t* const WO = (pg8::bf16_t*)(P.ws + WS_WO); pg8::bf16_t* const WQ = (pg8::bf16_t*)(P.ws + WS_WQ);
    pg8::bf16_t* const WG = (pg8::bf16_t*)(P.ws + WS_WG); pg8::bf16_t* const WP = (pg8::bf16_t*)(P.ws + WS_WP);
    pg8::bf16_t* const XB = (pg8::bf16_t*)(P.ws + WS_XB); pg8::bf16_t* const PL = XB; pg8::bf16_t* const PROJ = (pg8::bf16_t*)(P.ws + WS_PROJ); pg8::bf16_t* const QB = PROJ;
    pg8::bf16_t* const MIX = (pg8::bf16_t*)(P.ws + WS_MIX); pg8::bf16_t* const HB = (pg8::bf16_t*)(P.ws + WS_HB); pg8::bf16_t* const PB = (pg8::bf16_t*)(P.ws + WS_PB);

    if (IN(0)) { for (int rep = 0; rep < REPS(1); ++rep) { p0a_phase(P, lds, vcu, G, tid, wave, lane); SEAM(0); } }
    if (IN(1)) { p0b_phase(P, lds, vcu, G, wave, lane); SEAM(1); }
    if (IN(2)) {
        pg8::Gemm g{XB, WIN, M, NPROJ, D}; pg8::StaticOrder S; S.init(M, NPROJ, G, bx);
        EpiProj E{PROJ, (const float*)(P.ws + WS_RSX)};
        for (int rep = 0; rep < REPS(2); ++rep) { pg8::gemm_phase<EpiProj, pg8::StaticOrder, PG8_ALIGN, PG8_SP2>(lds, g, S, E);
        SEAM(2); }
    }
    if (IN(3)) {
        for (int rep = 0; rep < REPS(3); ++rep) p2_phase(P, vcu, G, tid, wave);
        pg8::Gemm g{PB, WP, M, D, PLED}; pg8::StaticOrder S; S.init(M, D, G, bx);
        EpiBf16Row E{PL, D, nullptr};
        for (int rep = 0; rep < REPS(8); ++rep) pg8::gemm_phase<EpiBf16Row, pg8::StaticOrder, PG8_ALIGN, PG8_SP2>(lds, g, S, E);
        SEAM(3);
    }
    if (IN(4)) {
        pg8::Gemm g{MIX, WO, M, D, D}; pg8::StaticOrder S; S.init(M, D, G, bx);
        EpiH1 E{P.x, HB, (float*)(P.ws + WS_RS1)};
        for (int rep = 0; rep < REPS(4); ++rep) { pg8::gemm_phase<EpiH1, pg8::StaticOrder, PG8_ALIGN, PG8_SP2>(lds, g, S, E);
        SEAM(4); }
    }
    if (IN(5)) {
        pg8::Gemm g{HB, WQ, M, NQ, D}; pg8::StaticOrder S; S.init(M, NQ, G, bx);
        EpiBf16Row E{QB, NQ, nullptr};
        for (int rep = 0; rep < REPS(5); ++rep) { pg8::gemm_phase<EpiBf16Row, pg8::StaticOrder, PG8_ALIGN, PG8_SP2>(lds, g, S, E);
        SEAM(5); }
    }
    if (IN(6)) { for (int rep = 0; rep < REPS(6); ++rep) { score_phase(P, lds, bx, G, tid, wave, lane); SEAM(6); } }
    if (IN(7)) { peer_dots_phase(P, lds, vcu, G, wave, lane); SEAM(7); }
    if (IN(8)) { peer_sum_phase(P, vcu, G, wave, lane); SEAM(8); }
    if (IN(9)) {
        pg8::Gemm g{HB, WG, M, D, D}; pg8::StaticOrder S; S.init(M, D, G, bx);
        EpiGate E{PROJ  , HB, PL, (const float*)(P.ws + WS_RS2), (float*)(P.ws + WS_RS3)};
        pg8::gemm_phase<EpiGate, pg8::StaticOrder, PG8_ALIGN, PG8_SP2>(lds, g, S, E);
        SEAM(9);
    }
    if (IN(10)) { final_phase(P, vcu, G, wave, lane); }
#undef IN
#undef SEAM
}

extern "C" void kernel_launch(void* const* d_in, const int* in_sizes, int n_in, void* d_out, int out_size, void* d_ws, size_t ws_size, hipStream_t stream) {
    static int grid = 0;
    if (grid == 0) {
        if (n_in != 17 || in_sizes[0] != M * D || out_size != M * D || ws_size < WS_END) { fprintf(stderr, "kernel_launch: unexpected shapes (n_in %d, in0 %d, out %d, ws %zu); nothing launched\n", n_in, n_in > 0 ? in_sizes[0] : -1, out_size, ws_size); grid = -1; return; }
        int dev = 0, cus = 0, per_cu = 0;
        if (hipGetDevice(&dev) != hipSuccess || hipDeviceGetAttribute(&cus, hipDeviceAttributeMultiprocessorCount, dev) != hipSuccess) { fprintf(stderr, "kernel_launch: device query failed\n"); grid = -1; return; }
        if (hipFuncSetAttribute((const void*)mega_fwd, hipFuncAttributeMaxDynamicSharedMemorySize, LDS_BYTES) != hipSuccess) { fprintf(stderr, "kernel_launch: hipFuncSetAttribute failed\n"); grid = -1; return; }
        if (hipOccupancyMaxActiveBlocksPerMultiprocessor(&per_cu, (const void*)mega_fwd, NWAVES * 64, LDS_BYTES) != hipSuccess || per_cu < 1) {
            fprintf(stderr, "kernel_launch: the occupancy query reports %d resident workgroups per CU for this kernel (512 threads, %d B LDS): the grid barrier needs one per CU; nothing launched\n", per_cu, LDS_BYTES);
            (void)hipGetLastError(); grid = -1; return; }
        grid = cus;
    }
    if (grid < 0) return;
    if (hipMemsetAsync((char*)d_ws + WS_CTL, 0, CTL_ZERO_BYTES, stream) != hipSuccess) { fprintf(stderr, "kernel_launch: memset failed\n"); return; }
    Args a{};
    for (int i = 0; i < 17; ++i) a.in[i] = (const float*)d_in[i];
    a.out = (float*)d_out; a.ws = (unsigned char*)d_ws;
#if MK_PER_PHASE
    for (int ph = 0; ph < NPHASES; ++ph) { a.ph_lo = ph; a.ph_hi = ph + 1; hipLaunchKernelGGL(mega_fwd, dim3(grid), dim3(NWAVES * 64), LDS_BYTES, stream, a); }
#else
    a.ph_lo = 0; a.ph_hi = NPHASES;
    hipLaunchKernelGGL(mega_fwd, dim3(grid), dim3(NWAVES * 64), LDS_BYTES, stream, a);
#endif
    const hipError_t le = hipPeekAtLastError();
    if (le != hipSuccess) fprintf(stderr, "kernel_launch: launch failed: %s\n", hipGetErrorName(le));
}
```

```cpp
#include <hip/hip_runtime.h>
#include <cstdio>
#include <cstdint>
namespace pg8 {
#define PG8_LAS __attribute__((address_space(3)))
typedef unsigned short bf16_t;
typedef short bf16x8 __attribute__((ext_vector_type(8)));
typedef float f32x4 __attribute__((ext_vector_type(4)));
typedef unsigned u32x4 __attribute__((ext_vector_type(4)));
constexpr int BM = 256, BK = 64, HALF = 128, HTB = HALF * BK * 2  , STAGE_BYTES = 8 * HTB, NXCD = 8, WGM = 8;

__host__ __device__ __forceinline__ int lds_byte(int r, int c) { const int st = (r >> 4) * 2 + (c >> 5), rr = r & 15, cc = c & 31, ob = rr * 64 + cc * 2; return st * 1024 + (ob ^ (((ob >> 9) & 1) << 5)); }
__host__ __device__ __forceinline__ void stage_rc(int b, int& R, int& C) { const int st = b / 1024, sb = b % 1024, swz = sb ^ (((sb >> 9) & 1) << 5); R = (st >> 1) * 16 + swz / 64; C = (st & 1) * 32 + (swz % 64) / 2; }
__host__ __device__ __forceinline__ int perm32(int rho) { const int n = rho >> 4, i = rho & 15; return 8 * (i >> 2) + 4 * n + (i & 3); }

struct Unit { int pm, pn; };
struct Gemm { const bf16_t* A; const bf16_t* Bt; int M, N, K; };

struct StaticOrder {
    int nM, nN, nwg, G, c;
    __host__ __device__ void init(int M, int N, int G_, int c_) { nM = M / BM; nN = N / BM; nwg = nM * nN; G = G_; c = c_; }
    __host__ __device__ bool next(int i, Unit& u) const {
        const long L = (long)i * G + c; if (L >= nwg) return false;
        int wgid = (int)L; { const int q = nwg / NXCD, r = nwg % NXCD, xcd = wgid % NXCD, off = wgid / NXCD; wgid = (xcd < r ? xcd * (q + 1) : r * (q + 1) + (xcd - r) * q) + off; }
        const int nig = WGM * nN, gid = wgid / nig, fm = gid * WGM, gsz = (nM - fm) < WGM ? (nM - fm) : WGM;
        u.pm = fm + ((wgid % nig) % gsz); u.pn = (wgid % nig) / gsz; return true;
    }
    __device__ __forceinline__ void a_ready(const Unit&) const {}
    __device__ __forceinline__ void done(const Unit&) const {}
};

__device__ __forceinline__ unsigned cvt_pk_bf16(float lo, float hi) { unsigned r; asm volatile("v_cvt_pk_bf16_f32 %0, %1, %2" : "=v"(r) : "v"(lo), "v"(hi)); return r; }
template <class Epi, class Sched, bool ALIGN_EPI = false, bool SP2 = false>
__device__ __forceinline__ void gemm_phase(PG8_LAS unsigned char* lds, const Gemm g, const Sched& S, const Epi& E) {
    const int tid = threadIdx.x, wid = __builtin_amdgcn_readfirstlane(tid >> 6), lane = tid & 63, wr = wid >> 2, wc = wid & 3, fr = lane & 15, fq = lane >> 4;
    const int K = g.K, nt = K / BK;
    unsigned voffA[2], voffB[2];
#pragma unroll
    for (int i = 0; i < 2; ++i) { int R, C; stage_rc(tid * 16 + i * 8192, R, C); const int Rb = Epi::PERM ? ((R & ~31) + perm32(R & 31)) : R;
        voffA[i] = (unsigned)(R * K + C) * 2u; voffB[i] = (unsigned)(Rb * K + C) * 2u; }
    const size_t kstep = (size_t)(BK * 2);
    const size_t hstep = (size_t)HALF * K * 2;
    const size_t tstep = 2 * hstep;
    const unsigned ldsw = (unsigned)wid * 1024u;
    const int aoff = lds_byte(wr * 64 + fr, fq * 8), boff = lds_byte(wc * 32 + fr, fq * 8);
#define PG8_SA(b, h) (((b) * 2 + (h)) * HTB)
#define PG8_SB(b, h) ((4 + (b) * 2 + (h)) * HTB)
#define PG8_STAGE(bufoff, gbase, voff) do { _Pragma("unroll") for (int _i = 0; _i < 2; ++_i) \
        __builtin_amdgcn_global_load_lds((const unsigned*)((const char*)(gbase) + (voff)[_i]), (PG8_LAS unsigned*)(lds + (bufoff) + ldsw + _i * 8192), 16, 0, 0); } while (0)
#define PG8_LDA(dst, b, h) do { _Pragma("unroll") for (int m = 0; m < 4; ++m) _Pragma("unroll") for (int k = 0; k < 2; ++k) dst[m][k] = *(const PG8_LAS bf16x8*)(lds + PG8_SA(b, h) + aoff + m * 2048 + k * 1024); } while (0)
#define PG8_LDB(dst, b, h) do { _Pragma("unroll") for (int n = 0; n < 2; ++n) _Pragma("unroll") for (int k = 0; k < 2; ++k) dst[n][k] = *(const PG8_LAS bf16x8*)(lds + PG8_SB(b, h) + boff + n * 2048 + k * 1024); } while (0)
#define PG8_MMA(ai, bj, At, Bt) do { __builtin_amdgcn_s_setprio(1); _Pragma("unroll") for (int m = 0; m < 4; ++m) _Pragma("unroll") for (int n = 0; n < 2; ++n) _Pragma("unroll") for (int k = 0; k < 2; ++k) \
        acc[ai][bj][m][n] = __builtin_amdgcn_mfma_f32_16x16x32_bf16(Bt[n][k], At[m][k], acc[ai][bj][m][n], 0, 0, 0); __builtin_amdgcn_s_setprio(0); } while (0)
#define PG8_WAIT_V(n) asm volatile("s_waitcnt vmcnt(" #n ")" ::: "memory")
#define PG8_WAIT_L(n) asm volatile("s_waitcnt lgkmcnt(" #n ")" ::: "memory")
#define PG8_BAR __builtin_amdgcn_s_barrier()
#define PG8_SCHED __builtin_amdgcn_sched_barrier(0)
    Unit cur, nxt; int ui = 0;
    if (!S.next(0, cur)) return;
    f32x4 acc[2][2][4][2];
#pragma unroll
    for (int a = 0; a < 2; ++a)
#pragma unroll
        for (int b = 0; b < 2; ++b)
#pragma unroll
            for (int m = 0; m < 4; ++m)
#pragma unroll
                for (int n = 0; n < 2; ++n) acc[a][b][m][n] = (f32x4){0.f, 0.f, 0.f, 0.f};
    bf16x8 At[4][2], B0[2][2], B1[2][2];
    const char* cA = (const char*)g.A + (size_t)cur.pm * tstep; const char* cB = (const char*)g.Bt + (size_t)cur.pn * tstep;
    S.a_ready(cur);
    if constexpr (SP2) {
        PG8_STAGE(PG8_SB(0, 0), cB, voffB); PG8_STAGE(PG8_SB(0, 1), cB + hstep, voffB); PG8_STAGE(PG8_SA(0, 0), cA, voffA); PG8_STAGE(PG8_SA(0, 1), cA + hstep, voffA);
        if (wr == 1) PG8_BAR;
        PG8_WAIT_V(2); PG8_BAR;
        PG8_STAGE(PG8_SB(1, 0), cB + kstep, voffB); PG8_STAGE(PG8_SA(1, 0), cA + kstep, voffA); PG8_STAGE(PG8_SB(1, 1), cB + hstep + kstep, voffB);
        PG8_WAIT_V(6); PG8_BAR;
    } else {
        PG8_STAGE(PG8_SB(0, 0), cB, voffB); PG8_STAGE(PG8_SA(0, 0), cA, voffA); PG8_STAGE(PG8_SB(0, 1), cB + hstep, voffB); PG8_STAGE(PG8_SA(0, 1), cA + hstep, voffA);
        if (wr == 1) PG8_BAR;
        PG8_WAIT_V(4); PG8_BAR;
        PG8_STAGE(PG8_SB(1, 0), cB + kstep, voffB); PG8_STAGE(PG8_SA(1, 0), cA + kstep, voffA); PG8_STAGE(PG8_SB(1, 1), cB + hstep + kstep, voffB);
        PG8_WAIT_V(6); PG8_BAR;
    }
    for (;;) {
        const bool has_next = S.next(ui + 1, nxt);
        const char* nA = has_next ? (const char*)g.A + (size_t)nxt.pm * tstep : cA; const char* nB = has_next ? (const char*)g.Bt + (size_t)nxt.pn * tstep : cB;
        for (int t = 0; t < nt; t += 2) {
            const bool last = (t == nt - 2);
            const char* a1 = cA + (size_t)(t + 1) * kstep;
            const char* a2 = last ? nA : cA + (size_t)(t + 2) * kstep; const char* b2 = last ? nB : cB + (size_t)(t + 2) * kstep;
            const char* a3 = a2 + kstep; const char* b3 = b2 + kstep;
            if (last && has_next) S.a_ready(nxt);
            if constexpr (SP2) {
            PG8_LDB(B0, 0, 0); PG8_LDB(B1, 0, 1); PG8_SCHED; PG8_LDA(At, 0, 0); PG8_STAGE(PG8_SA(1, 1), a1 + hstep, voffA);
            PG8_WAIT_V(8); PG8_WAIT_L(0); PG8_BAR; PG8_MMA(0, 0, At, B0); PG8_MMA(0, 1, At, B1); PG8_BAR; PG8_SCHED;
            PG8_LDA(At, 0, 1); PG8_STAGE(PG8_SB(0, 0), b2, voffB); PG8_STAGE(PG8_SB(0, 1), b2 + hstep, voffB); PG8_STAGE(PG8_SA(0, 0), a2, voffA);
            PG8_WAIT_V(8); PG8_WAIT_L(0); PG8_BAR; PG8_MMA(1, 0, At, B0); PG8_MMA(1, 1, At, B1); PG8_BAR; PG8_SCHED;
            PG8_LDB(B0, 1, 0); PG8_LDB(B1, 1, 1); PG8_SCHED; PG8_LDA(At, 1, 0); PG8_STAGE(PG8_SA(0, 1), a2 + hstep, voffA);
            PG8_WAIT_V(8); PG8_WAIT_L(0); PG8_BAR; PG8_MMA(0, 0, At, B0); PG8_MMA(0, 1, At, B1); PG8_BAR; PG8_SCHED;
            PG8_LDA(At, 1, 1); PG8_STAGE(PG8_SB(1, 0), b3, voffB); PG8_STAGE(PG8_SB(1, 1), b3 + hstep, voffB); PG8_STAGE(PG8_SA(1, 0), a3, voffA);
            PG8_WAIT_V(8); PG8_WAIT_L(0); PG8_BAR; PG8_MMA(1, 0, At, B0); PG8_MMA(1, 1, At, B1); PG8_BAR; PG8_SCHED;
            } else {
            PG8_LDB(B0, 0, 0); PG8_SCHED; PG8_LDA(At, 0, 0); PG8_STAGE(PG8_SA(1, 1), a1 + hstep, voffA);
            PG8_WAIT_L(8); PG8_BAR; PG8_WAIT_L(0); PG8_MMA(0, 0, At, B0); PG8_BAR; PG8_SCHED;
            PG8_LDB(B1, 0, 1); PG8_STAGE(PG8_SB(0, 0), b2, voffB);
            PG8_BAR; PG8_WAIT_L(0); PG8_MMA(0, 1, At, B1); PG8_BAR;
            PG8_LDA(At, 0, 1); PG8_STAGE(PG8_SA(0, 0), a2, voffA);
            PG8_BAR; PG8_WAIT_L(0); PG8_MMA(1, 0, At, B0); PG8_BAR; PG8_SCHED;
            PG8_STAGE(PG8_SB(0, 1), b2 + hstep, voffB);
            PG8_WAIT_V(6); PG8_BAR; PG8_MMA(1, 1, At, B1); PG8_BAR;
            PG8_LDB(B0, 1, 0); PG8_SCHED; PG8_LDA(At, 1, 0); PG8_STAGE(PG8_SA(0, 1), a2 + hstep, voffA);
            PG8_WAIT_L(8); PG8_BAR; PG8_WAIT_L(0); PG8_MMA(0, 0, At, B0); PG8_BAR; PG8_SCHED;
            PG8_LDB(B1, 1, 1); PG8_STAGE(PG8_SB(1, 0), b3, voffB);
            PG8_BAR; PG8_WAIT_L(0); PG8_MMA(0, 1, At, B1); PG8_BAR;
            PG8_LDA(At, 1, 1); PG8_STAGE(PG8_SA(1, 0), a3, voffA);
            PG8_BAR; PG8_WAIT_L(0); PG8_MMA(1, 0, At, B0); PG8_BAR; PG8_SCHED;
            PG8_STAGE(PG8_SB(1, 1), b3 + hstep, voffB);
            PG8_WAIT_V(6); PG8_BAR; PG8_MMA(1, 1, At, B1); PG8_BAR;
            }
        }
        if constexpr (ALIGN_EPI) { if (wr == 0) PG8_BAR; }
        if constexpr (!Epi::AFTER_DRAIN) { E(acc, cur, wr, wc, fr, fq);
            if constexpr (Epi::TWICE) { asm volatile("" ::: "memory"); E(acc, cur, wr, wc, fr, fq); }
            S.done(cur); }
        if (!has_next) break;
#pragma unroll
        for (int a = 0; a < 2; ++a)
#pragma unroll
            for (int b = 0; b < 2; ++b)
#pragma unroll
                for (int m = 0; m < 4; ++m)
#pragma unroll
                    for (int n = 0; n < 2; ++n) acc[a][b][m][n] = (f32x4){0.f, 0.f, 0.f, 0.f};
        cur = nxt; cA = nA; cB = nB; ++ui;
        if constexpr (ALIGN_EPI) { if (wr == 1) PG8_BAR; }
    }
    PG8_WAIT_V(0);
    if constexpr (!ALIGN_EPI) { if (wr == 0) PG8_BAR; }
    PG8_BAR;
    if constexpr (Epi::AFTER_DRAIN) { E.fused(acc, cur, wr, wc, fr, fq, lds, wid, lane); S.done(cur); }
#undef PG8_SA
#undef PG8_SB
#undef PG8_STAGE
#undef PG8_LDA
#undef PG8_LDB
#undef PG8_MMA
#undef PG8_WAIT_V
#undef PG8_WAIT_L
#undef PG8_BAR
#undef PG8_SCHED
}
}

#define GAS __attribute__((address_space(1)))
#define LAS __attribute__((address_space(3)))
typedef unsigned short bf16;
typedef unsigned v4u __attribute__((ext_vector_type(4)));
typedef float f32x4 __attribute__((ext_vector_type(4)));
typedef short bf16x8 __attribute__((ext_vector_type(8)));
typedef GAS unsigned gu32;
typedef GAS unsigned long long gu64;
#define RLX_AGENT __ATOMIC_RELAXED, __HIP_MEMORY_SCOPE_AGENT
#define LDS_WAIT() asm volatile("s_waitcnt lgkmcnt(0)" ::: "memory")
#define VM_WAIT() asm volatile("s_waitcnt vmcnt(0)" ::: "memory")
__device__ __forceinline__ unsigned long long rt() { return __builtin_amdgcn_s_memrealtime(); }
__device__ __forceinline__ unsigned f2bf(float f) { unsigned u = __builtin_bit_cast(unsigned, f); return (u + 0x7fffu + ((u >> 16) & 1u)) >> 16; }
__device__ __forceinline__ unsigned pk2(float lo, float hi) { return f2bf(lo) | (f2bf(hi) << 16); }

#define XB_TMO      128
#define XB_XCNT(j)  (256  + 64 * (j))
#define XB_XSUB(j)  (1280 + 64 * (j))
#define XB_XGEN(j)  (2304 + 64 * (j))
#define XB_TOP      3328
#define XB_TOPGEN   3392
#define XCD_BAR_WORDS 3456
#define XB_SPIN_CAP (1u << 18)

__device__ __forceinline__ unsigned xb_ld(unsigned* p)              { return __hip_atomic_load(p, __ATOMIC_RELAXED, __HIP_MEMORY_SCOPE_AGENT); }
__device__ __forceinline__ unsigned xb_add(unsigned* p, unsigned v) { return __hip_atomic_fetch_add(p, v, __ATOMIC_RELAXED, __HIP_MEMORY_SCOPE_AGENT); }
__device__ __forceinline__ unsigned xb_xcc_id() { return (unsigned)__builtin_amdgcn_s_getreg((3 << 11) | 20) & 0xFu; }
#define XB_SPIN(cond, bar) do { unsigned _sp = 0; while (cond) { __builtin_amdgcn_s_sleep(1); \
    if ((++_sp & 255u) == 0u) { if (xb_ld(&(bar)[XB_TMO])) break; if (_sp > XB_SPIN_CAP) { atomicAdd(&(bar)[XB_TMO], 1u); break; } } } } while (0)

struct XcdBarrier {
    unsigned* bar; unsigned x;
    volatile LAS unsigned* st;
};

__device__ __forceinline__ XcdBarrier xcd_barrier_post(unsigned* bar, volatile LAS unsigned* st) {
    XcdBarrier b; b.bar = bar; b.x = xb_xcc_id(); b.st = st;
    if (threadIdx.x == 0) (void)xb_add(&bar[XB_XCNT(b.x)], 1u);
    return b;
}
__device__ __forceinline__ void xcd_barrier_complete(unsigned* bar, unsigned x, unsigned& nloc, unsigned& nx) {
    const unsigned G = gridDim.x * gridDim.y * gridDim.z;
    unsigned sum, cnt, mine, sp = 0u;
    for (;;) {
        sum = 0u; cnt = 0u; mine = 0u;
#pragma unroll
        for (unsigned j = 0; j < 16; ++j) { const unsigned c = xb_ld(&bar[XB_XCNT(j)]); sum += c; cnt += (c > 0u) ? 1u : 0u; mine = (j == x) ? c : mine; }
        if (sum == G) break;
        __builtin_amdgcn_s_sleep(1);
        if ((++sp & 255u) == 0u) { if (xb_ld(&bar[XB_TMO])) break; if (sp > XB_SPIN_CAP) { atomicAdd(&bar[XB_TMO], 1u); break; } }
    }
    nloc = mine > 0u ? mine : 1u; nx = cnt > 0u ? cnt : 1u;
}

__device__ __forceinline__ void xcd_barrier(const XcdBarrier& b) {
    asm volatile("s_waitcnt vmcnt(0)" ::: "memory");
    __syncthreads();
    if (threadIdx.x == 0) {
        unsigned* bar = b.bar;
        __builtin_amdgcn_s_waitcnt(0);
        unsigned nloc = b.st[0], nx = b.st[1];
        if (nloc == 0u) { xcd_barrier_complete(bar, b.x, nloc, nx); b.st[0] = nloc; b.st[1] = nx; }
        const unsigned old = xb_add(&bar[XB_XSUB(b.x)], 1u);
        const unsigned gen = old / nloc;
        if (old + 1u == (gen + 1u) * nloc) {
            __builtin_amdgcn_fence(__ATOMIC_RELEASE, "agent");
            asm volatile("s_waitcnt vmcnt(0)" ::: "memory");
            const unsigned og = xb_add(&bar[XB_TOP], 1u);
            const unsigned tg = og / nx;
            if (og + 1u == (tg + 1u) * nx) xb_add(&bar[XB_TOPGEN], 1u);
            else XB_SPIN(xb_ld(&bar[XB_TOPGEN]) == tg, bar);
            __builtin_amdgcn_fence(__ATOMIC_ACQUIRE, "agent");
            xb_add(&bar[XB_XGEN(b.x)], 1u);
            asm volatile("s_waitcnt vmcnt(0)" ::: "memory");
        } else {
            XB_SPIN(xb_ld(&bar[XB_XGEN(b.x)]) == gen, bar);
            __builtin_amdgcn_fence(__ATOMIC_ACQUIRE, "agent");
            asm volatile("s_waitcnt vmcnt(0)" ::: "memory");
        }
    }
    __syncthreads();
}

#ifndef PROBE_REP
#define PROBE_REP 0
#endif
#define REPS(k) ((PROBE_REP == (k)) ? 2 : 1)
constexpr int NWAVES = 8;
constexpr int M = 32768, D = 1024, SEQ = 4096, NPROJ = 2048, NQ = 2048, PLED = 256, NEXP = 16384;
constexpr float EPS = 1e-6f;
#ifndef MK_PER_PHASE
#define MK_PER_PHASE 0
#endif
constexpr int NPHASES = 11;

constexpr size_t MiB = 1u << 20;
constexpr size_t WS_CTL = 0, CTL_ZERO_BYTES = 1 * MiB;
constexpr size_t WS_WIN = 2 * MiB, WS_WO = 6 * MiB, WS_WQ = 8 * MiB, WS_WG = 12 * MiB, WS_WP = 14 * MiB, WS_KEYS = 14 * MiB + 512 * 1024;
constexpr size_t WS_WF = 15 * MiB;
constexpr size_t WS_RSX = 17 * MiB, WS_RS2 = 17 * MiB + 512 * 1024, WS_RS1 = 18 * MiB, WS_RS3 = 20 * MiB;
constexpr size_t WS_SU = 22 * MiB, WS_SV = 22 * MiB + 65536;
constexpr size_t WS_U = 24 * MiB, WS_V = 56 * MiB;
constexpr size_t WS_XB = 88 * MiB;
constexpr size_t WS_PROJ = 152 * MiB;
constexpr size_t WS_MIX = 280 * MiB;
constexpr size_t WS_CF = WS_MIX;
constexpr size_t WS_HB = 344 * MiB;
constexpr size_t WS_EIDX = 408 * MiB, WS_GATE = 424 * MiB;
constexpr size_t WS_PB = 440 * MiB;
constexpr size_t WS_END = 456 * MiB;
constexpr int CW_BAR = 4096;
static_assert((CW_BAR + XCD_BAR_WORDS) * 4 <= (int)CTL_ZERO_BYTES, "CTL words inside the memset region");

constexpr int RING_BYTES = 131072;
constexpr int LDSCTL_OFF = RING_BYTES, MISC_OFF = LDSCTL_OFF + 320;
constexpr int LDS_BYTES = 147456;

typedef float f32x16 __attribute__((ext_vector_type(16)));
typedef _Float16 h2_t __attribute__((ext_vector_type(2)));
typedef float f32x2 __attribute__((ext_vector_type(2)));
typedef int i32x4 __attribute__((ext_vector_type(4)));
typedef unsigned v2u __attribute__((ext_vector_type(2)));

__device__ __forceinline__ float wave_sum(float v) {
    v += __builtin_bit_cast(float, __builtin_amdgcn_mov_dpp(__builtin_bit_cast(int, v), 0xB1, 0xF, 0xF, true));
    v += __builtin_bit_cast(float, __builtin_amdgcn_mov_dpp(__builtin_bit_cast(int, v), 0x4E, 0xF, 0xF, true));
    v += __builtin_bit_cast(float, __builtin_amdgcn_mov_dpp(__builtin_bit_cast(int, v), 0x124, 0xF, 0xF, true));
    v += __builtin_bit_cast(float, __builtin_amdgcn_mov_dpp(__builtin_bit_cast(int, v), 0x128, 0xF, 0xF, true));
    const float r0 = __builtin_bit_cast(float, __builtin_amdgcn_readlane(__builtin_bit_cast(int, v), 0)), r1 = __builtin_bit_cast(float, __builtin_amdgcn_readlane(__builtin_bit_cast(int, v), 16));
    const float r2 = __builtin_bit_cast(float, __builtin_amdgcn_readlane(__builtin_bit_cast(int, v), 32)), r3 = __builtin_bit_cast(float, __builtin_amdgcn_readlane(__builtin_bit_cast(int, v), 48));
    return (r0 + r1) + (r2 + r3);
}
__device__ __forceinline__ float bf_lo(unsigned w) { return __uint_as_float(w << 16); }
__device__ __forceinline__ float bf_hi(unsigned w) { return __uint_as_float(w & 0xffff0000u); }
__device__ __forceinline__ unsigned pkh(float lo, float hi) { f32x2 v = {lo, hi}; h2_t h = __builtin_convertvector(v, h2_t); return __builtin_bit_cast(unsigned, h); }

struct EpiProj {
    static constexpr bool PERM = true, AFTER_DRAIN = false, TWICE = false;
    pg8::bf16_t* O; const float* rowss;
    __device__ __forceinline__ void operator()(const pg8::f32x4 (&acc)[2][2][4][2], const pg8::Unit& u, int wr, int wc, int fr, int fq) const {
        const int row0 = u.pm * 256 + wr * 64 + fr, cw = wc * 32 + 8 * fq; const int pn = u.pn;
        const bool prod = (pn >= 2) && (pn < 6);
        const int cbase = prod ? 512 + (pn - 2) * 128 : (pn < 2 ? pn * 256 : 1024 + (pn - 6) * 256);
#pragma unroll
        for (int ai = 0; ai < 2; ++ai)
#pragma unroll
            for (int m = 0; m < 4; ++m) {
                const int row = row0 + ai * 128 + m * 16;
                const float sc = __builtin_amdgcn_rsqf(rowss[row] * (1.0f / 1024.0f) + EPS);
                pg8::bf16_t* rowp = O + (size_t)row * 1536 + cbase + cw;
                if (prod) {
                    const float s2 = sc * sc;
                    const pg8::f32x4 v0 = acc[ai][0][m][0] * acc[ai][1][m][0] * s2, v1 = acc[ai][0][m][1] * acc[ai][1][m][1] * s2;
                    pg8::u32x4 w; w.x = pg8::cvt_pk_bf16(v0[0], v0[1]); w.y = pg8::cvt_pk_bf16(v0[2], v0[3]); w.z = pg8::cvt_pk_bf16(v1[0], v1[1]); w.w = pg8::cvt_pk_bf16(v1[2], v1[3]);
                    *(pg8::u32x4*)rowp = w;
                } else {
#pragma unroll
                    for (int bj = 0; bj < 2; ++bj) {
                        const pg8::f32x4 v0 = acc[ai][bj][m][0] * sc, v1 = acc[ai][bj][m][1] * sc;
                        pg8::u32x4 w; w.x = pg8::cvt_pk_bf16(v0[0], v0[1]); w.y = pg8::cvt_pk_bf16(v0[2], v0[3]); w.z = pg8::cvt_pk_bf16(v1[0], v1[1]); w.w = pg8::cvt_pk_bf16(v1[2], v1[3]);
                        *(pg8::u32x4*)(rowp + bj * 128) = w;
                    }
                }
            }
    }
};
struct EpiBf16Row {
    static constexpr bool PERM = true, AFTER_DRAIN = false, TWICE = (PROBE_REP == 12);
    pg8::bf16_t* O; int ldc; const float* rowss;
    __device__ __forceinline__ void operator()(const pg8::f32x4 (&acc)[2][2][4][2], const pg8::Unit& u, int wr, int wc, int fr, int fq) const {
        const int row0 = u.pm * 256 + wr * 64 + fr, col0 = u.pn * 256 + wc * 32 + 8 * fq;
#pragma unroll
        for (int ai = 0; ai < 2; ++ai)
#pragma unroll
            for (int m = 0; m < 4; ++m) {
                const int row = row0 + ai * 128 + m * 16;
                const float sc = rowss ? __builtin_amdgcn_rsqf(rowss[row] * (1.0f / 1024.0f) + EPS) : 1.0f;
                pg8::bf16_t* rowp = O + (size_t)row * ldc + col0;
#pragma unroll
                for (int bj = 0; bj < 2; ++bj) {
                    const pg8::f32x4 v0 = acc[ai][bj][m][0] * sc, v1 = acc[ai][bj][m][1] * sc;
                    pg8::u32x4 w; w.x = pg8::cvt_pk_bf16(v0[0], v0[1]); w.y = pg8::cvt_pk_bf16(v0[2], v0[3]); w.z = pg8::cvt_pk_bf16(v1[0], v1[1]); w.w = pg8::cvt_pk_bf16(v1[2], v1[3]);
                    *(pg8::u32x4*)(rowp + bj * 128) = w;
                }
            }
    }
};
struct EpiH1 {
    static constexpr bool PERM = true, AFTER_DRAIN = false, TWICE = (PROBE_REP == 13);
    const float* X; pg8::bf16_t* HB; float* RS;
    __device__ __forceinline__ void operator()(const pg8::f32x4 (&acc)[2][2][4][2], const pg8::Unit& u, int wr, int wc, int fr, int fq) const {
        const int row0 = u.pm * 256 + wr * 64 + fr, col0 = u.pn * 256 + wc * 32 + 8 * fq;
#pragma unroll
        for (int ai = 0; ai < 2; ++ai)
#pragma unroll
            for (int m = 0; m < 4; ++m) {
                const int row = row0 + ai * 128 + m * 16; float s = 0.f;
#pragma unroll
                for (int bj = 0; bj < 2; ++bj) {
                    const size_t off = (size_t)row * 1024 + col0 + bj * 128;
                    const pg8::f32x4 x0 = *(const pg8::f32x4*)(X + off), x1 = *(const pg8::f32x4*)(X + off + 4);
                    const pg8::f32x4 v0 = acc[ai][bj][m][0] + x0, v1 = acc[ai][bj][m][1] + x1;
                    pg8::u32x4 w; w.x = pg8::cvt_pk_bf16(v0[0], v0[1]); w.y = pg8::cvt_pk_bf16(v0[2], v0[3]); w.z = pg8::cvt_pk_bf16(v1[0], v1[1]); w.w = pg8::cvt_pk_bf16(v1[2], v1[3]);
                    *(pg8::u32x4*)(HB + off) = w;
                    s += (v0[0] * v0[0] + v0[1] * v0[1]) + (v0[2] * v0[2] + v0[3] * v0[3]) + (v1[0] * v1[0] + v1[1] * v1[1]) + (v1[2] * v1[2] + v1[3] * v1[3]);
                }
                s += __shfl_xor(s, 16); s += __shfl_xor(s, 32);
                if (fq == 0) RS[(size_t)row * 16 + u.pn * 4 + wc] = s;
            }
    }
};
struct EpiGate {
    static constexpr bool PERM = true, AFTER_DRAIN = false, TWICE = (PROBE_REP == 14);
    pg8::bf16_t* OUT; const pg8::bf16_t* HB; const pg8::bf16_t* PL; const float* RS2; float* RS3;
    __device__ __forceinline__ void operator()(const pg8::f32x4 (&acc)[2][2][4][2], const pg8::Unit& u, int wr, int wc, int fr, int fq) const {
        const int row0 = u.pm * 256 + wr * 64 + fr, col0 = u.pn * 256 + wc * 32 + 8 * fq;
#pragma unroll
        for (int ai = 0; ai < 2; ++ai)
#pragma unroll
            for (int m = 0; m < 4; ++m) {
                const int row = row0 + ai * 128 + m * 16; float s = 0.f;
                const float rstd = __builtin_amdgcn_rsqf(RS2[row] * (1.0f / 1024.0f) + EPS);
#pragma unroll
                for (int bj = 0; bj < 2; ++bj) {
                    const size_t off = (size_t)row * 1024 + col0 + bj * 128;
                    const pg8::u32x4 w = *(const pg8::u32x4*)(PL + off), hw = *(const pg8::u32x4*)(HB + off);
                    const pg8::f32x4 h0 = {bf_lo(hw.x), bf_hi(hw.x), bf_lo(hw.y), bf_hi(hw.y)}, h1 = {bf_lo(hw.z), bf_hi(hw.z), bf_lo(hw.w), bf_hi(hw.w)};
                    const pg8::f32x4 a0 = acc[ai][bj][m][0] * rstd, a1 = acc[ai][bj][m][1] * rstd;
                    pg8::f32x4 g0, g1;
#pragma unroll
                    for (int e = 0; e < 4; ++e) { g0[e] = 1.0f / (1.0f + __expf(-a0[e])); g1[e] = 1.0f / (1.0f + __expf(-a1[e])); }
                    const pg8::f32x4 p0 = {bf_lo(w.x), bf_hi(w.x), bf_lo(w.y), bf_hi(w.y)}, p1 = {bf_lo(w.z), bf_hi(w.z), bf_lo(w.w), bf_hi(w.w)};
                    const pg8::f32x4 v0 = h0 + g0 * p0, v1 = h1 + g1 * p1;
                    { pg8::u32x4 ow; ow.x = pg8::cvt_pk_bf16(v0[0], v0[1]); ow.y = pg8::cvt_pk_bf16(v0[2], v0[3]); ow.z = pg8::cvt_pk_bf16(v1[0], v1[1]); ow.w = pg8::cvt_pk_bf16(v1[2], v1[3]); *(pg8::u32x4*)(OUT + off) = ow; }
                    s += (v0[0] * v0[0] + v0[1] * v0[1]) + (v0[2] * v0[2] + v0[3] * v0[3]) + (v1[0] * v1[0] + v1[1] * v1[1]) + (v1[2] * v1[2] + v1[3] * v1[3]);
                }
                s += __shfl_xor(s, 16); s += __shfl_xor(s, 32);
                if (fq == 0) RS3[(size_t)row * 16 + u.pn * 4 + wc] = s;
            }
    }
};

__device__ __forceinline__ void p0_transpose_item(const float* W, int ldn, const float* gk, int K, bf16* WT, int row_off, int nblk, LAS float* scr, int item, int lane) {
    const int kb = item / nblk, nb = item % nblk, k0 = 64 * kb, n0 = 32 * nb;
    float wv[32];
#pragma unroll
    for (int i = 0; i < 32; ++i) wv[i] = W[(size_t)(k0 + 2 * i + (lane >> 5)) * ldn + n0 + (lane & 31)];
#pragma unroll
    for (int i = 0; i < 32; ++i) { const int kk = 2 * i + (lane >> 5); float v = wv[i]; if (gk) v *= gk[k0 + kk]; scr[kk * 33 + (lane & 31)] = v; }
    LDS_WAIT(); asm volatile("" ::: "memory");
    const int c = lane & 7;
#pragma unroll
    for (int j = 0; j < 4; ++j) { const int n = (lane >> 3) + 8 * j; const LAS float* s = scr + (8 * c) * 33 + n;
        v4u o; o.x = pk2(s[0 * 33], s[1 * 33]); o.y = pk2(s[2 * 33], s[3 * 33]); o.z = pk2(s[4 * 33], s[5 * 33]); o.w = pk2(s[6 * 33], s[7 * 33]);
        *(GAS v4u*)(WT + (size_t)(row_off + n0 + n) * K + k0 + 8 * c) = o; }
    LDS_WAIT(); asm volatile("" ::: "memory");
}

struct Ptrs {
    const float *x, *p, *g_mix, *w_in, *conv_w, *pool_w, *pool_scale, *w_o, *g_ffn, *w_q, *sub_keys, *eu, *ev, *g_ple, *w_gate, *w_proj, *g_final;
    float* out; unsigned char* ws;
};

__device__ __forceinline__ void p0a_phase(const Ptrs& P, LAS unsigned char* lds, int vcu, int G, int tid, int wave, int lane) {
    const int gw = vcu * 4 + (wave & 3), NGW = G * 4;
    const int gt = gw * 64 + lane, NGT = NGW * 64;
    if (wave < 4) {
    { float* Wf = (float*)(P.ws + WS_WF);
      for (int tk = gw; tk < 2048; tk += NGW) {
          const int k4 = (tk >> 3) * 4, j = tk & 7, g = j >> 1, np = j * 64 + lane, d = np & 127;
          const float* wi = P.w_in + (size_t)k4 * 2048 + 1536 + g * 128; const float* pw = P.pool_w + (size_t)g * 128 * 128 + d;
          float a0 = 0.f, a1 = 0.f, a2 = 0.f, a3 = 0.f;
          for (int c0 = 0; c0 < 128; c0 += 16) {
              float pv[16], w0[16], w1[16], w2[16], w3[16];
#pragma unroll
              for (int c = 0; c < 16; ++c) { pv[c] = pw[(size_t)(c0 + c) * 128]; w0[c] = wi[c0 + c]; w1[c] = wi[2048 + c0 + c]; w2[c] = wi[4096 + c0 + c]; w3[c] = wi[6144 + c0 + c]; }
#pragma unroll
              for (int c = 0; c < 16; ++c) { a0 += w0[c] * pv[c]; a1 += w1[c] * pv[c]; a2 += w2[c] * pv[c]; a3 += w3[c] * pv[c]; }
          }
          const float sc = P.pool_scale[np];
          Wf[(size_t)k4 * 512 + np] = a0 * sc; Wf[(size_t)(k4 + 1) * 512 + np] = a1 * sc; Wf[(size_t)(k4 + 2) * 512 + np] = a2 * sc; Wf[(size_t)(k4 + 3) * 512 + np] = a3 * sc;
      } }
    { LAS float* scr = (LAS float*)(lds + wave * 16384);
      constexpr int I_WO = 16 * 32, I_WQ = 16 * 64, I_WG = 16 * 32, I_WP = 4 * 32, I_WINA = 16 * 48;
      constexpr int NITEMS = I_WO + I_WQ + I_WG + I_WP + I_WINA;
      for (int it = gw; it < NITEMS; it += NGW) {
          int r = it;
          if (r < I_WO) { p0_transpose_item(P.w_o, 1024, nullptr, 1024, (bf16*)(P.ws + WS_WO), 0, 32, scr, r, lane); continue; } r -= I_WO;
          if (r < I_WQ) { p0_transpose_item(P.w_q, 2048, P.g_ffn, 1024, (bf16*)(P.ws + WS_WQ), 0, 64, scr, r, lane); continue; } r -= I_WQ;
          if (r < I_WG) { p0_transpose_item(P.w_gate, 1024, P.g_ple, 1024, (bf16*)(P.ws + WS_WG), 0, 32, scr, r, lane); continue; } r -= I_WG;
          if (r < I_WP) { p0_transpose_item(P.w_proj, 1024, nullptr, 256, (bf16*)(P.ws + WS_WP), 0, 32, scr, r, lane); continue; } r -= I_WP;
          {
            const int nb = r % 48, n0 = 32 * nb; int sc0 = n0;
            if (n0 >= 512) { const int jj = (n0 - 512) >> 8, rr = (n0 - 512) & 255; sc0 = rr < 128 ? 512 + 128 * jj + rr : 1024 + 128 * jj + (rr - 128); }
            p0_transpose_item(P.w_in + (sc0 - n0), 2048, P.g_mix, 1024, (bf16*)(P.ws + WS_WIN), 0, 48, scr, r, lane); }
      } }
    } else {
    { for (int r0 = 4 * gw; r0 < NEXP; r0 += 4 * NGW) {
          f32x4 a[4][4]; float q[4];
#pragma unroll
          for (int rr = 0; rr < 4; ++rr) { const GAS f32x4* src = (const GAS f32x4*)(P.eu + (size_t)(r0 + rr) * 1024);
#pragma unroll
              for (int j = 0; j < 4; ++j) a[rr][j] = src[4 * lane + j]; }
          { const GAS f32x4* gf = (const GAS f32x4*)P.g_ffn + 4 * lane;
#pragma unroll
            for (int j = 0; j < 4; ++j) { const f32x4 g = gf[j];
#pragma unroll
                for (int rr = 0; rr < 4; ++rr) a[rr][j] = a[rr][j] * g; } }
#pragma unroll
          for (int rr = 0; rr < 4; ++rr) { q[rr] = 0.f;
#pragma unroll
              for (int j = 0; j < 4; ++j) q[rr] += (a[rr][j].x * a[rr][j].x + a[rr][j].y * a[rr][j].y) + (a[rr][j].z * a[rr][j].z + a[rr][j].w * a[rr][j].w); }
          q[0] = wave_sum(q[0]); q[1] = wave_sum(q[1]); q[2] = wave_sum(q[2]); q[3] = wave_sum(q[3]);
#pragma unroll
          for (int rr = 0; rr < 4; ++rr) { const int e = r0 + rr;
              const float rms = sqrtf(q[rr] * (1.0f / 1024.0f)); const float sc = rms > 0.f ? 2.0f / rms : 0.f;
              unsigned w0 = 0u, w1 = 0u;
              w0 = __builtin_amdgcn_cvt_scalef32_pk_fp4_f32(w0, a[rr][0].x * sc, a[rr][0].y * sc, 1.0f, 0); w0 = __builtin_amdgcn_cvt_scalef32_pk_fp4_f32(w0, a[rr][0].z * sc, a[rr][0].w * sc, 1.0f, 1);
              w0 = __builtin_amdgcn_cvt_scalef32_pk_fp4_f32(w0, a[rr][1].x * sc, a[rr][1].y * sc, 1.0f, 2); w0 = __builtin_amdgcn_cvt_scalef32_pk_fp4_f32(w0, a[rr][1].z * sc, a[rr][1].w * sc, 1.0f, 3);
              w1 = __builtin_amdgcn_cvt_scalef32_pk_fp4_f32(w1, a[rr][2].x * sc, a[rr][2].y * sc, 1.0f, 0); w1 = __builtin_amdgcn_cvt_scalef32_pk_fp4_f32(w1, a[rr][2].z * sc, a[rr][2].w * sc, 1.0f, 1);
              w1 = __builtin_amdgcn_cvt_scalef32_pk_fp4_f32(w1, a[rr][3].x * sc, a[rr][3].y * sc, 1.0f, 2); w1 = __builtin_amdgcn_cvt_scalef32_pk_fp4_f32(w1, a[rr][3].z * sc, a[rr][3].w * sc, 1.0f, 3);
              ((GAS v2u*)(P.ws + WS_U))[(size_t)e * 64 + lane] = (v2u){w0, w1};
              if (lane == 0) ((float*)(P.ws + WS_SU))[e] = rms * 0.5f; }
      } }
    { const int ci = lane >> 2, cb = lane & 3; const int eoff = 256 * cb + 64 * (ci >> 2) + (ci & 3);
      for (int r0 = 2 * gw; r0 < NEXP; r0 += 2 * NGW) {
          float v[2][16]; float q[2];
#pragma unroll
          for (int rr = 0; rr < 2; ++rr) { const float* src = P.ev + (size_t)(r0 + rr) * 1024 + eoff;
#pragma unroll
              for (int n = 0; n < 16; ++n) v[rr][n] = src[4 * n]; }
#pragma unroll
          for (int rr = 0; rr < 2; ++rr) { q[rr] = 0.f;
#pragma unroll
              for (int n = 0; n < 16; ++n) q[rr] += v[rr][n] * v[rr][n]; }
          q[0] = wave_sum(q[0]); q[1] = wave_sum(q[1]);
#pragma unroll
          for (int rr = 0; rr < 2; ++rr) { const int e = r0 + rr;
              const float rms = sqrtf(q[rr] * (1.0f / 1024.0f)); const float sc = rms > 0.f ? 2.0f / rms : 0.f;
              unsigned w0 = 0u, w1 = 0u;
              w0 = __builtin_amdgcn_cvt_scalef32_pk_fp4_f32(w0, v[rr][0] * sc, v[rr][1] * sc, 1.0f, 0); w0 = __builtin_amdgcn_cvt_scalef32_pk_fp4_f32(w0, v[rr][2] * sc, v[rr][3] * sc, 1.0f, 1);
              w0 = __builtin_amdgcn_cvt_scalef32_pk_fp4_f32(w0, v[rr][4] * sc, v[rr][5] * sc, 1.0f, 2); w0 = __builtin_amdgcn_cvt_scalef32_pk_fp4_f32(w0, v[rr][6] * sc, v[rr][7] * sc, 1.0f, 3);
              w1 = __builtin_amdgcn_cvt_scalef32_pk_fp4_f32(w1, v[rr][8] * sc, v[rr][9] * sc, 1.0f, 0); w1 = __builtin_amdgcn_cvt_scalef32_pk_fp4_f32(w1, v[rr][10] * sc, v[rr][11] * sc, 1.0f, 1);
              w1 = __builtin_amdgcn_cvt_scalef32_pk_fp4_f32(w1, v[rr][12] * sc, v[rr][13] * sc, 1.0f, 2); w1 = __builtin_amdgcn_cvt_scalef32_pk_fp4_f32(w1, v[rr][14] * sc, v[rr][15] * sc, 1.0f, 3);
              ((GAS v2u*)(P.ws + WS_V))[(size_t)e * 64 + (cb >> 1) * 32 + 2 * ci + (cb & 1)] = (v2u){w0, w1};
              if (lane == 0) ((float*)(P.ws + WS_SV))[e] = rms * 0.5f; }
      } }
    { const GAS f32x4* sp = (const GAS f32x4*)P.p; GAS v4u* dp = (GAS v4u*)(P.ws + WS_PB);
      for (int i0 = gt; i0 < M * PLED / 8; i0 += 4 * NGT) {
          f32x4 a[4], b[4];
#pragma unroll
          for (int q = 0; q < 4; ++q) { const int i = i0 + q * NGT; if (i < M * PLED / 8) { a[q] = sp[2 * (size_t)i]; b[q] = sp[2 * (size_t)i + 1]; } }
#pragma unroll
          for (int q = 0; q < 4; ++q) { const int i = i0 + q * NGT; if (i < M * PLED / 8) { v4u o; o.x = pk2(a[q].x, a[q].y); o.y = pk2(a[q].z, a[q].w); o.z = pk2(b[q].x, b[q].y); o.w = pk2(b[q].z, b[q].w); dp[i] = o; } }
      }
      const GAS f32x4* sk = (const GAS f32x4*)P.sub_keys; GAS v4u* dk = (GAS v4u*)(P.ws + WS_KEYS);
      for (int i = gt; i < 16 * 128 * 128 / 8; i += NGT) { const f32x4 a = sk[2 * (size_t)i], b = sk[2 * (size_t)i + 1]; v4u o; o.x = pk2(a.x, a.y); o.y = pk2(a.z, a.w); o.z = pk2(b.x, b.y); o.w = pk2(b.z, b.w); dk[i] = o; } }
    { float* RSX = (float*)(P.ws + WS_RSX); bf16* XB = (bf16*)(P.ws + WS_XB);
      for (int m0 = 4 * gw; m0 < M; m0 += 4 * NGW) {
          f32x4 v[4][4]; float sq[4];
#pragma unroll
          for (int r = 0; r < 4; ++r) { const GAS f32x4* xr = (const GAS f32x4*)(P.x + (size_t)(m0 + r) * D) + lane;
#pragma unroll
              for (int j = 0; j < 4; ++j) v[r][j] = xr[64 * j]; }
#pragma unroll
          for (int r = 0; r < 4; ++r) { sq[r] = 0.f;
#pragma unroll
              for (int j = 0; j < 4; ++j) sq[r] += (v[r][j].x * v[r][j].x + v[r][j].y * v[r][j].y) + (v[r][j].z * v[r][j].z + v[r][j].w * v[r][j].w); }
#pragma unroll
          for (int r = 0; r < 4; ++r) sq[r] = wave_sum(sq[r]);
#pragma unroll
          for (int r = 0; r < 4; ++r) { if (lane == 0) RSX[m0 + r] = sq[r];
              GAS unsigned long long* o8 = (GAS unsigned long long*)(XB + (size_t)(m0 + r) * D) + lane;
#pragma unroll
              for (int j = 0; j < 4; ++j) o8[64 * j] = (unsigned long long)pk2(v[r][j].x, v[r][j].y) | ((unsigned long long)pk2(v[r][j].z, v[r][j].w) << 32); }
      } }
    }
}
__device__ __forceinline__ void p0b_phase(const Ptrs& P, LAS unsigned char* lds, int vcu, int G, int wave, int lane) {
    const int gw = vcu * NWAVES + wave, NGW = G * NWAVES; LAS float* scr = (LAS float*)(lds + wave * 16384);
    for (int it = gw; it < 16 * 16; it += NGW) p0_transpose_item((const float*)(P.ws + WS_WF), 512, P.g_mix, 1024, (bf16*)(P.ws + WS_WIN), 1536, 16, scr, it, lane);
}

template <int HALF>
__device__ __forceinline__ void pool_chunk(const unsigned* col, unsigned* mx, int t0, int s0) {
    constexpr int TC = 32, NV = TC + 2 * HALF;
    float v0[NV], v1[NV];
#pragma unroll
    for (int i = 0; i < NV; ++i) {
        const int s = s0 - HALF + i; const bool ok = (s >= 0) && (s < SEQ);
        const unsigned w = col[(size_t)(ok ? (t0 - HALF + i) : t0) * 768];
        v0[i] = ok ? bf_lo(w) : 0.f; v1[i] = ok ? bf_hi(w) : 0.f;
    }
    float S0 = 0.f, S1 = 0.f;
#pragma unroll
    for (int j = 0; j < 2 * HALF; ++j) { S0 += v0[j]; S1 += v1[j]; }
#pragma unroll
    for (int i = 0; i < TC; ++i) {
        const int s = s0 + i; const int lo = (s - HALF) > 0 ? (s - HALF) : 0, hi = (s + HALF) < SEQ ? (s + HALF) : SEQ;
        const float inv = 1.0f / (float)(hi - lo);
        mx[(size_t)(t0 + i) * 512] = pk2(S0 * inv - v0[i + HALF], S1 * inv - v1[i + HALF]);
        if (i + 1 < TC) { S0 += v0[i + 2 * HALF] - v0[i]; S1 += v1[i + 2 * HALF] - v1[i]; }
    }
}
__device__ __forceinline__ void p2_phase(const Ptrs& P, int vcu, int G, int tid, int wave) {
    const unsigned* PR = (const unsigned*)(P.ws + WS_PROJ);
    unsigned* MX = (unsigned*)(P.ws + WS_MIX);
    constexpr int TC = 32;
    for (int ck = vcu; ck < M / TC; ck += G) {
        const int t0 = ck * TC, s0 = t0 & (SEQ - 1);
        if (tid < 256) {
            const unsigned* col = PR + 512 + tid; unsigned* mx = MX + 256 + tid;
            if (wave == 0) pool_chunk<1>(col, mx, t0, s0); else if (wave == 1) pool_chunk<2>(col, mx, t0, s0); else if (wave == 2) pool_chunk<4>(col, mx, t0, s0); else pool_chunk<8>(col, mx, t0, s0);
        } else {
            const int cp = tid - 256;
            const unsigned* bcol = PR + cp; const unsigned* zcol = PR + 256 + cp;
            const float w00 = P.conv_w[2 * cp], w01 = P.conv_w[2 * cp + 1], w10 = P.conv_w[512 + 2 * cp], w11 = P.conv_w[512 + 2 * cp + 1], w20 = P.conv_w[1024 + 2 * cp], w21 = P.conv_w[1024 + 2 * cp + 1];
            float z0[TC + 2], z1[TC + 2]; unsigned bw[TC];
#pragma unroll
            for (int i = 0; i < TC + 2; ++i) {
                const int s = s0 - 1 + i; const bool ok = (s >= 0) && (s < SEQ);
                const unsigned z = zcol[(size_t)(ok ? (t0 - 1 + i) : t0) * 768];
                z0[i] = ok ? bf_lo(z) : 0.f; z1[i] = ok ? bf_hi(z) : 0.f;
            }
#pragma unroll
            for (int i = 0; i < TC; ++i) bw[i] = bcol[(size_t)(t0 + i) * 768];
#pragma unroll
            for (int i = 0; i < TC; ++i) {
                const float y0 = w00 * z0[i] + w10 * z0[i + 1] + w20 * z0[i + 2], y1 = w01 * z1[i] + w11 * z1[i + 1] + w21 * z1[i + 2];
                MX[(size_t)(t0 + i) * 512 + cp] = pk2(bf_lo(bw[i]) * y0, bf_hi(bw[i]) * y1);
            }
        }
    }
}

__device__ __forceinline__ float fmax_s(float a, float b) { float r; asm("v_max_f32_e32 %0, %1, %2" : "=v"(r) : "v"(a), "v"(b)); return r; }
__device__ __forceinline__ float fmin_s(float a, float b) { float r; asm("v_min_f32_e32 %0, %1, %2" : "=v"(r) : "v"(a), "v"(b)); return r; }
#define CE_DESC(a, b) do { const float _t = fmax_s(a, b); b = fmin_s(a, b); a = _t; } while (0)
#define CE_ASC(a, b)  do { const float _t = fmin_s(a, b); b = fmax_s(a, b); a = _t; } while (0)
__device__ __forceinline__ void sort16_desc(float* a) {
#pragma unroll
    for (int k = 2; k <= 16; k <<= 1)
#pragma unroll
        for (int j = k >> 1; j > 0; j >>= 1)
#pragma unroll
            for (int i = 0; i < 16; ++i) { const int l = i ^ j; if (l > i) { if ((i & k) == 0) CE_DESC(a[i], a[l]); else CE_ASC(a[i], a[l]); } }
}
__device__ __forceinline__ void merge16_desc(float* a) {
#pragma unroll
    for (int j = 8; j > 0; j >>= 1)
#pragma unroll
        for (int i = 0; i < 16; ++i) { const int l = i ^ j; if (l > i) CE_DESC(a[i], a[l]); }
}
__device__ __forceinline__ void top16_merge(float* a, const float* b) {
#pragma unroll
    for (int i = 0; i < 16; ++i) a[i] = fmax_s(a[i], b[15 - i]);
    merge16_desc(a);
}
__device__ __forceinline__ void top16_of_64(float* v) {
    sort16_desc(v); sort16_desc(v + 16); sort16_desc(v + 32); sort16_desc(v + 48);
    top16_merge(v, v + 16); top16_merge(v + 32, v + 48); top16_merge(v, v + 32);
}
__device__ __forceinline__ unsigned key_lookup(unsigned long long lo, unsigned long long hi, unsigned i) {
    const unsigned long long v = (i & 8u) ? hi : lo;
    return (unsigned)(v >> ((i & 7u) * 8u)) & 0x7fu;
}

constexpr int KROW = 272;
__device__ __forceinline__ void score_phase(const Ptrs& P, LAS unsigned char* lds, int bid, int G, int tid, int wave, int lane) {
    const bf16* Q = (const bf16*)(P.ws + WS_PROJ); const bf16* KEYS = (const bf16*)(P.ws + WS_KEYS); const float* RS1 = (const float*)(P.ws + WS_RS1);
    int* EIDX = (int*)(P.ws + WS_EIDX); float* GATE = (float*)(P.ws + WS_GATE);
    const int l31 = lane & 31, hi = lane >> 5;
    int cur_h = -1;
    bf16x8 bqa[2][8];
    if (bid < (M / 256) * 8) { const int tok0 = (bid >> 3) * 256 + wave * 32 + l31;
#pragma unroll
        for (int p = 0; p < 2; ++p) { const bf16* qp = Q + (size_t)tok0 * 2048 + (bid & 7) * 256 + p * 128 + hi * 8;
#pragma unroll
            for (int ks = 0; ks < 8; ++ks) bqa[p][ks] = *(const GAS bf16x8*)(qp + ks * 16); } }
    for (int u = bid; u < (M / 256) * 8; u += G) {
        const int h = u & 7, tile = u >> 3;
        if (h != cur_h) {
            __syncthreads();
#pragma unroll
            for (int i = 0; i < 8; ++i) { const int q = tid + 512 * i, row = q >> 4, ch = q & 15;
                const v4u val = *(const GAS v4u*)(KEYS + ((size_t)(h * 256 + row)) * 128 + ch * 8);
                *(LAS v4u*)(lds + row * KROW + ch * 16) = val; }
            __syncthreads();
            cur_h = h;
        }
        const int tok = tile * 256 + wave * 32 + l31;
        float T0[16], T1[16];
#pragma unroll
        for (int p = 0; p < 2; ++p) {
            f32x16 acc[4];
#pragma unroll
            for (int kb = 0; kb < 4; ++kb)
#pragma unroll
                for (int r = 0; r < 16; ++r) acc[kb][r] = 0.f;
#pragma unroll
            for (int ks = 0; ks < 8; ++ks)
#pragma unroll
                for (int kb = 0; kb < 4; ++kb) {
                    const bf16x8 ak = *(const LAS bf16x8*)(lds + (p * 128 + kb * 32 + l31) * KROW + (ks * 16 + hi * 8) * 2);
                    acc[kb] = __builtin_amdgcn_mfma_f32_32x32x16_bf16(ak, bqa[p][ks], acc[kb], 0, 0, 0);
                }
            if (p == 1) {
                const int un = (u + G < (M / 256) * 8) ? u + G : u; const int tokn = (un >> 3) * 256 + wave * 32 + l31;
                asm volatile("" : "+v"(acc[0]), "+v"(acc[1]), "+v"(acc[2]), "+v"(acc[3]));
#pragma unroll
                for (int pp = 0; pp < 2; ++pp) { const bf16* qp = Q + (size_t)tokn * 2048 + (un & 7) * 256 + pp * 128 + hi * 8;
#pragma unroll
                    for (int ks = 0; ks < 8; ++ks) bqa[pp][ks] = *(const GAS bf16x8*)(qp + ks * 16); }
            }
            float v[64];
#pragma unroll
            for (int kb = 0; kb < 4; ++kb)
#pragma unroll
                for (int r = 0; r < 16; ++r) v[kb * 16 + r] = __uint_as_float((__float_as_uint(acc[kb][r]) & 0xffffff80u) | (unsigned)(kb * 32 + (r & 3) + 8 * (r >> 2)));
            top16_of_64(v);
            const unsigned hb = (unsigned)hi << 2;
#pragma unroll
            for (int i = 0; i < 16; ++i) v[i] = __uint_as_float(__float_as_uint(v[i]) | hb);
            float c[16];
#pragma unroll
            for (int i = 0; i < 16; ++i) c[i] = fmax_s(v[i], __shfl_xor(v[15 - i], 32));
            merge16_desc(c);
#pragma unroll
            for (int i = 0; i < 16; ++i) { if (p == 0) T0[i] = c[i]; else T1[i] = c[i]; }
        }
        float f0[16], f1[16];
        unsigned long long K0lo = 0ull, K0hi = 0ull, K1lo = 0ull, K1hi = 0ull;
#pragma unroll
        for (int b = 0; b < 8; ++b) {
            K0lo |= (unsigned long long)(__float_as_uint(T0[b]) & 0x7fu) << (8 * b); K0hi |= (unsigned long long)(__float_as_uint(T0[8 + b]) & 0x7fu) << (8 * b);
            K1lo |= (unsigned long long)(__float_as_uint(T1[b]) & 0x7fu) << (8 * b); K1hi |= (unsigned long long)(__float_as_uint(T1[8 + b]) & 0x7fu) << (8 * b);
        }
#pragma unroll
        for (int i = 0; i < 16; ++i) { f0[i] = __uint_as_float(__float_as_uint(T0[i]) & 0xffffff80u); f1[i] = __uint_as_float(__float_as_uint(T1[i]) & 0xffffff80u); }
        float cd[32]; int n = 0;
#pragma unroll
        for (int i = 0; i < 16; ++i)
#pragma unroll
            for (int j = 0; j < 16; ++j)
                if ((i + 1) * (j + 1) <= 16) {
                    const float cv = __uint_as_float((__float_as_uint(f0[i] + f1[j]) & 0xffffff00u) | (unsigned)(i * 16 + j));
                    if ((n & 1) == 0) cd[n >> 1] = cv; else cd[n >> 1] = hi ? cv : cd[n >> 1];
                    ++n;
                }
#pragma unroll
        for (int q = 25; q < 32; ++q) cd[q] = __uint_as_float(0xff800000u);
        sort16_desc(cd); sort16_desc(cd + 16); top16_merge(cd, cd + 16);
        { float cm[16];
#pragma unroll
          for (int i = 0; i < 16; ++i) cm[i] = fmax_s(cd[i], __shfl_xor(cd[15 - i], 32));
          merge16_desc(cm);
#pragma unroll
          for (int i = 0; i < 16; ++i) cd[i] = cm[i]; }
        float rs = 0.f;
        { const GAS f32x4* rp = (const GAS f32x4*)(RS1 + (size_t)tok * 16);
#pragma unroll
          for (int i = 0; i < 4; ++i) { const f32x4 a = rp[i]; rs += (a.x + a.y) + (a.z + a.w); } }
        const float rstd = __builtin_amdgcn_rsqf(rs * (1.0f / 1024.0f) + EPS);
        int eidx[16]; float gt_[16]; float z0 = 0.f, sum = 0.f;
#pragma unroll
        for (int k = 0; k < 16; ++k) {
            const unsigned wb = __float_as_uint(cd[k]); const unsigned i = (wb >> 4) & 15u, j = wb & 15u;
            eidx[k] = (int)(key_lookup(K0lo, K0hi, i) * 128u + key_lookup(K1lo, K1hi, j));
            const float z = __uint_as_float(wb & 0xffffff00u) * rstd;
            if (k == 0) z0 = z;
            gt_[k] = __expf(z - z0); sum += gt_[k];
        }
        const float inv = 1.0f / sum;
        if (hi == 0) { GAS i32x4* ep = (GAS i32x4*)(EIDX + (size_t)tok * 128 + h * 16);
#pragma unroll
            for (int q = 0; q < 4; ++q) ep[q] = (i32x4){eidx[4 * q], eidx[4 * q + 1], eidx[4 * q + 2], eidx[4 * q + 3]};
        } else { GAS f32x4* gp = (GAS f32x4*)(GATE + (size_t)tok * 128 + h * 16);
#pragma unroll
            for (int q = 0; q < 4; ++q) gp[q] = (f32x4){gt_[4 * q] * inv, gt_[4 * q + 1] * inv, gt_[4 * q + 2] * inv, gt_[4 * q + 3] * inv};
        }
    }
}

__device__ __forceinline__ float gelu_tanh(float x) {
    const float y = 1.5957691216057308f * (x + 0.044715f * x * x * x);
    return x / (1.0f + __expf(-y));
}
typedef int v8i __attribute__((ext_vector_type(8)));
#define PEER_MFMA(a, b, c) __builtin_amdgcn_mfma_scale_f32_16x16x128_f8f6f4(a, b, c, 4  , 0  , 0, 0x7F7F7F7F, 0, 0x7F7F7F7F)
__device__ __forceinline__ void peer_dots_phase(const Ptrs& P, LAS unsigned char* lds, int vcu, int G, int wave, int lane) {
    const int gw = vcu * NWAVES + wave, NGW = G * NWAVES;
    const bf16* HB = (const bf16*)(P.ws + WS_HB); float* CF = (float*)(P.ws + WS_CF);
    const int* EIDX = (const int*)(P.ws + WS_EIDX); const float* GATE = (const float*)(P.ws + WS_GATE);
    const unsigned char* U4 = P.ws + WS_U;
    const float* SU = (const float*)(P.ws + WS_SU); const float* SV = (const float*)(P.ws + WS_SV);
    LAS unsigned char* xl = lds + 65536 + wave * 1024;
    LAS unsigned char* tb = lds + wave * 8192;
    const int lr = lane >> 5, lp = lane & 31;
    const int li = lane & 15, lq = lane >> 4;
    const int kl = 4 * lq + (li & 3);
    int t = gw; if (t >= M) return;
    int ei0 = __builtin_nontemporal_load(EIDX + (size_t)t * 128 + lane), ei1 = __builtin_nontemporal_load(EIDX + (size_t)t * 128 + 64 + lane);
    float gg0 = __builtin_nontemporal_load(GATE + (size_t)t * 128 + lane), gg1 = __builtin_nontemporal_load(GATE + (size_t)t * 128 + 64 + lane);
    v2u hrow[4];
    { const GAS v2u* hp = (const GAS v2u*)(HB + (size_t)t * 1024) + lane;
#pragma unroll
      for (int j = 0; j < 4; ++j) hrow[j] = __builtin_nontemporal_load(hp + 64 * j); }
    v4u uw[8];
#pragma unroll
    for (int v = 0; v < 8; ++v) { const int e = __shfl(ei0, 2 * v + lr); uw[v] = *(const GAS v4u*)(U4 + (size_t)e * 512 + 16 * lp); }
    for (; t < M; t += NGW) {
        const int tn = (t + NGW < M) ? t + NGW : t;
        f32x2 x[8]; float ss = 0.f;
#pragma unroll
        for (int j = 0; j < 4; ++j) { const unsigned wa = hrow[j].x, wb = hrow[j].y; x[2 * j] = (f32x2){bf_lo(wa), bf_hi(wa)}; x[2 * j + 1] = (f32x2){bf_lo(wb), bf_hi(wb)};
            ss += (x[2 * j].x * x[2 * j].x + x[2 * j].y * x[2 * j].y) + (x[2 * j + 1].x * x[2 * j + 1].x + x[2 * j + 1].y * x[2 * j + 1].y); }
        ss = wave_sum(ss);
        const float rstd = __builtin_amdgcn_rsqf(ss * (1.0f / 1024.0f) + EPS);
        { const float sx = 16.0f * rstd;
#pragma unroll
          for (int j = 0; j < 4; ++j) { int w = __builtin_amdgcn_cvt_pk_fp8_f32(x[2 * j].x * sx, x[2 * j].y * sx, 0, false); w = __builtin_amdgcn_cvt_pk_fp8_f32(x[2 * j + 1].x * sx, x[2 * j + 1].y * sx, w, true);
              const int n = 4 * lane + 256 * j, sN = n >> 7, nn = n & 127, hN = nn >> 6, qN = (nn & 63) >> 4, jN = nn & 15;
              *(LAS unsigned*)(xl + 128 * sN + 32 * qN + 16 * hN + jN) = (unsigned)w; }
          asm volatile("s_waitcnt lgkmcnt(0)" ::: "memory"); }
        v8i xb[8];
#pragma unroll
        for (int sI = 0; sI < 8; ++sI) { const v4u b0 = *(const LAS v4u*)(xl + 128 * sI + 32 * lq), b1 = *(const LAS v4u*)(xl + 128 * sI + 32 * lq + 16);
            xb[sI] = (v8i){(int)b0.x, (int)b0.y, (int)b0.z, (int)b0.w, (int)b1.x, (int)b1.y, (int)b1.z, (int)b1.w}; }
        const int nei0 = __builtin_nontemporal_load(EIDX + (size_t)tn * 128 + lane), nei1 = __builtin_nontemporal_load(EIDX + (size_t)tn * 128 + 64 + lane);
        const float ngg0 = __builtin_nontemporal_load(GATE + (size_t)tn * 128 + lane), ngg1 = __builtin_nontemporal_load(GATE + (size_t)tn * 128 + 64 + lane);
        { const GAS v2u* hn = (const GAS v2u*)(HB + (size_t)tn * 1024) + lane;
#pragma unroll
          for (int j = 0; j < 4; ++j) hrow[j] = __builtin_nontemporal_load(hn + 64 * j); }
        for (int hq = 0; hq < 8 * REPS(7); ++hq) { const int hh = hq & 7;
            const int ereg = hh < 4 ? ei0 : ei1; const float greg = hh < 4 ? gg0 : gg1; const int lb = (hh & 3) * 16;
            const int el = __shfl(ereg, lb + kl);
            const float su = SU[el], sv = SV[el];
#pragma unroll
            for (int v = 0; v < 8; ++v) { const int r = 2 * v + lr; *(LAS v4u*)(tb + 512 * r + 16 * (lp ^ r)) = uw[v]; }
            __builtin_amdgcn_sched_barrier(0);
            { const bool lasth = (hq == 8 * REPS(7) - 1); const int hn = (hh + 1) & 7;
              const int nreg = lasth ? nei0 : (hn < 4 ? ei0 : ei1); const int nlb = (hn & 3) * 16;
#pragma unroll
              for (int v = 0; v < 8; ++v) { const int e = __shfl(nreg, nlb + 2 * v + lr); uw[v] = *(const GAS v4u*)(U4 + (size_t)e * 512 + 16 * lp); } }
            __builtin_amdgcn_sched_barrier(0);
            f32x4 acc = {0.f, 0.f, 0.f, 0.f};
#pragma unroll
            for (int sI = 0; sI < 8; ++sI) { const v4u af = *(const LAS v4u*)(tb + 512 * li + 16 * ((4 * sI + lq) ^ li));
                const v8i av = {(int)af.x, (int)af.y, (int)af.z, (int)af.w, 0, 0, 0, 0}; acc = PEER_MFMA(av, xb[sI], acc); }
            const int rsel = li & 3;
            const float d = rsel == 0 ? acc[0] : (rsel == 1 ? acc[1] : (rsel == 2 ? acc[2] : acc[3]));
            const float gk = __shfl(greg, lb + kl);
            const float cf = gk * gelu_tanh(d * su * (1.0f / 16.0f)) * sv * 1024.0f;
            if (li < 4) __builtin_nontemporal_store(cf, CF + (size_t)t * 128 + hh * 16 + kl);
        }
        ei0 = nei0; ei1 = nei1; gg0 = ngg0; gg1 = ngg1;
    }
}
__device__ __forceinline__ void peer_sum_phase(const Ptrs& P, int vcu, int G, int wave, int lane) {
    const int gw = vcu * NWAVES + wave, NGW = G * NWAVES;
    bf16* HB = (bf16*)(P.ws + WS_HB); float* RS2 = (float*)(P.ws + WS_RS2); const float* CF = (const float*)(P.ws + WS_CF);
    const int* EIDX = (const int*)(P.ws + WS_EIDX); const unsigned char* V4 = P.ws + WS_V;
    const int li = lane & 15, lq = lane >> 4;
    const unsigned bsh = 8u * (unsigned)(li & 3); const int breg = li >> 2;
    int t = gw; if (t >= M) return;
    int ei0 = __builtin_nontemporal_load(EIDX + (size_t)t * 128 + lane), ei1 = __builtin_nontemporal_load(EIDX + (size_t)t * 128 + 64 + lane);
    float cf0 = __builtin_nontemporal_load(CF + (size_t)t * 128 + lane), cf1 = __builtin_nontemporal_load(CF + (size_t)t * 128 + 64 + lane);
    v2u hrow[4];
    { const GAS v2u* hp = (const GAS v2u*)(HB + (size_t)t * 1024) + lane;
#pragma unroll
      for (int j = 0; j < 4; ++j) hrow[j] = __builtin_nontemporal_load(hp + 64 * j); }
    v4u va[2][2], vb[2][2];
#pragma unroll
    for (int g8 = 0; g8 < 2; ++g8) {
        const int eA = __shfl(ei0, 8 * g8 + 2 * lq), eB = __shfl(ei0, 8 * g8 + 2 * lq + 1);
        const GAS v4u* pa = (const GAS v4u*)(V4 + (size_t)eA * 512 + 16 * li); const GAS v4u* pb = (const GAS v4u*)(V4 + (size_t)eB * 512 + 16 * li);
        va[g8][0] = pa[0]; va[g8][1] = pa[16]; vb[g8][0] = pb[0]; vb[g8][1] = pb[16];
    }
    for (; t < M; t += NGW) {
        const int tn = (t + NGW < M) ? t + NGW : t;
        const int nei0 = __builtin_nontemporal_load(EIDX + (size_t)tn * 128 + lane), nei1 = __builtin_nontemporal_load(EIDX + (size_t)tn * 128 + 64 + lane);
        const float ncf0 = __builtin_nontemporal_load(CF + (size_t)tn * 128 + lane), ncf1 = __builtin_nontemporal_load(CF + (size_t)tn * 128 + 64 + lane);
        f32x4 oacc[4];
#pragma unroll
        for (int b = 0; b < 4; ++b) oacc[b] = (f32x4){0.f, 0.f, 0.f, 0.f};
        for (int hq = 0; hq < 8 * REPS(11); ++hq) { const int hh = hq & 7;
            const float creg = hh < 4 ? cf0 : cf1; const int lb = (hh & 3) * 16;
            v8i bv[2];
#pragma unroll
            for (int g8 = 0; g8 < 2; ++g8) {
                float cA = __shfl(creg, lb + 8 * g8 + lq), cB = __shfl(creg, lb + 8 * g8 + 4 + lq);
                cA = fminf(fmaxf(cA, -448.0f), 448.0f); cB = fminf(fmaxf(cB, -448.0f), 448.0f);
                const unsigned pk = (unsigned)__builtin_amdgcn_cvt_pk_fp8_f32(cA, cB, 0, false);
                const unsigned wA = (pk & 0xffu) << bsh, wB = ((pk >> 8) & 0xffu) << bsh;
                bv[g8] = (v8i){breg == 0 ? (int)wA : 0, breg == 1 ? (int)wA : 0, breg == 2 ? (int)wA : 0, breg == 3 ? (int)wA : 0,
                               breg == 0 ? (int)wB : 0, breg == 1 ? (int)wB : 0, breg == 2 ? (int)wB : 0, breg == 3 ? (int)wB : 0};
            }
#pragma unroll
            for (int g8 = 0; g8 < 2; ++g8) {
                { const v8i a0 = {(int)va[g8][0].x, (int)va[g8][0].y, (int)vb[g8][0].x, (int)vb[g8][0].y, 0, 0, 0, 0}; oacc[0] = PEER_MFMA(a0, bv[g8], oacc[0]); }
                { const v8i a1 = {(int)va[g8][0].z, (int)va[g8][0].w, (int)vb[g8][0].z, (int)vb[g8][0].w, 0, 0, 0, 0}; oacc[1] = PEER_MFMA(a1, bv[g8], oacc[1]); }
                { const v8i a2 = {(int)va[g8][1].x, (int)va[g8][1].y, (int)vb[g8][1].x, (int)vb[g8][1].y, 0, 0, 0, 0}; oacc[2] = PEER_MFMA(a2, bv[g8], oacc[2]); }
                { const v8i a3 = {(int)va[g8][1].z, (int)va[g8][1].w, (int)vb[g8][1].z, (int)vb[g8][1].w, 0, 0, 0, 0}; oacc[3] = PEER_MFMA(a3, bv[g8], oacc[3]); }
            }
            __builtin_amdgcn_sched_barrier(0);
            { const bool lasth = (hq == 8 * REPS(11) - 1); const int hn = (hh + 1) & 7;
              const int nreg = lasth ? nei0 : (hn < 4 ? ei0 : ei1); const int nlb = (hn & 3) * 16;
#pragma unroll
              for (int g8 = 0; g8 < 2; ++g8) {
                  const int eA = __shfl(nreg, nlb + 8 * g8 + 2 * lq), eB = __shfl(nreg, nlb + 8 * g8 + 2 * lq + 1);
                  const GAS v4u* pa = (const GAS v4u*)(V4 + (size_t)eA * 512 + 16 * li); const GAS v4u* pb = (const GAS v4u*)(V4 + (size_t)eB * 512 + 16 * li);
                  va[g8][0] = pa[0]; va[g8][1] = pa[16]; vb[g8][0] = pb[0]; vb[g8][1] = pb[16];
              } }
            __builtin_amdgcn_sched_barrier(0);
        }
        const float osc = (REPS(11) == 2 ? 0.5f : 1.0f) * (1.0f / 1024.0f);
        float s2 = 0.f;
        GAS v2u* hb = (GAS v2u*)(HB + (size_t)t * 1024) + lane;
#pragma unroll
        for (int j = 0; j < 4; ++j) { const unsigned wa = hrow[j].x, wb = hrow[j].y;
            const f32x2 o0 = (f32x2){bf_lo(wa) + oacc[j][0] * osc, bf_hi(wa) + oacc[j][1] * osc}, o1 = (f32x2){bf_lo(wb) + oacc[j][2] * osc, bf_hi(wb) + oacc[j][3] * osc};
            __builtin_nontemporal_store((v2u){pk2(o0.x, o0.y), pk2(o1.x, o1.y)}, hb + 64 * j);
            s2 += (o0.x * o0.x + o0.y * o0.y) + (o1.x * o1.x + o1.y * o1.y); }
        s2 = wave_sum(s2);
        if (lane == 0) RS2[t] = s2;
        { const GAS v2u* hn = (const GAS v2u*)(HB + (size_t)tn * 1024) + lane;
#pragma unroll
          for (int j = 0; j < 4; ++j) hrow[j] = __builtin_nontemporal_load(hn + 64 * j); }
        ei0 = nei0; ei1 = nei1; cf0 = ncf0; cf1 = ncf1;
    }
}

__device__ __forceinline__ void final_phase(const Ptrs& P, int vcu, int G, int wave, int lane) {
    const int gw = vcu * NWAVES + wave, NGW = G * NWAVES; const float* RS3 = (const float*)(P.ws + WS_RS3); const bf16* H3 = (const bf16*)(P.ws + WS_PROJ);
    const GAS f32x4* gf = (const GAS f32x4*)P.g_final + lane;
    f32x4 g[4];
#pragma unroll
    for (int j = 0; j < 4; ++j) g[j] = gf[64 * j];
    for (int m0 = 2 * gw; m0 < M; m0 += 2 * NGW) {
        v2u hv[2][4]; float rs[2];
#pragma unroll
        for (int r = 0; r < 2; ++r) { const GAS v2u* hp = (const GAS v2u*)(H3 + (size_t)(m0 + r) * D) + lane;
#pragma unroll
            for (int j = 0; j < 4; ++j) hv[r][j] = hp[64 * j];
            rs[r] = 0.f; const GAS f32x4* rp = (const GAS f32x4*)(RS3 + (size_t)(m0 + r) * 16);
#pragma unroll
            for (int i = 0; i < 4; ++i) { const f32x4 a = rp[i]; rs[r] += (a.x + a.y) + (a.z + a.w); } }
#pragma unroll
        for (int r = 0; r < 2; ++r) { const float rstd = __builtin_amdgcn_rsqf(rs[r] * (1.0f / 1024.0f) + EPS);
            GAS f32x4* xr = (GAS f32x4*)(P.out + (size_t)(m0 + r) * D) + lane;
#pragma unroll
            for (int j = 0; j < 4; ++j) { const unsigned wa = hv[r][j].x, wb = hv[r][j].y; const f32x4 v = {bf_lo(wa), bf_hi(wa), bf_lo(wb), bf_hi(wb)}; xr[64 * j] = v * rstd * g[j]; } }
    }
}

struct Args { const float* in[17]; float* out; unsigned char* ws; int ph_lo, ph_hi; };
#ifndef PG8_SP2
#define PG8_SP2 true
#endif
#ifndef PG8_ALIGN
#define PG8_ALIGN true
#endif
__global__ void __launch_bounds__(NWAVES * 64, 2) mega_fwd(Args args) {
    extern __shared__ __attribute__((aligned(16))) unsigned char lds_raw[];
    LAS unsigned char* lds = (LAS unsigned char*)lds_raw;
    volatile LAS unsigned* MISC = (volatile LAS unsigned*)(lds + MISC_OFF);
    const int tid = threadIdx.x, lane = tid & 63, wave = __builtin_amdgcn_readfirstlane(tid >> 6);
    const int G = gridDim.x, bx = blockIdx.x; const int vcu = (G % 8 == 0) ? (bx % 8) * (G / 8) + bx / 8 : bx;
    Ptrs P;
    P.x = args.in[0]; P.p = args.in[1]; P.g_mix = args.in[2]; P.w_in = args.in[3]; P.conv_w = args.in[4]; P.pool_w = args.in[5]; P.pool_scale = args.in[6]; P.w_o = args.in[7];
    P.g_ffn = args.in[8]; P.w_q = args.in[9]; P.sub_keys = args.in[10]; P.eu = args.in[11]; P.ev = args.in[12]; P.g_ple = args.in[13]; P.w_gate = args.in[14]; P.w_proj = args.in[15]; P.g_final = args.in[16];
    P.out = args.out; P.ws = args.ws;
    gu32* ctl = (gu32*)(P.ws + WS_CTL);
    for (int u = tid; u < (LDS_BYTES - LDSCTL_OFF) / 4; u += NWAVES * 64) ((LAS unsigned*)(lds + LDSCTL_OFF))[u] = 0u;
    __syncthreads();
    XcdBarrier bar; bar.bar = (unsigned*)(ctl + CW_BAR); bar.x = 0; bar.st = nullptr;
    if (!MK_PER_PHASE) bar = xcd_barrier_post((unsigned*)(ctl + CW_BAR), MISC + 8);
    const int lo = args.ph_lo, hi = args.ph_hi;
#define IN(k) (lo <= (k) && (k) < hi)
#define SEAM(k) do { if (IN(k) && IN((k) + 1)) xcd_barrier(bar); } while (0)
    pg8::bf16_t* const WIN = (pg8::bf16_t*)(P.ws + WS_WIN); pg8::bf16_t* const WO = (pg8::bf16_t*)(P.ws + WS_WO); pg8::bf16_t* const WQ = (pg8::bf16_t*)(P.ws + WS_WQ);
    pg8::bf16_t* const WG = (pg8::bf16_t*)(P.ws + WS_WG); pg8::bf16_t* const WP = (pg8::bf16_t*)(P.ws + WS_WP);
    pg8::bf16_t* const XB = (pg8::bf16_t*)(P.ws + WS_XB); pg8::bf16_t* const PL = XB; pg8::bf16_t* const PROJ = (pg8::bf16_t*)(P.ws + WS_PROJ); pg8::bf16_t* const QB = PROJ;
    pg8::bf16_t* const MIX = (pg8::bf16_t*)(P.ws + WS_MIX); pg8::bf16_t* const HB = (pg8::bf16_t*)(P.ws + WS_HB); pg8::bf16_t* const PB = (pg8::bf16_t*)(P.ws + WS_PB);

    if (IN(0)) { for (int rep = 0; rep < REPS(1); ++rep) { p0a_phase(P, lds, vcu, G, tid, wave, lane); SEAM(0); } }
    if (IN(1)) { p0b_phase(P, lds, vcu, G, wave, lane); SEAM(1); }
    if (IN(2)) {
        pg8::Gemm g{XB, WIN, M, NPROJ, D}; pg8::StaticOrder S; S.init(M, NPROJ, G, bx);
        EpiProj E{PROJ, (const float*)(P.ws + WS_RSX)};
        for (int rep = 0; rep < REPS(2); ++rep) { pg8::gemm_phase<EpiProj, pg8::StaticOrder, PG8_ALIGN, PG8_SP2>(lds, g, S, E);
        SEAM(2); }
    }
    if (IN(3)) {
        for (int rep = 0; rep < REPS(3); ++rep) p2_phase(P, vcu, G, tid, wave);
        pg8::Gemm g{PB, WP, M, D, PLED}; pg8::StaticOrder S; S.init(M, D, G, bx);
        EpiBf16Row E{PL, D, nullptr};
        for (int rep = 0; rep < REPS(8); ++rep) pg8::gemm_phase<EpiBf16Row, pg8::StaticOrder, PG8_ALIGN, PG8_SP2>(lds, g, S, E);
        SEAM(3);
    }
    if (IN(4)) {
        pg8::Gemm g{MIX, WO, M, D, D}; pg8::StaticOrder S; S.init(M, D, G, bx);
        EpiH1 E{P.x, HB, (float*)(P.ws + WS_RS1)};
        for (int rep = 0; rep < REPS(4); ++rep) { pg8::gemm_phase<EpiH1, pg8::StaticOrder, PG8_ALIGN, PG8_SP2>(lds, g, S, E);
        SEAM(4); }
    }
    if (IN(5)) {
        pg8::Gemm g{HB, WQ, M, NQ, D}; pg8::StaticOrder S; S.init(M, NQ, G, bx);
        EpiBf16Row E{QB, NQ, nullptr};
        for (int rep = 0; rep < REPS(5); ++rep) { pg8::gemm_phase<EpiBf16Row, pg8::StaticOrder, PG8_ALIGN, PG8_SP2>(lds, g, S, E);
        SEAM(5); }
    }
    if (IN(6)) { for (int rep = 0; rep < REPS(6); ++rep) { score_phase(P, lds, bx, G, tid, wave, lane); SEAM(6); } }
    if (IN(7)) { peer_dots_phase(P, lds, vcu, G, wave, lane); SEAM(7); }
    if (IN(8)) { peer_sum_phase(P, vcu, G, wave, lane); SEAM(8); }
    if (IN(9)) {
        pg8::Gemm g{HB, WG, M, D, D}; pg8::StaticOrder S; S.init(M, D, G, bx);
        EpiGate E{PROJ  , HB, PL, (const float*)(P.ws + WS_RS2), (float*)(P.ws + WS_RS3)};
        pg8::gemm_phase<EpiGate, pg8::StaticOrder, PG8_ALIGN, PG8_SP2>(lds, g, S, E);
        SEAM(9);
    }
    if (IN(10)) { final_phase(P, vcu, G, wave, lane); }
#undef IN
#undef SEAM
}

extern "C" void kernel_launch(void* const* d_in, const int* in_sizes, int n_in, void* d_out, int out_size, void* d_ws, size_t ws_size, hipStream_t stream) {
    static int grid = 0;
    if (grid == 0) {
        if (n_in != 17 || in_sizes[0] != M * D || out_size != M * D || ws_size < WS_END) { fprintf(stderr, "kernel_launch: unexpected shapes (n_in %d, in0 %d, out %d, ws %zu); nothing launched\n", n_in, n_in > 0 ? in_sizes[0] : -1, out_size, ws_size); grid = -1; return; }
        int dev = 0, cus = 0, per_cu = 0;
        if (hipGetDevice(&dev) != hipSuccess || hipDeviceGetAttribute(&cus, hipDeviceAttributeMultiprocessorCount, dev) != hipSuccess) { fprintf(stderr, "kernel_launch: device query failed\n"); grid = -1; return; }
        if (hipFuncSetAttribute((const void*)mega_fwd, hipFuncAttributeMaxDynamicSharedMemorySize, LDS_BYTES) != hipSuccess) { fprintf(stderr, "kernel_launch: hipFuncSetAttribute failed\n"); grid = -1; return; }
        if (hipOccupancyMaxActiveBlocksPerMultiprocessor(&per_cu, (const void*)mega_fwd, NWAVES * 64, LDS_BYTES) != hipSuccess || per_cu < 1) {
            fprintf(stderr, "kernel_launch: the occupancy query reports %d resident workgroups per CU for this kernel (512 threads, %d B LDS): the grid barrier needs one per CU; nothing launched\n", per_cu, LDS_BYTES);
            (void)hipGetLastError(); grid = -1; return; }
        grid = cus;
    }
    if (grid < 0) return;
    if (hipMemsetAsync((char*)d_ws + WS_CTL, 0, CTL_ZERO_BYTES, stream) != hipSuccess) { fprintf(stderr, "kernel_launch: memset failed\n"); return; }
    Args a{};
    for (int i = 0; i < 17; ++i) a.in[i] = (const float*)d_in[i];
    a.out = (float*)d_out; a.ws = (unsigned char*)d_ws;
#if MK_PER_PHASE
    for (int ph = 0; ph < NPHASES; ++ph) { a.ph_lo = ph; a.ph_hi = ph + 1; hipLaunchKernelGGL(mega_fwd, dim3(grid), dim3(NWAVES * 64), LDS_BYTES, stream, a); }
#else
    a.ph_lo = 0; a.ph_hi = NPHASES;
    hipLaunchKernelGGL(mega_fwd, dim3(grid), dim3(NWAVES * 64), LDS_BYTES, stream, a);
#endif
    const hipError_t le = hipPeekAtLastError();
    if (le != hipSuccess) fprintf(stderr, "kernel_launch: launch failed: %s\n", hipGetErrorName(le));
}
```

```cpp
#include <hip/hip_runtime.h>
#include <cstdio>
#include <cstdint>
namespace pg8 {
#define PG8_LAS __attribute__((address_space(3)))
typedef unsigned short bf16_t;
typedef short bf16x8 __attribute__((ext_vector_type(8)));
typedef float f32x4 __attribute__((ext_vector_type(4)));
typedef unsigned u32x4 __attribute__((ext_vector_type(4)));
constexpr int BM = 256, BK = 64, HALF = 128, HTB = HALF * BK * 2  , STAGE_BYTES = 8 * HTB, NXCD = 8, WGM = 8;

__host__ __device__ __forceinline__ int lds_byte(int r, int c) { const int st = (r >> 4) * 2 + (c >> 5), rr = r & 15, cc = c & 31, ob = rr * 64 + cc * 2; return st * 1024 + (ob ^ (((ob >> 9) & 1) << 5)); }
__host__ __device__ __forceinline__ void stage_rc(int b, int& R, int& C) { const int st = b / 1024, sb = b % 1024, swz = sb ^ (((sb >> 9) & 1) << 5); R = (st >> 1) * 16 + swz / 64; C = (st & 1) * 32 + (swz % 64) / 2; }
__host__ __device__ __forceinline__ int perm32(int rho) { const int n = rho >> 4, i = rho & 15; return 8 * (i >> 2) + 4 * n + (i & 3); }

struct Unit { int pm, pn; };
struct Gemm { const bf16_t* A; const bf16_t* Bt; int M, N, K; };

struct StaticOrder {
    int nM, nN, nwg, G, c;
    __host__ __device__ void init(int M, int N, int G_, int c_) { nM = M / BM; nN = N / BM; nwg = nM * nN; G = G_; c = c_; }
    __host__ __device__ bool next(int i, Unit& u) const {
        const long L = (long)i * G + c; if (L >= nwg) return false;
        int wgid = (int)L; { const int q = nwg / NXCD, r = nwg % NXCD, xcd = wgid % NXCD, off = wgid / NXCD; wgid = (xcd < r ? xcd * (q + 1) : r * (q + 1) + (xcd - r) * q) + off; }
        const int nig = WGM * nN, gid = wgid / nig, fm = gid * WGM, gsz = (nM - fm) < WGM ? (nM - fm) : WGM;
        u.pm = fm + ((wgid % nig) % gsz); u.pn = (wgid % nig) / gsz; return true;
    }
    __device__ __forceinline__ void a_ready(const Unit&) const {}
    __device__ __forceinline__ void done(const Unit&) const {}
};

__device__ __forceinline__ unsigned cvt_pk_bf16(float lo, float hi) { unsigned r; asm volatile("v_cvt_pk_bf16_f32 %0, %1, %2" : "=v"(r) : "v"(lo), "v"(hi)); return r; }
template <class Epi, class Sched, bool ALIGN_EPI = false, bool SP2 = false>
__device__ __forceinline__ void gemm_phase(PG8_LAS unsigned char* lds, const Gemm g, const Sched& S, const Epi& E) {
    const int tid = threadIdx.x, wid = __builtin_amdgcn_readfirstlane(tid >> 6), lane = tid & 63, wr = wid >> 2, wc = wid & 3, fr = lane & 15, fq = lane >> 4;
    const int K = g.K, nt = K / BK;
    unsigned voffA[2], voffB[2];
#pragma unroll
    for (int i = 0; i < 2; ++i) { int R, C; stage_rc(tid * 16 + i * 8192, R, C); const int Rb = Epi::PERM ? ((R & ~31) + perm32(R & 31)) : R;
        voffA[i] = (unsigned)(R * K + C) * 2u; voffB[i] = (unsigned)(Rb * K + C) * 2u; }
    const size_t kstep = (size_t)(BK * 2);
    const size_t hstep = (size_t)HALF * K * 2;
    const size_t tstep = 2 * hstep;
    const unsigned ldsw = (unsigned)wid * 1024u;
    const int aoff = lds_byte(wr * 64 + fr, fq * 8), boff = lds_byte(wc * 32 + fr, fq * 8);
#define PG8_SA(b, h) (((b) * 2 + (h)) * HTB)
#define PG8_SB(b, h) ((4 + (b) * 2 + (h)) * HTB)
#define PG8_STAGE(bufoff, gbase, voff) do { _Pragma("unroll") for (int _i = 0; _i < 2; ++_i) \
        __builtin_amdgcn_global_load_lds((const unsigned*)((const char*)(gbase) + (voff)[_i]), (PG8_LAS unsigned*)(lds + (bufoff) + ldsw + _i * 8192), 16, 0, 0); } while (0)
#define PG8_LDA(dst, b, h) do { _Pragma("unroll") for (int m = 0; m < 4; ++m) _Pragma("unroll") for (int k = 0; k < 2; ++k) dst[m][k] = *(const PG8_LAS bf16x8*)(lds + PG8_SA(b, h) + aoff + m * 2048 + k * 1024); } while (0)
#define PG8_LDB(dst, b, h) do { _Pragma("unroll") for (int n = 0; n < 2; ++n) _Pragma("unroll") for (int k = 0; k < 2; ++k) dst[n][k] = *(const PG8_LAS bf16x8*)(lds + PG8_SB(b, h) + boff + n * 2048 + k * 1024); } while (0)
#define PG8_MMA(ai, bj, At, Bt) do { __builtin_amdgcn_s_setprio(1); _Pragma("unroll") for (int m = 0; m < 4; ++m) _Pragma("unroll") for (int n = 0; n < 2; ++n) _Pragma("unroll") for (int k = 0; k < 2; ++k) \
        acc[ai][bj][m][n] = __builtin_amdgcn_mfma_f32_16x16x32_bf16(Bt[n][k], At[m][k], acc[ai][bj][m][n], 0, 0, 0); __builtin_amdgcn_s_setprio(0); } while (0)
#define PG8_WAIT_V(n) asm volatile("s_waitcnt vmcnt(" #n ")" ::: "memory")
#define PG8_WAIT_L(n) asm volatile("s_waitcnt lgkmcnt(" #n ")" ::: "memory")
#define PG8_BAR __builtin_amdgcn_s_barrier()
#define PG8_SCHED __builtin_amdgcn_sched_barrier(0)
    Unit cur, nxt; int ui = 0;
    if (!S.next(0, cur)) return;
    f32x4 acc[2][2][4][2];
#pragma unroll
    for (int a = 0; a < 2; ++a)
#pragma unroll
        for (int b = 0; b < 2; ++b)
#pragma unroll
            for (int m = 0; m < 4; ++m)
#pragma unroll
                for (int n = 0; n < 2; ++n) acc[a][b][m][n] = (f32x4){0.f, 0.f, 0.f, 0.f};
    bf16x8 At[4][2], B0[2][2], B1[2][2];
    const char* cA = (const char*)g.A + (size_t)cur.pm * tstep; const char* cB = (const char*)g.Bt + (size_t)cur.pn * tstep;
    S.a_ready(cur);
    if constexpr (SP2) {
        PG8_STAGE(PG8_SB(0, 0), cB, voffB); PG8_STAGE(PG8_SB(0, 1), cB + hstep, voffB); PG8_STAGE(PG8_SA(0, 0), cA, voffA); PG8_STAGE(PG8_SA(0, 1), cA + hstep, voffA);
        if (wr == 1) PG8_BAR;
        PG8_WAIT_V(2); PG8_BAR;
        PG8_STAGE(PG8_SB(1, 0), cB + kstep, voffB); PG8_STAGE(PG8_SA(1, 0), cA + kstep, voffA); PG8_STAGE(PG8_SB(1, 1), cB + hstep + kstep, voffB);
        PG8_WAIT_V(6); PG8_BAR;
    } else {
        PG8_STAGE(PG8_SB(0, 0), cB, voffB); PG8_STAGE(PG8_SA(0, 0), cA, voffA); PG8_STAGE(PG8_SB(0, 1), cB + hstep, voffB); PG8_STAGE(PG8_SA(0, 1), cA + hstep, voffA);
        if (wr == 1) PG8_BAR;
        PG8_WAIT_V(4); PG8_BAR;
        PG8_STAGE(PG8_SB(1, 0), cB + kstep, voffB); PG8_STAGE(PG8_SA(1, 0), cA + kstep, voffA); PG8_STAGE(PG8_SB(1, 1), cB + hstep + kstep, voffB);
        PG8_WAIT_V(6); PG8_BAR;
    }
    for (;;) {
        const bool has_next = S.next(ui + 1, nxt);
        const char* nA = has_next ? (const char*)g.A + (size_t)nxt.pm * tstep : cA; const char* nB = has_next ? (const char*)g.Bt + (size_t)nxt.pn * tstep : cB;
        for (int t = 0; t < nt; t += 2) {
            const bool last = (t == nt - 2);
            const char* a1 = cA + (size_t)(t + 1) * kstep;
            const char* a2 = last ? nA : cA + (size_t)(t + 2) * kstep; const char* b2 = last ? nB : cB + (size_t)(t + 2) * kstep;
            const char* a3 = a2 + kstep; const char* b3 = b2 + kstep;
            if (last && has_next) S.a_ready(nxt);
            if constexpr (SP2) {
            PG8_LDB(B0, 0, 0); PG8_LDB(B1, 0, 1); PG8_SCHED; PG8_LDA(At, 0, 0); PG8_STAGE(PG8_SA(1, 1), a1 + hstep, voffA);
            PG8_WAIT_V(8); PG8_WAIT_L(0); PG8_BAR; PG8_MMA(0, 0, At, B0); PG8_MMA(0, 1, At, B1); PG8_BAR; PG8_SCHED;
            PG8_LDA(At, 0, 1); PG8_STAGE(PG8_SB(0, 0), b2, voffB); PG8_STAGE(PG8_SB(0, 1), b2 + hstep, voffB); PG8_STAGE(PG8_SA(0, 0), a2, voffA);
            PG8_WAIT_V(8); PG8_WAIT_L(0); PG8_BAR; PG8_MMA(1, 0, At, B0); PG8_MMA(1, 1, At, B1); PG8_BAR; PG8_SCHED;
            PG8_LDB(B0, 1, 0); PG8_LDB(B1, 1, 1); PG8_SCHED; PG8_LDA(At, 1, 0); PG8_STAGE(PG8_SA(0, 1), a2 + hstep, voffA);
            PG8_WAIT_V(8); PG8_WAIT_L(0); PG8_BAR; PG8_MMA(0, 0, At, B0); PG8_MMA(0, 1, At, B1); PG8_BAR; PG8_SCHED;
            PG8_LDA(At, 1, 1); PG8_STAGE(PG8_SB(1, 0), b3, voffB); PG8_STAGE(PG8_SB(1, 1), b3 + hstep, voffB); PG8_STAGE(PG8_SA(1, 0), a3, voffA);
            PG8_WAIT_V(8); PG8_WAIT_L(0); PG8_BAR; PG8_MMA(1, 0, At, B0); PG8_MMA(1, 1, At, B1); PG8_BAR; PG8_SCHED;
            } else {
            PG8_LDB(B0, 0, 0); PG8_SCHED; PG8_LDA(At, 0, 0); PG8_STAGE(PG8_SA(1, 1), a1 + hstep, voffA);
            PG8_WAIT_L(8); PG8_BAR; PG8_WAIT_L(0); PG8_MMA(0, 0, At, B0); PG8_BAR; PG8_SCHED;
            PG8_LDB(B1, 0, 1); PG8_STAGE(PG8_SB(0, 0), b2, voffB);
            PG8_BAR; PG8_WAIT_L(0); PG8_MMA(0, 1, At, B1); PG8_BAR;
            PG8_LDA(At, 0, 1); PG8_STAGE(PG8_SA(0, 0), a2, voffA);
            PG8_BAR; PG8_WAIT_L(0); PG8_MMA(1, 0, At, B0); PG8_BAR; PG8_SCHED;
            PG8_STAGE(PG8_SB(0, 1), b2 + hstep, voffB);
            PG8_WAIT_V(6); PG8_BAR; PG8_MMA(1, 1, At, B1); PG8_BAR;
            PG8_LDB(B0, 1, 0); PG8_SCHED; PG8_LDA(At, 1, 0); PG8_STAGE(PG8_SA(0, 1), a2 + hstep, voffA);
            PG8_WAIT_L(8); PG8_BAR; PG8_WAIT_L(0); PG8_MMA(0, 0, At, B0); PG8_BAR; PG8_SCHED;
            PG8_LDB(B1, 1, 1); PG8_STAGE(PG8_SB(1, 0), b3, voffB);
            PG8_BAR; PG8_WAIT_L(0); PG8_MMA(0, 1, At, B1); PG8_BAR;
            PG8_LDA(At, 1, 1); PG8_STAGE(PG8_SA(1, 0), a3, voffA);
            PG8_BAR; PG8_WAIT_L(0); PG8_MMA(1, 0, At, B0); PG8_BAR; PG8_SCHED;
            PG8_STAGE(PG8_SB(1, 1), b3 + hstep, voffB);
            PG8_WAIT_V(6); PG8_BAR; PG8_MMA(1, 1, At, B1); PG8_BAR;
            }
        }
        if constexpr (ALIGN_EPI) { if (wr == 0) PG8_BAR; }
        if constexpr (!Epi::AFTER_DRAIN) { E(acc, cur, wr, wc, fr, fq);
            if constexpr (Epi::TWICE) { asm volatile("" ::: "memory"); E(acc, cur, wr, wc, fr, fq); }
            S.done(cur); }
        if (!has_next) break;
#pragma unroll
        for (int a = 0; a < 2; ++a)
#pragma unroll
            for (int b = 0; b < 2; ++b)
#pragma unroll
                for (int m = 0; m < 4; ++m)
#pragma unroll
                    for (int n = 0; n < 2; ++n) acc[a][b][m][n] = (f32x4){0.f, 0.f, 0.f, 0.f};
        cur = nxt; cA = nA; cB = nB; ++ui;
        if constexpr (ALIGN_EPI) { if (wr == 1) PG8_BAR; }
    }
    PG8_WAIT_V(0);
    if constexpr (!ALIGN_EPI) { if (wr == 0) PG8_BAR; }
    PG8_BAR;
    if constexpr (Epi::AFTER_DRAIN) { E.fused(acc, cur, wr, wc, fr, fq, lds, wid, lane); S.done(cur); }
#undef PG8_SA
#undef PG8_SB
#undef PG8_STAGE
#undef PG8_LDA
#undef PG8_LDB
#undef PG8_MMA
#undef PG8_WAIT_V
#undef PG8_WAIT_L
#undef PG8_BAR
#undef PG8_SCHED
}
}

#define GAS __attribute__((address_space(1)))
#define LAS __attribute__((address_space(3)))
typedef unsigned short bf16;
typedef unsigned v4u __attribute__((ext_vector_type(4)));
typedef float f32x4 __attribute__((ext_vector_type(4)));
typedef short bf16x8 __attribute__((ext_vector_type(8)));
typedef GAS unsigned gu32;
typedef GAS unsigned long long gu64;
#define RLX_AGENT __ATOMIC_RELAXED, __HIP_MEMORY_SCOPE_AGENT
#define LDS_WAIT() asm volatile("s_waitcnt lgkmcnt(0)" ::: "memory")
#define VM_WAIT() asm volatile("s_waitcnt vmcnt(0)" ::: "memory")
__device__ __forceinline__ unsigned long long rt() { return __builtin_amdgcn_s_memrealtime(); }
__device__ __forceinline__ unsigned f2bf(float f) { unsigned u = __builtin_bit_cast(unsigned, f); return (u + 0x7fffu + ((u >> 16) & 1u)) >> 16; }
__device__ __forceinline__ unsigned pk2(float lo, float hi) { return f2bf(lo) | (f2bf(hi) << 16); }

#define XB_TMO      128
#define XB_XCNT(j)  (256  + 64 * (j))
#define XB_XSUB(j)  (1280 + 64 * (j))
#define XB_XGEN(j)  (2304 + 64 * (j))
#define XB_TOP      3328
#define XB_TOPGEN   3392
#define XCD_BAR_WORDS 3456
#define XB_SPIN_CAP (1u << 18)

__device__ __forceinline__ unsigned xb_ld(unsigned* p)              { return __hip_atomic_load(p, __ATOMIC_RELAXED, __HIP_MEMORY_SCOPE_AGENT); }
__device__ __forceinline__ unsigned xb_add(unsigned* p, unsigned v) { return __hip_atomic_fetch_add(p, v, __ATOMIC_RELAXED, __HIP_MEMORY_SCOPE_AGENT); }
__device__ __forceinline__ unsigned xb_xcc_id() { return (unsigned)__builtin_amdgcn_s_getreg((3 << 11) | 20) & 0xFu; }
#define XB_SPIN(cond, bar) do { unsigned _sp = 0; while (cond) { __builtin_amdgcn_s_sleep(1); \
    if ((++_sp & 255u) == 0u) { if (xb_ld(&(bar)[XB_TMO])) break; if (_sp > XB_SPIN_CAP) { atomicAdd(&(bar)[XB_TMO], 1u); break; } } } } while (0)

struct XcdBarrier {
    unsigned* bar; unsigned x;
    volatile LAS unsigned* st;
};

__device__ __forceinline__ XcdBarrier xcd_barrier_post(unsigned* bar, volatile LAS unsigned* st) {
    XcdBarrier b; b.bar = bar; b.x = xb_xcc_id(); b.st = st;
    if (threadIdx.x == 0) (void)xb_add(&bar[XB_XCNT(b.x)], 1u);
    return b;
}
__device__ __forceinline__ void xcd_barrier_complete(unsigned* bar, unsigned x, unsigned& nloc, unsigned& nx) {
    const unsigned G = gridDim.x * gridDim.y * gridDim.z;
    unsigned sum, cnt, mine, sp = 0u;
    for (;;) {
        sum = 0u; cnt = 0u; mine = 0u;
#pragma unroll
        for (unsigned j = 0; j < 16; ++j) { const unsigned c = xb_ld(&bar[XB_XCNT(j)]); sum += c; cnt += (c > 0u) ? 1u : 0u; mine = (j == x) ? c : mine; }
        if (sum == G) break;
        __builtin_amdgcn_s_sleep(1);
        if ((++sp & 255u) == 0u) { if (xb_ld(&bar[XB_TMO])) break; if (sp > XB_SPIN_CAP) { atomicAdd(&bar[XB_TMO], 1u); break; } }
    }
    nloc = mine > 0u ? mine : 1u; nx = cnt > 0u ? cnt : 1u;
}

__device__ __forceinline__ void xcd_barrier(const XcdBarrier& b) {
    asm volatile("s_waitcnt vmcnt(0)" ::: "memory");
    __syncthreads();
    if (threadIdx.x == 0) {
        unsigned* bar = b.bar;
        __builtin_amdgcn_s_waitcnt(0);
        unsigned nloc = b.st[0], nx = b.st[1];
        if (nloc == 0u) { xcd_barrier_complete(bar, b.x, nloc, nx); b.st[0] = nloc; b.st[1] = nx; }
        const unsigned old = xb_add(&bar[XB_XSUB(b.x)], 1u);
        const unsigned gen = old / nloc;
        if (old + 1u == (gen + 1u) * nloc) {
            __builtin_amdgcn_fence(__ATOMIC_RELEASE, "agent");
            asm volatile("s_waitcnt vmcnt(0)" ::: "memory");
            const unsigned og = xb_add(&bar[XB_TOP], 1u);
            const unsigned tg = og / nx;
            if (og + 1u == (tg + 1u) * nx) xb_add(&bar[XB_TOPGEN], 1u);
            else XB_SPIN(xb_ld(&bar[XB_TOPGEN]) == tg, bar);
            __builtin_amdgcn_fence(__ATOMIC_ACQUIRE, "agent");
            xb_add(&bar[XB_XGEN(b.x)], 1u);
            asm volatile("s_waitcnt vmcnt(0)" ::: "memory");
        } else {
            XB_SPIN(xb_ld(&bar[XB_XGEN(b.x)]) == gen, bar);
            __builtin_amdgcn_fence(__ATOMIC_ACQUIRE, "agent");
            asm volatile("s_waitcnt vmcnt(0)" ::: "memory");
        }
    }
    __syncthreads();
}

#ifndef PROBE_REP
#define PROBE_REP 0
#endif
#define REPS(k) ((PROBE_REP == (k)) ? 2 : 1)
constexpr int NWAVES = 8;
constexpr int M = 32768, D = 1024, SEQ = 4096, NPROJ = 2048, NQ = 2048, PLED = 256, NEXP = 16384;
constexpr float EPS = 1e-6f;
#ifndef MK_PER_PHASE
#define MK_PER_PHASE 0
#endif
constexpr int D2NS = 4;
constexpr int D2HV = 4 / D2NS, D2PIECE = 128 * D2HV;
constexpr int NPHASES = 11;

constexpr size_t MiB = 1u << 20;
constexpr size_t WS_CTL = 0, CTL_ZERO_BYTES = 1 * MiB;
constexpr size_t WS_WIN = 2 * MiB, WS_WO = 6 * MiB, WS_WQ = 8 * MiB, WS_WG = 12 * MiB, WS_WP = 14 * MiB, WS_KEYS = 14 * MiB + 512 * 1024;
constexpr size_t WS_WF = 15 * MiB;
constexpr size_t WS_RSX = 17 * MiB, WS_RS1 = 18 * MiB, WS_RS3 = 20 * MiB, WS_RS2 = 23 * MiB;
constexpr size_t WS_SU = 22 * MiB, WS_SV = 22 * MiB + 65536;
constexpr size_t WS_U = 24 * MiB, WS_V = 56 * MiB;
constexpr size_t WS_XB = 88 * MiB;
constexpr size_t WS_PROJ = 152 * MiB;
constexpr size_t WS_MIX = 280 * MiB;
constexpr size_t WS_CF = WS_MIX;
constexpr size_t WS_HB = 344 * MiB;
constexpr size_t WS_EIDX = 408 * MiB, WS_GATE = 424 * MiB;
constexpr size_t WS_PB = 440 * MiB;
constexpr size_t WS_EOFF = 456 * MiB;
constexpr size_t WS_END = 472 * MiB;
constexpr int CW_BAR = 4096;
static_assert((CW_BAR + XCD_BAR_WORDS) * 4 <= (int)CTL_ZERO_BYTES, "CTL words inside the memset region");

constexpr int RING_BYTES = 131072;
constexpr int LDSCTL_OFF = RING_BYTES, MISC_OFF = LDSCTL_OFF + 320;
constexpr int LDS_BYTES = 147456;

typedef float f32x16 __attribute__((ext_vector_type(16)));
typedef _Float16 h2_t __attribute__((ext_vector_type(2)));
typedef float f32x2 __attribute__((ext_vector_type(2)));
typedef int i32x4 __attribute__((ext_vector_type(4)));
typedef unsigned v2u __attribute__((ext_vector_type(2)));

__device__ __forceinline__ float wave_sum(float v) {
    v += __builtin_bit_cast(float, __builtin_amdgcn_mov_dpp(__builtin_bit_cast(int, v), 0xB1, 0xF, 0xF, true));
    v += __builtin_bit_cast(float, __builtin_amdgcn_mov_dpp(__builtin_bit_cast(int, v), 0x4E, 0xF, 0xF, true));
    v += __builtin_bit_cast(float, __builtin_amdgcn_mov_dpp(__builtin_bit_cast(int, v), 0x124, 0xF, 0xF, true));
    v += __builtin_bit_cast(float, __builtin_amdgcn_mov_dpp(__builtin_bit_cast(int, v), 0x128, 0xF, 0xF, true));
    const float r0 = __builtin_bit_cast(float, __builtin_amdgcn_readlane(__builtin_bit_cast(int, v), 0)), r1 = __builtin_bit_cast(float, __builtin_amdgcn_readlane(__builtin_bit_cast(int, v), 16));
    const float r2 = __builtin_bit_cast(float, __builtin_amdgcn_readlane(__builtin_bit_cast(int, v), 32)), r3 = __builtin_bit_cast(float, __builtin_amdgcn_readlane(__builtin_bit_cast(int, v), 48));
    return (r0 + r1) + (r2 + r3);
}
__device__ __forceinline__ float bf_lo(unsigned w) { return __uint_as_float(w << 16); }
__device__ __forceinline__ float bf_hi(unsigned w) { return __uint_as_float(w & 0xffff0000u); }
__device__ __forceinline__ unsigned pkh(float lo, float hi) { f32x2 v = {lo, hi}; h2_t h = __builtin_convertvector(v, h2_t); return __builtin_bit_cast(unsigned, h); }

struct EpiProj {
    static constexpr bool PERM = true, AFTER_DRAIN = false, TWICE = false;
    pg8::bf16_t* O; const float* rowss;
    __device__ __forceinline__ void operator()(const pg8::f32x4 (&acc)[2][2][4][2], const pg8::Unit& u, int wr, int wc, int fr, int fq) const {
        const int row0 = u.pm * 256 + wr * 64 + fr, cw = wc * 32 + 8 * fq; const int pn = u.pn;
        const bool prod = (pn >= 2) && (pn < 6);
        const int cbase = prod ? 512 + (pn - 2) * 128 : (pn < 2 ? pn * 256 : 1024 + (pn - 6) * 256);
#pragma unroll
        for (int ai = 0; ai < 2; ++ai)
#pragma unroll
            for (int m = 0; m < 4; ++m) {
                const int row = row0 + ai * 128 + m * 16;
                const float sc = __builtin_amdgcn_rsqf(rowss[row] * (1.0f / 1024.0f) + EPS);
                pg8::bf16_t* rowp = O + (size_t)row * 1536 + cbase + cw;
                if (prod) {
                    const float s2 = sc * sc;
                    const pg8::f32x4 v0 = acc[ai][0][m][0] * acc[ai][1][m][0] * s2, v1 = acc[ai][0][m][1] * acc[ai][1][m][1] * s2;
                    pg8::u32x4 w; w.x = pg8::cvt_pk_bf16(v0[0], v0[1]); w.y = pg8::cvt_pk_bf16(v0[2], v0[3]); w.z = pg8::cvt_pk_bf16(v1[0], v1[1]); w.w = pg8::cvt_pk_bf16(v1[2], v1[3]);
                    *(pg8::u32x4*)rowp = w;
                } else {
#pragma unroll
                    for (int bj = 0; bj < 2; ++bj) {
                        const pg8::f32x4 v0 = acc[ai][bj][m][0] * sc, v1 = acc[ai][bj][m][1] * sc;
                        pg8::u32x4 w; w.x = pg8::cvt_pk_bf16(v0[0], v0[1]); w.y = pg8::cvt_pk_bf16(v0[2], v0[3]); w.z = pg8::cvt_pk_bf16(v1[0], v1[1]); w.w = pg8::cvt_pk_bf16(v1[2], v1[3]);
                        *(pg8::u32x4*)(rowp + bj * 128) = w;
                    }
                }
            }
    }
};
struct EpiBf16Row {
    static constexpr bool PERM = true, AFTER_DRAIN = false, TWICE = (PROBE_REP == 12);
    pg8::bf16_t* O; int ldc; const float* rowss;
    __device__ __forceinline__ void operator()(const pg8::f32x4 (&acc)[2][2][4][2], const pg8::Unit& u, int wr, int wc, int fr, int fq) const {
        const int row0 = u.pm * 256 + wr * 64 + fr, col0 = u.pn * 256 + wc * 32 + 8 * fq;
#pragma unroll
        for (int ai = 0; ai < 2; ++ai)
#pragma unroll
            for (int m = 0; m < 4; ++m) {
                const int row = row0 + ai * 128 + m * 16;
                const float sc = rowss ? __builtin_amdgcn_rsqf(rowss[row] * (1.0f / 1024.0f) + EPS) : 1.0f;
                pg8::bf16_t* rowp = O + (size_t)row * ldc + col0;
#pragma unroll
                for (int bj = 0; bj < 2; ++bj) {
                    const pg8::f32x4 v0 = acc[ai][bj][m][0] * sc, v1 = acc[ai][bj][m][1] * sc;
                    pg8::u32x4 w; w.x = pg8::cvt_pk_bf16(v0[0], v0[1]); w.y = pg8::cvt_pk_bf16(v0[2], v0[3]); w.z = pg8::cvt_pk_bf16(v1[0], v1[1]); w.w = pg8::cvt_pk_bf16(v1[2], v1[3]);
                    *(pg8::u32x4*)(rowp + bj * 128) = w;
                }
            }
    }
};
struct EpiH1 {
    static constexpr bool PERM = true, AFTER_DRAIN = false, TWICE = (PROBE_REP == 13);
    const float* X; pg8::bf16_t* HB; float* RS;
    __device__ __forceinline__ void operator()(const pg8::f32x4 (&acc)[2][2][4][2], const pg8::Unit& u, int wr, int wc, int fr, int fq) const {
        const int row0 = u.pm * 256 + wr * 64 + fr, col0 = u.pn * 256 + wc * 32 + 8 * fq;
#pragma unroll
        for (int ai = 0; ai < 2; ++ai)
#pragma unroll
            for (int m = 0; m < 4; ++m) {
                const int row = row0 + ai * 128 + m * 16; float s = 0.f;
#pragma unroll
                for (int bj = 0; bj < 2; ++bj) {
                    const size_t off = (size_t)row * 1024 + col0 + bj * 128;
                    const pg8::f32x4 x0 = *(const pg8::f32x4*)(X + off), x1 = *(const pg8::f32x4*)(X + off + 4);
                    const pg8::f32x4 v0 = acc[ai][bj][m][0] + x0, v1 = acc[ai][bj][m][1] + x1;
                    pg8::u32x4 w; w.x = pg8::cvt_pk_bf16(v0[0], v0[1]); w.y = pg8::cvt_pk_bf16(v0[2], v0[3]); w.z = pg8::cvt_pk_bf16(v1[0], v1[1]); w.w = pg8::cvt_pk_bf16(v1[2], v1[3]);
                    *(pg8::u32x4*)(HB + off) = w;
                    s += (v0[0] * v0[0] + v0[1] * v0[1]) + (v0[2] * v0[2] + v0[3] * v0[3]) + (v1[0] * v1[0] + v1[1] * v1[1]) + (v1[2] * v1[2] + v1[3] * v1[3]);
                }
                s += __shfl_xor(s, 16); s += __shfl_xor(s, 32);
                if (fq == 0) RS[(size_t)row * 16 + u.pn * 4 + wc] = s;
            }
    }
};
struct EpiGate {
    static constexpr bool PERM = true, AFTER_DRAIN = false, TWICE = (PROBE_REP == 14);
    pg8::bf16_t* OUT; const pg8::bf16_t* HB; const pg8::bf16_t* PL; const float* RS2; float* RS3;
    __device__ __forceinline__ void operator()(const pg8::f32x4 (&acc)[2][2][4][2], const pg8::Unit& u, int wr, int wc, int fr, int fq) const {
        const int row0 = u.pm * 256 + wr * 64 + fr, col0 = u.pn * 256 + wc * 32 + 8 * fq;
#pragma unroll
        for (int ai = 0; ai < 2; ++ai)
#pragma unroll
            for (int m = 0; m < 4; ++m) {
                const int row = row0 + ai * 128 + m * 16; float s = 0.f;
                float rs2 = 0.f;
#pragma unroll
                for (int k = 0; k < D2NS; ++k) rs2 += RS2[(size_t)row * D2NS + k];
                const float rstd = __builtin_amdgcn_rsqf(rs2 * (1.0f / 1024.0f) + EPS);
#pragma unroll
                for (int bj = 0; bj < 2; ++bj) {
                    const size_t off = (size_t)row * 1024 + col0 + bj * 128;
                    const pg8::u32x4 w = *(const pg8::u32x4*)(PL + off), hw = *(const pg8::u32x4*)(HB + off);
                    const pg8::f32x4 h0 = {bf_lo(hw.x), bf_hi(hw.x), bf_lo(hw.y), bf_hi(hw.y)}, h1 = {bf_lo(hw.z), bf_hi(hw.z), bf_lo(hw.w), bf_hi(hw.w)};
                    const pg8::f32x4 a0 = acc[ai][bj][m][0] * rstd, a1 = acc[ai][bj][m][1] * rstd;
                    pg8::f32x4 g0, g1;
#pragma unroll
                    for (int e = 0; e < 4; ++e) { g0[e] = 1.0f / (1.0f + __expf(-a0[e])); g1[e] = 1.0f / (1.0f + __expf(-a1[e])); }
                    const pg8::f32x4 p0 = {bf_lo(w.x), bf_hi(w.x), bf_lo(w.y), bf_hi(w.y)}, p1 = {bf_lo(w.z), bf_hi(w.z), bf_lo(w.w), bf_hi(w.w)};
                    const pg8::f32x4 v0 = h0 + g0 * p0, v1 = h1 + g1 * p1;
                    { pg8::u32x4 ow; ow.x = pg8::cvt_pk_bf16(v0[0], v0[1]); ow.y = pg8::cvt_pk_bf16(v0[2], v0[3]); ow.z = pg8::cvt_pk_bf16(v1[0], v1[1]); ow.w = pg8::cvt_pk_bf16(v1[2], v1[3]); *(pg8::u32x4*)(OUT + off) = ow; }
                    s += (v0[0] * v0[0] + v0[1] * v0[1]) + (v0[2] * v0[2] + v0[3] * v0[3]) + (v1[0] * v1[0] + v1[1] * v1[1]) + (v1[2] * v1[2] + v1[3] * v1[3]);
                }
                s += __shfl_xor(s, 16); s += __shfl_xor(s, 32);
                if (fq == 0) RS3[(size_t)row * 16 + u.pn * 4 + wc] = s;
            }
    }
};

__device__ __forceinline__ void p0_transpose_item(const float* W, int ldn, const float* gk, int K, bf16* WT, int row_off, int nblk, LAS float* scr, int item, int lane) {
    const int kb = item / nblk, nb = item % nblk, k0 = 64 * kb, n0 = 32 * nb;
    float wv[32];
#pragma unroll
    for (int i = 0; i < 32; ++i) wv[i] = W[(size_t)(k0 + 2 * i + (lane >> 5)) * ldn + n0 + (lane & 31)];
#pragma unroll
    for (int i = 0; i < 32; ++i) { const int kk = 2 * i + (lane >> 5); float v = wv[i]; if (gk) v *= gk[k0 + kk]; scr[kk * 33 + (lane & 31)] = v; }
    LDS_WAIT(); asm volatile("" ::: "memory");
    const int c = lane & 7;
#pragma unroll
    for (int j = 0; j < 4; ++j) { const int n = (lane >> 3) + 8 * j; const LAS float* s = scr + (8 * c) * 33 + n;
        v4u o; o.x = pk2(s[0 * 33], s[1 * 33]); o.y = pk2(s[2 * 33], s[3 * 33]); o.z = pk2(s[4 * 33], s[5 * 33]); o.w = pk2(s[6 * 33], s[7 * 33]);
        *(GAS v4u*)(WT + (size_t)(row_off + n0 + n) * K + k0 + 8 * c) = o; }
    LDS_WAIT(); asm volatile("" ::: "memory");
}

struct Ptrs {
    const float *x, *p, *g_mix, *w_in, *conv_w, *pool_w, *pool_scale, *w_o, *g_ffn, *w_q, *sub_keys, *eu, *ev, *g_ple, *w_gate, *w_proj, *g_final;
    float* out; unsigned char* ws;
};

__device__ __forceinline__ void p0a_phase(const Ptrs& P, LAS unsigned char* lds, int vcu, int G, int tid, int wave, int lane) {
    const int gw = vcu * 4 + (wave & 3), NGW = G * 4;
    const int gt = gw * 64 + lane, NGT = NGW * 64;
    if (wave < 4) {
    { float* Wf = (float*)(P.ws + WS_WF);
      for (int tk = gw; tk < 2048; tk += NGW) {
          const int k4 = (tk >> 3) * 4, j = tk & 7, g = j >> 1, np = j * 64 + lane, d = np & 127;
          const float* wi = P.w_in + (size_t)k4 * 2048 + 1536 + g * 128; const float* pw = P.pool_w + (size_t)g * 128 * 128 + d;
          float a0 = 0.f, a1 = 0.f, a2 = 0.f, a3 = 0.f;
          for (int c0 = 0; c0 < 128; c0 += 16) {
              float pv[16], w0[16], w1[16], w2[16], w3[16];
#pragma unroll
              for (int c = 0; c < 16; ++c) { pv[c] = pw[(size_t)(c0 + c) * 128]; w0[c] = wi[c0 + c]; w1[c] = wi[2048 + c0 + c]; w2[c] = wi[4096 + c0 + c]; w3[c] = wi[6144 + c0 + c]; }
#pragma unroll
              for (int c = 0; c < 16; ++c) { a0 += w0[c] * pv[c]; a1 += w1[c] * pv[c]; a2 += w2[c] * pv[c]; a3 += w3[c] * pv[c]; }
          }
          const float sc = P.pool_scale[np];
          Wf[(size_t)k4 * 512 + np] = a0 * sc; Wf[(size_t)(k4 + 1) * 512 + np] = a1 * sc; Wf[(size_t)(k4 + 2) * 512 + np] = a2 * sc; Wf[(size_t)(k4 + 3) * 512 + np] = a3 * sc;
      } }
    { LAS float* scr = (LAS float*)(lds + wave * 16384);
      constexpr int I_WO = 16 * 32, I_WQ = 16 * 64, I_WG = 16 * 32, I_WP = 4 * 32, I_WINA = 16 * 48;
      constexpr int NITEMS = I_WO + I_WQ + I_WG + I_WP + I_WINA;
      for (int it = gw; it < NITEMS; it += NGW) {
          int r = it;
          if (r < I_WO) { p0_transpose_item(P.w_o, 1024, nullptr, 1024, (bf16*)(P.ws + WS_WO), 0, 32, scr, r, lane); continue; } r -= I_WO;
          if (r < I_WQ) { p0_transpose_item(P.w_q, 2048, P.g_ffn, 1024, (bf16*)(P.ws + WS_WQ), 0, 64, scr, r, lane); continue; } r -= I_WQ;
          if (r < I_WG) { p0_transpose_item(P.w_gate, 1024, P.g_ple, 1024, (bf16*)(P.ws + WS_WG), 0, 32, scr, r, lane); continue; } r -= I_WG;
          if (r < I_WP) { p0_transpose_item(P.w_proj, 1024, nullptr, 256, (bf16*)(P.ws + WS_WP), 0, 32, scr, r, lane); continue; } r -= I_WP;
          {
            const int nb = r % 48, n0 = 32 * nb; int sc0 = n0;
            if (n0 >= 512) { const int jj = (n0 - 512) >> 8, rr = (n0 - 512) & 255; sc0 = rr < 128 ? 512 + 128 * jj + rr : 1024 + 128 * jj + (rr - 128); }
            p0_transpose_item(P.w_in + (sc0 - n0), 2048, P.g_mix, 1024, (bf16*)(P.ws + WS_WIN), 0, 48, scr, r, lane); }
      } }
    } else {
    { for (int r0 = 4 * gw; r0 < NEXP; r0 += 4 * NGW) {
          f32x4 a[4][4]; float q[4];
#pragma unroll
          for (int rr = 0; rr < 4; ++rr) { const GAS f32x4* src = (const GAS f32x4*)(P.eu + (size_t)(r0 + rr) * 1024);
#pragma unroll
              for (int j = 0; j < 4; ++j) a[rr][j] = src[4 * lane + j]; }
          { const GAS f32x4* gf = (const GAS f32x4*)P.g_ffn + 4 * lane;
#pragma unroll
            for (int j = 0; j < 4; ++j) { const f32x4 g = gf[j];
#pragma unroll
                for (int rr = 0; rr < 4; ++rr) a[rr][j] = a[rr][j] * g; } }
#pragma unroll
          for (int rr = 0; rr < 4; ++rr) { q[rr] = 0.f;
#pragma unroll
              for (int j = 0; j < 4; ++j) q[rr] += (a[rr][j].x * a[rr][j].x + a[rr][j].y * a[rr][j].y) + (a[rr][j].z * a[rr][j].z + a[rr][j].w * a[rr][j].w); }
          q[0] = wave_sum(q[0]); q[1] = wave_sum(q[1]); q[2] = wave_sum(q[2]); q[3] = wave_sum(q[3]);
#pragma unroll
          for (int rr = 0; rr < 4; ++rr) { const int e = r0 + rr;
              const float rms = sqrtf(q[rr] * (1.0f / 1024.0f)); const float sc = rms > 0.f ? 2.0f / rms : 0.f;
              unsigned w0 = 0u, w1 = 0u;
              w0 = __builtin_amdgcn_cvt_scalef32_pk_fp4_f32(w0, a[rr][0].x * sc, a[rr][0].y * sc, 1.0f, 0); w0 = __builtin_amdgcn_cvt_scalef32_pk_fp4_f32(w0, a[rr][0].z * sc, a[rr][0].w * sc, 1.0f, 1);
              w0 = __builtin_amdgcn_cvt_scalef32_pk_fp4_f32(w0, a[rr][1].x * sc, a[rr][1].y * sc, 1.0f, 2); w0 = __builtin_amdgcn_cvt_scalef32_pk_fp4_f32(w0, a[rr][1].z * sc, a[rr][1].w * sc, 1.0f, 3);
              w1 = __builtin_amdgcn_cvt_scalef32_pk_fp4_f32(w1, a[rr][2].x * sc, a[rr][2].y * sc, 1.0f, 0); w1 = __builtin_amdgcn_cvt_scalef32_pk_fp4_f32(w1, a[rr][2].z * sc, a[rr][2].w * sc, 1.0f, 1);
              w1 = __builtin_amdgcn_cvt_scalef32_pk_fp4_f32(w1, a[rr][3].x * sc, a[rr][3].y * sc, 1.0f, 2); w1 = __builtin_amdgcn_cvt_scalef32_pk_fp4_f32(w1, a[rr][3].z * sc, a[rr][3].w * sc, 1.0f, 3);
              ((GAS v2u*)(P.ws + WS_U))[(size_t)e * 64 + lane] = (v2u){w0, w1};
              if (lane == 0) ((float*)(P.ws + WS_SU))[e] = rms * 0.5f; }
      } }
    { const int ci = lane >> 2, cb = lane & 3; const int eoff = 256 * cb + 64 * (ci >> 2) + (ci & 3);
      for (int r0 = 2 * gw; r0 < NEXP; r0 += 2 * NGW) {
          float v[2][16]; float q[2];
#pragma unroll
          for (int rr = 0; rr < 2; ++rr) { const float* src = P.ev + (size_t)(r0 + rr) * 1024 + eoff;
#pragma unroll
              for (int n = 0; n < 16; ++n) v[rr][n] = src[4 * n]; }
#pragma unroll
          for (int rr = 0; rr < 2; ++rr) { q[rr] = 0.f;
#pragma unroll
              for (int n = 0; n < 16; ++n) q[rr] += v[rr][n] * v[rr][n]; }
          q[0] = wave_sum(q[0]); q[1] = wave_sum(q[1]);
#pragma unroll
          for (int rr = 0; rr < 2; ++rr) { const int e = r0 + rr;
              const float rms = sqrtf(q[rr] * (1.0f / 1024.0f)); const float sc = rms > 0.f ? 2.0f / rms : 0.f;
              unsigned w0 = 0u, w1 = 0u;
              w0 = __builtin_amdgcn_cvt_scalef32_pk_fp4_f32(w0, v[rr][0] * sc, v[rr][1] * sc, 1.0f, 0); w0 = __builtin_amdgcn_cvt_scalef32_pk_fp4_f32(w0, v[rr][2] * sc, v[rr][3] * sc, 1.0f, 1);
              w0 = __builtin_amdgcn_cvt_scalef32_pk_fp4_f32(w0, v[rr][4] * sc, v[rr][5] * sc, 1.0f, 2); w0 = __builtin_amdgcn_cvt_scalef32_pk_fp4_f32(w0, v[rr][6] * sc, v[rr][7] * sc, 1.0f, 3);
              w1 = __builtin_amdgcn_cvt_scalef32_pk_fp4_f32(w1, v[rr][8] * sc, v[rr][9] * sc, 1.0f, 0); w1 = __builtin_amdgcn_cvt_scalef32_pk_fp4_f32(w1, v[rr][10] * sc, v[rr][11] * sc, 1.0f, 1);
              w1 = __builtin_amdgcn_cvt_scalef32_pk_fp4_f32(w1, v[rr][12] * sc, v[rr][13] * sc, 1.0f, 2); w1 = __builtin_amdgcn_cvt_scalef32_pk_fp4_f32(w1, v[rr][14] * sc, v[rr][15] * sc, 1.0f, 3);
              ((GAS v2u*)(P.ws + WS_V + (size_t)(cb / D2HV) * ((size_t)NEXP * D2PIECE) + (size_t)e * D2PIECE + (cb % D2HV) * 128))[ci] = (v2u){w0, w1};
              if (lane == 0) ((float*)(P.ws + WS_SV))[e] = rms * 0.5f; }
      } }
    { const GAS f32x4* sp = (const GAS f32x4*)P.p; GAS v4u* dp = (GAS v4u*)(P.ws + WS_PB);
      for (int i0 = gt; i0 < M * PLED / 8; i0 += 4 * NGT) {
          f32x4 a[4], b[4];
#pragma unroll
          for (int q = 0; q < 4; ++q) { const int i = i0 + q * NGT; if (i < M * PLED / 8) { a[q] = sp[2 * (size_t)i]; b[q] = sp[2 * (size_t)i + 1]; } }
#pragma unroll
          for (int q = 0; q < 4; ++q) { const int i = i0 + q * NGT; if (i < M * PLED / 8) { v4u o; o.x = pk2(a[q].x, a[q].y); o.y = pk2(a[q].z, a[q].w); o.z = pk2(b[q].x, b[q].y); o.w = pk2(b[q].z, b[q].w); dp[i] = o; } }
      }
      const GAS f32x4* sk = (const GAS f32x4*)P.sub_keys; GAS v4u* dk = (GAS v4u*)(P.ws + WS_KEYS);
      for (int i = gt; i < 16 * 128 * 128 / 8; i += NGT) { const f32x4 a = sk[2 * (size_t)i], b = sk[2 * (size_t)i + 1]; v4u o; o.x = pk2(a.x, a.y); o.y = pk2(a.z, a.w); o.z = pk2(b.x, b.y); o.w = pk2(b.z, b.w); dk[i] = o; } }
    { float* RSX = (float*)(P.ws + WS_RSX); bf16* XB = (bf16*)(P.ws + WS_XB);
      for (int m0 = 4 * gw; m0 < M; m0 += 4 * NGW) {
          f32x4 v[4][4]; float sq[4];
#pragma unroll
          for (int r = 0; r < 4; ++r) { const GAS f32x4* xr = (const GAS f32x4*)(P.x + (size_t)(m0 + r) * D) + lane;
#pragma unroll
              for (int j = 0; j < 4; ++j) v[r][j] = xr[64 * j]; }
#pragma unroll
          for (int r = 0; r < 4; ++r) { sq[r] = 0.f;
#pragma unroll
              for (int j = 0; j < 4; ++j) sq[r] += (v[r][j].x * v[r][j].x + v[r][j].y * v[r][j].y) + (v[r][j].z * v[r][j].z + v[r][j].w * v[r][j].w); }
#pragma unroll
          for (int r = 0; r < 4; ++r) sq[r] = wave_sum(sq[r]);
#pragma unroll
          for (int r = 0; r < 4; ++r) { if (lane == 0) RSX[m0 + r] = sq[r];
              GAS unsigned long long* o8 = (GAS unsigned long long*)(XB + (size_t)(m0 + r) * D) + lane;
#pragma unroll
              for (int j = 0; j < 4; ++j) o8[64 * j] = (unsigned long long)pk2(v[r][j].x, v[r][j].y) | ((unsigned long long)pk2(v[r][j].z, v[r][j].w) << 32); }
      } }
    }
}
__device__ __forceinline__ void p0b_phase(const Ptrs& P, LAS unsigned char* lds, int vcu, int G, int wave, int lane) {
    const int gw = vcu * NWAVES + wave, NGW = G * NWAVES; LAS float* scr = (LAS float*)(lds + wave * 16384);
    for (int it = gw; it < 16 * 16; it += NGW) p0_transpose_item((const float*)(P.ws + WS_WF), 512, P.g_mix, 1024, (bf16*)(P.ws + WS_WIN), 1536, 16, scr, it, lane);
}

template <int HALF>
__device__ __forceinline__ void pool_chunk(const unsigned* col, unsigned* mx, int t0, int s0) {
    constexpr int TC = 32, NV = TC + 2 * HALF;
    float v0[NV], v1[NV];
#pragma unroll
    for (int i = 0; i < NV; ++i) {
        const int s = s0 - HALF + i; const bool ok = (s >= 0) && (s < SEQ);
        const unsigned w = col[(size_t)(ok ? (t0 - HALF + i) : t0) * 768];
        v0[i] = ok ? bf_lo(w) : 0.f; v1[i] = ok ? bf_hi(w) : 0.f;
    }
    float S0 = 0.f, S1 = 0.f;
#pragma unroll
    for (int j = 0; j < 2 * HALF; ++j) { S0 += v0[j]; S1 += v1[j]; }
#pragma unroll
    for (int i = 0; i < TC; ++i) {
        const int s = s0 + i; const int lo = (s - HALF) > 0 ? (s - HALF) : 0, hi = (s + HALF) < SEQ ? (s + HALF) : SEQ;
        const float inv = 1.0f / (float)(hi - lo);
        mx[(size_t)(t0 + i) * 512] = pk2(S0 * inv - v0[i + HALF], S1 * inv - v1[i + HALF]);
        if (i + 1 < TC) { S0 += v0[i + 2 * HALF] - v0[i]; S1 += v1[i + 2 * HALF] - v1[i]; }
    }
}
__device__ __forceinline__ void p2_phase(const Ptrs& P, int vcu, int G, int tid, int wave) {
    const unsigned* PR = (const unsigned*)(P.ws + WS_PROJ);
    unsigned* MX = (unsigned*)(P.ws + WS_MIX);
    constexpr int TC = 32;
    for (int ck = vcu; ck < M / TC; ck += G) {
        const int t0 = ck * TC, s0 = t0 & (SEQ - 1);
        if (tid < 256) {
            const unsigned* col = PR + 512 + tid; unsigned* mx = MX + 256 + tid;
            if (wave == 0) pool_chunk<1>(col, mx, t0, s0); else if (wave == 1) pool_chunk<2>(col, mx, t0, s0); else if (wave == 2) pool_chunk<4>(col, mx, t0, s0); else pool_chunk<8>(col, mx, t0, s0);
        } else {
            const int cp = tid - 256;
            const unsigned* bcol = PR + cp; const unsigned* zcol = PR + 256 + cp;
            const float w00 = P.conv_w[2 * cp], w01 = P.conv_w[2 * cp + 1], w10 = P.conv_w[512 + 2 * cp], w11 = P.conv_w[512 + 2 * cp + 1], w20 = P.conv_w[1024 + 2 * cp], w21 = P.conv_w[1024 + 2 * cp + 1];
            float z0[TC + 2], z1[TC + 2]; unsigned bw[TC];
#pragma unroll
            for (int i = 0; i < TC + 2; ++i) {
                const int s = s0 - 1 + i; const bool ok = (s >= 0) && (s < SEQ);
                const unsigned z = zcol[(size_t)(ok ? (t0 - 1 + i) : t0) * 768];
                z0[i] = ok ? bf_lo(z) : 0.f; z1[i] = ok ? bf_hi(z) : 0.f;
            }
#pragma unroll
            for (int i = 0; i < TC; ++i) bw[i] = bcol[(size_t)(t0 + i) * 768];
#pragma unroll
            for (int i = 0; i < TC; ++i) {
                const float y0 = w00 * z0[i] + w10 * z0[i + 1] + w20 * z0[i + 2], y1 = w01 * z1[i] + w11 * z1[i + 1] + w21 * z1[i + 2];
                MX[(size_t)(t0 + i) * 512 + cp] = pk2(bf_lo(bw[i]) * y0, bf_hi(bw[i]) * y1);
            }
        }
    }
}

__device__ __forceinline__ float fmax_s(float a, float b) { float r; asm("v_max_f32_e32 %0, %1, %2" : "=v"(r) : "v"(a), "v"(b)); return r; }
__device__ __forceinline__ float fmin_s(float a, float b) { float r; asm("v_min_f32_e32 %0, %1, %2" : "=v"(r) : "v"(a), "v"(b)); return r; }
#define CE_DESC(a, b) do { const float _t = fmax_s(a, b); b = fmin_s(a, b); a = _t; } while (0)
#define CE_ASC(a, b)  do { const float _t = fmin_s(a, b); b = fmax_s(a, b); a = _t; } while (0)
__device__ __forceinline__ void sort16_desc(float* a) {
#pragma unroll
    for (int k = 2; k <= 16; k <<= 1)
#pragma unroll
        for (int j = k >> 1; j > 0; j >>= 1)
#pragma unroll
            for (int i = 0; i < 16; ++i) { const int l = i ^ j; if (l > i) { if ((i & k) == 0) CE_DESC(a[i], a[l]); else CE_ASC(a[i], a[l]); } }
}
__device__ __forceinline__ void merge16_desc(float* a) {
#pragma unroll
    for (int j = 8; j > 0; j >>= 1)
#pragma unroll
        for (int i = 0; i < 16; ++i) { const int l = i ^ j; if (l > i) CE_DESC(a[i], a[l]); }
}
__device__ __forceinline__ void top16_merge(float* a, const float* b) {
#pragma unroll
    for (int i = 0; i < 16; ++i) a[i] = fmax_s(a[i], b[15 - i]);
    merge16_desc(a);
}
__device__ __forceinline__ void top16_of_64(float* v) {
    sort16_desc(v); sort16_desc(v + 16); sort16_desc(v + 32); sort16_desc(v + 48);
    top16_merge(v, v + 16); top16_merge(v + 32, v + 48); top16_merge(v, v + 32);
}
__device__ __forceinline__ unsigned key_lookup(unsigned long long lo, unsigned long long hi, unsigned i) {
    const unsigned long long v = (i & 8u) ? hi : lo;
    return (unsigned)(v >> ((i & 7u) * 8u)) & 0x7fu;
}

constexpr int KROW = 272;
__device__ __forceinline__ void score_phase(const Ptrs& P, LAS unsigned char* lds, int bid, int G, int tid, int wave, int lane) {
    const bf16* Q = (const bf16*)(P.ws + WS_PROJ); const bf16* KEYS = (const bf16*)(P.ws + WS_KEYS); const float* RS1 = (const float*)(P.ws + WS_RS1);
    int* EIDX = (int*)(P.ws + WS_EIDX); float* GATE = (float*)(P.ws + WS_GATE);
    const int l31 = lane & 31, hi = lane >> 5;
    int cur_h = -1;
    bf16x8 bqa[2][8];
    if (bid < (M / 256) * 8) { const int tok0 = (bid >> 3) * 256 + wave * 32 + l31;
#pragma unroll
        for (int p = 0; p < 2; ++p) { const bf16* qp = Q + (size_t)tok0 * 2048 + (bid & 7) * 256 + p * 128 + hi * 8;
#pragma unroll
            for (int ks = 0; ks < 8; ++ks) bqa[p][ks] = *(const GAS bf16x8*)(qp + ks * 16); } }
    for (int u = bid; u < (M / 256) * 8; u += G) {
        const int h = u & 7, tile = u >> 3;
        if (h != cur_h) {
            __syncthreads();
#pragma unroll
            for (int i = 0; i < 8; ++i) { const int q = tid + 512 * i, row = q >> 4, ch = q & 15;
                const v4u val = *(const GAS v4u*)(KEYS + ((size_t)(h * 256 + row)) * 128 + ch * 8);
                *(LAS v4u*)(lds + row * KROW + ch * 16) = val; }
            __syncthreads();
            cur_h = h;
        }
        const int tok = tile * 256 + wave * 32 + l31;
        float T0[16], T1[16];
#pragma unroll
        for (int p = 0; p < 2; ++p) {
            f32x16 acc[4];
#pragma unroll
            for (int kb = 0; kb < 4; ++kb)
#pragma unroll
                for (int r = 0; r < 16; ++r) acc[kb][r] = 0.f;
#pragma unroll
            for (int ks = 0; ks < 8; ++ks)
#pragma unroll
                for (int kb = 0; kb < 4; ++kb) {
                    const bf16x8 ak = *(const LAS bf16x8*)(lds + (p * 128 + kb * 32 + l31) * KROW + (ks * 16 + hi * 8) * 2);
                    acc[kb] = __builtin_amdgcn_mfma_f32_32x32x16_bf16(ak, bqa[p][ks], acc[kb], 0, 0, 0);
                }
            if (p == 1) {
                const int un = (u + G < (M / 256) * 8) ? u + G : u; const int tokn = (un >> 3) * 256 + wave * 32 + l31;
                asm volatile("" : "+v"(acc[0]), "+v"(acc[1]), "+v"(acc[2]), "+v"(acc[3]));
#pragma unroll
                for (int pp = 0; pp < 2; ++pp) { const bf16* qp = Q + (size_t)tokn * 2048 + (un & 7) * 256 + pp * 128 + hi * 8;
#pragma unroll
                    for (int ks = 0; ks < 8; ++ks) bqa[pp][ks] = *(const GAS bf16x8*)(qp + ks * 16); }
            }
            float v[64];
#pragma unroll
            for (int kb = 0; kb < 4; ++kb)
#pragma unroll
                for (int r = 0; r < 16; ++r) v[kb * 16 + r] = __uint_as_float((__float_as_uint(acc[kb][r]) & 0xffffff80u) | (unsigned)(kb * 32 + (r & 3) + 8 * (r >> 2)));
            top16_of_64(v);
            const unsigned hb = (unsigned)hi << 2;
#pragma unroll
            for (int i = 0; i < 16; ++i) v[i] = __uint_as_float(__float_as_uint(v[i]) | hb);
            float c[16];
#pragma unroll
            for (int i = 0; i < 16; ++i) c[i] = fmax_s(v[i], __shfl_xor(v[15 - i], 32));
            merge16_desc(c);
#pragma unroll
            for (int i = 0; i < 16; ++i) { if (p == 0) T0[i] = c[i]; else T1[i] = c[i]; }
        }
        float f0[16], f1[16];
        unsigned long long K0lo = 0ull, K0hi = 0ull, K1lo = 0ull, K1hi = 0ull;
#pragma unroll
        for (int b = 0; b < 8; ++b) {
            K0lo |= (unsigned long long)(__float_as_uint(T0[b]) & 0x7fu) << (8 * b); K0hi |= (unsigned long long)(__float_as_uint(T0[8 + b]) & 0x7fu) << (8 * b);
            K1lo |= (unsigned long long)(__float_as_uint(T1[b]) & 0x7fu) << (8 * b); K1hi |= (unsigned long long)(__float_as_uint(T1[8 + b]) & 0x7fu) << (8 * b);
        }
#pragma unroll
        for (int i = 0; i < 16; ++i) { f0[i] = __uint_as_float(__float_as_uint(T0[i]) & 0xffffff80u); f1[i] = __uint_as_float(__float_as_uint(T1[i]) & 0xffffff80u); }
        float cd[32]; int n = 0;
#pragma unroll
        for (int i = 0; i < 16; ++i)
#pragma unroll
            for (int j = 0; j < 16; ++j)
                if ((i + 1) * (j + 1) <= 16) {
                    const float cv = __uint_as_float((__float_as_uint(f0[i] + f1[j]) & 0xffffff00u) | (unsigned)(i * 16 + j));
                    if ((n & 1) == 0) cd[n >> 1] = cv; else cd[n >> 1] = hi ? cv : cd[n >> 1];
                    ++n;
                }
#pragma unroll
        for (int q = 25; q < 32; ++q) cd[q] = __uint_as_float(0xff800000u);
        sort16_desc(cd); sort16_desc(cd + 16); top16_merge(cd, cd + 16);
        { float cm[16];
#pragma unroll
          for (int i = 0; i < 16; ++i) cm[i] = fmax_s(cd[i], __shfl_xor(cd[15 - i], 32));
          merge16_desc(cm);
#pragma unroll
          for (int i = 0; i < 16; ++i) cd[i] = cm[i]; }
        float rs = 0.f;
        { const GAS f32x4* rp = (const GAS f32x4*)(RS1 + (size_t)tok * 16);
#pragma unroll
          for (int i = 0; i < 4; ++i) { const f32x4 a = rp[i]; rs += (a.x + a.y) + (a.z + a.w); } }
        const float rstd = __builtin_amdgcn_rsqf(rs * (1.0f / 1024.0f) + EPS);
        int eidx[16]; float gt_[16]; float z0 = 0.f, sum = 0.f;
#pragma unroll
        for (int k = 0; k < 16; ++k) {
            const unsigned wb = __float_as_uint(cd[k]); const unsigned i = (wb >> 4) & 15u, j = wb & 15u;
            eidx[k] = (int)(key_lookup(K0lo, K0hi, i) * 128u + key_lookup(K1lo, K1hi, j));
            const float z = __uint_as_float(wb & 0xffffff00u) * rstd;
            if (k == 0) z0 = z;
            gt_[k] = __expf(z - z0); sum += gt_[k];
        }
        const float inv = 1.0f / sum;
        if (hi == 0) { GAS i32x4* ep = (GAS i32x4*)(EIDX + (size_t)tok * 128 + h * 16);
#pragma unroll
            for (int q = 0; q < 4; ++q) ep[q] = (i32x4){eidx[4 * q], eidx[4 * q + 1], eidx[4 * q + 2], eidx[4 * q + 3]};
        } else { GAS f32x4* gp = (GAS f32x4*)(GATE + (size_t)tok * 128 + h * 16);
#pragma unroll
            for (int q = 0; q < 4; ++q) gp[q] = (f32x4){gt_[4 * q] * inv, gt_[4 * q + 1] * inv, gt_[4 * q + 2] * inv, gt_[4 * q + 3] * inv};
        }
    }
}

__device__ __forceinline__ float gelu_tanh(float x) {
    const float y = 1.5957691216057308f * (x + 0.044715f * x * x * x);
    return x / (1.0f + __expf(-y));
}
typedef int v8i __attribute__((ext_vector_type(8)));
#define PEER_MFMA(a, b, c) __builtin_amdgcn_mfma_scale_f32_16x16x128_f8f6f4(a, b, c, 4  , 0  , 0, 0x7F7F7F7F, 0, 0x7F7F7F7F)
__device__ __forceinline__ void peer_dots_phase(const Ptrs& P, LAS unsigned char* lds, int vcu, int G, int wave, int lane) {
    const int gw = vcu * NWAVES + wave, NGW = G * NWAVES;
    const bf16* HB = (const bf16*)(P.ws + WS_HB); unsigned char* CF8 = P.ws + WS_CF; int* EOFF = (int*)(P.ws + WS_EOFF);
    const int* EIDX = (const int*)(P.ws + WS_EIDX); const float* GATE = (const float*)(P.ws + WS_GATE);
    const unsigned char* U4 = P.ws + WS_U;
    const float* SU = (const float*)(P.ws + WS_SU); const float* SV = (const float*)(P.ws + WS_SV);
    LAS unsigned char* xl = lds + 65536 + wave * 1024;
    LAS unsigned char* tb = lds + wave * 8192;
    const int lr = lane >> 5, lp = lane & 31;
    const int li = lane & 15, lq = lane >> 4;
    const int kl = 4 * lq + (li & 3);
    const int gam = lq + 4 * (li & 1); const int cpos = lq * 32 + (li & 3), epos = gam * 16 + ((li >> 1) & 1);
    int t = gw; if (t >= M) return;
    int ei0 = __builtin_nontemporal_load(EIDX + (size_t)t * 128 + lane), ei1 = __builtin_nontemporal_load(EIDX + (size_t)t * 128 + 64 + lane);
    float gg0 = __builtin_nontemporal_load(GATE + (size_t)t * 128 + lane), gg1 = __builtin_nontemporal_load(GATE + (size_t)t * 128 + 64 + lane);
    v2u hrow[4];
    { const GAS v2u* hp = (const GAS v2u*)(HB + (size_t)t * 1024) + lane;
#pragma unroll
      for (int j = 0; j < 4; ++j) hrow[j] = __builtin_nontemporal_load(hp + 64 * j); }
    v4u uw[8];
#pragma unroll
    for (int v = 0; v < 8; ++v) { const int e = __shfl(ei0, 2 * v + lr); uw[v] = *(const GAS v4u*)(U4 + (size_t)e * 512 + 16 * lp); }
    for (; t < M; t += NGW) {
        const int tn = (t + NGW < M) ? t + NGW : t;
        f32x2 x[8]; float ss = 0.f;
#pragma unroll
        for (int j = 0; j < 4; ++j) { const unsigned wa = hrow[j].x, wb = hrow[j].y; x[2 * j] = (f32x2){bf_lo(wa), bf_hi(wa)}; x[2 * j + 1] = (f32x2){bf_lo(wb), bf_hi(wb)};
            ss += (x[2 * j].x * x[2 * j].x + x[2 * j].y * x[2 * j].y) + (x[2 * j + 1].x * x[2 * j + 1].x + x[2 * j + 1].y * x[2 * j + 1].y); }
        ss = wave_sum(ss);
        const float rstd = __builtin_amdgcn_rsqf(ss * (1.0f / 1024.0f) + EPS);
        { const float sx = 16.0f * rstd;
#pragma unroll
          for (int j = 0; j < 4; ++j) { int w = __builtin_amdgcn_cvt_pk_fp8_f32(x[2 * j].x * sx, x[2 * j].y * sx, 0, false); w = __builtin_amdgcn_cvt_pk_fp8_f32(x[2 * j + 1].x * sx, x[2 * j + 1].y * sx, w, true);
              const int n = 4 * lane + 256 * j, sN = n >> 7, nn = n & 127, hN = nn >> 6, qN = (nn & 63) >> 4, jN = nn & 15;
              *(LAS unsigned*)(xl + 128 * sN + 32 * qN + 16 * hN + jN) = (unsigned)w; }
          asm volatile("s_waitcnt lgkmcnt(0)" ::: "memory"); }
        v8i xb[8];
#pragma unroll
        for (int sI = 0; sI < 8; ++sI) { const v4u b0 = *(const LAS v4u*)(xl + 128 * sI + 32 * lq), b1 = *(const LAS v4u*)(xl + 128 * sI + 32 * lq + 16);
            xb[sI] = (v8i){(int)b0.x, (int)b0.y, (int)b0.z, (int)b0.w, (int)b1.x, (int)b1.y, (int)b1.z, (int)b1.w}; }
        const int nei0 = __builtin_nontemporal_load(EIDX + (size_t)tn * 128 + lane), nei1 = __builtin_nontemporal_load(EIDX + (size_t)tn * 128 + 64 + lane);
        const float ngg0 = __builtin_nontemporal_load(GATE + (size_t)tn * 128 + lane), ngg1 = __builtin_nontemporal_load(GATE + (size_t)tn * 128 + 64 + lane);
        { const GAS v2u* hn = (const GAS v2u*)(HB + (size_t)tn * 1024) + lane;
#pragma unroll
          for (int j = 0; j < 4; ++j) hrow[j] = __builtin_nontemporal_load(hn + 64 * j); }
        for (int hq = 0; hq < 8 * REPS(7); ++hq) { const int hh = hq & 7;
            const int ereg = hh < 4 ? ei0 : ei1; const float greg = hh < 4 ? gg0 : gg1; const int lb = (hh & 3) * 16;
            const int el = __shfl(ereg, lb + kl);
            const float su = SU[el], sv = SV[el];
#pragma unroll
            for (int v = 0; v < 8; ++v) { const int r = 2 * v + lr; *(LAS v4u*)(tb + 512 * r + 16 * (lp ^ r)) = uw[v]; }
            __builtin_amdgcn_sched_barrier(0);
            { const bool lasth = (hq == 8 * REPS(7) - 1); const int hn = (hh + 1) & 7;
              const int nreg = lasth ? nei0 : (hn < 4 ? ei0 : ei1); const int nlb = (hn & 3) * 16;
#pragma unroll
              for (int v = 0; v < 8; ++v) { const int e = __shfl(nreg, nlb + 2 * v + lr); uw[v] = *(const GAS v4u*)(U4 + (size_t)e * 512 + 16 * lp); } }
            __builtin_amdgcn_sched_barrier(0);
            f32x4 acc = {0.f, 0.f, 0.f, 0.f};
#pragma unroll
            for (int sI = 0; sI < 8; ++sI) { const v4u af = *(const LAS v4u*)(tb + 512 * li + 16 * ((4 * sI + lq) ^ li));
                const v8i av = {(int)af.x, (int)af.y, (int)af.z, (int)af.w, 0, 0, 0, 0}; acc = PEER_MFMA(av, xb[sI], acc); }
            const int rsel = li & 3;
            const float d = rsel == 0 ? acc[0] : (rsel == 1 ? acc[1] : (rsel == 2 ? acc[2] : acc[3]));
            const float gk = __shfl(greg, lb + kl);
            const float cf = gk * gelu_tanh(d * su * (1.0f / 16.0f)) * sv * 1024.0f;
            const float cfc = fminf(fmaxf(cf, -448.0f), 448.0f);
            const unsigned c8 = (unsigned)__builtin_amdgcn_cvt_pk_fp8_f32(cfc, cfc, 0, false);
            if (li < 4) { CF8[(size_t)t * 128 + cpos + hh * 4] = (unsigned char)c8; EOFF[(size_t)t * 128 + epos + hh * 2] = el * D2PIECE; }
        }
        ei0 = nei0; ei1 = nei1; gg0 = ngg0; gg1 = ngg1;
    }
}
__device__ __forceinline__ void peer_sum_phase(const Ptrs& P, LAS unsigned char* lds, int bx, int G, int wave, int lane) {
    static_assert(D2NS == 4, "this body is written for four slices");
    constexpr int NTP = 2, SL = 256, MT = M / NTP, NSLOT = 6, AHD = 5;
    const int kx = bx & 7, sl = kx & 3, tp = kx >> 2, nbk = (G - kx + 7) >> 3;
    const int wj = (bx >> 3) * NWAVES + wave, NW = nbk * NWAVES;
    bf16* HB = (bf16*)(P.ws + WS_HB); float* RS2 = (float*)(P.ws + WS_RS2);
    const unsigned char* CF8 = P.ws + WS_CF; const unsigned char* EOFF = P.ws + WS_EOFF;
    const unsigned char* Vs = P.ws + WS_V + (size_t)sl * ((size_t)NEXP * D2PIECE);
    LAS unsigned char* rec = lds + wave * 16384;
    LAS unsigned char* dring = rec + 4096;
    const int li = lane & 15, lq = lane >> 4, rho = lane >> 3;
    const unsigned lc16 = 16u * (unsigned)(lane & 7);
    unsigned sel[2][8];
    { const unsigned pz = 0x0c0c0c0cu, psh = 8u * (unsigned)(li & 3);
#pragma unroll
      for (int g8 = 0; g8 < 2; ++g8)
#pragma unroll
          for (int r = 0; r < 8; ++r) { const unsigned pl = (pz & ~(0xffu << psh)) | ((unsigned)(2 * g8 + (r >> 2)) << psh); sel[g8][r] = ((r & 3) == (li >> 2)) ? pl : pz; } }
    const bool stl = lane < 40;
    auto rec_ptr = [&](int uu) -> const GAS v4u* { const size_t tt = (size_t)uu * NTP + tp; return (const GAS v4u*)(lane < 32 ? EOFF + tt * 512 + 16 * lane : CF8 + tt * 128 + 16 * (lane & 7)); };
    int u = wj; if (u >= MT) return;
    auto clampu = [&](int xx) { return xx < MT ? xx : u; };
#define D2_DMA(rs_, hd_, is_) do { const v2u eq_ = *(const LAS v2u*)((rs_) + rho * 64 + (hd_) * 8); \
        __builtin_amdgcn_global_load_lds((const unsigned*)(Vs + (size_t)(eq_.x + lc16)), (LAS unsigned*)(dring + (is_) * 2048), 16, 0, 0); \
        __builtin_amdgcn_global_load_lds((const unsigned*)(Vs + (size_t)(eq_.y + lc16)), (LAS unsigned*)(dring + (is_) * 2048 + 1024), 16, 0, 0); } while (0)
#define D2_REC(uu_, slot_) do { if (stl) __builtin_amdgcn_global_load_lds((const unsigned*)rec_ptr(uu_), (LAS unsigned*)(rec + (slot_) * 640), 16, 0, 0); } while (0)
    D2_REC(u, 0); D2_REC(clampu(u + NW), 1); D2_REC(clampu(u + 2 * NW), 2);
    asm volatile("s_waitcnt vmcnt(0)" ::: "memory");
#pragma unroll
    for (int h = 0; h < AHD; ++h) D2_DMA(rec, h, h);
    int cs = 0;
    for (int it = 0; u < MT; u += NW, ++it) {
        const int t = u * NTP + tp;
        LAS unsigned char* scur = rec + (it & 3) * 640; LAS unsigned char* snxt = rec + ((it + 1) & 3) * 640;
        D2_REC(clampu(u + 3 * NW), (it + 3) & 3);
        if (lane < 32) __builtin_amdgcn_global_load_lds((const unsigned*)((const unsigned char*)HB + (size_t)t * 2048 + SL * 2 * sl + 16 * lane), (LAS unsigned*)(rec + 2560), 16, 0, 0);
        f32x4 acc = {0.f, 0.f, 0.f, 0.f};
#pragma unroll
        for (int h = 0; h < 8; ++h) {
            { const int is = cs + AHD >= NSLOT ? cs + AHD - NSLOT : cs + AHD;
              if (h + AHD < 8) D2_DMA(scur, h + AHD, is); else D2_DMA(snxt, h + AHD - 8, is); }
            asm volatile("s_waitcnt vmcnt(10)" ::: "memory");
            const LAS unsigned char* im = dring + cs * 2048;
            const unsigned cw = *(const LAS unsigned*)(scur + 512 + lq * 32 + h * 4);
#pragma unroll
            for (int g8 = 0; g8 < 2; ++g8) {
                const v2u a0 = *(const LAS v2u*)(im + (8 * g8 + 2 * lq) * 128 + 8 * li), a1 = *(const LAS v2u*)(im + (8 * g8 + 2 * lq + 1) * 128 + 8 * li);
                const v8i bv = {(int)__builtin_amdgcn_perm(0u, cw, sel[g8][0]), (int)__builtin_amdgcn_perm(0u, cw, sel[g8][1]), (int)__builtin_amdgcn_perm(0u, cw, sel[g8][2]), (int)__builtin_amdgcn_perm(0u, cw, sel[g8][3]),
                                (int)__builtin_amdgcn_perm(0u, cw, sel[g8][4]), (int)__builtin_amdgcn_perm(0u, cw, sel[g8][5]), (int)__builtin_amdgcn_perm(0u, cw, sel[g8][6]), (int)__builtin_amdgcn_perm(0u, cw, sel[g8][7])};
                const v8i av = {(int)a0.x, (int)a0.y, (int)a1.x, (int)a1.y, 0, 0, 0, 0};
                acc = PEER_MFMA(av, bv, acc);
            }
            asm volatile("s_waitcnt lgkmcnt(0)" ::: "memory");
            cs = cs + 1 >= NSLOT ? 0 : cs + 1;
        }
        const float osc = 1.0f / 1024.0f;
        const v2u hrow = *(const LAS v2u*)(rec + 2560 + 8 * lane);
        const unsigned wa = hrow.x, wb = hrow.y;
        const f32x2 o0 = (f32x2){bf_lo(wa) + acc[0] * osc, bf_hi(wa) + acc[1] * osc}, o1 = (f32x2){bf_lo(wb) + acc[2] * osc, bf_hi(wb) + acc[3] * osc};
        __builtin_nontemporal_store((v2u){pk2(o0.x, o0.y), pk2(o1.x, o1.y)}, (GAS v2u*)(HB + (size_t)t * 1024 + SL * sl + 4 * lane));
        float s2 = (o0.x * o0.x + o0.y * o0.y) + (o1.x * o1.x + o1.y * o1.y);
        s2 = wave_sum(s2);
        if (lane == 0) RS2[(size_t)t * D2NS + sl] = s2;
    }
    asm volatile("s_waitcnt vmcnt(0)" ::: "memory");
#undef D2_DMA
#undef D2_REC
}

__device__ __forceinline__ void final_phase(const Ptrs& P, int vcu, int G, int wave, int lane) {
    const int gw = vcu * NWAVES + wave, NGW = G * NWAVES; const float* RS3 = (const float*)(P.ws + WS_RS3); const bf16* H3 = (const bf16*)(P.ws + WS_PROJ);
    const GAS f32x4* gf = (const GAS f32x4*)P.g_final + lane;
    f32x4 g[4];
#pragma unroll
    for (int j = 0; j < 4; ++j) g[j] = gf[64 * j];
    for (int m0 = 2 * gw; m0 < M; m0 += 2 * NGW) {
        v2u hv[2][4]; float rs[2];
#pragma unroll
        for (int r = 0; r < 2; ++r) { const GAS v2u* hp = (const GAS v2u*)(H3 + (size_t)(m0 + r) * D) + lane;
#pragma unroll
            for (int j = 0; j < 4; ++j) hv[r][j] = hp[64 * j];
            rs[r] = 0.f; const GAS f32x4* rp = (const GAS f32x4*)(RS3 + (size_t)(m0 + r) * 16);
#pragma unroll
            for (int i = 0; i < 4; ++i) { const f32x4 a = rp[i]; rs[r] += (a.x + a.y) + (a.z + a.w); } }
#pragma unroll
        for (int r = 0; r < 2; ++r) { const float rstd = __builtin_amdgcn_rsqf(rs[r] * (1.0f / 1024.0f) + EPS);
            GAS f32x4* xr = (GAS f32x4*)(P.out + (size_t)(m0 + r) * D) + lane;
#pragma unroll
            for (int j = 0; j < 4; ++j) { const unsigned wa = hv[r][j].x, wb = hv[r][j].y; const f32x4 v = {bf_lo(wa), bf_hi(wa), bf_lo(wb), bf_hi(wb)}; xr[64 * j] = v * rstd * g[j]; } }
    }
}

struct Args { const float* in[17]; float* out; unsigned char* ws; int ph_lo, ph_hi; };
#ifndef PG8_SP2
#define PG8_SP2 true
#endif
#ifndef PG8_ALIGN
#define PG8_ALIGN true
#endif
__global__ void __launch_bounds__(NWAVES * 64, 2) mega_fwd(Args args) {
    extern __shared__ __attribute__((aligned(16))) unsigned char lds_raw[];
    LAS unsigned char* lds = (LAS unsigned char*)lds_raw;
    volatile LAS unsigned* MISC = (volatile LAS unsigned*)(lds + MISC_OFF);
    const int tid = threadIdx.x, lane = tid & 63, wave = __builtin_amdgcn_readfirstlane(tid >> 6);
    const int G = gridDim.x, bx = blockIdx.x; const int vcu = (G % 8 == 0) ? (bx % 8) * (G / 8) + bx / 8 : bx;
    Ptrs P;
    P.x = args.in[0]; P.p = args.in[1]; P.g_mix = args.in[2]; P.w_in = args.in[3]; P.conv_w = args.in[4]; P.pool_w = args.in[5]; P.pool_scale = args.in[6]; P.w_o = args.in[7];
    P.g_ffn = args.in[8]; P.w_q = args.in[9]; P.sub_keys = args.in[10]; P.eu = args.in[11]; P.ev = args.in[12]; P.g_ple = args.in[13]; P.w_gate = args.in[14]; P.w_proj = args.in[15]; P.g_final = args.in[16];
    P.out = args.out; P.ws = args.ws;
    gu32* ctl = (gu32*)(P.ws + WS_CTL);
    for (int u = tid; u < (LDS_BYTES - LDSCTL_OFF) / 4; u += NWAVES * 64) ((LAS unsigned*)(lds + LDSCTL_OFF))[u] = 0u;
    __syncthreads();
    XcdBarrier bar; bar.bar = (unsigned*)(ctl + CW_BAR); bar.x = 0; bar.st = nullptr;
    if (!MK_PER_PHASE) bar = xcd_barrier_post((unsigned*)(ctl + CW_BAR), MISC + 8);
    const int lo = args.ph_lo, hi = args.ph_hi;
#define IN(k) (lo <= (k) && (k) < hi)
#define SEAM(k) do { if (IN(k) && IN((k) + 1)) xcd_barrier(bar); } while (0)
    pg8::bf16_t* const WIN = (pg8::bf16_t*)(P.ws + WS_WIN); pg8::bf16_t* const WO = (pg8::bf16_t*)(P.ws + WS_WO); pg8::bf16_t* const WQ = (pg8::bf16_t*)(P.ws + WS_WQ);
    pg8::bf16_t* const WG = (pg8::bf16_t*)(P.ws + WS_WG); pg8::bf16_t* const WP = (pg8::bf16_t*)(P.ws + WS_WP);
    pg8::bf16_t* const XB = (pg8::bf16_t*)(P.ws + WS_XB); pg8::bf16_t* const PL = XB; pg8::bf16_t* const PROJ = (pg8::bf16_t*)(P.ws + WS_PROJ); pg8::bf16_t* const QB = PROJ;
    pg8::bf16_t* const MIX = (pg8::bf16_t*)(P.ws + WS_MIX); pg8::bf16_t* const HB = (pg8::bf16_t*)(P.ws + WS_HB); pg8::bf16_t* const PB = (pg8::bf16_t*)(P.ws + WS_PB);

    if (IN(0)) { for (int rep = 0; rep < REPS(1); ++rep) { p0a_phase(P, lds, vcu, G, tid, wave, lane); SEAM(0); } }
    if (IN(1)) { p0b_phase(P, lds, vcu, G, wave, lane); SEAM(1); }
    if (IN(2)) {
        pg8::Gemm g{XB, WIN, M, NPROJ, D}; pg8::StaticOrder S; S.init(M, NPROJ, G, bx);
        EpiProj E{PROJ, (const float*)(P.ws + WS_RSX)};
        for (int rep = 0; rep < REPS(2); ++rep) { pg8::gemm_phase<EpiProj, pg8::StaticOrder, PG8_ALIGN, PG8_SP2>(lds, g, S, E);
        SEAM(2); }
    }
    if (IN(3)) {
        for (int rep = 0; rep < REPS(3); ++rep) p2_phase(P, vcu, G, tid, wave);
        pg8::Gemm g{PB, WP, M, D, PLED}; pg8::StaticOrder S; S.init(M, D, G, bx);
        EpiBf16Row E{PL, D, nullptr};
        for (int rep = 0; rep < REPS(8); ++rep) pg8::gemm_phase<EpiBf16Row, pg8::StaticOrder, PG8_ALIGN, PG8_SP2>(lds, g, S, E);
        SEAM(3);
    }
    if (IN(4)) {
        pg8::Gemm g{MIX, WO, M, D, D}; pg8::StaticOrder S; S.init(M, D, G, bx);
        EpiH1 E{P.x, HB, (float*)(P.ws + WS_RS1)};
        for (int rep = 0; rep < REPS(4); ++rep) { pg8::gemm_phase<EpiH1, pg8::StaticOrder, PG8_ALIGN, PG8_SP2>(lds, g, S, E);
        SEAM(4); }
    }
    if (IN(5)) {
        pg8::Gemm g{HB, WQ, M, NQ, D}; pg8::StaticOrder S; S.init(M, NQ, G, bx);
        EpiBf16Row E{QB, NQ, nullptr};
        for (int rep = 0; rep < REPS(5); ++rep) { pg8::gemm_phase<EpiBf16Row, pg8::StaticOrder, PG8_ALIGN, PG8_SP2>(lds, g, S, E);
        SEAM(5); }
    }
    if (IN(6)) { for (int rep = 0; rep < REPS(6); ++rep) { score_phase(P, lds, bx, G, tid, wave, lane); SEAM(6); } }
    if (IN(7)) { peer_dots_phase(P, lds, vcu, G, wave, lane); SEAM(7); }
    if (IN(8)) { peer_sum_phase(P, lds, bx, G, wave, lane); SEAM(8); }
    if (IN(9)) {
        pg8::Gemm g{HB, WG, M, D, D}; pg8::StaticOrder S; S.init(M, D, G, bx);
        EpiGate E{PROJ  , HB, PL, (const float*)(P.ws + WS_RS2), (float*)(P.ws + WS_RS3)};
        pg8::gemm_phase<EpiGate, pg8::StaticOrder, PG8_ALIGN, PG8_SP2>(lds, g, S, E);
        SEAM(9);
    }
    if (IN(10)) { final_phase(P, vcu, G, wave, lane); }
#undef IN
#undef SEAM
}

extern "C" void kernel_launch(void* const* d_in, const int* in_sizes, int n_in, void* d_out, int out_size, void* d_ws, size_t ws_size, hipStream_t stream) {
    static int grid = 0;
    if (grid == 0) {
        if (n_in != 17 || in_sizes[0] != M * D || out_size != M * D || ws_size < WS_END) { fprintf(stderr, "kernel_launch: unexpected shapes (n_in %d, in0 %d, out %d, ws %zu); nothing launched\n", n_in, n_in > 0 ? in_sizes[0] : -1, out_size, ws_size); grid = -1; return; }
        int dev = 0, cus = 0, per_cu = 0;
        if (hipGetDevice(&dev) != hipSuccess || hipDeviceGetAttribute(&cus, hipDeviceAttributeMultiprocessorCount, dev) != hipSuccess) { fprintf(stderr, "kernel_launch: device query failed\n"); grid = -1; return; }
        if (hipFuncSetAttribute((const void*)mega_fwd, hipFuncAttributeMaxDynamicSharedMemorySize, LDS_BYTES) != hipSuccess) { fprintf(stderr, "kernel_launch: hipFuncSetAttribute failed\n"); grid = -1; return; }
        if (hipOccupancyMaxActiveBlocksPerMultiprocessor(&per_cu, (const void*)mega_fwd, NWAVES * 64, LDS_BYTES) != hipSuccess || per_cu < 1) {
            fprintf(stderr, "kernel_launch: the occupancy query reports %d resident workgroups per CU for this kernel (512 threads, %d B LDS): the grid barrier needs one per CU; nothing launched\n", per_cu, LDS_BYTES);
            (void)hipGetLastError(); grid = -1; return; }
        grid = cus;
    }
    if (grid < 0) return;
    if (hipMemsetAsync((char*)d_ws + WS_CTL, 0, CTL_ZERO_BYTES, stream) != hipSuccess) { fprintf(stderr, "kernel_launch: memset failed\n"); return; }
    Args a{};
    for (int i = 0; i < 17; ++i) a.in[i] = (const float*)d_in[i];
    a.out = (float*)d_out; a.ws = (unsigned char*)d_ws;
#if MK_PER_PHASE
    for (int ph = 0; ph < NPHASES; ++ph) { a.ph_lo = ph; a.ph_hi = ph + 1; hipLaunchKernelGGL(mega_fwd, dim3(grid), dim3(NWAVES * 64), LDS_BYTES, stream, a); }
#else
    a.ph_lo = 0; a.ph_hi = NPHASES;
    hipLaunchKernelGGL(mega_fwd, dim3(grid), dim3(NWAVES * 64), LDS_BYTES, stream, a);
#endif
    const hipError_t le = hipPeekAtLastError();
    if (le != hipSuccess) fprintf(stderr, "kernel_launch: launch failed: %s\n", hipGetErrorName(le));
}
```

```cpp
#include <hip/hip_runtime.h>
#include <cstdio>
#include <cstdint>
namespace pg8 {
#define PG8_LAS __attribute__((address_space(3)))
typedef unsigned short bf16_t;
typedef short bf16x8 __attribute__((ext_vector_type(8)));
typedef float f32x4 __attribute__((ext_vector_type(4)));
typedef unsigned u32x4 __attribute__((ext_vector_type(4)));
constexpr int BM = 256, BK = 64, HALF = 128, HTB = HALF * BK * 2  , STAGE_BYTES = 8 * HTB, NXCD = 8, WGM = 8;

__host__ __device__ __forceinline__ int lds_byte(int r, int c) { const int st = (r >> 4) * 2 + (c >> 5), rr = r & 15, cc = c & 31, ob = rr * 64 + cc * 2; return st * 1024 + (ob ^ (((ob >> 9) & 1) << 5)); }
__host__ __device__ __forceinline__ void stage_rc(int b, int& R, int& C) { const int st = b / 1024, sb = b % 1024, swz = sb ^ (((sb >> 9) & 1) << 5); R = (st >> 1) * 16 + swz / 64; C = (st & 1) * 32 + (swz % 64) / 2; }
__host__ __device__ __forceinline__ int perm32(int rho) { const int n = rho >> 4, i = rho & 15; return 8 * (i >> 2) + 4 * n + (i & 3); }

struct Unit { int pm, pn; };
struct Gemm { const bf16_t* A; const bf16_t* Bt; int M, N, K; };

struct StaticOrder {
    int nM, nN, nwg, G, c;
    __host__ __device__ void init(int M, int N, int G_, int c_) { nM = M / BM; nN = N / BM; nwg = nM * nN; G = G_; c = c_; }
    __host__ __device__ bool next(int i, Unit& u) const {
        const long L = (long)i * G + c; if (L >= nwg) return false;
        int wgid = (int)L; { const int q = nwg / NXCD, r = nwg % NXCD, xcd = wgid % NXCD, off = wgid / NXCD; wgid = (xcd < r ? xcd * (q + 1) : r * (q + 1) + (xcd - r) * q) + off; }
        const int nig = WGM * nN, gid = wgid / nig, fm = gid * WGM, gsz = (nM - fm) < WGM ? (nM - fm) : WGM;
        u.pm = fm + ((wgid % nig) % gsz); u.pn = (wgid % nig) / gsz; return true;
    }
    __device__ __forceinline__ void a_ready(const Unit&) const {}
    __device__ __forceinline__ void done(const Unit&) const {}
};

__device__ __forceinline__ unsigned cvt_pk_bf16(float lo, float hi) { unsigned r; asm volatile("v_cvt_pk_bf16_f32 %0, %1, %2" : "=v"(r) : "v"(lo), "v"(hi)); return r; }
template <class Epi, class Sched, bool ALIGN_EPI = false, bool SP2 = false>
__device__ __forceinline__ void gemm_phase(PG8_LAS unsigned char* lds, const Gemm g, const Sched& S, const Epi& E) {
    const int tid = threadIdx.x, wid = __builtin_amdgcn_readfirstlane(tid >> 6), lane = tid & 63, wr = wid >> 2, wc = wid & 3, fr = lane & 15, fq = lane >> 4;
    const int K = g.K, nt = K / BK;
    unsigned voffA[2], voffB[2];
#pragma unroll
    for (int i = 0; i < 2; ++i) { int R, C; stage_rc(tid * 16 + i * 8192, R, C); const int Rb = Epi::PERM ? ((R & ~31) + perm32(R & 31)) : R;
        voffA[i] = (unsigned)(R * K + C) * 2u; voffB[i] = (unsigned)(Rb * K + C) * 2u; }
    const size_t kstep = (size_t)(BK * 2);
    const size_t hstep = (size_t)HALF * K * 2;
    const size_t tstep = 2 * hstep;
    const unsigned ldsw = (unsigned)wid * 1024u;
    const int aoff = lds_byte(wr * 64 + fr, fq * 8), boff = lds_byte(wc * 32 + fr, fq * 8);
#define PG8_SA(b, h) (((b) * 2 + (h)) * HTB)
#define PG8_SB(b, h) ((4 + (b) * 2 + (h)) * HTB)
#define PG8_STAGE(bufoff, gbase, voff) do { _Pragma("unroll") for (int _i = 0; _i < 2; ++_i) \
        __builtin_amdgcn_global_load_lds((const unsigned*)((const char*)(gbase) + (voff)[_i]), (PG8_LAS unsigned*)(lds + (bufoff) + ldsw + _i * 8192), 16, 0, 0); } while (0)
#define PG8_LDA(dst, b, h) do { _Pragma("unroll") for (int m = 0; m < 4; ++m) _Pragma("unroll") for (int k = 0; k < 2; ++k) dst[m][k] = *(const PG8_LAS bf16x8*)(lds + PG8_SA(b, h) + aoff + m * 2048 + k * 1024); } while (0)
#define PG8_LDB(dst, b, h) do { _Pragma("unroll") for (int n = 0; n < 2; ++n) _Pragma("unroll") for (int k = 0; k < 2; ++k) dst[n][k] = *(const PG8_LAS bf16x8*)(lds + PG8_SB(b, h) + boff + n * 2048 + k * 1024); } while (0)
#define PG8_MMA(ai, bj, At, Bt) do { __builtin_amdgcn_s_setprio(1); _Pragma("unroll") for (int m = 0; m < 4; ++m) _Pragma("unroll") for (int n = 0; n < 2; ++n) _Pragma("unroll") for (int k = 0; k < 2; ++k) \
        acc[ai][bj][m][n] = __builtin_amdgcn_mfma_f32_16x16x32_bf16(Bt[n][k], At[m][k], acc[ai][bj][m][n], 0, 0, 0); __builtin_amdgcn_s_setprio(0); } while (0)
#define PG8_WAIT_V(n) asm volatile("s_waitcnt vmcnt(" #n ")" ::: "memory")
#define PG8_WAIT_L(n) asm volatile("s_waitcnt lgkmcnt(" #n ")" ::: "memory")
#define PG8_BAR __builtin_amdgcn_s_barrier()
#define PG8_SCHED __builtin_amdgcn_sched_barrier(0)
    Unit cur, nxt; int ui = 0;
    if (!S.next(0, cur)) return;
    f32x4 acc[2][2][4][2];
#pragma unroll
    for (int a = 0; a < 2; ++a)
#pragma unroll
        for (int b = 0; b < 2; ++b)
#pragma unroll
            for (int m = 0; m < 4; ++m)
#pragma unroll
                for (int n = 0; n < 2; ++n) acc[a][b][m][n] = (f32x4){0.f, 0.f, 0.f, 0.f};
    bf16x8 At[4][2], B0[2][2], B1[2][2];
    const char* cA = (const char*)g.A + (size_t)cur.pm * tstep; const char* cB = (const char*)g.Bt + (size_t)cur.pn * tstep;
    S.a_ready(cur);
    if constexpr (SP2) {
        PG8_STAGE(PG8_SB(0, 0), cB, voffB); PG8_STAGE(PG8_SB(0, 1), cB + hstep, voffB); PG8_STAGE(PG8_SA(0, 0), cA, voffA); PG8_STAGE(PG8_SA(0, 1), cA + hstep, voffA);
        if (wr == 1) PG8_BAR;
        PG8_WAIT_V(2); PG8_BAR;
        PG8_STAGE(PG8_SB(1, 0), cB + kstep, voffB); PG8_STAGE(PG8_SA(1, 0), cA + kstep, voffA); PG8_STAGE(PG8_SB(1, 1), cB + hstep + kstep, voffB);
        PG8_WAIT_V(6); PG8_BAR;
    } else {
        PG8_STAGE(PG8_SB(0, 0), cB, voffB); PG8_STAGE(PG8_SA(0, 0), cA, voffA); PG8_STAGE(PG8_SB(0, 1), cB + hstep, voffB); PG8_STAGE(PG8_SA(0, 1), cA + hstep, voffA);
        if (wr == 1) PG8_BAR;
        PG8_WAIT_V(4); PG8_BAR;
        PG8_STAGE(PG8_SB(1, 0), cB + kstep, voffB); PG8_STAGE(PG8_SA(1, 0), cA + kstep, voffA); PG8_STAGE(PG8_SB(1, 1), cB + hstep + kstep, voffB);
        PG8_WAIT_V(6); PG8_BAR;
    }
    for (;;) {
        const bool has_next = S.next(ui + 1, nxt);
        const char* nA = has_next ? (const char*)g.A + (size_t)nxt.pm * tstep : cA; const char* nB = has_next ? (const char*)g.Bt + (size_t)nxt.pn * tstep : cB;
        for (int t = 0; t < nt; t += 2) {
            const bool last = (t == nt - 2);
            const char* a1 = cA + (size_t)(t + 1) * kstep;
            const char* a2 = last ? nA : cA + (size_t)(t + 2) * kstep; const char* b2 = last ? nB : cB + (size_t)(t + 2) * kstep;
            const char* a3 = a2 + kstep; const char* b3 = b2 + kstep;
            if (last && has_next) S.a_ready(nxt);
            if constexpr (SP2) {
            PG8_LDB(B0, 0, 0); PG8_LDB(B1, 0, 1); PG8_SCHED; PG8_LDA(At, 0, 0); PG8_STAGE(PG8_SA(1, 1), a1 + hstep, voffA);
            PG8_WAIT_V(8); PG8_WAIT_L(0); PG8_BAR; PG8_MMA(0, 0, At, B0); PG8_MMA(0, 1, At, B1); PG8_BAR; PG8_SCHED;
            PG8_LDA(At, 0, 1); PG8_STAGE(PG8_SB(0, 0), b2, voffB); PG8_STAGE(PG8_SB(0, 1), b2 + hstep, voffB); PG8_STAGE(PG8_SA(0, 0), a2, voffA);
            PG8_WAIT_V(8); PG8_WAIT_L(0); PG8_BAR; PG8_MMA(1, 0, At, B0); PG8_MMA(1, 1, At, B1); PG8_BAR; PG8_SCHED;
            PG8_LDB(B0, 1, 0); PG8_LDB(B1, 1, 1); PG8_SCHED; PG8_LDA(At, 1, 0); PG8_STAGE(PG8_SA(0, 1), a2 + hstep, voffA);
            PG8_WAIT_V(8); PG8_WAIT_L(0); PG8_BAR; PG8_MMA(0, 0, At, B0); PG8_MMA(0, 1, At, B1); PG8_BAR; PG8_SCHED;
            PG8_LDA(At, 1, 1); PG8_STAGE(PG8_SB(1, 0), b3, voffB); PG8_STAGE(PG8_SB(1, 1), b3 + hstep, voffB); PG8_STAGE(PG8_SA(1, 0), a3, voffA);
            PG8_WAIT_V(8); PG8_WAIT_L(0); PG8_BAR; PG8_MMA(1, 0, At, B0); PG8_MMA(1, 1, At, B1); PG8_BAR; PG8_SCHED;
            } else {
            PG8_LDB(B0, 0, 0); PG8_SCHED; PG8_LDA(At, 0, 0); PG8_STAGE(PG8_SA(1, 1), a1 + hstep, voffA);
            PG8_WAIT_L(8); PG8_BAR; PG8_WAIT_L(0); PG8_MMA(0, 0, At, B0); PG8_BAR; PG8_SCHED;
            PG8_LDB(B1, 0, 1); PG8_STAGE(PG8_SB(0, 0), b2, voffB);
            PG8_BAR; PG8_WAIT_L(0); PG8_MMA(0, 1, At, B1); PG8_BAR;
            PG8_LDA(At, 0, 1); PG8_STAGE(PG8_SA(0, 0), a2, voffA);
            PG8_BAR; PG8_WAIT_L(0); PG8_MMA(1, 0, At, B0); PG8_BAR; PG8_SCHED;
            PG8_STAGE(PG8_SB(0, 1), b2 + hstep, voffB);
            PG8_WAIT_V(6); PG8_BAR; PG8_MMA(1, 1, At, B1); PG8_BAR;
            PG8_LDB(B0, 1, 0); PG8_SCHED; PG8_LDA(At, 1, 0); PG8_STAGE(PG8_SA(0, 1), a2 + hstep, voffA);
            PG8_WAIT_L(8); PG8_BAR; PG8_WAIT_L(0); PG8_MMA(0, 0, At, B0); PG8_BAR; PG8_SCHED;
            PG8_LDB(B1, 1, 1); PG8_STAGE(PG8_SB(1, 0), b3, voffB);
            PG8_BAR; PG8_WAIT_L(0); PG8_MMA(0, 1, At, B1); PG8_BAR;
            PG8_LDA(At, 1, 1); PG8_STAGE(PG8_SA(1, 0), a3, voffA);
            PG8_BAR; PG8_WAIT_L(0); PG8_MMA(1, 0, At, B0); PG8_BAR; PG8_SCHED;
            PG8_STAGE(PG8_SB(1, 1), b3 + hstep, voffB);
            PG8_WAIT_V(6); PG8_BAR; PG8_MMA(1, 1, At, B1); PG8_BAR;
            }
        }
        if constexpr (ALIGN_EPI) { if (wr == 0) PG8_BAR; }
        if constexpr (!Epi::AFTER_DRAIN) { E(acc, cur, wr, wc, fr, fq);
            if constexpr (Epi::TWICE) { asm volatile("" ::: "memory"); E(acc, cur, wr, wc, fr, fq); }
            S.done(cur); }
        if (!has_next) break;
#pragma unroll
        for (int a = 0; a < 2; ++a)
#pragma unroll
            for (int b = 0; b < 2; ++b)
#pragma unroll
                for (int m = 0; m < 4; ++m)
#pragma unroll
                    for (int n = 0; n < 2; ++n) acc[a][b][m][n] = (f32x4){0.f, 0.f, 0.f, 0.f};
        cur = nxt; cA = nA; cB = nB; ++ui;
        if constexpr (ALIGN_EPI) { if (wr == 1) PG8_BAR; }
    }
    PG8_WAIT_V(0);
    if constexpr (!ALIGN_EPI) { if (wr == 0) PG8_BAR; }
    PG8_BAR;
    if constexpr (Epi::AFTER_DRAIN) { E.fused(acc, cur, wr, wc, fr, fq, lds, wid, lane); S.done(cur); }
#undef PG8_SA
#undef PG8_SB
#undef PG8_STAGE
#undef PG8_LDA
#undef PG8_LDB
#undef PG8_MMA
#undef PG8_WAIT_V
#undef PG8_WAIT_L
#undef PG8_BAR
#undef PG8_SCHED
}
}

#define GAS __attribute__((address_space(1)))
#define LAS __attribute__((address_space(3)))
typedef unsigned short bf16;
typedef unsigned v4u __attribute__((ext_vector_type(4)));
typedef float f32x4 __attribute__((ext_vector_type(4)));
typedef short bf16x8 __attribute__((ext_vector_type(8)));
typedef GAS unsigned gu32;
typedef GAS unsigned long long gu64;
#define RLX_AGENT __ATOMIC_RELAXED, __HIP_MEMORY_SCOPE_AGENT
#define LDS_WAIT() asm volatile("s_waitcnt lgkmcnt(0)" ::: "memory")
#define VM_WAIT() asm volatile("s_waitcnt vmcnt(0)" ::: "memory")
__device__ __forceinline__ unsigned long long rt() { return __builtin_amdgcn_s_memrealtime(); }
__device__ __forceinline__ unsigned f2bf(float f) { unsigned u = __builtin_bit_cast(unsigned, f); return (u + 0x7fffu + ((u >> 16) & 1u)) >> 16; }
__device__ __forceinline__ unsigned pk2(float lo, float hi) { return f2bf(lo) | (f2bf(hi) << 16); }

#define XB_TMO      128
#define XB_XCNT(j)  (256  + 64 * (j))
#define XB_XSUB(j)  (1280 + 64 * (j))
#define XB_XGEN(j)  (2304 + 64 * (j))
#define XB_TOP      3328
#define XB_TOPGEN   3392
#define XCD_BAR_WORDS 3456
#define XB_SPIN_CAP (1u << 18)

__device__ __forceinline__ unsigned xb_ld(unsigned* p)              { return __hip_atomic_load(p, __ATOMIC_RELAXED, __HIP_MEMORY_SCOPE_AGENT); }
__device__ __forceinline__ unsigned xb_add(unsigned* p, unsigned v) { return __hip_atomic_fetch_add(p, v, __ATOMIC_RELAXED, __HIP_MEMORY_SCOPE_AGENT); }
__device__ __forceinline__ unsigned xb_xcc_id() { return (unsigned)__builtin_amdgcn_s_getreg((3 << 11) | 20) & 0xFu; }
#define XB_SPIN(cond, bar) do { unsigned _sp = 0; while (cond) { __builtin_amdgcn_s_sleep(1); \
    if ((++_sp & 255u) == 0u) { if (xb_ld(&(bar)[XB_TMO])) break; if (_sp > XB_SPIN_CAP) { atomicAdd(&(bar)[XB_TMO], 1u); break; } } } } while (0)

struct XcdBarrier {
    unsigned* bar; unsigned x;
    volatile LAS unsigned* st;
};

__device__ __forceinline__ XcdBarrier xcd_barrier_post(unsigned* bar, volatile LAS unsigned* st) {
    XcdBarrier b; b.bar = bar; b.x = xb_xcc_id(); b.st = st;
    if (threadIdx.x == 0) (void)xb_add(&bar[XB_XCNT(b.x)], 1u);
    return b;
}
__device__ __forceinline__ void xcd_barrier_complete(unsigned* bar, unsigned x, unsigned& nloc, unsigned& nx) {
    const unsigned G = gridDim.x * gridDim.y * gridDim.z;
    unsigned sum, cnt, mine, sp = 0u;
    for (;;) {
        sum = 0u; cnt = 0u; mine = 0u;
#pragma unroll
        for (unsigned j = 0; j < 16; ++j) { const unsigned c = xb_ld(&bar[XB_XCNT(j)]); sum += c; cnt += (c > 0u) ? 1u : 0u; mine = (j == x) ? c : mine; }
        if (sum == G) break;
        __builtin_amdgcn_s_sleep(1);
        if ((++sp & 255u) == 0u) { if (xb_ld(&bar[XB_TMO])) break; if (sp > XB_SPIN_CAP) { atomicAdd(&bar[XB_TMO], 1u); break; } }
    }
    nloc = mine > 0u ? mine : 1u; nx = cnt > 0u ? cnt : 1u;
}

__device__ __forceinline__ void xcd_barrier(const XcdBarrier& b) {
    asm volatile("s_waitcnt vmcnt(0)" ::: "memory");
    __syncthreads();
    if (threadIdx.x == 0) {
        unsigned* bar = b.bar;
        __builtin_amdgcn_s_waitcnt(0);
        unsigned nloc = b.st[0], nx = b.st[1];
        if (nloc == 0u) { xcd_barrier_complete(bar, b.x, nloc, nx); b.st[0] = nloc; b.st[1] = nx; }
        const unsigned old = xb_add(&bar[XB_XSUB(b.x)], 1u);
        const unsigned gen = old / nloc;
        if (old + 1u == (gen + 1u) * nloc) {
            __builtin_amdgcn_fence(__ATOMIC_RELEASE, "agent");
            asm volatile("s_waitcnt vmcnt(0)" ::: "memory");
            const unsigned og = xb_add(&bar[XB_TOP], 1u);
            const unsigned tg = og / nx;
            if (og + 1u == (tg + 1u) * nx) xb_add(&bar[XB_TOPGEN], 1u);
            else XB_SPIN(xb_ld(&bar[XB_TOPGEN]) == tg, bar);
            __builtin_amdgcn_fence(__ATOMIC_ACQUIRE, "agent");
            xb_add(&bar[XB_XGEN(b.x)], 1u);
            asm volatile("s_waitcnt vmcnt(0)" ::: "memory");
        } else {
            XB_SPIN(xb_ld(&bar[XB_XGEN(b.x)]) == gen, bar);
            __builtin_amdgcn_fence(__ATOMIC_ACQUIRE, "agent");
            asm volatile("s_waitcnt vmcnt(0)" ::: "memory");
        }
    }
    __syncthreads();
}

#ifndef PROBE_REP
#define PROBE_REP 0
#endif
#define REPS(k) ((PROBE_REP == (k)) ? 2 : 1)
constexpr int NWAVES = 8;
constexpr int M = 32768, D = 1024, SEQ = 4096, NPROJ = 2048, NQ = 2048, PLED = 256, NEXP = 16384;
constexpr float EPS = 1e-6f;
#ifndef MK_PER_PHASE
#define MK_PER_PHASE 0
#endif
constexpr int D2NS = 4;
constexpr int D2HV = 4 / D2NS, D2PIECE = 128 * D2HV;
constexpr int NPHASES = 11;

constexpr size_t MiB = 1u << 20;
constexpr size_t WS_CTL = 0, CTL_ZERO_BYTES = 1 * MiB;
constexpr size_t WS_WIN = 2 * MiB, WS_WO = 6 * MiB, WS_WQ = 8 * MiB, WS_WG = 12 * MiB, WS_WP = 14 * MiB, WS_KEYS = 14 * MiB + 512 * 1024;
constexpr size_t WS_WF = 15 * MiB;
constexpr size_t WS_RSX = 17 * MiB, WS_RS1 = 18 * MiB, WS_RS3 = 20 * MiB, WS_RS2 = 23 * MiB;
constexpr size_t WS_SU = 22 * MiB, WS_SV = 22 * MiB + 65536;
constexpr size_t WS_U = 24 * MiB, WS_V = 56 * MiB;
constexpr size_t WS_XB = 88 * MiB;
constexpr size_t WS_PROJ = 152 * MiB;
constexpr size_t WS_MIX = 280 * MiB;
constexpr size_t WS_CF = WS_MIX;
constexpr size_t WS_HB = 344 * MiB;
constexpr size_t WS_EIDX = 408 * MiB, WS_GATE = 424 * MiB;
constexpr size_t WS_PB = 440 * MiB;
constexpr size_t WS_EOFF = 456 * MiB;
constexpr size_t WS_END = 472 * MiB;
constexpr int CW_BAR = 4096;
static_assert((CW_BAR + XCD_BAR_WORDS) * 4 <= (int)CTL_ZERO_BYTES, "CTL words inside the memset region");

constexpr int RING_BYTES = 131072;
constexpr int LDSCTL_OFF = RING_BYTES, MISC_OFF = LDSCTL_OFF + 320;
constexpr int LDS_BYTES = 147456;

typedef float f32x16 __attribute__((ext_vector_type(16)));
typedef _Float16 h2_t __attribute__((ext_vector_type(2)));
typedef float f32x2 __attribute__((ext_vector_type(2)));
typedef int i32x4 __attribute__((ext_vector_type(4)));
typedef unsigned v2u __attribute__((ext_vector_type(2)));

__device__ __forceinline__ float wave_sum(float v) {
    v += __builtin_bit_cast(float, __builtin_amdgcn_mov_dpp(__builtin_bit_cast(int, v), 0xB1, 0xF, 0xF, true));
    v += __builtin_bit_cast(float, __builtin_amdgcn_mov_dpp(__builtin_bit_cast(int, v), 0x4E, 0xF, 0xF, true));
    v += __builtin_bit_cast(float, __builtin_amdgcn_mov_dpp(__builtin_bit_cast(int, v), 0x124, 0xF, 0xF, true));
    v += __builtin_bit_cast(float, __builtin_amdgcn_mov_dpp(__builtin_bit_cast(int, v), 0x128, 0xF, 0xF, true));
    const float r0 = __builtin_bit_cast(float, __builtin_amdgcn_readlane(__builtin_bit_cast(int, v), 0)), r1 = __builtin_bit_cast(float, __builtin_amdgcn_readlane(__builtin_bit_cast(int, v), 16));
    const float r2 = __builtin_bit_cast(float, __builtin_amdgcn_readlane(__builtin_bit_cast(int, v), 32)), r3 = __builtin_bit_cast(float, __builtin_amdgcn_readlane(__builtin_bit_cast(int, v), 48));
    return (r0 + r1) + (r2 + r3);
}
__device__ __forceinline__ float bf_lo(unsigned w) { return __uint_as_float(w << 16); }
__device__ __forceinline__ float bf_hi(unsigned w) { return __uint_as_float(w & 0xffff0000u); }
__device__ __forceinline__ unsigned pkh(float lo, float hi) { f32x2 v = {lo, hi}; h2_t h = __builtin_convertvector(v, h2_t); return __builtin_bit_cast(unsigned, h); }

struct EpiProj {
    static constexpr bool PERM = true, AFTER_DRAIN = false, TWICE = false;
    pg8::bf16_t* O; const float* rowss;
    __device__ __forceinline__ void operator()(const pg8::f32x4 (&acc)[2][2][4][2], const pg8::Unit& u, int wr, int wc, int fr, int fq) const {
        const int row0 = u.pm * 256 + wr * 64 + fr, cw = wc * 32 + 8 * fq; const int pn = u.pn;
        const bool prod = (pn >= 2) && (pn < 6);
        const int cbase = prod ? 512 + (pn - 2) * 128 : (pn < 2 ? pn * 256 : 1024 + (pn - 6) * 256);
#pragma unroll
        for (int ai = 0; ai < 2; ++ai)
#pragma unroll
            for (int m = 0; m < 4; ++m) {
                const int row = row0 + ai * 128 + m * 16;
                const float sc = __builtin_amdgcn_rsqf(rowss[row] * (1.0f / 1024.0f) + EPS);
                pg8::bf16_t* rowp = O + (size_t)row * 1536 + cbase + cw;
                if (prod) {
                    const float s2 = sc * sc;
                    const pg8::f32x4 v0 = acc[ai][0][m][0] * acc[ai][1][m][0] * s2, v1 = acc[ai][0][m][1] * acc[ai][1][m][1] * s2;
                    pg8::u32x4 w; w.x = pg8::cvt_pk_bf16(v0[0], v0[1]); w.y = pg8::cvt_pk_bf16(v0[2], v0[3]); w.z = pg8::cvt_pk_bf16(v1[0], v1[1]); w.w = pg8::cvt_pk_bf16(v1[2], v1[3]);
                    *(pg8::u32x4*)rowp = w;
                } else {
#pragma unroll
                    for (int bj = 0; bj < 2; ++bj) {
                        const pg8::f32x4 v0 = acc[ai][bj][m][0] * sc, v1 = acc[ai][bj][m][1] * sc;
                        pg8::u32x4 w; w.x = pg8::cvt_pk_bf16(v0[0], v0[1]); w.y = pg8::cvt_pk_bf16(v0[2], v0[3]); w.z = pg8::cvt_pk_bf16(v1[0], v1[1]); w.w = pg8::cvt_pk_bf16(v1[2], v1[3]);
                        *(pg8::u32x4*)(rowp + bj * 128) = w;
                    }
                }
            }
    }
};
struct EpiBf16Row {
    static constexpr bool PERM = true, AFTER_DRAIN = false, TWICE = (PROBE_REP == 12);
    pg8::bf16_t* O; int ldc; const float* rowss;
    __device__ __forceinline__ void operator()(const pg8::f32x4 (&acc)[2][2][4][2], const pg8::Unit& u, int wr, int wc, int fr, int fq) const {
        const int row0 = u.pm * 256 + wr * 64 + fr, col0 = u.pn * 256 + wc * 32 + 8 * fq;
#pragma unroll
        for (int ai = 0; ai < 2; ++ai)
#pragma unroll
            for (int m = 0; m < 4; ++m) {
                const int row = row0 + ai * 128 + m * 16;
                const float sc = rowss ? __builtin_amdgcn_rsqf(rowss[row] * (1.0f / 1024.0f) + EPS) : 1.0f;
                pg8::bf16_t* rowp = O + (size_t)row * ldc + col0;
#pragma unroll
                for (int bj = 0; bj < 2; ++bj) {
                    const pg8::f32x4 v0 = acc[ai][bj][m][0] * sc, v1 = acc[ai][bj][m][1] * sc;
                    pg8::u32x4 w; w.x = pg8::cvt_pk_bf16(v0[0], v0[1]); w.y = pg8::cvt_pk_bf16(v0[2], v0[3]); w.z = pg8::cvt_pk_bf16(v1[0], v1[1]); w.w = pg8::cvt_pk_bf16(v1[2], v1[3]);
                    *(pg8::u32x4*)(rowp + bj * 128) = w;
                }
            }
    }
};
struct EpiH1 {
    static constexpr bool PERM = true, AFTER_DRAIN = false, TWICE = (PROBE_REP == 13);
    const float* X; pg8::bf16_t* HB; float* RS;
    __device__ __forceinline__ void operator()(const pg8::f32x4 (&acc)[2][2][4][2], const pg8::Unit& u, int wr, int wc, int fr, int fq) const {
        const int row0 = u.pm * 256 + wr * 64 + fr, col0 = u.pn * 256 + wc * 32 + 8 * fq;
#pragma unroll
        for (int ai = 0; ai < 2; ++ai)
#pragma unroll
            for (int m = 0; m < 4; ++m) {
                const int row = row0 + ai * 128 + m * 16; float s = 0.f;
#pragma unroll
                for (int bj = 0; bj < 2; ++bj) {
                    const size_t off = (size_t)row * 1024 + col0 + bj * 128;
                    const pg8::f32x4 x0 = *(const pg8::f32x4*)(X + off), x1 = *(const pg8::f32x4*)(X + off + 4);
                    const pg8::f32x4 v0 = acc[ai][bj][m][0] + x0, v1 = acc[ai][bj][m][1] + x1;
                    pg8::u32x4 w; w.x = pg8::cvt_pk_bf16(v0[0], v0[1]); w.y = pg8::cvt_pk_bf16(v0[2], v0[3]); w.z = pg8::cvt_pk_bf16(v1[0], v1[1]); w.w = pg8::cvt_pk_bf16(v1[2], v1[3]);
                    *(pg8::u32x4*)(HB + off) = w;
                    s += (v0[0] * v0[0] + v0[1] * v0[1]) + (v0[2] * v0[2] + v0[3] * v0[3]) + (v1[0] * v1[0] + v1[1] * v1[1]) + (v1[2] * v1[2] + v1[3] * v1[3]);
                }
                s += __shfl_xor(s, 16); s += __shfl_xor(s, 32);
                if (fq == 0) RS[(size_t)row * 16 + u.pn * 4 + wc] = s;
            }
    }
};
struct EpiGate {
    static constexpr bool PERM = true, AFTER_DRAIN = false, TWICE = (PROBE_REP == 14);
    pg8::bf16_t* OUT; const pg8::bf16_t* HB; const pg8::bf16_t* PL; const float* RS2; float* RS3;
    __device__ __forceinline__ void operator()(const pg8::f32x4 (&acc)[2][2][4][2], const pg8::Unit& u, int wr, int wc, int fr, int fq) const {
        const int row0 = u.pm * 256 + wr * 64 + fr, col0 = u.pn * 256 + wc * 32 + 8 * fq;
#pragma unroll
        for (int ai = 0; ai < 2; ++ai)
#pragma unroll
            for (int m = 0; m < 4; ++m) {
                const int row = row0 + ai * 128 + m * 16; float s = 0.f;
                float rs2 = 0.f;
#pragma unroll
                for (int k = 0; k < D2NS; ++k) rs2 += RS2[(size_t)row * D2NS + k];
                const float rstd = __builtin_amdgcn_rsqf(rs2 * (1.0f / 1024.0f) + EPS);
#pragma unroll
                for (int bj = 0; bj < 2; ++bj) {
                    const size_t off = (size_t)row * 1024 + col0 + bj * 128;
                    const pg8::u32x4 w = *(const pg8::u32x4*)(PL + off), hw = *(const pg8::u32x4*)(HB + off);
                    const pg8::f32x4 h0 = {bf_lo(hw.x), bf_hi(hw.x), bf_lo(hw.y), bf_hi(hw.y)}, h1 = {bf_lo(hw.z), bf_hi(hw.z), bf_lo(hw.w), bf_hi(hw.w)};
                    const pg8::f32x4 a0 = acc[ai][bj][m][0] * rstd, a1 = acc[ai][bj][m][1] * rstd;
                    pg8::f32x4 g0, g1;
#pragma unroll
                    for (int e = 0; e < 4; ++e) { g0[e] = 1.0f / (1.0f + __expf(-a0[e])); g1[e] = 1.0f / (1.0f + __expf(-a1[e])); }
                    const pg8::f32x4 p0 = {bf_lo(w.x), bf_hi(w.x), bf_lo(w.y), bf_hi(w.y)}, p1 = {bf_lo(w.z), bf_hi(w.z), bf_lo(w.w), bf_hi(w.w)};
                    const pg8::f32x4 v0 = h0 + g0 * p0, v1 = h1 + g1 * p1;
                    { pg8::u32x4 ow; ow.x = pg8::cvt_pk_bf16(v0[0], v0[1]); ow.y = pg8::cvt_pk_bf16(v0[2], v0[3]); ow.z = pg8::cvt_pk_bf16(v1[0], v1[1]); ow.w = pg8::cvt_pk_bf16(v1[2], v1[3]); *(pg8::u32x4*)(OUT + off) = ow; }
                    s += (v0[0] * v0[0] + v0[1] * v0[1]) + (v0[2] * v0[2] + v0[3] * v0[3]) + (v1[0] * v1[0] + v1[1] * v1[1]) + (v1[2] * v1[2] + v1[3] * v1[3]);
                }
                s += __shfl_xor(s, 16); s += __shfl_xor(s, 32);
                if (fq == 0) RS3[(size_t)row * 16 + u.pn * 4 + wc] = s;
            }
    }
};

__device__ __forceinline__ void p0_transpose_item(const float* W, int ldn, const float* gk, int K, bf16* WT, int row_off, int nblk, LAS float* scr, int item, int lane) {
    const int kb = item / nblk, nb = item % nblk, k0 = 64 * kb, n0 = 32 * nb;
    float wv[32];
#pragma unroll
    for (int i = 0; i < 32; ++i) wv[i] = W[(size_t)(k0 + 2 * i + (lane >> 5)) * ldn + n0 + (lane & 31)];
#pragma unroll
    for (int i = 0; i < 32; ++i) { const int kk = 2 * i + (lane >> 5); float v = wv[i]; if (gk) v *= gk[k0 + kk]; scr[kk * 33 + (lane & 31)] = v; }
    LDS_WAIT(); asm volatile("" ::: "memory");
    const int c = lane & 7;
#pragma unroll
    for (int j = 0; j < 4; ++j) { const int n = (lane >> 3) + 8 * j; const LAS float* s = scr + (8 * c) * 33 + n;
        v4u o; o.x = pk2(s[0 * 33], s[1 * 33]); o.y = pk2(s[2 * 33], s[3 * 33]); o.z = pk2(s[4 * 33], s[5 * 33]); o.w = pk2(s[6 * 33], s[7 * 33]);
        *(GAS v4u*)(WT + (size_t)(row_off + n0 + n) * K + k0 + 8 * c) = o; }
    LDS_WAIT(); asm volatile("" ::: "memory");
}

struct Ptrs {
    const float *x, *p, *g_mix, *w_in, *conv_w, *pool_w, *pool_scale, *w_o, *g_ffn, *w_q, *sub_keys, *eu, *ev, *g_ple, *w_gate, *w_proj, *g_final;
    float* out; unsigned char* ws;
};

__device__ __forceinline__ void p0a_phase(const Ptrs& P, LAS unsigned char* lds, int vcu, int G, int tid, int wave, int lane) {
    const int gw = vcu * 4 + (wave & 3), NGW = G * 4;
    const int gt = gw * 64 + lane, NGT = NGW * 64;
    if (wave < 4) {
    { float* Wf = (float*)(P.ws + WS_WF);
      for (int tk = gw; tk < 2048; tk += NGW) {
          const int k4 = (tk >> 3) * 4, j = tk & 7, g = j >> 1, np = j * 64 + lane, d = np & 127;
          const float* wi = P.w_in + (size_t)k4 * 2048 + 1536 + g * 128; const float* pw = P.pool_w + (size_t)g * 128 * 128 + d;
          float a0 = 0.f, a1 = 0.f, a2 = 0.f, a3 = 0.f;
          for (int c0 = 0; c0 < 128; c0 += 16) {
              float pv[16], w0[16], w1[16], w2[16], w3[16];
#pragma unroll
              for (int c = 0; c < 16; ++c) { pv[c] = pw[(size_t)(c0 + c) * 128]; w0[c] = wi[c0 + c]; w1[c] = wi[2048 + c0 + c]; w2[c] = wi[4096 + c0 + c]; w3[c] = wi[6144 + c0 + c]; }
#pragma unroll
              for (int c = 0; c < 16; ++c) { a0 += w0[c] * pv[c]; a1 += w1[c] * pv[c]; a2 += w2[c] * pv[c]; a3 += w3[c] * pv[c]; }
          }
          const float sc = P.pool_scale[np];
          Wf[(size_t)k4 * 512 + np] = a0 * sc; Wf[(size_t)(k4 + 1) * 512 + np] = a1 * sc; Wf[(size_t)(k4 + 2) * 512 + np] = a2 * sc; Wf[(size_t)(k4 + 3) * 512 + np] = a3 * sc;
      } }
    { LAS float* scr = (LAS float*)(lds + wave * 16384);
      constexpr int I_WO = 16 * 32, I_WQ = 16 * 64, I_WG = 16 * 32, I_WP = 4 * 32, I_WINA = 16 * 48;
      constexpr int NITEMS = I_WO + I_WQ + I_WG + I_WP + I_WINA;
      for (int it = gw; it < NITEMS; it += NGW) {
          int r = it;
          if (r < I_WO) { p0_transpose_item(P.w_o, 1024, nullptr, 1024, (bf16*)(P.ws + WS_WO), 0, 32, scr, r, lane); continue; } r -= I_WO;
          if (r < I_WQ) { p0_transpose_item(P.w_q, 2048, P.g_ffn, 1024, (bf16*)(P.ws + WS_WQ), 0, 64, scr, r, lane); continue; } r -= I_WQ;
          if (r < I_WG) { p0_transpose_item(P.w_gate, 1024, P.g_ple, 1024, (bf16*)(P.ws + WS_WG), 0, 32, scr, r, lane); continue; } r -= I_WG;
          if (r < I_WP) { p0_transpose_item(P.w_proj, 1024, nullptr, 256, (bf16*)(P.ws + WS_WP), 0, 32, scr, r, lane); continue; } r -= I_WP;
          {
            const int nb = r % 48, n0 = 32 * nb; int sc0 = n0;
            if (n0 >= 512) { const int jj = (n0 - 512) >> 8, rr = (n0 - 512) & 255; sc0 = rr < 128 ? 512 + 128 * jj + rr : 1024 + 128 * jj + (rr - 128); }
            p0_transpose_item(P.w_in + (sc0 - n0), 2048, P.g_mix, 1024, (bf16*)(P.ws + WS_WIN), 0, 48, scr, r, lane); }
      } }
    } else {
    { for (int r0 = 4 * gw; r0 < NEXP; r0 += 4 * NGW) {
          f32x4 a[4][4]; float q[4];
#pragma unroll
          for (int rr = 0; rr < 4; ++rr) { const GAS f32x4* src = (const GAS f32x4*)(P.eu + (size_t)(r0 + rr) * 1024);
#pragma unroll
              for (int j = 0; j < 4; ++j) a[rr][j] = src[4 * lane + j]; }
          { const GAS f32x4* gf = (const GAS f32x4*)P.g_ffn + 4 * lane;
#pragma unroll
            for (int j = 0; j < 4; ++j) { const f32x4 g = gf[j];
#pragma unroll
                for (int rr = 0; rr < 4; ++rr) a[rr][j] = a[rr][j] * g; } }
#pragma unroll
          for (int rr = 0; rr < 4; ++rr) { q[rr] = 0.f;
#pragma unroll
              for (int j = 0; j < 4; ++j) q[rr] += (a[rr][j].x * a[rr][j].x + a[rr][j].y * a[rr][j].y) + (a[rr][j].z * a[rr][j].z + a[rr][j].w * a[rr][j].w); }
          q[0] = wave_sum(q[0]); q[1] = wave_sum(q[1]); q[2] = wave_sum(q[2]); q[3] = wave_sum(q[3]);
#pragma unroll
          for (int rr = 0; rr < 4; ++rr) { const int e = r0 + rr;
              const float rms = sqrtf(q[rr] * (1.0f / 1024.0f)); const float sc = rms > 0.f ? 2.0f / rms : 0.f;
              unsigned w0 = 0u, w1 = 0u;
              w0 = __builtin_amdgcn_cvt_scalef32_pk_fp4_f32(w0, a[rr][0].x * sc, a[rr][0].y * sc, 1.0f, 0); w0 = __builtin_amdgcn_cvt_scalef32_pk_fp4_f32(w0, a[rr][0].z * sc, a[rr][0].w * sc, 1.0f, 1);
              w0 = __builtin_amdgcn_cvt_scalef32_pk_fp4_f32(w0, a[rr][1].x * sc, a[rr][1].y * sc, 1.0f, 2); w0 = __builtin_amdgcn_cvt_scalef32_pk_fp4_f32(w0, a[rr][1].z * sc, a[rr][1].w * sc, 1.0f, 3);
              w1 = __builtin_amdgcn_cvt_scalef32_pk_fp4_f32(w1, a[rr][2].x * sc, a[rr][2].y * sc, 1.0f, 0); w1 = __builtin_amdgcn_cvt_scalef32_pk_fp4_f32(w1, a[rr][2].z * sc, a[rr][2].w * sc, 1.0f, 1);
              w1 = __builtin_amdgcn_cvt_scalef32_pk_fp4_f32(w1, a[rr][3].x * sc, a[rr][3].y * sc, 1.0f, 2); w1 = __builtin_amdgcn_cvt_scalef32_pk_fp4_f32(w1, a[rr][3].z * sc, a[rr][3].w * sc, 1.0f, 3);
              ((GAS v2u*)(P.ws + WS_U))[(size_t)e * 64 + lane] = (v2u){w0, w1};
              if (lane == 0) ((float*)(P.ws + WS_SU))[e] = rms * 0.5f; }
      } }
    { const int ci = lane >> 2, cb = lane & 3; const int eoff = 256 * cb + 64 * (ci >> 2) + (ci & 3);
      for (int r0 = 2 * gw; r0 < NEXP; r0 += 2 * NGW) {
          float v[2][16]; float q[2];
#pragma unroll
          for (int rr = 0; rr < 2; ++rr) { const float* src = P.ev + (size_t)(r0 + rr) * 1024 + eoff;
#pragma unroll
              for (int n = 0; n < 16; ++n) v[rr][n] = src[4 * n]; }
#pragma unroll
          for (int rr = 0; rr < 2; ++rr) { q[rr] = 0.f;
#pragma unroll
              for (int n = 0; n < 16; ++n) q[rr] += v[rr][n] * v[rr][n]; }
          q[0] = wave_sum(q[0]); q[1] = wave_sum(q[1]);
#pragma unroll
          for (int rr = 0; rr < 2; ++rr) { const int e = r0 + rr;
              const float rms = sqrtf(q[rr] * (1.0f / 1024.0f)); const float sc = rms > 0.f ? 2.0f / rms : 0.f;
              unsigned w0 = 0u, w1 = 0u;
              w0 = __builtin_amdgcn_cvt_scalef32_pk_fp4_f32(w0, v[rr][0] * sc, v[rr][1] * sc, 1.0f, 0); w0 = __builtin_amdgcn_cvt_scalef32_pk_fp4_f32(w0, v[rr][2] * sc, v[rr][3] * sc, 1.0f, 1);
              w0 = __builtin_amdgcn_cvt_scalef32_pk_fp4_f32(w0, v[rr][4] * sc, v[rr][5] * sc, 1.0f, 2); w0 = __builtin_amdgcn_cvt_scalef32_pk_fp4_f32(w0, v[rr][6] * sc, v[rr][7] * sc, 1.0f, 3);
              w1 = __builtin_amdgcn_cvt_scalef32_pk_fp4_f32(w1, v[rr][8] * sc, v[rr][9] * sc, 1.0f, 0); w1 = __builtin_amdgcn_cvt_scalef32_pk_fp4_f32(w1, v[rr][10] * sc, v[rr][11] * sc, 1.0f, 1);
              w1 = __builtin_amdgcn_cvt_scalef32_pk_fp4_f32(w1, v[rr][12] * sc, v[rr][13] * sc, 1.0f, 2); w1 = __builtin_amdgcn_cvt_scalef32_pk_fp4_f32(w1, v[rr][14] * sc, v[rr][15] * sc, 1.0f, 3);
              ((GAS v2u*)(P.ws + WS_V + (size_t)(cb / D2HV) * ((size_t)NEXP * D2PIECE) + (size_t)e * D2PIECE + (cb % D2HV) * 128))[ci] = (v2u){w0, w1};
              if (lane == 0) ((float*)(P.ws + WS_SV))[e] = rms * 0.5f; }
      } }
    { const GAS f32x4* sp = (const GAS f32x4*)P.p; GAS v4u* dp = (GAS v4u*)(P.ws + WS_PB);
      for (int i0 = gt; i0 < M * PLED / 8; i0 += 4 * NGT) {
          f32x4 a[4], b[4];
#pragma unroll
          for (int q = 0; q < 4; ++q) { const int i = i0 + q * NGT; if (i < M * PLED / 8) { a[q] = sp[2 * (size_t)i]; b[q] = sp[2 * (size_t)i + 1]; } }
#pragma unroll
          for (int q = 0; q < 4; ++q) { const int i = i0 + q * NGT; if (i < M * PLED / 8) { v4u o; o.x = pk2(a[q].x, a[q].y); o.y = pk2(a[q].z, a[q].w); o.z = pk2(b[q].x, b[q].y); o.w = pk2(b[q].z, b[q].w); dp[i] = o; } }
      }
      const GAS f32x4* sk = (const GAS f32x4*)P.sub_keys; GAS v4u* dk = (GAS v4u*)(P.ws + WS_KEYS);
      for (int i = gt; i < 16 * 128 * 128 / 8; i += NGT) { const f32x4 a = sk[2 * (size_t)i], b = sk[2 * (size_t)i + 1]; v4u o; o.x = pk2(a.x, a.y); o.y = pk2(a.z, a.w); o.z = pk2(b.x, b.y); o.w = pk2(b.z, b.w); dk[i] = o; } }
    { float* RSX = (float*)(P.ws + WS_RSX); bf16* XB = (bf16*)(P.ws + WS_XB);
      for (int m0 = 4 * gw; m0 < M; m0 += 4 * NGW) {
          f32x4 v[4][4]; float sq[4];
#pragma unroll
          for (int r = 0; r < 4; ++r) { const GAS f32x4* xr = (const GAS f32x4*)(P.x + (size_t)(m0 + r) * D) + lane;
#pragma unroll
              for (int j = 0; j < 4; ++j) v[r][j] = xr[64 * j]; }
#pragma unroll
          for (int r = 0; r < 4; ++r) { sq[r] = 0.f;
#pragma unroll
              for (int j = 0; j < 4; ++j) sq[r] += (v[r][j].x * v[r][j].x + v[r][j].y * v[r][j].y) + (v[r][j].z * v[r][j].z + v[r][j].w * v[r][j].w); }
#pragma unroll
          for (int r = 0; r < 4; ++r) sq[r] = wave_sum(sq[r]);
#pragma unroll
          for (int r = 0; r < 4; ++r) { if (lane == 0) RSX[m0 + r] = sq[r];
              GAS unsigned long long* o8 = (GAS unsigned long long*)(XB + (size_t)(m0 + r) * D) + lane;
#pragma unroll
              for (int j = 0; j < 4; ++j) o8[64 * j] = (unsigned long long)pk2(v[r][j].x, v[r][j].y) | ((unsigned long long)pk2(v[r][j].z, v[r][j].w) << 32); }
      } }
    }
}
__device__ __forceinline__ void p0b_phase(const Ptrs& P, LAS unsigned char* lds, int vcu, int G, int wave, int lane) {
    const int gw = vcu * NWAVES + wave, NGW = G * NWAVES; LAS float* scr = (LAS float*)(lds + wave * 16384);
    for (int it = gw; it < 16 * 16; it += NGW) p0_transpose_item((const float*)(P.ws + WS_WF), 512, P.g_mix, 1024, (bf16*)(P.ws + WS_WIN), 1536, 16, scr, it, lane);
}

template <int HALF>
__device__ __forceinline__ void pool_chunk(const unsigned* col, unsigned* mx, int t0, int s0) {
    constexpr int TC = 32, NV = TC + 2 * HALF;
    float v0[NV], v1[NV];
#pragma unroll
    for (int i = 0; i < NV; ++i) {
        const int s = s0 - HALF + i; const bool ok = (s >= 0) && (s < SEQ);
        const unsigned w = col[(size_t)(ok ? (t0 - HALF + i) : t0) * 768];
        v0[i] = ok ? bf_lo(w) : 0.f; v1[i] = ok ? bf_hi(w) : 0.f;
    }
    float S0 = 0.f, S1 = 0.f;
#pragma unroll
    for (int j = 0; j < 2 * HALF; ++j) { S0 += v0[j]; S1 += v1[j]; }
#pragma unroll
    for (int i = 0; i < TC; ++i) {
        const int s = s0 + i; const int lo = (s - HALF) > 0 ? (s - HALF) : 0, hi = (s + HALF) < SEQ ? (s + HALF) : SEQ;
        const float inv = 1.0f / (float)(hi - lo);
        mx[(size_t)(t0 + i) * 512] = pk2(S0 * inv - v0[i + HALF], S1 * inv - v1[i + HALF]);
        if (i + 1 < TC) { S0 += v0[i + 2 * HALF] - v0[i]; S1 += v1[i + 2 * HALF] - v1[i]; }
    }
}
__device__ __forceinline__ void p2_phase(const Ptrs& P, int vcu, int G, int tid, int wave) {
    const unsigned* PR = (const unsigned*)(P.ws + WS_PROJ);
    unsigned* MX = (unsigned*)(P.ws + WS_MIX);
    constexpr int TC = 32;
    for (int ck = vcu; ck < M / TC; ck += G) {
        const int t0 = ck * TC, s0 = t0 & (SEQ - 1);
        if (tid < 256) {
            const unsigned* col = PR + 512 + tid; unsigned* mx = MX + 256 + tid;
            if (wave == 0) pool_chunk<1>(col, mx, t0, s0); else if (wave == 1) pool_chunk<2>(col, mx, t0, s0); else if (wave == 2) pool_chunk<4>(col, mx, t0, s0); else pool_chunk<8>(col, mx, t0, s0);
        } else {
            const int cp = tid - 256;
            const unsigned* bcol = PR + cp; const unsigned* zcol = PR + 256 + cp;
            const float w00 = P.conv_w[2 * cp], w01 = P.conv_w[2 * cp + 1], w10 = P.conv_w[512 + 2 * cp], w11 = P.conv_w[512 + 2 * cp + 1], w20 = P.conv_w[1024 + 2 * cp], w21 = P.conv_w[1024 + 2 * cp + 1];
            float z0[TC + 2], z1[TC + 2]; unsigned bw[TC];
#pragma unroll
            for (int i = 0; i < TC + 2; ++i) {
                const int s = s0 - 1 + i; const bool ok = (s >= 0) && (s < SEQ);
                const unsigned z = zcol[(size_t)(ok ? (t0 - 1 + i) : t0) * 768];
                z0[i] = ok ? bf_lo(z) : 0.f; z1[i] = ok ? bf_hi(z) : 0.f;
            }
#pragma unroll
            for (int i = 0; i < TC; ++i) bw[i] = bcol[(size_t)(t0 + i) * 768];
#pragma unroll
            for (int i = 0; i < TC; ++i) {
                const float y0 = w00 * z0[i] + w10 * z0[i + 1] + w20 * z0[i + 2], y1 = w01 * z1[i] + w11 * z1[i + 1] + w21 * z1[i + 2];
                MX[(size_t)(t0 + i) * 512 + cp] = pk2(bf_lo(bw[i]) * y0, bf_hi(bw[i]) * y1);
            }
        }
    }
}

__device__ __forceinline__ float fmax_s(float a, float b) { float r; asm("v_max_f32_e32 %0, %1, %2" : "=v"(r) : "v"(a), "v"(b)); return r; }
__device__ __forceinline__ float fmin_s(float a, float b) { float r; asm("v_min_f32_e32 %0, %1, %2" : "=v"(r) : "v"(a), "v"(b)); return r; }
#define CE_DESC(a, b) do { const float _t = fmax_s(a, b); b = fmin_s(a, b); a = _t; } while (0)
#define CE_ASC(a, b)  do { const float _t = fmin_s(a, b); b = fmax_s(a, b); a = _t; } while (0)
__device__ __forceinline__ void sort16_desc(float* a) {
#pragma unroll
    for (int k = 2; k <= 16; k <<= 1)
#pragma unroll
        for (int j = k >> 1; j > 0; j >>= 1)
#pragma unroll
            for (int i = 0; i < 16; ++i) { const int l = i ^ j; if (l > i) { if ((i & k) == 0) CE_DESC(a[i], a[l]); else CE_ASC(a[i], a[l]); } }
}
__device__ __forceinline__ void merge16_desc(float* a) {
#pragma unroll
    for (int j = 8; j > 0; j >>= 1)
#pragma unroll
        for (int i = 0; i < 16; ++i) { const int l = i ^ j; if (l > i) CE_DESC(a[i], a[l]); }
}
__device__ __forceinline__ void top16_merge(float* a, const float* b) {
#pragma unroll
    for (int i = 0; i < 16; ++i) a[i] = fmax_s(a[i], b[15 - i]);
    merge16_desc(a);
}
__device__ __forceinline__ void top16_of_64(float* v) {
    sort16_desc(v); sort16_desc(v + 16); sort16_desc(v + 32); sort16_desc(v + 48);
    top16_merge(v, v + 16); top16_merge(v + 32, v + 48); top16_merge(v, v + 32);
}
__device__ __forceinline__ unsigned key_lookup(unsigned long long lo, unsigned long long hi, unsigned i) {
    const unsigned long long v = (i & 8u) ? hi : lo;
    return (unsigned)(v >> ((i & 7u) * 8u)) & 0x7fu;
}

constexpr int KROW = 272;
__device__ __forceinline__ void score_phase(const Ptrs& P, LAS unsigned char* lds, int bid, int G, int tid, int wave, int lane) {
    const bf16* Q = (const bf16*)(P.ws + WS_PROJ); const bf16* KEYS = (const bf16*)(P.ws + WS_KEYS); const float* RS1 = (const float*)(P.ws + WS_RS1);
    int* EIDX = (int*)(P.ws + WS_EIDX); float* GATE = (float*)(P.ws + WS_GATE);
    const int l31 = lane & 31, hi = lane >> 5;
    int cur_h = -1;
    bf16x8 bqa[2][8];
    if (bid < (M / 256) * 8) { const int tok0 = (bid >> 3) * 256 + wave * 32 + l31;
#pragma unroll
        for (int p = 0; p < 2; ++p) { const bf16* qp = Q + (size_t)tok0 * 2048 + (bid & 7) * 256 + p * 128 + hi * 8;
#pragma unroll
            for (int ks = 0; ks < 8; ++ks) bqa[p][ks] = *(const GAS bf16x8*)(qp + ks * 16); } }
    for (int u = bid; u < (M / 256) * 8; u += G) {
        const int h = u & 7, tile = u >> 3;
        if (h != cur_h) {
            __syncthreads();
#pragma unroll
            for (int i = 0; i < 8; ++i) { const int q = tid + 512 * i, row = q >> 4, ch = q & 15;
                const v4u val = *(const GAS v4u*)(KEYS + ((size_t)(h * 256 + row)) * 128 + ch * 8);
                *(LAS v4u*)(lds + row * KROW + ch * 16) = val; }
            __syncthreads();
            cur_h = h;
        }
        const int tok = tile * 256 + wave * 32 + l31;
        float T0[16], T1[16];
#pragma unroll
        for (int p = 0; p < 2; ++p) {
            f32x16 acc[4];
#pragma unroll
            for (int kb = 0; kb < 4; ++kb)
#pragma unroll
                for (int r = 0; r < 16; ++r) acc[kb][r] = 0.f;
#pragma unroll
            for (int ks = 0; ks < 8; ++ks)
#pragma unroll
                for (int kb = 0; kb < 4; ++kb) {
                    const bf16x8 ak = *(const LAS bf16x8*)(lds + (p * 128 + kb * 32 + l31) * KROW + (ks * 16 + hi * 8) * 2);
                    acc[kb] = __builtin_amdgcn_mfma_f32_32x32x16_bf16(ak, bqa[p][ks], acc[kb], 0, 0, 0);
                }
            if (p == 1) {
                const int un = (u + G < (M / 256) * 8) ? u + G : u; const int tokn = (un >> 3) * 256 + wave * 32 + l31;
                asm volatile("" : "+v"(acc[0]), "+v"(acc[1]), "+v"(acc[2]), "+v"(acc[3]));
#pragma unroll
                for (int pp = 0; pp < 2; ++pp) { const bf16* qp = Q + (size_t)tokn * 2048 + (un & 7) * 256 + pp * 128 + hi * 8;
#pragma unroll
                    for (int ks = 0; ks < 8; ++ks) bqa[pp][ks] = *(const GAS bf16x8*)(qp + ks * 16); }
            }
            float v[64];
#pragma unroll
            for (int kb = 0; kb < 4; ++kb)
#pragma unroll
                for (int r = 0; r < 16; ++r) v[kb * 16 + r] = __uint_as_float((__float_as_uint(acc[kb][r]) & 0xffffff80u) | (unsigned)(kb * 32 + (r & 3) + 8 * (r >> 2)));
            top16_of_64(v);
            const unsigned hb = (unsigned)hi << 2;
#pragma unroll
            for (int i = 0; i < 16; ++i) v[i] = __uint_as_float(__float_as_uint(v[i]) | hb);
            float c[16];
#pragma unroll
            for (int i = 0; i < 16; ++i) c[i] = fmax_s(v[i], __shfl_xor(v[15 - i], 32));
            merge16_desc(c);
#pragma unroll
            for (int i = 0; i < 16; ++i) { if (p == 0) T0[i] = c[i]; else T1[i] = c[i]; }
        }
        float f0[16], f1[16];
        unsigned long long K0lo = 0ull, K0hi = 0ull, K1lo = 0ull, K1hi = 0ull;
#pragma unroll
        for (int b = 0; b < 8; ++b) {
            K0lo |= (unsigned long long)(__float_as_uint(T0[b]) & 0x7fu) << (8 * b); K0hi |= (unsigned long long)(__float_as_uint(T0[8 + b]) & 0x7fu) << (8 * b);
            K1lo |= (unsigned long long)(__float_as_uint(T1[b]) & 0x7fu) << (8 * b); K1hi |= (unsigned long long)(__float_as_uint(T1[8 + b]) & 0x7fu) << (8 * b);
        }
#pragma unroll
        for (int i = 0; i < 16; ++i) { f0[i] = __uint_as_float(__float_as_uint(T0[i]) & 0xffffff80u); f1[i] = __uint_as_float(__float_as_uint(T1[i]) & 0xffffff80u); }
        float cd[32]; int n = 0;
#pragma unroll
        for (int i = 0; i < 16; ++i)
#pragma unroll
            for (int j = 0; j < 16; ++j)
                if ((i + 1) * (j + 1) <= 16) {
                    const float cv = __uint_as_float((__float_as_uint(f0[i] + f1[j]) & 0xffffff00u) | (unsigned)(i * 16 + j));
                    if ((n & 1) == 0) cd[n >> 1] = cv; else cd[n >> 1] = hi ? cv : cd[n >> 1];
                    ++n;
                }
#pragma unroll
        for (int q = 25; q < 32; ++q) cd[q] = __uint_as_float(0xff800000u);
        sort16_desc(cd); sort16_desc(cd + 16); top16_merge(cd, cd + 16);
        { float cm[16];
#pragma unroll
          for (int i = 0; i < 16; ++i) cm[i] = fmax_s(cd[i], __shfl_xor(cd[15 - i], 32));
          merge16_desc(cm);
#pragma unroll
          for (int i = 0; i < 16; ++i) cd[i] = cm[i]; }
        float rs = 0.f;
        { const GAS f32x4* rp = (const GAS f32x4*)(RS1 + (size_t)tok * 16);
#pragma unroll
          for (int i = 0; i < 4; ++i) { const f32x4 a = rp[i]; rs += (a.x + a.y) + (a.z + a.w); } }
        const float rstd = __builtin_amdgcn_rsqf(rs * (1.0f / 1024.0f) + EPS);
        int eidx[16]; float gt_[16]; float z0 = 0.f, sum = 0.f;
#pragma unroll
        for (int k = 0; k < 16; ++k) {
            const unsigned wb = __float_as_uint(cd[k]); const unsigned i = (wb >> 4) & 15u, j = wb & 15u;
            eidx[k] = (int)(key_lookup(K0lo, K0hi, i) * 128u + key_lookup(K1lo, K1hi, j));
            const float z = __uint_as_float(wb & 0xffffff00u) * rstd;
            if (k == 0) z0 = z;
            gt_[k] = __expf(z - z0); sum += gt_[k];
        }
        const float inv = 1.0f / sum;
        if (hi == 0) { GAS i32x4* ep = (GAS i32x4*)(EIDX + (size_t)tok * 128 + h * 16);
#pragma unroll
            for (int q = 0; q < 4; ++q) ep[q] = (i32x4){eidx[4 * q], eidx[4 * q + 1], eidx[4 * q + 2], eidx[4 * q + 3]};
        } else { GAS f32x4* gp = (GAS f32x4*)(GATE + (size_t)tok * 128 + h * 16);
#pragma unroll
            for (int q = 0; q < 4; ++q) gp[q] = (f32x4){gt_[4 * q] * inv, gt_[4 * q + 1] * inv, gt_[4 * q + 2] * inv, gt_[4 * q + 3] * inv};
        }
    }
}

__device__ __forceinline__ float gelu_tanh(float x) {
    const float y = 1.5957691216057308f * (x + 0.044715f * x * x * x);
    return x / (1.0f + __expf(-y));
}
typedef int v8i __attribute__((ext_vector_type(8)));
#define PEER_MFMA(a, b, c) __builtin_amdgcn_mfma_scale_f32_16x16x128_f8f6f4(a, b, c, 4  , 0  , 0, 0x7F7F7F7F, 0, 0x7F7F7F7F)
__device__ __forceinline__ void peer_dots_phase(const Ptrs& P, LAS unsigned char* lds, int vcu, int G, int wave, int lane) {
    const int gw = vcu * NWAVES + wave, NGW = G * NWAVES;
    const bf16* HB = (const bf16*)(P.ws + WS_HB); unsigned char* CF8 = P.ws + WS_CF; int* EOFF = (int*)(P.ws + WS_EOFF);
    const int* EIDX = (const int*)(P.ws + WS_EIDX); const float* GATE = (const float*)(P.ws + WS_GATE);
    const unsigned char* U4 = P.ws + WS_U;
    const float* SU = (const float*)(P.ws + WS_SU); const float* SV = (const float*)(P.ws + WS_SV);
    LAS unsigned char* xl = lds + 65536 + wave * 1024;
    LAS unsigned char* tb = lds + wave * 8192;
    const int lr = lane >> 5, lp = lane & 31;
    const int li = lane & 15, lq = lane >> 4;
    const int kl = 4 * lq + (li & 3);
    const int gam = lq + 4 * (li & 1); const int cpos = lq * 32 + (li & 3), epos = gam * 16 + ((li >> 1) & 1);
    int t = gw; if (t >= M) return;
    int ei0 = __builtin_nontemporal_load(EIDX + (size_t)t * 128 + lane), ei1 = __builtin_nontemporal_load(EIDX + (size_t)t * 128 + 64 + lane);
    float gg0 = __builtin_nontemporal_load(GATE + (size_t)t * 128 + lane), gg1 = __builtin_nontemporal_load(GATE + (size_t)t * 128 + 64 + lane);
    v2u hrow[4];
    { const GAS v2u* hp = (const GAS v2u*)(HB + (size_t)t * 1024) + lane;
#pragma unroll
      for (int j = 0; j < 4; ++j) hrow[j] = __builtin_nontemporal_load(hp + 64 * j); }
    v4u uw[8];
#pragma unroll
    for (int v = 0; v < 8; ++v) { const int e = __shfl(ei0, 2 * v + lr); uw[v] = *(const GAS v4u*)(U4 + (size_t)e * 512 + 16 * lp); }
    for (; t < M; t += NGW) {
        const int tn = (t + NGW < M) ? t + NGW : t;
        f32x2 x[8]; float ss = 0.f;
#pragma unroll
        for (int j = 0; j < 4; ++j) { const unsigned wa = hrow[j].x, wb = hrow[j].y; x[2 * j] = (f32x2){bf_lo(wa), bf_hi(wa)}; x[2 * j + 1] = (f32x2){bf_lo(wb), bf_hi(wb)};
            ss += (x[2 * j].x * x[2 * j].x + x[2 * j].y * x[2 * j].y) + (x[2 * j + 1].x * x[2 * j + 1].x + x[2 * j + 1].y * x[2 * j + 1].y); }
        ss = wave_sum(ss);
        const float rstd = __builtin_amdgcn_rsqf(ss * (1.0f / 1024.0f) + EPS);
        { const float sx = 16.0f * rstd;
#pragma unroll
          for (int j = 0; j < 4; ++j) { int w = __builtin_amdgcn_cvt_pk_fp8_f32(x[2 * j].x * sx, x[2 * j].y * sx, 0, false); w = __builtin_amdgcn_cvt_pk_fp8_f32(x[2 * j + 1].x * sx, x[2 * j + 1].y * sx, w, true);
              const int n = 4 * lane + 256 * j, sN = n >> 7, nn = n & 127, hN = nn >> 6, qN = (nn & 63) >> 4, jN = nn & 15;
              *(LAS unsigned*)(xl + 128 * sN + 32 * qN + 16 * hN + jN) = (unsigned)w; }
          asm volatile("s_waitcnt lgkmcnt(0)" ::: "memory"); }
        v8i xb[8];
#pragma unroll
        for (int sI = 0; sI < 8; ++sI) { const v4u b0 = *(const LAS v4u*)(xl + 128 * sI + 32 * lq), b1 = *(const LAS v4u*)(xl + 128 * sI + 32 * lq + 16);
            xb[sI] = (v8i){(int)b0.x, (int)b0.y, (int)b0.z, (int)b0.w, (int)b1.x, (int)b1.y, (int)b1.z, (int)b1.w}; }
        const int nei0 = __builtin_nontemporal_load(EIDX + (size_t)tn * 128 + lane), nei1 = __builtin_nontemporal_load(EIDX + (size_t)tn * 128 + 64 + lane);
        const float ngg0 = __builtin_nontemporal_load(GATE + (size_t)tn * 128 + lane), ngg1 = __builtin_nontemporal_load(GATE + (size_t)tn * 128 + 64 + lane);
        { const GAS v2u* hn = (const GAS v2u*)(HB + (size_t)tn * 1024) + lane;
#pragma unroll
          for (int j = 0; j < 4; ++j) hrow[j] = __builtin_nontemporal_load(hn + 64 * j); }
        for (int hq = 0; hq < 8 * REPS(7); ++hq) { const int hh = hq & 7;
            const int ereg = hh < 4 ? ei0 : ei1; const float greg = hh < 4 ? gg0 : gg1; const int lb = (hh & 3) * 16;
            const int el = __shfl(ereg, lb + kl);
            const float su = SU[el], sv = SV[el];
#pragma unroll
            for (int v = 0; v < 8; ++v) { const int r = 2 * v + lr; *(LAS v4u*)(tb + 512 * r + 16 * (lp ^ r)) = uw[v]; }
            __builtin_amdgcn_sched_barrier(0);
            { const bool lasth = (hq == 8 * REPS(7) - 1); const int hn = (hh + 1) & 7;
              const int nreg = lasth ? nei0 : (hn < 4 ? ei0 : ei1); const int nlb = (hn & 3) * 16;
#pragma unroll
              for (int v = 0; v < 8; ++v) { const int e = __shfl(nreg, nlb + 2 * v + lr); uw[v] = *(const GAS v4u*)(U4 + (size_t)e * 512 + 16 * lp); } }
            __builtin_amdgcn_sched_barrier(0);
            f32x4 acc = {0.f, 0.f, 0.f, 0.f};
#pragma unroll
            for (int sI = 0; sI < 8; ++sI) { const v4u af = *(const LAS v4u*)(tb + 512 * li + 16 * ((4 * sI + lq) ^ li));
                const v8i av = {(int)af.x, (int)af.y, (int)af.z, (int)af.w, 0, 0, 0, 0}; acc = PEER_MFMA(av, xb[sI], acc); }
            const int rsel = li & 3;
            const float d = rsel == 0 ? acc[0] : (rsel == 1 ? acc[1] : (rsel == 2 ? acc[2] : acc[3]));
            const float gk = __shfl(greg, lb + kl);
            const float cf = gk * gelu_tanh(d * su * (1.0f / 16.0f)) * sv * 1024.0f;
            const float cfc = fminf(fmaxf(cf, -448.0f), 448.0f);
            const unsigned c8 = (unsigned)__builtin_amdgcn_cvt_pk_fp8_f32(cfc, cfc, 0, false);
            if (li < 4) { CF8[(size_t)t * 128 + cpos + hh * 4] = (unsigned char)c8; EOFF[(size_t)t * 128 + epos + hh * 2] = el * D2PIECE; }
        }
        ei0 = nei0; ei1 = nei1; gg0 = ngg0; gg1 = ngg1;
    }
}
__device__ __forceinline__ void peer_sum_phase(const Ptrs& P, LAS unsigned char* lds, int bx, int G, int wave, int lane) {
    static_assert(D2NS == 4, "this body is written for four slices");
    constexpr int NTP = 2, SL = 256, MT = M / NTP, NSLOT = 6, AHD = 5;
    const int kx = bx & 7, sl = kx & 3, tp = kx >> 2, nbk = (G - kx + 7) >> 3;
    const int wj = (bx >> 3) * NWAVES + wave, NW = nbk * NWAVES;
    bf16* HB = (bf16*)(P.ws + WS_HB); float* RS2 = (float*)(P.ws + WS_RS2);
    const unsigned char* CF8 = P.ws + WS_CF; const unsigned char* EOFF = P.ws + WS_EOFF;
    const unsigned char* Vs = P.ws + WS_V + (size_t)sl * ((size_t)NEXP * D2PIECE);
    LAS unsigned char* rec = lds + wave * 16384;
    LAS unsigned char* dring = rec + 4096;
    const int li = lane & 15, lq = lane >> 4, rho = lane >> 3;
    const unsigned lc16 = 16u * (unsigned)(lane & 7);
    unsigned sel[2][8];
    { const unsigned pz = 0x0c0c0c0cu, psh = 8u * (unsigned)(li & 3);
#pragma unroll
      for (int g8 = 0; g8 < 2; ++g8)
#pragma unroll
          for (int r = 0; r < 8; ++r) { const unsigned pl = (pz & ~(0xffu << psh)) | ((unsigned)(2 * g8 + (r >> 2)) << psh); sel[g8][r] = ((r & 3) == (li >> 2)) ? pl : pz; } }
    const bool stl = lane < 40;
    auto rec_ptr = [&](int uu) -> const GAS v4u* { const size_t tt = (size_t)uu * NTP + tp; return (const GAS v4u*)(lane < 32 ? EOFF + tt * 512 + 16 * lane : CF8 + tt * 128 + 16 * (lane & 7)); };
    int u = wj; if (u >= MT) return;
    auto clampu = [&](int xx) { return xx < MT ? xx : u; };
#define D2_DMA(rs_, hd_, is_) do { const v2u eq_ = *(const LAS v2u*)((rs_) + rho * 64 + (hd_) * 8); \
        __builtin_amdgcn_global_load_lds((const unsigned*)(Vs + (size_t)(eq_.x + lc16)), (LAS unsigned*)(dring + (is_) * 2048), 16, 0, 0); \
        __builtin_amdgcn_global_load_lds((const unsigned*)(Vs + (size_t)(eq_.y + lc16)), (LAS unsigned*)(dring + (is_) * 2048 + 1024), 16, 0, 0); } while (0)
#define D2_REC(uu_, slot_) do { if (stl) __builtin_amdgcn_global_load_lds((const unsigned*)rec_ptr(uu_), (LAS unsigned*)(rec + (slot_) * 640), 16, 0, 0); } while (0)
    D2_REC(u, 0); D2_REC(clampu(u + NW), 1); D2_REC(clampu(u + 2 * NW), 2);
    asm volatile("s_waitcnt vmcnt(0)" ::: "memory");
#pragma unroll
    for (int h = 0; h < AHD; ++h) D2_DMA(rec, h, h);
    int cs = 0;
#define D2_IMG(dst_, slot_) do { const LAS unsigned char* im_ = dring + (slot_) * 2048 + (2 * lq) * 128 + 8 * li; \
        (dst_)[0] = *(const LAS v2u*)(im_); (dst_)[1] = *(const LAS v2u*)(im_ + 128); (dst_)[2] = *(const LAS v2u*)(im_ + 1024); (dst_)[3] = *(const LAS v2u*)(im_ + 1152); } while (0)
    v2u acur[4];
    asm volatile("s_waitcnt vmcnt(8)" ::: "memory");
    D2_IMG(acur, 0);
    for (int it = 0; u < MT; u += NW, ++it) {
        const int t = u * NTP + tp;
        LAS unsigned char* scur = rec + (it & 3) * 640; LAS unsigned char* snxt = rec + ((it + 1) & 3) * 640;
        D2_REC(clampu(u + 3 * NW), (it + 3) & 3);
        if (lane < 32) __builtin_amdgcn_global_load_lds((const unsigned*)((const unsigned char*)HB + (size_t)t * 2048 + SL * 2 * sl + 16 * lane), (LAS unsigned*)(rec + 2560), 16, 0, 0);
        v2u eqs[8]; unsigned cws[8];
#pragma unroll
        for (int h = 0; h < 8; ++h) { eqs[h] = *(const LAS v2u*)((h + AHD < 8 ? scur : snxt) + rho * 64 + ((h + AHD) & 7) * 8); cws[h] = *(const LAS unsigned*)(scur + 512 + lq * 32 + h * 4); }
        f32x4 acc = {0.f, 0.f, 0.f, 0.f};
#pragma unroll
        for (int h = 0; h < 8; ++h) {
            { const int is = cs + AHD >= NSLOT ? cs + AHD - NSLOT : cs + AHD;
              __builtin_amdgcn_global_load_lds((const unsigned*)(Vs + (size_t)(eqs[h].x + lc16)), (LAS unsigned*)(dring + is * 2048), 16, 0, 0);
              __builtin_amdgcn_global_load_lds((const unsigned*)(Vs + (size_t)(eqs[h].y + lc16)), (LAS unsigned*)(dring + is * 2048 + 1024), 16, 0, 0); }
            if (h <= 3) asm volatile("s_waitcnt vmcnt(10)" ::: "memory"); else asm volatile("s_waitcnt vmcnt(8)" ::: "memory");
            v2u anxt[4]; { const int ns = cs + 1 >= NSLOT ? 0 : cs + 1; D2_IMG(anxt, ns); }
            const unsigned cw = cws[h];
#pragma unroll
            for (int g8 = 0; g8 < 2; ++g8) {
                const v8i bv = {(int)__builtin_amdgcn_perm(0u, cw, sel[g8][0]), (int)__builtin_amdgcn_perm(0u, cw, sel[g8][1]), (int)__builtin_amdgcn_perm(0u, cw, sel[g8][2]), (int)__builtin_amdgcn_perm(0u, cw, sel[g8][3]),
                                (int)__builtin_amdgcn_perm(0u, cw, sel[g8][4]), (int)__builtin_amdgcn_perm(0u, cw, sel[g8][5]), (int)__builtin_amdgcn_perm(0u, cw, sel[g8][6]), (int)__builtin_amdgcn_perm(0u, cw, sel[g8][7])};
                const v8i av = {(int)acur[2 * g8].x, (int)acur[2 * g8].y, (int)acur[2 * g8 + 1].x, (int)acur[2 * g8 + 1].y, 0, 0, 0, 0};
                acc = PEER_MFMA(av, bv, acc);
            }
#pragma unroll
            for (int k = 0; k < 4; ++k) acur[k] = anxt[k];
            cs = cs + 1 >= NSLOT ? 0 : cs + 1;
        }
        const float osc = 1.0f / 1024.0f;
        const v2u hrow = *(const LAS v2u*)(rec + 2560 + 8 * lane);
        const unsigned wa = hrow.x, wb = hrow.y;
        const f32x2 o0 = (f32x2){bf_lo(wa) + acc[0] * osc, bf_hi(wa) + acc[1] * osc}, o1 = (f32x2){bf_lo(wb) + acc[2] * osc, bf_hi(wb) + acc[3] * osc};
        __builtin_nontemporal_store((v2u){pk2(o0.x, o0.y), pk2(o1.x, o1.y)}, (GAS v2u*)(HB + (size_t)t * 1024 + SL * sl + 4 * lane));
        float s2 = (o0.x * o0.x + o0.y * o0.y) + (o1.x * o1.x + o1.y * o1.y);
        s2 = wave_sum(s2);
        if (lane == 0) RS2[(size_t)t * D2NS + sl] = s2;
    }
    asm volatile("s_waitcnt vmcnt(0)" ::: "memory");
#undef D2_DMA
#undef D2_IMG
#undef D2_REC
}

__device__ __forceinline__ void final_phase(const Ptrs& P, int vcu, int G, int wave, int lane) {
    const int gw = vcu * NWAVES + wave, NGW = G * NWAVES; const float* RS3 = (const float*)(P.ws + WS_RS3); const bf16* H3 = (const bf16*)(P.ws + WS_PROJ);
    const GAS f32x4* gf = (const GAS f32x4*)P.g_final + lane;
    f32x4 g[4];
#pragma unroll
    for (int j = 0; j < 4; ++j) g[j] = gf[64 * j];
    for (int m0 = 2 * gw; m0 < M; m0 += 2 * NGW) {
        v2u hv[2][4]; float rs[2];
#pragma unroll
        for (int r = 0; r < 2; ++r) { const GAS v2u* hp = (const GAS v2u*)(H3 + (size_t)(m0 + r) * D) + lane;
#pragma unroll
            for (int j = 0; j < 4; ++j) hv[r][j] = hp[64 * j];
            rs[r] = 0.f; const GAS f32x4* rp = (const GAS f32x4*)(RS3 + (size_t)(m0 + r) * 16);
#pragma unroll
            for (int i = 0; i < 4; ++i) { const f32x4 a = rp[i]; rs[r] += (a.x + a.y) + (a.z + a.w); } }
#pragma unroll
        for (int r = 0; r < 2; ++r) { const float rstd = __builtin_amdgcn_rsqf(rs[r] * (1.0f / 1024.0f) + EPS);
            GAS f32x4* xr = (GAS f32x4*)(P.out + (size_t)(m0 + r) * D) + lane;
#pragma unroll
            for (int j = 0; j < 4; ++j) { const unsigned wa = hv[r][j].x, wb = hv[r][j].y; const f32x4 v = {bf_lo(wa), bf_hi(wa), bf_lo(wb), bf_hi(wb)}; xr[64 * j] = v * rstd * g[j]; } }
    }
}

struct Args { const float* in[17]; float* out; unsigned char* ws; int ph_lo, ph_hi; };
#ifndef PG8_SP2
#define PG8_SP2 true
#endif
#ifndef PG8_ALIGN
#define PG8_ALIGN true
#endif
__global__ void __launch_bounds__(NWAVES * 64, 2) mega_fwd(Args args) {
    extern __shared__ __attribute__((aligned(16))) unsigned char lds_raw[];
    LAS unsigned char* lds = (LAS unsigned char*)lds_raw;
    volatile LAS unsigned* MISC = (volatile LAS unsigned*)(lds + MISC_OFF);
    const int tid = threadIdx.x, lane = tid & 63, wave = __builtin_amdgcn_readfirstlane(tid >> 6);
    const int G = gridDim.x, bx = blockIdx.x; const int vcu = (G % 8 == 0) ? (bx % 8) * (G / 8) + bx / 8 : bx;
    Ptrs P;
    P.x = args.in[0]; P.p = args.in[1]; P.g_mix = args.in[2]; P.w_in = args.in[3]; P.conv_w = args.in[4]; P.pool_w = args.in[5]; P.pool_scale = args.in[6]; P.w_o = args.in[7];
    P.g_ffn = args.in[8]; P.w_q = args.in[9]; P.sub_keys = args.in[10]; P.eu = args.in[11]; P.ev = args.in[12]; P.g_ple = args.in[13]; P.w_gate = args.in[14]; P.w_proj = args.in[15]; P.g_final = args.in[16];
    P.out = args.out; P.ws = args.ws;
    gu32* ctl = (gu32*)(P.ws + WS_CTL);
    for (int u = tid; u < (LDS_BYTES - LDSCTL_OFF) / 4; u += NWAVES * 64) ((LAS unsigned*)(lds + LDSCTL_OFF))[u] = 0u;
    __syncthreads();
    XcdBarrier bar; bar.bar = (unsigned*)(ctl + CW_BAR); bar.x = 0; bar.st = nullptr;
    if (!MK_PER_PHASE) bar = xcd_barrier_post((unsigned*)(ctl + CW_BAR), MISC + 8);
    const int lo = args.ph_lo, hi = args.ph_hi;
#define IN(k) (lo <= (k) && (k) < hi)
#define SEAM(k) do { if (IN(k) && IN((k) + 1)) xcd_barrier(bar); } while (0)
    pg8::bf16_t* const WIN = (pg8::bf16_t*)(P.ws + WS_WIN); pg8::bf16_t* const WO = (pg8::bf16_t*)(P.ws + WS_WO); pg8::bf16_t* const WQ = (pg8::bf16_t*)(P.ws + WS_WQ);
    pg8::bf16_t* const WG = (pg8::bf16_t*)(P.ws + WS_WG); pg8::bf16_t* const WP = (pg8::bf16_t*)(P.ws + WS_WP);
    pg8::bf16_t* const XB = (pg8::bf16_t*)(P.ws + WS_XB); pg8::bf16_t* const PL = XB; pg8::bf16_t* const PROJ = (pg8::bf16_t*)(P.ws + WS_PROJ); pg8::bf16_t* const QB = PROJ;
    pg8::bf16_t* const MIX = (pg8::bf16_t*)(P.ws + WS_MIX); pg8::bf16_t* const HB = (pg8::bf16_t*)(P.ws + WS_HB); pg8::bf16_t* const PB = (pg8::bf16_t*)(P.ws + WS_PB);

    if (IN(0)) { for (int rep = 0; rep < REPS(1); ++rep) { p0a_phase(P, lds, vcu, G, tid, wave, lane); SEAM(0); } }
    if (IN(1)) { p0b_phase(P, lds, vcu, G, wave, lane); SEAM(1); }
    if (IN(2)) {
        pg8::Gemm g{XB, WIN, M, NPROJ, D}; pg8::StaticOrder S; S.init(M, NPROJ, G, bx);
        EpiProj E{PROJ, (const float*)(P.ws + WS_RSX)};
        for (int rep = 0; rep < REPS(2); ++rep) { pg8::gemm_phase<EpiProj, pg8::StaticOrder, PG8_ALIGN, PG8_SP2>(lds, g, S, E);
        SEAM(2); }
    }
    if (IN(3)) {
        for (int rep = 0; rep < REPS(3); ++rep) p2_phase(P, vcu, G, tid, wave);
        pg8::Gemm g{PB, WP, M, D, PLED}; pg8::StaticOrder S; S.init(M, D, G, bx);
        EpiBf16Row E{PL, D, nullptr};
        for (int rep = 0; rep < REPS(8); ++rep) pg8::gemm_phase<EpiBf16Row, pg8::StaticOrder, PG8_ALIGN, PG8_SP2>(lds, g, S, E);
        SEAM(3);
    }
    if (IN(4)) {
        pg8::Gemm g{MIX, WO, M, D, D}; pg8::StaticOrder S; S.init(M, D, G, bx);
        EpiH1 E{P.x, HB, (float*)(P.ws + WS_RS1)};
        for (int rep = 0; rep < REPS(4); ++rep) { pg8::gemm_phase<EpiH1, pg8::StaticOrder, PG8_ALIGN, PG8_SP2>(lds, g, S, E);
        SEAM(4); }
    }
    if (IN(5)) {
        pg8::Gemm g{HB, WQ, M, NQ, D}; pg8::StaticOrder S; S.init(M, NQ, G, bx);
        EpiBf16Row E{QB, NQ, nullptr};
        for (int rep = 0; rep < REPS(5); ++rep) { pg8::gemm_phase<EpiBf16Row, pg8::StaticOrder, PG8_ALIGN, PG8_SP2>(lds, g, S, E);
        SEAM(5); }
    }
    if (IN(6)) { for (int rep = 0; rep < REPS(6); ++rep) { score_phase(P, lds, bx, G, tid, wave, lane); SEAM(6); } }
    if (IN(7)) { peer_dots_phase(P, lds, vcu, G, wave, lane); SEAM(7); }
    if (IN(8)) { peer_sum_phase(P, lds, bx, G, wave, lane); SEAM(8); }
    if (IN(9)) {
        pg8::Gemm g{HB, WG, M, D, D}; pg8::StaticOrder S; S.init(M, D, G, bx);
        EpiGate E{PROJ  , HB, PL, (const float*)(P.ws + WS_RS2), (float*)(P.ws + WS_RS3)};
        pg8::gemm_phase<EpiGate, pg8::StaticOrder, PG8_ALIGN, PG8_SP2>(lds, g, S, E);
        SEAM(9);
    }
    if (IN(10)) { final_phase(P, vcu, G, wave, lane); }
#undef IN
#undef SEAM
}

extern "C" void kernel_launch(void* const* d_in, const int* in_sizes, int n_in, void* d_out, int out_size, void* d_ws, size_t ws_size, hipStream_t stream) {
    static int grid = 0;
    if (grid == 0) {
        if (n_in != 17 || in_sizes[0] != M * D || out_size != M * D || ws_size < WS_END) { fprintf(stderr, "kernel_launch: unexpected shapes (n_in %d, in0 %d, out %d, ws %zu); nothing launched\n", n_in, n_in > 0 ? in_sizes[0] : -1, out_size, ws_size); grid = -1; return; }
        int dev = 0, cus = 0, per_cu = 0;
        if (hipGetDevice(&dev) != hipSuccess || hipDeviceGetAttribute(&cus, hipDeviceAttributeMultiprocessorCount, dev) != hipSuccess) { fprintf(stderr, "kernel_launch: device query failed\n"); grid = -1; return; }
        if (hipFuncSetAttribute((const void*)mega_fwd, hipFuncAttributeMaxDynamicSharedMemorySize, LDS_BYTES) != hipSuccess) { fprintf(stderr, "kernel_launch: hipFuncSetAttribute failed\n"); grid = -1; return; }
        if (hipOccupancyMaxActiveBlocksPerMultiprocessor(&per_cu, (const void*)mega_fwd, NWAVES * 64, LDS_BYTES) != hipSuccess || per_cu < 1) {
            fprintf(stderr, "kernel_launch: the occupancy query reports %d resident workgroups per CU for this kernel (512 threads, %d B LDS): the grid barrier needs one per CU; nothing launched\n", per_cu, LDS_BYTES);
            (void)hipGetLastError(); grid = -1; return; }
        grid = cus;
    }
    if (grid < 0) return;
    if (hipMemsetAsync((char*)d_ws + WS_CTL, 0, CTL_ZERO_BYTES, stream) != hipSuccess) { fprintf(stderr, "kernel_launch: memset failed\n"); return; }
    Args a{};
    for (int i = 0; i < 17; ++i) a.in[i] = (const float*)d_in[i];
    a.out = (float*)d_out; a.ws = (unsigned char*)d_ws;
#if MK_PER_PHASE
    for (int ph = 0; ph < NPHASES; ++ph) { a.ph_lo = ph; a.ph_hi = ph + 1; hipLaunchKernelGGL(mega_fwd, dim3(grid), dim3(NWAVES * 64), LDS_BYTES, stream, a); }
#else
    a.ph_lo = 0; a.ph_hi = NPHASES;
    hipLaunchKernelGGL(mega_fwd, dim3(grid), dim3(NWAVES * 64), LDS_BYTES, stream, a);
#endif
    const hipError_t le = hipPeekAtLastError();
    if (le != hipSuccess) fprintf(stderr, "kernel_launch: launch failed: %s\n", hipGetErrorName(le));
}
```

```cpp
#include <hip/hip_runtime.h>
#include <cstdio>
#include <cstdint>
namespace pg8 {
#define PG8_LAS __attribute__((address_space(3)))
typedef unsigned short bf16_t;
typedef short bf16x8 __attribute__((ext_vector_type(8)));
typedef float f32x4 __attribute__((ext_vector_type(4)));
typedef unsigned u32x4 __attribute__((ext_vector_type(4)));
constexpr int BM = 256, BK = 64, HALF = 128, HTB = HALF * BK * 2  , STAGE_BYTES = 8 * HTB, NXCD = 8, WGM = 8;

__host__ __device__ __forceinline__ int lds_byte(int r, int c) { const int st = (r >> 4) * 2 + (c >> 5), rr = r & 15, cc = c & 31, ob = rr * 64 + cc * 2; return st * 1024 + (ob ^ (((ob >> 9) & 1) << 5)); }
__host__ __device__ __forceinline__ void stage_rc(int b, int& R, int& C) { const int st = b / 1024, sb = b % 1024, swz = sb ^ (((sb >> 9) & 1) << 5); R = (st >> 1) * 16 + swz / 64; C = (st & 1) * 32 + (swz % 64) / 2; }
__host__ __device__ __forceinline__ int perm32(int rho) { const int n = rho >> 4, i = rho & 15; return 8 * (i >> 2) + 4 * n + (i & 3); }

struct Unit { int pm, pn; };
struct Gemm { const bf16_t* A; const bf16_t* Bt; int M, N, K; };

struct StaticOrder {
    int nM, nN, nwg, G, c;
    __host__ __device__ void init(int M, int N, int G_, int c_) { nM = M / BM; nN = N / BM; nwg = nM * nN; G = G_; c = c_; }
    __host__ __device__ bool next(int i, Unit& u) const {
        const long L = (long)i * G + c; if (L >= nwg) return false;
        int wgid = (int)L; { const int q = nwg / NXCD, r = nwg % NXCD, xcd = wgid % NXCD, off = wgid / NXCD; wgid = (xcd < r ? xcd * (q + 1) : r * (q + 1) + (xcd - r) * q) + off; }
        const int nig = WGM * nN, gid = wgid / nig, fm = gid * WGM, gsz = (nM - fm) < WGM ? (nM - fm) : WGM;
        u.pm = fm + ((wgid % nig) % gsz); u.pn = (wgid % nig) / gsz; return true;
    }
    __device__ __forceinline__ void a_ready(const Unit&) const {}
    __device__ __forceinline__ void done(const Unit&) const {}
};

__device__ __forceinline__ unsigned cvt_pk_bf16(float lo, float hi) { unsigned r; asm volatile("v_cvt_pk_bf16_f32 %0, %1, %2" : "=v"(r) : "v"(lo), "v"(hi)); return r; }
template <class Epi, class Sched, bool ALIGN_EPI = false, bool SP2 = false>
__device__ __forceinline__ void gemm_phase(PG8_LAS unsigned char* lds, const Gemm g, const Sched& S, const Epi& E) {
    const int tid = threadIdx.x, wid = __builtin_amdgcn_readfirstlane(tid >> 6), lane = tid & 63, wr = wid >> 2, wc = wid & 3, fr = lane & 15, fq = lane >> 4;
    const int K = g.K, nt = K / BK;
    unsigned voffA[2], voffB[2];
#pragma unroll
    for (int i = 0; i < 2; ++i) { int R, C; stage_rc(tid * 16 + i * 8192, R, C); const int Rb = Epi::PERM ? ((R & ~31) + perm32(R & 31)) : R;
        voffA[i] = (unsigned)(R * K + C) * 2u; voffB[i] = (unsigned)(Rb * K + C) * 2u; }
    const size_t kstep = (size_t)(BK * 2);
    const size_t hstep = (size_t)HALF * K * 2;
    const size_t tstep = 2 * hstep;
    const unsigned ldsw = (unsigned)wid * 1024u;
    const int aoff = lds_byte(wr * 64 + fr, fq * 8), boff = lds_byte(wc * 32 + fr, fq * 8);
#define PG8_SA(b, h) (((b) * 2 + (h)) * HTB)
#define PG8_SB(b, h) ((4 + (b) * 2 + (h)) * HTB)
#define PG8_STAGE(bufoff, gbase, voff) do { _Pragma("unroll") for (int _i = 0; _i < 2; ++_i) \
        __builtin_amdgcn_global_load_lds((const unsigned*)((const char*)(gbase) + (voff)[_i]), (PG8_LAS unsigned*)(lds + (bufoff) + ldsw + _i * 8192), 16, 0, 0); } while (0)
#define PG8_LDA(dst, b, h) do { _Pragma("unroll") for (int m = 0; m < 4; ++m) _Pragma("unroll") for (int k = 0; k < 2; ++k) dst[m][k] = *(const PG8_LAS bf16x8*)(lds + PG8_SA(b, h) + aoff + m * 2048 + k * 1024); } while (0)
#define PG8_LDB(dst, b, h) do { _Pragma("unroll") for (int n = 0; n < 2; ++n) _Pragma("unroll") for (int k = 0; k < 2; ++k) dst[n][k] = *(const PG8_LAS bf16x8*)(lds + PG8_SB(b, h) + boff + n * 2048 + k * 1024); } while (0)
#define PG8_MMA(ai, bj, At, Bt) do { __builtin_amdgcn_s_setprio(1); _Pragma("unroll") for (int m = 0; m < 4; ++m) _Pragma("unroll") for (int n = 0; n < 2; ++n) _Pragma("unroll") for (int k = 0; k < 2; ++k) \
        acc[ai][bj][m][n] = __builtin_amdgcn_mfma_f32_16x16x32_bf16(Bt[n][k], At[m][k], acc[ai][bj][m][n], 0, 0, 0); __builtin_amdgcn_s_setprio(0); } while (0)
#define PG8_WAIT_V(n) asm volatile("s_waitcnt vmcnt(" #n ")" ::: "memory")
#define PG8_WAIT_L(n) asm volatile("s_waitcnt lgkmcnt(" #n ")" ::: "memory")
#define PG8_BAR __builtin_amdgcn_s_barrier()
#define PG8_SCHED __builtin_amdgcn_sched_barrier(0)
    Unit cur, nxt; int ui = 0;
    if (!S.next(0, cur)) return;
    f32x4 acc[2][2][4][2];
#pragma unroll
    for (int a = 0; a < 2; ++a)
#pragma unroll
        for (int b = 0; b < 2; ++b)
#pragma unroll
            for (int m = 0; m < 4; ++m)
#pragma unroll
                for (int n = 0; n < 2; ++n) acc[a][b][m][n] = (f32x4){0.f, 0.f, 0.f, 0.f};
    bf16x8 At[4][2], B0[2][2], B1[2][2];
    const char* cA = (const char*)g.A + (size_t)cur.pm * tstep; const char* cB = (const char*)g.Bt + (size_t)cur.pn * tstep;
    S.a_ready(cur);
    if constexpr (SP2) {
        PG8_STAGE(PG8_SB(0, 0), cB, voffB); PG8_STAGE(PG8_SB(0, 1), cB + hstep, voffB); PG8_STAGE(PG8_SA(0, 0), cA, voffA); PG8_STAGE(PG8_SA(0, 1), cA + hstep, voffA);
        if (wr == 1) PG8_BAR;
        PG8_WAIT_V(2); PG8_BAR;
        PG8_STAGE(PG8_SB(1, 0), cB + kstep, voffB); PG8_STAGE(PG8_SA(1, 0), cA + kstep, voffA); PG8_STAGE(PG8_SB(1, 1), cB + hstep + kstep, voffB);
        PG8_WAIT_V(6); PG8_BAR;
    } else {
        PG8_STAGE(PG8_SB(0, 0), cB, voffB); PG8_STAGE(PG8_SA(0, 0), cA, voffA); PG8_STAGE(PG8_SB(0, 1), cB + hstep, voffB); PG8_STAGE(PG8_SA(0, 1), cA + hstep, voffA);
        if (wr == 1) PG8_BAR;
        PG8_WAIT_V(4); PG8_BAR;
        PG8_STAGE(PG8_SB(1, 0), cB + kstep, voffB); PG8_STAGE(PG8_SA(1, 0), cA + kstep, voffA); PG8_STAGE(PG8_SB(1, 1), cB + hstep + kstep, voffB);
        PG8_WAIT_V(6); PG8_BAR;
    }
    for (;;) {
        const bool has_next = S.next(ui + 1, nxt);
        const char* nA = has_next ? (const char*)g.A + (size_t)nxt.pm * tstep : cA; const char* nB = has_next ? (const char*)g.Bt + (size_t)nxt.pn * tstep : cB;
        for (int t = 0; t < nt; t += 2) {
            const bool last = (t == nt - 2);
            const char* a1 = cA + (size_t)(t + 1) * kstep;
            const char* a2 = last ? nA : cA + (size_t)(t + 2) * kstep; const char* b2 = last ? nB : cB + (size_t)(t + 2) * kstep;
            const char* a3 = a2 + kstep; const char* b3 = b2 + kstep;
            if (last && has_next) S.a_ready(nxt);
            if constexpr (SP2) {
            PG8_LDB(B0, 0, 0); PG8_LDB(B1, 0, 1); PG8_SCHED; PG8_LDA(At, 0, 0); PG8_STAGE(PG8_SA(1, 1), a1 + hstep, voffA);
            PG8_WAIT_V(8); PG8_WAIT_L(0); PG8_BAR; PG8_MMA(0, 0, At, B0); PG8_MMA(0, 1, At, B1); PG8_BAR; PG8_SCHED;
            PG8_LDA(At, 0, 1); PG8_STAGE(PG8_SB(0, 0), b2, voffB); PG8_STAGE(PG8_SB(0, 1), b2 + hstep, voffB); PG8_STAGE(PG8_SA(0, 0), a2, voffA);
            PG8_WAIT_V(8); PG8_WAIT_L(0); PG8_BAR; PG8_MMA(1, 0, At, B0); PG8_MMA(1, 1, At, B1); PG8_BAR; PG8_SCHED;
            PG8_LDB(B0, 1, 0); PG8_LDB(B1, 1, 1); PG8_SCHED; PG8_LDA(At, 1, 0); PG8_STAGE(PG8_SA(0, 1), a2 + hstep, voffA);
            PG8_WAIT_V(8); PG8_WAIT_L(0); PG8_BAR; PG8_MMA(0, 0, At, B0); PG8_MMA(0, 1, At, B1); PG8_BAR; PG8_SCHED;
            PG8_LDA(At, 1, 1); PG8_STAGE(PG8_SB(1, 0), b3, voffB); PG8_STAGE(PG8_SB(1, 1), b3 + hstep, voffB); PG8_STAGE(PG8_SA(1, 0), a3, voffA);
            PG8_WAIT_V(8); PG8_WAIT_L(0); PG8_BAR; PG8_MMA(1, 0, At, B0); PG8_MMA(1, 1, At, B1); PG8_BAR; PG8_SCHED;
            } else {
            PG8_LDB(B0, 0, 0); PG8_SCHED; PG8_LDA(At, 0, 0); PG8_STAGE(PG8_SA(1, 1), a1 + hstep, voffA);
            PG8_WAIT_L(8); PG8_BAR; PG8_WAIT_L(0); PG8_MMA(0, 0, At, B0); PG8_BAR; PG8_SCHED;
            PG8_LDB(B1, 0, 1); PG8_STAGE(PG8_SB(0, 0), b2, voffB);
            PG8_BAR; PG8_WAIT_L(0); PG8_MMA(0, 1, At, B1); PG8_BAR;
            PG8_LDA(At, 0, 1); PG8_STAGE(PG8_SA(0, 0), a2, voffA);
            PG8_BAR; PG8_WAIT_L(0); PG8_MMA(1, 0, At, B0); PG8_BAR; PG8_SCHED;
            PG8_STAGE(PG8_SB(0, 1), b2 + hstep, voffB);
            PG8_WAIT_V(6); PG8_BAR; PG8_MMA(1, 1, At, B1); PG8_BAR;
            PG8_LDB(B0, 1, 0); PG8_SCHED; PG8_LDA(At, 1, 0); PG8_STAGE(PG8_SA(0, 1), a2 + hstep, voffA);
            PG8_WAIT_L(8); PG8_BAR; PG8_WAIT_L(0); PG8_MMA(0, 0, At, B0); PG8_BAR; PG8_SCHED;
            PG8_LDB(B1, 1, 1); PG8_STAGE(PG8_SB(1, 0), b3, voffB);
            PG8_BAR; PG8_WAIT_L(0); PG8_MMA(0, 1, At, B1); PG8_BAR;
            PG8_LDA(At, 1, 1); PG8_STAGE(PG8_SA(1, 0), a3, voffA);
            PG8_BAR; PG8_WAIT_L(0); PG8_MMA(1, 0, At, B0); PG8_BAR; PG8_SCHED;
            PG8_STAGE(PG8_SB(1, 1), b3 + hstep, voffB);
            PG8_WAIT_V(6); PG8_BAR; PG8_MMA(1, 1, At, B1); PG8_BAR;
            }
        }
        if constexpr (ALIGN_EPI) { if (wr == 0) PG8_BAR; }
        if constexpr (!Epi::AFTER_DRAIN) { E(acc, cur, wr, wc, fr, fq);
            if constexpr (Epi::TWICE) { asm volatile("" ::: "memory"); E(acc, cur, wr, wc, fr, fq); }
            S.done(cur); }
        if (!has_next) break;
#pragma unroll
        for (int a = 0; a < 2; ++a)
#pragma unroll
            for (int b = 0; b < 2; ++b)
#pragma unroll
                for (int m = 0; m < 4; ++m)
#pragma unroll
                    for (int n = 0; n < 2; ++n) acc[a][b][m][n] = (f32x4){0.f, 0.f, 0.f, 0.f};
        cur = nxt; cA = nA; cB = nB; ++ui;
        if constexpr (ALIGN_EPI) { if (wr == 1) PG8_BAR; }
    }
    PG8_WAIT_V(0);
    if constexpr (!ALIGN_EPI) { if (wr == 0) PG8_BAR; }
    PG8_BAR;
    if constexpr (Epi::AFTER_DRAIN) { E.fused(acc, cur, wr, wc, fr, fq, lds, wid, lane); S.done(cur); }
#undef PG8_SA
#undef PG8_SB
#undef PG8_STAGE
#undef PG8_LDA
#undef PG8_LDB
#undef PG8_MMA
#undef PG8_WAIT_V
#undef PG8_WAIT_L
#undef PG8_BAR
#undef PG8_SCHED
}
}

#define GAS __attribute__((address_space(1)))
#define LAS __attribute__((address_space(3)))
typedef unsigned short bf16;
typedef unsigned v4u __attribute__((ext_vector_type(4)));
typedef float f32x4 __attribute__((ext_vector_type(4)));
typedef short bf16x8 __attribute__((ext_vector_type(8)));
typedef GAS unsigned gu32;
typedef GAS unsigned long long gu64;
#define RLX_AGENT __ATOMIC_RELAXED, __HIP_MEMORY_SCOPE_AGENT
#define LDS_WAIT() asm volatile("s_waitcnt lgkmcnt(0)" ::: "memory")
#define VM_WAIT() asm volatile("s_waitcnt vmcnt(0)" ::: "memory")
__device__ __forceinline__ unsigned long long rt() { return __builtin_amdgcn_s_memrealtime(); }
__device__ __forceinline__ unsigned f2bf(float f) { unsigned u = __builtin_bit_cast(unsigned, f); return (u + 0x7fffu + ((u >> 16) & 1u)) >> 16; }
__device__ __forceinline__ unsigned pk2(float lo, float hi) { return f2bf(lo) | (f2bf(hi) << 16); }

#define XB_TMO      128
#define XB_XCNT(j)  (256  + 64 * (j))
#define XB_XSUB(j)  (1280 + 64 * (j))
#define XB_XGEN(j)  (2304 + 64 * (j))
#define XB_TOP      3328
#define XB_TOPGEN   3392
#define XCD_BAR_WORDS 3456
#define XB_SPIN_CAP (1u << 18)

__device__ __forceinline__ unsigned xb_ld(unsigned* p)              { return __hip_atomic_load(p, __ATOMIC_RELAXED, __HIP_MEMORY_SCOPE_AGENT); }
__device__ __forceinline__ unsigned xb_add(unsigned* p, unsigned v) { return __hip_atomic_fetch_add(p, v, __ATOMIC_RELAXED, __HIP_MEMORY_SCOPE_AGENT); }
__device__ __forceinline__ unsigned xb_xcc_id() { return (unsigned)__builtin_amdgcn_s_getreg((3 << 11) | 20) & 0xFu; }
#define XB_SPIN(cond, bar) do { unsigned _sp = 0; while (cond) { __builtin_amdgcn_s_sleep(1); \
    if ((++_sp & 255u) == 0u) { if (xb_ld(&(bar)[XB_TMO])) break; if (_sp > XB_SPIN_CAP) { atomicAdd(&(bar)[XB_TMO], 1u); break; } } } } while (0)

struct XcdBarrier {
    unsigned* bar; unsigned x;
    volatile LAS unsigned* st;
};

__device__ __forceinline__ XcdBarrier xcd_barrier_post(unsigned* bar, volatile LAS unsigned* st) {
    XcdBarrier b; b.bar = bar; b.x = xb_xcc_id(); b.st = st;
    if (threadIdx.x == 0) (void)xb_add(&bar[XB_XCNT(b.x)], 1u);
    return b;
}
__device__ __forceinline__ void xcd_barrier_complete(unsigned* bar, unsigned x, unsigned& nloc, unsigned& nx) {
    const unsigned G = gridDim.x * gridDim.y * gridDim.z;
    unsigned sum, cnt, mine, sp = 0u;
    for (;;) {
        sum = 0u; cnt = 0u; mine = 0u;
#pragma unroll
        for (unsigned j = 0; j < 16; ++j) { const unsigned c = xb_ld(&bar[XB_XCNT(j)]); sum += c; cnt += (c > 0u) ? 1u : 0u; mine = (j == x) ? c : mine; }
        if (sum == G) break;
        __builtin_amdgcn_s_sleep(1);
        if ((++sp & 255u) == 0u) { if (xb_ld(&bar[XB_TMO])) break; if (sp > XB_SPIN_CAP) { atomicAdd(&bar[XB_TMO], 1u); break; } }
    }
    nloc = mine > 0u ? mine : 1u; nx = cnt > 0u ? cnt : 1u;
}

__device__ __forceinline__ void xcd_barrier(const XcdBarrier& b) {
    asm volatile("s_waitcnt vmcnt(0)" ::: "memory");
    __syncthreads();
    if (threadIdx.x == 0) {
        unsigned* bar = b.bar;
        __builtin_amdgcn_s_waitcnt(0);
        unsigned nloc = b.st[0], nx = b.st[1];
        if (nloc == 0u) { xcd_barrier_complete(bar, b.x, nloc, nx); b.st[0] = nloc; b.st[1] = nx; }
        const unsigned old = xb_add(&bar[XB_XSUB(b.x)], 1u);
        const unsigned gen = old / nloc;
        if (old + 1u == (gen + 1u) * nloc) {
            __builtin_amdgcn_fence(__ATOMIC_RELEASE, "agent");
            asm volatile("s_waitcnt vmcnt(0)" ::: "memory");
            const unsigned og = xb_add(&bar[XB_TOP], 1u);
            const unsigned tg = og / nx;
            if (og + 1u == (tg + 1u) * nx) xb_add(&bar[XB_TOPGEN], 1u);
            else XB_SPIN(xb_ld(&bar[XB_TOPGEN]) == tg, bar);
            __builtin_amdgcn_fence(__ATOMIC_ACQUIRE, "agent");
            xb_add(&bar[XB_XGEN(b.x)], 1u);
            asm volatile("s_waitcnt vmcnt(0)" ::: "memory");
        } else {
            XB_SPIN(xb_ld(&bar[XB_XGEN(b.x)]) == gen, bar);
            __builtin_amdgcn_fence(__ATOMIC_ACQUIRE, "agent");
            asm volatile("s_waitcnt vmcnt(0)" ::: "memory");
        }
    }
    __syncthreads();
}

#ifndef PROBE_REP
#define PROBE_REP 0
#endif
#define REPS(k) ((PROBE_REP == (k)) ? 2 : 1)
constexpr int NWAVES = 8;
constexpr int M = 32768, D = 1024, SEQ = 4096, NPROJ = 2048, NQ = 2048, PLED = 256, NEXP = 16384;
constexpr float EPS = 1e-6f;
#ifndef MK_PER_PHASE
#define MK_PER_PHASE 0
#endif
constexpr int D2NS = 4;
constexpr int D2HV = 4 / D2NS, D2PIECE = 128 * D2HV;
constexpr int NPHASES = 11;

constexpr size_t MiB = 1u << 20;
constexpr size_t WS_CTL = 0, CTL_ZERO_BYTES = 1 * MiB;
constexpr size_t WS_WIN = 2 * MiB, WS_WO = 6 * MiB, WS_WQ = 8 * MiB, WS_WG = 12 * MiB, WS_WP = 14 * MiB, WS_KEYS = 14 * MiB + 512 * 1024;
constexpr size_t WS_WF = 15 * MiB;
constexpr size_t WS_RSX = 17 * MiB, WS_RS1 = 18 * MiB, WS_RS3 = 20 * MiB, WS_RS2 = 23 * MiB;
constexpr size_t WS_SU = 22 * MiB, WS_SV = 22 * MiB + 65536;
constexpr size_t WS_U = 24 * MiB, WS_V = 56 * MiB;
constexpr size_t WS_XB = 88 * MiB;
constexpr size_t WS_PROJ = 152 * MiB;
constexpr size_t WS_MIX = 280 * MiB;
constexpr size_t WS_CF = WS_MIX;
constexpr size_t WS_HB = 344 * MiB;
constexpr size_t WS_EIDX = 408 * MiB, WS_GATE = 424 * MiB;
constexpr size_t WS_PB = 440 * MiB;
constexpr size_t WS_EOFF = 456 * MiB;
constexpr size_t WS_END = 472 * MiB;
constexpr int CW_BAR = 4096;
static_assert((CW_BAR + XCD_BAR_WORDS) * 4 <= (int)CTL_ZERO_BYTES, "CTL words inside the memset region");

constexpr int RING_BYTES = 131072;
constexpr int LDSCTL_OFF = RING_BYTES, MISC_OFF = LDSCTL_OFF + 320;
constexpr int LDS_BYTES = 147456;

typedef float f32x16 __attribute__((ext_vector_type(16)));
typedef _Float16 h2_t __attribute__((ext_vector_type(2)));
typedef float f32x2 __attribute__((ext_vector_type(2)));
typedef int i32x4 __attribute__((ext_vector_type(4)));
typedef unsigned v2u __attribute__((ext_vector_type(2)));

__device__ __forceinline__ float wave_sum(float v) {
    v += __builtin_bit_cast(float, __builtin_amdgcn_mov_dpp(__builtin_bit_cast(int, v), 0xB1, 0xF, 0xF, true));
    v += __builtin_bit_cast(float, __builtin_amdgcn_mov_dpp(__builtin_bit_cast(int, v), 0x4E, 0xF, 0xF, true));
    v += __builtin_bit_cast(float, __builtin_amdgcn_mov_dpp(__builtin_bit_cast(int, v), 0x124, 0xF, 0xF, true));
    v += __builtin_bit_cast(float, __builtin_amdgcn_mov_dpp(__builtin_bit_cast(int, v), 0x128, 0xF, 0xF, true));
    const float r0 = __builtin_bit_cast(float, __builtin_amdgcn_readlane(__builtin_bit_cast(int, v), 0)), r1 = __builtin_bit_cast(float, __builtin_amdgcn_readlane(__builtin_bit_cast(int, v), 16));
    const float r2 = __builtin_bit_cast(float, __builtin_amdgcn_readlane(__builtin_bit_cast(int, v), 32)), r3 = __builtin_bit_cast(float, __builtin_amdgcn_readlane(__builtin_bit_cast(int, v), 48));
    return (r0 + r1) + (r2 + r3);
}
__device__ __forceinline__ float bf_lo(unsigned w) { return __uint_as_float(w << 16); }
__device__ __forceinline__ float bf_hi(unsigned w) { return __uint_as_float(w & 0xffff0000u); }
__device__ __forceinline__ unsigned pkh(float lo, float hi) { f32x2 v = {lo, hi}; h2_t h = __builtin_convertvector(v, h2_t); return __builtin_bit_cast(unsigned, h); }

struct EpiProj {
    static constexpr bool PERM = true, AFTER_DRAIN = false, TWICE = false;
    pg8::bf16_t* O; const float* rowss;
    __device__ __forceinline__ void operator()(const pg8::f32x4 (&acc)[2][2][4][2], const pg8::Unit& u, int wr, int wc, int fr, int fq) const {
        const int row0 = u.pm * 256 + wr * 64 + fr, cw = wc * 32 + 8 * fq; const int pn = u.pn;
        const bool prod = (pn >= 2) && (pn < 6);
        const int cbase = prod ? 512 + (pn - 2) * 128 : (pn < 2 ? pn * 256 : 1024 + (pn - 6) * 256);
#pragma unroll
        for (int ai = 0; ai < 2; ++ai)
#pragma unroll
            for (int m = 0; m < 4; ++m) {
                const int row = row0 + ai * 128 + m * 16;
                const float sc = __builtin_amdgcn_rsqf(rowss[row] * (1.0f / 1024.0f) + EPS);
                pg8::bf16_t* rowp = O + (size_t)row * 1536 + cbase + cw;
                if (prod) {
                    const float s2 = sc * sc;
                    const pg8::f32x4 v0 = acc[ai][0][m][0] * acc[ai][1][m][0] * s2, v1 = acc[ai][0][m][1] * acc[ai][1][m][1] * s2;
                    pg8::u32x4 w; w.x = pg8::cvt_pk_bf16(v0[0], v0[1]); w.y = pg8::cvt_pk_bf16(v0[2], v0[3]); w.z = pg8::cvt_pk_bf16(v1[0], v1[1]); w.w = pg8::cvt_pk_bf16(v1[2], v1[3]);
                    *(pg8::u32x4*)rowp = w;
                } else {
#pragma unroll
                    for (int bj = 0; bj < 2; ++bj) {
                        const pg8::f32x4 v0 = acc[ai][bj][m][0] * sc, v1 = acc[ai][bj][m][1] * sc;
                        pg8::u32x4 w; w.x = pg8::cvt_pk_bf16(v0[0], v0[1]); w.y = pg8::cvt_pk_bf16(v0[2], v0[3]); w.z = pg8::cvt_pk_bf16(v1[0], v1[1]); w.w = pg8::cvt_pk_bf16(v1[2], v1[3]);
                        *(pg8::u32x4*)(rowp + bj * 128) = w;
                    }
                }
            }
    }
};
struct EpiBf16Row {
    static constexpr bool PERM = true, AFTER_DRAIN = false, TWICE = (PROBE_REP == 12);
    pg8::bf16_t* O; int ldc; const float* rowss;
    __device__ __forceinline__ void operator()(const pg8::f32x4 (&acc)[2][2][4][2], const pg8::Unit& u, int wr, int wc, int fr, int fq) const {
        const int row0 = u.pm * 256 + wr * 64 + fr, col0 = u.pn * 256 + wc * 32 + 8 * fq;
#pragma unroll
        for (int ai = 0; ai < 2; ++ai)
#pragma unroll
            for (int m = 0; m < 4; ++m) {
                const int row = row0 + ai * 128 + m * 16;
                const float sc = rowss ? __builtin_amdgcn_rsqf(rowss[row] * (1.0f / 1024.0f) + EPS) : 1.0f;
                pg8::bf16_t* rowp = O + (size_t)row * ldc + col0;
#pragma unroll
                for (int bj = 0; bj < 2; ++bj) {
                    const pg8::f32x4 v0 = acc[ai][bj][m][0] * sc, v1 = acc[ai][bj][m][1] * sc;
                    pg8::u32x4 w; w.x = pg8::cvt_pk_bf16(v0[0], v0[1]); w.y = pg8::cvt_pk_bf16(v0[2], v0[3]); w.z = pg8::cvt_pk_bf16(v1[0], v1[1]); w.w = pg8::cvt_pk_bf16(v1[2], v1[3]);
                    *(pg8::u32x4*)(rowp + bj * 128) = w;
                }
            }
    }
};
struct EpiH1 {
    static constexpr bool PERM = true, AFTER_DRAIN = false, TWICE = (PROBE_REP == 13);
    const float* X; pg8::bf16_t* HB; float* RS;
    __device__ __forceinline__ void operator()(const pg8::f32x4 (&acc)[2][2][4][2], const pg8::Unit& u, int wr, int wc, int fr, int fq) const {
        const int row0 = u.pm * 256 + wr * 64 + fr, col0 = u.pn * 256 + wc * 32 + 8 * fq;
#pragma unroll
        for (int ai = 0; ai < 2; ++ai)
#pragma unroll
            for (int m = 0; m < 4; ++m) {
                const int row = row0 + ai * 128 + m * 16; float s = 0.f;
#pragma unroll
                for (int bj = 0; bj < 2; ++bj) {
                    const size_t off = (size_t)row * 1024 + col0 + bj * 128;
                    const pg8::f32x4 x0 = *(const pg8::f32x4*)(X + off), x1 = *(const pg8::f32x4*)(X + off + 4);
                    const pg8::f32x4 v0 = acc[ai][bj][m][0] + x0, v1 = acc[ai][bj][m][1] + x1;
                    pg8::u32x4 w; w.x = pg8::cvt_pk_bf16(v0[0], v0[1]); w.y = pg8::cvt_pk_bf16(v0[2], v0[3]); w.z = pg8::cvt_pk_bf16(v1[0], v1[1]); w.w = pg8::cvt_pk_bf16(v1[2], v1[3]);
                    *(pg8::u32x4*)(HB + off) = w;
                    s += (v0[0] * v0[0] + v0[1] * v0[1]) + (v0[2] * v0[2] + v0[3] * v0[3]) + (v1[0] * v1[0] + v1[1] * v1[1]) + (v1[2] * v1[2] + v1[3] * v1[3]);
                }
                s += __shfl_xor(s, 16); s += __shfl_xor(s, 32);
                if (fq == 0) RS[(size_t)row * 16 + u.pn * 4 + wc] = s;
            }
    }
};
struct EpiGate {
    static constexpr bool PERM = true, AFTER_DRAIN = false, TWICE = (PROBE_REP == 14);
    pg8::bf16_t* OUT; const pg8::bf16_t* HB; const pg8::bf16_t* PL; const float* RS2; float* RS3;
    __device__ __forceinline__ void operator()(const pg8::f32x4 (&acc)[2][2][4][2], const pg8::Unit& u, int wr, int wc, int fr, int fq) const {
        const int row0 = u.pm * 256 + wr * 64 + fr, col0 = u.pn * 256 + wc * 32 + 8 * fq;
#pragma unroll
        for (int ai = 0; ai < 2; ++ai)
#pragma unroll
            for (int m = 0; m < 4; ++m) {
                const int row = row0 + ai * 128 + m * 16; float s = 0.f;
                float rs2 = 0.f;
#pragma unroll
                for (int k = 0; k < D2NS; ++k) rs2 += RS2[(size_t)row * D2NS + k];
                const float rstd = __builtin_amdgcn_rsqf(rs2 * (1.0f / 1024.0f) + EPS);
#pragma unroll
                for (int bj = 0; bj < 2; ++bj) {
                    const size_t off = (size_t)row * 1024 + col0 + bj * 128;
                    const pg8::u32x4 w = *(const pg8::u32x4*)(PL + off), hw = *(const pg8::u32x4*)(HB + off);
                    const pg8::f32x4 h0 = {bf_lo(hw.x), bf_hi(hw.x), bf_lo(hw.y), bf_hi(hw.y)}, h1 = {bf_lo(hw.z), bf_hi(hw.z), bf_lo(hw.w), bf_hi(hw.w)};
                    const pg8::f32x4 a0 = acc[ai][bj][m][0] * rstd, a1 = acc[ai][bj][m][1] * rstd;
                    pg8::f32x4 g0, g1;
#pragma unroll
                    for (int e = 0; e < 4; ++e) { g0[e] = 1.0f / (1.0f + __expf(-a0[e])); g1[e] = 1.0f / (1.0f + __expf(-a1[e])); }
                    const pg8::f32x4 p0 = {bf_lo(w.x), bf_hi(w.x), bf_lo(w.y), bf_hi(w.y)}, p1 = {bf_lo(w.z), bf_hi(w.z), bf_lo(w.w), bf_hi(w.w)};
                    const pg8::f32x4 v0 = h0 + g0 * p0, v1 = h1 + g1 * p1;
                    { pg8::u32x4 ow; ow.x = pg8::cvt_pk_bf16(v0[0], v0[1]); ow.y = pg8::cvt_pk_bf16(v0[2], v0[3]); ow.z = pg8::cvt_pk_bf16(v1[0], v1[1]); ow.w = pg8::cvt_pk_bf16(v1[2], v1[3]); *(pg8::u32x4*)(OUT + off) = ow; }
                    s += (v0[0] * v0[0] + v0[1] * v0[1]) + (v0[2] * v0[2] + v0[3] * v0[3]) + (v1[0] * v1[0] + v1[1] * v1[1]) + (v1[2] * v1[2] + v1[3] * v1[3]);
                }
                s += __shfl_xor(s, 16); s += __shfl_xor(s, 32);
                if (fq == 0) RS3[(size_t)row * 16 + u.pn * 4 + wc] = s;
            }
    }
};

__device__ __forceinline__ void p0_transpose_item(const float* W, int ldn, const float* gk, int K, bf16* WT, int row_off, int nblk, LAS float* scr, int item, int lane) {
    const int kb = item / nblk, nb = item % nblk, k0 = 64 * kb, n0 = 32 * nb;
    float wv[32];
#pragma unroll
    for (int i = 0; i < 32; ++i) wv[i] = W[(size_t)(k0 + 2 * i + (lane >> 5)) * ldn + n0 + (lane & 31)];
#pragma unroll
    for (int i = 0; i < 32; ++i) { const int kk = 2 * i + (lane >> 5); float v = wv[i]; if (gk) v *= gk[k0 + kk]; scr[kk * 33 + (lane & 31)] = v; }
    LDS_WAIT(); asm volatile("" ::: "memory");
    const int c = lane & 7;
#pragma unroll
    for (int j = 0; j < 4; ++j) { const int n = (lane >> 3) + 8 * j; const LAS float* s = scr + (8 * c) * 33 + n;
        v4u o; o.x = pk2(s[0 * 33], s[1 * 33]); o.y = pk2(s[2 * 33], s[3 * 33]); o.z = pk2(s[4 * 33], s[5 * 33]); o.w = pk2(s[6 * 33], s[7 * 33]);
        *(GAS v4u*)(WT + (size_t)(row_off + n0 + n) * K + k0 + 8 * c) = o; }
    LDS_WAIT(); asm volatile("" ::: "memory");
}

struct Ptrs {
    const float *x, *p, *g_mix, *w_in, *conv_w, *pool_w, *pool_scale, *w_o, *g_ffn, *w_q, *sub_keys, *eu, *ev, *g_ple, *w_gate, *w_proj, *g_final;
    float* out; unsigned char* ws;
};

__device__ __forceinline__ void p0a_phase(const Ptrs& P, LAS unsigned char* lds, int vcu, int G, int tid, int wave, int lane) {
    const int gw = vcu * 4 + (wave & 3), NGW = G * 4;
    const int gt = gw * 64 + lane, NGT = NGW * 64;
    if (wave < 4) {
    {
      for (int tk = gw; tk < 2048; tk += NGW) {
          const int k4 = (tk >> 3) * 4, j = tk & 7, g = j >> 1, np = j * 64 + lane, d = np & 127;
          const float* wi = P.w_in + (size_t)k4 * 2048 + 1536 + g * 128; const float* pw = P.pool_w + (size_t)g * 128 * 128 + d;
          float a0 = 0.f, a1 = 0.f, a2 = 0.f, a3 = 0.f;
          for (int c0 = 0; c0 < 128; c0 += 16) {
              float pv[16], w0[16], w1[16], w2[16], w3[16];
#pragma unroll
              for (int c = 0; c < 16; ++c) { pv[c] = pw[(size_t)(c0 + c) * 128]; w0[c] = wi[c0 + c]; w1[c] = wi[2048 + c0 + c]; w2[c] = wi[4096 + c0 + c]; w3[c] = wi[6144 + c0 + c]; }
#pragma unroll
              for (int c = 0; c < 16; ++c) { a0 += w0[c] * pv[c]; a1 += w1[c] * pv[c]; a2 += w2[c] * pv[c]; a3 += w3[c] * pv[c]; }
          }
          const float sc = P.pool_scale[np];
          { const f32x4 gm = *(const GAS f32x4*)(P.g_mix + k4);
            *(GAS v2u*)((bf16*)(P.ws + WS_WIN) + (size_t)(1536 + np) * 1024 + k4) = (v2u){pk2(a0 * sc * gm.x, a1 * sc * gm.y), pk2(a2 * sc * gm.z, a3 * sc * gm.w)}; }
      } }
    { LAS float* scr = (LAS float*)(lds + wave * 16384);
      constexpr int I_WO = 16 * 32, I_WQ = 16 * 64, I_WG = 16 * 32, I_WP = 4 * 32, I_WINA = 16 * 48;
      constexpr int NITEMS = I_WO + I_WQ + I_WG + I_WP + I_WINA;
      for (int it = gw; it < NITEMS; it += NGW) {
          int r = it;
          if (r < I_WO) { p0_transpose_item(P.w_o, 1024, nullptr, 1024, (bf16*)(P.ws + WS_WO), 0, 32, scr, r, lane); continue; } r -= I_WO;
          if (r < I_WQ) { p0_transpose_item(P.w_q, 2048, P.g_ffn, 1024, (bf16*)(P.ws + WS_WQ), 0, 64, scr, r, lane); continue; } r -= I_WQ;
          if (r < I_WG) { p0_transpose_item(P.w_gate, 1024, P.g_ple, 1024, (bf16*)(P.ws + WS_WG), 0, 32, scr, r, lane); continue; } r -= I_WG;
          if (r < I_WP) { p0_transpose_item(P.w_proj, 1024, nullptr, 256, (bf16*)(P.ws + WS_WP), 0, 32, scr, r, lane); continue; } r -= I_WP;
          {
            const int nb = r % 48, n0 = 32 * nb; int sc0 = n0;
            if (n0 >= 512) { const int jj = (n0 - 512) >> 8, rr = (n0 - 512) & 255; sc0 = rr < 128 ? 512 + 128 * jj + rr : 1024 + 128 * jj + (rr - 128); }
            p0_transpose_item(P.w_in + (sc0 - n0), 2048, P.g_mix, 1024, (bf16*)(P.ws + WS_WIN), 0, 48, scr, r, lane); }
      } }
    } else {
    { for (int r0 = 4 * gw; r0 < NEXP; r0 += 4 * NGW) {
          f32x4 a[4][4]; float q[4];
#pragma unroll
          for (int rr = 0; rr < 4; ++rr) { const GAS f32x4* src = (const GAS f32x4*)(P.eu + (size_t)(r0 + rr) * 1024);
#pragma unroll
              for (int j = 0; j < 4; ++j) a[rr][j] = src[4 * lane + j]; }
          { const GAS f32x4* gf = (const GAS f32x4*)P.g_ffn + 4 * lane;
#pragma unroll
            for (int j = 0; j < 4; ++j) { const f32x4 g = gf[j];
#pragma unroll
                for (int rr = 0; rr < 4; ++rr) a[rr][j] = a[rr][j] * g; } }
#pragma unroll
          for (int rr = 0; rr < 4; ++rr) { q[rr] = 0.f;
#pragma unroll
              for (int j = 0; j < 4; ++j) q[rr] += (a[rr][j].x * a[rr][j].x + a[rr][j].y * a[rr][j].y) + (a[rr][j].z * a[rr][j].z + a[rr][j].w * a[rr][j].w); }
          q[0] = wave_sum(q[0]); q[1] = wave_sum(q[1]); q[2] = wave_sum(q[2]); q[3] = wave_sum(q[3]);
#pragma unroll
          for (int rr = 0; rr < 4; ++rr) { const int e = r0 + rr;
              const float rms = sqrtf(q[rr] * (1.0f / 1024.0f)); const float sc = rms > 0.f ? 2.0f / rms : 0.f;
              unsigned w0 = 0u, w1 = 0u;
              w0 = __builtin_amdgcn_cvt_scalef32_pk_fp4_f32(w0, a[rr][0].x * sc, a[rr][0].y * sc, 1.0f, 0); w0 = __builtin_amdgcn_cvt_scalef32_pk_fp4_f32(w0, a[rr][0].z * sc, a[rr][0].w * sc, 1.0f, 1);
              w0 = __builtin_amdgcn_cvt_scalef32_pk_fp4_f32(w0, a[rr][1].x * sc, a[rr][1].y * sc, 1.0f, 2); w0 = __builtin_amdgcn_cvt_scalef32_pk_fp4_f32(w0, a[rr][1].z * sc, a[rr][1].w * sc, 1.0f, 3);
              w1 = __builtin_amdgcn_cvt_scalef32_pk_fp4_f32(w1, a[rr][2].x * sc, a[rr][2].y * sc, 1.0f, 0); w1 = __builtin_amdgcn_cvt_scalef32_pk_fp4_f32(w1, a[rr][2].z * sc, a[rr][2].w * sc, 1.0f, 1);
              w1 = __builtin_amdgcn_cvt_scalef32_pk_fp4_f32(w1, a[rr][3].x * sc, a[rr][3].y * sc, 1.0f, 2); w1 = __builtin_amdgcn_cvt_scalef32_pk_fp4_f32(w1, a[rr][3].z * sc, a[rr][3].w * sc, 1.0f, 3);
              ((GAS v2u*)(P.ws + WS_U))[(size_t)e * 64 + lane] = (v2u){w0, w1};
              if (lane == 0) ((float*)(P.ws + WS_SU))[e] = rms * 0.5f; }
      } }
    { const int ci = lane >> 2, cb = lane & 3; const int eoff = 256 * cb + 64 * (ci >> 2) + (ci & 3);
      for (int r0 = 2 * gw; r0 < NEXP; r0 += 2 * NGW) {
          float v[2][16]; float q[2];
#pragma unroll
          for (int rr = 0; rr < 2; ++rr) { const float* src = P.ev + (size_t)(r0 + rr) * 1024 + eoff;
#pragma unroll
              for (int n = 0; n < 16; ++n) v[rr][n] = src[4 * n]; }
#pragma unroll
          for (int rr = 0; rr < 2; ++rr) { q[rr] = 0.f;
#pragma unroll
              for (int n = 0; n < 16; ++n) q[rr] += v[rr][n] * v[rr][n]; }
          q[0] = wave_sum(q[0]); q[1] = wave_sum(q[1]);
#pragma unroll
          for (int rr = 0; rr < 2; ++rr) { const int e = r0 + rr;
              const float rms = sqrtf(q[rr] * (1.0f / 1024.0f)); const float sc = rms > 0.f ? 2.0f / rms : 0.f;
              unsigned w0 = 0u, w1 = 0u;
              w0 = __builtin_amdgcn_cvt_scalef32_pk_fp4_f32(w0, v[rr][0] * sc, v[rr][1] * sc, 1.0f, 0); w0 = __builtin_amdgcn_cvt_scalef32_pk_fp4_f32(w0, v[rr][2] * sc, v[rr][3] * sc, 1.0f, 1);
              w0 = __builtin_amdgcn_cvt_scalef32_pk_fp4_f32(w0, v[rr][4] * sc, v[rr][5] * sc, 1.0f, 2); w0 = __builtin_amdgcn_cvt_scalef32_pk_fp4_f32(w0, v[rr][6] * sc, v[rr][7] * sc, 1.0f, 3);
              w1 = __builtin_amdgcn_cvt_scalef32_pk_fp4_f32(w1, v[rr][8] * sc, v[rr][9] * sc, 1.0f, 0); w1 = __builtin_amdgcn_cvt_scalef32_pk_fp4_f32(w1, v[rr][10] * sc, v[rr][11] * sc, 1.0f, 1);
              w1 = __builtin_amdgcn_cvt_scalef32_pk_fp4_f32(w1, v[rr][12] * sc, v[rr][13] * sc, 1.0f, 2); w1 = __builtin_amdgcn_cvt_scalef32_pk_fp4_f32(w1, v[rr][14] * sc, v[rr][15] * sc, 1.0f, 3);
              ((GAS v2u*)(P.ws + WS_V + (size_t)(cb / D2HV) * ((size_t)NEXP * D2PIECE) + (size_t)e * D2PIECE + (cb % D2HV) * 128))[ci] = (v2u){w0, w1};
              if (lane == 0) ((float*)(P.ws + WS_SV))[e] = rms * 0.5f; }
      } }
    { const GAS f32x4* sp = (const GAS f32x4*)P.p; GAS v4u* dp = (GAS v4u*)(P.ws + WS_PB);
      for (int i0 = gt; i0 < M * PLED / 8; i0 += 4 * NGT) {
          f32x4 a[4], b[4];
#pragma unroll
          for (int q = 0; q < 4; ++q) { const int i = i0 + q * NGT; if (i < M * PLED / 8) { a[q] = sp[2 * (size_t)i]; b[q] = sp[2 * (size_t)i + 1]; } }
#pragma unroll
          for (int q = 0; q < 4; ++q) { const int i = i0 + q * NGT; if (i < M * PLED / 8) { v4u o; o.x = pk2(a[q].x, a[q].y); o.y = pk2(a[q].z, a[q].w); o.z = pk2(b[q].x, b[q].y); o.w = pk2(b[q].z, b[q].w); dp[i] = o; } }
      }
      const GAS f32x4* sk = (const GAS f32x4*)P.sub_keys; GAS v4u* dk = (GAS v4u*)(P.ws + WS_KEYS);
      for (int i = gt; i < 16 * 128 * 128 / 8; i += NGT) { const f32x4 a = sk[2 * (size_t)i], b = sk[2 * (size_t)i + 1]; v4u o; o.x = pk2(a.x, a.y); o.y = pk2(a.z, a.w); o.z = pk2(b.x, b.y); o.w = pk2(b.z, b.w); dk[i] = o; } }
    { float* RSX = (float*)(P.ws + WS_RSX); bf16* XB = (bf16*)(P.ws + WS_XB);
      for (int m0 = 4 * gw; m0 < M; m0 += 4 * NGW) {
          f32x4 v[4][4]; float sq[4];
#pragma unroll
          for (int r = 0; r < 4; ++r) { const GAS f32x4* xr = (const GAS f32x4*)(P.x + (size_t)(m0 + r) * D) + lane;
#pragma unroll
              for (int j = 0; j < 4; ++j) v[r][j] = xr[64 * j]; }
#pragma unroll
          for (int r = 0; r < 4; ++r) { sq[r] = 0.f;
#pragma unroll
              for (int j = 0; j < 4; ++j) sq[r] += (v[r][j].x * v[r][j].x + v[r][j].y * v[r][j].y) + (v[r][j].z * v[r][j].z + v[r][j].w * v[r][j].w); }
#pragma unroll
          for (int r = 0; r < 4; ++r) sq[r] = wave_sum(sq[r]);
#pragma unroll
          for (int r = 0; r < 4; ++r) { if (lane == 0) RSX[m0 + r] = sq[r];
              GAS unsigned long long* o8 = (GAS unsigned long long*)(XB + (size_t)(m0 + r) * D) + lane;
#pragma unroll
              for (int j = 0; j < 4; ++j) o8[64 * j] = (unsigned long long)pk2(v[r][j].x, v[r][j].y) | ((unsigned long long)pk2(v[r][j].z, v[r][j].w) << 32); }
      } }
    }
}
__device__ __forceinline__ void p0b_phase(const Ptrs& P, LAS unsigned char* lds, int vcu, int G, int wave, int lane) {
    const int gw = vcu * NWAVES + wave, NGW = G * NWAVES; LAS float* scr = (LAS float*)(lds + wave * 16384);
    for (int it = gw; it < 16 * 16; it += NGW) p0_transpose_item((const float*)(P.ws + WS_WF), 512, P.g_mix, 1024, (bf16*)(P.ws + WS_WIN), 1536, 16, scr, it, lane);
}

template <int HALF>
__device__ __forceinline__ void pool_chunk(const unsigned* col, unsigned* mx, int t0, int s0) {
    constexpr int TC = 32, NV = TC + 2 * HALF;
    float v0[NV], v1[NV];
#pragma unroll
    for (int i = 0; i < NV; ++i) {
        const int s = s0 - HALF + i; const bool ok = (s >= 0) && (s < SEQ);
        const unsigned w = col[(size_t)(ok ? (t0 - HALF + i) : t0) * 768];
        v0[i] = ok ? bf_lo(w) : 0.f; v1[i] = ok ? bf_hi(w) : 0.f;
    }
    float S0 = 0.f, S1 = 0.f;
#pragma unroll
    for (int j = 0; j < 2 * HALF; ++j) { S0 += v0[j]; S1 += v1[j]; }
#pragma unroll
    for (int i = 0; i < TC; ++i) {
        const int s = s0 + i; const int lo = (s - HALF) > 0 ? (s - HALF) : 0, hi = (s + HALF) < SEQ ? (s + HALF) : SEQ;
        const float inv = 1.0f / (float)(hi - lo);
        mx[(size_t)(t0 + i) * 512] = pk2(S0 * inv - v0[i + HALF], S1 * inv - v1[i + HALF]);
        if (i + 1 < TC) { S0 += v0[i + 2 * HALF] - v0[i]; S1 += v1[i + 2 * HALF] - v1[i]; }
    }
}
__device__ __forceinline__ void p2_phase(const Ptrs& P, int vcu, int G, int tid, int wave) {
    const unsigned* PR = (const unsigned*)(P.ws + WS_PROJ);
    unsigned* MX = (unsigned*)(P.ws + WS_MIX);
    constexpr int TC = 32;
    for (int ck = vcu; ck < M / TC; ck += G) {
        const int t0 = ck * TC, s0 = t0 & (SEQ - 1);
        if (tid < 256) {
            const unsigned* col = PR + 512 + tid; unsigned* mx = MX + 256 + tid;
            if (wave == 0) pool_chunk<1>(col, mx, t0, s0); else if (wave == 1) pool_chunk<2>(col, mx, t0, s0); else if (wave == 2) pool_chunk<4>(col, mx, t0, s0); else pool_chunk<8>(col, mx, t0, s0);
        } else {
            const int cp = tid - 256;
            const unsigned* bcol = PR + cp; const unsigned* zcol = PR + 256 + cp;
            const float w00 = P.conv_w[2 * cp], w01 = P.conv_w[2 * cp + 1], w10 = P.conv_w[512 + 2 * cp], w11 = P.conv_w[512 + 2 * cp + 1], w20 = P.conv_w[1024 + 2 * cp], w21 = P.conv_w[1024 + 2 * cp + 1];
            float z0[TC + 2], z1[TC + 2]; unsigned bw[TC];
#pragma unroll
            for (int i = 0; i < TC + 2; ++i) {
                const int s = s0 - 1 + i; const bool ok = (s >= 0) && (s < SEQ);
                const unsigned z = zcol[(size_t)(ok ? (t0 - 1 + i) : t0) * 768];
                z0[i] = ok ? bf_lo(z) : 0.f; z1[i] = ok ? bf_hi(z) : 0.f;
            }
#pragma unroll
            for (int i = 0; i < TC; ++i) bw[i] = bcol[(size_t)(t0 + i) * 768];
#pragma unroll
            for (int i = 0; i < TC; ++i) {
                const float y0 = w00 * z0[i] + w10 * z0[i + 1] + w20 * z0[i + 2], y1 = w01 * z1[i] + w11 * z1[i + 1] + w21 * z1[i + 2];
                MX[(size_t)(t0 + i) * 512 + cp] = pk2(bf_lo(bw[i]) * y0, bf_hi(bw[i]) * y1);
            }
        }
    }
}

__device__ __forceinline__ float fmax_s(float a, float b) { float r; asm("v_max_f32_e32 %0, %1, %2" : "=v"(r) : "v"(a), "v"(b)); return r; }
__device__ __forceinline__ float fmin_s(float a, float b) { float r; asm("v_min_f32_e32 %0, %1, %2" : "=v"(r) : "v"(a), "v"(b)); return r; }
#define CE_DESC(a, b) do { const float _t = fmax_s(a, b); b = fmin_s(a, b); a = _t; } while (0)
#define CE_ASC(a, b)  do { const float _t = fmin_s(a, b); b = fmax_s(a, b); a = _t; } while (0)
__device__ __forceinline__ void sort16_desc(float* a) {
#pragma unroll
    for (int k = 2; k <= 16; k <<= 1)
#pragma unroll
        for (int j = k >> 1; j > 0; j >>= 1)
#pragma unroll
            for (int i = 0; i < 16; ++i) { const int l = i ^ j; if (l > i) { if ((i & k) == 0) CE_DESC(a[i], a[l]); else CE_ASC(a[i], a[l]); } }
}
__device__ __forceinline__ void merge16_desc(float* a) {
#pragma unroll
    for (int j = 8; j > 0; j >>= 1)
#pragma unroll
        for (int i = 0; i < 16; ++i) { const int l = i ^ j; if (l > i) CE_DESC(a[i], a[l]); }
}
__device__ __forceinline__ void top16_merge(float* a, const float* b) {
#pragma unroll
    for (int i = 0; i < 16; ++i) a[i] = fmax_s(a[i], b[15 - i]);
    merge16_desc(a);
}
__device__ __forceinline__ void top16_of_64(float* v) {
    sort16_desc(v); sort16_desc(v + 16); sort16_desc(v + 32); sort16_desc(v + 48);
    top16_merge(v, v + 16); top16_merge(v + 32, v + 48); top16_merge(v, v + 32);
}
__device__ __forceinline__ unsigned key_lookup(unsigned long long lo, unsigned long long hi, unsigned i) {
    const unsigned long long v = (i & 8u) ? hi : lo;
    return (unsigned)(v >> ((i & 7u) * 8u)) & 0x7fu;
}

constexpr int KROW = 272;
__device__ __forceinline__ void score_phase(const Ptrs& P, LAS unsigned char* lds, int bid, int G, int tid, int wave, int lane) {
    const bf16* Q = (const bf16*)(P.ws + WS_PROJ); const bf16* KEYS = (const bf16*)(P.ws + WS_KEYS); const float* RS1 = (const float*)(P.ws + WS_RS1);
    int* EIDX = (int*)(P.ws + WS_EIDX); float* GATE = (float*)(P.ws + WS_GATE);
    const int l31 = lane & 31, hi = lane >> 5;
    int cur_h = -1;
    bf16x8 bqa[2][8];
    if (bid < (M / 256) * 8) { const int tok0 = (bid >> 3) * 256 + wave * 32 + l31;
#pragma unroll
        for (int p = 0; p < 2; ++p) { const bf16* qp = Q + (size_t)tok0 * 2048 + (bid & 7) * 256 + p * 128 + hi * 8;
#pragma unroll
            for (int ks = 0; ks < 8; ++ks) bqa[p][ks] = *(const GAS bf16x8*)(qp + ks * 16); } }
    for (int u = bid; u < (M / 256) * 8; u += G) {
        const int h = u & 7, tile = u >> 3;
        if (h != cur_h) {
            __syncthreads();
#pragma unroll
            for (int i = 0; i < 8; ++i) { const int q = tid + 512 * i, row = q >> 4, ch = q & 15;
                const v4u val = *(const GAS v4u*)(KEYS + ((size_t)(h * 256 + row)) * 128 + ch * 8);
                *(LAS v4u*)(lds + row * KROW + ch * 16) = val; }
            __syncthreads();
            cur_h = h;
        }
        const int tok = tile * 256 + wave * 32 + l31;
        float T0[16], T1[16];
#pragma unroll
        for (int p = 0; p < 2; ++p) {
            f32x16 acc[4];
#pragma unroll
            for (int kb = 0; kb < 4; ++kb)
#pragma unroll
                for (int r = 0; r < 16; ++r) acc[kb][r] = 0.f;
#pragma unroll
            for (int ks = 0; ks < 8; ++ks)
#pragma unroll
                for (int kb = 0; kb < 4; ++kb) {
                    const bf16x8 ak = *(const LAS bf16x8*)(lds + (p * 128 + kb * 32 + l31) * KROW + (ks * 16 + hi * 8) * 2);
                    acc[kb] = __builtin_amdgcn_mfma_f32_32x32x16_bf16(ak, bqa[p][ks], acc[kb], 0, 0, 0);
                }
            if (p == 1) {
                const int un = (u + G < (M / 256) * 8) ? u + G : u; const int tokn = (un >> 3) * 256 + wave * 32 + l31;
                asm volatile("" : "+v"(acc[0]), "+v"(acc[1]), "+v"(acc[2]), "+v"(acc[3]));
#pragma unroll
                for (int pp = 0; pp < 2; ++pp) { const bf16* qp = Q + (size_t)tokn * 2048 + (un & 7) * 256 + pp * 128 + hi * 8;
#pragma unroll
                    for (int ks = 0; ks < 8; ++ks) bqa[pp][ks] = *(const GAS bf16x8*)(qp + ks * 16); }
            }
            float v[64];
#pragma unroll
            for (int kb = 0; kb < 4; ++kb)
#pragma unroll
                for (int r = 0; r < 16; ++r) v[kb * 16 + r] = __uint_as_float((__float_as_uint(acc[kb][r]) & 0xffffff80u) | (unsigned)(kb * 32 + (r & 3) + 8 * (r >> 2)));
            top16_of_64(v);
            const unsigned hb = (unsigned)hi << 2;
#pragma unroll
            for (int i = 0; i < 16; ++i) v[i] = __uint_as_float(__float_as_uint(v[i]) | hb);
            float c[16];
#pragma unroll
            for (int i = 0; i < 16; ++i) c[i] = fmax_s(v[i], __shfl_xor(v[15 - i], 32));
            merge16_desc(c);
#pragma unroll
            for (int i = 0; i < 16; ++i) { if (p == 0) T0[i] = c[i]; else T1[i] = c[i]; }
        }
        float f0[16], f1[16];
        unsigned long long K0lo = 0ull, K0hi = 0ull, K1lo = 0ull, K1hi = 0ull;
#pragma unroll
        for (int b = 0; b < 8; ++b) {
            K0lo |= (unsigned long long)(__float_as_uint(T0[b]) & 0x7fu) << (8 * b); K0hi |= (unsigned long long)(__float_as_uint(T0[8 + b]) & 0x7fu) << (8 * b);
            K1lo |= (unsigned long long)(__float_as_uint(T1[b]) & 0x7fu) << (8 * b); K1hi |= (unsigned long long)(__float_as_uint(T1[8 + b]) & 0x7fu) << (8 * b);
        }
#pragma unroll
        for (int i = 0; i < 16; ++i) { f0[i] = __uint_as_float(__float_as_uint(T0[i]) & 0xffffff80u); f1[i] = __uint_as_float(__float_as_uint(T1[i]) & 0xffffff80u); }
        float cd[32]; int n = 0;
#pragma unroll
        for (int i = 0; i < 16; ++i)
#pragma unroll
            for (int j = 0; j < 16; ++j)
                if ((i + 1) * (j + 1) <= 16) {
                    const float cv = __uint_as_float((__float_as_uint(f0[i] + f1[j]) & 0xffffff00u) | (unsigned)(i * 16 + j));
                    if ((n & 1) == 0) cd[n >> 1] = cv; else cd[n >> 1] = hi ? cv : cd[n >> 1];
                    ++n;
                }
#pragma unroll
        for (int q = 25; q < 32; ++q) cd[q] = __uint_as_float(0xff800000u);
        sort16_desc(cd); sort16_desc(cd + 16); top16_merge(cd, cd + 16);
        { float cm[16];
#pragma unroll
          for (int i = 0; i < 16; ++i) cm[i] = fmax_s(cd[i], __shfl_xor(cd[15 - i], 32));
          merge16_desc(cm);
#pragma unroll
          for (int i = 0; i < 16; ++i) cd[i] = cm[i]; }
        float rs = 0.f;
        { const GAS f32x4* rp = (const GAS f32x4*)(RS1 + (size_t)tok * 16);
#pragma unroll
          for (int i = 0; i < 4; ++i) { const f32x4 a = rp[i]; rs += (a.x + a.y) + (a.z + a.w); } }
        const float rstd = __builtin_amdgcn_rsqf(rs * (1.0f / 1024.0f) + EPS);
        int eidx[16]; float gt_[16]; float z0 = 0.f, sum = 0.f;
#pragma unroll
        for (int k = 0; k < 16; ++k) {
            const unsigned wb = __float_as_uint(cd[k]); const unsigned i = (wb >> 4) & 15u, j = wb & 15u;
            eidx[k] = (int)(key_lookup(K0lo, K0hi, i) * 128u + key_lookup(K1lo, K1hi, j));
            const float z = __uint_as_float(wb & 0xffffff00u) * rstd;
            if (k == 0) z0 = z;
            gt_[k] = __expf(z - z0); sum += gt_[k];
        }
        const float inv = 1.0f / sum;
        if (hi == 0) { GAS i32x4* ep = (GAS i32x4*)(EIDX + (size_t)tok * 128 + h * 16);
#pragma unroll
            for (int q = 0; q < 4; ++q) ep[q] = (i32x4){eidx[4 * q], eidx[4 * q + 1], eidx[4 * q + 2], eidx[4 * q + 3]};
        } else { GAS f32x4* gp = (GAS f32x4*)(GATE + (size_t)tok * 128 + h * 16);
#pragma unroll
            for (int q = 0; q < 4; ++q) gp[q] = (f32x4){gt_[4 * q] * inv, gt_[4 * q + 1] * inv, gt_[4 * q + 2] * inv, gt_[4 * q + 3] * inv};
        }
    }
}

__device__ __forceinline__ float gelu_tanh(float x) {
    const float y = 1.5957691216057308f * (x + 0.044715f * x * x * x);
    return x / (1.0f + __expf(-y));
}
typedef int v8i __attribute__((ext_vector_type(8)));
#define PEER_MFMA(a, b, c) __builtin_amdgcn_mfma_scale_f32_16x16x128_f8f6f4(a, b, c, 4  , 0  , 0, 0x7F7F7F7F, 0, 0x7F7F7F7F)
__device__ __forceinline__ void peer_dots_phase(const Ptrs& P, LAS unsigned char* lds, int vcu, int G, int wave, int lane) {
    const int gw = vcu * NWAVES + wave, NGW = G * NWAVES;
    const bf16* HB = (const bf16*)(P.ws + WS_HB); unsigned char* CF8 = P.ws + WS_CF; int* EOFF = (int*)(P.ws + WS_EOFF);
    const int* EIDX = (const int*)(P.ws + WS_EIDX); const float* GATE = (const float*)(P.ws + WS_GATE);
    const unsigned char* U4 = P.ws + WS_U;
    const float* SU = (const float*)(P.ws + WS_SU); const float* SV = (const float*)(P.ws + WS_SV);
    LAS unsigned char* xl = lds + 65536 + wave * 1024;
    LAS unsigned char* tb = lds + wave * 8192;
    const int lr = lane >> 5, lp = lane & 31;
    const int li = lane & 15, lq = lane >> 4;
    const int kl = 4 * lq + (li & 3);
    const int gam = lq + 4 * (li & 1); const int cpos = lq * 32 + (li & 3), epos = gam * 16 + ((li >> 1) & 1);
    int t = gw; if (t >= M) return;
    int ei0 = __builtin_nontemporal_load(EIDX + (size_t)t * 128 + lane), ei1 = __builtin_nontemporal_load(EIDX + (size_t)t * 128 + 64 + lane);
    float gg0 = __builtin_nontemporal_load(GATE + (size_t)t * 128 + lane), gg1 = __builtin_nontemporal_load(GATE + (size_t)t * 128 + 64 + lane);
    v2u hrow[4];
    { const GAS v2u* hp = (const GAS v2u*)(HB + (size_t)t * 1024) + lane;
#pragma unroll
      for (int j = 0; j < 4; ++j) hrow[j] = __builtin_nontemporal_load(hp + 64 * j); }
    v4u uw[8];
#pragma unroll
    for (int v = 0; v < 8; ++v) { const int e = __shfl(ei0, 2 * v + lr); uw[v] = *(const GAS v4u*)(U4 + (size_t)e * 512 + 16 * lp); }
    for (; t < M; t += NGW) {
        const int tn = (t + NGW < M) ? t + NGW : t;
        f32x2 x[8]; float ss = 0.f;
#pragma unroll
        for (int j = 0; j < 4; ++j) { const unsigned wa = hrow[j].x, wb = hrow[j].y; x[2 * j] = (f32x2){bf_lo(wa), bf_hi(wa)}; x[2 * j + 1] = (f32x2){bf_lo(wb), bf_hi(wb)};
            ss += (x[2 * j].x * x[2 * j].x + x[2 * j].y * x[2 * j].y) + (x[2 * j + 1].x * x[2 * j + 1].x + x[2 * j + 1].y * x[2 * j + 1].y); }
        ss = wave_sum(ss);
        const float rstd = __builtin_amdgcn_rsqf(ss * (1.0f / 1024.0f) + EPS);
        { const float sx = 16.0f * rstd;
#pragma unroll
          for (int j = 0; j < 4; ++j) { int w = __builtin_amdgcn_cvt_pk_fp8_f32(x[2 * j].x * sx, x[2 * j].y * sx, 0, false); w = __builtin_amdgcn_cvt_pk_fp8_f32(x[2 * j + 1].x * sx, x[2 * j + 1].y * sx, w, true);
              const int n = 4 * lane + 256 * j, sN = n >> 7, nn = n & 127, hN = nn >> 6, qN = (nn & 63) >> 4, jN = nn & 15;
              *(LAS unsigned*)(xl + 128 * sN + 32 * qN + 16 * hN + jN) = (unsigned)w; }
          asm volatile("s_waitcnt lgkmcnt(0)" ::: "memory"); }
        v8i xb[8];
#pragma unroll
        for (int sI = 0; sI < 8; ++sI) { const v4u b0 = *(const LAS v4u*)(xl + 128 * sI + 32 * lq), b1 = *(const LAS v4u*)(xl + 128 * sI + 32 * lq + 16);
            xb[sI] = (v8i){(int)b0.x, (int)b0.y, (int)b0.z, (int)b0.w, (int)b1.x, (int)b1.y, (int)b1.z, (int)b1.w}; }
        const int nei0 = __builtin_nontemporal_load(EIDX + (size_t)tn * 128 + lane), nei1 = __builtin_nontemporal_load(EIDX + (size_t)tn * 128 + 64 + lane);
        const float ngg0 = __builtin_nontemporal_load(GATE + (size_t)tn * 128 + lane), ngg1 = __builtin_nontemporal_load(GATE + (size_t)tn * 128 + 64 + lane);
        { const GAS v2u* hn = (const GAS v2u*)(HB + (size_t)tn * 1024) + lane;
#pragma unroll
          for (int j = 0; j < 4; ++j) hrow[j] = __builtin_nontemporal_load(hn + 64 * j); }
        for (int hq = 0; hq < 8 * REPS(7); ++hq) { const int hh = hq & 7;
            const int ereg = hh < 4 ? ei0 : ei1; const float greg = hh < 4 ? gg0 : gg1; const int lb = (hh & 3) * 16;
            const int el = __shfl(ereg, lb + kl);
            const float su = SU[el], sv = SV[el];
#pragma unroll
            for (int v = 0; v < 8; ++v) { const int r = 2 * v + lr; *(LAS v4u*)(tb + 512 * r + 16 * (lp ^ r)) = uw[v]; }
            __builtin_amdgcn_sched_barrier(0);
            { const bool lasth = (hq == 8 * REPS(7) - 1); const int hn = (hh + 1) & 7;
              const int nreg = lasth ? nei0 : (hn < 4 ? ei0 : ei1); const int nlb = (hn & 3) * 16;
#pragma unroll
              for (int v = 0; v < 8; ++v) { const int e = __shfl(nreg, nlb + 2 * v + lr); uw[v] = *(const GAS v4u*)(U4 + (size_t)e * 512 + 16 * lp); } }
            __builtin_amdgcn_sched_barrier(0);
            f32x4 acc = {0.f, 0.f, 0.f, 0.f};
#pragma unroll
            for (int sI = 0; sI < 8; ++sI) { const v4u af = *(const LAS v4u*)(tb + 512 * li + 16 * ((4 * sI + lq) ^ li));
                const v8i av = {(int)af.x, (int)af.y, (int)af.z, (int)af.w, 0, 0, 0, 0}; acc = PEER_MFMA(av, xb[sI], acc); }
            const int rsel = li & 3;
            const float d = rsel == 0 ? acc[0] : (rsel == 1 ? acc[1] : (rsel == 2 ? acc[2] : acc[3]));
            const float gk = __shfl(greg, lb + kl);
            const float cf = gk * gelu_tanh(d * su * (1.0f / 16.0f)) * sv * 1024.0f;
            const float cfc = fminf(fmaxf(cf, -448.0f), 448.0f);
            const unsigned c8 = (unsigned)__builtin_amdgcn_cvt_pk_fp8_f32(cfc, cfc, 0, false);
            if (li < 4) { CF8[(size_t)t * 128 + cpos + hh * 4] = (unsigned char)c8; EOFF[(size_t)t * 128 + epos + hh * 2] = el * D2PIECE; }
        }
        ei0 = nei0; ei1 = nei1; gg0 = ngg0; gg1 = ngg1;
    }
}
__device__ __forceinline__ void peer_sum_phase(const Ptrs& P, LAS unsigned char* lds, int bx, int G, int wave, int lane) {
    static_assert(D2NS == 4, "this body is written for four slices");
    constexpr int NTP = 2, SL = 256, MT = M / NTP, NSLOT = 6, AHD = 5;
    const int kx = bx & 7, sl = kx & 3, tp = kx >> 2, nbk = (G - kx + 7) >> 3;
    const int wj = (bx >> 3) * NWAVES + wave, NW = nbk * NWAVES;
    bf16* HB = (bf16*)(P.ws + WS_HB); float* RS2 = (float*)(P.ws + WS_RS2);
    const unsigned char* CF8 = P.ws + WS_CF; const unsigned char* EOFF = P.ws + WS_EOFF;
    const unsigned char* Vs = P.ws + WS_V + (size_t)sl * ((size_t)NEXP * D2PIECE);
    LAS unsigned char* rec = lds + wave * 16384;
    LAS unsigned char* dring = rec + 4096;
    const int li = lane & 15, lq = lane >> 4, rho = lane >> 3;
    const unsigned lc16 = 16u * (unsigned)(lane & 7);
    unsigned sel[2][8];
    { const unsigned pz = 0x0c0c0c0cu, psh = 8u * (unsigned)(li & 3);
#pragma unroll
      for (int g8 = 0; g8 < 2; ++g8)
#pragma unroll
          for (int r = 0; r < 8; ++r) { const unsigned pl = (pz & ~(0xffu << psh)) | ((unsigned)(2 * g8 + (r >> 2)) << psh); sel[g8][r] = ((r & 3) == (li >> 2)) ? pl : pz; } }
    const bool stl = lane < 40;
    auto rec_ptr = [&](int uu) -> const GAS v4u* { const size_t tt = (size_t)uu * NTP + tp; return (const GAS v4u*)(lane < 32 ? EOFF + tt * 512 + 16 * lane : CF8 + tt * 128 + 16 * (lane & 7)); };
    int u = wj; if (u >= MT) return;
    auto clampu = [&](int xx) { return xx < MT ? xx : u; };
#define D2_DMA(rs_, hd_, is_) do { const v2u eq_ = *(const LAS v2u*)((rs_) + rho * 64 + (hd_) * 8); \
        __builtin_amdgcn_global_load_lds((const unsigned*)(Vs + (size_t)(eq_.x + lc16)), (LAS unsigned*)(dring + (is_) * 2048), 16, 0, 0); \
        __builtin_amdgcn_global_load_lds((const unsigned*)(Vs + (size_t)(eq_.y + lc16)), (LAS unsigned*)(dring + (is_) * 2048 + 1024), 16, 0, 0); } while (0)
#define D2_REC(uu_, slot_) do { if (stl) __builtin_amdgcn_global_load_lds((const unsigned*)rec_ptr(uu_), (LAS unsigned*)(rec + (slot_) * 640), 16, 0, 0); } while (0)
    D2_REC(u, 0); D2_REC(clampu(u + NW), 1); D2_REC(clampu(u + 2 * NW), 2);
    asm volatile("s_waitcnt vmcnt(0)" ::: "memory");
#pragma unroll
    for (int h = 0; h < AHD; ++h) D2_DMA(rec, h, h);
    int cs = 0;
#define D2_IMG(dst_, slot_) do { const LAS unsigned char* im_ = dring + (slot_) * 2048 + (2 * lq) * 128 + 8 * li; \
        (dst_)[0] = *(const LAS v2u*)(im_); (dst_)[1] = *(const LAS v2u*)(im_ + 128); (dst_)[2] = *(const LAS v2u*)(im_ + 1024); (dst_)[3] = *(const LAS v2u*)(im_ + 1152); } while (0)
    v2u acur[4];
    asm volatile("s_waitcnt vmcnt(8)" ::: "memory");
    D2_IMG(acur, 0);
    for (int it = 0; u < MT; u += NW, ++it) {
        const int t = u * NTP + tp;
        LAS unsigned char* scur = rec + (it & 3) * 640; LAS unsigned char* snxt = rec + ((it + 1) & 3) * 640;
        D2_REC(clampu(u + 3 * NW), (it + 3) & 3);
        if (lane < 32) __builtin_amdgcn_global_load_lds((const unsigned*)((const unsigned char*)HB + (size_t)t * 2048 + SL * 2 * sl + 16 * lane), (LAS unsigned*)(rec + 2560), 16, 0, 0);
        v2u eqs[8]; unsigned cws[8];
#pragma unroll
        for (int h = 0; h < 8; ++h) { eqs[h] = *(const LAS v2u*)((h + AHD < 8 ? scur : snxt) + rho * 64 + ((h + AHD) & 7) * 8); cws[h] = *(const LAS unsigned*)(scur + 512 + lq * 32 + h * 4); }
        f32x4 acc = {0.f, 0.f, 0.f, 0.f};
#pragma unroll
        for (int h = 0; h < 8; ++h) {
            { const int is = cs + AHD >= NSLOT ? cs + AHD - NSLOT : cs + AHD;
              __builtin_amdgcn_global_load_lds((const unsigned*)(Vs + (size_t)(eqs[h].x + lc16)), (LAS unsigned*)(dring + is * 2048), 16, 0, 0);
              __builtin_amdgcn_global_load_lds((const unsigned*)(Vs + (size_t)(eqs[h].y + lc16)), (LAS unsigned*)(dring + is * 2048 + 1024), 16, 0, 0); }
            if (h <= 3) asm volatile("s_waitcnt vmcnt(10)" ::: "memory"); else asm volatile("s_waitcnt vmcnt(8)" ::: "memory");
            v2u anxt[4]; { const int ns = cs + 1 >= NSLOT ? 0 : cs + 1; D2_IMG(anxt, ns); }
            const unsigned cw = cws[h];
#pragma unroll
            for (int g8 = 0; g8 < 2; ++g8) {
                const v8i bv = {(int)__builtin_amdgcn_perm(0u, cw, sel[g8][0]), (int)__builtin_amdgcn_perm(0u, cw, sel[g8][1]), (int)__builtin_amdgcn_perm(0u, cw, sel[g8][2]), (int)__builtin_amdgcn_perm(0u, cw, sel[g8][3]),
                                (int)__builtin_amdgcn_perm(0u, cw, sel[g8][4]), (int)__builtin_amdgcn_perm(0u, cw, sel[g8][5]), (int)__builtin_amdgcn_perm(0u, cw, sel[g8][6]), (int)__builtin_amdgcn_perm(0u, cw, sel[g8][7])};
                const v8i av = {(int)acur[2 * g8].x, (int)acur[2 * g8].y, (int)acur[2 * g8 + 1].x, (int)acur[2 * g8 + 1].y, 0, 0, 0, 0};
                acc = PEER_MFMA(av, bv, acc);
            }
#pragma unroll
            for (int k = 0; k < 4; ++k) acur[k] = anxt[k];
            cs = cs + 1 >= NSLOT ? 0 : cs + 1;
        }
        const float osc = 1.0f / 1024.0f;
        const v2u hrow = *(const LAS v2u*)(rec + 2560 + 8 * lane);
        const unsigned wa = hrow.x, wb = hrow.y;
        const f32x2 o0 = (f32x2){bf_lo(wa) + acc[0] * osc, bf_hi(wa) + acc[1] * osc}, o1 = (f32x2){bf_lo(wb) + acc[2] * osc, bf_hi(wb) + acc[3] * osc};
        __builtin_nontemporal_store((v2u){pk2(o0.x, o0.y), pk2(o1.x, o1.y)}, (GAS v2u*)(HB + (size_t)t * 1024 + SL * sl + 4 * lane));
        float s2 = (o0.x * o0.x + o0.y * o0.y) + (o1.x * o1.x + o1.y * o1.y);
        s2 = wave_sum(s2);
        if (lane == 0) RS2[(size_t)t * D2NS + sl] = s2;
    }
    asm volatile("s_waitcnt vmcnt(0)" ::: "memory");
#undef D2_DMA
#undef D2_IMG
#undef D2_REC
}

__device__ __forceinline__ void final_phase(const Ptrs& P, int vcu, int G, int wave, int lane) {
    const int gw = vcu * NWAVES + wave, NGW = G * NWAVES; const float* RS3 = (const float*)(P.ws + WS_RS3); const bf16* H3 = (const bf16*)(P.ws + WS_PROJ);
    const GAS f32x4* gf = (const GAS f32x4*)P.g_final + lane;
    f32x4 g[4];
#pragma unroll
    for (int j = 0; j < 4; ++j) g[j] = gf[64 * j];
    for (int m0 = 2 * gw; m0 < M; m0 += 2 * NGW) {
        v2u hv[2][4]; float rs[2];
#pragma unroll
        for (int r = 0; r < 2; ++r) { const GAS v2u* hp = (const GAS v2u*)(H3 + (size_t)(m0 + r) * D) + lane;
#pragma unroll
            for (int j = 0; j < 4; ++j) hv[r][j] = hp[64 * j];
            rs[r] = 0.f; const GAS f32x4* rp = (const GAS f32x4*)(RS3 + (size_t)(m0 + r) * 16);
#pragma unroll
            for (int i = 0; i < 4; ++i) { const f32x4 a = rp[i]; rs[r] += (a.x + a.y) + (a.z + a.w); } }
#pragma unroll
        for (int r = 0; r < 2; ++r) { const float rstd = __builtin_amdgcn_rsqf(rs[r] * (1.0f / 1024.0f) + EPS);
            GAS f32x4* xr = (GAS f32x4*)(P.out + (size_t)(m0 + r) * D) + lane;
#pragma unroll
            for (int j = 0; j < 4; ++j) { const unsigned wa = hv[r][j].x, wb = hv[r][j].y; const f32x4 v = {bf_lo(wa), bf_hi(wa), bf_lo(wb), bf_hi(wb)}; xr[64 * j] = v * rstd * g[j]; } }
    }
}

struct Args { const float* in[17]; float* out; unsigned char* ws; int ph_lo, ph_hi; };
#ifndef PG8_SP2
#define PG8_SP2 true
#endif
#ifndef PG8_ALIGN
#define PG8_ALIGN true
#endif
__global__ void __launch_bounds__(NWAVES * 64, 2) mega_fwd(Args args) {
    extern __shared__ __attribute__((aligned(16))) unsigned char lds_raw[];
    LAS unsigned char* lds = (LAS unsigned char*)lds_raw;
    volatile LAS unsigned* MISC = (volatile LAS unsigned*)(lds + MISC_OFF);
    const int tid = threadIdx.x, lane = tid & 63, wave = __builtin_amdgcn_readfirstlane(tid >> 6);
    const int G = gridDim.x, bx = blockIdx.x; const int vcu = (G % 8 == 0) ? (bx % 8) * (G / 8) + bx / 8 : bx;
    Ptrs P;
    P.x = args.in[0]; P.p = args.in[1]; P.g_mix = args.in[2]; P.w_in = args.in[3]; P.conv_w = args.in[4]; P.pool_w = args.in[5]; P.pool_scale = args.in[6]; P.w_o = args.in[7];
    P.g_ffn = args.in[8]; P.w_q = args.in[9]; P.sub_keys = args.in[10]; P.eu = args.in[11]; P.ev = args.in[12]; P.g_ple = args.in[13]; P.w_gate = args.in[14]; P.w_proj = args.in[15]; P.g_final = args.in[16];
    P.out = args.out; P.ws = args.ws;
    gu32* ctl = (gu32*)(P.ws + WS_CTL);
    for (int u = tid; u < (LDS_BYTES - LDSCTL_OFF) / 4; u += NWAVES * 64) ((LAS unsigned*)(lds + LDSCTL_OFF))[u] = 0u;
    __syncthreads();
    XcdBarrier bar; bar.bar = (unsigned*)(ctl + CW_BAR); bar.x = 0; bar.st = nullptr;
    if (!MK_PER_PHASE) bar = xcd_barrier_post((unsigned*)(ctl + CW_BAR), MISC + 8);
    const int lo = args.ph_lo, hi = args.ph_hi;
#define IN(k) (lo <= (k) && (k) < hi)
#define SEAM(k) do { if (IN(k) && IN((k) + 1) && (k) != 1) xcd_barrier(bar); } while (0)
    pg8::bf16_t* const WIN = (pg8::bf16_t*)(P.ws + WS_WIN); pg8::bf16_t* const WO = (pg8::bf16_t*)(P.ws + WS_WO); pg8::bf16_t* const WQ = (pg8::bf16_t*)(P.ws + WS_WQ);
    pg8::bf16_t* const WG = (pg8::bf16_t*)(P.ws + WS_WG); pg8::bf16_t* const WP = (pg8::bf16_t*)(P.ws + WS_WP);
    pg8::bf16_t* const XB = (pg8::bf16_t*)(P.ws + WS_XB); pg8::bf16_t* const PL = XB; pg8::bf16_t* const PROJ = (pg8::bf16_t*)(P.ws + WS_PROJ); pg8::bf16_t* const QB = PROJ;
    pg8::bf16_t* const MIX = (pg8::bf16_t*)(P.ws + WS_MIX); pg8::bf16_t* const HB = (pg8::bf16_t*)(P.ws + WS_HB); pg8::bf16_t* const PB = (pg8::bf16_t*)(P.ws + WS_PB);

    if (IN(0)) { for (int rep = 0; rep < REPS(1); ++rep) { p0a_phase(P, lds, vcu, G, tid, wave, lane); SEAM(0); } }
    if (IN(2)) {
        pg8::Gemm g{XB, WIN, M, NPROJ, D}; pg8::StaticOrder S; S.init(M, NPROJ, G, bx);
        EpiProj E{PROJ, (const float*)(P.ws + WS_RSX)};
        for (int rep = 0; rep < REPS(2); ++rep) { pg8::gemm_phase<EpiProj, pg8::StaticOrder, PG8_ALIGN, PG8_SP2>(lds, g, S, E);
        SEAM(2); }
    }
    if (IN(3)) {
        for (int rep = 0; rep < REPS(3); ++rep) p2_phase(P, vcu, G, tid, wave);
        pg8::Gemm g{PB, WP, M, D, PLED}; pg8::StaticOrder S; S.init(M, D, G, bx);
        EpiBf16Row E{PL, D, nullptr};
        for (int rep = 0; rep < REPS(8); ++rep) pg8::gemm_phase<EpiBf16Row, pg8::StaticOrder, PG8_ALIGN, PG8_SP2>(lds, g, S, E);
        SEAM(3);
    }
    if (IN(4)) {
        pg8::Gemm g{MIX, WO, M, D, D}; pg8::StaticOrder S; S.init(M, D, G, bx);
        EpiH1 E{P.x, HB, (float*)(P.ws + WS_RS1)};
        for (int rep = 0; rep < REPS(4); ++rep) { pg8::gemm_phase<EpiH1, pg8::StaticOrder, PG8_ALIGN, PG8_SP2>(lds, g, S, E);
        SEAM(4); }
    }
    if (IN(5)) {
        pg8::Gemm g{HB, WQ, M, NQ, D}; pg8::StaticOrder S; S.init(M, NQ, G, bx);
        EpiBf16Row E{QB, NQ, nullptr};
        for (int rep = 0; rep < REPS(5); ++rep) { pg8::gemm_phase<EpiBf16Row, pg8::StaticOrder, PG8_ALIGN, PG8_SP2>(lds, g, S, E);
        SEAM(5); }
    }
    if (IN(6)) { for (int rep = 0; rep < REPS(6); ++rep) { score_phase(P, lds, bx, G, tid, wave, lane); SEAM(6); } }
    if (IN(7)) { peer_dots_phase(P, lds, vcu, G, wave, lane); SEAM(7); }
    if (IN(8)) { peer_sum_phase(P, lds, bx, G, wave, lane); SEAM(8); }
    if (IN(9)) {
        pg8::Gemm g{HB, WG, M, D, D}; pg8::StaticOrder S; S.init(M, D, G, bx);
        EpiGate E{PROJ  , HB, PL, (const float*)(P.ws + WS_RS2), (float*)(P.ws + WS_RS3)};
        pg8::gemm_phase<EpiGate, pg8::StaticOrder, PG8_ALIGN, PG8_SP2>(lds, g, S, E);
        SEAM(9);
    }
    if (IN(10)) { final_phase(P, vcu, G, wave, lane); }
#undef IN
#undef SEAM
}

extern "C" void kernel_launch(void* const* d_in, const int* in_sizes, int n_in, void* d_out, int out_size, void* d_ws, size_t ws_size, hipStream_t stream) {
    static int grid = 0;
    if (grid == 0) {
        if (n_in != 17 || in_sizes[0] != M * D || out_size != M * D || ws_size < WS_END) { fprintf(stderr, "kernel_launch: unexpected shapes (n_in %d, in0 %d, out %d, ws %zu); nothing launched\n", n_in, n_in > 0 ? in_sizes[0] : -1, out_size, ws_size); grid = -1; return; }
        int dev = 0, cus = 0, per_cu = 0;
        if (hipGetDevice(&dev) != hipSuccess || hipDeviceGetAttribute(&cus, hipDeviceAttributeMultiprocessorCount, dev) != hipSuccess) { fprintf(stderr, "kernel_launch: device query failed\n"); grid = -1; return; }
        if (hipFuncSetAttribute((const void*)mega_fwd, hipFuncAttributeMaxDynamicSharedMemorySize, LDS_BYTES) != hipSuccess) { fprintf(stderr, "kernel_launch: hipFuncSetAttribute failed\n"); grid = -1; return; }
        if (hipOccupancyMaxActiveBlocksPerMultiprocessor(&per_cu, (const void*)mega_fwd, NWAVES * 64, LDS_BYTES) != hipSuccess || per_cu < 1) {
            fprintf(stderr, "kernel_launch: the occupancy query reports %d resident workgroups per CU for this kernel (512 threads, %d B LDS): the grid barrier needs one per CU; nothing launched\n", per_cu, LDS_BYTES);
            (void)hipGetLastError(); grid = -1; return; }
        grid = cus;
    }
    if (grid < 0) return;
    if (hipMemsetAsync((char*)d_ws + WS_CTL, 0, CTL_ZERO_BYTES, stream) != hipSuccess) { fprintf(stderr, "kernel_launch: memset failed\n"); return; }
    Args a{};
    for (int i = 0; i < 17; ++i) a.in[i] = (const float*)d_in[i];
    a.out = (float*)d_out; a.ws = (unsigned char*)d_ws;
#if MK_PER_PHASE
    for (int ph = 0; ph < NPHASES; ++ph) { a.ph_lo = ph; a.ph_hi = ph + 1; hipLaunchKernelGGL(mega_fwd, dim3(grid), dim3(NWAVES * 64), LDS_BYTES, stream, a); }
#else
    a.ph_lo = 0; a.ph_hi = NPHASES;
    hipLaunchKernelGGL(mega_fwd, dim3(grid), dim3(NWAVES * 64), LDS_BYTES, stream, a);
#endif
    const hipError_t le = hipPeekAtLastError();
    if (le != hipSuccess) fprintf(stderr, "kernel_launch: launch failed: %s\n", hipGetErrorName(le));
}
```

```cpp
#include <hip/hip_runtime.h>
#include <cstdio>
#include <cstdint>
namespace pg8 {
#define PG8_LAS __attribute__((address_space(3)))
typedef unsigned short bf16_t;
typedef short bf16x8 __attribute__((ext_vector_type(8)));
typedef float f32x4 __attribute__((ext_vector_type(4)));
typedef unsigned u32x4 __attribute__((ext_vector_type(4)));
constexpr int BM = 256, BK = 64, HALF = 128, HTB = HALF * BK * 2  , STAGE_BYTES = 8 * HTB, NXCD = 8, WGM = 8;

__host__ __device__ __forceinline__ int lds_byte(int r, int c) { const int st = (r >> 4) * 2 + (c >> 5), rr = r & 15, cc = c & 31, ob = rr * 64 + cc * 2; return st * 1024 + (ob ^ (((ob >> 9) & 1) << 5)); }
__host__ __device__ __forceinline__ void stage_rc(int b, int& R, int& C) { const int st = b / 1024, sb = b % 1024, swz = sb ^ (((sb >> 9) & 1) << 5); R = (st >> 1) * 16 + swz / 64; C = (st & 1) * 32 + (swz % 64) / 2; }
__host__ __device__ __forceinline__ int perm32(int rho) { const int n = rho >> 4, i = rho & 15; return 8 * (i >> 2) + 4 * n + (i & 3); }

struct Unit { int pm, pn; };
struct Gemm { const bf16_t* A; const bf16_t* Bt; int M, N, K; };

struct StaticOrder {
    int nM, nN, nwg, G, c;
    __host__ __device__ void init(int M, int N, int G_, int c_) { nM = M / BM; nN = N / BM; nwg = nM * nN; G = G_; c = c_; }
    __host__ __device__ bool next(int i, Unit& u) const {
        const long L = (long)i * G + c; if (L >= nwg) return false;
        int wgid = (int)L; { const int q = nwg / NXCD, r = nwg % NXCD, xcd = wgid % NXCD, off = wgid / NXCD; wgid = (xcd < r ? xcd * (q + 1) : r * (q + 1) + (xcd - r) * q) + off; }
        const int nig = WGM * nN, gid = wgid / nig, fm = gid * WGM, gsz = (nM - fm) < WGM ? (nM - fm) : WGM;
        u.pm = fm + ((wgid % nig) % gsz); u.pn = (wgid % nig) / gsz; return true;
    }
    __device__ __forceinline__ void a_ready(const Unit&) const {}
    __device__ __forceinline__ void done(const Unit&) const {}
};

__device__ __forceinline__ unsigned cvt_pk_bf16(float lo, float hi) { unsigned r; asm volatile("v_cvt_pk_bf16_f32 %0, %1, %2" : "=v"(r) : "v"(lo), "v"(hi)); return r; }
template <class Epi, class Sched, bool ALIGN_EPI = false, bool SP2 = false>
__device__ __forceinline__ void gemm_phase(PG8_LAS unsigned char* lds, const Gemm g, const Sched& S, const Epi& E) {
    const int tid = threadIdx.x, wid = __builtin_amdgcn_readfirstlane(tid >> 6), lane = tid & 63, wr = wid >> 2, wc = wid & 3, fr = lane & 15, fq = lane >> 4;
    const int K = g.K, nt = K / BK;
    unsigned voffA[2], voffB[2];
#pragma unroll
    for (int i = 0; i < 2; ++i) { int R, C; stage_rc(tid * 16 + i * 8192, R, C); const int Rb = Epi::PERM ? ((R & ~31) + perm32(R & 31)) : R;
        voffA[i] = (unsigned)(R * K + C) * 2u; voffB[i] = (unsigned)(Rb * K + C) * 2u; }
    const size_t kstep = (size_t)(BK * 2);
    const size_t hstep = (size_t)HALF * K * 2;
    const size_t tstep = 2 * hstep;
    const unsigned ldsw = (unsigned)wid * 1024u;
    const int aoff = lds_byte(wr * 64 + fr, fq * 8), boff = lds_byte(wc * 32 + fr, fq * 8);
#define PG8_SA(b, h) (((b) * 2 + (h)) * HTB)
#define PG8_SB(b, h) ((4 + (b) * 2 + (h)) * HTB)
#define PG8_STAGE(bufoff, gbase, voff) do { _Pragma("unroll") for (int _i = 0; _i < 2; ++_i) \
        __builtin_amdgcn_global_load_lds((const unsigned*)((const char*)(gbase) + (voff)[_i]), (PG8_LAS unsigned*)(lds + (bufoff) + ldsw + _i * 8192), 16, 0, 0); } while (0)
#define PG8_LDA(dst, b, h) do { _Pragma("unroll") for (int m = 0; m < 4; ++m) _Pragma("unroll") for (int k = 0; k < 2; ++k) dst[m][k] = *(const PG8_LAS bf16x8*)(lds + PG8_SA(b, h) + aoff + m * 2048 + k * 1024); } while (0)
#define PG8_LDB(dst, b, h) do { _Pragma("unroll") for (int n = 0; n < 2; ++n) _Pragma("unroll") for (int k = 0; k < 2; ++k) dst[n][k] = *(const PG8_LAS bf16x8*)(lds + PG8_SB(b, h) + boff + n * 2048 + k * 1024); } while (0)
#define PG8_MMA(ai, bj, At, Bt) do { __builtin_amdgcn_s_setprio(1); _Pragma("unroll") for (int m = 0; m < 4; ++m) _Pragma("unroll") for (int n = 0; n < 2; ++n) _Pragma("unroll") for (int k = 0; k < 2; ++k) \
        acc[ai][bj][m][n] = __builtin_amdgcn_mfma_f32_16x16x32_bf16(Bt[n][k], At[m][k], acc[ai][bj][m][n], 0, 0, 0); __builtin_amdgcn_s_setprio(0); } while (0)
#define PG8_WAIT_V(n) asm volatile("s_waitcnt vmcnt(" #n ")" ::: "memory")
#define PG8_WAIT_L(n) asm volatile("s_waitcnt lgkmcnt(" #n ")" ::: "memory")
#define PG8_BAR __builtin_amdgcn_s_barrier()
#define PG8_SCHED __builtin_amdgcn_sched_barrier(0)
    Unit cur, nxt; int ui = 0;
    if (!S.next(0, cur)) return;
    f32x4 acc[2][2][4][2];
#pragma unroll
    for (int a = 0; a < 2; ++a)
#pragma unroll
        for (int b = 0; b < 2; ++b)
#pragma unroll
            for (int m = 0; m < 4; ++m)
#pragma unroll
                for (int n = 0; n < 2; ++n) acc[a][b][m][n] = (f32x4){0.f, 0.f, 0.f, 0.f};
    bf16x8 At[4][2], B0[2][2], B1[2][2];
    const char* cA = (const char*)g.A + (size_t)cur.pm * tstep; const char* cB = (const char*)g.Bt + (size_t)cur.pn * tstep;
    S.a_ready(cur);
    if constexpr (SP2) {
        PG8_STAGE(PG8_SB(0, 0), cB, voffB); PG8_STAGE(PG8_SB(0, 1), cB + hstep, voffB); PG8_STAGE(PG8_SA(0, 0), cA, voffA); PG8_STAGE(PG8_SA(0, 1), cA + hstep, voffA);
        if (wr == 1) PG8_BAR;
        PG8_WAIT_V(2); PG8_BAR;
        PG8_STAGE(PG8_SB(1, 0), cB + kstep, voffB); PG8_STAGE(PG8_SA(1, 0), cA + kstep, voffA); PG8_STAGE(PG8_SB(1, 1), cB + hstep + kstep, voffB);
        PG8_WAIT_V(6); PG8_BAR;
    } else {
        PG8_STAGE(PG8_SB(0, 0), cB, voffB); PG8_STAGE(PG8_SA(0, 0), cA, voffA); PG8_STAGE(PG8_SB(0, 1), cB + hstep, voffB); PG8_STAGE(PG8_SA(0, 1), cA + hstep, voffA);
        if (wr == 1) PG8_BAR;
        PG8_WAIT_V(4); PG8_BAR;
        PG8_STAGE(PG8_SB(1, 0), cB + kstep, voffB); PG8_STAGE(PG8_SA(1, 0), cA + kstep, voffA); PG8_STAGE(PG8_SB(1, 1), cB + hstep + kstep, voffB);
        PG8_WAIT_V(6); PG8_BAR;
    }
    for (;;) {
        const bool has_next = S.next(ui + 1, nxt);
        const char* nA = has_next ? (const char*)g.A + (size_t)nxt.pm * tstep : cA; const char* nB = has_next ? (const char*)g.Bt + (size_t)nxt.pn * tstep : cB;
        for (int t = 0; t < nt; t += 2) {
            const bool last = (t == nt - 2);
            const char* a1 = cA + (size_t)(t + 1) * kstep;
            const char* a2 = last ? nA : cA + (size_t)(t + 2) * kstep; const char* b2 = last ? nB : cB + (size_t)(t + 2) * kstep;
            const char* a3 = a2 + kstep; const char* b3 = b2 + kstep;
            if (last && has_next) S.a_ready(nxt);
            if constexpr (SP2) {
            PG8_LDB(B0, 0, 0); PG8_LDB(B1, 0, 1); PG8_SCHED; PG8_LDA(At, 0, 0); PG8_STAGE(PG8_SA(1, 1), a1 + hstep, voffA);
            PG8_WAIT_V(8); PG8_WAIT_L(0); PG8_BAR; PG8_MMA(0, 0, At, B0); PG8_MMA(0, 1, At, B1); PG8_BAR; PG8_SCHED;
            PG8_LDA(At, 0, 1); PG8_STAGE(PG8_SB(0, 0), b2, voffB); PG8_STAGE(PG8_SB(0, 1), b2 + hstep, voffB); PG8_STAGE(PG8_SA(0, 0), a2, voffA);
            PG8_WAIT_V(8); PG8_WAIT_L(0); PG8_BAR; PG8_MMA(1, 0, At, B0); PG8_MMA(1, 1, At, B1); PG8_BAR; PG8_SCHED;
            PG8_LDB(B0, 1, 0); PG8_LDB(B1, 1, 1); PG8_SCHED; PG8_LDA(At, 1, 0); PG8_STAGE(PG8_SA(0, 1), a2 + hstep, voffA);
            PG8_WAIT_V(8); PG8_WAIT_L(0); PG8_BAR; PG8_MMA(0, 0, At, B0); PG8_MMA(0, 1, At, B1); PG8_BAR; PG8_SCHED;
            PG8_LDA(At, 1, 1); PG8_STAGE(PG8_SB(1, 0), b3, voffB); PG8_STAGE(PG8_SB(1, 1), b3 + hstep, voffB); PG8_STAGE(PG8_SA(1, 0), a3, voffA);
            PG8_WAIT_V(8); PG8_WAIT_L(0); PG8_BAR; PG8_MMA(1, 0, At, B0); PG8_MMA(1, 1, At, B1); PG8_BAR; PG8_SCHED;
            } else {
            PG8_LDB(B0, 0, 0); PG8_SCHED; PG8_LDA(At, 0, 0); PG8_STAGE(PG8_SA(1, 1), a1 + hstep, voffA);
            PG8_WAIT_L(8); PG8_BAR; PG8_WAIT_L(0); PG8_MMA(0, 0, At, B0); PG8_BAR; PG8_SCHED;
            PG8_LDB(B1, 0, 1); PG8_STAGE(PG8_SB(0, 0), b2, voffB);
            PG8_BAR; PG8_WAIT_L(0); PG8_MMA(0, 1, At, B1); PG8_BAR;
            PG8_LDA(At, 0, 1); PG8_STAGE(PG8_SA(0, 0), a2, voffA);
            PG8_BAR; PG8_WAIT_L(0); PG8_MMA(1, 0, At, B0); PG8_BAR; PG8_SCHED;
            PG8_STAGE(PG8_SB(0, 1), b2 + hstep, voffB);
            PG8_WAIT_V(6); PG8_BAR; PG8_MMA(1, 1, At, B1); PG8_BAR;
            PG8_LDB(B0, 1, 0); PG8_SCHED; PG8_LDA(At, 1, 0); PG8_STAGE(PG8_SA(0, 1), a2 + hstep, voffA);
            PG8_WAIT_L(8); PG8_BAR; PG8_WAIT_L(0); PG8_MMA(0, 0, At, B0); PG8_BAR; PG8_SCHED;
            PG8_LDB(B1, 1, 1); PG8_STAGE(PG8_SB(1, 0), b3, voffB);
            PG8_BAR; PG8_WAIT_L(0); PG8_MMA(0, 1, At, B1); PG8_BAR;
            PG8_LDA(At, 1, 1); PG8_STAGE(PG8_SA(1, 0), a3, voffA);
            PG8_BAR; PG8_WAIT_L(0); PG8_MMA(1, 0, At, B0); PG8_BAR; PG8_SCHED;
            PG8_STAGE(PG8_SB(1, 1), b3 + hstep, voffB);
            PG8_WAIT_V(6); PG8_BAR; PG8_MMA(1, 1, At, B1); PG8_BAR;
            }
        }
        if constexpr (ALIGN_EPI) { if (wr == 0) PG8_BAR; }
        if constexpr (!Epi::AFTER_DRAIN) { E(acc, cur, wr, wc, fr, fq);
            if constexpr (Epi::TWICE) { asm volatile("" ::: "memory"); E(acc, cur, wr, wc, fr, fq); }
            S.done(cur); }
        if (!has_next) break;
#pragma unroll
        for (int a = 0; a < 2; ++a)
#pragma unroll
            for (int b = 0; b < 2; ++b)
#pragma unroll
                for (int m = 0; m < 4; ++m)
#pragma unroll
                    for (int n = 0; n < 2; ++n) acc[a][b][m][n] = (f32x4){0.f, 0.f, 0.f, 0.f};
        cur = nxt; cA = nA; cB = nB; ++ui;
        if constexpr (ALIGN_EPI) { if (wr == 1) PG8_BAR; }
    }
    PG8_WAIT_V(0);
    if constexpr (!ALIGN_EPI) { if (wr == 0) PG8_BAR; }
    PG8_BAR;
    if constexpr (Epi::AFTER_DRAIN) { E.fused(acc, cur, wr, wc, fr, fq, lds, wid, lane); S.done(cur); }
#undef PG8_SA
#undef PG8_SB
#undef PG8_STAGE
#undef PG8_LDA
#undef PG8_LDB
#undef PG8_MMA
#undef PG8_WAIT_V
#undef PG8_WAIT_L
#undef PG8_BAR
#undef PG8_SCHED
}
}

#define GAS __attribute__((address_space(1)))
#define LAS __attribute__((address_space(3)))
typedef unsigned short bf16;
typedef unsigned v4u __attribute__((ext_vector_type(4)));
typedef float f32x4 __attribute__((ext_vector_type(4)));
typedef short bf16x8 __attribute__((ext_vector_type(8)));
typedef GAS unsigned gu32;
typedef GAS unsigned long long gu64;
#define RLX_AGENT __ATOMIC_RELAXED, __HIP_MEMORY_SCOPE_AGENT
#define LDS_WAIT() asm volatile("s_waitcnt lgkmcnt(0)" ::: "memory")
#define VM_WAIT() asm volatile("s_waitcnt vmcnt(0)" ::: "memory")
__device__ __forceinline__ unsigned long long rt() { return __builtin_amdgcn_s_memrealtime(); }
__device__ __forceinline__ unsigned f2bf(float f) { unsigned u = __builtin_bit_cast(unsigned, f); return (u + 0x7fffu + ((u >> 16) & 1u)) >> 16; }
__device__ __forceinline__ unsigned pk2(float lo, float hi) { return f2bf(lo) | (f2bf(hi) << 16); }

#define XB_TMO      128
#define XB_XCNT(j)  (256  + 64 * (j))
#define XB_XSUB(j)  (1280 + 64 * (j))
#define XB_XGEN(j)  (2304 + 64 * (j))
#define XB_TOP      3328
#define XB_TOPGEN   3392
#define XCD_BAR_WORDS 3456
#define XB_SPIN_CAP (1u << 18)

__device__ __forceinline__ unsigned xb_ld(unsigned* p)              { return __hip_atomic_load(p, __ATOMIC_RELAXED, __HIP_MEMORY_SCOPE_AGENT); }
__device__ __forceinline__ unsigned xb_add(unsigned* p, unsigned v) { return __hip_atomic_fetch_add(p, v, __ATOMIC_RELAXED, __HIP_MEMORY_SCOPE_AGENT); }
__device__ __forceinline__ unsigned xb_xcc_id() { return (unsigned)__builtin_amdgcn_s_getreg((3 << 11) | 20) & 0xFu; }
#define XB_SPIN(cond, bar) do { unsigned _sp = 0; while (cond) { __builtin_amdgcn_s_sleep(1); \
    if ((++_sp & 255u) == 0u) { if (xb_ld(&(bar)[XB_TMO])) break; if (_sp > XB_SPIN_CAP) { atomicAdd(&(bar)[XB_TMO], 1u); break; } } } } while (0)

struct XcdBarrier {
    unsigned* bar; unsigned x;
    volatile LAS unsigned* st;
};

__device__ __forceinline__ XcdBarrier xcd_barrier_post(unsigned* bar, volatile LAS unsigned* st) {
    XcdBarrier b; b.bar = bar; b.x = xb_xcc_id(); b.st = st;
    if (threadIdx.x == 0) (void)xb_add(&bar[XB_XCNT(b.x)], 1u);
    return b;
}
__device__ __forceinline__ void xcd_barrier_complete(unsigned* bar, unsigned x, unsigned& nloc, unsigned& nx) {
    const unsigned G = gridDim.x * gridDim.y * gridDim.z;
    unsigned sum, cnt, mine, sp = 0u;
    for (;;) {
        sum = 0u; cnt = 0u; mine = 0u;
#pragma unroll
        for (unsigned j = 0; j < 16; ++j) { const unsigned c = xb_ld(&bar[XB_XCNT(j)]); sum += c; cnt += (c > 0u) ? 1u : 0u; mine = (j == x) ? c : mine; }
        if (sum == G) break;
        __builtin_amdgcn_s_sleep(1);
        if ((++sp & 255u) == 0u) { if (xb_ld(&bar[XB_TMO])) break; if (sp > XB_SPIN_CAP) { atomicAdd(&bar[XB_TMO], 1u); break; } }
    }
    nloc = mine > 0u ? mine : 1u; nx = cnt > 0u ? cnt : 1u;
}

__device__ __forceinline__ void xcd_barrier(const XcdBarrier& b) {
    asm volatile("s_waitcnt vmcnt(0)" ::: "memory");
    __syncthreads();
    if (threadIdx.x == 0) {
        unsigned* bar = b.bar;
        __builtin_amdgcn_s_waitcnt(0);
        unsigned nloc = b.st[0], nx = b.st[1];
        if (nloc == 0u) { xcd_barrier_complete(bar, b.x, nloc, nx); b.st[0] = nloc; b.st[1] = nx; }
        const unsigned old = xb_add(&bar[XB_XSUB(b.x)], 1u);
        const unsigned gen = old / nloc;
        if (old + 1u == (gen + 1u) * nloc) {
            __builtin_amdgcn_fence(__ATOMIC_RELEASE, "agent");
            asm volatile("s_waitcnt vmcnt(0)" ::: "memory");
            const unsigned og = xb_add(&bar[XB_TOP], 1u);
            const unsigned tg = og / nx;
            if (og + 1u == (tg + 1u) * nx) xb_add(&bar[XB_TOPGEN], 1u);
            else XB_SPIN(xb_ld(&bar[XB_TOPGEN]) == tg, bar);
            __builtin_amdgcn_fence(__ATOMIC_ACQUIRE, "agent");
            xb_add(&bar[XB_XGEN(b.x)], 1u);
            asm volatile("s_waitcnt vmcnt(0)" ::: "memory");
        } else {
            XB_SPIN(xb_ld(&bar[XB_XGEN(b.x)]) == gen, bar);
            __builtin_amdgcn_fence(__ATOMIC_ACQUIRE, "agent");
            asm volatile("s_waitcnt vmcnt(0)" ::: "memory");
        }
    }
    __syncthreads();
}

#ifndef PROBE_REP
#define PROBE_REP 0
#endif
#define REPS(k) ((PROBE_REP == (k)) ? 2 : 1)
constexpr int NWAVES = 8;
constexpr int M = 32768, D = 1024, SEQ = 4096, NPROJ = 2048, NQ = 2048, PLED = 256, NEXP = 16384;
constexpr float EPS = 1e-6f;
#ifndef MK_PER_PHASE
#define MK_PER_PHASE 0
#endif
constexpr int D2NS = 4;
constexpr int D2HV = 4 / D2NS, D2PIECE = 128 * D2HV;
constexpr int NPHASES = 11;

constexpr size_t MiB = 1u << 20;
constexpr size_t WS_CTL = 0, CTL_ZERO_BYTES = 1 * MiB;
constexpr size_t WS_WIN = 2 * MiB, WS_WO = 6 * MiB, WS_WQ = 8 * MiB, WS_WG = 12 * MiB, WS_WP = 14 * MiB, WS_KEYS = 14 * MiB + 512 * 1024;
constexpr size_t WS_WF = 15 * MiB;
constexpr size_t WS_RSX = 17 * MiB, WS_RS1 = 18 * MiB, WS_RS3 = 20 * MiB, WS_RS2 = 23 * MiB;
constexpr size_t WS_SU = 22 * MiB, WS_SV = 22 * MiB + 65536;
constexpr size_t WS_U = 24 * MiB, WS_V = 56 * MiB;
constexpr size_t WS_XB = 88 * MiB;
constexpr size_t WS_PROJ = 152 * MiB;
constexpr size_t WS_MIX = 280 * MiB;
constexpr size_t WS_CF = WS_MIX;
constexpr size_t WS_HB = 344 * MiB;
constexpr size_t WS_EIDX = 408 * MiB, WS_GATE = 424 * MiB;
constexpr size_t WS_PB = 440 * MiB;
constexpr size_t WS_EOFF = 456 * MiB;
constexpr size_t WS_END = 472 * MiB;
constexpr int CW_BAR = 4096;
static_assert((CW_BAR + XCD_BAR_WORDS) * 4 <= (int)CTL_ZERO_BYTES, "CTL words inside the memset region");

constexpr int RING_BYTES = 131072;
constexpr int LDSCTL_OFF = RING_BYTES, MISC_OFF = LDSCTL_OFF + 320;
constexpr int LDS_BYTES = 147456;

typedef float f32x16 __attribute__((ext_vector_type(16)));
typedef _Float16 h2_t __attribute__((ext_vector_type(2)));
typedef float f32x2 __attribute__((ext_vector_type(2)));
typedef int i32x4 __attribute__((ext_vector_type(4)));
typedef unsigned v2u __attribute__((ext_vector_type(2)));

__device__ __forceinline__ float wave_sum(float v) {
    v += __builtin_bit_cast(float, __builtin_amdgcn_mov_dpp(__builtin_bit_cast(int, v), 0xB1, 0xF, 0xF, true));
    v += __builtin_bit_cast(float, __builtin_amdgcn_mov_dpp(__builtin_bit_cast(int, v), 0x4E, 0xF, 0xF, true));
    v += __builtin_bit_cast(float, __builtin_amdgcn_mov_dpp(__builtin_bit_cast(int, v), 0x124, 0xF, 0xF, true));
    v += __builtin_bit_cast(float, __builtin_amdgcn_mov_dpp(__builtin_bit_cast(int, v), 0x128, 0xF, 0xF, true));
    const float r0 = __builtin_bit_cast(float, __builtin_amdgcn_readlane(__builtin_bit_cast(int, v), 0)), r1 = __builtin_bit_cast(float, __builtin_amdgcn_readlane(__builtin_bit_cast(int, v), 16));
    const float r2 = __builtin_bit_cast(float, __builtin_amdgcn_readlane(__builtin_bit_cast(int, v), 32)), r3 = __builtin_bit_cast(float, __builtin_amdgcn_readlane(__builtin_bit_cast(int, v), 48));
    return (r0 + r1) + (r2 + r3);
}
__device__ __forceinline__ float bf_lo(unsigned w) { return __uint_as_float(w << 16); }
__device__ __forceinline__ float bf_hi(unsigned w) { return __uint_as_float(w & 0xffff0000u); }
__device__ __forceinline__ unsigned pkh(float lo, float hi) { f32x2 v = {lo, hi}; h2_t h = __builtin_convertvector(v, h2_t); return __builtin_bit_cast(unsigned, h); }

struct EpiProj {
    static constexpr bool PERM = true, AFTER_DRAIN = false, TWICE = false;
    pg8::bf16_t* O; const float* rowss;
    __device__ __forceinline__ void operator()(const pg8::f32x4 (&acc)[2][2][4][2], const pg8::Unit& u, int wr, int wc, int fr, int fq) const {
        const int row0 = u.pm * 256 + wr * 64 + fr, cw = wc * 32 + 8 * fq; const int pn = u.pn;
        const bool prod = (pn >= 2) && (pn < 6);
        const int cbase = prod ? 512 + (pn - 2) * 128 : (pn < 2 ? pn * 256 : 1024 + (pn - 6) * 256);
#pragma unroll
        for (int ai = 0; ai < 2; ++ai)
#pragma unroll
            for (int m = 0; m < 4; ++m) {
                const int row = row0 + ai * 128 + m * 16;
                const float sc = __builtin_amdgcn_rsqf(rowss[row] * (1.0f / 1024.0f) + EPS);
                pg8::bf16_t* rowp = O + (size_t)row * 1536 + cbase + cw;
                if (prod) {
                    const float s2 = sc * sc;
                    const pg8::f32x4 v0 = acc[ai][0][m][0] * acc[ai][1][m][0] * s2, v1 = acc[ai][0][m][1] * acc[ai][1][m][1] * s2;
                    pg8::u32x4 w; w.x = pg8::cvt_pk_bf16(v0[0], v0[1]); w.y = pg8::cvt_pk_bf16(v0[2], v0[3]); w.z = pg8::cvt_pk_bf16(v1[0], v1[1]); w.w = pg8::cvt_pk_bf16(v1[2], v1[3]);
                    *(pg8::u32x4*)rowp = w;
                } else {
#pragma unroll
                    for (int bj = 0; bj < 2; ++bj) {
                        const pg8::f32x4 v0 = acc[ai][bj][m][0] * sc, v1 = acc[ai][bj][m][1] * sc;
                        pg8::u32x4 w; w.x = pg8::cvt_pk_bf16(v0[0], v0[1]); w.y = pg8::cvt_pk_bf16(v0[2], v0[3]); w.z = pg8::cvt_pk_bf16(v1[0], v1[1]); w.w = pg8::cvt_pk_bf16(v1[2], v1[3]);
                        *(pg8::u32x4*)(rowp + bj * 128) = w;
                    }
                }
            }
    }
};
struct EpiBf16Row {
    static constexpr bool PERM = true, AFTER_DRAIN = false, TWICE = (PROBE_REP == 12);
    pg8::bf16_t* O; int ldc; const float* rowss;
    __device__ __forceinline__ void operator()(const pg8::f32x4 (&acc)[2][2][4][2], const pg8::Unit& u, int wr, int wc, int fr, int fq) const {
        const int row0 = u.pm * 256 + wr * 64 + fr, col0 = u.pn * 256 + wc * 32 + 8 * fq;
#pragma unroll
        for (int ai = 0; ai < 2; ++ai)
#pragma unroll
            for (int m = 0; m < 4; ++m) {
                const int row = row0 + ai * 128 + m * 16;
                const float sc = rowss ? __builtin_amdgcn_rsqf(rowss[row] * (1.0f / 1024.0f) + EPS) : 1.0f;
                pg8::bf16_t* rowp = O + (size_t)row * ldc + col0;
#pragma unroll
                for (int bj = 0; bj < 2; ++bj) {
                    const pg8::f32x4 v0 = acc[ai][bj][m][0] * sc, v1 = acc[ai][bj][m][1] * sc;
                    pg8::u32x4 w; w.x = pg8::cvt_pk_bf16(v0[0], v0[1]); w.y = pg8::cvt_pk_bf16(v0[2], v0[3]); w.z = pg8::cvt_pk_bf16(v1[0], v1[1]); w.w = pg8::cvt_pk_bf16(v1[2], v1[3]);
                    *(pg8::u32x4*)(rowp + bj * 128) = w;
                }
            }
    }
};
struct EpiH1 {
    static constexpr bool PERM = true, AFTER_DRAIN = false, TWICE = (PROBE_REP == 13);
    const float* X; pg8::bf16_t* HB; float* RS;
    __device__ __forceinline__ void operator()(const pg8::f32x4 (&acc)[2][2][4][2], const pg8::Unit& u, int wr, int wc, int fr, int fq) const {
        const int row0 = u.pm * 256 + wr * 64 + fr, col0 = u.pn * 256 + wc * 32 + 8 * fq;
#pragma unroll
        for (int ai = 0; ai < 2; ++ai)
#pragma unroll
            for (int m = 0; m < 4; ++m) {
                const int row = row0 + ai * 128 + m * 16; float s = 0.f;
#pragma unroll
                for (int bj = 0; bj < 2; ++bj) {
                    const size_t off = (size_t)row * 1024 + col0 + bj * 128;
                    const pg8::f32x4 x0 = *(const pg8::f32x4*)(X + off), x1 = *(const pg8::f32x4*)(X + off + 4);
                    const pg8::f32x4 v0 = acc[ai][bj][m][0] + x0, v1 = acc[ai][bj][m][1] + x1;
                    pg8::u32x4 w; w.x = pg8::cvt_pk_bf16(v0[0], v0[1]); w.y = pg8::cvt_pk_bf16(v0[2], v0[3]); w.z = pg8::cvt_pk_bf16(v1[0], v1[1]); w.w = pg8::cvt_pk_bf16(v1[2], v1[3]);
                    *(pg8::u32x4*)(HB + off) = w;
                    s += (v0[0] * v0[0] + v0[1] * v0[1]) + (v0[2] * v0[2] + v0[3] * v0[3]) + (v1[0] * v1[0] + v1[1] * v1[1]) + (v1[2] * v1[2] + v1[3] * v1[3]);
                }
                s += __shfl_xor(s, 16); s += __shfl_xor(s, 32);
                if (fq == 0) RS[(size_t)row * 16 + u.pn * 4 + wc] = s;
            }
    }
};
struct EpiGate {
    static constexpr bool PERM = true, AFTER_DRAIN = false, TWICE = (PROBE_REP == 14);
    pg8::bf16_t* OUT; const pg8::bf16_t* HB; const pg8::bf16_t* PL; const float* RS2; float* RS3;
    __device__ __forceinline__ void operator()(const pg8::f32x4 (&acc)[2][2][4][2], const pg8::Unit& u, int wr, int wc, int fr, int fq) const {
        const int row0 = u.pm * 256 + wr * 64 + fr, col0 = u.pn * 256 + wc * 32 + 8 * fq;
#pragma unroll
        for (int ai = 0; ai < 2; ++ai)
#pragma unroll
            for (int m = 0; m < 4; ++m) {
                const int row = row0 + ai * 128 + m * 16; float s = 0.f;
                float rs2 = 0.f;
#pragma unroll
                for (int k = 0; k < D2NS; ++k) rs2 += RS2[(size_t)row * D2NS + k];
                const float rstd = __builtin_amdgcn_rsqf(rs2 * (1.0f / 1024.0f) + EPS);
#pragma unroll
                for (int bj = 0; bj < 2; ++bj) {
                    const size_t off = (size_t)row * 1024 + col0 + bj * 128;
                    const pg8::u32x4 w = *(const pg8::u32x4*)(PL + off), hw = *(const pg8::u32x4*)(HB + off);
                    const pg8::f32x4 h0 = {bf_lo(hw.x), bf_hi(hw.x), bf_lo(hw.y), bf_hi(hw.y)}, h1 = {bf_lo(hw.z), bf_hi(hw.z), bf_lo(hw.w), bf_hi(hw.w)};
                    const pg8::f32x4 a0 = acc[ai][bj][m][0] * rstd, a1 = acc[ai][bj][m][1] * rstd;
                    pg8::f32x4 g0, g1;
#pragma unroll
                    for (int e = 0; e < 4; ++e) { g0[e] = 1.0f / (1.0f + __expf(-a0[e])); g1[e] = 1.0f / (1.0f + __expf(-a1[e])); }
                    const pg8::f32x4 p0 = {bf_lo(w.x), bf_hi(w.x), bf_lo(w.y), bf_hi(w.y)}, p1 = {bf_lo(w.z), bf_hi(w.z), bf_lo(w.w), bf_hi(w.w)};
                    const pg8::f32x4 v0 = h0 + g0 * p0, v1 = h1 + g1 * p1;
                    { pg8::u32x4 ow; ow.x = pg8::cvt_pk_bf16(v0[0], v0[1]); ow.y = pg8::cvt_pk_bf16(v0[2], v0[3]); ow.z = pg8::cvt_pk_bf16(v1[0], v1[1]); ow.w = pg8::cvt_pk_bf16(v1[2], v1[3]); *(pg8::u32x4*)(OUT + off) = ow; }
                    s += (v0[0] * v0[0] + v0[1] * v0[1]) + (v0[2] * v0[2] + v0[3] * v0[3]) + (v1[0] * v1[0] + v1[1] * v1[1]) + (v1[2] * v1[2] + v1[3] * v1[3]);
                }
                s += __shfl_xor(s, 16); s += __shfl_xor(s, 32);
                if (fq == 0) RS3[(size_t)row * 16 + u.pn * 4 + wc] = s;
            }
    }
};

__device__ __forceinline__ void p0_transpose_item(const float* W, int ldn, const float* gk, int K, bf16* WT, int row_off, int nblk, LAS float* scr, int item, int lane) {
    const int kb = item / nblk, nb = item % nblk, k0 = 64 * kb, n0 = 32 * nb;
    float wv[32];
#pragma unroll
    for (int i = 0; i < 32; ++i) wv[i] = W[(size_t)(k0 + 2 * i + (lane >> 5)) * ldn + n0 + (lane & 31)];
#pragma unroll
    for (int i = 0; i < 32; ++i) { const int kk = 2 * i + (lane >> 5); float v = wv[i]; if (gk) v *= gk[k0 + kk]; scr[kk * 33 + (lane & 31)] = v; }
    LDS_WAIT(); asm volatile("" ::: "memory");
    const int c = lane & 7;
#pragma unroll
    for (int j = 0; j < 4; ++j) { const int n = (lane >> 3) + 8 * j; const LAS float* s = scr + (8 * c) * 33 + n;
        v4u o; o.x = pk2(s[0 * 33], s[1 * 33]); o.y = pk2(s[2 * 33], s[3 * 33]); o.z = pk2(s[4 * 33], s[5 * 33]); o.w = pk2(s[6 * 33], s[7 * 33]);
        *(GAS v4u*)(WT + (size_t)(row_off + n0 + n) * K + k0 + 8 * c) = o; }
    LDS_WAIT(); asm volatile("" ::: "memory");
}

struct Ptrs {
    const float *x, *p, *g_mix, *w_in, *conv_w, *pool_w, *pool_scale, *w_o, *g_ffn, *w_q, *sub_keys, *eu, *ev, *g_ple, *w_gate, *w_proj, *g_final;
    float* out; unsigned char* ws;
};

__device__ __forceinline__ void p0a_phase(const Ptrs& P, LAS unsigned char* lds, int vcu, int G, int tid, int wave, int lane) {
    const int gw = vcu * 4 + (wave & 3), NGW = G * 4;
    const int gt = gw * 64 + lane, NGT = NGW * 64;
    if (wave < 4) {
    {
      for (int tk = gw; tk < 2048; tk += NGW) {
          const int k4 = (tk >> 3) * 4, j = tk & 7, g = j >> 1, np = j * 64 + lane, d = np & 127;
          const float* wi = P.w_in + (size_t)k4 * 2048 + 1536 + g * 128; const float* pw = P.pool_w + (size_t)g * 128 * 128 + d;
          float a0 = 0.f, a1 = 0.f, a2 = 0.f, a3 = 0.f;
          for (int c0 = 0; c0 < 128; c0 += 16) {
              float pv[16], w0[16], w1[16], w2[16], w3[16];
#pragma unroll
              for (int c = 0; c < 16; ++c) { pv[c] = pw[(size_t)(c0 + c) * 128]; w0[c] = wi[c0 + c]; w1[c] = wi[2048 + c0 + c]; w2[c] = wi[4096 + c0 + c]; w3[c] = wi[6144 + c0 + c]; }
#pragma unroll
              for (int c = 0; c < 16; ++c) { a0 += w0[c] * pv[c]; a1 += w1[c] * pv[c]; a2 += w2[c] * pv[c]; a3 += w3[c] * pv[c]; }
          }
          const float sc = P.pool_scale[np];
          { const f32x4 gm = *(const GAS f32x4*)(P.g_mix + k4);
            *(GAS v2u*)((bf16*)(P.ws + WS_WIN) + (size_t)(1536 + np) * 1024 + k4) = (v2u){pk2(a0 * sc * gm.x, a1 * sc * gm.y), pk2(a2 * sc * gm.z, a3 * sc * gm.w)}; }
      } }
    { LAS float* scr = (LAS float*)(lds + wave * 16384);
      constexpr int I_WO = 16 * 32, I_WQ = 16 * 64, I_WG = 16 * 32, I_WP = 4 * 32, I_WINA = 16 * 48;
      constexpr int NITEMS = I_WO + I_WQ + I_WG + I_WP + I_WINA;
      for (int it = gw; it < NITEMS; it += NGW) {
          int r = it;
          if (r < I_WO) { p0_transpose_item(P.w_o, 1024, nullptr, 1024, (bf16*)(P.ws + WS_WO), 0, 32, scr, r, lane); continue; } r -= I_WO;
          if (r < I_WQ) { p0_transpose_item(P.w_q, 2048, P.g_ffn, 1024, (bf16*)(P.ws + WS_WQ), 0, 64, scr, r, lane); continue; } r -= I_WQ;
          if (r < I_WG) { p0_transpose_item(P.w_gate, 1024, P.g_ple, 1024, (bf16*)(P.ws + WS_WG), 0, 32, scr, r, lane); continue; } r -= I_WG;
          if (r < I_WP) { p0_transpose_item(P.w_proj, 1024, nullptr, 256, (bf16*)(P.ws + WS_WP), 0, 32, scr, r, lane); continue; } r -= I_WP;
          {
            const int nb = r % 48, n0 = 32 * nb; int sc0 = n0;
            if (n0 >= 512) { const int jj = (n0 - 512) >> 8, rr = (n0 - 512) & 255; sc0 = rr < 128 ? 512 + 128 * jj + rr : 1024 + 128 * jj + (rr - 128); }
            p0_transpose_item(P.w_in + (sc0 - n0), 2048, P.g_mix, 1024, (bf16*)(P.ws + WS_WIN), 0, 48, scr, r, lane); }
      } }
    } else {
    { for (int r0 = 4 * gw; r0 < NEXP; r0 += 4 * NGW) {
          f32x4 a[4][4]; float q[4];
#pragma unroll
          for (int rr = 0; rr < 4; ++rr) { const GAS f32x4* src = (const GAS f32x4*)(P.eu + (size_t)(r0 + rr) * 1024);
#pragma unroll
              for (int j = 0; j < 4; ++j) a[rr][j] = src[4 * lane + j]; }
          { const GAS f32x4* gf = (const GAS f32x4*)P.g_ffn + 4 * lane;
#pragma unroll
            for (int j = 0; j < 4; ++j) { const f32x4 g = gf[j];
#pragma unroll
                for (int rr = 0; rr < 4; ++rr) a[rr][j] = a[rr][j] * g; } }
#pragma unroll
          for (int rr = 0; rr < 4; ++rr) { q[rr] = 0.f;
#pragma unroll
              for (int j = 0; j < 4; ++j) q[rr] += (a[rr][j].x * a[rr][j].x + a[rr][j].y * a[rr][j].y) + (a[rr][j].z * a[rr][j].z + a[rr][j].w * a[rr][j].w); }
          q[0] = wave_sum(q[0]); q[1] = wave_sum(q[1]); q[2] = wave_sum(q[2]); q[3] = wave_sum(q[3]);
#pragma unroll
          for (int rr = 0; rr < 4; ++rr) { const int e = r0 + rr;
              const float rms = sqrtf(q[rr] * (1.0f / 1024.0f)); const float sc = rms > 0.f ? 2.0f / rms : 0.f;
              unsigned w0 = 0u, w1 = 0u;
              w0 = __builtin_amdgcn_cvt_scalef32_pk_fp4_f32(w0, a[rr][0].x * sc, a[rr][0].y * sc, 1.0f, 0); w0 = __builtin_amdgcn_cvt_scalef32_pk_fp4_f32(w0, a[rr][0].z * sc, a[rr][0].w * sc, 1.0f, 1);
              w0 = __builtin_amdgcn_cvt_scalef32_pk_fp4_f32(w0, a[rr][1].x * sc, a[rr][1].y * sc, 1.0f, 2); w0 = __builtin_amdgcn_cvt_scalef32_pk_fp4_f32(w0, a[rr][1].z * sc, a[rr][1].w * sc, 1.0f, 3);
              w1 = __builtin_amdgcn_cvt_scalef32_pk_fp4_f32(w1, a[rr][2].x * sc, a[rr][2].y * sc, 1.0f, 0); w1 = __builtin_amdgcn_cvt_scalef32_pk_fp4_f32(w1, a[rr][2].z * sc, a[rr][2].w * sc, 1.0f, 1);
              w1 = __builtin_amdgcn_cvt_scalef32_pk_fp4_f32(w1, a[rr][3].x * sc, a[rr][3].y * sc, 1.0f, 2); w1 = __builtin_amdgcn_cvt_scalef32_pk_fp4_f32(w1, a[rr][3].z * sc, a[rr][3].w * sc, 1.0f, 3);
              ((GAS v2u*)(P.ws + WS_U))[(size_t)e * 64 + lane] = (v2u){w0, w1};
              if (lane == 0) ((float*)(P.ws + WS_SU))[e] = rms * 0.5f; }
      } }
    { const int ci = lane >> 2, cb = lane & 3; const int eoff = 256 * cb + 64 * (ci >> 2) + (ci & 3);
      for (int r0 = 2 * gw; r0 < NEXP; r0 += 2 * NGW) {
          float v[2][16]; float q[2];
#pragma unroll
          for (int rr = 0; rr < 2; ++rr) { const float* src = P.ev + (size_t)(r0 + rr) * 1024 + eoff;
#pragma unroll
              for (int n = 0; n < 16; ++n) v[rr][n] = src[4 * n]; }
#pragma unroll
          for (int rr = 0; rr < 2; ++rr) { q[rr] = 0.f;
#pragma unroll
              for (int n = 0; n < 16; ++n) q[rr] += v[rr][n] * v[rr][n]; }
          q[0] = wave_sum(q[0]); q[1] = wave_sum(q[1]);
#pragma unroll
          for (int rr = 0; rr < 2; ++rr) { const int e = r0 + rr;
              const float rms = sqrtf(q[rr] * (1.0f / 1024.0f)); const float sc = rms > 0.f ? 2.0f / rms : 0.f;
              unsigned w0 = 0u, w1 = 0u;
              w0 = __builtin_amdgcn_cvt_scalef32_pk_fp4_f32(w0, v[rr][0] * sc, v[rr][1] * sc, 1.0f, 0); w0 = __builtin_amdgcn_cvt_scalef32_pk_fp4_f32(w0, v[rr][2] * sc, v[rr][3] * sc, 1.0f, 1);
              w0 = __builtin_amdgcn_cvt_scalef32_pk_fp4_f32(w0, v[rr][4] * sc, v[rr][5] * sc, 1.0f, 2); w0 = __builtin_amdgcn_cvt_scalef32_pk_fp4_f32(w0, v[rr][6] * sc, v[rr][7] * sc, 1.0f, 3);
              w1 = __builtin_amdgcn_cvt_scalef32_pk_fp4_f32(w1, v[rr][8] * sc, v[rr][9] * sc, 1.0f, 0); w1 = __builtin_amdgcn_cvt_scalef32_pk_fp4_f32(w1, v[rr][10] * sc, v[rr][11] * sc, 1.0f, 1);
              w1 = __builtin_amdgcn_cvt_scalef32_pk_fp4_f32(w1, v[rr][12] * sc, v[rr][13] * sc, 1.0f, 2); w1 = __builtin_amdgcn_cvt_scalef32_pk_fp4_f32(w1, v[rr][14] * sc, v[rr][15] * sc, 1.0f, 3);
              ((GAS v2u*)(P.ws + WS_V + (size_t)(cb / D2HV) * ((size_t)NEXP * D2PIECE) + (size_t)e * D2PIECE + (cb % D2HV) * 128))[ci] = (v2u){w0, w1};
              if (lane == 0) ((float*)(P.ws + WS_SV))[e] = rms * 0.5f; }
      } }
    { const GAS f32x4* sp = (const GAS f32x4*)P.p; GAS v4u* dp = (GAS v4u*)(P.ws + WS_PB);
      for (int i0 = gt; i0 < M * PLED / 8; i0 += 4 * NGT) {
          f32x4 a[4], b[4];
#pragma unroll
          for (int q = 0; q < 4; ++q) { const int i = i0 + q * NGT; if (i < M * PLED / 8) { a[q] = sp[2 * (size_t)i]; b[q] = sp[2 * (size_t)i + 1]; } }
#pragma unroll
          for (int q = 0; q < 4; ++q) { const int i = i0 + q * NGT; if (i < M * PLED / 8) { v4u o; o.x = pk2(a[q].x, a[q].y); o.y = pk2(a[q].z, a[q].w); o.z = pk2(b[q].x, b[q].y); o.w = pk2(b[q].z, b[q].w); dp[i] = o; } }
      }
      const GAS f32x4* sk = (const GAS f32x4*)P.sub_keys; GAS v4u* dk = (GAS v4u*)(P.ws + WS_KEYS);
      for (int i = gt; i < 16 * 128 * 128 / 8; i += NGT) { const f32x4 a = sk[2 * (size_t)i], b = sk[2 * (size_t)i + 1]; v4u o; o.x = pk2(a.x, a.y); o.y = pk2(a.z, a.w); o.z = pk2(b.x, b.y); o.w = pk2(b.z, b.w); dk[i] = o; } }
    { float* RSX = (float*)(P.ws + WS_RSX); bf16* XB = (bf16*)(P.ws + WS_XB);
      for (int m0 = 4 * gw; m0 < M; m0 += 4 * NGW) {
          f32x4 v[4][4]; float sq[4];
#pragma unroll
          for (int r = 0; r < 4; ++r) { const GAS f32x4* xr = (const GAS f32x4*)(P.x + (size_t)(m0 + r) * D) + lane;
#pragma unroll
              for (int j = 0; j < 4; ++j) v[r][j] = xr[64 * j]; }
#pragma unroll
          for (int r = 0; r < 4; ++r) { sq[r] = 0.f;
#pragma unroll
              for (int j = 0; j < 4; ++j) sq[r] += (v[r][j].x * v[r][j].x + v[r][j].y * v[r][j].y) + (v[r][j].z * v[r][j].z + v[r][j].w * v[r][j].w); }
#pragma unroll
          for (int r = 0; r < 4; ++r) sq[r] = wave_sum(sq[r]);
#pragma unroll
          for (int r = 0; r < 4; ++r) { if (lane == 0) RSX[m0 + r] = sq[r];
              GAS unsigned long long* o8 = (GAS unsigned long long*)(XB + (size_t)(m0 + r) * D) + lane;
#pragma unroll
              for (int j = 0; j < 4; ++j) o8[64 * j] = (unsigned long long)pk2(v[r][j].x, v[r][j].y) | ((unsigned long long)pk2(v[r][j].z, v[r][j].w) << 32); }
      } }
    }
}
__device__ __forceinline__ void p0b_phase(const Ptrs& P, LAS unsigned char* lds, int vcu, int G, int wave, int lane) {
    const int gw = vcu * NWAVES + wave, NGW = G * NWAVES; LAS float* scr = (LAS float*)(lds + wave * 16384);
    for (int it = gw; it < 16 * 16; it += NGW) p0_transpose_item((const float*)(P.ws + WS_WF), 512, P.g_mix, 1024, (bf16*)(P.ws + WS_WIN), 1536, 16, scr, it, lane);
}

template <int HALF>
__device__ __forceinline__ void pool_chunk(const unsigned* col, unsigned* mx, int t0, int s0) {
    constexpr int TC = 32, NV = TC + 2 * HALF;
    float v0[NV], v1[NV];
#pragma unroll
    for (int i = 0; i < NV; ++i) {
        const int s = s0 - HALF + i; const bool ok = (s >= 0) && (s < SEQ);
        const unsigned w = col[(size_t)(ok ? (t0 - HALF + i) : t0) * 768];
        v0[i] = ok ? bf_lo(w) : 0.f; v1[i] = ok ? bf_hi(w) : 0.f;
    }
    float S0 = 0.f, S1 = 0.f;
#pragma unroll
    for (int j = 0; j < 2 * HALF; ++j) { S0 += v0[j]; S1 += v1[j]; }
#pragma unroll
    for (int i = 0; i < TC; ++i) {
        const int s = s0 + i; const int lo = (s - HALF) > 0 ? (s - HALF) : 0, hi = (s + HALF) < SEQ ? (s + HALF) : SEQ;
        const float inv = 1.0f / (float)(hi - lo);
        mx[(size_t)(t0 + i) * 512] = pk2(S0 * inv - v0[i + HALF], S1 * inv - v1[i + HALF]);
        if (i + 1 < TC) { S0 += v0[i + 2 * HALF] - v0[i]; S1 += v1[i + 2 * HALF] - v1[i]; }
    }
}
__device__ __forceinline__ void p2_phase(const Ptrs& P, int vcu, int G, int tid, int wave) {
    const unsigned* PR = (const unsigned*)(P.ws + WS_PROJ);
    unsigned* MX = (unsigned*)(P.ws + WS_MIX);
    constexpr int TC = 32;
    for (int ck = vcu; ck < M / TC; ck += G) {
        const int t0 = ck * TC, s0 = t0 & (SEQ - 1);
        if (tid < 256) {
            const unsigned* col = PR + 512 + tid; unsigned* mx = MX + 256 + tid;
            if (wave == 0) pool_chunk<1>(col, mx, t0, s0); else if (wave == 1) pool_chunk<2>(col, mx, t0, s0); else if (wave == 2) pool_chunk<4>(col, mx, t0, s0); else pool_chunk<8>(col, mx, t0, s0);
        } else {
            const int cp = tid - 256;
            const unsigned* bcol = PR + cp; const unsigned* zcol = PR + 256 + cp;
            const float w00 = P.conv_w[2 * cp], w01 = P.conv_w[2 * cp + 1], w10 = P.conv_w[512 + 2 * cp], w11 = P.conv_w[512 + 2 * cp + 1], w20 = P.conv_w[1024 + 2 * cp], w21 = P.conv_w[1024 + 2 * cp + 1];
            float z0[TC + 2], z1[TC + 2]; unsigned bw[TC];
#pragma unroll
            for (int i = 0; i < TC + 2; ++i) {
                const int s = s0 - 1 + i; const bool ok = (s >= 0) && (s < SEQ);
                const unsigned z = zcol[(size_t)(ok ? (t0 - 1 + i) : t0) * 768];
                z0[i] = ok ? bf_lo(z) : 0.f; z1[i] = ok ? bf_hi(z) : 0.f;
            }
#pragma unroll
            for (int i = 0; i < TC; ++i) bw[i] = bcol[(size_t)(t0 + i) * 768];
#pragma unroll
            for (int i = 0; i < TC; ++i) {
                const float y0 = w00 * z0[i] + w10 * z0[i + 1] + w20 * z0[i + 2], y1 = w01 * z1[i] + w11 * z1[i + 1] + w21 * z1[i + 2];
                MX[(size_t)(t0 + i) * 512 + cp] = pk2(bf_lo(bw[i]) * y0, bf_hi(bw[i]) * y1);
            }
        }
    }
}

__device__ __forceinline__ float fmax_s(float a, float b) { float r; asm("v_max_f32_e32 %0, %1, %2" : "=v"(r) : "v"(a), "v"(b)); return r; }
__device__ __forceinline__ float fmin_s(float a, float b) { float r; asm("v_min_f32_e32 %0, %1, %2" : "=v"(r) : "v"(a), "v"(b)); return r; }
#define CE_DESC(a, b) do { const float _t = fmax_s(a, b); b = fmin_s(a, b); a = _t; } while (0)
#define CE_ASC(a, b)  do { const float _t = fmin_s(a, b); b = fmax_s(a, b); a = _t; } while (0)
__device__ __forceinline__ void sort16_desc(float* a) {
#pragma unroll
    for (int k = 2; k <= 16; k <<= 1)
#pragma unroll
        for (int j = k >> 1; j > 0; j >>= 1)
#pragma unroll
            for (int i = 0; i < 16; ++i) { const int l = i ^ j; if (l > i) { if ((i & k) == 0) CE_DESC(a[i], a[l]); else CE_ASC(a[i], a[l]); } }
}
__device__ __forceinline__ void merge16_desc(float* a) {
#pragma unroll
    for (int j = 8; j > 0; j >>= 1)
#pragma unroll
        for (int i = 0; i < 16; ++i) { const int l = i ^ j; if (l > i) CE_DESC(a[i], a[l]); }
}
__device__ __forceinline__ void top16_merge(float* a, const float* b) {
#pragma unroll
    for (int i = 0; i < 16; ++i) a[i] = fmax_s(a[i], b[15 - i]);
    merge16_desc(a);
}
__device__ __forceinline__ void top16_of_64(float* v) {
    sort16_desc(v); sort16_desc(v + 16); sort16_desc(v + 32); sort16_desc(v + 48);
    top16_merge(v, v + 16); top16_merge(v + 32, v + 48); top16_merge(v, v + 32);
}
__device__ __forceinline__ unsigned key_lookup(unsigned long long lo, unsigned long long hi, unsigned i) {
    const unsigned long long v = (i & 8u) ? hi : lo;
    return (unsigned)(v >> ((i & 7u) * 8u)) & 0x7fu;
}

constexpr int KROW = 272;
__device__ __forceinline__ void score_phase(const Ptrs& P, LAS unsigned char* lds, int bid, int G, int tid, int wave, int lane) {
    const bf16* Q = (const bf16*)(P.ws + WS_PROJ); const bf16* KEYS = (const bf16*)(P.ws + WS_KEYS); const float* RS1 = (const float*)(P.ws + WS_RS1);
    int* EIDX = (int*)(P.ws + WS_EIDX); float* GATE = (float*)(P.ws + WS_GATE);
    const int l31 = lane & 31, hi = lane >> 5;
    int cur_h = -1;
    bf16x8 bqa[2][8];
    if (bid < (M / 256) * 8) { const int tok0 = (bid >> 3) * 256 + wave * 32 + l31;
#pragma unroll
        for (int p = 0; p < 2; ++p) { const bf16* qp = Q + (size_t)tok0 * 2048 + (bid & 7) * 256 + p * 128 + hi * 8;
#pragma unroll
            for (int ks = 0; ks < 8; ++ks) bqa[p][ks] = *(const GAS bf16x8*)(qp + ks * 16); } }
    for (int u = bid; u < (M / 256) * 8; u += G) {
        const int h = u & 7, tile = u >> 3;
        if (h != cur_h) {
            __syncthreads();
#pragma unroll
            for (int i = 0; i < 8; ++i) { const int q = tid + 512 * i, row = q >> 4, ch = q & 15;
                const v4u val = *(const GAS v4u*)(KEYS + ((size_t)(h * 256 + row)) * 128 + ch * 8);
                *(LAS v4u*)(lds + row * KROW + ch * 16) = val; }
            __syncthreads();
            cur_h = h;
        }
        const int tok = tile * 256 + wave * 32 + l31;
        float T0[16], T1[16];
#pragma unroll
        for (int p = 0; p < 2; ++p) {
            f32x16 acc[4];
#pragma unroll
            for (int kb = 0; kb < 4; ++kb)
#pragma unroll
                for (int r = 0; r < 16; ++r) acc[kb][r] = 0.f;
#pragma unroll
            for (int ks = 0; ks < 8; ++ks)
#pragma unroll
                for (int kb = 0; kb < 4; ++kb) {
                    const bf16x8 ak = *(const LAS bf16x8*)(lds + (p * 128 + kb * 32 + l31) * KROW + (ks * 16 + hi * 8) * 2);
                    acc[kb] = __builtin_amdgcn_mfma_f32_32x32x16_bf16(ak, bqa[p][ks], acc[kb], 0, 0, 0);
                }
            if (p == 1) {
                const int un = (u + G < (M / 256) * 8) ? u + G : u; const int tokn = (un >> 3) * 256 + wave * 32 + l31;
                asm volatile("" : "+v"(acc[0]), "+v"(acc[1]), "+v"(acc[2]), "+v"(acc[3]));
#pragma unroll
                for (int pp = 0; pp < 2; ++pp) { const bf16* qp = Q + (size_t)tokn * 2048 + (un & 7) * 256 + pp * 128 + hi * 8;
#pragma unroll
                    for (int ks = 0; ks < 8; ++ks) bqa[pp][ks] = *(const GAS bf16x8*)(qp + ks * 16); }
            }
            float v[64];
#pragma unroll
            for (int kb = 0; kb < 4; ++kb)
#pragma unroll
                for (int r = 0; r < 16; ++r) v[kb * 16 + r] = __uint_as_float((__float_as_uint(acc[kb][r]) & 0xffffff80u) | (unsigned)(kb * 32 + (r & 3) + 8 * (r >> 2)));
            top16_of_64(v);
            const unsigned hb = (unsigned)hi << 2;
#pragma unroll
            for (int i = 0; i < 16; ++i) v[i] = __uint_as_float(__float_as_uint(v[i]) | hb);
            float c[16];
#pragma unroll
            for (int i = 0; i < 16; ++i) c[i] = fmax_s(v[i], __shfl_xor(v[15 - i], 32));
            merge16_desc(c);
#pragma unroll
            for (int i = 0; i < 16; ++i) { if (p == 0) T0[i] = c[i]; else T1[i] = c[i]; }
        }
        float f0[16], f1[16];
        unsigned long long K0lo = 0ull, K0hi = 0ull, K1lo = 0ull, K1hi = 0ull;
#pragma unroll
        for (int b = 0; b < 8; ++b) {
            K0lo |= (unsigned long long)(__float_as_uint(T0[b]) & 0x7fu) << (8 * b); K0hi |= (unsigned long long)(__float_as_uint(T0[8 + b]) & 0x7fu) << (8 * b);
            K1lo |= (unsigned long long)(__float_as_uint(T1[b]) & 0x7fu) << (8 * b); K1hi |= (unsigned long long)(__float_as_uint(T1[8 + b]) & 0x7fu) << (8 * b);
        }
#pragma unroll
        for (int i = 0; i < 16; ++i) { f0[i] = __uint_as_float(__float_as_uint(T0[i]) & 0xffffff80u); f1[i] = __uint_as_float(__float_as_uint(T1[i]) & 0xffffff80u); }
        float cd[32]; int n = 0;
#pragma unroll
        for (int i = 0; i < 16; ++i)
#pragma unroll
            for (int j = 0; j < 16; ++j)
                if ((i + 1) * (j + 1) <= 16) {
                    const float cv = __uint_as_float((__float_as_uint(f0[i] + f1[j]) & 0xffffff00u) | (unsigned)(i * 16 + j));
                    if ((n & 1) == 0) cd[n >> 1] = cv; else cd[n >> 1] = hi ? cv : cd[n >> 1];
                    ++n;
                }
#pragma unroll
        for (int q = 25; q < 32; ++q) cd[q] = __uint_as_float(0xff800000u);
        sort16_desc(cd); sort16_desc(cd + 16); top16_merge(cd, cd + 16);
        { float cm[16];
#pragma unroll
          for (int i = 0; i < 16; ++i) cm[i] = fmax_s(cd[i], __shfl_xor(cd[15 - i], 32));
          merge16_desc(cm);
#pragma unroll
          for (int i = 0; i < 16; ++i) cd[i] = cm[i]; }
        float rs = 0.f;
        { const GAS f32x4* rp = (const GAS f32x4*)(RS1 + (size_t)tok * 16);
#pragma unroll
          for (int i = 0; i < 4; ++i) { const f32x4 a = rp[i]; rs += (a.x + a.y) + (a.z + a.w); } }
        const float rstd = __builtin_amdgcn_rsqf(rs * (1.0f / 1024.0f) + EPS);
        int eidx[16]; float gt_[16]; float z0 = 0.f, sum = 0.f;
#pragma unroll
        for (int k = 0; k < 16; ++k) {
            const unsigned wb = __float_as_uint(cd[k]); const unsigned i = (wb >> 4) & 15u, j = wb & 15u;
            eidx[k] = (int)(key_lookup(K0lo, K0hi, i) * 128u + key_lookup(K1lo, K1hi, j));
            const float z = __uint_as_float(wb & 0xffffff00u) * rstd;
            if (k == 0) z0 = z;
            gt_[k] = __expf(z - z0); sum += gt_[k];
        }
        const float inv = 1.0f / sum;
        if (hi == 0) { GAS i32x4* ep = (GAS i32x4*)(EIDX + (size_t)tok * 128 + h * 16);
#pragma unroll
            for (int q = 0; q < 4; ++q) ep[q] = (i32x4){eidx[4 * q], eidx[4 * q + 1], eidx[4 * q + 2], eidx[4 * q + 3]};
        } else { GAS f32x4* gp = (GAS f32x4*)(GATE + (size_t)tok * 128 + h * 16);
#pragma unroll
            for (int q = 0; q < 4; ++q) gp[q] = (f32x4){gt_[4 * q] * inv, gt_[4 * q + 1] * inv, gt_[4 * q + 2] * inv, gt_[4 * q + 3] * inv};
        }
    }
}

__device__ __forceinline__ float gelu_tanh(float x) {
    const float y = 1.5957691216057308f * (x + 0.044715f * x * x * x);
    return x / (1.0f + __expf(-y));
}
typedef int v8i __attribute__((ext_vector_type(8)));
#define PEER_MFMA(a, b, c) __builtin_amdgcn_mfma_scale_f32_16x16x128_f8f6f4(a, b, c, 4  , 0  , 0, 0x7F7F7F7F, 0, 0x7F7F7F7F)
__device__ __forceinline__ void peer_dots_phase(const Ptrs& P, LAS unsigned char* lds, int vcu, int G, int wave, int lane) {
    const int gw = vcu * NWAVES + wave, NGW = G * NWAVES;
    const bf16* HB = (const bf16*)(P.ws + WS_HB); unsigned char* CF8 = P.ws + WS_CF; int* EOFF = (int*)(P.ws + WS_EOFF);
    const int* EIDX = (const int*)(P.ws + WS_EIDX); const float* GATE = (const float*)(P.ws + WS_GATE);
    const unsigned char* U4 = P.ws + WS_U;
    const float* SU = (const float*)(P.ws + WS_SU); const float* SV = (const float*)(P.ws + WS_SV);
    LAS unsigned char* xl = lds + 65536 + wave * 1024;
    LAS unsigned char* tb = lds + wave * 8192;
    const int lr = lane >> 5, lp = lane & 31;
    const int li = lane & 15, lq = lane >> 4;
    const int kl = 4 * lq + (li & 3);
    const int gam = lq + 4 * (li & 1); const int cpos = lq * 32 + (li & 3), epos = gam * 16 + ((li >> 1) & 1);
    int t = gw; if (t >= M) return;
    int ei0 = __builtin_nontemporal_load(EIDX + (size_t)t * 128 + lane), ei1 = __builtin_nontemporal_load(EIDX + (size_t)t * 128 + 64 + lane);
    float gg0 = __builtin_nontemporal_load(GATE + (size_t)t * 128 + lane), gg1 = __builtin_nontemporal_load(GATE + (size_t)t * 128 + 64 + lane);
    v2u hrow[4];
    { const GAS v2u* hp = (const GAS v2u*)(HB + (size_t)t * 1024) + lane;
#pragma unroll
      for (int j = 0; j < 4; ++j) hrow[j] = __builtin_nontemporal_load(hp + 64 * j); }
    v4u uw[8];
#pragma unroll
    for (int v = 0; v < 8; ++v) { const int e = __shfl(ei0, 2 * v + lr); uw[v] = *(const GAS v4u*)(U4 + (size_t)e * 512 + 16 * lp); }
    for (; t < M; t += NGW) {
        const int tn = (t + NGW < M) ? t + NGW : t;
        f32x2 x[8]; float ss = 0.f;
#pragma unroll
        for (int j = 0; j < 4; ++j) { const unsigned wa = hrow[j].x, wb = hrow[j].y; x[2 * j] = (f32x2){bf_lo(wa), bf_hi(wa)}; x[2 * j + 1] = (f32x2){bf_lo(wb), bf_hi(wb)};
            ss += (x[2 * j].x * x[2 * j].x + x[2 * j].y * x[2 * j].y) + (x[2 * j + 1].x * x[2 * j + 1].x + x[2 * j + 1].y * x[2 * j + 1].y); }
        ss = wave_sum(ss);
        const float rstd = __builtin_amdgcn_rsqf(ss * (1.0f / 1024.0f) + EPS);
        { const float sx = 16.0f * rstd;
#pragma unroll
          for (int j = 0; j < 4; ++j) { int w = __builtin_amdgcn_cvt_pk_fp8_f32(x[2 * j].x * sx, x[2 * j].y * sx, 0, false); w = __builtin_amdgcn_cvt_pk_fp8_f32(x[2 * j + 1].x * sx, x[2 * j + 1].y * sx, w, true);
              const int n = 4 * lane + 256 * j, sN = n >> 7, nn = n & 127, hN = nn >> 6, qN = (nn & 63) >> 4, jN = nn & 15;
              *(LAS unsigned*)(xl + 128 * sN + 32 * qN + 16 * hN + jN) = (unsigned)w; }
          asm volatile("s_waitcnt lgkmcnt(0)" ::: "memory"); }
        v8i xb[8];
#pragma unroll
        for (int sI = 0; sI < 8; ++sI) { const v4u b0 = *(const LAS v4u*)(xl + 128 * sI + 32 * lq), b1 = *(const LAS v4u*)(xl + 128 * sI + 32 * lq + 16);
            xb[sI] = (v8i){(int)b0.x, (int)b0.y, (int)b0.z, (int)b0.w, (int)b1.x, (int)b1.y, (int)b1.z, (int)b1.w}; }
        const int nei0 = __builtin_nontemporal_load(EIDX + (size_t)tn * 128 + lane), nei1 = __builtin_nontemporal_load(EIDX + (size_t)tn * 128 + 64 + lane);
        const float ngg0 = __builtin_nontemporal_load(GATE + (size_t)tn * 128 + lane), ngg1 = __builtin_nontemporal_load(GATE + (size_t)tn * 128 + 64 + lane);
        { const GAS v2u* hn = (const GAS v2u*)(HB + (size_t)tn * 1024) + lane;
#pragma unroll
          for (int j = 0; j < 4; ++j) hrow[j] = __builtin_nontemporal_load(hn + 64 * j); }
        for (int hq = 0; hq < 8 * REPS(7); ++hq) { const int hh = hq & 7;
            const int ereg = hh < 4 ? ei0 : ei1; const float greg = hh < 4 ? gg0 : gg1; const int lb = (hh & 3) * 16;
            const int el = __shfl(ereg, lb + kl);
            const float su = SU[el], sv = SV[el];
#pragma unroll
            for (int v = 0; v < 8; ++v) { const int r = 2 * v + lr; *(LAS v4u*)(tb + 512 * r + 16 * (lp ^ r)) = uw[v]; }
            __builtin_amdgcn_sched_barrier(0);
            { const bool lasth = (hq == 8 * REPS(7) - 1); const int hn = (hh + 1) & 7;
              const int nreg = lasth ? nei0 : (hn < 4 ? ei0 : ei1); const int nlb = (hn & 3) * 16;
#pragma unroll
              for (int v = 0; v < 8; ++v) { const int e = __shfl(nreg, nlb + 2 * v + lr); uw[v] = *(const GAS v4u*)(U4 + (size_t)e * 512 + 16 * lp); } }
            __builtin_amdgcn_sched_barrier(0);
            f32x4 acc = {0.f, 0.f, 0.f, 0.f};
#pragma unroll
            for (int sI = 0; sI < 8; ++sI) { const v4u af = *(const LAS v4u*)(tb + 512 * li + 16 * ((4 * sI + lq) ^ li));
                const v8i av = {(int)af.x, (int)af.y, (int)af.z, (int)af.w, 0, 0, 0, 0}; acc = PEER_MFMA(av, xb[sI], acc); }
            const int rsel = li & 3;
            const float d = rsel == 0 ? acc[0] : (rsel == 1 ? acc[1] : (rsel == 2 ? acc[2] : acc[3]));
            const float gk = __shfl(greg, lb + kl);
            const float cf = gk * gelu_tanh(d * su * (1.0f / 16.0f)) * sv * 1024.0f;
            const float cfc = fminf(fmaxf(cf, -448.0f), 448.0f);
            const unsigned c8 = (unsigned)__builtin_amdgcn_cvt_pk_fp8_f32(cfc, cfc, 0, false);
            if (li < 4) { CF8[(size_t)t * 128 + cpos + hh * 4] = (unsigned char)c8; EOFF[(size_t)t * 128 + epos + hh * 2] = el * D2PIECE; }
        }
        ei0 = nei0; ei1 = nei1; gg0 = ngg0; gg1 = ngg1;
    }
}
__device__ __forceinline__ void peer_sum_phase(const Ptrs& P, LAS unsigned char* lds, int bx, int G, int wave, int lane) {
    static_assert(D2NS == 4, "this body is written for four slices");
    constexpr int NTP = 2, SL = 256, MT = M / NTP, NSLOT = 5, AHD = 4;
    const int kx = bx & 7, sl = kx & 3, tp = kx >> 2, nbk = (G - kx + 7) >> 3;
    const int wj = (bx >> 3) * NWAVES + wave, NW = nbk * NWAVES;
    bf16* HB = (bf16*)(P.ws + WS_HB); float* RS2 = (float*)(P.ws + WS_RS2);
    const unsigned char* CF8 = P.ws + WS_CF; const unsigned char* EOFF = P.ws + WS_EOFF;
    const unsigned char* Vs = P.ws + WS_V + (size_t)sl * ((size_t)NEXP * D2PIECE);
    LAS unsigned char* rec = lds + wave * 16384;
    LAS unsigned char* dring = rec + 4096;
    const int li = lane & 15, lq = lane >> 4, rho = lane >> 3;
    const unsigned lc16 = 16u * (unsigned)(lane & 7);
    unsigned sel[2][8];
    { const unsigned pz = 0x0c0c0c0cu, psh = 8u * (unsigned)(li & 3);
#pragma unroll
      for (int g8 = 0; g8 < 2; ++g8)
#pragma unroll
          for (int r = 0; r < 8; ++r) { const unsigned pl = (pz & ~(0xffu << psh)) | ((unsigned)(2 * g8 + (r >> 2)) << psh); sel[g8][r] = ((r & 3) == (li >> 2)) ? pl : pz; } }
    const bool stl = lane < 40;
    auto rec_ptr = [&](int uu) -> const GAS v4u* { const size_t tt = (size_t)uu * NTP + tp; return (const GAS v4u*)(lane < 32 ? EOFF + tt * 512 + 16 * lane : CF8 + tt * 128 + 16 * (lane & 7)); };
    int u = wj; if (u >= MT) return;
    auto clampu = [&](int xx) { return xx < MT ? xx : u; };
#define D2_DMA(rs_, hd_, is_) do { const v2u eq_ = *(const LAS v2u*)((rs_) + rho * 64 + (hd_) * 8); \
        __builtin_amdgcn_global_load_lds((const unsigned*)(Vs + (size_t)(eq_.x + lc16)), (LAS unsigned*)(dring + (is_) * 2048), 16, 0, 0); \
        __builtin_amdgcn_global_load_lds((const unsigned*)(Vs + (size_t)(eq_.y + lc16)), (LAS unsigned*)(dring + (is_) * 2048 + 1024), 16, 0, 0); } while (0)
#define D2_REC(uu_, slot_) do { if (stl) __builtin_amdgcn_global_load_lds((const unsigned*)rec_ptr(uu_), (LAS unsigned*)(rec + (slot_) * 640), 16, 0, 0); } while (0)
    D2_REC(u, 0); D2_REC(clampu(u + NW), 1); D2_REC(clampu(u + 2 * NW), 2);
    asm volatile("s_waitcnt vmcnt(0)" ::: "memory");
#pragma unroll
    for (int h = 0; h < AHD; ++h) D2_DMA(rec, h, h);
    int cs = 0;
#define D2_IMG(dst_, slot_) do { const LAS unsigned char* im_ = dring + (slot_) * 2048 + (2 * lq) * 128 + 8 * li; \
        (dst_)[0] = *(const LAS v2u*)(im_); (dst_)[1] = *(const LAS v2u*)(im_ + 128); (dst_)[2] = *(const LAS v2u*)(im_ + 1024); (dst_)[3] = *(const LAS v2u*)(im_ + 1152); } while (0)
    v2u acur[4];
    asm volatile("s_waitcnt vmcnt(6)" ::: "memory");
    D2_IMG(acur, 0);
    for (int it = 0; u < MT; u += NW, ++it) {
        const int t = u * NTP + tp;
        LAS unsigned char* scur = rec + (it & 3) * 640; LAS unsigned char* snxt = rec + ((it + 1) & 3) * 640;
        D2_REC(clampu(u + 3 * NW), (it + 3) & 3);
        if (lane < 32) __builtin_amdgcn_global_load_lds((const unsigned*)((const unsigned char*)HB + (size_t)t * 2048 + SL * 2 * sl + 16 * lane), (LAS unsigned*)(rec + 2560), 16, 0, 0);
        v2u eqs[8]; unsigned cws[8];
#pragma unroll
        for (int h = 0; h < 8; ++h) { eqs[h] = *(const LAS v2u*)((h + AHD < 8 ? scur : snxt) + rho * 64 + ((h + AHD) & 7) * 8); cws[h] = *(const LAS unsigned*)(scur + 512 + lq * 32 + h * 4); }
        f32x4 acc = {0.f, 0.f, 0.f, 0.f};
#pragma unroll
        for (int h = 0; h < 8; ++h) {
            { const int is = cs + AHD >= NSLOT ? cs + AHD - NSLOT : cs + AHD;
              __builtin_amdgcn_global_load_lds((const unsigned*)(Vs + (size_t)(eqs[h].x + lc16)), (LAS unsigned*)(dring + is * 2048), 16, 0, 0);
              __builtin_amdgcn_global_load_lds((const unsigned*)(Vs + (size_t)(eqs[h].y + lc16)), (LAS unsigned*)(dring + is * 2048 + 1024), 16, 0, 0); }
            if (h <= 2) asm volatile("s_waitcnt vmcnt(8)" ::: "memory"); else asm volatile("s_waitcnt vmcnt(6)" ::: "memory");
            v2u anxt[4]; { const int ns = cs + 1 >= NSLOT ? 0 : cs + 1; D2_IMG(anxt, ns); }
            const unsigned cw = cws[h];
#pragma unroll
            for (int g8 = 0; g8 < 2; ++g8) {
                const v8i bv = {(int)__builtin_amdgcn_perm(0u, cw, sel[g8][0]), (int)__builtin_amdgcn_perm(0u, cw, sel[g8][1]), (int)__builtin_amdgcn_perm(0u, cw, sel[g8][2]), (int)__builtin_amdgcn_perm(0u, cw, sel[g8][3]),
                                (int)__builtin_amdgcn_perm(0u, cw, sel[g8][4]), (int)__builtin_amdgcn_perm(0u, cw, sel[g8][5]), (int)__builtin_amdgcn_perm(0u, cw, sel[g8][6]), (int)__builtin_amdgcn_perm(0u, cw, sel[g8][7])};
                const v8i av = {(int)acur[2 * g8].x, (int)acur[2 * g8].y, (int)acur[2 * g8 + 1].x, (int)acur[2 * g8 + 1].y, 0, 0, 0, 0};
                acc = PEER_MFMA(av, bv, acc);
            }
#pragma unroll
            for (int k = 0; k < 4; ++k) acur[k] = anxt[k];
            cs = cs + 1 >= NSLOT ? 0 : cs + 1;
        }
        const float osc = 1.0f / 1024.0f;
        const v2u hrow = *(const LAS v2u*)(rec + 2560 + 8 * lane);
        const unsigned wa = hrow.x, wb = hrow.y;
        const f32x2 o0 = (f32x2){bf_lo(wa) + acc[0] * osc, bf_hi(wa) + acc[1] * osc}, o1 = (f32x2){bf_lo(wb) + acc[2] * osc, bf_hi(wb) + acc[3] * osc};
        __builtin_nontemporal_store((v2u){pk2(o0.x, o0.y), pk2(o1.x, o1.y)}, (GAS v2u*)(HB + (size_t)t * 1024 + SL * sl + 4 * lane));
        float s2 = (o0.x * o0.x + o0.y * o0.y) + (o1.x * o1.x + o1.y * o1.y);
        s2 = wave_sum(s2);
        if (lane == 0) RS2[(size_t)t * D2NS + sl] = s2;
    }
    asm volatile("s_waitcnt vmcnt(0)" ::: "memory");
#undef D2_DMA
#undef D2_IMG
#undef D2_REC
}

__device__ __forceinline__ void final_phase(const Ptrs& P, int vcu, int G, int wave, int lane) {
    const int gw = vcu * NWAVES + wave, NGW = G * NWAVES; const float* RS3 = (const float*)(P.ws + WS_RS3); const bf16* H3 = (const bf16*)(P.ws + WS_PROJ);
    const GAS f32x4* gf = (const GAS f32x4*)P.g_final + lane;
    f32x4 g[4];
#pragma unroll
    for (int j = 0; j < 4; ++j) g[j] = gf[64 * j];
    for (int m0 = 2 * gw; m0 < M; m0 += 2 * NGW) {
        v2u hv[2][4]; float rs[2];
#pragma unroll
        for (int r = 0; r < 2; ++r) { const GAS v2u* hp = (const GAS v2u*)(H3 + (size_t)(m0 + r) * D) + lane;
#pragma unroll
            for (int j = 0; j < 4; ++j) hv[r][j] = hp[64 * j];
            rs[r] = 0.f; const GAS f32x4* rp = (const GAS f32x4*)(RS3 + (size_t)(m0 + r) * 16);
#pragma unroll
            for (int i = 0; i < 4; ++i) { const f32x4 a = rp[i]; rs[r] += (a.x + a.y) + (a.z + a.w); } }
#pragma unroll
        for (int r = 0; r < 2; ++r) { const float rstd = __builtin_amdgcn_rsqf(rs[r] * (1.0f / 1024.0f) + EPS);
            GAS f32x4* xr = (GAS f32x4*)(P.out + (size_t)(m0 + r) * D) + lane;
#pragma unroll
            for (int j = 0; j < 4; ++j) { const unsigned wa = hv[r][j].x, wb = hv[r][j].y; const f32x4 v = {bf_lo(wa), bf_hi(wa), bf_lo(wb), bf_hi(wb)}; xr[64 * j] = v * rstd * g[j]; } }
    }
}

struct Args { const float* in[17]; float* out; unsigned char* ws; int ph_lo, ph_hi; };
#ifndef PG8_SP2
#define PG8_SP2 true
#endif
#ifndef PG8_ALIGN
#define PG8_ALIGN true
#endif
__global__ void __launch_bounds__(NWAVES * 64, 2) mega_fwd(Args args) {
    extern __shared__ __attribute__((aligned(16))) unsigned char lds_raw[];
    LAS unsigned char* lds = (LAS unsigned char*)lds_raw;
    volatile LAS unsigned* MISC = (volatile LAS unsigned*)(lds + MISC_OFF);
    const int tid = threadIdx.x, lane = tid & 63, wave = __builtin_amdgcn_readfirstlane(tid >> 6);
    const int G = gridDim.x, bx = blockIdx.x; const int vcu = (G % 8 == 0) ? (bx % 8) * (G / 8) + bx / 8 : bx;
    Ptrs P;
    P.x = args.in[0]; P.p = args.in[1]; P.g_mix = args.in[2]; P.w_in = args.in[3]; P.conv_w = args.in[4]; P.pool_w = args.in[5]; P.pool_scale = args.in[6]; P.w_o = args.in[7];
    P.g_ffn = args.in[8]; P.w_q = args.in[9]; P.sub_keys = args.in[10]; P.eu = args.in[11]; P.ev = args.in[12]; P.g_ple = args.in[13]; P.w_gate = args.in[14]; P.w_proj = args.in[15]; P.g_final = args.in[16];
    P.out = args.out; P.ws = args.ws;
    gu32* ctl = (gu32*)(P.ws + WS_CTL);
    for (int u = tid; u < (LDS_BYTES - LDSCTL_OFF) / 4; u += NWAVES * 64) ((LAS unsigned*)(lds + LDSCTL_OFF))[u] = 0u;
    __syncthreads();
    XcdBarrier bar; bar.bar = (unsigned*)(ctl + CW_BAR); bar.x = 0; bar.st = nullptr;
    if (!MK_PER_PHASE) bar = xcd_barrier_post((unsigned*)(ctl + CW_BAR), MISC + 8);
    const int lo = args.ph_lo, hi = args.ph_hi;
#define IN(k) (lo <= (k) && (k) < hi)
#define SEAM(k) do { if (IN(k) && IN((k) + 1) && (k) != 1) xcd_barrier(bar); } while (0)
    pg8::bf16_t* const WIN = (pg8::bf16_t*)(P.ws + WS_WIN); pg8::bf16_t* const WO = (pg8::bf16_t*)(P.ws + WS_WO); pg8::bf16_t* const WQ = (pg8::bf16_t*)(P.ws + WS_WQ);
    pg8::bf16_t* const WG = (pg8::bf16_t*)(P.ws + WS_WG); pg8::bf16_t* const WP = (pg8::bf16_t*)(P.ws + WS_WP);
    pg8::bf16_t* const XB = (pg8::bf16_t*)(P.ws + WS_XB); pg8::bf16_t* const PL = XB; pg8::bf16_t* const PROJ = (pg8::bf16_t*)(P.ws + WS_PROJ); pg8::bf16_t* const QB = PROJ;
    pg8::bf16_t* const MIX = (pg8::bf16_t*)(P.ws + WS_MIX); pg8::bf16_t* const HB = (pg8::bf16_t*)(P.ws + WS_HB); pg8::bf16_t* const PB = (pg8::bf16_t*)(P.ws + WS_PB);

    if (IN(0)) { for (int rep = 0; rep < REPS(1); ++rep) { p0a_phase(P, lds, vcu, G, tid, wave, lane); SEAM(0); } }
    if (IN(2)) {
        pg8::Gemm g{XB, WIN, M, NPROJ, D}; pg8::StaticOrder S; S.init(M, NPROJ, G, bx);
        EpiProj E{PROJ, (const float*)(P.ws + WS_RSX)};
        for (int rep = 0; rep < REPS(2); ++rep) { pg8::gemm_phase<EpiProj, pg8::StaticOrder, PG8_ALIGN, PG8_SP2>(lds, g, S, E);
        SEAM(2); }
    }
    if (IN(3)) {
        for (int rep = 0; rep < REPS(3); ++rep) p2_phase(P, vcu, G, tid, wave);
        pg8::Gemm g{PB, WP, M, D, PLED}; pg8::StaticOrder S; S.init(M, D, G, bx);
        EpiBf16Row E{PL, D, nullptr};
        for (int rep = 0; rep < REPS(8); ++rep) pg8::gemm_phase<EpiBf16Row, pg8::StaticOrder, PG8_ALIGN, PG8_SP2>(lds, g, S, E);
        SEAM(3);
    }
    if (IN(4)) {
        pg8::Gemm g{MIX, WO, M, D, D}; pg8::StaticOrder S; S.init(M, D, G, bx);
        EpiH1 E{P.x, HB, (float*)(P.ws + WS_RS1)};
        for (int rep = 0; rep < REPS(4); ++rep) { pg8::gemm_phase<EpiH1, pg8::StaticOrder, PG8_ALIGN, PG8_SP2>(lds, g, S, E);
        SEAM(4); }
    }
    if (IN(5)) {
        pg8::Gemm g{HB, WQ, M, NQ, D}; pg8::StaticOrder S; S.init(M, NQ, G, bx);
        EpiBf16Row E{QB, NQ, nullptr};
        for (int rep = 0; rep < REPS(5); ++rep) { pg8::gemm_phase<EpiBf16Row, pg8::StaticOrder, PG8_ALIGN, PG8_SP2>(lds, g, S, E);
        SEAM(5); }
    }
    if (IN(6)) { for (int rep = 0; rep < REPS(6); ++rep) { score_phase(P, lds, bx, G, tid, wave, lane); SEAM(6); } }
    if (IN(7)) { peer_dots_phase(P, lds, vcu, G, wave, lane); SEAM(7); }
    if (IN(8)) { peer_sum_phase(P, lds, bx, G, wave, lane); SEAM(8); }
    if (IN(9)) {
        pg8::Gemm g{HB, WG, M, D, D}; pg8::StaticOrder S; S.init(M, D, G, bx);
        EpiGate E{PROJ  , HB, PL, (const float*)(P.ws + WS_RS2), (float*)(P.ws + WS_RS3)};
        pg8::gemm_phase<EpiGate, pg8::StaticOrder, PG8_ALIGN, PG8_SP2>(lds, g, S, E);
        SEAM(9);
    }
    if (IN(10)) { final_phase(P, vcu, G, wave, lane); }
#undef IN
#undef SEAM
}

extern "C" void kernel_launch(void* const* d_in, const int* in_sizes, int n_in, void* d_out, int out_size, void* d_ws, size_t ws_size, hipStream_t stream) {
    static int grid = 0;
    if (grid == 0) {
        if (n_in != 17 || in_sizes[0] != M * D || out_size != M * D || ws_size < WS_END) { fprintf(stderr, "kernel_launch: unexpected shapes (n_in %d, in0 %d, out %d, ws %zu); nothing launched\n", n_in, n_in > 0 ? in_sizes[0] : -1, out_size, ws_size); grid = -1; return; }
        int dev = 0, cus = 0, per_cu = 0;
        if (hipGetDevice(&dev) != hipSuccess || hipDeviceGetAttribute(&cus, hipDeviceAttributeMultiprocessorCount, dev) != hipSuccess) { fprintf(stderr, "kernel_launch: device query failed\n"); grid = -1; return; }
        if (hipFuncSetAttribute((const void*)mega_fwd, hipFuncAttributeMaxDynamicSharedMemorySize, LDS_BYTES) != hipSuccess) { fprintf(stderr, "kernel_launch: hipFuncSetAttribute failed\n"); grid = -1; return; }
        if (hipOccupancyMaxActiveBlocksPerMultiprocessor(&per_cu, (const void*)mega_fwd, NWAVES * 64, LDS_BYTES) != hipSuccess || per_cu < 1) {
            fprintf(stderr, "kernel_launch: the occupancy query reports %d resident workgroups per CU for this kernel (512 threads, %d B LDS): the grid barrier needs one per CU; nothing launched\n", per_cu, LDS_BYTES);
            (void)hipGetLastError(); grid = -1; return; }
        grid = cus;
    }
    if (grid < 0) return;
    if (hipMemsetAsync((char*)d_ws + WS_CTL, 0, CTL_ZERO_BYTES, stream) != hipSuccess) { fprintf(stderr, "kernel_launch: memset failed\n"); return; }
    Args a{};
    for (int i = 0; i < 17; ++i) a.in[i] = (const float*)d_in[i];
    a.out = (float*)d_out; a.ws = (unsigned char*)d_ws;
#if MK_PER_PHASE
    for (int ph = 0; ph < NPHASES; ++ph) { a.ph_lo = ph; a.ph_hi = ph + 1; hipLaunchKernelGGL(mega_fwd, dim3(grid), dim3(NWAVES * 64), LDS_BYTES, stream, a); }
#else
    a.ph_lo = 0; a.ph_hi = NPHASES;
    hipLaunchKernelGGL(mega_fwd, dim3(grid), dim3(NWAVES * 64), LDS_BYTES, stream, a);
#endif
    const hipError_t le = hipPeekAtLastError();
    if (le != hipSuccess) fprintf(stderr, "kernel_launch: launch failed: %s\n", hipGetErrorName(le));
}
```
